# Optimizing an MI355X kernel written in HIP

```python
import jax, jax.numpy as jnp
from jax import lax
import numpy as np

D_MODEL = 1024
BATCH = 4
SEQ = 4096
DEPTH = 2

HEAD_DIM = 64
N_FOX_HEADS = 8
N_NSA_HEADS = 8
N_NSA_KV = 2
NSA_GROUP = N_NSA_HEADS // N_NSA_KV
CMP_LEN = 32
CMP_STRIDE = 16
SLC_LEN = 64
SLC_TOPK = 16
WINDOW = 512
Q_BLOCK = 128
FORCE_BONUS = 1.0e4
NEG = -1.0e30
ATTN_WIDTH = (N_FOX_HEADS + N_NSA_HEADS) * HEAD_DIM
FOX_QKV = 3 * N_FOX_HEADS * HEAD_DIM
FOX_F = N_FOX_HEADS
NSA_Q = N_NSA_HEADS * HEAD_DIM
NSA_KV = 6 * N_NSA_KV * HEAD_DIM
NSA_GATES = 3 * N_NSA_HEADS
EVEN_IN = FOX_QKV + FOX_F + NSA_Q + NSA_KV + NSA_GATES

D_RNN = 1280
RNN_BLOCKS = 10
RNN_BLOCK_W = D_RNN // RNN_BLOCKS
CONV_W = 4
LRU_C = 8.0

PEER_HEADS = 8
PEER_NKEYS = 128
PEER_NEXP = PEER_NKEYS * PEER_NKEYS
PEER_DKEY = 256
PEER_HALF = PEER_DKEY // 2
PEER_TOPK = 16
TOKEN_BLOCK = 128

RMS_EPS = 1e-6

kernel_name = 'fox_nsa_rglru_peer_hybrid'


def rmsnorm(x, g):
    xf = x.astype(jnp.float32)
    y = xf * lax.rsqrt(jnp.mean(xf * xf, axis=-1, keepdims=True) + RMS_EPS)
    return (y * g.astype(jnp.float32)).astype(x.dtype)


def alibi_slopes(n):
    return jnp.asarray(2.0 ** (-8.0 * np.arange(1, n + 1) / n), jnp.float32)


def masked_softmax(s, mask):
    return jax.nn.softmax(jnp.where(mask, s, NEG), axis=-1)


def fox_attention(q, k, v, logf):
    B, S, H, dh = q.shape
    cT = jnp.cumsum(logf, axis=1).transpose(0, 2, 1)
    qs = q * (dh ** -0.5)
    kpos = jnp.arange(S)

    def block(i):
        t0 = i * Q_BLOCK
        tpos = t0 + jnp.arange(Q_BLOCK)
        qb = lax.dynamic_slice_in_dim(qs, t0, Q_BLOCK, axis=1)
        cb = lax.dynamic_slice_in_dim(cT, t0, Q_BLOCK, axis=2)
        s = jnp.einsum('bthd,bshd->bhts', qb, k) + cb[..., None] - cT[:, :, None, :]
        p = masked_softmax(s, kpos[None, :] <= tpos[:, None])
        return jnp.einsum('bhts,bshd->bthd', p, v)

    out = lax.map(block, jnp.arange(S // Q_BLOCK))
    return out.swapaxes(0, 1).reshape(B, S, H * dh)


def nsa_attention(q, k_cmp, v_cmp, k_slc, v_slc, k_win, v_win, gates, cmp_pos, w_cmp_k, w_cmp_v):
    B, S, H, dh = q.shape
    G, R = N_NSA_KV, NSA_GROUP
    f32 = jnp.float32
    n_cmp = (S - CMP_LEN) // CMP_STRIDE + 1
    n_sel = S // SLC_LEN
    k_sel = min(SLC_TOPK, n_sel)
    slopes = alibi_slopes(H).reshape(G, R)
    cstart = CMP_STRIDE * np.arange(n_cmp)
    cidx = cstart[:, None] + np.arange(CMP_LEN)[None, :]
    kc = jnp.einsum('bnlgd,lde->bnge', k_cmp[:, cidx] + cmp_pos[:, None, :], w_cmp_k)
    vc = jnp.einsum('bnlgd,lde->bnge', v_cmp[:, cidx] + cmp_pos[:, None, :], w_cmp_v)
    cend = jnp.asarray(cstart + CMP_LEN - 1, jnp.int32)
    sstart = SLC_LEN * np.arange(n_sel)
    overlap = jnp.asarray((cstart[:, None] < sstart[None, :] + SLC_LEN)
                          & (cstart[:, None] + CMP_LEN > sstart[None, :]), f32)
    ks = k_slc.reshape(B, n_sel, SLC_LEN, G, dh).transpose(0, 3, 1, 2, 4)
    vs = v_slc.reshape(B, n_sel, SLC_LEN, G, dh).transpose(0, 3, 1, 2, 4)
    kw_pad = jnp.pad(k_win, ((0, 0), (WINDOW, 0), (0, 0), (0, 0)))
    vw_pad = jnp.pad(v_win, ((0, 0), (WINDOW, 0), (0, 0), (0, 0)))
    qg = q.reshape(B, S, G, R, dh) * (dh ** -0.5)
    gg = gates.reshape(B, S, G, R, 3)
    jpos = jnp.arange(n_sel)
    gather_blocks = jax.vmap(jax.vmap(lambda tab, ix: tab[ix]))
    M = k_sel * SLC_LEN

    def block(i):
        t0 = i * Q_BLOCK
        tpos = t0 + jnp.arange(Q_BLOCK)
        qb = lax.dynamic_slice_in_dim(qg, t0, Q_BLOCK, axis=1)
        gb = lax.dynamic_slice_in_dim(gg, t0, Q_BLOCK, axis=1)
        cmask = cend[None, :] <= tpos[:, None]
        s_c = (jnp.einsum('btgrd,bngd->bgrtn', qb, kc)
               - slopes[:, :, None, None] * (tpos[:, None] - cend[None, :]).astype(f32))
        p_c = masked_softmax(s_c, cmask) * jnp.any(cmask, axis=-1)[:, None].astype(f32)
        o_c = jnp.einsum('bgrtn,bngd->btgrd', p_c, vc)
        imp = jnp.einsum('bgrtn,nj->bgtj', p_c, overlap)
        cur = tpos // SLC_LEN
        forced = ((jpos[None, :] == 0) | (jpos[None, :] == cur[:, None])
                  | (jpos[None, :] == cur[:, None] - 1))
        imp = jnp.where(jpos[None, :] <= cur[:, None], imp + FORCE_BONUS * forced.astype(f32), -jnp.inf)
        _, sel = lax.top_k(imp, k_sel)
        gk = gather_blocks(ks, sel).reshape(B, G, Q_BLOCK, M, dh)
        gv = gather_blocks(vs, sel).reshape(B, G, Q_BLOCK, M, dh)
        spos = (sel[..., None] * SLC_LEN + jnp.arange(SLC_LEN)).reshape(B, G, Q_BLOCK, M)
        sdist = (tpos[:, None] - spos).astype(f32)
        s_s = (jnp.einsum('btgrd,bgtmd->bgrtm', qb, gk)
               - slopes[None, :, :, None, None] * sdist[:, :, None])
        p_s = masked_softmax(s_s, (sdist >= 0)[:, :, None])
        o_s = jnp.einsum('bgrtm,bgtmd->btgrd', p_s, gv)
        kw = lax.dynamic_slice_in_dim(kw_pad, t0, Q_BLOCK + WINDOW, axis=1)
        vw = lax.dynamic_slice_in_dim(vw_pad, t0, Q_BLOCK + WINDOW, axis=1)
        wpos = t0 - WINDOW + jnp.arange(Q_BLOCK + WINDOW)
        wdist = tpos[:, None] - wpos[None, :]
        wmask = (wdist >= 0) & (wdist < WINDOW) & (wpos[None, :] >= 0)
        s_w = (jnp.einsum('btgrd,bsgd->bgrts', qb, kw)
               - slopes[:, :, None, None] * wdist.astype(f32))
        o_w = jnp.einsum('bgrts,bsgd->btgrd', masked_softmax(s_w, wmask), vw)
        return gb[..., 0:1] * o_c + gb[..., 1:2] * o_s + gb[..., 2:3] * o_w

    out = lax.map(block, jnp.arange(S // Q_BLOCK))
    return out.swapaxes(0, 1).reshape(B, S, H * dh)


def even_mixer(h, w_in, b_f, cmp_pos, w_cmp_k, w_cmp_v, w_out):
    B, S, _ = h.shape
    z = jnp.einsum('bsd,de->bse', h, w_in).astype(jnp.float32)
    splits = [int(v) for v in np.cumsum([FOX_QKV, FOX_F, NSA_Q, NSA_KV])]
    fox_qkv, fox_f, nsa_q, nsa_kv, nsa_g = jnp.split(z, splits, axis=-1)
    fqkv = fox_qkv.reshape(B, S, 3, N_FOX_HEADS, HEAD_DIM)
    logf = jax.nn.log_sigmoid(fox_f + b_f.astype(jnp.float32))
    o_fox = fox_attention(fqkv[:, :, 0], fqkv[:, :, 1], fqkv[:, :, 2], logf)
    kv = nsa_kv.reshape(B, S, 6, N_NSA_KV, HEAD_DIM)
    gates = jax.nn.sigmoid(nsa_g).reshape(B, S, N_NSA_HEADS, 3)
    o_nsa = nsa_attention(nsa_q.reshape(B, S, N_NSA_HEADS, HEAD_DIM),
                          kv[:, :, 0], kv[:, :, 1], kv[:, :, 2], kv[:, :, 3], kv[:, :, 4], kv[:, :, 5],
                          gates, cmp_pos.astype(jnp.float32), w_cmp_k.astype(jnp.float32),
                          w_cmp_v.astype(jnp.float32))
    o = jnp.concatenate([o_fox, o_nsa], axis=-1)
    return jnp.einsum('bse,ed->bsd', o, w_out.astype(jnp.float32)).astype(h.dtype)


def rg_lru(x, w_ra, b_ra, w_ri, b_ri, lam):
    B, S, C = x.shape
    f32 = jnp.float32
    xf = x.astype(f32)
    xb = xf.reshape(B, S, RNN_BLOCKS, RNN_BLOCK_W)
    r = jax.nn.sigmoid(jnp.einsum('bsnc,nce->bsne', xb, w_ra.astype(f32)).reshape(B, S, C) + b_ra.astype(f32))
    i = jax.nn.sigmoid(jnp.einsum('bsnc,nce->bsne', xb, w_ri.astype(f32)).reshape(B, S, C) + b_ri.astype(f32))
    log_a = -LRU_C * r * jax.nn.softplus(-lam.astype(f32))
    a = jnp.exp(log_a)
    u = jnp.sqrt(-jnp.expm1(2.0 * log_a)) * (i * xf)

    def combine(left, right):
        a1, b1 = left
        a2, b2 = right
        return a1 * a2, a2 * b1 + b2

    _, hs = lax.associative_scan(combine, (a, u), axis=1)
    return hs


def odd_mixer(h, w_in, conv_w, conv_b, w_ra, b_ra, w_ri, b_ri, lam, w_out):
    z = jnp.einsum('bsd,de->bse', h, w_in)
    gate, xr = jnp.split(z, 2, axis=-1)
    xr = lax.conv_general_dilated(xr, conv_w[:, None, :].astype(xr.dtype), window_strides=(1,),
                                  padding=((CONV_W - 1, 0),),
                                  dimension_numbers=('NWC', 'WIO', 'NWC'),
                                  feature_group_count=D_RNN) + conv_b.astype(xr.dtype)
    y = rg_lru(xr, w_ra, b_ra, w_ri, b_ri, lam)
    y = jax.nn.gelu(gate.astype(jnp.float32), approximate=False) * y
    return jnp.einsum('bse,ed->bsd', y, w_out.astype(jnp.float32)).astype(h.dtype)


def peer_ffn(h, w_q, sub_keys, u_tab, v_tab):
    B, S, D = h.shape
    K = PEER_TOPK
    q = jnp.einsum('bsd,de->bse', h, w_q).astype(jnp.float32).reshape(B, S, PEER_HEADS, 2, PEER_HALF)
    s = jnp.einsum('bshcd,hckd->bshck', q, sub_keys.astype(jnp.float32))
    top_s, top_i = lax.top_k(s, K)
    cand = (top_s[..., 0, :, None] + top_s[..., 1, None, :]).reshape(B, S, PEER_HEADS, K * K)
    best_s, best_c = lax.top_k(cand, K)
    i1 = jnp.take_along_axis(top_i[..., 0, :], best_c // K, axis=-1)
    i2 = jnp.take_along_axis(top_i[..., 1, :], best_c % K, axis=-1)
    ids = i1 * PEER_NKEYS + i2
    g = jax.nn.softmax(best_s, axis=-1)
    nb = S // TOKEN_BLOCK

    def to_blocks(a):
        return a.reshape(B, nb, TOKEN_BLOCK, *a.shape[2:]).swapaxes(0, 1)

    def block(args):
        xb, idb, gb = args
        act = jax.nn.gelu(jnp.einsum('btd,bthkd->bthk', xb, u_tab[idb]).astype(jnp.float32),
                          approximate=False)
        w = (gb * act).astype(v_tab.dtype)
        return jnp.einsum('bthk,bthkd->btd', w, v_tab[idb])

    out = lax.map(block, (to_blocks(h), to_blocks(ids), to_blocks(g)))
    return out.swapaxes(0, 1).reshape(B, S, D).astype(h.dtype)


def setup_inputs(seed: int = 0) -> dict:
    key = jax.random.key(seed)
    ks = jax.random.split(key, 32)
    f32 = jnp.float32
    n_even = (DEPTH + 1) // 2
    n_odd = DEPTH // 2

    def nrm(k, shape, scale):
        return scale * jax.random.normal(k, shape, f32)

    def gain(k, shape):
        return 1.0 + 0.02 * jax.random.normal(k, shape, f32)

    a0 = jax.random.uniform(ks[16], (n_odd, D_RNN), f32, 0.9, 0.999)
    return {
        'x': nrm(ks[0], (BATCH, SEQ, D_MODEL), 1.0),
        'even_norm_g': gain(ks[1], (n_even, D_MODEL)),
        'even_w_in': nrm(ks[2], (n_even, D_MODEL, EVEN_IN), D_MODEL ** -0.5),
        'even_b_f': 3.0 + nrm(ks[3], (n_even, N_FOX_HEADS), 0.5),
        'even_cmp_pos': nrm(ks[4], (n_even, CMP_LEN, HEAD_DIM), 0.1),
        'even_w_cmp_k': nrm(ks[5], (n_even, CMP_LEN, HEAD_DIM, HEAD_DIM), (CMP_LEN * HEAD_DIM) ** -0.5),
        'even_w_cmp_v': nrm(ks[6], (n_even, CMP_LEN, HEAD_DIM, HEAD_DIM), (CMP_LEN * HEAD_DIM) ** -0.5),
        'even_w_out': nrm(ks[7], (n_even, ATTN_WIDTH, D_MODEL), ATTN_WIDTH ** -0.5),
        'odd_norm_g': gain(ks[8], (n_odd, D_MODEL)),
        'odd_w_in': nrm(ks[9], (n_odd, D_MODEL, 2 * D_RNN), D_MODEL ** -0.5),
        'odd_conv_w': nrm(ks[10], (n_odd, CONV_W, D_RNN), CONV_W ** -0.5),
        'odd_conv_b': nrm(ks[11], (n_odd, D_RNN), 0.01),
        'odd_w_ra': nrm(ks[12], (n_odd, RNN_BLOCKS, RNN_BLOCK_W, RNN_BLOCK_W), RNN_BLOCK_W ** -0.5),
        'odd_b_ra': nrm(ks[13], (n_odd, D_RNN), 0.01),
        'odd_w_ri': nrm(ks[14], (n_odd, RNN_BLOCKS, RNN_BLOCK_W, RNN_BLOCK_W), RNN_BLOCK_W ** -0.5),
        'odd_b_ri': nrm(ks[15], (n_odd, D_RNN), 0.01),
        'odd_lam': jnp.log(a0) - jnp.log1p(-a0),
        'odd_w_out': nrm(ks[17], (n_odd, D_RNN, D_MODEL), D_RNN ** -0.5),
        'ffn_norm_g': gain(ks[18], (DEPTH, D_MODEL)),
        'peer_w_q': nrm(ks[19], (DEPTH, D_MODEL, PEER_HEADS * PEER_DKEY), D_MODEL ** -0.5),
        'peer_sub_keys': nrm(ks[20], (DEPTH, PEER_HEADS, 2, PEER_NKEYS, PEER_HALF), PEER_HALF ** -0.5),
        'peer_u': nrm(ks[21], (DEPTH, PEER_NEXP, D_MODEL), D_MODEL ** -0.5),
        'peer_v': nrm(ks[22], (DEPTH, PEER_NEXP, D_MODEL), PEER_HEADS ** -0.5),
        'final_g': gain(ks[23], (D_MODEL,)),
    }


def reference(x, even_norm_g, even_w_in, even_b_f, even_cmp_pos, even_w_cmp_k, even_w_cmp_v, even_w_out,
              odd_norm_g, odd_w_in, odd_conv_w, odd_conv_b, odd_w_ra, odd_b_ra, odd_w_ri, odd_b_ri,
              odd_lam, odd_w_out, ffn_norm_g, peer_w_q, peer_sub_keys, peer_u, peer_v, final_g):
    h = x
    for layer in range(DEPTH):
        j = layer // 2
        if layer % 2 == 0:
            h = h + even_mixer(rmsnorm(h, even_norm_g[j]), even_w_in[j], even_b_f[j], even_cmp_pos[j],
                               even_w_cmp_k[j], even_w_cmp_v[j], even_w_out[j])
        else:
            h = h + odd_mixer(rmsnorm(h, odd_norm_g[j]), odd_w_in[j], odd_conv_w[j], odd_conv_b[j],
                              odd_w_ra[j], odd_b_ra[j], odd_w_ri[j], odd_b_ri[j], odd_lam[j], odd_w_out[j])
        h = h + peer_ffn(rmsnorm(h, ffn_norm_g[layer]), peer_w_q[layer], peer_sub_keys[layer],
                         peer_u[layer], peer_v[layer])
    return rmsnorm(h, final_g)
```

```cpp
#include <hip/hip_runtime.h>
#include <hip/hip_cooperative_groups.h>
#include <cstdio>
#include <cstdint>
#include <cstring>
namespace cg = cooperative_groups;

#ifndef SINGLE_LAUNCH
#define SINGLE_LAUNCH 0
#endif

typedef _Float16 h16;
typedef _Float16 half8 __attribute__((ext_vector_type(8)));
typedef _Float16 half4 __attribute__((ext_vector_type(4)));
typedef _Float16 half2v __attribute__((ext_vector_type(2)));
typedef float f32x4 __attribute__((ext_vector_type(4)));
typedef float f32x16 __attribute__((ext_vector_type(16)));
typedef unsigned long long u64;

#define NTHR 256
constexpr int BATCH = 4, SEQ = 4096, DM = 1024, TOK = BATCH * SEQ;
constexpr int ZLD = 2944, Z2LD = 2560, DRNN = 1280;
constexpr int EVEN_IN = 2848;
constexpr float LOG2E = 1.4426950408889634f;
constexpr float QSCALE = 0.125f * LOG2E;
constexpr float NEGBIG = -1.0e30f;
constexpr int KST = 72;
constexpr int NPHASE = 20;

struct Params {
    const float *x, *even_norm_g, *even_w_in, *even_b_f, *even_cmp_pos, *even_w_cmp_k, *even_w_cmp_v, *even_w_out;
    const float *odd_norm_g, *odd_w_in, *odd_conv_w, *odd_conv_b, *odd_w_ra, *odd_b_ra, *odd_w_ri, *odd_b_ri, *odd_lam, *odd_w_out;
    const float *ffn_norm_g, *peer_w_q, *peer_sub_keys, *peer_u, *peer_v, *final_g;
    float* out;
    h16 *WtE, *WtEo, *WtO, *WtOo, *WtQ, *Wc, *Wr, *Keys, *Pos16, *U16, *V16;
    float* H; h16* HN;
    h16 *Z, *VtF, *VtS, *VtW, *KC, *VCt, *O; float *FG, *C2, *OACC;
    h16* QP; float* SC; int* IDS; float* GW;
    h16* Z2; float *RA, *RU, *AggP, *AggH;
    long long ph0, ph1;
};

__device__ __forceinline__ int tidx_() { int t = threadIdx.x; asm volatile("" : "+v"(t)); return t; }
__device__ __forceinline__ int bidx_() { int b = blockIdx.x; asm volatile("" : "+s"(b)); return b; }
__device__ __forceinline__ int widx_() { return __builtin_amdgcn_readfirstlane(tidx_() >> 6); }

__device__ __forceinline__ float wave_sum(float v) {
#pragma unroll
    for (int o = 32; o > 0; o >>= 1) v += __shfl_xor(v, o);
    return v;
}
__device__ __forceinline__ float gelu_exact(float v) { return 0.5f * v * (1.0f + erff(v * 0.70710678118654752f)); }
__device__ __forceinline__ float sigmoidf_(float v) { return 1.0f / (1.0f + __expf(-v)); }
__device__ __forceinline__ float log_sigmoid(float v) { return v >= 0.f ? -log1pf(expf(-v)) : v - log1pf(expf(v)); }
__device__ __forceinline__ int crow(int r, int hi) { return (r & 3) + 8 * (r >> 2) + 4 * hi; }
__device__ __forceinline__ f32x16 zero16() { f32x16 z;
#pragma unroll
    for (int i = 0; i < 16; ++i) z[i] = 0.f; return z; }

__device__ __forceinline__ void rms_write_h16(const float (&v)[16], const float* __restrict__ g, h16* __restrict__ dst, int lane) {
    float ss = 0.f;
#pragma unroll
    for (int i = 0; i < 16; ++i) ss += v[i] * v[i];
    ss = wave_sum(ss);
    const float rstd = rsqrtf(ss * (1.0f / 1024.0f) + 1e-6f);
#pragma unroll
    for (int hseg = 0; hseg < 2; ++hseg) {
        const int c0 = hseg * 512 + lane * 8;
        const f32x4 g0 = *(const f32x4*)(g + c0), g1 = *(const f32x4*)(g + c0 + 4);
        half8 o;
#pragma unroll
        for (int i = 0; i < 4; ++i) { o[i] = (h16)(v[hseg * 8 + i] * rstd * g0[i]); o[4 + i] = (h16)(v[hseg * 8 + 4 + i] * rstd * g1[i]); }
        *(half8*)(dst + c0) = o;
    }
}
__device__ __forceinline__ void load_row16(const float* __restrict__ src, float (&v)[16], int lane) {
#pragma unroll
    for (int hseg = 0; hseg < 2; ++hseg) {
        const int c0 = hseg * 512 + lane * 8;
        const f32x4 a = *(const f32x4*)(src + c0), b = *(const f32x4*)(src + c0 + 4);
#pragma unroll
        for (int i = 0; i < 4; ++i) { v[hseg * 8 + i] = a[i]; v[hseg * 8 + 4 + i] = b[i]; }
    }
}

__device__ __forceinline__ int even_col_map(int n) {
    if (n < 1536) return n;
    if (n < 2048) return 1544 + (n - 1536);
    if (n < 2816) return 2056 + (n - 2048);
    if (n < 2824) return 1536 + (n - 2816);
    if (n < 2848) return n;
    return -1;
}
__device__ __forceinline__ void transpose_job(const float* __restrict__ src, int K, int N, h16* __restrict__ dst, int Ndst, bool mapped, float* tileS, int& base) {
    const int tid = tidx_(), nb = gridDim.x, bid = bidx_();
    const int nkt = K / 64, nnt = Ndst / 64, ntiles = nkt * nnt;
    int first = (bid - (base % nb) + nb) % nb;
    for (int tile = first; tile < ntiles; tile += nb) {
        const int k0 = (tile % nkt) * 64, n0 = (tile / nkt) * 64;
#pragma unroll
        for (int i = 0; i < 16; ++i) {
            const int e = tid + 256 * i, kk = e >> 6, nn = e & 63;
            const int sc = mapped ? even_col_map(n0 + nn) : (n0 + nn);
            tileS[kk * 65 + nn] = (sc >= 0) ? src[(size_t)(k0 + kk) * N + sc] : 0.f;
        }
        __syncthreads();
        const int n = tid >> 2, ks = (tid & 3) * 16;
        half8 o0, o1;
#pragma unroll
        for (int i = 0; i < 8; ++i) { o0[i] = (h16)tileS[(ks + i) * 65 + n]; o1[i] = (h16)tileS[(ks + 8 + i) * 65 + n]; }
        h16* d = dst + (size_t)(n0 + n) * K + k0 + ks;
        *(half8*)d = o0; *(half8*)(d + 8) = o1;
        __syncthreads();
    }
    base += ntiles;
}
__device__ __forceinline__ void convert_job(const float* __restrict__ src, h16* __restrict__ dst, size_t n) {
    const size_t n4 = n / 4, stride = (size_t)gridDim.x * NTHR;
    for (size_t i = (size_t)bidx_() * NTHR + tidx_(); i < n4; i += stride) {
        const f32x4 v = *(const f32x4*)(src + 4 * i);
        half4 o; o[0] = (h16)v[0]; o[1] = (h16)v[1]; o[2] = (h16)v[2]; o[3] = (h16)v[3];
        *(half4*)(dst + 4 * i) = o;
    }
}
__device__ __forceinline__ void phase_prep(const Params& p, char* smem) {
    float* tileS = (float*)smem;
    int base = 0;
    for (int job = 0; job < 28; ++job) {
        const float* src; int K, N, Nd; h16* dst; bool mapped = false;
        if (job == 0) { src = p.even_w_in; K = 1024; N = EVEN_IN; dst = p.WtE; Nd = ZLD; mapped = true; }
        else if (job == 1) { src = p.even_w_out; K = 1024; N = 1024; dst = p.WtEo; Nd = 1024; }
        else if (job == 2) { src = p.odd_w_in; K = 1024; N = 2560; dst = p.WtO; Nd = 2560; }
        else if (job == 3) { src = p.odd_w_out; K = 1280; N = 1024; dst = p.WtOo; Nd = 1024; }
        else if (job < 6) { const int l = job - 4; src = p.peer_w_q + (size_t)l * 1024 * 2048; K = 1024; N = 2048; dst = p.WtQ + (size_t)l * 2048 * 1024; Nd = 2048; }
        else if (job == 6) { src = p.even_w_cmp_k; K = 2048; N = 64; dst = p.Wc; Nd = 64; }
        else if (job == 7) { src = p.even_w_cmp_v; K = 2048; N = 64; dst = p.Wc + 64 * 2048; Nd = 64; }
        else if (job < 18) { const int n = job - 8; src = p.odd_w_ra + n * 16384; K = 128; N = 128; dst = p.Wr + n * 16384; Nd = 128; }
        else { const int n = job - 18; src = p.odd_w_ri + n * 16384; K = 128; N = 128; dst = p.Wr + (10 + n) * 16384; Nd = 128; }
        transpose_job(src, K, N, dst, Nd, mapped, tileS, base);
    }
    convert_job(p.peer_sub_keys, p.Keys, (size_t)2 * 8 * 2 * 128 * 128);
    convert_job(p.even_cmp_pos, p.Pos16, 2048);
    convert_job(p.peer_u, p.U16, (size_t)2 * 16384 * 1024);
    convert_job(p.peer_v, p.V16, (size_t)2 * 16384 * 1024);
    const int lane = tidx_() & 63, wv = bidx_() * 4 + widx_(), nwv = gridDim.x * 4;
    for (int row = wv; row < TOK; row += nwv) {
        float v[16]; load_row16(p.x + (size_t)row * DM, v, lane);
        rms_write_h16(v, p.even_norm_g, p.HN + (size_t)row * DM, lane);
    }
}

enum { EPI_EVEN_IN = 0, EPI_F32_RESID = 1, EPI_H16 = 2, EPI_F32 = 3 };
struct GemmArgs {
    const h16* A; int lda; const h16* Bt; int ldb; int M, N, K; int a_ntile_stride;
    int mode; h16* c16; int ldc16; float* c32; int ldc32; const float* resid;
};
constexpr int GST = 40;

template <int MODE, int LDC>
__device__ __forceinline__ void gemm_epilogue(const Params& p, const GemmArgs& g, int mt, int nt, const f32x4 (&acc)[4][4]) {
    const int lane = tidx_() & 63, wid = widx_(), wm = wid >> 1, wn = wid & 1;
    const int rbase = mt * 128 + wm * 64 + (lane >> 4) * 4, cbase = nt * 128 + wn * 64 + (lane & 15);
    if (MODE == EPI_EVEN_IN) {
        int kind;
        if (nt < 4 || (nt >= 12 && nt < 16)) kind = 0; else if (nt >= 8 && nt < 12) kind = 2; else if (nt == 19) kind = 3; else if (nt == 21) kind = 4; else if (nt == 22) kind = 5; else kind = 1;
#pragma unroll
        for (int m = 0; m < 4; ++m)
#pragma unroll
            for (int n = 0; n < 4; ++n) {
                const int row = rbase + m * 16, col = cbase + n * 16;
                const f32x4 v = acc[m][n];
                if (kind <= 1) {
                    const float sc = kind == 0 ? QSCALE : 1.0f;
#pragma unroll
                    for (int j = 0; j < 4; ++j) p.Z[(size_t)(row + j) * ZLD + col] = (h16)(v[j] * sc);
                } else if (kind <= 4) {
                    const int b = row >> 12, s = row & 4095;
                    half4 o; o[0] = (h16)v[0]; o[1] = (h16)v[1]; o[2] = (h16)v[2]; o[3] = (h16)v[3];
                    h16* dst;
                    if (kind == 2) { const int c = col - 1024; dst = p.VtF + ((size_t)(b * 8 + (c >> 6)) * 64 + (c & 63)) * SEQ + s; }
                    else if (kind == 3) { const int c = col - 2432; dst = p.VtS + ((size_t)(b * 2 + (c >> 6)) * 64 + (c & 63)) * SEQ + s; }
                    else { const int c = col - 2688; dst = p.VtW + ((size_t)(b * 2 + (c >> 6)) * 64 + (c & 63)) * SEQ + s; }
                    *(half4*)dst = o;
                } else {
                    const int c = col - 2816;
                    if (c < 32) {
                        const float bf = c < 8 ? p.even_b_f[c] : 0.f;
#pragma unroll
                        for (int j = 0; j < 4; ++j) p.FG[(size_t)(row + j) * 32 + c] = c < 8 ? log_sigmoid(v[j] + bf) * LOG2E : sigmoidf_(v[j]);
                    }
                }
            }
    } else {
#pragma unroll
        for (int m = 0; m < 4; ++m)
#pragma unroll
            for (int n = 0; n < 4; ++n) {
                const int row = rbase + m * 16, col = cbase + n * 16;
                const f32x4 v = acc[m][n];
#pragma unroll
                for (int j = 0; j < 4; ++j) {
                    if (MODE == EPI_F32_RESID) g.c32[(size_t)(row + j) * LDC + col] = g.resid[(size_t)(row + j) * LDC + col] + v[j];
                    else if (MODE == EPI_H16) g.c16[(size_t)(row + j) * LDC + col] = (h16)v[j];
                    else g.c32[(size_t)(row + j) * LDC + col] = v[j];
                }
            }
    }
}

template <int MODE, int LDA, int LDB, int GN, int GK, int LDC, int ANS>
__device__ __forceinline__ void phase_gemm(const Params& p, const GemmArgs& g, char* smem) {
    h16* As = (h16*)smem;
    h16* Bs = As + 2 * 128 * GST;
    const int tid = tidx_(), lane = tid & 63, wid = widx_(), wm = wid >> 1, wn = wid & 1;
    constexpr int nM = TOK / 128, nN = GN / 128, ntiles = nM * nN, nk = GK / 32;
    const int lr = tid >> 2, lc = (tid & 3) * 8;
    for (int tile = bidx_(); tile < ntiles; tile += gridDim.x) {
        const int mt = tile / nN, nt = tile % nN;
        const h16* Ag = g.A + (size_t)(mt * 128 + lr) * LDA + (size_t)nt * ANS + lc;
        const h16* Bg = g.Bt + (size_t)(nt * 128 + lr) * LDB + lc;
        constexpr size_t a64 = (size_t)64 * LDA, b64 = (size_t)64 * LDB;
        f32x4 acc[4][4];
#pragma unroll
        for (int m = 0; m < 4; ++m)
#pragma unroll
            for (int n = 0; n < 4; ++n) acc[m][n] = (f32x4){0.f, 0.f, 0.f, 0.f};
        half8 ra0 = *(const half8*)Ag, ra1 = *(const half8*)(Ag + a64), rb0 = *(const half8*)Bg, rb1 = *(const half8*)(Bg + b64);
        *(half8*)(As + lr * GST + lc) = ra0; *(half8*)(As + (lr + 64) * GST + lc) = ra1;
        *(half8*)(Bs + lr * GST + lc) = rb0; *(half8*)(Bs + (lr + 64) * GST + lc) = rb1;
        __syncthreads();
        for (int kt = 0; kt < nk; ++kt) {
            const int cur = kt & 1;
            if (kt + 1 < nk) {
                const int ko = (kt + 1) * 32;
                ra0 = *(const half8*)(Ag + ko); ra1 = *(const half8*)(Ag + a64 + ko); rb0 = *(const half8*)(Bg + ko); rb1 = *(const half8*)(Bg + b64 + ko);
            }
            const h16* Ac = As + cur * 128 * GST + (wm * 64 + (lane & 15)) * GST + (lane >> 4) * 8;
            const h16* Bc = Bs + cur * 128 * GST + (wn * 64 + (lane & 15)) * GST + (lane >> 4) * 8;
            half8 af[4], bf[4];
#pragma unroll
            for (int m = 0; m < 4; ++m) af[m] = *(const half8*)(Ac + m * 16 * GST);
#pragma unroll
            for (int n = 0; n < 4; ++n) bf[n] = *(const half8*)(Bc + n * 16 * GST);
#pragma unroll
            for (int m = 0; m < 4; ++m)
#pragma unroll
                for (int n = 0; n < 4; ++n) acc[m][n] = __builtin_amdgcn_mfma_f32_16x16x32_f16(af[m], bf[n], acc[m][n], 0, 0, 0);
            if (kt + 1 < nk) {
                const int nx = cur ^ 1;
                *(half8*)(As + nx * 128 * GST + lr * GST + lc) = ra0; *(half8*)(As + nx * 128 * GST + (lr + 64) * GST + lc) = ra1;
                *(half8*)(Bs + nx * 128 * GST + lr * GST + lc) = rb0; *(half8*)(Bs + nx * 128 * GST + (lr + 64) * GST + lc) = rb1;
            }
            __syncthreads();
        }
        gemm_epilogue<MODE, LDC>(p, g, mt, nt, acc);
    }
}

__device__ __forceinline__ void phase_cumsum_compress(const Params& p) {
    const int lane = tidx_() & 63, wv = bidx_() * 4 + widx_(), nwv = gridDim.x * 4;
    for (int u = wv; u < 32 + 256; u += nwv) {
        if (u < 32) {
            const int b = u >> 3, h = u & 7;
            const float* src = p.FG + (size_t)(b * SEQ + lane * 64) * 32 + h;
            float loc[64]; float run = 0.f;
#pragma unroll
            for (int i = 0; i < 64; ++i) { run += src[(size_t)i * 32]; loc[i] = run; }
            float incl = run;
#pragma unroll
            for (int o = 1; o < 64; o <<= 1) { const float t = __shfl_up(incl, o); if (lane >= o) incl += t; }
            const float excl = incl - run;
            float* dst = p.C2 + (size_t)(b * 8 + h) * SEQ + lane * 64;
#pragma unroll
            for (int i = 0; i < 64; ++i) dst[i] = excl + loc[i];
        } else {
            const int cu = u - 32, kv = cu >> 7, bg = (cu >> 4) & 7, nt = cu & 15;
            const int b = bg >> 1, g = bg & 1;
            int n = nt * 16 + (lane & 15); const int nc = n < 255 ? n : 254;
            const h16* Ab = p.Z + (size_t)(b * SEQ + 16 * nc) * ZLD + 2048 + kv * 128 + g * 64 + (lane >> 4) * 8;
            const h16* Wb = p.Wc + (size_t)kv * 64 * 2048 + (size_t)(lane & 15) * 2048 + (lane >> 4) * 8;
            const h16* Pb = p.Pos16 + (lane >> 4) * 8;
            f32x4 acc[4];
#pragma unroll
            for (int e = 0; e < 4; ++e) acc[e] = (f32x4){0.f, 0.f, 0.f, 0.f};
#pragma unroll 4
            for (int ks = 0; ks < 64; ++ks) {
                const int l = ks >> 1, d0 = (ks & 1) * 32;
                half8 a = *(const half8*)(Ab + (size_t)l * ZLD + d0);
                const half8 ps = *(const half8*)(Pb + ks * 32);
                a = a + ps;
#pragma unroll
                for (int e = 0; e < 4; ++e) {
                    const half8 w = *(const half8*)(Wb + (size_t)e * 16 * 2048 + ks * 32);
                    acc[e] = __builtin_amdgcn_mfma_f32_16x16x32_f16(a, w, acc[e], 0, 0, 0);
                }
            }
            const int n0 = nt * 16 + (lane >> 4) * 4;
#pragma unroll
            for (int e = 0; e < 4; ++e) {
                const int ec = e * 16 + (lane & 15);
                if (kv == 0) {
#pragma unroll
                    for (int j = 0; j < 4; ++j) p.KC[((size_t)bg * 256 + n0 + j) * 64 + ec] = (n0 + j < 255) ? (h16)acc[e][j] : (h16)0.f;
                } else {
                    half4 o;
#pragma unroll
                    for (int j = 0; j < 4; ++j) o[j] = (n0 + j < 255) ? (h16)acc[e][j] : (h16)0.f;
                    *(half4*)(p.VCt + ((size_t)bg * 64 + ec) * 256 + n0) = o;
                }
            }
        }
    }
}

struct RowState { float m, l; f32x16 o0, o1; };
__device__ __forceinline__ void rs_reset(RowState& s) { s.m = NEGBIG; s.l = 0.f; s.o0 = zero16(); s.o1 = zero16(); }

__device__ __forceinline__ void kv_load(const h16* kb, int kst, const h16* vb, int vst, half8 (&kr)[2], half8 (&vr)[2]) {
    const int tid = tidx_();
#pragma unroll
    for (int i = 0; i < 2; ++i) {
        const int c = tid + 256 * i, row = c >> 3, cc = (c & 7) * 8;
        kr[i] = *(const half8*)(kb + (size_t)row * kst + cc);
        vr[i] = *(const half8*)(vb + (size_t)row * vst + cc);
    }
}
__device__ __forceinline__ void kv_store(h16* Ks, h16* Vs, const half8 (&kr)[2], const half8 (&vr)[2]) {
    const int tid = tidx_();
#pragma unroll
    for (int i = 0; i < 2; ++i) {
        const int c = tid + 256 * i, row = c >> 3, cc = (c & 7) * 8;
        *(half8*)(Ks + row * KST + cc) = kr[i];
        *(half8*)(Vs + row * KST + cc) = vr[i];
    }
}
__device__ __forceinline__ void qk_tile(const h16* Ks, const half8 (&qf)[4], f32x16 (&s)[2], int lane) {
    const int r32 = lane & 31, hh = lane >> 5;
#pragma unroll
    for (int kt = 0; kt < 2; ++kt) {
        s[kt] = zero16();
#pragma unroll
        for (int ks = 0; ks < 4; ++ks) {
            const half8 kf = *(const half8*)(Ks + (kt * 32 + r32) * KST + ks * 16 + hh * 8);
            s[kt] = __builtin_amdgcn_mfma_f32_32x32x16_f16(kf, qf[ks], s[kt], 0, 0, 0);
        }
    }
}
__device__ __forceinline__ void pv_tile(const h16* Vs, const f32x16 (&pr)[2], f32x16& o0, f32x16& o1, int lane) {
    const int r32 = lane & 31, hh = lane >> 5;
#pragma unroll
    for (int kt = 0; kt < 2; ++kt)
#pragma unroll
        for (int s2 = 0; s2 < 2; ++s2) {
            half8 pf;
#pragma unroll
            for (int j = 0; j < 8; ++j) pf[j] = (h16)pr[kt][8 * s2 + j];
            const int kof = kt * 32 + 16 * s2 + 4 * hh;
            {
                const half4 a = *(const half4*)(Vs + r32 * KST + kof), b = *(const half4*)(Vs + r32 * KST + kof + 8);
                half8 vf; vf[0] = a[0]; vf[1] = a[1]; vf[2] = a[2]; vf[3] = a[3]; vf[4] = b[0]; vf[5] = b[1]; vf[6] = b[2]; vf[7] = b[3];
                o0 = __builtin_amdgcn_mfma_f32_32x32x16_f16(vf, pf, o0, 0, 0, 0);
            }
            {
                const half4 a = *(const half4*)(Vs + (32 + r32) * KST + kof), b = *(const half4*)(Vs + (32 + r32) * KST + kof + 8);
                half8 vf; vf[0] = a[0]; vf[1] = a[1]; vf[2] = a[2]; vf[3] = a[3]; vf[4] = b[0]; vf[5] = b[1]; vf[6] = b[2]; vf[7] = b[3];
                o1 = __builtin_amdgcn_mfma_f32_32x32x16_f16(vf, pf, o1, 0, 0, 0);
            }
        }
}

enum { M_FOX = 0, M_SLC = 1, M_WIN = 2 };
template <int MODE>
__device__ __forceinline__ void flash_step(const h16* Ks, const h16* Vs, const float* csS, const half8 (&qf)[4], RowState& st,
                                           int t, int kpos0, float slope2, float ct2, bool selbit, int lane) {
    const int hh = lane >> 5;
    f32x16 s[2];
    qk_tile(Ks, qf, s, lane);
    float mx = NEGBIG;
    int dbase = t - kpos0 - 4 * hh;
    asm volatile("" : "+v"(dbase));
#pragma unroll
    for (int kt = 0; kt < 2; ++kt)
#pragma unroll
        for (int r = 0; r < 16; ++r) {
            const int kl = kt * 32 + crow(r, hh);
            const int dist = dbase - (kt * 32 + (r & 3) + 8 * (r >> 2));
            bool valid; float v;
            if (MODE == M_FOX) { valid = dist >= 0; v = s[kt][r] + ct2 - csS[kl]; }
            else if (MODE == M_SLC) { valid = selbit && dist >= 0; v = s[kt][r] - slope2 * (float)dist; }
            else { valid = dist >= 0 && dist < 512; v = s[kt][r] - slope2 * (float)dist; }
            v = valid ? v : NEGBIG;
            s[kt][r] = v;
            mx = fmaxf(mx, v);
        }
    mx = fmaxf(mx, __shfl_xor(mx, 32));
    const float mn = fmaxf(st.m, mx);
    const float alpha = __builtin_amdgcn_exp2f(st.m - mn);
    st.m = mn;
    float ps = 0.f;
#pragma unroll
    for (int kt = 0; kt < 2; ++kt)
#pragma unroll
        for (int r = 0; r < 16; ++r) {
            const float v = s[kt][r];
            const float pe = v > -1.0e29f ? __builtin_amdgcn_exp2f(v - mn) : 0.f;
            s[kt][r] = pe; ps += pe;
        }
    st.l = st.l * alpha + ps;
#pragma unroll
    for (int r = 0; r < 16; ++r) { st.o0[r] *= alpha; st.o1[r] *= alpha; }
    pv_tile(Vs, s, st.o0, st.o1, lane);
}

template <int MODE>
__device__ __forceinline__ void run_flash(u64 mask, const h16* Kg, int kst, const h16* Vg, int vst, const float* csg, char* smem,
                                          const half8 (&qf)[4], RowState& st, int t, int twlo, int twhi, float slope2, float ct2, u64 sel, int lane) {
    h16* Kb = (h16*)smem; h16* Vb = Kb + 2 * 64 * KST; float* csb = (float*)(Vb + 2 * 64 * KST);
    if (mask == 0ull) return;
    half8 kr[2], vr[2]; float csr = 0.f;
    int jc = __builtin_ctzll(mask); mask &= mask - 1;
    kv_load(Kg + (size_t)jc * 64 * kst, kst, Vg + jc * 64, vst, kr, vr);
    if (MODE == M_FOX && tidx_() < 64) csr = csg[jc * 64 + tidx_()];
    kv_store(Kb, Vb, kr, vr);
    if (MODE == M_FOX && tidx_() < 64) csb[tidx_()] = csr;
    __syncthreads();
    int buf = 0;
    for (;;) {
        int jn = -1;
        if (mask) { jn = __builtin_ctzll(mask); mask &= mask - 1; }
        if (jn >= 0) {
            kv_load(Kg + (size_t)jn * 64 * kst, kst, Vg + jn * 64, vst, kr, vr);
            if (MODE == M_FOX && tidx_() < 64) csr = csg[jn * 64 + tidx_()];
        }
        bool need = jc * 64 <= twhi;
        if (MODE == M_WIN) need = need && (jc * 64 + 63 >= twlo - 511);
        if (need)
            flash_step<MODE>(Kb + buf * 64 * KST, Vb + buf * 64 * KST, csb + buf * 64, qf, st, t, jc * 64, slope2, ct2, (sel >> jc) & 1ull, lane);
        if (jn >= 0) {
            kv_store(Kb + (buf ^ 1) * 64 * KST, Vb + (buf ^ 1) * 64 * KST, kr, vr);
            if (MODE == M_FOX && tidx_() < 64) csb[(buf ^ 1) * 64 + tidx_()] = csr;
        }
        __syncthreads();
        if (jn < 0) break;
        jc = jn; buf ^= 1;
    }
}

__device__ __forceinline__ void load_q(const h16* qrow, half8 (&qf)[4], int lane) {
#pragma unroll
    for (int ks = 0; ks < 4; ++ks) qf[ks] = *(const half8*)(qrow + ks * 16 + (lane >> 5) * 8);
}
__device__ __forceinline__ void store_o(h16* orow, const f32x16& o0, const f32x16& o1, int lane) {
    const int hh = lane >> 5;
#pragma unroll
    for (int rg = 0; rg < 4; ++rg) {
        half4 a, b;
#pragma unroll
        for (int j = 0; j < 4; ++j) { a[j] = (h16)o0[4 * rg + j]; b[j] = (h16)o1[4 * rg + j]; }
        *(half4*)(orow + 8 * rg + 4 * hh) = a;
        *(half4*)(orow + 32 + 8 * rg + 4 * hh) = b;
    }
}

__device__ __forceinline__ void oacc_store(float* row, const f32x16& o0, const f32x16& o1, float sc, int lane) {
    const int hh = lane >> 5;
#pragma unroll
    for (int rg = 0; rg < 4; ++rg) {
        *(f32x4*)(row + 8 * rg + 4 * hh) = (f32x4){o0[4 * rg] * sc, o0[4 * rg + 1] * sc, o0[4 * rg + 2] * sc, o0[4 * rg + 3] * sc};
        *(f32x4*)(row + 32 + 8 * rg + 4 * hh) = (f32x4){o1[4 * rg] * sc, o1[4 * rg + 1] * sc, o1[4 * rg + 2] * sc, o1[4 * rg + 3] * sc};
    }
}
__device__ __forceinline__ void oacc_add(float* row, const f32x16& o0, const f32x16& o1, float sc, int lane) {
    const int hh = lane >> 5;
#pragma unroll
    for (int rg = 0; rg < 4; ++rg) {
        f32x4 a = *(const f32x4*)(row + 8 * rg + 4 * hh), b = *(const f32x4*)(row + 32 + 8 * rg + 4 * hh);
#pragma unroll
        for (int j = 0; j < 4; ++j) { a[j] += o0[4 * rg + j] * sc; b[j] += o1[4 * rg + j] * sc; }
        *(f32x4*)(row + 8 * rg + 4 * hh) = a; *(f32x4*)(row + 32 + 8 * rg + 4 * hh) = b;
    }
}
__device__ __forceinline__ void oacc_final(const float* row, h16* orow, const f32x16& o0, const f32x16& o1, float sc, int lane) {
    const int hh = lane >> 5;
#pragma unroll
    for (int rg = 0; rg < 4; ++rg) {
        const f32x4 a = *(const f32x4*)(row + 8 * rg + 4 * hh), b = *(const f32x4*)(row + 32 + 8 * rg + 4 * hh);
        half4 x, y;
#pragma unroll
        for (int j = 0; j < 4; ++j) { x[j] = (h16)(a[j] + o0[4 * rg + j] * sc); y[j] = (h16)(b[j] + o1[4 * rg + j] * sc); }
        *(half4*)(orow + 8 * rg + 4 * hh) = x; *(half4*)(orow + 32 + 8 * rg + 4 * hh) = y;
    }
}

__device__ __forceinline__ void fox_unit(const Params& p, int b, int h, int qt, char* smem) {
    const int tid = tidx_(), lane = tid & 63, wid = widx_();
    const int q0 = qt * 128, t0w = q0 + wid * 32, t = t0w + (lane & 31);
    half8 qf[4]; load_q(p.Z + (size_t)(b * SEQ + t) * ZLD + h * 64, qf, lane);
    const float* csg = p.C2 + (size_t)(b * 8 + h) * SEQ;
    const float ct2 = csg[t];
    RowState st; rs_reset(st);
    const int jmax = (q0 + 127) >> 6;
    const u64 mask = (jmax >= 63) ? ~0ull : ((1ull << (jmax + 1)) - 1ull);
    run_flash<M_FOX>(mask, p.Z + (size_t)b * SEQ * ZLD + 512 + h * 64, ZLD, p.VtF + (size_t)(b * 8 + h) * 64 * SEQ, SEQ, csg, smem,
                     qf, st, t, t0w, t0w + 31, 0.f, ct2, 0ull, lane);
    const float lt = st.l + __shfl_xor(st.l, 32);
    const float inv = 1.0f / lt;
#pragma unroll
    for (int r = 0; r < 16; ++r) { st.o0[r] *= inv; st.o1[r] *= inv; }
    store_o(p.O + (size_t)(b * SEQ + t) * DM + h * 64, st.o0, st.o1, lane);
}

__device__ __forceinline__ void nsa_unit(const Params& p, int b, int g, int qt32, char* smem) {
    const int tid = tidx_(), lane = tid & 63, wid = widx_(), hh = lane >> 5, r32 = lane & 31;
    const int t0 = qt32 * 32, t = t0 + r32, head = g * 4 + wid, bg = b * 2 + g;
    const float slope2 = exp2f(-(float)(head + 1)) * LOG2E;
    half8 qf[4]; load_q(p.Z + (size_t)(b * SEQ + t) * ZLD + 1536 + head * 64, qf, lane);
    const float* gp = p.FG + (size_t)(b * SEQ + t) * 32 + 8 + head * 3;
    const float gate_c = gp[0], gate_s = gp[1], gate_w = gp[2];
    h16* Kb = (h16*)smem; h16* Vb = Kb + 2 * 64 * KST;
    u64* selS = (u64*)(smem + 37376);
    u64* unS = selS + 32;
    float* oaccrow = p.OACC + (size_t)(b * SEQ + t) * 512 + head * 64;
    unsigned* impS = (unsigned*)(smem + 37888);
    {
        for (int i = tid; i < 32 * 64; i += NTHR) impS[i] = 0u;
        const int nsteps = ((t0 >> 4) >> 6) + 1;
        const h16* Kg = p.KC + (size_t)bg * 256 * 64; const h16* Vg = p.VCt + (size_t)bg * 64 * 256;
        float mrun = NEGBIG, lrun = 0.f;
        for (int i = 0; i < nsteps; ++i) {
            half8 kr[2], vr[2];
            kv_load(Kg + (size_t)i * 64 * 64, 64, Vg + i * 64, 256, kr, vr);
            kv_store(Kb, Vb, kr, vr);
            __syncthreads();
            f32x16 s[2];
            qk_tile(Kb, qf, s, lane);
            float mx = NEGBIG;
            int dbase = t - 31 - 16 * (i * 64 + 4 * hh);
            asm volatile("" : "+v"(dbase));
#pragma unroll
            for (int kt = 0; kt < 2; ++kt)
#pragma unroll
                for (int r = 0; r < 16; ++r) {
                    const int dist = dbase - 16 * (kt * 32 + (r & 3) + 8 * (r >> 2));
                    float v = s[kt][r] - slope2 * (float)dist;
                    v = dist >= 0 ? v : NEGBIG;
                    s[kt][r] = v; mx = fmaxf(mx, v);
                }
            mx = fmaxf(mx, __shfl_xor(mx, 32));
            const float mn = fmaxf(mrun, mx), alpha = __builtin_amdgcn_exp2f(mrun - mn);
            mrun = mn;
            float ps = 0.f;
#pragma unroll
            for (int kt = 0; kt < 2; ++kt)
#pragma unroll
                for (int r = 0; r < 16; ++r) { const float v = s[kt][r]; ps += v > -1.0e29f ? __builtin_amdgcn_exp2f(v - mn) : 0.f; }
            lrun = lrun * alpha + ps;
            __syncthreads();
        }
        const float lt = lrun + __shfl_xor(lrun, 32);
        const float inv = lt > 0.f ? 1.0f / lt : 0.f;
        f32x16 o0 = zero16(), o1 = zero16();
        float carry = 0.f;
        for (int i = 0; i < nsteps; ++i) {
            half8 kr[2], vr[2];
            kv_load(Kg + (size_t)i * 64 * 64, 64, Vg + i * 64, 256, kr, vr);
            kv_store(Kb, Vb, kr, vr);
            __syncthreads();
            f32x16 s[2];
            qk_tile(Kb, qf, s, lane);
            int dbase = t - 31 - 16 * (i * 64 + 4 * hh);
            asm volatile("" : "+v"(dbase));
#pragma unroll
            for (int kt = 0; kt < 2; ++kt)
#pragma unroll
                for (int r = 0; r < 16; ++r) {
                    const int dist = dbase - 16 * (kt * 32 + (r & 3) + 8 * (r >> 2));
                    const float v = s[kt][r] - slope2 * (float)dist;
                    s[kt][r] = dist >= 0 ? __builtin_amdgcn_exp2f(v - mrun) * inv : 0.f;
                }
            float R[2][4];
#pragma unroll
            for (int kt = 0; kt < 2; ++kt)
#pragma unroll
                for (int rg = 0; rg < 4; ++rg) R[kt][rg] = __shfl_xor(s[kt][4 * rg + 3], 32);
#pragma unroll
            for (int kt = 0; kt < 2; ++kt)
#pragma unroll
                for (int rg = 0; rg < 4; ++rg) {
                    const float G = (s[kt][4 * rg] + s[kt][4 * rg + 1]) + (s[kt][4 * rg + 2] + s[kt][4 * rg + 3]);
                    const float prev = (kt == 0 && rg == 0) ? carry : (rg > 0 ? R[kt][rg - 1] : R[kt - 1][3]);
                    const float val = G + (hh ? R[kt][rg] : prev);
                    const int j = 16 * i + 8 * kt + 2 * rg + hh;
                    atomicAdd(&impS[r32 * 64 + j], (unsigned)(val * 67108864.0f + 0.5f));
                }
            carry = R[1][3];
            pv_tile(Vb, s, o0, o1, lane);
            __syncthreads();
        }
        oacc_store(oaccrow, o0, o1, gate_c, lane);
    }
    __syncthreads();
    {
        u64 un = 0ull;
        for (int i = 0; i < 8; ++i) {
            const int tok = wid * 8 + i, tt = t0 + tok, cur = tt >> 6;
            const int j = lane;
            const bool valid = j <= cur;
            const bool forced = (j == 0) || (j == cur) || (j == cur - 1);
            const unsigned key = valid ? impS[tok * 64 + j] + (forced ? 0x40000000u : 0u) : 0u;
            int rank = 0;
            for (int jj = 0; jj < 64; ++jj) {
                const unsigned kv = (unsigned)__builtin_amdgcn_readlane((int)key, jj);
                rank += (kv > key || (kv == key && jj < j)) ? 1 : 0;
            }
            const u64 selm = __ballot(valid && rank < 16);
            if (lane == 0) selS[tok] = selm;
            un |= selm;
        }
        if (lane == 0) unS[wid] = un;
    }
    __syncthreads();
    const u64 mysel = selS[r32];
    const u64 un = unS[0] | unS[1] | unS[2] | unS[3];
    __syncthreads();
    {
        RowState st; rs_reset(st);
        run_flash<M_SLC>(un, p.Z + (size_t)b * SEQ * ZLD + 2304 + g * 64, ZLD, p.VtS + (size_t)bg * 64 * SEQ, SEQ, nullptr, smem,
                         qf, st, t, t0, t0 + 31, slope2, 0.f, mysel, lane);
        const float lt = st.l + __shfl_xor(st.l, 32);
        oacc_add(oaccrow, st.o0, st.o1, gate_s / lt, lane);
    }
    {
        RowState st; rs_reset(st);
        const int lo = t0 - 511, jlo = lo > 0 ? (lo >> 6) : 0, jhi = (t0 + 31) >> 6;
        u64 mask = (jhi >= 63 ? ~0ull : ((1ull << (jhi + 1)) - 1ull)) & ~((1ull << jlo) - 1ull);
        run_flash<M_WIN>(mask, p.Z + (size_t)b * SEQ * ZLD + 2560 + g * 64, ZLD, p.VtW + (size_t)bg * 64 * SEQ, SEQ, nullptr, smem,
                         qf, st, t, t0, t0 + 31, slope2, 0.f, 0ull, lane);
        const float lt = st.l + __shfl_xor(st.l, 32);
        oacc_final(oaccrow, p.O + (size_t)(b * SEQ + t) * DM + 512 + head * 64, st.o0, st.o1, gate_w / lt, lane);
    }
}

__device__ __forceinline__ void phase_attention(const Params& p, char* smem) {
    for (int u = bidx_(); u < 2048; u += gridDim.x) {
        const int st = 31 - (u >> 6), w = u & 63;
        if (w < 32) fox_unit(p, w >> 3, w & 7, st, smem);
        else { const int idx = w - 32; nsa_unit(p, (idx & 7) >> 1, idx & 1, st * 4 + (idx >> 3), smem); }
        __syncthreads();
    }
}

__device__ __forceinline__ void phase_rmsnorm(const Params& p, const float* g) {
    const int lane = tidx_() & 63, wv = bidx_() * 4 + widx_(), nwv = gridDim.x * 4;
    for (int row = wv; row < TOK; row += nwv) {
        float v[16]; load_row16(p.H + (size_t)row * DM, v, lane);
        rms_write_h16(v, g, p.HN + (size_t)row * DM, lane);
    }
}

__device__ __forceinline__ void top16_of_128(float va, float vb, int lane, float& tv, int& ti) {
    tv = -INFINITY; ti = 0;
    for (int r = 0; r < 16; ++r) {
        float m; int mi;
        if (va >= vb) { m = va; mi = lane; } else { m = vb; mi = lane + 64; }
#pragma unroll
        for (int o = 32; o > 0; o >>= 1) {
            const float om = __shfl_xor(m, o); const int oi = __shfl_xor(mi, o);
            if (om > m || (om == m && oi < mi)) { m = om; mi = oi; }
        }
        if (lane == r) { tv = m; ti = mi; }
        if (mi == lane) va = -INFINITY;
        if (mi == lane + 64) vb = -INFINITY;
    }
}
__device__ __forceinline__ void phase_peer_topk(const Params& p) {
    const int lane = tidx_() & 63, wv = bidx_() * 4 + widx_(), nwv = gridDim.x * 4;
    int ca, cb;
    {
        const int c = lane;
        if (c < 16) { ca = 0; cb = c; } else if (c < 24) { ca = 1; cb = c - 16; } else if (c < 29) { ca = 2; cb = c - 24; } else if (c < 33) { ca = 3; cb = c - 29; }
        else if (c < 36) { ca = 4; cb = c - 33; } else if (c < 38) { ca = 5; cb = c - 36; } else if (c < 40) { ca = 6; cb = c - 38; } else if (c < 42) { ca = 7; cb = c - 40; }
        else { ca = 8 + (c - 42); cb = 0; }
        if (c >= 50) { ca = 0; cb = 0; }
    }
    for (int u = wv; u < TOK * 8; u += nwv) {
        const int tk = u >> 3, h = u & 7;
        const float* sp = p.SC + (size_t)tk * 2048 + h * 256;
        float tv0, tv1; int ti0, ti1;
        top16_of_128(sp[lane], sp[lane + 64], lane, tv0, ti0);
        top16_of_128(sp[128 + lane], sp[192 + lane], lane, tv1, ti1);
        const float sa = __shfl(tv0, ca), sb = __shfl(tv1, cb);
        float cv = lane < 50 ? sa + sb : -INFINITY; const int cidx = ca * 16 + cb;
        float bs = -INFINITY; int bc = 0;
        for (int r = 0; r < 16; ++r) {
            float m = cv; int mi = lane < 50 ? cidx : 1 << 20;
#pragma unroll
            for (int o = 32; o > 0; o >>= 1) {
                const float om = __shfl_xor(m, o); const int oi = __shfl_xor(mi, o);
                if (om > m || (om == m && oi < mi)) { m = om; mi = oi; }
            }
            if (lane == r) { bs = m; bc = mi; }
            if (lane < 50 && mi == cidx) cv = -INFINITY;
        }
        const int i1 = __shfl(ti0, (bc >> 4) & 15), i2 = __shfl(ti1, bc & 15);
        const float smax = __shfl(bs, 0);
        float e = lane < 16 ? __expf(bs - smax) : 0.f;
        float sum = e;
#pragma unroll
        for (int o = 8; o > 0; o >>= 1) sum += __shfl_xor(sum, o);
        if (lane < 16) {
            p.IDS[(size_t)tk * 128 + h * 16 + lane] = i1 * 128 + i2;
            p.GW[(size_t)tk * 128 + h * 16 + lane] = e / sum;
        }
    }
}

__device__ __forceinline__ void phase_peer_experts(const Params& p, int layer, const float* gnext, int mode) {
    const int lane = tidx_() & 63, wv = bidx_() * 4 + widx_(), nwv = gridDim.x * 4;
    const h16* U = p.U16 + (size_t)layer * 16384 * 1024; const h16* V = p.V16 + (size_t)layer * 16384 * 1024;
    for (int tk = wv; tk < TOK; tk += nwv) {
        const half8 x0 = *(const half8*)(p.HN + (size_t)tk * DM + lane * 8), x1 = *(const half8*)(p.HN + (size_t)tk * DM + 512 + lane * 8);
        const int id0 = p.IDS[(size_t)tk * 128 + lane], id1 = p.IDS[(size_t)tk * 128 + 64 + lane];
        const float g0 = p.GW[(size_t)tk * 128 + lane], g1 = p.GW[(size_t)tk * 128 + 64 + lane];
        float acc[16];
#pragma unroll
        for (int i = 0; i < 16; ++i) acc[i] = 0.f;
#pragma unroll 4
        for (int e = 0; e < 128; ++e) {
            const int id = __builtin_amdgcn_readlane(e < 64 ? id0 : id1, e & 63);
            const float gw = __builtin_bit_cast(float, __builtin_amdgcn_readlane(__builtin_bit_cast(int, e < 64 ? g0 : g1), e & 63));
            const h16* up = U + (size_t)id * 1024 + lane * 8; const h16* vp = V + (size_t)id * 1024 + lane * 8;
            const half8 u0 = *(const half8*)up, u1 = *(const half8*)(up + 512);
            const half8 v0 = *(const half8*)vp, v1 = *(const half8*)(vp + 512);
            float d = 0.f;
#pragma unroll
            for (int i = 0; i < 4; ++i) {
                half2v a; a[0] = x0[2 * i]; a[1] = x0[2 * i + 1]; half2v b; b[0] = u0[2 * i]; b[1] = u0[2 * i + 1];
                d = __builtin_amdgcn_fdot2(a, b, d, false);
                half2v a2; a2[0] = x1[2 * i]; a2[1] = x1[2 * i + 1]; half2v b2; b2[0] = u1[2 * i]; b2[1] = u1[2 * i + 1];
                d = __builtin_amdgcn_fdot2(a2, b2, d, false);
            }
            d = wave_sum(d);
            const float w = gw * gelu_exact(d);
#pragma unroll
            for (int i = 0; i < 8; ++i) { acc[i] += w * (float)v0[i]; acc[8 + i] += w * (float)v1[i]; }
        }
        float hv[16]; load_row16(p.H + (size_t)tk * DM, hv, lane);
#pragma unroll
        for (int i = 0; i < 16; ++i) hv[i] += acc[i];
        if (mode == 0) {
#pragma unroll
            for (int hseg = 0; hseg < 2; ++hseg) {
                float* dst = p.H + (size_t)tk * DM + hseg * 512 + lane * 8;
                *(f32x4*)dst = (f32x4){hv[hseg * 8], hv[hseg * 8 + 1], hv[hseg * 8 + 2], hv[hseg * 8 + 3]};
                *(f32x4*)(dst + 4) = (f32x4){hv[hseg * 8 + 4], hv[hseg * 8 + 5], hv[hseg * 8 + 6], hv[hseg * 8 + 7]};
            }
            rms_write_h16(hv, gnext, p.HN + (size_t)tk * DM, lane);
        } else {
            float ss = 0.f;
#pragma unroll
            for (int i = 0; i < 16; ++i) ss += hv[i] * hv[i];
            ss = wave_sum(ss);
            const float rstd = rsqrtf(ss * (1.0f / 1024.0f) + 1e-6f);
#pragma unroll
            for (int hseg = 0; hseg < 2; ++hseg) {
                const int c0 = hseg * 512 + lane * 8;
                const f32x4 ga = *(const f32x4*)(p.final_g + c0), gb = *(const f32x4*)(p.final_g + c0 + 4);
                float* dst = p.out + (size_t)tk * DM + c0;
                *(f32x4*)dst = (f32x4){hv[hseg * 8] * rstd * ga[0], hv[hseg * 8 + 1] * rstd * ga[1], hv[hseg * 8 + 2] * rstd * ga[2], hv[hseg * 8 + 3] * rstd * ga[3]};
                *(f32x4*)(dst + 4) = (f32x4){hv[hseg * 8 + 4] * rstd * gb[0], hv[hseg * 8 + 5] * rstd * gb[1], hv[hseg * 8 + 6] * rstd * gb[2], hv[hseg * 8 + 7] * rstd * gb[3]};
            }
        }
    }
}

constexpr int XST = 136;
__device__ __forceinline__ void phase_rnn_gates(const Params& p, char* smem) {
    h16* xcS = (h16*)smem;
    const int tid = tidx_(), lane = tid & 63, wid = widx_();
    for (int u = bidx_(); u < 4 * 64 * 10; u += gridDim.x) {
        const int nb = u % 10, ck = (u / 10) & 63, b = u / 640;
        const int s0 = ck * 64, ch0 = nb * 128;
        {
            const int tt = tid >> 2, cs = (tid & 3) * 32, s = s0 + tt;
#pragma unroll
            for (int c8 = 0; c8 < 4; ++c8) {
                const int ch = ch0 + cs + c8 * 8;
                float accv[8];
#pragma unroll
                for (int i = 0; i < 8; ++i) accv[i] = p.odd_conv_b[ch + i];
#pragma unroll
                for (int j = 0; j < 4; ++j) {
                    const int sp = s - 3 + j;
                    if (sp >= 0) {
                        const half8 xv = *(const half8*)(p.Z2 + (size_t)(b * SEQ + sp) * Z2LD + DRNN + ch);
#pragma unroll
                        for (int i = 0; i < 8; ++i) accv[i] += p.odd_conv_w[j * DRNN + ch + i] * (float)xv[i];
                    }
                }
                half8 o;
#pragma unroll
                for (int i = 0; i < 8; ++i) o[i] = (h16)accv[i];
                *(half8*)(xcS + tt * XST + cs + c8 * 8) = o;
            }
        }
        __syncthreads();
        f32x4 ar[8], ai[8];
#pragma unroll
        for (int e = 0; e < 8; ++e) { ar[e] = (f32x4){0.f, 0.f, 0.f, 0.f}; ai[e] = (f32x4){0.f, 0.f, 0.f, 0.f}; }
        const h16* wr = p.Wr + (size_t)nb * 16384 + (lane & 15) * 128 + (lane >> 4) * 8;
        const h16* wi = p.Wr + (size_t)(10 + nb) * 16384 + (lane & 15) * 128 + (lane >> 4) * 8;
#pragma unroll
        for (int ks = 0; ks < 4; ++ks) {
            const half8 a = *(const half8*)(xcS + (wid * 16 + (lane & 15)) * XST + ks * 32 + (lane >> 4) * 8);
#pragma unroll
            for (int e = 0; e < 8; ++e) {
                const half8 w1 = *(const half8*)(wr + e * 16 * 128 + ks * 32), w2 = *(const half8*)(wi + e * 16 * 128 + ks * 32);
                ar[e] = __builtin_amdgcn_mfma_f32_16x16x32_f16(a, w1, ar[e], 0, 0, 0);
                ai[e] = __builtin_amdgcn_mfma_f32_16x16x32_f16(a, w2, ai[e], 0, 0, 0);
            }
        }
#pragma unroll
        for (int e = 0; e < 8; ++e) {
            const int cl = e * 16 + (lane & 15), ch = ch0 + cl;
            const float bra = p.odd_b_ra[ch], bri = p.odd_b_ri[ch], lam = p.odd_lam[ch];
            const float sp = lam >= 0.f ? log1pf(expf(-lam)) : -lam + log1pf(expf(lam));
#pragma unroll
            for (int j = 0; j < 4; ++j) {
                const int tt = wid * 16 + (lane >> 4) * 4 + j;
                const float r = sigmoidf_(ar[e][j] + bra), ig = sigmoidf_(ai[e][j] + bri);
                const float la = -8.0f * r * sp;
                const float a = expf(la);
                const float xc = (float)xcS[tt * XST + cl];
                const float uu = sqrtf(fmaxf(-expm1f(2.0f * la), 0.f)) * (ig * xc);
                const size_t o = (size_t)(b * SEQ + s0 + tt) * DRNN + ch;
                p.RA[o] = a; p.RU[o] = uu;
            }
        }
        __syncthreads();
    }
}
__device__ __forceinline__ void phase_rnn_scan_a(const Params& p) {
    for (int u = bidx_(); u < 4 * 64 * 5; u += gridDim.x) {
        const int cb = u % 5, ck = (u / 5) & 63, b = u / 320;
        const int ch = cb * 256 + tidx_();
        const size_t base = (size_t)(b * SEQ + ck * 64) * DRNN + ch;
        float h = 0.f, P = 1.f;
#pragma unroll 8
        for (int i = 0; i < 64; ++i) { const float a = p.RA[base + (size_t)i * DRNN], uu = p.RU[base + (size_t)i * DRNN]; h = a * h + uu; P *= a; }
        p.AggP[(size_t)(b * 64 + ck) * DRNN + ch] = P; p.AggH[(size_t)(b * 64 + ck) * DRNN + ch] = h;
    }
}
__device__ __forceinline__ void phase_rnn_scan_b(const Params& p) {
    for (int u = bidx_(); u < 4 * 64 * 5; u += gridDim.x) {
        const int cb = u % 5, ck = (u / 5) & 63, b = u / 320;
        const int ch = cb * 256 + tidx_();
        float h = 0.f;
        for (int c = 0; c < ck; ++c) { const size_t o = (size_t)(b * 64 + c) * DRNN + ch; h = p.AggP[o] * h + p.AggH[o]; }
        const size_t base = (size_t)(b * SEQ + ck * 64) * DRNN + ch;
        h16* zrow = p.Z2 + (size_t)(b * SEQ + ck * 64) * Z2LD;
#pragma unroll 8
        for (int i = 0; i < 64; ++i) {
            const float a = p.RA[base + (size_t)i * DRNN], uu = p.RU[base + (size_t)i * DRNN];
            h = a * h + uu;
            const float gt = (float)zrow[(size_t)i * Z2LD + ch];
            zrow[(size_t)i * Z2LD + DRNN + ch] = (h16)(gelu_exact(gt) * h);
        }
    }
}

__device__ __forceinline__ GemmArgs mk_gemm(const h16* A, int lda, const h16* Bt, int ldb, int M, int N, int K, int ans, int mode, h16* c16, int ldc16, float* c32, int ldc32, const float* resid) {
    GemmArgs g; g.A = A; g.lda = lda; g.Bt = Bt; g.ldb = ldb; g.M = M; g.N = N; g.K = K; g.a_ntile_stride = ans; g.mode = mode; g.c16 = c16; g.ldc16 = ldc16; g.c32 = c32; g.ldc32 = ldc32; g.resid = resid; return g;
}

__device__ __forceinline__ void run_phase(const Params& p, int ph, char* smem) {
    GemmArgs g; bool isg = true;
    switch (ph) {
    case 1: g = mk_gemm(p.HN, DM, p.WtE, DM, TOK, ZLD, DM, 0, EPI_EVEN_IN, nullptr, 0, nullptr, 0, nullptr); break;
    case 4: g = mk_gemm(p.O, DM, p.WtEo, DM, TOK, DM, DM, 0, EPI_F32_RESID, nullptr, 0, p.H, DM, p.x); break;
    case 6: g = mk_gemm(p.HN, DM, p.WtQ, DM, TOK, 2048, DM, 0, EPI_H16, p.QP, 2048, nullptr, 0, nullptr); break;
    case 7: g = mk_gemm(p.QP, 2048, p.Keys, 128, TOK, 2048, 128, 128, EPI_F32, nullptr, 0, p.SC, 2048, nullptr); break;
    case 10: g = mk_gemm(p.HN, DM, p.WtO, DM, TOK, Z2LD, DM, 0, EPI_H16, p.Z2, Z2LD, nullptr, 0, nullptr); break;
    case 14: g = mk_gemm(p.Z2 + DRNN, Z2LD, p.WtOo, DRNN, TOK, DM, DRNN, 0, EPI_F32_RESID, nullptr, 0, p.H, DM, p.H); break;
    case 16: g = mk_gemm(p.HN, DM, p.WtQ + (size_t)2048 * 1024, DM, TOK, 2048, DM, 0, EPI_H16, p.QP, 2048, nullptr, 0, nullptr); break;
    case 17: g = mk_gemm(p.QP, 2048, p.Keys + (size_t)8 * 2 * 128 * 128, 128, TOK, 2048, 128, 128, EPI_F32, nullptr, 0, p.SC, 2048, nullptr); break;
    default: isg = false; g = mk_gemm(nullptr, 0, nullptr, 0, 0, 0, 0, 0, 0, nullptr, 0, nullptr, 0, nullptr); break;
    }
    if (isg) {
        if (ph == 1) phase_gemm<EPI_EVEN_IN, DM, DM, ZLD, DM, ZLD, 0>(p, g, smem);
        else if (ph == 4) phase_gemm<EPI_F32_RESID, DM, DM, DM, DM, DM, 0>(p, g, smem);
        else if (ph == 14) phase_gemm<EPI_F32_RESID, Z2LD, DRNN, DM, DRNN, DM, 0>(p, g, smem);
        else if (ph == 7 || ph == 17) phase_gemm<EPI_F32, 2048, 128, 2048, 128, 2048, 128>(p, g, smem);
        else if (ph == 10) phase_gemm<EPI_H16, DM, DM, Z2LD, DM, Z2LD, 0>(p, g, smem);
        else phase_gemm<EPI_H16, DM, DM, 2048, DM, 2048, 0>(p, g, smem);
        return;
    }
    if (ph == 0) phase_prep(p, smem);
    else if (ph == 2) phase_cumsum_compress(p);
    else if (ph == 3) phase_attention(p, smem);
    else if (ph == 5 || ph == 15) phase_rmsnorm(p, ph == 5 ? p.ffn_norm_g : p.ffn_norm_g + DM);
    else if (ph == 8 || ph == 18) phase_peer_topk(p);
    else if (ph == 9 || ph == 19) phase_peer_experts(p, ph == 19 ? 1 : 0, ph == 19 ? p.final_g : p.odd_norm_g, ph == 19 ? 1 : 0);
    else if (ph == 11) phase_rnn_gates(p, smem);
    else if (ph == 12) phase_rnn_scan_a(p);
    else if (ph == 13) phase_rnn_scan_b(p);
}

__global__ void __launch_bounds__(NTHR, 2) mega(Params p) {
    __shared__ __attribute__((aligned(16))) char smem[46080];
    const int ph0 = (int)p.ph0, ph1 = (int)p.ph1;
    for (int ph = ph0; ph < ph1; ++ph) {
        run_phase(p, ph, smem);
        if (ph + 1 < ph1) cg::this_grid().sync();
    }
}

extern "C" void kernel_launch(void* const* d_in, const int* in_sizes, int n_in, void* d_out, int out_size, void* d_ws, size_t ws_size, hipStream_t stream) {
    Params p; memset(&p, 0, sizeof(p));
    const float* const* in = (const float* const*)d_in;
    p.x = in[0]; p.even_norm_g = in[1]; p.even_w_in = in[2]; p.even_b_f = in[3]; p.even_cmp_pos = in[4]; p.even_w_cmp_k = in[5]; p.even_w_cmp_v = in[6]; p.even_w_out = in[7];
    p.odd_norm_g = in[8]; p.odd_w_in = in[9]; p.odd_conv_w = in[10]; p.odd_conv_b = in[11]; p.odd_w_ra = in[12]; p.odd_b_ra = in[13]; p.odd_w_ri = in[14]; p.odd_b_ri = in[15];
    p.odd_lam = in[16]; p.odd_w_out = in[17]; p.ffn_norm_g = in[18]; p.peer_w_q = in[19]; p.peer_sub_keys = in[20]; p.peer_u = in[21]; p.peer_v = in[22]; p.final_g = in[23];
    p.out = (float*)d_out;
    char* ws = (char*)d_ws; size_t off = 0;
    auto take = [&](size_t bytes) { char* r = ws + off; off += (bytes + 255) & ~(size_t)255; return r; };
    p.WtE = (h16*)take((size_t)ZLD * 1024 * 2); p.WtEo = (h16*)take((size_t)1024 * 1024 * 2); p.WtO = (h16*)take((size_t)2560 * 1024 * 2); p.WtOo = (h16*)take((size_t)1024 * 1280 * 2);
    p.WtQ = (h16*)take((size_t)2 * 2048 * 1024 * 2); p.Wc = (h16*)take((size_t)2 * 64 * 2048 * 2); p.Wr = (h16*)take((size_t)20 * 16384 * 2); p.Keys = (h16*)take((size_t)2 * 8 * 2 * 128 * 128 * 2);
    p.Pos16 = (h16*)take(4096); p.U16 = (h16*)take((size_t)2 * 16384 * 1024 * 2); p.V16 = (h16*)take((size_t)2 * 16384 * 1024 * 2);
    p.H = (float*)take((size_t)TOK * DM * 4); p.HN = (h16*)take((size_t)TOK * DM * 2);
    const size_t scratch0 = off;
    p.Z = (h16*)take((size_t)TOK * ZLD * 2); p.VtF = (h16*)take((size_t)4 * 8 * 64 * SEQ * 2); p.VtS = (h16*)take((size_t)4 * 2 * 64 * SEQ * 2); p.VtW = (h16*)take((size_t)4 * 2 * 64 * SEQ * 2);
    p.KC = (h16*)take((size_t)8 * 256 * 64 * 2); p.VCt = (h16*)take((size_t)8 * 64 * 256 * 2); p.O = (h16*)take((size_t)TOK * DM * 2); p.FG = (float*)take((size_t)TOK * 32 * 4); p.C2 = (float*)take((size_t)32 * SEQ * 4); p.OACC = (float*)take((size_t)TOK * 512 * 4);
    size_t mx = off;
    off = scratch0;
    p.QP = (h16*)take((size_t)TOK * 2048 * 2); p.SC = (float*)take((size_t)TOK * 2048 * 4); p.IDS = (int*)take((size_t)TOK * 128 * 4); p.GW = (float*)take((size_t)TOK * 128 * 4);
    if (off > mx) mx = off;
    off = scratch0;
    p.Z2 = (h16*)take((size_t)TOK * Z2LD * 2); p.RA = (float*)take((size_t)TOK * DRNN * 4); p.RU = (float*)take((size_t)TOK * DRNN * 4);
    p.AggP = (float*)take((size_t)4 * 64 * DRNN * 4); p.AggH = (float*)take((size_t)4 * 64 * DRNN * 4);
    if (off > mx) mx = off;
    if (mx > ws_size) { fprintf(stderr, "workspace too small: need %zu have %zu\n", mx, ws_size); return; }

    static int grid_blocks = 0;
    if (!grid_blocks) {
        int dev = 0, cus = 0, per_cu = 0;
        hipGetDevice(&dev);
        hipDeviceGetAttribute(&cus, hipDeviceAttributeMultiprocessorCount, dev);
        hipOccupancyMaxActiveBlocksPerMultiprocessor(&per_cu, mega, NTHR, 0);
        if (per_cu > 2) per_cu = 2;
        if (per_cu < 1) per_cu = 1;
        grid_blocks = cus * per_cu;
    }
#if SINGLE_LAUNCH
    p.ph0 = 0; p.ph1 = NPHASE;
    void* args[] = {&p};
    hipError_t e = hipLaunchCooperativeKernel((void*)mega, dim3(grid_blocks), dim3(NTHR), args, 0, stream);
    if (e != hipSuccess) fprintf(stderr, "cooperative launch failed: %s (grid %d)\n", hipGetErrorString(e), grid_blocks);
#else
    for (int ph = 0; ph < NPHASE; ++ph) {
        p.ph0 = ph; p.ph1 = ph + 1;
        hipLaunchKernelGGL(mega, dim3(grid_blocks), dim3(NTHR), 0, stream, p);
    }
#endif
}
```

```cpp
#include <hip/hip_runtime.h>
#include <hip/hip_cooperative_groups.h>
#include <cstdio>
#include <cstdint>
#include <cstring>
namespace cg = cooperative_groups;

#ifndef SINGLE_LAUNCH
#define SINGLE_LAUNCH 1
#endif

typedef _Float16 h16;
typedef _Float16 half8 __attribute__((ext_vector_type(8)));
typedef _Float16 half4 __attribute__((ext_vector_type(4)));
typedef _Float16 half2v __attribute__((ext_vector_type(2)));
typedef float f32x4 __attribute__((ext_vector_type(4)));
typedef float f32x16 __attribute__((ext_vector_type(16)));
typedef unsigned long long u64;

#define NTHR 256
constexpr int BATCH = 4, SEQ = 4096, DM = 1024, TOK = BATCH * SEQ;
constexpr int ZLD = 2944, Z2LD = 2560, DRNN = 1280;
constexpr int EVEN_IN = 2848;
constexpr float LOG2E = 1.4426950408889634f;
constexpr float QSCALE = 0.125f * LOG2E;
constexpr float NEGBIG = -1.0e30f;
constexpr int KST = 72;
constexpr int NPHASE = 20;

struct Params {
    const float *x, *even_norm_g, *even_w_in, *even_b_f, *even_cmp_pos, *even_w_cmp_k, *even_w_cmp_v, *even_w_out;
    const float *odd_norm_g, *odd_w_in, *odd_conv_w, *odd_conv_b, *odd_w_ra, *odd_b_ra, *odd_w_ri, *odd_b_ri, *odd_lam, *odd_w_out;
    const float *ffn_norm_g, *peer_w_q, *peer_sub_keys, *peer_u, *peer_v, *final_g;
    float* out;
    h16 *WtE, *WtEo, *WtO, *WtOo, *WtQ, *Wc, *Wr, *Keys, *Pos16, *U16, *V16;
    float* H; h16* HN;
    h16 *Z, *VtF, *VtS, *VtW, *KC, *VCt, *O; float *FG, *C2, *OACC;
    h16* QP; float* SC; int* IDS; float* GW;
    h16* Z2; float *RA, *RU, *AggP, *AggH;
    long long ph0, ph1;
};

__device__ __forceinline__ int tidx_() { int t = threadIdx.x; asm volatile("" : "+v"(t)); return t; }
__device__ __forceinline__ int bidx_() { int b = blockIdx.x; asm volatile("" : "+s"(b)); return b; }
__device__ __forceinline__ int widx_() { return __builtin_amdgcn_readfirstlane(tidx_() >> 6); }

__device__ __forceinline__ float wave_sum(float v) {
#pragma unroll
    for (int o = 32; o > 0; o >>= 1) v += __shfl_xor(v, o);
    return v;
}
__device__ __forceinline__ float gelu_exact(float v) { return 0.5f * v * (1.0f + erff(v * 0.70710678118654752f)); }
__device__ __forceinline__ float sigmoidf_(float v) { return 1.0f / (1.0f + __expf(-v)); }
__device__ __forceinline__ float log_sigmoid(float v) { return v >= 0.f ? -log1pf(expf(-v)) : v - log1pf(expf(v)); }
__device__ __forceinline__ int crow(int r, int hi) { return (r & 3) + 8 * (r >> 2) + 4 * hi; }
__device__ __forceinline__ f32x16 zero16() { f32x16 z;
#pragma unroll
    for (int i = 0; i < 16; ++i) z[i] = 0.f; return z; }

__device__ __forceinline__ void rms_write_h16(const float (&v)[16], const float* __restrict__ g, h16* __restrict__ dst, int lane) {
    float ss = 0.f;
#pragma unroll
    for (int i = 0; i < 16; ++i) ss += v[i] * v[i];
    ss = wave_sum(ss);
    const float rstd = rsqrtf(ss * (1.0f / 1024.0f) + 1e-6f);
#pragma unroll
    for (int hseg = 0; hseg < 2; ++hseg) {
        const int c0 = hseg * 512 + lane * 8;
        const f32x4 g0 = *(const f32x4*)(g + c0), g1 = *(const f32x4*)(g + c0 + 4);
        half8 o;
#pragma unroll
        for (int i = 0; i < 4; ++i) { o[i] = (h16)(v[hseg * 8 + i] * rstd * g0[i]); o[4 + i] = (h16)(v[hseg * 8 + 4 + i] * rstd * g1[i]); }
        *(half8*)(dst + c0) = o;
    }
}
__device__ __forceinline__ void load_row16(const float* __restrict__ src, float (&v)[16], int lane) {
#pragma unroll
    for (int hseg = 0; hseg < 2; ++hseg) {
        const int c0 = hseg * 512 + lane * 8;
        const f32x4 a = *(const f32x4*)(src + c0), b = *(const f32x4*)(src + c0 + 4);
#pragma unroll
        for (int i = 0; i < 4; ++i) { v[hseg * 8 + i] = a[i]; v[hseg * 8 + 4 + i] = b[i]; }
    }
}

__device__ __forceinline__ int even_col_map(int n) {
    if (n < 1536) return n;
    if (n < 2048) return 1544 + (n - 1536);
    if (n < 2816) return 2056 + (n - 2048);
    if (n < 2824) return 1536 + (n - 2816);
    if (n < 2848) return n;
    return -1;
}
__device__ __forceinline__ void transpose_job(const float* __restrict__ src, int K, int N, h16* __restrict__ dst, int Ndst, bool mapped, float* tileS, int& base) {
    const int tid = tidx_(), nb = gridDim.x, bid = bidx_();
    const int nkt = K / 64, nnt = Ndst / 64, ntiles = nkt * nnt;
    int first = (bid - (base % nb) + nb) % nb;
    for (int tile = first; tile < ntiles; tile += nb) {
        const int k0 = (tile % nkt) * 64, n0 = (tile / nkt) * 64;
#pragma unroll
        for (int i = 0; i < 16; ++i) {
            const int e = tid + 256 * i, kk = e >> 6, nn = e & 63;
            const int sc = mapped ? even_col_map(n0 + nn) : (n0 + nn);
            tileS[kk * 65 + nn] = (sc >= 0) ? src[(size_t)(k0 + kk) * N + sc] : 0.f;
        }
        __syncthreads();
        const int n = tid >> 2, ks = (tid & 3) * 16;
        half8 o0, o1;
#pragma unroll
        for (int i = 0; i < 8; ++i) { o0[i] = (h16)tileS[(ks + i) * 65 + n]; o1[i] = (h16)tileS[(ks + 8 + i) * 65 + n]; }
        h16* d = dst + (size_t)(n0 + n) * K + k0 + ks;
        *(half8*)d = o0; *(half8*)(d + 8) = o1;
        __syncthreads();
    }
    base += ntiles;
}
__device__ __forceinline__ void convert_job(const float* __restrict__ src, h16* __restrict__ dst, size_t n) {
    const size_t n4 = n / 4, stride = (size_t)gridDim.x * NTHR;
    for (size_t i = (size_t)bidx_() * NTHR + tidx_(); i < n4; i += stride) {
        const f32x4 v = *(const f32x4*)(src + 4 * i);
        half4 o; o[0] = (h16)v[0]; o[1] = (h16)v[1]; o[2] = (h16)v[2]; o[3] = (h16)v[3];
        *(half4*)(dst + 4 * i) = o;
    }
}
__device__ __forceinline__ void phase_prep(const Params& p, char* smem) {
    float* tileS = (float*)smem;
    int base = 0;
    for (int job = 0; job < 28; ++job) {
        const float* src; int K, N, Nd; h16* dst; bool mapped = false;
        if (job == 0) { src = p.even_w_in; K = 1024; N = EVEN_IN; dst = p.WtE; Nd = ZLD; mapped = true; }
        else if (job == 1) { src = p.even_w_out; K = 1024; N = 1024; dst = p.WtEo; Nd = 1024; }
        else if (job == 2) { src = p.odd_w_in; K = 1024; N = 2560; dst = p.WtO; Nd = 2560; }
        else if (job == 3) { src = p.odd_w_out; K = 1280; N = 1024; dst = p.WtOo; Nd = 1024; }
        else if (job < 6) { const int l = job - 4; src = p.peer_w_q + (size_t)l * 1024 * 2048; K = 1024; N = 2048; dst = p.WtQ + (size_t)l * 2048 * 1024; Nd = 2048; }
        else if (job == 6) { src = p.even_w_cmp_k; K = 2048; N = 64; dst = p.Wc; Nd = 64; }
        else if (job == 7) { src = p.even_w_cmp_v; K = 2048; N = 64; dst = p.Wc + 64 * 2048; Nd = 64; }
        else if (job < 18) { const int n = job - 8; src = p.odd_w_ra + n * 16384; K = 128; N = 128; dst = p.Wr + n * 16384; Nd = 128; }
        else { const int n = job - 18; src = p.odd_w_ri + n * 16384; K = 128; N = 128; dst = p.Wr + (10 + n) * 16384; Nd = 128; }
        transpose_job(src, K, N, dst, Nd, mapped, tileS, base);
    }
    convert_job(p.peer_sub_keys, p.Keys, (size_t)2 * 8 * 2 * 128 * 128);
    convert_job(p.even_cmp_pos, p.Pos16, 2048);
    convert_job(p.peer_u, p.U16, (size_t)2 * 16384 * 1024);
    convert_job(p.peer_v, p.V16, (size_t)2 * 16384 * 1024);
    const int lane = tidx_() & 63, wv = bidx_() * 4 + widx_(), nwv = gridDim.x * 4;
    for (int row = wv; row < TOK; row += nwv) {
        float v[16]; load_row16(p.x + (size_t)row * DM, v, lane);
        rms_write_h16(v, p.even_norm_g, p.HN + (size_t)row * DM, lane);
    }
}

enum { EPI_EVEN_IN = 0, EPI_F32_RESID = 1, EPI_H16 = 2, EPI_F32 = 3 };
struct GemmArgs {
    const h16* A; int lda; const h16* Bt; int ldb; int M, N, K; int a_ntile_stride;
    int mode; h16* c16; int ldc16; float* c32; int ldc32; const float* resid;
};
constexpr int GST = 40;

template <int MODE, int LDC>
__device__ __forceinline__ void gemm_epilogue(const Params& p, const GemmArgs& g, int mt, int nt, const f32x4 (&acc)[4][4]) {
    const int lane = tidx_() & 63, wid = widx_(), wm = wid >> 1, wn = wid & 1;
    const int rbase = mt * 128 + wm * 64 + (lane >> 4) * 4, cbase = nt * 128 + wn * 64 + (lane & 15);
    if (MODE == EPI_EVEN_IN) {
        int kind;
        if (nt < 4 || (nt >= 12 && nt < 16)) kind = 0; else if (nt >= 8 && nt < 12) kind = 2; else if (nt == 19) kind = 3; else if (nt == 21) kind = 4; else if (nt == 22) kind = 5; else kind = 1;
#pragma unroll
        for (int m = 0; m < 4; ++m)
#pragma unroll
            for (int n = 0; n < 4; ++n) {
                const int row = rbase + m * 16, col = cbase + n * 16;
                const f32x4 v = acc[m][n];
                if (kind <= 1) {
                    const float sc = kind == 0 ? QSCALE : 1.0f;
#pragma unroll
                    for (int j = 0; j < 4; ++j) p.Z[(size_t)(row + j) * ZLD + col] = (h16)(v[j] * sc);
                } else if (kind <= 4) {
                    const int b = row >> 12, s = row & 4095;
                    half4 o; o[0] = (h16)v[0]; o[1] = (h16)v[1]; o[2] = (h16)v[2]; o[3] = (h16)v[3];
                    h16* dst;
                    if (kind == 2) { const int c = col - 1024; dst = p.VtF + ((size_t)(b * 8 + (c >> 6)) * 64 + (c & 63)) * SEQ + s; }
                    else if (kind == 3) { const int c = col - 2432; dst = p.VtS + ((size_t)(b * 2 + (c >> 6)) * 64 + (c & 63)) * SEQ + s; }
                    else { const int c = col - 2688; dst = p.VtW + ((size_t)(b * 2 + (c >> 6)) * 64 + (c & 63)) * SEQ + s; }
                    *(half4*)dst = o;
                } else {
                    const int c = col - 2816;
                    if (c < 32) {
                        const float bf = c < 8 ? p.even_b_f[c] : 0.f;
#pragma unroll
                        for (int j = 0; j < 4; ++j) p.FG[(size_t)(row + j) * 32 + c] = c < 8 ? log_sigmoid(v[j] + bf) * LOG2E : sigmoidf_(v[j]);
                    }
                }
            }
    } else {
#pragma unroll
        for (int m = 0; m < 4; ++m)
#pragma unroll
            for (int n = 0; n < 4; ++n) {
                const int row = rbase + m * 16, col = cbase + n * 16;
                const f32x4 v = acc[m][n];
#pragma unroll
                for (int j = 0; j < 4; ++j) {
                    if (MODE == EPI_F32_RESID) g.c32[(size_t)(row + j) * LDC + col] = g.resid[(size_t)(row + j) * LDC + col] + v[j];
                    else if (MODE == EPI_H16) g.c16[(size_t)(row + j) * LDC + col] = (h16)v[j];
                    else g.c32[(size_t)(row + j) * LDC + col] = v[j];
                }
            }
    }
}

template <int MODE, int LDA, int LDB, int GN, int GK, int LDC, int ANS>
__device__ __forceinline__ void phase_gemm(const Params& p, const GemmArgs& g, char* smem) {
    h16* As = (h16*)smem;
    h16* Bs = As + 2 * 128 * GST;
    const int tid = tidx_(), lane = tid & 63, wid = widx_(), wm = wid >> 1, wn = wid & 1;
    constexpr int nM = TOK / 128, nN = GN / 128, ntiles = nM * nN, nk = GK / 32;
    const int lr = tid >> 2, lc = (tid & 3) * 8;
    for (int tile = bidx_(); tile < ntiles; tile += gridDim.x) {
        const int mt = tile / nN, nt = tile % nN;
        const h16* Ag = g.A + (size_t)(mt * 128 + lr) * LDA + (size_t)nt * ANS + lc;
        const h16* Bg = g.Bt + (size_t)(nt * 128 + lr) * LDB + lc;
        constexpr size_t a64 = (size_t)64 * LDA, b64 = (size_t)64 * LDB;
        f32x4 acc[4][4];
#pragma unroll
        for (int m = 0; m < 4; ++m)
#pragma unroll
            for (int n = 0; n < 4; ++n) acc[m][n] = (f32x4){0.f, 0.f, 0.f, 0.f};
        half8 ra0 = *(const half8*)Ag, ra1 = *(const half8*)(Ag + a64), rb0 = *(const half8*)Bg, rb1 = *(const half8*)(Bg + b64);
        *(half8*)(As + lr * GST + lc) = ra0; *(half8*)(As + (lr + 64) * GST + lc) = ra1;
        *(half8*)(Bs + lr * GST + lc) = rb0; *(half8*)(Bs + (lr + 64) * GST + lc) = rb1;
        __syncthreads();
        for (int kt = 0; kt < nk; ++kt) {
            const int cur = kt & 1;
            if (kt + 1 < nk) {
                const int ko = (kt + 1) * 32;
                ra0 = *(const half8*)(Ag + ko); ra1 = *(const half8*)(Ag + a64 + ko); rb0 = *(const half8*)(Bg + ko); rb1 = *(const half8*)(Bg + b64 + ko);
            }
            const h16* Ac = As + cur * 128 * GST + (wm * 64 + (lane & 15)) * GST + (lane >> 4) * 8;
            const h16* Bc = Bs + cur * 128 * GST + (wn * 64 + (lane & 15)) * GST + (lane >> 4) * 8;
            half8 af[4], bf[4];
#pragma unroll
            for (int m = 0; m < 4; ++m) af[m] = *(const half8*)(Ac + m * 16 * GST);
#pragma unroll
            for (int n = 0; n < 4; ++n) bf[n] = *(const half8*)(Bc + n * 16 * GST);
#pragma unroll
            for (int m = 0; m < 4; ++m)
#pragma unroll
                for (int n = 0; n < 4; ++n) acc[m][n] = __builtin_amdgcn_mfma_f32_16x16x32_f16(af[m], bf[n], acc[m][n], 0, 0, 0);
            if (kt + 1 < nk) {
                const int nx = cur ^ 1;
                *(half8*)(As + nx * 128 * GST + lr * GST + lc) = ra0; *(half8*)(As + nx * 128 * GST + (lr + 64) * GST + lc) = ra1;
                *(half8*)(Bs + nx * 128 * GST + lr * GST + lc) = rb0; *(half8*)(Bs + nx * 128 * GST + (lr + 64) * GST + lc) = rb1;
            }
            __syncthreads();
        }
        gemm_epilogue<MODE, LDC>(p, g, mt, nt, acc);
    }
}

__device__ __forceinline__ void phase_cumsum_compress(const Params& p) {
    const int lane = tidx_() & 63, wv = bidx_() * 4 + widx_(), nwv = gridDim.x * 4;
    for (int u = wv; u < 32 + 256; u += nwv) {
        if (u < 32) {
            const int b = u >> 3, h = u & 7;
            const float* src = p.FG + (size_t)(b * SEQ + lane * 64) * 32 + h;
            float loc[64]; float run = 0.f;
#pragma unroll
            for (int i = 0; i < 64; ++i) { run += src[(size_t)i * 32]; loc[i] = run; }
            float incl = run;
#pragma unroll
            for (int o = 1; o < 64; o <<= 1) { const float t = __shfl_up(incl, o); if (lane >= o) incl += t; }
            const float excl = incl - run;
            float* dst = p.C2 + (size_t)(b * 8 + h) * SEQ + lane * 64;
#pragma unroll
            for (int i = 0; i < 64; ++i) dst[i] = excl + loc[i];
        } else {
            const int cu = u - 32, kv = cu >> 7, bg = (cu >> 4) & 7, nt = cu & 15;
            const int b = bg >> 1, g = bg & 1;
            int n = nt * 16 + (lane & 15); const int nc = n < 255 ? n : 254;
            const h16* Ab = p.Z + (size_t)(b * SEQ + 16 * nc) * ZLD + 2048 + kv * 128 + g * 64 + (lane >> 4) * 8;
            const h16* Wb = p.Wc + (size_t)kv * 64 * 2048 + (size_t)(lane & 15) * 2048 + (lane >> 4) * 8;
            const h16* Pb = p.Pos16 + (lane >> 4) * 8;
            f32x4 acc[4];
#pragma unroll
            for (int e = 0; e < 4; ++e) acc[e] = (f32x4){0.f, 0.f, 0.f, 0.f};
#pragma unroll 4
            for (int ks = 0; ks < 64; ++ks) {
                const int l = ks >> 1, d0 = (ks & 1) * 32;
                half8 a = *(const half8*)(Ab + (size_t)l * ZLD + d0);
                const half8 ps = *(const half8*)(Pb + ks * 32);
                a = a + ps;
#pragma unroll
                for (int e = 0; e < 4; ++e) {
                    const half8 w = *(const half8*)(Wb + (size_t)e * 16 * 2048 + ks * 32);
                    acc[e] = __builtin_amdgcn_mfma_f32_16x16x32_f16(a, w, acc[e], 0, 0, 0);
                }
            }
            const int n0 = nt * 16 + (lane >> 4) * 4;
#pragma unroll
            for (int e = 0; e < 4; ++e) {
                const int ec = e * 16 + (lane & 15);
                if (kv == 0) {
#pragma unroll
                    for (int j = 0; j < 4; ++j) p.KC[((size_t)bg * 256 + n0 + j) * 64 + ec] = (n0 + j < 255) ? (h16)acc[e][j] : (h16)0.f;
                } else {
                    half4 o;
#pragma unroll
                    for (int j = 0; j < 4; ++j) o[j] = (n0 + j < 255) ? (h16)acc[e][j] : (h16)0.f;
                    *(half4*)(p.VCt + ((size_t)bg * 64 + ec) * 256 + n0) = o;
                }
            }
        }
    }
}

struct RowState { float m, l; f32x16 o0, o1; };
__device__ __forceinline__ void rs_reset(RowState& s) { s.m = NEGBIG; s.l = 0.f; s.o0 = zero16(); s.o1 = zero16(); }

__device__ __forceinline__ void kv_load(const h16* kb, int kst, const h16* vb, int vst, half8 (&kr)[2], half8 (&vr)[2]) {
    const int tid = tidx_();
#pragma unroll
    for (int i = 0; i < 2; ++i) {
        const int c = tid + 256 * i, row = c >> 3, cc = (c & 7) * 8;
        kr[i] = *(const half8*)(kb + (size_t)row * kst + cc);
        vr[i] = *(const half8*)(vb + (size_t)row * vst + cc);
    }
}
__device__ __forceinline__ void kv_store(h16* Ks, h16* Vs, const half8 (&kr)[2], const half8 (&vr)[2]) {
    const int tid = tidx_();
#pragma unroll
    for (int i = 0; i < 2; ++i) {
        const int c = tid + 256 * i, row = c >> 3, cc = (c & 7) * 8;
        *(half8*)(Ks + row * KST + cc) = kr[i];
        *(half8*)(Vs + row * KST + cc) = vr[i];
    }
}
__device__ __forceinline__ void qk_tile(const h16* Ks, const half8 (&qf)[4], f32x16 (&s)[2], int lane) {
    const int r32 = lane & 31, hh = lane >> 5;
#pragma unroll
    for (int kt = 0; kt < 2; ++kt) {
        s[kt] = zero16();
#pragma unroll
        for (int ks = 0; ks < 4; ++ks) {
            const half8 kf = *(const half8*)(Ks + (kt * 32 + r32) * KST + ks * 16 + hh * 8);
            s[kt] = __builtin_amdgcn_mfma_f32_32x32x16_f16(kf, qf[ks], s[kt], 0, 0, 0);
        }
    }
}
__device__ __forceinline__ void pv_tile(const h16* Vs, const f32x16 (&pr)[2], f32x16& o0, f32x16& o1, int lane) {
    const int r32 = lane & 31, hh = lane >> 5;
#pragma unroll
    for (int kt = 0; kt < 2; ++kt)
#pragma unroll
        for (int s2 = 0; s2 < 2; ++s2) {
            half8 pf;
#pragma unroll
            for (int j = 0; j < 8; ++j) pf[j] = (h16)pr[kt][8 * s2 + j];
            const int kof = kt * 32 + 16 * s2 + 4 * hh;
            {
                const half4 a = *(const half4*)(Vs + r32 * KST + kof), b = *(const half4*)(Vs + r32 * KST + kof + 8);
                half8 vf; vf[0] = a[0]; vf[1] = a[1]; vf[2] = a[2]; vf[3] = a[3]; vf[4] = b[0]; vf[5] = b[1]; vf[6] = b[2]; vf[7] = b[3];
                o0 = __builtin_amdgcn_mfma_f32_32x32x16_f16(vf, pf, o0, 0, 0, 0);
            }
            {
                const half4 a = *(const half4*)(Vs + (32 + r32) * KST + kof), b = *(const half4*)(Vs + (32 + r32) * KST + kof + 8);
                half8 vf; vf[0] = a[0]; vf[1] = a[1]; vf[2] = a[2]; vf[3] = a[3]; vf[4] = b[0]; vf[5] = b[1]; vf[6] = b[2]; vf[7] = b[3];
                o1 = __builtin_amdgcn_mfma_f32_32x32x16_f16(vf, pf, o1, 0, 0, 0);
            }
        }
}

enum { M_FOX = 0, M_SLC = 1, M_WIN = 2 };
template <int MODE>
__device__ __forceinline__ void flash_step(const h16* Ks, const h16* Vs, const float* csS, const half8 (&qf)[4], RowState& st,
                                           int t, int kpos0, float slope2, float ct2, bool selbit, int lane) {
    const int hh = lane >> 5;
    f32x16 s[2];
    qk_tile(Ks, qf, s, lane);
    float mx = NEGBIG;
    int dbase = t - kpos0 - 4 * hh;
    asm volatile("" : "+v"(dbase));
#pragma unroll
    for (int kt = 0; kt < 2; ++kt)
#pragma unroll
        for (int r = 0; r < 16; ++r) {
            const int kl = kt * 32 + crow(r, hh);
            const int dist = dbase - (kt * 32 + (r & 3) + 8 * (r >> 2));
            bool valid; float v;
            if (MODE == M_FOX) { valid = dist >= 0; v = s[kt][r] + ct2 - csS[kl]; }
            else if (MODE == M_SLC) { valid = selbit && dist >= 0; v = s[kt][r] - slope2 * (float)dist; }
            else { valid = dist >= 0 && dist < 512; v = s[kt][r] - slope2 * (float)dist; }
            v = valid ? v : NEGBIG;
            s[kt][r] = v;
            mx = fmaxf(mx, v);
        }
    mx = fmaxf(mx, __shfl_xor(mx, 32));
    const float mn = fmaxf(st.m, mx);
    const float alpha = __builtin_amdgcn_exp2f(st.m - mn);
    st.m = mn;
    float ps = 0.f;
#pragma unroll
    for (int kt = 0; kt < 2; ++kt)
#pragma unroll
        for (int r = 0; r < 16; ++r) {
            const float v = s[kt][r];
            const float pe = v > -1.0e29f ? __builtin_amdgcn_exp2f(v - mn) : 0.f;
            s[kt][r] = pe; ps += pe;
        }
    st.l = st.l * alpha + ps;
#pragma unroll
    for (int r = 0; r < 16; ++r) { st.o0[r] *= alpha; st.o1[r] *= alpha; }
    pv_tile(Vs, s, st.o0, st.o1, lane);
}

template <int MODE>
__device__ __forceinline__ void run_flash(u64 mask, const h16* Kg, int kst, const h16* Vg, int vst, const float* csg, char* smem,
                                          const half8 (&qf)[4], RowState& st, int t, int twlo, int twhi, float slope2, float ct2, u64 sel, int lane) {
    h16* Kb = (h16*)smem; h16* Vb = Kb + 2 * 64 * KST; float* csb = (float*)(Vb + 2 * 64 * KST);
    if (mask == 0ull) return;
    half8 kr[2], vr[2]; float csr = 0.f;
    int jc = __builtin_ctzll(mask); mask &= mask - 1;
    kv_load(Kg + (size_t)jc * 64 * kst, kst, Vg + jc * 64, vst, kr, vr);
    if (MODE == M_FOX && tidx_() < 64) csr = csg[jc * 64 + tidx_()];
    kv_store(Kb, Vb, kr, vr);
    if (MODE == M_FOX && tidx_() < 64) csb[tidx_()] = csr;
    __syncthreads();
    int buf = 0;
    for (;;) {
        int jn = -1;
        if (mask) { jn = __builtin_ctzll(mask); mask &= mask - 1; }
        if (jn >= 0) {
            kv_load(Kg + (size_t)jn * 64 * kst, kst, Vg + jn * 64, vst, kr, vr);
            if (MODE == M_FOX && tidx_() < 64) csr = csg[jn * 64 + tidx_()];
        }
        bool need = jc * 64 <= twhi;
        if (MODE == M_WIN) need = need && (jc * 64 + 63 >= twlo - 511);
        if (need)
            flash_step<MODE>(Kb + buf * 64 * KST, Vb + buf * 64 * KST, csb + buf * 64, qf, st, t, jc * 64, slope2, ct2, (sel >> jc) & 1ull, lane);
        if (jn >= 0) {
            kv_store(Kb + (buf ^ 1) * 64 * KST, Vb + (buf ^ 1) * 64 * KST, kr, vr);
            if (MODE == M_FOX && tidx_() < 64) csb[(buf ^ 1) * 64 + tidx_()] = csr;
        }
        __syncthreads();
        if (jn < 0) break;
        jc = jn; buf ^= 1;
    }
}

__device__ __forceinline__ void load_q(const h16* qrow, half8 (&qf)[4], int lane) {
#pragma unroll
    for (int ks = 0; ks < 4; ++ks) qf[ks] = *(const half8*)(qrow + ks * 16 + (lane >> 5) * 8);
}
__device__ __forceinline__ void store_o(h16* orow, const f32x16& o0, const f32x16& o1, int lane) {
    const int hh = lane >> 5;
#pragma unroll
    for (int rg = 0; rg < 4; ++rg) {
        half4 a, b;
#pragma unroll
        for (int j = 0; j < 4; ++j) { a[j] = (h16)o0[4 * rg + j]; b[j] = (h16)o1[4 * rg + j]; }
        *(half4*)(orow + 8 * rg + 4 * hh) = a;
        *(half4*)(orow + 32 + 8 * rg + 4 * hh) = b;
    }
}

__device__ __forceinline__ void oacc_store(float* row, const f32x16& o0, const f32x16& o1, float sc, int lane) {
    const int hh = lane >> 5;
#pragma unroll
    for (int rg = 0; rg < 4; ++rg) {
        *(f32x4*)(row + 8 * rg + 4 * hh) = (f32x4){o0[4 * rg] * sc, o0[4 * rg + 1] * sc, o0[4 * rg + 2] * sc, o0[4 * rg + 3] * sc};
        *(f32x4*)(row + 32 + 8 * rg + 4 * hh) = (f32x4){o1[4 * rg] * sc, o1[4 * rg + 1] * sc, o1[4 * rg + 2] * sc, o1[4 * rg + 3] * sc};
    }
}
__device__ __forceinline__ void oacc_add(float* row, const f32x16& o0, const f32x16& o1, float sc, int lane) {
    const int hh = lane >> 5;
#pragma unroll
    for (int rg = 0; rg < 4; ++rg) {
        f32x4 a = *(const f32x4*)(row + 8 * rg + 4 * hh), b = *(const f32x4*)(row + 32 + 8 * rg + 4 * hh);
#pragma unroll
        for (int j = 0; j < 4; ++j) { a[j] += o0[4 * rg + j] * sc; b[j] += o1[4 * rg + j] * sc; }
        *(f32x4*)(row + 8 * rg + 4 * hh) = a; *(f32x4*)(row + 32 + 8 * rg + 4 * hh) = b;
    }
}
__device__ __forceinline__ void oacc_final(const float* row, h16* orow, const f32x16& o0, const f32x16& o1, float sc, int lane) {
    const int hh = lane >> 5;
#pragma unroll
    for (int rg = 0; rg < 4; ++rg) {
        const f32x4 a = *(const f32x4*)(row + 8 * rg + 4 * hh), b = *(const f32x4*)(row + 32 + 8 * rg + 4 * hh);
        half4 x, y;
#pragma unroll
        for (int j = 0; j < 4; ++j) { x[j] = (h16)(a[j] + o0[4 * rg + j] * sc); y[j] = (h16)(b[j] + o1[4 * rg + j] * sc); }
        *(half4*)(orow + 8 * rg + 4 * hh) = x; *(half4*)(orow + 32 + 8 * rg + 4 * hh) = y;
    }
}

__device__ __forceinline__ void fox_unit(const Params& p, int b, int h, int qt, char* smem) {
    const int tid = tidx_(), lane = tid & 63, wid = widx_();
    const int q0 = qt * 128, t0w = q0 + wid * 32, t = t0w + (lane & 31);
    half8 qf[4]; load_q(p.Z + (size_t)(b * SEQ + t) * ZLD + h * 64, qf, lane);
    const float* csg = p.C2 + (size_t)(b * 8 + h) * SEQ;
    const float ct2 = csg[t];
    RowState st; rs_reset(st);
    const int jmax = (q0 + 127) >> 6;
    const u64 mask = (jmax >= 63) ? ~0ull : ((1ull << (jmax + 1)) - 1ull);
    run_flash<M_FOX>(mask, p.Z + (size_t)b * SEQ * ZLD + 512 + h * 64, ZLD, p.VtF + (size_t)(b * 8 + h) * 64 * SEQ, SEQ, csg, smem,
                     qf, st, t, t0w, t0w + 31, 0.f, ct2, 0ull, lane);
    const float lt = st.l + __shfl_xor(st.l, 32);
    const float inv = 1.0f / lt;
#pragma unroll
    for (int r = 0; r < 16; ++r) { st.o0[r] *= inv; st.o1[r] *= inv; }
    store_o(p.O + (size_t)(b * SEQ + t) * DM + h * 64, st.o0, st.o1, lane);
}

__device__ __forceinline__ void nsa_unit(const Params& p, int b, int g, int qt32, char* smem) {
    const int tid = tidx_(), lane = tid & 63, wid = widx_(), hh = lane >> 5, r32 = lane & 31;
    const int t0 = qt32 * 32, t = t0 + r32, head = g * 4 + wid, bg = b * 2 + g;
    const float slope2 = exp2f(-(float)(head + 1)) * LOG2E;
    half8 qf[4]; load_q(p.Z + (size_t)(b * SEQ + t) * ZLD + 1536 + head * 64, qf, lane);
    const float* gp = p.FG + (size_t)(b * SEQ + t) * 32 + 8 + head * 3;
    const float gate_c = gp[0], gate_s = gp[1], gate_w = gp[2];
    h16* Kb = (h16*)smem; h16* Vb = Kb + 2 * 64 * KST;
    u64* selS = (u64*)(smem + 37376);
    u64* unS = selS + 32;
    float* oaccrow = p.OACC + (size_t)(b * SEQ + t) * 512 + head * 64;
    unsigned* impS = (unsigned*)(smem + 37888);
    {
        for (int i = tid; i < 32 * 64; i += NTHR) impS[i] = 0u;
        const int nsteps = ((t0 >> 4) >> 6) + 1;
        const h16* Kg = p.KC + (size_t)bg * 256 * 64; const h16* Vg = p.VCt + (size_t)bg * 64 * 256;
        float mrun = NEGBIG, lrun = 0.f;
        for (int i = 0; i < nsteps; ++i) {
            half8 kr[2], vr[2];
            kv_load(Kg + (size_t)i * 64 * 64, 64, Vg + i * 64, 256, kr, vr);
            kv_store(Kb, Vb, kr, vr);
            __syncthreads();
            f32x16 s[2];
            qk_tile(Kb, qf, s, lane);
            float mx = NEGBIG;
            int dbase = t - 31 - 16 * (i * 64 + 4 * hh);
            asm volatile("" : "+v"(dbase));
#pragma unroll
            for (int kt = 0; kt < 2; ++kt)
#pragma unroll
                for (int r = 0; r < 16; ++r) {
                    const int dist = dbase - 16 * (kt * 32 + (r & 3) + 8 * (r >> 2));
                    float v = s[kt][r] - slope2 * (float)dist;
                    v = dist >= 0 ? v : NEGBIG;
                    s[kt][r] = v; mx = fmaxf(mx, v);
                }
            mx = fmaxf(mx, __shfl_xor(mx, 32));
            const float mn = fmaxf(mrun, mx), alpha = __builtin_amdgcn_exp2f(mrun - mn);
            mrun = mn;
            float ps = 0.f;
#pragma unroll
            for (int kt = 0; kt < 2; ++kt)
#pragma unroll
                for (int r = 0; r < 16; ++r) { const float v = s[kt][r]; ps += v > -1.0e29f ? __builtin_amdgcn_exp2f(v - mn) : 0.f; }
            lrun = lrun * alpha + ps;
            __syncthreads();
        }
        const float lt = lrun + __shfl_xor(lrun, 32);
        const float inv = lt > 0.f ? 1.0f / lt : 0.f;
        f32x16 o0 = zero16(), o1 = zero16();
        float carry = 0.f;
        for (int i = 0; i < nsteps; ++i) {
            half8 kr[2], vr[2];
            kv_load(Kg + (size_t)i * 64 * 64, 64, Vg + i * 64, 256, kr, vr);
            kv_store(Kb, Vb, kr, vr);
            __syncthreads();
            f32x16 s[2];
            qk_tile(Kb, qf, s, lane);
            int dbase = t - 31 - 16 * (i * 64 + 4 * hh);
            asm volatile("" : "+v"(dbase));
#pragma unroll
            for (int kt = 0; kt < 2; ++kt)
#pragma unroll
                for (int r = 0; r < 16; ++r) {
                    const int dist = dbase - 16 * (kt * 32 + (r & 3) + 8 * (r >> 2));
                    const float v = s[kt][r] - slope2 * (float)dist;
                    s[kt][r] = dist >= 0 ? __builtin_amdgcn_exp2f(v - mrun) * inv : 0.f;
                }
            float R[2][4];
#pragma unroll
            for (int kt = 0; kt < 2; ++kt)
#pragma unroll
                for (int rg = 0; rg < 4; ++rg) R[kt][rg] = __shfl_xor(s[kt][4 * rg + 3], 32);
#pragma unroll
            for (int kt = 0; kt < 2; ++kt)
#pragma unroll
                for (int rg = 0; rg < 4; ++rg) {
                    const float G = (s[kt][4 * rg] + s[kt][4 * rg + 1]) + (s[kt][4 * rg + 2] + s[kt][4 * rg + 3]);
                    const float prev = (kt == 0 && rg == 0) ? carry : (rg > 0 ? R[kt][rg - 1] : R[kt - 1][3]);
                    const float val = G + (hh ? R[kt][rg] : prev);
                    const int j = 16 * i + 8 * kt + 2 * rg + hh;
                    atomicAdd(&impS[r32 * 64 + j], (unsigned)(val * 67108864.0f + 0.5f));
                }
            carry = R[1][3];
            pv_tile(Vb, s, o0, o1, lane);
            __syncthreads();
        }
        oacc_store(oaccrow, o0, o1, gate_c, lane);
    }
    __syncthreads();
    {
        u64 un = 0ull;
        for (int i = 0; i < 8; ++i) {
            const int tok = wid * 8 + i, tt = t0 + tok, cur = tt >> 6;
            const int j = lane;
            const bool valid = j <= cur;
            const bool forced = (j == 0) || (j == cur) || (j == cur - 1);
            const unsigned key = valid ? impS[tok * 64 + j] + (forced ? 0x40000000u : 0u) : 0u;
            int rank = 0;
            for (int jj = 0; jj < 64; ++jj) {
                const unsigned kv = (unsigned)__builtin_amdgcn_readlane((int)key, jj);
                rank += (kv > key || (kv == key && jj < j)) ? 1 : 0;
            }
            const u64 selm = __ballot(valid && rank < 16);
            if (lane == 0) selS[tok] = selm;
            un |= selm;
        }
        if (lane == 0) unS[wid] = un;
    }
    __syncthreads();
    const u64 mysel = selS[r32];
    const u64 un = unS[0] | unS[1] | unS[2] | unS[3];
    __syncthreads();
    {
        RowState st; rs_reset(st);
        run_flash<M_SLC>(un, p.Z + (size_t)b * SEQ * ZLD + 2304 + g * 64, ZLD, p.VtS + (size_t)bg * 64 * SEQ, SEQ, nullptr, smem,
                         qf, st, t, t0, t0 + 31, slope2, 0.f, mysel, lane);
        const float lt = st.l + __shfl_xor(st.l, 32);
        oacc_add(oaccrow, st.o0, st.o1, gate_s / lt, lane);
    }
    {
        RowState st; rs_reset(st);
        const int lo = t0 - 511, jlo = lo > 0 ? (lo >> 6) : 0, jhi = (t0 + 31) >> 6;
        u64 mask = (jhi >= 63 ? ~0ull : ((1ull << (jhi + 1)) - 1ull)) & ~((1ull << jlo) - 1ull);
        run_flash<M_WIN>(mask, p.Z + (size_t)b * SEQ * ZLD + 2560 + g * 64, ZLD, p.VtW + (size_t)bg * 64 * SEQ, SEQ, nullptr, smem,
                         qf, st, t, t0, t0 + 31, slope2, 0.f, 0ull, lane);
        const float lt = st.l + __shfl_xor(st.l, 32);
        oacc_final(oaccrow, p.O + (size_t)(b * SEQ + t) * DM + 512 + head * 64, st.o0, st.o1, gate_w / lt, lane);
    }
}

__device__ __forceinline__ void phase_attention(const Params& p, char* smem) {
    for (int u = bidx_(); u < 2048; u += gridDim.x) {
        const int st = 31 - (u >> 6), w = u & 63;
        if (w < 32) fox_unit(p, w >> 3, w & 7, st, smem);
        else { const int idx = w - 32; nsa_unit(p, (idx & 7) >> 1, idx & 1, st * 4 + (idx >> 3), smem); }
        __syncthreads();
    }
}

__device__ __forceinline__ void phase_rmsnorm(const Params& p, const float* g) {
    const int lane = tidx_() & 63, wv = bidx_() * 4 + widx_(), nwv = gridDim.x * 4;
    for (int row = wv; row < TOK; row += nwv) {
        float v[16]; load_row16(p.H + (size_t)row * DM, v, lane);
        rms_write_h16(v, g, p.HN + (size_t)row * DM, lane);
    }
}

__device__ __forceinline__ void top16_of_128(float va, float vb, int lane, float& tv, int& ti) {
    tv = -INFINITY; ti = 0;
    for (int r = 0; r < 16; ++r) {
        float m; int mi;
        if (va >= vb) { m = va; mi = lane; } else { m = vb; mi = lane + 64; }
#pragma unroll
        for (int o = 32; o > 0; o >>= 1) {
            const float om = __shfl_xor(m, o); const int oi = __shfl_xor(mi, o);
            if (om > m || (om == m && oi < mi)) { m = om; mi = oi; }
        }
        if (lane == r) { tv = m; ti = mi; }
        if (mi == lane) va = -INFINITY;
        if (mi == lane + 64) vb = -INFINITY;
    }
}
__device__ __forceinline__ void phase_peer_topk(const Params& p) {
    const int lane = tidx_() & 63, wv = bidx_() * 4 + widx_(), nwv = gridDim.x * 4;
    int ca, cb;
    {
        const int c = lane;
        if (c < 16) { ca = 0; cb = c; } else if (c < 24) { ca = 1; cb = c - 16; } else if (c < 29) { ca = 2; cb = c - 24; } else if (c < 33) { ca = 3; cb = c - 29; }
        else if (c < 36) { ca = 4; cb = c - 33; } else if (c < 38) { ca = 5; cb = c - 36; } else if (c < 40) { ca = 6; cb = c - 38; } else if (c < 42) { ca = 7; cb = c - 40; }
        else { ca = 8 + (c - 42); cb = 0; }
        if (c >= 50) { ca = 0; cb = 0; }
    }
    for (int u = wv; u < TOK * 8; u += nwv) {
        const int tk = u >> 3, h = u & 7;
        const float* sp = p.SC + (size_t)tk * 2048 + h * 256;
        float tv0, tv1; int ti0, ti1;
        top16_of_128(sp[lane], sp[lane + 64], lane, tv0, ti0);
        top16_of_128(sp[128 + lane], sp[192 + lane], lane, tv1, ti1);
        const float sa = __shfl(tv0, ca), sb = __shfl(tv1, cb);
        float cv = lane < 50 ? sa + sb : -INFINITY; const int cidx = ca * 16 + cb;
        float bs = -INFINITY; int bc = 0;
        for (int r = 0; r < 16; ++r) {
            float m = cv; int mi = lane < 50 ? cidx : 1 << 20;
#pragma unroll
            for (int o = 32; o > 0; o >>= 1) {
                const float om = __shfl_xor(m, o); const int oi = __shfl_xor(mi, o);
                if (om > m || (om == m && oi < mi)) { m = om; mi = oi; }
            }
            if (lane == r) { bs = m; bc = mi; }
            if (lane < 50 && mi == cidx) cv = -INFINITY;
        }
        const int i1 = __shfl(ti0, (bc >> 4) & 15), i2 = __shfl(ti1, bc & 15);
        const float smax = __shfl(bs, 0);
        float e = lane < 16 ? __expf(bs - smax) : 0.f;
        float sum = e;
#pragma unroll
        for (int o = 8; o > 0; o >>= 1) sum += __shfl_xor(sum, o);
        if (lane < 16) {
            p.IDS[(size_t)tk * 128 + h * 16 + lane] = i1 * 128 + i2;
            p.GW[(size_t)tk * 128 + h * 16 + lane] = e / sum;
        }
    }
}

__device__ __forceinline__ void phase_peer_experts(const Params& p, int layer, const float* gnext, int mode) {
    const int lane = tidx_() & 63, wv = bidx_() * 4 + widx_(), nwv = gridDim.x * 4;
    const h16* U = p.U16 + (size_t)layer * 16384 * 1024; const h16* V = p.V16 + (size_t)layer * 16384 * 1024;
    for (int tk = wv; tk < TOK; tk += nwv) {
        const half8 x0 = *(const half8*)(p.HN + (size_t)tk * DM + lane * 8), x1 = *(const half8*)(p.HN + (size_t)tk * DM + 512 + lane * 8);
        const int id0 = p.IDS[(size_t)tk * 128 + lane], id1 = p.IDS[(size_t)tk * 128 + 64 + lane];
        const float g0 = p.GW[(size_t)tk * 128 + lane], g1 = p.GW[(size_t)tk * 128 + 64 + lane];
        float acc[16];
#pragma unroll
        for (int i = 0; i < 16; ++i) acc[i] = 0.f;
#pragma unroll 4
        for (int e = 0; e < 128; ++e) {
            const int id = __builtin_amdgcn_readlane(e < 64 ? id0 : id1, e & 63);
            const float gw = __builtin_bit_cast(float, __builtin_amdgcn_readlane(__builtin_bit_cast(int, e < 64 ? g0 : g1), e & 63));
            const h16* up = U + (size_t)id * 1024 + lane * 8; const h16* vp = V + (size_t)id * 1024 + lane * 8;
            const half8 u0 = *(const half8*)up, u1 = *(const half8*)(up + 512);
            const half8 v0 = *(const half8*)vp, v1 = *(const half8*)(vp + 512);
            float d = 0.f;
#pragma unroll
            for (int i = 0; i < 4; ++i) {
                half2v a; a[0] = x0[2 * i]; a[1] = x0[2 * i + 1]; half2v b; b[0] = u0[2 * i]; b[1] = u0[2 * i + 1];
                d = __builtin_amdgcn_fdot2(a, b, d, false);
                half2v a2; a2[0] = x1[2 * i]; a2[1] = x1[2 * i + 1]; half2v b2; b2[0] = u1[2 * i]; b2[1] = u1[2 * i + 1];
                d = __builtin_amdgcn_fdot2(a2, b2, d, false);
            }
            d = wave_sum(d);
            const float w = gw * gelu_exact(d);
#pragma unroll
            for (int i = 0; i < 8; ++i) { acc[i] += w * (float)v0[i]; acc[8 + i] += w * (float)v1[i]; }
        }
        float hv[16]; load_row16(p.H + (size_t)tk * DM, hv, lane);
#pragma unroll
        for (int i = 0; i < 16; ++i) hv[i] += acc[i];
        if (mode == 0) {
#pragma unroll
            for (int hseg = 0; hseg < 2; ++hseg) {
                float* dst = p.H + (size_t)tk * DM + hseg * 512 + lane * 8;
                *(f32x4*)dst = (f32x4){hv[hseg * 8], hv[hseg * 8 + 1], hv[hseg * 8 + 2], hv[hseg * 8 + 3]};
                *(f32x4*)(dst + 4) = (f32x4){hv[hseg * 8 + 4], hv[hseg * 8 + 5], hv[hseg * 8 + 6], hv[hseg * 8 + 7]};
            }
            rms_write_h16(hv, gnext, p.HN + (size_t)tk * DM, lane);
        } else {
            float ss = 0.f;
#pragma unroll
            for (int i = 0; i < 16; ++i) ss += hv[i] * hv[i];
            ss = wave_sum(ss);
            const float rstd = rsqrtf(ss * (1.0f / 1024.0f) + 1e-6f);
#pragma unroll
            for (int hseg = 0; hseg < 2; ++hseg) {
                const int c0 = hseg * 512 + lane * 8;
                const f32x4 ga = *(const f32x4*)(p.final_g + c0), gb = *(const f32x4*)(p.final_g + c0 + 4);
                float* dst = p.out + (size_t)tk * DM + c0;
                *(f32x4*)dst = (f32x4){hv[hseg * 8] * rstd * ga[0], hv[hseg * 8 + 1] * rstd * ga[1], hv[hseg * 8 + 2] * rstd * ga[2], hv[hseg * 8 + 3] * rstd * ga[3]};
                *(f32x4*)(dst + 4) = (f32x4){hv[hseg * 8 + 4] * rstd * gb[0], hv[hseg * 8 + 5] * rstd * gb[1], hv[hseg * 8 + 6] * rstd * gb[2], hv[hseg * 8 + 7] * rstd * gb[3]};
            }
        }
    }
}

constexpr int XST = 136;
__device__ __forceinline__ void phase_rnn_gates(const Params& p, char* smem) {
    h16* xcS = (h16*)smem;
    const int tid = tidx_(), lane = tid & 63, wid = widx_();
    for (int u = bidx_(); u < 4 * 64 * 10; u += gridDim.x) {
        const int nb = u % 10, ck = (u / 10) & 63, b = u / 640;
        const int s0 = ck * 64, ch0 = nb * 128;
        {
            const int tt = tid >> 2, cs = (tid & 3) * 32, s = s0 + tt;
#pragma unroll
            for (int c8 = 0; c8 < 4; ++c8) {
                const int ch = ch0 + cs + c8 * 8;
                float accv[8];
#pragma unroll
                for (int i = 0; i < 8; ++i) accv[i] = p.odd_conv_b[ch + i];
#pragma unroll
                for (int j = 0; j < 4; ++j) {
                    const int sp = s - 3 + j;
                    if (sp >= 0) {
                        const half8 xv = *(const half8*)(p.Z2 + (size_t)(b * SEQ + sp) * Z2LD + DRNN + ch);
#pragma unroll
                        for (int i = 0; i < 8; ++i) accv[i] += p.odd_conv_w[j * DRNN + ch + i] * (float)xv[i];
                    }
                }
                half8 o;
#pragma unroll
                for (int i = 0; i < 8; ++i) o[i] = (h16)accv[i];
                *(half8*)(xcS + tt * XST + cs + c8 * 8) = o;
            }
        }
        __syncthreads();
        f32x4 ar[8], ai[8];
#pragma unroll
        for (int e = 0; e < 8; ++e) { ar[e] = (f32x4){0.f, 0.f, 0.f, 0.f}; ai[e] = (f32x4){0.f, 0.f, 0.f, 0.f}; }
        const h16* wr = p.Wr + (size_t)nb * 16384 + (lane & 15) * 128 + (lane >> 4) * 8;
        const h16* wi = p.Wr + (size_t)(10 + nb) * 16384 + (lane & 15) * 128 + (lane >> 4) * 8;
#pragma unroll
        for (int ks = 0; ks < 4; ++ks) {
            const half8 a = *(const half8*)(xcS + (wid * 16 + (lane & 15)) * XST + ks * 32 + (lane >> 4) * 8);
#pragma unroll
            for (int e = 0; e < 8; ++e) {
                const half8 w1 = *(const half8*)(wr + e * 16 * 128 + ks * 32), w2 = *(const half8*)(wi + e * 16 * 128 + ks * 32);
                ar[e] = __builtin_amdgcn_mfma_f32_16x16x32_f16(a, w1, ar[e], 0, 0, 0);
                ai[e] = __builtin_amdgcn_mfma_f32_16x16x32_f16(a, w2, ai[e], 0, 0, 0);
            }
        }
#pragma unroll
        for (int e = 0; e < 8; ++e) {
            const int cl = e * 16 + (lane & 15), ch = ch0 + cl;
            const float bra = p.odd_b_ra[ch], bri = p.odd_b_ri[ch], lam = p.odd_lam[ch];
            const float sp = lam >= 0.f ? log1pf(expf(-lam)) : -lam + log1pf(expf(lam));
#pragma unroll
            for (int j = 0; j < 4; ++j) {
                const int tt = wid * 16 + (lane >> 4) * 4 + j;
                const float r = sigmoidf_(ar[e][j] + bra), ig = sigmoidf_(ai[e][j] + bri);
                const float la = -8.0f * r * sp;
                const float a = expf(la);
                const float xc = (float)xcS[tt * XST + cl];
                const float uu = sqrtf(fmaxf(-expm1f(2.0f * la), 0.f)) * (ig * xc);
                const size_t o = (size_t)(b * SEQ + s0 + tt) * DRNN + ch;
                p.RA[o] = a; p.RU[o] = uu;
            }
        }
        __syncthreads();
    }
}
__device__ __forceinline__ void phase_rnn_scan_a(const Params& p) {
    for (int u = bidx_(); u < 4 * 64 * 5; u += gridDim.x) {
        const int cb = u % 5, ck = (u / 5) & 63, b = u / 320;
        const int ch = cb * 256 + tidx_();
        const size_t base = (size_t)(b * SEQ + ck * 64) * DRNN + ch;
        float h = 0.f, P = 1.f;
#pragma unroll 8
        for (int i = 0; i < 64; ++i) { const float a = p.RA[base + (size_t)i * DRNN], uu = p.RU[base + (size_t)i * DRNN]; h = a * h + uu; P *= a; }
        p.AggP[(size_t)(b * 64 + ck) * DRNN + ch] = P; p.AggH[(size_t)(b * 64 + ck) * DRNN + ch] = h;
    }
}
__device__ __forceinline__ void phase_rnn_scan_b(const Params& p) {
    for (int u = bidx_(); u < 4 * 64 * 5; u += gridDim.x) {
        const int cb = u % 5, ck = (u / 5) & 63, b = u / 320;
        const int ch = cb * 256 + tidx_();
        float h = 0.f;
        for (int c = 0; c < ck; ++c) { const size_t o = (size_t)(b * 64 + c) * DRNN + ch; h = p.AggP[o] * h + p.AggH[o]; }
        const size_t base = (size_t)(b * SEQ + ck * 64) * DRNN + ch;
        h16* zrow = p.Z2 + (size_t)(b * SEQ + ck * 64) * Z2LD;
#pragma unroll 8
        for (int i = 0; i < 64; ++i) {
            const float a = p.RA[base + (size_t)i * DRNN], uu = p.RU[base + (size_t)i * DRNN];
            h = a * h + uu;
            const float gt = (float)zrow[(size_t)i * Z2LD + ch];
            zrow[(size_t)i * Z2LD + DRNN + ch] = (h16)(gelu_exact(gt) * h);
        }
    }
}

__device__ __forceinline__ GemmArgs mk_gemm(const h16* A, int lda, const h16* Bt, int ldb, int M, int N, int K, int ans, int mode, h16* c16, int ldc16, float* c32, int ldc32, const float* resid) {
    GemmArgs g; g.A = A; g.lda = lda; g.Bt = Bt; g.ldb = ldb; g.M = M; g.N = N; g.K = K; g.a_ntile_stride = ans; g.mode = mode; g.c16 = c16; g.ldc16 = ldc16; g.c32 = c32; g.ldc32 = ldc32; g.resid = resid; return g;
}

__device__ __forceinline__ void run_phase(const Params& p, int ph, char* smem) {
    GemmArgs g; bool isg = true;
    switch (ph) {
    case 1: g = mk_gemm(p.HN, DM, p.WtE, DM, TOK, ZLD, DM, 0, EPI_EVEN_IN, nullptr, 0, nullptr, 0, nullptr); break;
    case 4: g = mk_gemm(p.O, DM, p.WtEo, DM, TOK, DM, DM, 0, EPI_F32_RESID, nullptr, 0, p.H, DM, p.x); break;
    case 6: g = mk_gemm(p.HN, DM, p.WtQ, DM, TOK, 2048, DM, 0, EPI_H16, p.QP, 2048, nullptr, 0, nullptr); break;
    case 7: g = mk_gemm(p.QP, 2048, p.Keys, 128, TOK, 2048, 128, 128, EPI_F32, nullptr, 0, p.SC, 2048, nullptr); break;
    case 10: g = mk_gemm(p.HN, DM, p.WtO, DM, TOK, Z2LD, DM, 0, EPI_H16, p.Z2, Z2LD, nullptr, 0, nullptr); break;
    case 14: g = mk_gemm(p.Z2 + DRNN, Z2LD, p.WtOo, DRNN, TOK, DM, DRNN, 0, EPI_F32_RESID, nullptr, 0, p.H, DM, p.H); break;
    case 16: g = mk_gemm(p.HN, DM, p.WtQ + (size_t)2048 * 1024, DM, TOK, 2048, DM, 0, EPI_H16, p.QP, 2048, nullptr, 0, nullptr); break;
    case 17: g = mk_gemm(p.QP, 2048, p.Keys + (size_t)8 * 2 * 128 * 128, 128, TOK, 2048, 128, 128, EPI_F32, nullptr, 0, p.SC, 2048, nullptr); break;
    default: isg = false; g = mk_gemm(nullptr, 0, nullptr, 0, 0, 0, 0, 0, 0, nullptr, 0, nullptr, 0, nullptr); break;
    }
    if (isg) {
        if (ph == 1) phase_gemm<EPI_EVEN_IN, DM, DM, ZLD, DM, ZLD, 0>(p, g, smem);
        else if (ph == 4) phase_gemm<EPI_F32_RESID, DM, DM, DM, DM, DM, 0>(p, g, smem);
        else if (ph == 14) phase_gemm<EPI_F32_RESID, Z2LD, DRNN, DM, DRNN, DM, 0>(p, g, smem);
        else if (ph == 7 || ph == 17) phase_gemm<EPI_F32, 2048, 128, 2048, 128, 2048, 128>(p, g, smem);
        else if (ph == 10) phase_gemm<EPI_H16, DM, DM, Z2LD, DM, Z2LD, 0>(p, g, smem);
        else phase_gemm<EPI_H16, DM, DM, 2048, DM, 2048, 0>(p, g, smem);
        return;
    }
    if (ph == 0) phase_prep(p, smem);
    else if (ph == 2) phase_cumsum_compress(p);
    else if (ph == 3) phase_attention(p, smem);
    else if (ph == 5 || ph == 15) phase_rmsnorm(p, ph == 5 ? p.ffn_norm_g : p.ffn_norm_g + DM);
    else if (ph == 8 || ph == 18) phase_peer_topk(p);
    else if (ph == 9 || ph == 19) phase_peer_experts(p, ph == 19 ? 1 : 0, ph == 19 ? p.final_g : p.odd_norm_g, ph == 19 ? 1 : 0);
    else if (ph == 11) phase_rnn_gates(p, smem);
    else if (ph == 12) phase_rnn_scan_a(p);
    else if (ph == 13) phase_rnn_scan_b(p);
}

__global__ void __launch_bounds__(NTHR, 2) mega(Params p) {
    __shared__ __attribute__((aligned(16))) char smem[46080];
    const int ph0 = (int)p.ph0, ph1 = (int)p.ph1;
    for (int ph = ph0; ph < ph1; ++ph) {
        run_phase(p, ph, smem);
        if (ph + 1 < ph1) cg::this_grid().sync();
    }
}

extern "C" void kernel_launch(void* const* d_in, const int* in_sizes, int n_in, void* d_out, int out_size, void* d_ws, size_t ws_size, hipStream_t stream) {
    Params p; memset(&p, 0, sizeof(p));
    const float* const* in = (const float* const*)d_in;
    p.x = in[0]; p.even_norm_g = in[1]; p.even_w_in = in[2]; p.even_b_f = in[3]; p.even_cmp_pos = in[4]; p.even_w_cmp_k = in[5]; p.even_w_cmp_v = in[6]; p.even_w_out = in[7];
    p.odd_norm_g = in[8]; p.odd_w_in = in[9]; p.odd_conv_w = in[10]; p.odd_conv_b = in[11]; p.odd_w_ra = in[12]; p.odd_b_ra = in[13]; p.odd_w_ri = in[14]; p.odd_b_ri = in[15];
    p.odd_lam = in[16]; p.odd_w_out = in[17]; p.ffn_norm_g = in[18]; p.peer_w_q = in[19]; p.peer_sub_keys = in[20]; p.peer_u = in[21]; p.peer_v = in[22]; p.final_g = in[23];
    p.out = (float*)d_out;
    char* ws = (char*)d_ws; size_t off = 0;
    auto take = [&](size_t bytes) { char* r = ws + off; off += (bytes + 255) & ~(size_t)255; return r; };
    p.WtE = (h16*)take((size_t)ZLD * 1024 * 2); p.WtEo = (h16*)take((size_t)1024 * 1024 * 2); p.WtO = (h16*)take((size_t)2560 * 1024 * 2); p.WtOo = (h16*)take((size_t)1024 * 1280 * 2);
    p.WtQ = (h16*)take((size_t)2 * 2048 * 1024 * 2); p.Wc = (h16*)take((size_t)2 * 64 * 2048 * 2); p.Wr = (h16*)take((size_t)20 * 16384 * 2); p.Keys = (h16*)take((size_t)2 * 8 * 2 * 128 * 128 * 2);
    p.Pos16 = (h16*)take(4096); p.U16 = (h16*)take((size_t)2 * 16384 * 1024 * 2); p.V16 = (h16*)take((size_t)2 * 16384 * 1024 * 2);
    p.H = (float*)take((size_t)TOK * DM * 4); p.HN = (h16*)take((size_t)TOK * DM * 2);
    const size_t scratch0 = off;
    p.Z = (h16*)take((size_t)TOK * ZLD * 2); p.VtF = (h16*)take((size_t)4 * 8 * 64 * SEQ * 2); p.VtS = (h16*)take((size_t)4 * 2 * 64 * SEQ * 2); p.VtW = (h16*)take((size_t)4 * 2 * 64 * SEQ * 2);
    p.KC = (h16*)take((size_t)8 * 256 * 64 * 2); p.VCt = (h16*)take((size_t)8 * 64 * 256 * 2); p.O = (h16*)take((size_t)TOK * DM * 2); p.FG = (float*)take((size_t)TOK * 32 * 4); p.C2 = (float*)take((size_t)32 * SEQ * 4); p.OACC = (float*)take((size_t)TOK * 512 * 4);
    size_t mx = off;
    off = scratch0;
    p.QP = (h16*)take((size_t)TOK * 2048 * 2); p.SC = (float*)take((size_t)TOK * 2048 * 4); p.IDS = (int*)take((size_t)TOK * 128 * 4); p.GW = (float*)take((size_t)TOK * 128 * 4);
    if (off > mx) mx = off;
    off = scratch0;
    p.Z2 = (h16*)take((size_t)TOK * Z2LD * 2); p.RA = (float*)take((size_t)TOK * DRNN * 4); p.RU = (float*)take((size_t)TOK * DRNN * 4);
    p.AggP = (float*)take((size_t)4 * 64 * DRNN * 4); p.AggH = (float*)take((size_t)4 * 64 * DRNN * 4);
    if (off > mx) mx = off;
    if (mx > ws_size) { fprintf(stderr, "workspace too small: need %zu have %zu\n", mx, ws_size); return; }

    static int grid_blocks = 0;
    if (!grid_blocks) {
        int dev = 0, cus = 0, per_cu = 0;
        hipGetDevice(&dev);
        hipDeviceGetAttribute(&cus, hipDeviceAttributeMultiprocessorCount, dev);
        hipOccupancyMaxActiveBlocksPerMultiprocessor(&per_cu, mega, NTHR, 0);
        if (per_cu > 2) per_cu = 2;
        if (per_cu < 1) per_cu = 1;
        grid_blocks = cus * per_cu;
    }
#if SINGLE_LAUNCH
    p.ph0 = 0; p.ph1 = NPHASE;
    void* args[] = {&p};
    hipError_t e = hipLaunchCooperativeKernel((void*)mega, dim3(grid_blocks), dim3(NTHR), args, 0, stream);
    if (e != hipSuccess) fprintf(stderr, "cooperative launch failed: %s (grid %d)\n", hipGetErrorString(e), grid_blocks);
#else
    for (int ph = 0; ph < NPHASE; ++ph) {
        p.ph0 = ph; p.ph1 = ph + 1;
        hipLaunchKernelGGL(mega, dim3(grid_blocks), dim3(NTHR), 0, stream, p);
    }
#endif
}
```

```cpp
#include <hip/hip_runtime.h>
#include <hip/hip_cooperative_groups.h>
#include <cstdio>
#include <cstdint>
#include <cstring>
namespace cg = cooperative_groups;

#ifndef SINGLE_LAUNCH
#define SINGLE_LAUNCH 1
#endif
#ifndef PROBE_PH
#define PROBE_PH -1
#endif
#ifndef PROBE_N
#define PROBE_N 1
#endif
#ifndef DUP_MASK
#define DUP_MASK 0
#endif

typedef _Float16 h16;
typedef _Float16 half8 __attribute__((ext_vector_type(8)));
typedef _Float16 half4 __attribute__((ext_vector_type(4)));
typedef _Float16 half2v __attribute__((ext_vector_type(2)));
typedef float f32x4 __attribute__((ext_vector_type(4)));
typedef float f32x16 __attribute__((ext_vector_type(16)));
typedef unsigned long long u64;
typedef int i32x4 __attribute__((ext_vector_type(4)));
typedef float f32x2 __attribute__((ext_vector_type(2)));

#define NTHR 256
constexpr int BATCH = 4, SEQ = 4096, DM = 1024, TOK = BATCH * SEQ;
constexpr int ZLD = 2304, Z2LD = 2560, DRNN = 1280;
constexpr int EVEN_IN = 2848;
constexpr float LOG2E = 1.4426950408889634f;
constexpr float QSCALE = 0.125f * LOG2E;
constexpr float NEGBIG = -1.0e30f;
constexpr int KST = 72;
constexpr int NPHASE = 20;
constexpr int XCD_BAR_WORDS_C = 3456;

struct Params {
    const float *x, *even_norm_g, *even_w_in, *even_b_f, *even_cmp_pos, *even_w_cmp_k, *even_w_cmp_v, *even_w_out;
    const float *odd_norm_g, *odd_w_in, *odd_conv_w, *odd_conv_b, *odd_w_ra, *odd_b_ra, *odd_w_ri, *odd_b_ri, *odd_lam, *odd_w_out;
    const float *ffn_norm_g, *peer_w_q, *peer_sub_keys, *peer_u, *peer_v, *final_g;
    float* out;
    h16 *WtE, *WtV, *WtEo, *WtO, *WtOo, *WtQ, *Wc, *Wr, *Keys, *Pos16;
    unsigned char *U8, *V8; float *US, *VS;
    float* H; h16* HN;
    h16 *Z, *VtF, *VtS, *VtW, *KC, *VCt, *O; float *FG, *C2, *OACC;
    h16* QP; h16* SC; int* IDS; float* GW;
    h16* Z2; h16 *LA, *RU; float *AggP, *AggH;
    unsigned long long* TS; unsigned* BAR;
    long long ph0, ph1;
};

typedef const __attribute__((address_space(4))) Params& PRef;
extern __shared__ __attribute__((aligned(16))) char dyn_lds[];
#define GRIDV ((int)gridDim.x * 2)
#define LAS __attribute__((address_space(3)))
__device__ __forceinline__ int hidx_() { return __builtin_amdgcn_readfirstlane((int)threadIdx.x >> 8); }
__device__ __forceinline__ int tidx_() { int t = threadIdx.x & 255; asm volatile("" : "+v"(t)); return t; }
__device__ __forceinline__ int bidx_() { int b = blockIdx.x * 2 + hidx_(); asm volatile("" : "+s"(b)); return b; }
__device__ __forceinline__ int widx_() { return __builtin_amdgcn_readfirstlane(((int)threadIdx.x >> 6) & 3); }
__device__ __forceinline__ void hsync() {
    volatile LAS unsigned* w = (volatile LAS unsigned*)(dyn_lds + 131072 + hidx_() * 16);
    asm volatile("s_waitcnt lgkmcnt(0)" ::: "memory");
    if ((threadIdx.x & 63) == 0) {
        const unsigned old = __hip_atomic_fetch_add((LAS unsigned*)w, 1u, __ATOMIC_RELAXED, __HIP_MEMORY_SCOPE_WORKGROUP);
        const unsigned target = (old | 3u) + 1u;
        while ((int)(w[0] - target) < 0) { }
    }
    asm volatile("s_waitcnt lgkmcnt(0)" ::: "memory");
}

__device__ __forceinline__ float wave_sum(float v) {
#pragma unroll
    for (int o = 32; o > 0; o >>= 1) v += __shfl_xor(v, o);
    return v;
}
__device__ __forceinline__ int mbcnt64(u64 m) { return __builtin_amdgcn_mbcnt_hi((unsigned)(m >> 32), __builtin_amdgcn_mbcnt_lo((unsigned)m, 0)); }
__device__ __forceinline__ float gelu_exact(float v) { return 0.5f * v * (1.0f + erff(v * 0.70710678118654752f)); }
__device__ __forceinline__ float sigmoidf_(float v) { return 1.0f / (1.0f + __expf(-v)); }
__device__ __forceinline__ float log_sigmoid(float v) { return v >= 0.f ? -log1pf(expf(-v)) : v - log1pf(expf(v)); }
__device__ __forceinline__ int crow(int r, int hi) { return (r & 3) + 8 * (r >> 2) + 4 * hi; }
__device__ __forceinline__ f32x16 zero16() { f32x16 z;
#pragma unroll
    for (int i = 0; i < 16; ++i) z[i] = 0.f; return z; }

__device__ __forceinline__ void rms_write_h16(const float (&v)[16], const float* __restrict__ g, h16* __restrict__ dst, int lane) {
    float ss = 0.f;
#pragma unroll
    for (int i = 0; i < 16; ++i) ss += v[i] * v[i];
    ss = wave_sum(ss);
    const float rstd = rsqrtf(ss * (1.0f / 1024.0f) + 1e-6f);
#pragma unroll
    for (int hseg = 0; hseg < 2; ++hseg) {
        const int c0 = hseg * 512 + lane * 8;
        const f32x4 g0 = *(const f32x4*)(g + c0), g1 = *(const f32x4*)(g + c0 + 4);
        half8 o;
#pragma unroll
        for (int i = 0; i < 4; ++i) { o[i] = (h16)(v[hseg * 8 + i] * rstd * g0[i]); o[4 + i] = (h16)(v[hseg * 8 + 4 + i] * rstd * g1[i]); }
        *(half8*)(dst + c0) = o;
    }
}
__device__ __forceinline__ void load_row16(const float* __restrict__ src, float (&v)[16], int lane) {
#pragma unroll
    for (int hseg = 0; hseg < 2; ++hseg) {
        const int c0 = hseg * 512 + lane * 8;
        const f32x4 a = *(const f32x4*)(src + c0), b = *(const f32x4*)(src + c0 + 4);
#pragma unroll
        for (int i = 0; i < 4; ++i) { v[hseg * 8 + i] = a[i]; v[hseg * 8 + 4 + i] = b[i]; }
    }
}

__device__ __forceinline__ int even_col_map(int n, int kind) {
    if (kind == 2) {
        if (n < 512) return 1024 + n;
        if (n < 640) return 2056 + 3 * 128 + (n - 512);
        return 2056 + 5 * 128 + (n - 640);
    }
    if (n < 1024) return n;
    if (n < 1536) return 1544 + (n - 1024);
    if (n < 1664) return 2056 + (n - 1536);
    if (n < 1792) return 2056 + 128 + (n - 1664);
    if (n < 1920) return 2056 + 256 + (n - 1792);
    if (n < 2048) return 2056 + 512 + (n - 1920);
    if (n < 2056) return 1536 + (n - 2048);
    if (n < 2080) return 2824 + (n - 2056);
    return -1;
}
__device__ __forceinline__ void transpose_job(const float* __restrict__ src, int K, int N, h16* __restrict__ dst, int Ndst, int mapped, float* tileS, int& base, int b0) {
    const int tid = tidx_(), nb = (int)GRIDV - b0, bid = bidx_() - b0;
    const int nkt = K / 64, nnt = Ndst / 64, ntiles = nkt * nnt;
    int first = (bid - (base % nb) + nb) % nb;
    for (int tile = first; tile < ntiles; tile += nb) {
        const int k0 = (tile % nkt) * 64, n0 = (tile / nkt) * 64;
#pragma unroll
        for (int i = 0; i < 16; ++i) {
            const int e = tid + 256 * i, kk = e >> 6, nn = e & 63;
            const int sc = mapped ? even_col_map(n0 + nn, mapped) : (n0 + nn);
            tileS[kk * 65 + nn] = (sc >= 0) ? src[(size_t)(k0 + kk) * N + sc] : 0.f;
        }
        hsync();
        const int n = tid >> 2, ks = (tid & 3) * 16;
        half8 o0, o1;
#pragma unroll
        for (int i = 0; i < 8; ++i) { o0[i] = (h16)tileS[(ks + i) * 65 + n]; o1[i] = (h16)tileS[(ks + 8 + i) * 65 + n]; }
        h16* d = dst + (size_t)(n0 + n) * K + k0 + ks;
        *(half8*)d = o0; *(half8*)(d + 8) = o1;
        hsync();
    }
    base += ntiles;
}
__device__ __forceinline__ void convert_job(const float* __restrict__ src, h16* __restrict__ dst, size_t n) {
    const size_t n4 = n / 4, stride = (size_t)GRIDV * NTHR;
    for (size_t i = (size_t)bidx_() * NTHR + tidx_(); i < n4; i += stride) {
        const f32x4 v = *(const f32x4*)(src + 4 * i);
        half4 o; o[0] = (h16)v[0]; o[1] = (h16)v[1]; o[2] = (h16)v[2]; o[3] = (h16)v[3];
        *(half4*)(dst + 4 * i) = o;
    }
}
template <int NR>
__device__ __forceinline__ void fp8_rows(const float* __restrict__ src, unsigned char* __restrict__ dst, float* __restrict__ scl, const int (&rows)[NR], int lane) {
    f32x4 v[NR][4];
#pragma unroll
    for (int q = 0; q < NR; ++q)
#pragma unroll
        for (int j = 0; j < 4; ++j) v[q][j] = *(const f32x4*)(src + (size_t)rows[q] * 1024 + lane * 16 + 4 * j);
#pragma unroll
    for (int q = 0; q < NR; ++q) {
        float am = 0.f;
#pragma unroll
        for (int j = 0; j < 4; ++j) am = fmaxf(am, fmaxf(fmaxf(fabsf(v[q][j][0]), fabsf(v[q][j][1])), fmaxf(fabsf(v[q][j][2]), fabsf(v[q][j][3]))));
#pragma unroll
        for (int o = 32; o > 0; o >>= 1) am = fmaxf(am, __shfl_xor(am, o));
        const float sc = am > 0.f ? am * (1.0f / 240.0f) : 1.0f, inv = 1.0f / sc;
        i32x4 qv;
#pragma unroll
        for (int j = 0; j < 4; ++j) {
            int pk = 0;
            pk = __builtin_amdgcn_cvt_pk_fp8_f32(v[q][j][0] * inv, v[q][j][1] * inv, pk, false);
            pk = __builtin_amdgcn_cvt_pk_fp8_f32(v[q][j][2] * inv, v[q][j][3] * inv, pk, true);
            qv[j] = pk;
        }
        *(i32x4*)(dst + (size_t)rows[q] * 1024 + lane * 16) = qv;
        if (lane == 0) scl[rows[q]] = sc;
    }
}
__device__ __forceinline__ void fp8_row(const float* __restrict__ src, unsigned char* __restrict__ dst, float* __restrict__ scl, int r, int lane) {
    const int rows[1] = {r}; fp8_rows<1>(src, dst, scl, rows, lane);
}
__device__ __forceinline__ void fp8_rows_job(const float* __restrict__ src, unsigned char* __restrict__ dst, float* __restrict__ scl, int nrows, int wv0) {
    const int lane = tidx_() & 63, wv = bidx_() * 4 + widx_() - wv0, nwv = GRIDV * 4 - wv0;
    if (wv < 0) return;
    int r = wv;
    for (; r + 3 * nwv < nrows; r += 4 * nwv) { const int rows[4] = {r, r + nwv, r + 2 * nwv, r + 3 * nwv}; fp8_rows<4>(src, dst, scl, rows, lane); }
    for (; r < nrows; r += nwv) fp8_row(src, dst, scl, r, lane);
}
__device__ __forceinline__ void weight_jobs(PRef p, char* smem, bool first_only, int b0) {
    float* tileS = (float*)smem;
    int base = 0;
    const int jlo = 0, jhi = 28;
    for (int job = jlo; job < jhi; ++job) {
        if (first_only != (job == 0 || job == 4 || job == 6 || job == 7)) continue;
        const float* src; int K, N, Nd; h16* dst; int mapped = 0;
        if (job == 0) { src = p.even_w_in; K = 1024; N = EVEN_IN; dst = p.WtE; Nd = ZLD; mapped = 1; }
        else if (job == 1) { src = p.even_w_out; K = 1024; N = 1024; dst = p.WtEo; Nd = 1024; }
        else if (job == 2) { src = p.odd_w_in; K = 1024; N = 2560; dst = p.WtO; Nd = 2560; }
        else if (job == 3) { src = p.odd_w_out; K = 1280; N = 1024; dst = p.WtOo; Nd = 1024; }
        else if (job == 4) { src = p.even_w_in; K = 1024; N = EVEN_IN; dst = p.WtV; Nd = 768; mapped = 2; }
        else if (job == 5) continue;
        else if (job == 6) { src = p.even_w_cmp_k; K = 2048; N = 64; dst = p.Wc; Nd = 64; }
        else if (job == 7) { src = p.even_w_cmp_v; K = 2048; N = 64; dst = p.Wc + 64 * 2048; Nd = 64; }
        else if (job < 18) { const int n = job - 8; src = p.odd_w_ra + n * 16384; K = 128; N = 128; dst = p.Wr + n * 16384; Nd = 128; }
        else { const int n = job - 18; src = p.odd_w_ri + n * 16384; K = 128; N = 128; dst = p.Wr + (10 + n) * 16384; Nd = 128; }
        transpose_job(src, K, N, dst, Nd, mapped, tileS, base, b0);
    }
}
__device__ __forceinline__ void phase_prep(PRef p, char* smem) {
    weight_jobs(p, smem, true, 0);
    convert_job(p.peer_sub_keys, p.Keys, (size_t)2 * 8 * 2 * 128 * 128);
    convert_job(p.even_cmp_pos, p.Pos16, 2048);
    const int lane = tidx_() & 63, wv = bidx_() * 4 + widx_(), nwv = GRIDV * 4;
    for (int row = wv; row < TOK; row += nwv) {
        float v[16]; load_row16(p.x + (size_t)row * DM, v, lane);
        rms_write_h16(v, p.even_norm_g, p.HN + (size_t)row * DM, lane);
    }
}

enum { EPI_EVEN_IN = 0, EPI_F32_RESID = 1, EPI_H16 = 2, EPI_F32T = 3, EPI_QSCORE = 4 };
struct GemmArgs {
    const h16* A; int lda; const h16* Bt; int ldb; int M, N, K; int a_ntile_stride;
    int mode; h16* c16; int ldc16; float* c32; int ldc32; const float* resid; const h16* aux;
};
template <int MODE, int LDC>
__device__ __forceinline__ void gemm_epilogue(PRef p, const GemmArgs& g, int mt, int nt, bool sw, const f32x4 (&acc)[4][4]) {
    const int lane = tidx_() & 63, wid = widx_(), wm = wid >> 1, wn = wid & 1;
    const int l4 = (lane >> 4) * 4, l15 = lane & 15;
    if (MODE == EPI_EVEN_IN) {
        int kind;
        if (nt < 4 || (nt >= 12 && nt < 16)) kind = 0; else if (nt >= 8 && nt < 12) kind = 2; else if (nt == 19) kind = 3; else if (nt == 21) kind = 4; else if (nt == 22) kind = 5; else kind = 1;
#pragma unroll
        for (int i = 0; i < 4; ++i)
#pragma unroll
            for (int j = 0; j < 4; ++j) {
                const f32x4 v = acc[i][j];
                if (kind <= 1) {
                    const int row = mt * 128 + wm * 64 + j * 16 + l15, col = nt * 128 + wn * 64 + i * 16 + l4;
                    const float sc = kind == 0 ? QSCALE : 1.0f;
                    half4 o; o[0] = (h16)(v[0] * sc); o[1] = (h16)(v[1] * sc); o[2] = (h16)(v[2] * sc); o[3] = (h16)(v[3] * sc);
                    *(half4*)(p.Z + (size_t)row * ZLD + col) = o;
                } else if (kind <= 4) {
                    const int row = mt * 128 + wm * 64 + i * 16 + l4, col = nt * 128 + wn * 64 + j * 16 + l15;
                    const int b = row >> 12, s = row & 4095;
                    half4 o; o[0] = (h16)v[0]; o[1] = (h16)v[1]; o[2] = (h16)v[2]; o[3] = (h16)v[3];
                    h16* dst;
                    if (kind == 2) { const int c = col - 1024; dst = p.VtF + ((size_t)(b * 8 + (c >> 6)) * 64 + (c & 63)) * SEQ + s; }
                    else if (kind == 3) { const int c = col - 2432; dst = p.VtS + ((size_t)(b * 2 + (c >> 6)) * 64 + (c & 63)) * SEQ + s; }
                    else { const int c = col - 2688; dst = p.VtW + ((size_t)(b * 2 + (c >> 6)) * 64 + (c & 63)) * SEQ + s; }
                    *(half4*)dst = o;
                } else {
                    const int row = mt * 128 + wm * 64 + j * 16 + l15, c = nt * 128 + wn * 64 + i * 16 + l4 - 2816;
                    if (c < 32) {
                        f32x4 o;
                        if (c < 8) {
#pragma unroll
                            for (int q = 0; q < 4; ++q) o[q] = log_sigmoid(v[q] + p.even_b_f[c + q]) * LOG2E;
                        } else {
#pragma unroll
                            for (int q = 0; q < 4; ++q) o[q] = sigmoidf_(v[q]);
                        }
                        *(f32x4*)(p.FG + (size_t)row * 32 + c) = o;
                    }
                }
            }
    } else {
#pragma unroll
        for (int i = 0; i < 4; ++i)
#pragma unroll
            for (int j = 0; j < 4; ++j) {
                const f32x4 v = acc[i][j];
                if (MODE == EPI_F32T) {
                    const int row = mt * 128 + wm * 64 + i * 16 + l4, col = nt * 128 + wn * 64 + j * 16 + l15;
                    *(f32x4*)(g.c32 + (size_t)col * TOK + row) = v;
                } else {
                    const int row = mt * 128 + wm * 64 + j * 16 + l15, col = nt * 128 + wn * 64 + i * 16 + l4;
                    if (MODE == EPI_F32_RESID) {
                        const f32x4 r = *(const f32x4*)(g.resid + (size_t)row * LDC + col);
                        *(f32x4*)(g.c32 + (size_t)row * LDC + col) = r + v;
                    } else {
                        half4 o; o[0] = (h16)v[0]; o[1] = (h16)v[1]; o[2] = (h16)v[2]; o[3] = (h16)v[3];
                        *(half4*)(g.c16 + (size_t)row * LDC + col) = o;
                    }
                }
            }
    }
}

template <int MODE, int LDA, int LDB, int GN, int GK, int LDC, int ANS>
__device__ __forceinline__ void phase_gemm(PRef p, const GemmArgs& g, char* smem) {
    h16* As = (h16*)smem;
    h16* Bs = As + 2 * 128 * 64;
    const int tid = tidx_(), lane = tid & 63, wid = widx_(), wm = wid >> 1, wn = wid & 1;
    constexpr int nM = TOK / 128, nN = GN / 128, ntiles = nM * nN, nk = GK / 64;
    const int lr = tid >> 3, lc = tid & 7;
    const int st_off = lr * 64 + ((lc ^ ((tid >> 4) & 7)) * 8);
    const int fsw = (lane & 15) >> 1;
    const int fo0 = (lane & 15) * 64 + ((((lane >> 4)) ^ fsw) * 8), fo1 = (lane & 15) * 64 + (((4 + (lane >> 4)) ^ fsw) * 8);
    for (int tile = bidx_(); tile < ntiles; tile += GRIDV) {
        const int mt = tile / nN, nt = tile % nN;
        bool sw = (MODE != EPI_F32T);
        if (MODE == EPI_EVEN_IN) sw = !((nt >= 8 && nt < 12) || nt == 19 || nt == 21);
        const h16* Ag = g.A + (size_t)(mt * 128 + lr) * LDA + (size_t)nt * ANS + lc * 8;
        const h16* Bg = g.Bt + (size_t)(nt * 128 + lr) * LDB + lc * 8;
        constexpr size_t a32 = (size_t)32 * LDA, b32 = (size_t)32 * LDB;
        f32x4 acc[4][4];
#pragma unroll
        for (int m = 0; m < 4; ++m)
#pragma unroll
            for (int n = 0; n < 4; ++n) acc[m][n] = (f32x4){0.f, 0.f, 0.f, 0.f};
        half8 ra[4], rb[4];
#pragma unroll
        for (int i = 0; i < 4; ++i) { ra[i] = *(const half8*)(Ag + i * a32); rb[i] = *(const half8*)(Bg + i * b32); }
#pragma unroll
        for (int i = 0; i < 4; ++i) { *(half8*)(As + st_off + i * 32 * 64) = ra[i]; *(half8*)(Bs + st_off + i * 32 * 64) = rb[i]; }
        hsync();
        const int pofs = (sw ? wn : wm) * 64 * 64, qofs = (sw ? wm : wn) * 64 * 64;
        for (int kt = 0; kt < nk; ++kt) {
            const int cur = kt & 1;
            if (kt + 1 < nk) {
                const int ko = (kt + 1) * 64;
#pragma unroll
                for (int i = 0; i < 4; ++i) { ra[i] = *(const half8*)(Ag + i * a32 + ko); rb[i] = *(const half8*)(Bg + i * b32 + ko); }
            }
            const h16* Pc = (sw ? Bs : As) + cur * 128 * 64 + pofs;
            const h16* Qc = (sw ? As : Bs) + cur * 128 * 64 + qofs;
#pragma unroll
            for (int ks = 0; ks < 2; ++ks) {
                const int fo = ks ? fo1 : fo0;
                half8 pf[4], qf[4];
#pragma unroll
                for (int i = 0; i < 4; ++i) { pf[i] = *(const half8*)(Pc + i * 16 * 64 + fo); qf[i] = *(const half8*)(Qc + i * 16 * 64 + fo); }
                __builtin_amdgcn_s_setprio(1);
#pragma unroll
                for (int i = 0; i < 4; ++i)
#pragma unroll
                    for (int j = 0; j < 4; ++j) acc[i][j] = __builtin_amdgcn_mfma_f32_16x16x32_f16(pf[i], qf[j], acc[i][j], 0, 0, 0);
                __builtin_amdgcn_s_setprio(0);
            }
            if (kt + 1 < nk) {
                const int nx = (cur ^ 1) * 128 * 64;
#pragma unroll
                for (int i = 0; i < 4; ++i) { *(half8*)(As + nx + st_off + i * 32 * 64) = ra[i]; *(half8*)(Bs + nx + st_off + i * 32 * 64) = rb[i]; }
            }
            hsync();
        }
        if (MODE == EPI_QSCORE) {
            constexpr int QST = 136;
            h16* Qs = (h16*)smem;
            const int l4 = (lane >> 4) * 4, l15 = lane & 15;
#pragma unroll
            for (int i = 0; i < 4; ++i)
#pragma unroll
                for (int j = 0; j < 4; ++j) {
                    const f32x4 v = acc[i][j];
                    half4 o; o[0] = (h16)v[0]; o[1] = (h16)v[1]; o[2] = (h16)v[2]; o[3] = (h16)v[3];
                    *(half4*)(Qs + (wm * 64 + j * 16 + l15) * QST + wn * 64 + i * 16 + l4) = o;
                }
            hsync();
            f32x4 sc[4][4];
#pragma unroll
            for (int i = 0; i < 4; ++i)
#pragma unroll
                for (int j = 0; j < 4; ++j) sc[i][j] = (f32x4){0.f, 0.f, 0.f, 0.f};
            const h16* kb = g.aux + (size_t)(nt * 128 + wn * 64 + l15) * 128 + (lane >> 4) * 8;
#pragma unroll
            for (int ks = 0; ks < 4; ++ks) {
                half8 pf[4], qf[4];
#pragma unroll
                for (int i = 0; i < 4; ++i) { pf[i] = *(const half8*)(Qs + (wm * 64 + i * 16 + l15) * QST + ks * 32 + (lane >> 4) * 8); qf[i] = *(const half8*)(kb + (size_t)i * 16 * 128 + ks * 32); }
#pragma unroll
                for (int i = 0; i < 4; ++i)
#pragma unroll
                    for (int j = 0; j < 4; ++j) sc[i][j] = __builtin_amdgcn_mfma_f32_16x16x32_f16(pf[i], qf[j], sc[i][j], 0, 0, 0);
            }
#pragma unroll
            for (int i = 0; i < 4; ++i)
#pragma unroll
                for (int j = 0; j < 4; ++j) {
                    const int row = mt * 128 + wm * 64 + i * 16 + l4, col = nt * 128 + wn * 64 + j * 16 + l15;
                    *(f32x4*)(g.c32 + (size_t)col * TOK + row) = sc[i][j];
                }
            hsync();
        } else
        gemm_epilogue<MODE, LDC>(p, g, mt, nt, sw, acc);
    }
}

__device__ __forceinline__ void wp_job(PRef p, int wv0) {
    const int lane = tidx_() & 63, wv = bidx_() * 4 + widx_() - wv0, nwv = GRIDV * 4 - wv0;
    if (wv < 0) return;
    for (int u = wv; u < 1024; u += nwv) {
        const int l = u >> 9, hc = (u >> 5) & 15, kh = (u >> 4) & 1, jt = u & 15;
        const float* wq = p.peer_w_q + (size_t)l * 1024 * 2048 + (size_t)(jt * 64 + (lane & 15)) * 2048 + hc * 128 + (lane >> 4) * 8;
        const h16* ky = p.Keys + ((size_t)(l * 16 + hc) * 128 + kh * 64 + (lane & 15)) * 128 + (lane >> 4) * 8;
        f32x4 acc[4][4];
#pragma unroll
        for (int a = 0; a < 4; ++a)
#pragma unroll
            for (int b = 0; b < 4; ++b) acc[a][b] = (f32x4){0.f, 0.f, 0.f, 0.f};
#pragma unroll
        for (int ks = 0; ks < 4; ++ks) {
            half8 af[4], bf[4];
#pragma unroll
            for (int a = 0; a < 4; ++a) {
                const f32x4 w0 = *(const f32x4*)(wq + (size_t)a * 16 * 2048 + ks * 32), w1 = *(const f32x4*)(wq + (size_t)a * 16 * 2048 + ks * 32 + 4);
#pragma unroll
                for (int q = 0; q < 4; ++q) { af[a][q] = (h16)w0[q]; af[a][4 + q] = (h16)w1[q]; }
                bf[a] = *(const half8*)(ky + (size_t)a * 16 * 128 + ks * 32);
            }
#pragma unroll
            for (int a = 0; a < 4; ++a)
#pragma unroll
                for (int b = 0; b < 4; ++b) acc[a][b] = __builtin_amdgcn_mfma_f32_16x16x32_f16(af[a], bf[b], acc[a][b], 0, 0, 0);
        }
        h16* wp = p.WtQ + (size_t)l * 2048 * 1024;
#pragma unroll
        for (int a = 0; a < 4; ++a)
#pragma unroll
            for (int b = 0; b < 4; ++b) {
                const int n = hc * 128 + kh * 64 + b * 16 + (lane & 15), j0 = jt * 64 + a * 16 + (lane >> 4) * 4;
                half4 o; o[0] = (h16)acc[a][b][0]; o[1] = (h16)acc[a][b][1]; o[2] = (h16)acc[a][b][2]; o[3] = (h16)acc[a][b][3];
                *(half4*)(wp + (size_t)n * 1024 + j0) = o;
            }
    }
}
__device__ __forceinline__ void phase_cumsum_compress(PRef p, char* smem) {
    const int lane = tidx_() & 63, wid = widx_(), vb = bidx_();
    if (vb >= 256 && vb < 264) {
        const int u = (vb - 256) * 4 + wid, b = u >> 3, h = u & 7;
        const float* src = p.FG + (size_t)(b * SEQ + lane * 64) * 32 + h;
        float loc[64]; float run = 0.f;
#pragma unroll
        for (int i = 0; i < 64; ++i) { run += src[(size_t)i * 32]; loc[i] = run; }
        float incl = run;
#pragma unroll
        for (int o = 1; o < 64; o <<= 1) { const float t = __shfl_up(incl, o); if (lane >= o) incl += t; }
        const float excl = incl - run;
        float* dst = p.C2 + (size_t)(b * 8 + h) * SEQ + lane * 64;
#pragma unroll
        for (int i = 0; i < 64; ++i) dst[i] = excl + loc[i];
    }
    if (vb < 256) {
        const int cu = vb, kv = cu >> 7, bg = (cu >> 4) & 7, nt = cu & 15;
        const int b = bg >> 1, g = bg & 1;
        int n = nt * 16 + (lane & 15); const int nc = n < 255 ? n : 254;
        const h16* Ab = p.Z + (size_t)(b * SEQ + 16 * nc) * ZLD + 1536 + kv * 128 + g * 64 + (lane >> 4) * 8;
        const h16* Wb = p.Wc + (size_t)kv * 64 * 2048 + (size_t)(lane & 15) * 2048 + (lane >> 4) * 8;
        const h16* Pb = p.Pos16 + (lane >> 4) * 8;
        f32x4 acc[4];
#pragma unroll
        for (int e = 0; e < 4; ++e) acc[e] = (f32x4){0.f, 0.f, 0.f, 0.f};
#pragma unroll
        for (int k2 = 0; k2 < 16; ++k2) {
            const int ks = wid * 16 + k2, l = ks >> 1, d0 = (ks & 1) * 32;
            half8 a = *(const half8*)(Ab + (size_t)l * ZLD + d0);
            const half8 ps = *(const half8*)(Pb + ks * 32);
            a = a + ps;
#pragma unroll
            for (int e = 0; e < 4; ++e) {
                const half8 w = *(const half8*)(Wb + (size_t)e * 16 * 2048 + ks * 32);
                acc[e] = __builtin_amdgcn_mfma_f32_16x16x32_f16(a, w, acc[e], 0, 0, 0);
            }
        }
        f32x4* part = (f32x4*)smem;
#pragma unroll
        for (int e = 0; e < 4; ++e) part[(wid * 4 + e) * 64 + lane] = acc[e];
        hsync();
        {
            const int e = wid;
            const f32x4 s = (part[(0 * 4 + e) * 64 + lane] + part[(1 * 4 + e) * 64 + lane]) + (part[(2 * 4 + e) * 64 + lane] + part[(3 * 4 + e) * 64 + lane]);
            const int n0 = nt * 16 + (lane >> 4) * 4, ec = e * 16 + (lane & 15);
            if (kv == 0) {
#pragma unroll
                for (int j = 0; j < 4; ++j) p.KC[((size_t)bg * 256 + n0 + j) * 64 + ec] = (n0 + j < 255) ? (h16)s[j] : (h16)0.f;
            } else {
                half4 o;
#pragma unroll
                for (int j = 0; j < 4; ++j) o[j] = (n0 + j < 255) ? (h16)s[j] : (h16)0.f;
                *(half4*)(p.VCt + ((size_t)bg * 64 + ec) * 256 + n0) = o;
            }
        }
        hsync();
    }
    weight_jobs(p, smem, false, 0);
    wp_job(p, 0);
    fp8_rows_job(p.peer_u, p.U8, p.US, 16384, 0);
    fp8_rows_job(p.peer_v, p.V8, p.VS, 16384, 0);
}

struct RowState { float m, l; f32x16 o0, o1; };
__device__ __forceinline__ void rs_reset(RowState& s) { s.m = NEGBIG; s.l = 0.f; s.o0 = zero16(); s.o1 = zero16(); }

__device__ __forceinline__ void kv_load(const h16* kb, int kst, const h16* vb, int vst, half8 (&kr)[2], half8 (&vr)[2]) {
    const int tid = tidx_();
#pragma unroll
    for (int i = 0; i < 2; ++i) {
        const int c = tid + 256 * i, row = c >> 3, cc = (c & 7) * 8;
        kr[i] = *(const half8*)(kb + (size_t)row * kst + cc);
        vr[i] = *(const half8*)(vb + (size_t)row * vst + cc);
    }
}
__device__ __forceinline__ void kv_store(h16* Ks, h16* Vs, const half8 (&kr)[2], const half8 (&vr)[2]) {
    const int tid = tidx_();
#pragma unroll
    for (int i = 0; i < 2; ++i) {
        const int c = tid + 256 * i, row = c >> 3, cc = (c & 7) * 8;
        *(half8*)(Ks + row * KST + cc) = kr[i];
        *(half8*)(Vs + row * KST + cc) = vr[i];
    }
}
__device__ __forceinline__ void qk_tile(const h16* Ks, const half8 (&qf)[4], f32x16 (&s)[2], int lane) {
    const int r32 = lane & 31, hh = lane >> 5;
#pragma unroll
    for (int kt = 0; kt < 2; ++kt) {
        s[kt] = zero16();
#pragma unroll
        for (int ks = 0; ks < 4; ++ks) {
            const half8 kf = *(const half8*)(Ks + (kt * 32 + r32) * KST + ks * 16 + hh * 8);
            s[kt] = __builtin_amdgcn_mfma_f32_32x32x16_f16(kf, qf[ks], s[kt], 0, 0, 0);
        }
    }
}
__device__ __forceinline__ void pv_tile(const h16* Vs, const f32x16 (&pr)[2], f32x16& o0, f32x16& o1, int lane) {
    const int r32 = lane & 31, hh = lane >> 5;
#pragma unroll
    for (int kt = 0; kt < 2; ++kt)
#pragma unroll
        for (int s2 = 0; s2 < 2; ++s2) {
            half8 pf;
#pragma unroll
            for (int j = 0; j < 8; ++j) pf[j] = (h16)pr[kt][8 * s2 + j];
            const int kof = kt * 32 + 16 * s2 + 4 * hh;
            {
                const half4 a = *(const half4*)(Vs + r32 * KST + kof), b = *(const half4*)(Vs + r32 * KST + kof + 8);
                half8 vf; vf[0] = a[0]; vf[1] = a[1]; vf[2] = a[2]; vf[3] = a[3]; vf[4] = b[0]; vf[5] = b[1]; vf[6] = b[2]; vf[7] = b[3];
                o0 = __builtin_amdgcn_mfma_f32_32x32x16_f16(vf, pf, o0, 0, 0, 0);
            }
            {
                const half4 a = *(const half4*)(Vs + (32 + r32) * KST + kof), b = *(const half4*)(Vs + (32 + r32) * KST + kof + 8);
                half8 vf; vf[0] = a[0]; vf[1] = a[1]; vf[2] = a[2]; vf[3] = a[3]; vf[4] = b[0]; vf[5] = b[1]; vf[6] = b[2]; vf[7] = b[3];
                o1 = __builtin_amdgcn_mfma_f32_32x32x16_f16(vf, pf, o1, 0, 0, 0);
            }
        }
}

enum { M_FOX = 0, M_SLC = 1, M_WIN = 2 };
template <int MODE, bool MASKED>
__device__ __forceinline__ void flash_step(const h16* Ks, const h16* Vs, const float* csS, const half8 (&qf)[4], RowState& st,
                                           int t, int kpos0, float slope2, float ct2, bool selbit, int lane) {
    const int hh = lane >> 5;
    f32x16 s[2];
    qk_tile(Ks, qf, s, lane);
    int dbase = t - kpos0 - 4 * hh;
    asm volatile("" : "+v"(dbase));
    const float off = (MODE == M_FOX) ? ct2 : -slope2 * (float)dbase;
    float mx = NEGBIG;
#pragma unroll
    for (int kt = 0; kt < 2; ++kt)
#pragma unroll
        for (int r = 0; r < 16; ++r) {
            const int c = kt * 32 + (r & 3) + 8 * (r >> 2);
            float v;
            if (MODE == M_FOX) v = s[kt][r] - csS[c + 4 * hh];
            else v = fmaf(slope2, (float)c, s[kt][r]);
            if (MASKED) {
                const int dist = dbase - c;
                bool valid;
                if (MODE == M_FOX) valid = dist >= 0; else if (MODE == M_SLC) valid = selbit && dist >= 0; else valid = dist >= 0 && dist < 512;
                v = valid ? v : NEGBIG;
            }
            s[kt][r] = v;
            mx = fmaxf(mx, v);
        }
    mx += off;
    mx = fmaxf(mx, __shfl_xor(mx, 32));
    const float mn = fmaxf(st.m, mx);
    const float alpha = __builtin_amdgcn_exp2f(st.m - mn);
    st.m = mn;
    const float moff = mn - off;
    float ps = 0.f;
#pragma unroll
    for (int kt = 0; kt < 2; ++kt)
#pragma unroll
        for (int r = 0; r < 16; ++r) {
            const float v = s[kt][r];
            float pe = __builtin_amdgcn_exp2f(v - moff);
            if (MASKED) pe = v > -1.0e29f ? pe : 0.f;
            s[kt][r] = pe; ps += pe;
        }
    st.l = st.l * alpha + ps;
#pragma unroll
    for (int r = 0; r < 16; ++r) { st.o0[r] *= alpha; st.o1[r] *= alpha; }
    pv_tile(Vs, s, st.o0, st.o1, lane);
}

template <int MODE>
__device__ __forceinline__ void run_flash(u64 mask, const h16* Kg, int kst, const h16* Vg, int vst, const float* csg, char* smem,
                                          const half8 (&qf)[4], RowState& st, int t, int twlo, int twhi, float slope2, float ct2, u64 sel, int lane) {
    h16* Kb = (h16*)smem; h16* Vb = Kb + 2 * 64 * KST; float* csb = (float*)(Vb + 2 * 64 * KST);
    if (mask == 0ull) return;
    half8 kr[2], vr[2]; float csr = 0.f;
    int jc = __builtin_ctzll(mask); mask &= mask - 1;
    kv_load(Kg + (size_t)jc * 64 * kst, kst, Vg + jc * 64, vst, kr, vr);
    if (MODE == M_FOX && tidx_() < 64) csr = csg[jc * 64 + tidx_()];
    kv_store(Kb, Vb, kr, vr);
    if (MODE == M_FOX && tidx_() < 64) csb[tidx_()] = csr;
    hsync();
    int buf = 0;
    for (;;) {
        int jn = -1;
        if (mask) { jn = __builtin_ctzll(mask); mask &= mask - 1; }
        if (jn >= 0) {
            kv_load(Kg + (size_t)jn * 64 * kst, kst, Vg + jn * 64, vst, kr, vr);
            if (MODE == M_FOX && tidx_() < 64) csr = csg[jn * 64 + tidx_()];
        }
        bool need = jc * 64 <= twhi;
        if (MODE == M_WIN) need = need && (jc * 64 + 63 >= twlo - 511);
        if (need) {
            const bool selbit = (sel >> jc) & 1ull;
            bool full = jc * 64 + 63 <= twlo;
            if (MODE == M_WIN) full = full && (jc * 64 > twhi - 512);
            if (MODE == M_SLC) full = full && (__ballot(selbit) == ~0ull);
            if (full) flash_step<MODE, false>(Kb + buf * 64 * KST, Vb + buf * 64 * KST, csb + buf * 64, qf, st, t, jc * 64, slope2, ct2, selbit, lane);
            else flash_step<MODE, true>(Kb + buf * 64 * KST, Vb + buf * 64 * KST, csb + buf * 64, qf, st, t, jc * 64, slope2, ct2, selbit, lane);
        }
        if (jn >= 0) {
            kv_store(Kb + (buf ^ 1) * 64 * KST, Vb + (buf ^ 1) * 64 * KST, kr, vr);
            if (MODE == M_FOX && tidx_() < 64) csb[(buf ^ 1) * 64 + tidx_()] = csr;
        }
        hsync();
        if (jn < 0) break;
        jc = jn; buf ^= 1;
    }
}

__device__ __forceinline__ void load_q(const h16* qrow, half8 (&qf)[4], int lane) {
#pragma unroll
    for (int ks = 0; ks < 4; ++ks) qf[ks] = *(const half8*)(qrow + ks * 16 + (lane >> 5) * 8);
}
__device__ __forceinline__ void store_o(h16* orow, const f32x16& o0, const f32x16& o1, int lane) {
    const int hh = lane >> 5;
#pragma unroll
    for (int rg = 0; rg < 4; ++rg) {
        half4 a, b;
#pragma unroll
        for (int j = 0; j < 4; ++j) { a[j] = (h16)o0[4 * rg + j]; b[j] = (h16)o1[4 * rg + j]; }
        *(half4*)(orow + 8 * rg + 4 * hh) = a;
        *(half4*)(orow + 32 + 8 * rg + 4 * hh) = b;
    }
}

__device__ __forceinline__ void oacc_store(float* row, const f32x16& o0, const f32x16& o1, float sc, int lane) {
    const int hh = lane >> 5;
#pragma unroll
    for (int rg = 0; rg < 4; ++rg) {
        *(f32x4*)(row + 8 * rg + 4 * hh) = (f32x4){o0[4 * rg] * sc, o0[4 * rg + 1] * sc, o0[4 * rg + 2] * sc, o0[4 * rg + 3] * sc};
        *(f32x4*)(row + 32 + 8 * rg + 4 * hh) = (f32x4){o1[4 * rg] * sc, o1[4 * rg + 1] * sc, o1[4 * rg + 2] * sc, o1[4 * rg + 3] * sc};
    }
}
__device__ __forceinline__ void oacc_add(float* row, const f32x16& o0, const f32x16& o1, float sc, int lane) {
    const int hh = lane >> 5;
#pragma unroll
    for (int rg = 0; rg < 4; ++rg) {
        f32x4 a = *(const f32x4*)(row + 8 * rg + 4 * hh), b = *(const f32x4*)(row + 32 + 8 * rg + 4 * hh);
#pragma unroll
        for (int j = 0; j < 4; ++j) { a[j] += o0[4 * rg + j] * sc; b[j] += o1[4 * rg + j] * sc; }
        *(f32x4*)(row + 8 * rg + 4 * hh) = a; *(f32x4*)(row + 32 + 8 * rg + 4 * hh) = b;
    }
}
__device__ __forceinline__ void oacc_final(const float* row, h16* orow, const f32x16& o0, const f32x16& o1, float sc, int lane) {
    const int hh = lane >> 5;
#pragma unroll
    for (int rg = 0; rg < 4; ++rg) {
        const f32x4 a = *(const f32x4*)(row + 8 * rg + 4 * hh), b = *(const f32x4*)(row + 32 + 8 * rg + 4 * hh);
        half4 x, y;
#pragma unroll
        for (int j = 0; j < 4; ++j) { x[j] = (h16)(a[j] + o0[4 * rg + j] * sc); y[j] = (h16)(b[j] + o1[4 * rg + j] * sc); }
        *(half4*)(orow + 8 * rg + 4 * hh) = x; *(half4*)(orow + 32 + 8 * rg + 4 * hh) = y;
    }
}

__device__ __forceinline__ void fox_unit(PRef p, int b, int h, int qt, char* smem) {
    const int tid = tidx_(), lane = tid & 63, wid = widx_();
    const int q0 = qt * 128, t0w = q0 + wid * 32, t = t0w + (lane & 31);
    half8 qf[4]; load_q(p.Z + (size_t)(b * SEQ + t) * ZLD + h * 64, qf, lane);
    const float* csg = p.C2 + (size_t)(b * 8 + h) * SEQ;
    const float ct2 = csg[t];
    RowState st; rs_reset(st);
    const int jmax = (q0 + 127) >> 6;
    const u64 mask = (jmax >= 63) ? ~0ull : ((1ull << (jmax + 1)) - 1ull);
    run_flash<M_FOX>(mask, p.Z + (size_t)b * SEQ * ZLD + 512 + h * 64, ZLD, p.VtF + (size_t)(b * 8 + h) * 64 * SEQ, SEQ, csg, smem,
                     qf, st, t, t0w, t0w + 31, 0.f, ct2, 0ull, lane);
    const float lt = st.l + __shfl_xor(st.l, 32);
    const float inv = 1.0f / lt;
#pragma unroll
    for (int r = 0; r < 16; ++r) { st.o0[r] *= inv; st.o1[r] *= inv; }
    store_o(p.O + (size_t)(b * SEQ + t) * DM + h * 64, st.o0, st.o1, lane);
}

__device__ __forceinline__ void nsa_unit(PRef p, int b, int g, int qt32, char* smem) {
    const int tid = tidx_(), lane = tid & 63, wid = widx_(), hh = lane >> 5, r32 = lane & 31;
    const int t0 = qt32 * 32, t = t0 + r32, head = g * 4 + wid, bg = b * 2 + g;
    const float slope2 = exp2f(-(float)(head + 1)) * LOG2E;
    half8 qf[4]; load_q(p.Z + (size_t)(b * SEQ + t) * ZLD + 1024 + head * 64, qf, lane);
    const float* gp = p.FG + (size_t)(b * SEQ + t) * 32 + 8 + head * 3;
    const float gate_c = gp[0], gate_s = gp[1], gate_w = gp[2];
    h16* Kb = (h16*)smem; h16* Vb = Kb + 2 * 64 * KST;
    u64* selS = (u64*)(smem + 37376);
    u64* unS = selS + 32;
    float* oaccrow = p.OACC + (size_t)(b * SEQ + t) * 512 + head * 64;
    unsigned* impS = (unsigned*)(smem + 37888);
    {
        for (int i = tid; i < 32 * 64; i += NTHR) impS[i] = 0u;
        const int nsteps = ((t0 >> 4) >> 6) + 1;
        const h16* Kg = p.KC + (size_t)bg * 256 * 64; const h16* Vg = p.VCt + (size_t)bg * 64 * 256;
        float mrun = NEGBIG, lrun = 0.f;
        for (int i = 0; i < nsteps; ++i) {
            half8 kr[2], vr[2];
            kv_load(Kg + (size_t)i * 64 * 64, 64, Vg + i * 64, 256, kr, vr);
            kv_store(Kb, Vb, kr, vr);
            hsync();
            f32x16 s[2];
            qk_tile(Kb, qf, s, lane);
            float mx = NEGBIG;
            int dbase = t - 31 - 16 * (i * 64 + 4 * hh);
            asm volatile("" : "+v"(dbase));
#pragma unroll
            for (int kt = 0; kt < 2; ++kt)
#pragma unroll
                for (int r = 0; r < 16; ++r) {
                    const int dist = dbase - 16 * (kt * 32 + (r & 3) + 8 * (r >> 2));
                    float v = s[kt][r] - slope2 * (float)dist;
                    v = dist >= 0 ? v : NEGBIG;
                    s[kt][r] = v; mx = fmaxf(mx, v);
                }
            mx = fmaxf(mx, __shfl_xor(mx, 32));
            const float mn = fmaxf(mrun, mx), alpha = __builtin_amdgcn_exp2f(mrun - mn);
            mrun = mn;
            float ps = 0.f;
#pragma unroll
            for (int kt = 0; kt < 2; ++kt)
#pragma unroll
                for (int r = 0; r < 16; ++r) { const float v = s[kt][r]; ps += v > -1.0e29f ? __builtin_amdgcn_exp2f(v - mn) : 0.f; }
            lrun = lrun * alpha + ps;
            hsync();
        }
        const float lt = lrun + __shfl_xor(lrun, 32);
        const float inv = lt > 0.f ? 1.0f / lt : 0.f;
        f32x16 o0 = zero16(), o1 = zero16();
        float carry = 0.f;
        for (int i = 0; i < nsteps; ++i) {
            half8 kr[2], vr[2];
            kv_load(Kg + (size_t)i * 64 * 64, 64, Vg + i * 64, 256, kr, vr);
            kv_store(Kb, Vb, kr, vr);
            hsync();
            f32x16 s[2];
            qk_tile(Kb, qf, s, lane);
            int dbase = t - 31 - 16 * (i * 64 + 4 * hh);
            asm volatile("" : "+v"(dbase));
#pragma unroll
            for (int kt = 0; kt < 2; ++kt)
#pragma unroll
                for (int r = 0; r < 16; ++r) {
                    const int dist = dbase - 16 * (kt * 32 + (r & 3) + 8 * (r >> 2));
                    const float v = s[kt][r] - slope2 * (float)dist;
                    s[kt][r] = dist >= 0 ? __builtin_amdgcn_exp2f(v - mrun) * inv : 0.f;
                }
            float R[2][4];
#pragma unroll
            for (int kt = 0; kt < 2; ++kt)
#pragma unroll
                for (int rg = 0; rg < 4; ++rg) R[kt][rg] = __shfl_xor(s[kt][4 * rg + 3], 32);
#pragma unroll
            for (int kt = 0; kt < 2; ++kt)
#pragma unroll
                for (int rg = 0; rg < 4; ++rg) {
                    const float G = (s[kt][4 * rg] + s[kt][4 * rg + 1]) + (s[kt][4 * rg + 2] + s[kt][4 * rg + 3]);
                    const float prev = (kt == 0 && rg == 0) ? carry : (rg > 0 ? R[kt][rg - 1] : R[kt - 1][3]);
                    const float val = G + (hh ? R[kt][rg] : prev);
                    const int j = 16 * i + 8 * kt + 2 * rg + hh;
                    atomicAdd(&impS[r32 * 64 + j], (unsigned)(val * 67108864.0f + 0.5f));
                }
            carry = R[1][3];
            pv_tile(Vb, s, o0, o1, lane);
            hsync();
        }
        oacc_store(oaccrow, o0, o1, gate_c, lane);
    }
    hsync();
    {
        u64 un = 0ull;
        for (int i = 0; i < 8; ++i) {
            const int tok = wid * 8 + i, tt = t0 + tok, cur = tt >> 6;
            const int j = lane;
            const bool valid = j <= cur;
            const bool forced = (j == 0) || (j == cur) || (j == cur - 1);
            const unsigned key = valid ? impS[tok * 64 + j] + (forced ? 0x40000000u : 0u) : 0u;
            int rank = 0;
            for (int jj = 0; jj < 64; ++jj) {
                const unsigned kv = (unsigned)__builtin_amdgcn_readlane((int)key, jj);
                rank += (kv > key || (kv == key && jj < j)) ? 1 : 0;
            }
            const u64 selm = __ballot(valid && rank < 16);
            if (lane == 0) selS[tok] = selm;
            un |= selm;
        }
        if (lane == 0) unS[wid] = un;
    }
    hsync();
    const u64 mysel = selS[r32];
    const u64 un = unS[0] | unS[1] | unS[2] | unS[3];
    hsync();
    {
        RowState st; rs_reset(st);
        run_flash<M_SLC>(un, p.Z + (size_t)b * SEQ * ZLD + 1792 + g * 64, ZLD, p.VtS + (size_t)bg * 64 * SEQ, SEQ, nullptr, smem,
                         qf, st, t, t0, t0 + 31, slope2, 0.f, mysel, lane);
        const float lt = st.l + __shfl_xor(st.l, 32);
        oacc_add(oaccrow, st.o0, st.o1, gate_s / lt, lane);
    }
    {
        RowState st; rs_reset(st);
        const int lo = t0 - 511, jlo = lo > 0 ? (lo >> 6) : 0, jhi = (t0 + 31) >> 6;
        u64 mask = (jhi >= 63 ? ~0ull : ((1ull << (jhi + 1)) - 1ull)) & ~((1ull << jlo) - 1ull);
        run_flash<M_WIN>(mask, p.Z + (size_t)b * SEQ * ZLD + 1920 + g * 64, ZLD, p.VtW + (size_t)bg * 64 * SEQ, SEQ, nullptr, smem,
                         qf, st, t, t0, t0 + 31, slope2, 0.f, 0ull, lane);
        const float lt = st.l + __shfl_xor(st.l, 32);
        oacc_final(oaccrow, p.O + (size_t)(b * SEQ + t) * DM + 512 + head * 64, st.o0, st.o1, gate_w / lt, lane);
    }
}

__device__ __forceinline__ void phase_attention(PRef p, char* smem) {
    int* nxt = (int*)(smem + 65536 - 16);
    for (;;) {
        if (tidx_() == 0) *nxt = (int)__hip_atomic_fetch_add(p.BAR + XCD_BAR_WORDS_C, 1u, __ATOMIC_RELAXED, __HIP_MEMORY_SCOPE_AGENT);
        hsync();
        const int q = *nxt;
        hsync();
        if (q >= 2048 + 512) break;
        if (q < 2048 && (q & 3) == 3) {
            const int c = q >> 2, r0 = (c & 255) * 64 + widx_() * 16, lane = tidx_() & 63;
            const float* srcp = (c < 256 ? p.peer_u : p.peer_v) + (size_t)16384 * 1024;
            unsigned char* dstp = (c < 256 ? p.U8 : p.V8) + (size_t)16384 * 1024;
            float* sclp = (c < 256 ? p.US : p.VS) + 16384;
            for (int i = 0; i < 16; i += 4) { const int rows[4] = {r0 + i, r0 + i + 1, r0 + i + 2, r0 + i + 3}; fp8_rows<4>(srcp, dstp, sclp, rows, lane); }
            continue;
        }
        const int u = q < 2048 ? q - ((q + 1) >> 2) : q - 512;
        const int st = 31 - (u >> 6), w = u & 63;
        if (w & 1) { const int idx = w >> 1; nsa_unit(p, (idx & 7) >> 1, idx & 1, st * 4 + (idx >> 3), smem); }
        else { const int idx = w >> 1; fox_unit(p, idx >> 3, idx & 7, st, smem); }
    }
}

__device__ __forceinline__ void phase_rmsnorm(PRef p, const float* g) {
    const int lane = tidx_() & 63, wv = bidx_() * 4 + widx_(), nwv = GRIDV * 4;
    for (int row = wv; row < TOK; row += nwv) {
        float v[16]; load_row16(p.H + (size_t)row * DM, v, lane);
        rms_write_h16(v, g, p.HN + (size_t)row * DM, lane);
    }
}

__device__ __forceinline__ unsigned fkey(float f) { const unsigned b = __float_as_uint(f); return b ^ ((b >> 31) ? 0xFFFFFFFFu : 0x80000000u); }
__device__ __forceinline__ float fkey_inv(unsigned k) { return __uint_as_float(k ^ ((k >> 31) ? 0x80000000u : 0xFFFFFFFFu)); }
__device__ __forceinline__ void ce_desc(unsigned& a, unsigned& b) { const unsigned hi = a > b ? a : b, lo = a > b ? b : a; a = hi; b = lo; }
__device__ __forceinline__ void sort16_desc(unsigned (&k)[16]) {
#pragma unroll
    for (int size = 2; size <= 16; size <<= 1)
#pragma unroll
        for (int stride = size >> 1; stride > 0; stride >>= 1)
#pragma unroll
            for (int i = 0; i < 16; ++i) {
                const int j = i ^ stride;
                if (j > i) { if ((i & size) == 0) ce_desc(k[i], k[j]); else ce_desc(k[j], k[i]); }
            }
}
__device__ __forceinline__ void merge16_desc(unsigned (&run)[16], const unsigned (&b)[16]) {
#pragma unroll
    for (int i = 0; i < 16; ++i) run[i] = run[i] > b[15 - i] ? run[i] : b[15 - i];
#pragma unroll
    for (int stride = 8; stride > 0; stride >>= 1)
#pragma unroll
        for (int i = 0; i < 16; ++i) { const int j = i ^ stride; if (j > i) ce_desc(run[i], run[j]); }
}
__device__ __forceinline__ void list_top16(const h16* __restrict__ base, unsigned (&run)[16]) {
    h16 cur[16], nxt[16];
#pragma unroll
    for (int i = 0; i < 16; ++i) cur[i] = base[(size_t)i * TOK];
#pragma unroll 1
    for (int bt = 0; bt < 8; ++bt) {
        if (bt < 7) {
#pragma unroll
            for (int i = 0; i < 16; ++i) nxt[i] = base[(size_t)((bt + 1) * 16 + i) * TOK];
        }
        unsigned kb[16];
#pragma unroll
        for (int i = 0; i < 16; ++i) kb[i] = (fkey((float)cur[i]) & ~127u) | (unsigned)(127 - (bt * 16 + i));
        sort16_desc(kb);
        if (bt == 0) {
#pragma unroll
            for (int i = 0; i < 16; ++i) run[i] = kb[i];
        } else merge16_desc(run, kb);
#pragma unroll
        for (int i = 0; i < 16; ++i) cur[i] = nxt[i];
    }
}
__device__ __forceinline__ void phase_peer_topk(PRef p, char* smem) {
    const int tid = tidx_(), lane = tid & 63, wv = bidx_() * 4 + widx_(), nwv = GRIDV * 4;
    int* idS = (int*)smem; float* evS = (float*)smem + 16 * NTHR;
    for (int u = wv; u < 8 * (TOK / 64); u += nwv) {
        const int h = u >> 8, tk = (u & 255) * 64 + lane;
        const h16* b0 = p.SC + (size_t)(h * 256) * TOK + tk;
        unsigned k0[16], k1[16];
        list_top16(b0, k0);
        list_top16(b0 + (size_t)128 * TOK, k1);
        float v0[16], v1[16]; int i0[16], i1[16];
#pragma unroll
        for (int j = 0; j < 16; ++j) {
            v0[j] = fkey_inv(k0[j] & ~127u); i0[j] = 127 - (int)(k0[j] & 127u);
            v1[j] = fkey_inv(k1[j] & ~127u); i1[j] = 127 - (int)(k1[j] & 127u);
        }
        unsigned run[16];
        {
            unsigned kb[16]; int n = 0, nb = 0;
#pragma unroll
            for (int a = 0; a < 16; ++a)
#pragma unroll
                for (int b = 0; b < 16; ++b)
                    if ((a + 1) * (b + 1) <= 16) {
                        kb[n] = fkey(v0[a] + v1[b]); ++n;
                        if (n == 16) {
                            sort16_desc(kb);
                            if (nb == 0) {
#pragma unroll
                                for (int i = 0; i < 16; ++i) run[i] = kb[i];
                            } else merge16_desc(run, kb);
                            n = 0; ++nb;
                        }
                    }
#pragma unroll
            for (int i = 2; i < 16; ++i) kb[i] = 0u;
            sort16_desc(kb); merge16_desc(run, kb);
        }
        const unsigned tkey = run[15]; const float smax = fkey_inv(run[0]);
        int cnt = 0; float esum = 0.f;
#pragma unroll
        for (int j = 0; j < 16; ++j) { idS[j * NTHR + tid] = 0; evS[j * NTHR + tid] = 0.f; }
#pragma unroll
        for (int pass = 0; pass < 2; ++pass)
#pragma unroll
            for (int a = 0; a < 16; ++a)
#pragma unroll
                for (int b = 0; b < 16; ++b)
                    if ((a + 1) * (b + 1) <= 16) {
                        const float s = v0[a] + v1[b]; const unsigned ks = fkey(s);
                        const bool take = pass == 0 ? (ks > tkey) : (ks == tkey && cnt < 16);
                        if (take) {
                            const float e = __expf(s - smax);
                            idS[cnt * NTHR + tid] = i0[a] * 128 + i1[b]; evS[cnt * NTHR + tid] = e;
                            esum += e; ++cnt;
                        }
                    }
        const float rinv = 1.0f / esum;
        int* ip = p.IDS + (size_t)tk * 128 + h * 16; float* gp = p.GW + (size_t)tk * 128 + h * 16;
#pragma unroll
        for (int q = 0; q < 4; ++q) {
            *(i32x4*)(ip + 4 * q) = (i32x4){idS[(4 * q) * NTHR + tid], idS[(4 * q + 1) * NTHR + tid], idS[(4 * q + 2) * NTHR + tid], idS[(4 * q + 3) * NTHR + tid]};
            *(f32x4*)(gp + 4 * q) = (f32x4){evS[(4 * q) * NTHR + tid] * rinv, evS[(4 * q + 1) * NTHR + tid] * rinv, evS[(4 * q + 2) * NTHR + tid] * rinv, evS[(4 * q + 3) * NTHR + tid] * rinv};
        }
    }
}

__device__ __forceinline__ float dot16_fp8h(const half8 xa, const half8 xb, const i32x4 q) {
    float d0 = 0.f, d1 = 0.f;
#pragma unroll
    for (int j = 0; j < 4; ++j) {
        const half2v lo = __builtin_amdgcn_cvt_scalef32_pk_f16_fp8(q[j], 1.0f, false), hi = __builtin_amdgcn_cvt_scalef32_pk_f16_fp8(q[j], 1.0f, true);
        half2v x0, x1;
        if (j < 2) { x0[0] = xa[4 * j]; x0[1] = xa[4 * j + 1]; x1[0] = xa[4 * j + 2]; x1[1] = xa[4 * j + 3]; }
        else { x0[0] = xb[4 * j - 8]; x0[1] = xb[4 * j - 7]; x1[0] = xb[4 * j - 6]; x1[1] = xb[4 * j - 5]; }
        d0 = __builtin_amdgcn_fdot2(lo, x0, d0, false); d1 = __builtin_amdgcn_fdot2(hi, x1, d1, false);
    }
    return d0 + d1;
}
__device__ __forceinline__ void axpy16_fp8(f32x2 (&acc)[8], float w, const i32x4 q) {
    const f32x2 ww = {w, w};
#pragma unroll
    for (int j = 0; j < 4; ++j) {
        const f32x2 lo = __builtin_amdgcn_cvt_pk_f32_fp8(q[j], false), hi = __builtin_amdgcn_cvt_pk_f32_fp8(q[j], true);
        acc[2 * j] = __builtin_elementwise_fma(ww, lo, acc[2 * j]); acc[2 * j + 1] = __builtin_elementwise_fma(ww, hi, acc[2 * j + 1]);
    }
}
constexpr int ET_SHIFT = 9, ET_N = 16384 >> ET_SHIFT;
__device__ __forceinline__ void phase_peer_experts(PRef p, int layer, const float* gnext, int mode, char* smem) {
    const int lane = tidx_() & 63, wid = widx_(), wv = bidx_() * 4 + wid, nwv = GRIDV * 4;
    const unsigned char* U = p.U8 + (size_t)layer * 16384 * 1024; const unsigned char* V = p.V8 + (size_t)layer * 16384 * 1024;
    const float* US = p.US + layer * 16384; const float* VS = p.VS + layer * 16384;
    const bool b5 = (lane & 32) != 0, b4 = (lane & 16) != 0, b3 = (lane & 8) != 0;
    int* sid = (int*)smem + wid * 1024;
    float* sgw = (float*)(sid + 512);
    h16* xS = (h16*)(smem + 16384) + wid * 4096;
    for (int tb = wv * 2; tb < TOK; tb += nwv * 2) {
#pragma unroll
        for (int g = 0; g < 2; ++g) {
            const half8 a = *(const half8*)(p.HN + (size_t)(tb + g) * DM + lane * 16), b = *(const half8*)(p.HN + (size_t)(tb + g) * DM + lane * 16 + 8);
            *(half8*)(xS + g * 1024 + lane * 16) = a; *(half8*)(xS + g * 1024 + lane * 16 + 8) = b;
        }
        {
            int idv[4]; float gv[4];
#pragma unroll
            for (int s = 0; s < 4; ++s) { idv[s] = p.IDS[(size_t)(tb + (s >> 1)) * 128 + (s & 1) * 64 + lane]; gv[s] = p.GW[(size_t)(tb + (s >> 1)) * 128 + (s & 1) * 64 + lane]; }
            int cnt = 0;
            for (int e = 0; e < ET_N; ++e) {
#pragma unroll
                for (int s = 0; s < 4; ++s) {
                    const bool in = (idv[s] >> ET_SHIFT) == e;
                    const u64 m = __ballot(in);
                    if (in) { const int pos = cnt + mbcnt64(m); sid[pos] = idv[s] | ((s >> 1) << 14); sgw[pos] = gv[s]; }
                    cnt += __popcll(m);
                }
            }
        }
        f32x2 acc[2][8];
#pragma unroll
        for (int g = 0; g < 2; ++g)
#pragma unroll
            for (int i = 0; i < 8; ++i) acc[g][i] = (f32x2){0.f, 0.f};
        for (int bt = 0; bt < 32; ++bt) {
            const int mine = sid[bt * 8 + (lane >> 3)]; const float gwm = sgw[bt * 8 + (lane >> 3)];
            const float usm = US[mine & 16383], vsm = VS[mine & 16383];
            i32x4 uq[8], vq[8]; int gk[8];
#pragma unroll
            for (int k = 0; k < 8; ++k) {
                const int pk = __builtin_amdgcn_readfirstlane(sid[bt * 8 + k]);
                const int id = pk & 16383; gk[k] = pk >> 14;
                uq[k] = *(const i32x4*)(U + (size_t)id * 1024 + lane * 16);
                vq[k] = *(const i32x4*)(V + (size_t)id * 1024 + lane * 16);
            }
            float d[8];
#pragma unroll
            for (int k = 0; k < 8; ++k) {
                const half8 xa = *(const half8*)(xS + gk[k] * 1024 + lane * 16), xb = *(const half8*)(xS + gk[k] * 1024 + lane * 16 + 8);
                d[k] = dot16_fp8h(xa, xb, uq[k]);
            }
            float r4[4], r2[2], z;
#pragma unroll
            for (int i = 0; i < 4; ++i) { const float keep = b5 ? d[i + 4] : d[i], send = b5 ? d[i] : d[i + 4]; r4[i] = keep + __shfl_xor(send, 32); }
#pragma unroll
            for (int i = 0; i < 2; ++i) { const float keep = b4 ? r4[i + 2] : r4[i], send = b4 ? r4[i] : r4[i + 2]; r2[i] = keep + __shfl_xor(send, 16); }
            { const float keep = b3 ? r2[1] : r2[0], send = b3 ? r2[0] : r2[1]; z = keep + __shfl_xor(send, 8); }
            z += __shfl_xor(z, 4); z += __shfl_xor(z, 2); z += __shfl_xor(z, 1);
            const float wm = gwm * gelu_exact(z * usm) * vsm;
#pragma unroll
            for (int k = 0; k < 8; ++k) {
                const float wk = __builtin_bit_cast(float, __builtin_amdgcn_readlane(__builtin_bit_cast(int, wm), 8 * k));
                if (gk[k] == 0) axpy16_fp8(acc[0], wk, vq[k]); else axpy16_fp8(acc[1], wk, vq[k]);
            }
        }
#pragma unroll
        for (int g = 0; g < 2; ++g) {
            const int tk = tb + g;
            float hv[16];
            {
                const float* hr = p.H + (size_t)tk * DM + lane * 16;
#pragma unroll
                for (int j = 0; j < 4; ++j) { const f32x4 t = *(const f32x4*)(hr + 4 * j); hv[4 * j] = t[0] + acc[g][2 * j][0]; hv[4 * j + 1] = t[1] + acc[g][2 * j][1]; hv[4 * j + 2] = t[2] + acc[g][2 * j + 1][0]; hv[4 * j + 3] = t[3] + acc[g][2 * j + 1][1]; }
            }
            float ss = 0.f;
#pragma unroll
            for (int i = 0; i < 16; ++i) ss += hv[i] * hv[i];
            ss = wave_sum(ss);
            const float rstd = rsqrtf(ss * (1.0f / 1024.0f) + 1e-6f);
            const float* gr = gnext + lane * 16;
            if (mode == 0) {
                float* hw = p.H + (size_t)tk * DM + lane * 16;
#pragma unroll
                for (int j = 0; j < 4; ++j) *(f32x4*)(hw + 4 * j) = (f32x4){hv[4 * j], hv[4 * j + 1], hv[4 * j + 2], hv[4 * j + 3]};
                half8 o0, o1;
#pragma unroll
                for (int j = 0; j < 2; ++j) {
                    const f32x4 ga = *(const f32x4*)(gr + 4 * j), gb = *(const f32x4*)(gr + 8 + 4 * j);
#pragma unroll
                    for (int i = 0; i < 4; ++i) { o0[4 * j + i] = (h16)(hv[4 * j + i] * rstd * ga[i]); o1[4 * j + i] = (h16)(hv[8 + 4 * j + i] * rstd * gb[i]); }
                }
                *(half8*)(p.HN + (size_t)tk * DM + lane * 16) = o0; *(half8*)(p.HN + (size_t)tk * DM + lane * 16 + 8) = o1;
            } else {
                float* ow = p.out + (size_t)tk * DM + lane * 16;
#pragma unroll
                for (int j = 0; j < 4; ++j) { const f32x4 ga = *(const f32x4*)(gr + 4 * j); *(f32x4*)(ow + 4 * j) = (f32x4){hv[4 * j] * rstd * ga[0], hv[4 * j + 1] * rstd * ga[1], hv[4 * j + 2] * rstd * ga[2], hv[4 * j + 3] * rstd * ga[3]}; }
            }
        }
    }
}

constexpr int XST = 136;
__device__ __forceinline__ float fast_sigmoid(float v) { return __builtin_amdgcn_rcpf(1.0f + __expf(-v)); }
__device__ __forceinline__ float gelu_as(float v) {
    const float av = fabsf(v), t = __builtin_amdgcn_rcpf(av * 0.2316419f + 1.0f);
    float q = t * 0.5307027145f - 0.7265760135f; q = q * t + 0.7107068705f; q = q * t - 0.142248368f; q = q * t + 0.127414796f; q = q * t;
    const float e = __builtin_amdgcn_exp2f(v * v * -0.72134752044f);
    const float m = v * (q * e);
    return v < 0.f ? m : v - m;
}
__device__ __forceinline__ void phase_rnn_gates(PRef p, char* smem) {
    h16* xcS = (h16*)smem;
    float* aggS = (float*)(smem + 64 * XST * 2);
    h16* laS = (h16*)(smem + 64 * XST * 2 + 4096);
    h16* ruS = laS + 64 * XST;
    const int tid = tidx_(), lane = tid & 63, wid = widx_();
    for (int u = bidx_(); u < 4 * 64 * 10; u += GRIDV) {
        const int nb = u % 10, ck = (u / 10) & 63, b = u / 640;
        const int s0 = ck * 64, ch0 = nb * 128;
        {
            const int c8 = (tid & 15) * 8, tq = (tid >> 4) * 4, ch = ch0 + c8;
            float w[4][8], bias[8];
#pragma unroll
            for (int j = 0; j < 4; ++j) {
                const f32x4 w0 = *(const f32x4*)(p.odd_conv_w + j * DRNN + ch), w1 = *(const f32x4*)(p.odd_conv_w + j * DRNN + ch + 4);
#pragma unroll
                for (int i = 0; i < 4; ++i) { w[j][i] = w0[i]; w[j][4 + i] = w1[i]; }
            }
            { const f32x4 b0 = *(const f32x4*)(p.odd_conv_b + ch), b1 = *(const f32x4*)(p.odd_conv_b + ch + 4);
#pragma unroll
              for (int i = 0; i < 4; ++i) { bias[i] = b0[i]; bias[4 + i] = b1[i]; } }
            half8 xin[7];
#pragma unroll
            for (int r = 0; r < 7; ++r) {
                const int sp = s0 + tq - 3 + r;
                if (sp >= 0) xin[r] = *(const half8*)(p.Z2 + (size_t)(b * SEQ + sp) * Z2LD + DRNN + ch);
                else {
#pragma unroll
                    for (int i = 0; i < 8; ++i) xin[r][i] = (h16)0.f;
                }
            }
#pragma unroll
            for (int tt = 0; tt < 4; ++tt) {
                half8 o;
#pragma unroll
                for (int i = 0; i < 8; ++i) {
                    float a = bias[i];
#pragma unroll
                    for (int j = 0; j < 4; ++j) a = fmaf(w[j][i], (float)xin[tt + j][i], a);
                    o[i] = (h16)a;
                }
                *(half8*)(xcS + (tq + tt) * XST + c8) = o;
            }
        }
        hsync();
        float bra8[8], bri8[8], sp8[8];
#pragma unroll
        for (int e = 0; e < 8; ++e) {
            const int chq = ch0 + e * 16 + (lane & 15);
            bra8[e] = p.odd_b_ra[chq]; bri8[e] = p.odd_b_ri[chq];
            const float lam = p.odd_lam[chq];
            sp8[e] = lam >= 0.f ? log1pf(__expf(-lam)) : -lam + log1pf(__expf(lam));
        }
        f32x4 ar[8], ai[8];
#pragma unroll
        for (int e = 0; e < 8; ++e) { ar[e] = (f32x4){0.f, 0.f, 0.f, 0.f}; ai[e] = (f32x4){0.f, 0.f, 0.f, 0.f}; }
        const h16* wr = p.Wr + (size_t)nb * 16384 + (lane & 15) * 128 + (lane >> 4) * 8;
        const h16* wi = p.Wr + (size_t)(10 + nb) * 16384 + (lane & 15) * 128 + (lane >> 4) * 8;
#pragma unroll
        for (int ks = 0; ks < 4; ++ks) {
            const half8 a = *(const half8*)(xcS + (wid * 16 + (lane & 15)) * XST + ks * 32 + (lane >> 4) * 8);
#pragma unroll
            for (int e = 0; e < 8; ++e) {
                const half8 w1 = *(const half8*)(wr + e * 16 * 128 + ks * 32), w2 = *(const half8*)(wi + e * 16 * 128 + ks * 32);
                ar[e] = __builtin_amdgcn_mfma_f32_16x16x32_f16(a, w1, ar[e], 0, 0, 0);
                ai[e] = __builtin_amdgcn_mfma_f32_16x16x32_f16(a, w2, ai[e], 0, 0, 0);
            }
        }
        const int g4 = lane >> 4;
#pragma unroll
        for (int e = 0; e < 8; ++e) {
            const int cl = e * 16 + (lane & 15), ch = ch0 + cl;
            const float bra = bra8[e], bri = bri8[e], sp = sp8[e];
            float A = 1.f, H = 0.f;
#pragma unroll
            for (int j = 0; j < 4; ++j) {
                const int tt = wid * 16 + g4 * 4 + j;
                const float r = fast_sigmoid(ar[e][j] + bra), ig = fast_sigmoid(ai[e][j] + bri);
                const h16 la16 = (h16)(-8.0f * r * sp);
                const float a = __expf((float)la16);
                const float xc = (float)xcS[tt * XST + cl];
                const h16 u16 = (h16)(__builtin_amdgcn_sqrtf(fmaxf(1.0f - a * a, 0.f)) * (ig * xc));
                laS[tt * XST + cl] = la16; ruS[tt * XST + cl] = u16;
                H = a * H + (float)u16; A *= a;
            }
            { const float Al = __shfl_xor(A, 16), Hl = __shfl_xor(H, 16); if (g4 & 1) { H = Hl * A + H; A = Al * A; } }
            { const float Al = __shfl_xor(A, 32), Hl = __shfl_xor(H, 32); if (g4 == 3) { H = Hl * A + H; A = Al * A; } }
            if (g4 == 3) { aggS[(wid * 128 + cl) * 2] = A; aggS[(wid * 128 + cl) * 2 + 1] = H; }
        }
        hsync();
        if (tid < 128) {
            float A = 1.f, H = 0.f;
#pragma unroll
            for (int w = 0; w < 4; ++w) { const float Aw = aggS[(w * 128 + tid) * 2], Hw = aggS[(w * 128 + tid) * 2 + 1]; H = H * Aw + Hw; A *= Aw; }
            p.AggP[(size_t)(b * 64 + ck) * DRNN + ch0 + tid] = A; p.AggH[(size_t)(b * 64 + ck) * DRNN + ch0 + tid] = H;
        }
#pragma unroll
        for (int i = 0; i < 4; ++i) {
            const int q = tid + 256 * i, row = q >> 4, c8 = (q & 15) * 8;
            const size_t o = (size_t)(b * SEQ + s0 + row) * DRNN + ch0 + c8;
            *(half8*)(p.LA + o) = *(const half8*)(laS + row * XST + c8);
            *(half8*)(p.RU + o) = *(const half8*)(ruS + row * XST + c8);
        }
        hsync();
    }
}
__device__ __forceinline__ void phase_rnn_scan_b(PRef p) {
    for (int u = bidx_(); u < 4 * 64 * 5; u += GRIDV) {
        const int cb = u % 5, ck = (u / 5) & 63, b = u / 320;
        const int ch = cb * 256 + tidx_();
        float h = 0.f;
        {
            const float* ap = p.AggP + (size_t)(b * 64) * DRNN + ch; const float* hp = p.AggH + (size_t)(b * 64) * DRNN + ch;
            int c = 0;
            for (; c + 8 <= ck; c += 8) {
                float pa[8], ph[8];
#pragma unroll
                for (int i = 0; i < 8; ++i) { pa[i] = ap[(size_t)(c + i) * DRNN]; ph[i] = hp[(size_t)(c + i) * DRNN]; }
#pragma unroll
                for (int i = 0; i < 8; ++i) h = pa[i] * h + ph[i];
            }
            for (; c < ck; ++c) h = ap[(size_t)c * DRNN] * h + hp[(size_t)c * DRNN];
        }
        const size_t base = (size_t)(b * SEQ + ck * 64) * DRNN + ch;
        h16* zrow = p.Z2 + (size_t)(b * SEQ + ck * 64) * Z2LD;
#pragma unroll 1
        for (int i0 = 0; i0 < 64; i0 += 32) {
            h16 la[32], uu[32], gt[32];
#pragma unroll
            for (int i = 0; i < 32; ++i) { la[i] = p.LA[base + (size_t)(i0 + i) * DRNN]; uu[i] = p.RU[base + (size_t)(i0 + i) * DRNN]; gt[i] = zrow[(size_t)(i0 + i) * Z2LD + ch]; }
#pragma unroll
            for (int i = 0; i < 32; ++i) {
                h = __expf((float)la[i]) * h + (float)uu[i];
                zrow[(size_t)(i0 + i) * Z2LD + DRNN + ch] = (h16)(gelu_as((float)gt[i]) * h);
            }
        }
    }
}

#define XB_TMO      128
#define XB_XCNT(j)  (256  + 64 * (j))
#define XB_XSUB(j)  (1280 + 64 * (j))
#define XB_XGEN(j)  (2304 + 64 * (j))
#define XB_TOP      3328
#define XB_TOPGEN   3392
#define XCD_BAR_WORDS 3456
#define XB_SPIN_CAP (1u << 22)
__device__ __forceinline__ unsigned xb_ld(unsigned* p)              { return __hip_atomic_load(p, __ATOMIC_RELAXED, __HIP_MEMORY_SCOPE_AGENT); }
__device__ __forceinline__ unsigned xb_add(unsigned* p, unsigned v) { return __hip_atomic_fetch_add(p, v, __ATOMIC_RELAXED, __HIP_MEMORY_SCOPE_AGENT); }
__device__ __forceinline__ unsigned xb_xcc_id() { return (unsigned)__builtin_amdgcn_s_getreg((3 << 11) | 20) & 0xFu; }
#define XB_SPIN(cond, bar) do { unsigned _sp = 0; while (cond) { __builtin_amdgcn_s_sleep(1); \
    if ((++_sp & 255u) == 0u) { if (xb_ld(&(bar)[XB_TMO])) break; if (_sp > XB_SPIN_CAP) { atomicAdd(&(bar)[XB_TMO], 1u); break; } } } } while (0)
struct XcdBarrier { unsigned* bar; unsigned x; volatile LAS unsigned* st; };
__device__ __forceinline__ XcdBarrier xcd_barrier_post(unsigned* bar, volatile LAS unsigned* st) {
    XcdBarrier b; b.bar = bar; b.x = xb_xcc_id(); b.st = st;
    if (threadIdx.x == 0) (void)xb_add(&bar[XB_XCNT(b.x)], 1u);
    return b;
}
__device__ __forceinline__ void xcd_barrier_complete(unsigned* bar, unsigned x, unsigned& nloc, unsigned& nx) {
    const unsigned G = gridDim.x * gridDim.y * gridDim.z;
    unsigned sum, cnt, mine, sp = 0u;
    for (;;) {
        sum = 0u; cnt = 0u; mine = 0u;
#pragma unroll
        for (unsigned j = 0; j < 16; ++j) { const unsigned c = xb_ld(&bar[XB_XCNT(j)]); sum += c; cnt += (c > 0u) ? 1u : 0u; mine = (j == x) ? c : mine; }
        if (sum == G) break;
        __builtin_amdgcn_s_sleep(1);
        if ((++sp & 255u) == 0u) { if (xb_ld(&bar[XB_TMO])) break; if (sp > XB_SPIN_CAP) { atomicAdd(&bar[XB_TMO], 1u); break; } }
    }
    nloc = mine > 0u ? mine : 1u; nx = cnt > 0u ? cnt : 1u;
}
__device__ __forceinline__ void xcd_barrier(const XcdBarrier& b) {
    asm volatile("s_waitcnt vmcnt(0)" ::: "memory");
    __syncthreads();
    if (threadIdx.x == 0) {
        unsigned* bar = b.bar;
        __builtin_amdgcn_s_waitcnt(0);
        unsigned nloc = b.st[0], nx = b.st[1];
        if (nloc == 0u) { xcd_barrier_complete(bar, b.x, nloc, nx); b.st[0] = nloc; b.st[1] = nx; }
        const unsigned old = xb_add(&bar[XB_XSUB(b.x)], 1u);
        const unsigned gen = old / nloc;
        if (old + 1u == (gen + 1u) * nloc) {
            __builtin_amdgcn_fence(__ATOMIC_RELEASE, "agent");
            asm volatile("s_waitcnt vmcnt(0)" ::: "memory");
            const unsigned og = xb_add(&bar[XB_TOP], 1u);
            const unsigned tg = og / nx;
            if (og + 1u == (tg + 1u) * nx) xb_add(&bar[XB_TOPGEN], 1u);
            else XB_SPIN(xb_ld(&bar[XB_TOPGEN]) == tg, bar);
            __builtin_amdgcn_fence(__ATOMIC_ACQUIRE, "agent");
            xb_add(&bar[XB_XGEN(b.x)], 1u);
            asm volatile("s_waitcnt vmcnt(0)" ::: "memory");
        } else {
            XB_SPIN(xb_ld(&bar[XB_XGEN(b.x)]) == gen, bar);
            __builtin_amdgcn_fence(__ATOMIC_ACQUIRE, "agent");
            asm volatile("s_waitcnt vmcnt(0)" ::: "memory");
        }
    }
    __syncthreads();
}

namespace pg8 {
#define PG8_LAS __attribute__((address_space(3)))
typedef unsigned short bf16_t;
typedef short bf16x8 __attribute__((ext_vector_type(8)));
typedef unsigned u32x4 __attribute__((ext_vector_type(4)));
constexpr int BM = 256, BK = 64, HALF = 128, HTB = HALF * BK * 2  , STAGE_BYTES = 8 * HTB, NXCD = 8, WGM = 8;

__host__ __device__ __forceinline__ int lds_byte(int r, int c) { const int st = (r >> 4) * 2 + (c >> 5), rr = r & 15, cc = c & 31, ob = rr * 64 + cc * 2; return st * 1024 + (ob ^ (((ob >> 9) & 1) << 5)); }
__host__ __device__ __forceinline__ void stage_rc(int b, int& R, int& C) { const int st = b / 1024, sb = b % 1024, swz = sb ^ (((sb >> 9) & 1) << 5); R = (st >> 1) * 16 + swz / 64; C = (st & 1) * 32 + (swz % 64) / 2; }
__host__ __device__ __forceinline__ int perm32(int rho) { const int n = rho >> 4, i = rho & 15; return 8 * (i >> 2) + 4 * n + (i & 3); }

struct Unit { int pm, pn; };
struct Gemm { const bf16_t* A; const bf16_t* Bt; int M, N, K, lda; };

struct StaticOrder {
    int nM, nN, nwg, G, c;
    __host__ __device__ void init(int M, int N, int G_, int c_) { nM = M / BM; nN = N / BM; nwg = nM * nN; G = G_; c = c_; }
    __host__ __device__ bool next(int i, Unit& u) const {
        const long L = (long)i * G + c; if (L >= nwg) return false;
        int wgid = (int)L; { const int q = nwg / NXCD, r = nwg % NXCD, xcd = wgid % NXCD, off = wgid / NXCD; wgid = (xcd < r ? xcd * (q + 1) : r * (q + 1) + (xcd - r) * q) + off; }
        const int nig = WGM * nN, gid = wgid / nig, fm = gid * WGM, gsz = (nM - fm) < WGM ? (nM - fm) : WGM;
        u.pm = fm + ((wgid % nig) % gsz); u.pn = (wgid % nig) / gsz; return true;
    }
    __device__ __forceinline__ void a_ready(const Unit&) const {}
    __device__ __forceinline__ void done(const Unit&) const {}
};
__device__ __forceinline__ unsigned pk_h16(float lo, float hi) { half2v t; t[0] = (h16)lo; t[1] = (h16)hi; return __builtin_bit_cast(unsigned, t); }
struct EpiResid {
    static constexpr bool PERM = false, AFTER_DRAIN = false;
    const float* resid; float* out; int ldc;
    __device__ __forceinline__ void operator()(const f32x4 (&acc)[2][2][4][2], const Unit& u, int wr, int wc, int fr, int fq) const {
#pragma unroll
        for (int ai = 0; ai < 2; ++ai)
#pragma unroll
            for (int m = 0; m < 4; ++m) { const size_t ro = (size_t)(u.pm * BM + ai * HALF + wr * 64 + m * 16 + fr) * ldc + u.pn * BM + wc * 32 + 4 * fq;
#pragma unroll
                for (int bj = 0; bj < 2; ++bj)
#pragma unroll
                    for (int n = 0; n < 2; ++n) { const size_t o = ro + bj * HALF + n * 16; *(f32x4*)(out + o) = *(const f32x4*)(resid + o) + acc[ai][bj][m][n]; } }
    }
};
struct EpiF32 {
    static constexpr bool PERM = false, AFTER_DRAIN = false;
    float* out; size_t ldc;
    __device__ __forceinline__ void operator()(const f32x4 (&acc)[2][2][4][2], const Unit& u, int wr, int wc, int fr, int fq) const {
#pragma unroll
        for (int ai = 0; ai < 2; ++ai)
#pragma unroll
            for (int m = 0; m < 4; ++m) { const size_t ro = (size_t)(u.pm * BM + ai * HALF + wr * 64 + m * 16 + fr) * ldc + u.pn * BM + wc * 32 + 4 * fq;
#pragma unroll
                for (int bj = 0; bj < 2; ++bj)
#pragma unroll
                    for (int n = 0; n < 2; ++n) *(f32x4*)(out + ro + bj * HALF + n * 16) = acc[ai][bj][m][n]; }
    }
};
struct EpiH16 {
    static constexpr bool PERM = true, AFTER_DRAIN = false;
    h16* out; int ldc;
    __device__ __forceinline__ void operator()(const f32x4 (&acc)[2][2][4][2], const Unit& u, int wr, int wc, int fr, int fq) const {
#pragma unroll
        for (int ai = 0; ai < 2; ++ai)
#pragma unroll
            for (int m = 0; m < 4; ++m) { h16* rowp = out + (size_t)(u.pm * BM + ai * HALF + wr * 64 + m * 16 + fr) * ldc + u.pn * BM + wc * 32 + 8 * fq;
#pragma unroll
                for (int bj = 0; bj < 2; ++bj) { const f32x4 v0 = acc[ai][bj][m][0], v1 = acc[ai][bj][m][1];
                    u32x4 w; w.x = pk_h16(v0[0], v0[1]); w.y = pk_h16(v0[2], v0[3]); w.z = pk_h16(v1[0], v1[1]); w.w = pk_h16(v1[2], v1[3]);
                    *(u32x4*)(rowp + bj * HALF) = w; } }
    }
};
struct EpiEvenMain {
    static constexpr bool PERM = true, AFTER_DRAIN = false;
    h16* Z; float* FG; const float* b_f;
    __device__ __forceinline__ void operator()(const f32x4 (&acc)[2][2][4][2], const Unit& u, int wr, int wc, int fr, int fq) const {
#pragma unroll
        for (int bj = 0; bj < 2; ++bj) {
            const int col0 = u.pn * BM + bj * HALF + wc * 32 + 8 * fq;
            if (col0 < 2048) {
                const float sc = (col0 < 512 || (col0 >= 1024 && col0 < 1536)) ? QSCALE : 1.0f;
#pragma unroll
                for (int ai = 0; ai < 2; ++ai)
#pragma unroll
                    for (int m = 0; m < 4; ++m) { const f32x4 v0 = acc[ai][bj][m][0] * sc, v1 = acc[ai][bj][m][1] * sc;
                        u32x4 w; w.x = pk_h16(v0[0], v0[1]); w.y = pk_h16(v0[2], v0[3]); w.z = pk_h16(v1[0], v1[1]); w.w = pk_h16(v1[2], v1[3]);
                        *(u32x4*)(Z + (size_t)(u.pm * BM + ai * HALF + wr * 64 + m * 16 + fr) * ZLD + col0) = w; }
            } else if (col0 < 2080) {
                const int c = col0 - 2048;
#pragma unroll
                for (int ai = 0; ai < 2; ++ai)
#pragma unroll
                    for (int m = 0; m < 4; ++m) { const f32x4 v0 = acc[ai][bj][m][0], v1 = acc[ai][bj][m][1]; f32x4 o0, o1;
                        if (c == 0) {
#pragma unroll
                            for (int q = 0; q < 4; ++q) { o0[q] = log_sigmoid(v0[q] + b_f[q]) * LOG2E; o1[q] = log_sigmoid(v1[q] + b_f[4 + q]) * LOG2E; }
                        } else {
#pragma unroll
                            for (int q = 0; q < 4; ++q) { o0[q] = sigmoidf_(v0[q]); o1[q] = sigmoidf_(v1[q]); }
                        }
                        float* fr_ = FG + (size_t)(u.pm * BM + ai * HALF + wr * 64 + m * 16 + fr) * 32 + c;
                        *(f32x4*)fr_ = o0; *(f32x4*)(fr_ + 4) = o1; }
            }
        }
    }
};
struct EpiVt {
    static constexpr bool PERM = true, AFTER_DRAIN = false;
    h16 *VtF, *VtS, *VtW;
    __device__ __forceinline__ void operator()(const f32x4 (&acc)[2][2][4][2], const Unit& u, int wr, int wc, int fr, int fq) const {
#pragma unroll
        for (int ai = 0; ai < 2; ++ai)
#pragma unroll
            for (int m = 0; m < 4; ++m) {
                const int n = u.pm * BM + ai * HALF + wr * 64 + m * 16 + fr;
#pragma unroll
                for (int bj = 0; bj < 2; ++bj) {
                    const int t0 = u.pn * BM + bj * HALF + wc * 32 + 8 * fq, b = t0 >> 12, s = t0 & 4095;
                    h16* dst = n < 512 ? VtF + ((size_t)(b * 512 + n)) * SEQ + s : (n < 640 ? VtS + ((size_t)(b * 128 + n - 512)) * SEQ + s : VtW + ((size_t)(b * 128 + n - 640)) * SEQ + s);
                    const f32x4 v0 = acc[ai][bj][m][0], v1 = acc[ai][bj][m][1];
                    u32x4 w; w.x = pk_h16(v0[0], v0[1]); w.y = pk_h16(v0[2], v0[3]); w.z = pk_h16(v1[0], v1[1]); w.w = pk_h16(v1[2], v1[3]);
                    *(u32x4*)dst = w;
                }
            }
    }
};

template <class Epi, class Sched, bool ALIGN_EPI = false, bool SP2 = false>
__device__ __forceinline__ void gemm_phase(PG8_LAS unsigned char* lds, const Gemm g, const Sched& S, const Epi& E) {
    int tid_ = threadIdx.x; asm volatile("" : "+v"(tid_));
    const int tid = tid_, wid = __builtin_amdgcn_readfirstlane(tid >> 6), lane = tid & 63, wr = wid >> 2, wc = wid & 3, fr = lane & 15, fq = lane >> 4;
    const int K = g.K, nt = K / BK;
    unsigned voffA[2], voffB[2];
#pragma unroll
    for (int i = 0; i < 2; ++i) { int R, C; stage_rc(tid * 16 + i * 8192, R, C); const int Rb = Epi::PERM ? ((R & ~31) + perm32(R & 31)) : R;
        voffA[i] = (unsigned)(R * g.lda + C) * 2u; voffB[i] = (unsigned)(Rb * K + C) * 2u; }
    const size_t kstep = (size_t)(BK * 2);
    const size_t hstepA = (size_t)HALF * g.lda * 2, hstepB = (size_t)HALF * K * 2;
    const size_t tstepA = 2 * hstepA, tstepB = 2 * hstepB;
    const unsigned ldsw = (unsigned)wid * 1024u;
    const int aoff = lds_byte(wr * 64 + fr, fq * 8), boff = lds_byte(wc * 32 + fr, fq * 8);
#define PG8_SA(b, h) (((b) * 2 + (h)) * HTB)
#define PG8_SB(b, h) ((4 + (b) * 2 + (h)) * HTB)
#define PG8_STAGE(bufoff, gbase, voff) do { _Pragma("unroll") for (int _i = 0; _i < 2; ++_i) \
        __builtin_amdgcn_global_load_lds((const unsigned*)((const char*)(gbase) + (voff)[_i]), (PG8_LAS unsigned*)(lds + (bufoff) + ldsw + _i * 8192), 16, 0, 0); } while (0)
#define PG8_LDA(dst, b, h) do { _Pragma("unroll") for (int m = 0; m < 4; ++m) _Pragma("unroll") for (int k = 0; k < 2; ++k) dst[m][k] = *(const PG8_LAS bf16x8*)(lds + PG8_SA(b, h) + aoff + m * 2048 + k * 1024); } while (0)
#define PG8_LDB(dst, b, h) do { _Pragma("unroll") for (int n = 0; n < 2; ++n) _Pragma("unroll") for (int k = 0; k < 2; ++k) dst[n][k] = *(const PG8_LAS bf16x8*)(lds + PG8_SB(b, h) + boff + n * 2048 + k * 1024); } while (0)
#define PG8_MMA(ai, bj, At, Bt) do { __builtin_amdgcn_s_setprio(1); _Pragma("unroll") for (int m = 0; m < 4; ++m) _Pragma("unroll") for (int n = 0; n < 2; ++n) _Pragma("unroll") for (int k = 0; k < 2; ++k) \
        acc[ai][bj][m][n] = __builtin_amdgcn_mfma_f32_16x16x32_f16(__builtin_bit_cast(half8, Bt[n][k]), __builtin_bit_cast(half8, At[m][k]), acc[ai][bj][m][n], 0, 0, 0); __builtin_amdgcn_s_setprio(0); } while (0)
#define PG8_WAIT_V(n) asm volatile("s_waitcnt vmcnt(" #n ")" ::: "memory")
#define PG8_WAIT_L(n) asm volatile("s_waitcnt lgkmcnt(" #n ")" ::: "memory")
#define PG8_BAR __builtin_amdgcn_s_barrier()
#define PG8_SCHED __builtin_amdgcn_sched_barrier(0)
    Unit cur, nxt; int ui = 0;
    if (!S.next(0, cur)) return;
    f32x4 acc[2][2][4][2];
#pragma unroll
    for (int a = 0; a < 2; ++a)
#pragma unroll
        for (int b = 0; b < 2; ++b)
#pragma unroll
            for (int m = 0; m < 4; ++m)
#pragma unroll
                for (int n = 0; n < 2; ++n) acc[a][b][m][n] = (f32x4){0.f, 0.f, 0.f, 0.f};
    bf16x8 At[4][2], B0[2][2], B1[2][2];
    const char* cA = (const char*)g.A + (size_t)cur.pm * tstepA; const char* cB = (const char*)g.Bt + (size_t)cur.pn * tstepB;
    S.a_ready(cur);
    if constexpr (SP2) {
        PG8_STAGE(PG8_SB(0, 0), cB, voffB); PG8_STAGE(PG8_SB(0, 1), cB + hstepB, voffB); PG8_STAGE(PG8_SA(0, 0), cA, voffA); PG8_STAGE(PG8_SA(0, 1), cA + hstepA, voffA);
        if (wr == 1) PG8_BAR;
        PG8_WAIT_V(2); PG8_BAR;
        PG8_STAGE(PG8_SB(1, 0), cB + kstep, voffB); PG8_STAGE(PG8_SA(1, 0), cA + kstep, voffA); PG8_STAGE(PG8_SB(1, 1), cB + hstepB + kstep, voffB);
        PG8_WAIT_V(6); PG8_BAR;
    } else {
        PG8_STAGE(PG8_SB(0, 0), cB, voffB); PG8_STAGE(PG8_SA(0, 0), cA, voffA); PG8_STAGE(PG8_SB(0, 1), cB + hstepB, voffB); PG8_STAGE(PG8_SA(0, 1), cA + hstepA, voffA);
        if (wr == 1) PG8_BAR;
        PG8_WAIT_V(4); PG8_BAR;
        PG8_STAGE(PG8_SB(1, 0), cB + kstep, voffB); PG8_STAGE(PG8_SA(1, 0), cA + kstep, voffA); PG8_STAGE(PG8_SB(1, 1), cB + hstepB + kstep, voffB);
        PG8_WAIT_V(6); PG8_BAR;
    }
    for (;;) {
        const bool has_next = S.next(ui + 1, nxt);
        const char* nA = has_next ? (const char*)g.A + (size_t)nxt.pm * tstepA : cA; const char* nB = has_next ? (const char*)g.Bt + (size_t)nxt.pn * tstepB : cB;
        for (int t = 0; t < nt; t += 2) {
            const bool last = (t == nt - 2);
            const char* a1 = cA + (size_t)(t + 1) * kstep;
            const char* a2 = last ? nA : cA + (size_t)(t + 2) * kstep; const char* b2 = last ? nB : cB + (size_t)(t + 2) * kstep;
            const char* a3 = a2 + kstep; const char* b3 = b2 + kstep;
            if (last && has_next) S.a_ready(nxt);
            if constexpr (SP2) {
            PG8_LDB(B0, 0, 0); PG8_LDB(B1, 0, 1); PG8_SCHED; PG8_LDA(At, 0, 0); PG8_STAGE(PG8_SA(1, 1), a1 + hstepA, voffA);
            PG8_WAIT_V(8); PG8_WAIT_L(0); PG8_BAR; PG8_MMA(0, 0, At, B0); PG8_MMA(0, 1, At, B1); PG8_BAR; PG8_SCHED;
            PG8_LDA(At, 0, 1); PG8_STAGE(PG8_SB(0, 0), b2, voffB); PG8_STAGE(PG8_SB(0, 1), b2 + hstepB, voffB); PG8_STAGE(PG8_SA(0, 0), a2, voffA);
            PG8_WAIT_V(8); PG8_WAIT_L(0); PG8_BAR; PG8_MMA(1, 0, At, B0); PG8_MMA(1, 1, At, B1); PG8_BAR; PG8_SCHED;
            PG8_LDB(B0, 1, 0); PG8_LDB(B1, 1, 1); PG8_SCHED; PG8_LDA(At, 1, 0); PG8_STAGE(PG8_SA(0, 1), a2 + hstepA, voffA);
            PG8_WAIT_V(8); PG8_WAIT_L(0); PG8_BAR; PG8_MMA(0, 0, At, B0); PG8_MMA(0, 1, At, B1); PG8_BAR; PG8_SCHED;
            PG8_LDA(At, 1, 1); PG8_STAGE(PG8_SB(1, 0), b3, voffB); PG8_STAGE(PG8_SB(1, 1), b3 + hstepB, voffB); PG8_STAGE(PG8_SA(1, 0), a3, voffA);
            PG8_WAIT_V(8); PG8_WAIT_L(0); PG8_BAR; PG8_MMA(1, 0, At, B0); PG8_MMA(1, 1, At, B1); PG8_BAR; PG8_SCHED;
            } else {
            PG8_LDB(B0, 0, 0); PG8_SCHED; PG8_LDA(At, 0, 0); PG8_STAGE(PG8_SA(1, 1), a1 + hstepA, voffA);
            PG8_WAIT_L(8); PG8_BAR; PG8_WAIT_L(0); PG8_MMA(0, 0, At, B0); PG8_BAR; PG8_SCHED;
            PG8_LDB(B1, 0, 1); PG8_STAGE(PG8_SB(0, 0), b2, voffB);
            PG8_BAR; PG8_WAIT_L(0); PG8_MMA(0, 1, At, B1); PG8_BAR;
            PG8_LDA(At, 0, 1); PG8_STAGE(PG8_SA(0, 0), a2, voffA);
            PG8_BAR; PG8_WAIT_L(0); PG8_MMA(1, 0, At, B0); PG8_BAR; PG8_SCHED;
            PG8_STAGE(PG8_SB(0, 1), b2 + hstepB, voffB);
            PG8_WAIT_V(6); PG8_BAR; PG8_MMA(1, 1, At, B1); PG8_BAR;
            PG8_LDB(B0, 1, 0); PG8_SCHED; PG8_LDA(At, 1, 0); PG8_STAGE(PG8_SA(0, 1), a2 + hstepA, voffA);
            PG8_WAIT_L(8); PG8_BAR; PG8_WAIT_L(0); PG8_MMA(0, 0, At, B0); PG8_BAR; PG8_SCHED;
            PG8_LDB(B1, 1, 1); PG8_STAGE(PG8_SB(1, 0), b3, voffB);
            PG8_BAR; PG8_WAIT_L(0); PG8_MMA(0, 1, At, B1); PG8_BAR;
            PG8_LDA(At, 1, 1); PG8_STAGE(PG8_SA(1, 0), a3, voffA);
            PG8_BAR; PG8_WAIT_L(0); PG8_MMA(1, 0, At, B0); PG8_BAR; PG8_SCHED;
            PG8_STAGE(PG8_SB(1, 1), b3 + hstepB, voffB);
            PG8_WAIT_V(6); PG8_BAR; PG8_MMA(1, 1, At, B1); PG8_BAR;
            }
        }
        if constexpr (ALIGN_EPI) { if (wr == 0) PG8_BAR; }
        if constexpr (!Epi::AFTER_DRAIN) { E(acc, cur, wr, wc, fr, fq); S.done(cur); }
        if (!has_next) break;
#pragma unroll
        for (int a = 0; a < 2; ++a)
#pragma unroll
            for (int b = 0; b < 2; ++b)
#pragma unroll
                for (int m = 0; m < 4; ++m)
#pragma unroll
                    for (int n = 0; n < 2; ++n) acc[a][b][m][n] = (f32x4){0.f, 0.f, 0.f, 0.f};
        cur = nxt; cA = nA; cB = nB; ++ui;
        if constexpr (ALIGN_EPI) { if (wr == 1) PG8_BAR; }
    }
    PG8_WAIT_V(0);
    if constexpr (!ALIGN_EPI) { if (wr == 0) PG8_BAR; }
    PG8_BAR;
    if constexpr (Epi::AFTER_DRAIN) { E.fused(acc, cur, wr, wc, fr, fq, lds, wid, lane); S.done(cur); }
#undef PG8_SA
#undef PG8_SB
#undef PG8_STAGE
#undef PG8_LDA
#undef PG8_LDB
#undef PG8_MMA
#undef PG8_WAIT_V
#undef PG8_WAIT_L
#undef PG8_BAR
#undef PG8_SCHED
}
}

__device__ __forceinline__ GemmArgs mk_gemm(const h16* A, int lda, const h16* Bt, int ldb, int M, int N, int K, int ans, int mode, h16* c16, int ldc16, float* c32, int ldc32, const float* resid) {
    GemmArgs g; g.A = A; g.lda = lda; g.Bt = Bt; g.ldb = ldb; g.M = M; g.N = N; g.K = K; g.a_ntile_stride = ans; g.mode = mode; g.c16 = c16; g.ldc16 = ldc16; g.c32 = c32; g.ldc32 = ldc32; g.resid = resid; g.aux = nullptr; return g;
}

__device__ __forceinline__ void run_phase(PRef p, int ph, char* smem) {
    if (ph == 1 || ph == 4 || ph == 6 || ph == 10 || ph == 14 || ph == 16) {
        PG8_LAS unsigned char* lds = (PG8_LAS unsigned char*)dyn_lds;
        const int G = (int)gridDim.x, c = (int)blockIdx.x;
        pg8::StaticOrder S;
        typedef const pg8::bf16_t* bp;
        if (ph == 1) {
            { pg8::EpiEvenMain E{p.Z, p.FG, p.even_b_f}; S.init(TOK, ZLD, G, c);
              pg8::gemm_phase<pg8::EpiEvenMain, pg8::StaticOrder, true, true>(lds, pg8::Gemm{(bp)p.HN, (bp)p.WtE, TOK, ZLD, DM, DM}, S, E); }
            { pg8::EpiVt E{p.VtF, p.VtS, p.VtW}; S.init(768, TOK, G, (c + 3 * G / 4) % G);
              pg8::gemm_phase<pg8::EpiVt, pg8::StaticOrder, true, true>(lds, pg8::Gemm{(bp)p.WtV, (bp)p.HN, 768, TOK, DM, DM}, S, E); }
        } else if (ph == 4) {
            pg8::EpiResid E{p.x, p.H, DM}; S.init(TOK, DM, G, c);
            pg8::gemm_phase<pg8::EpiResid, pg8::StaticOrder, true, true>(lds, pg8::Gemm{(bp)p.O, (bp)p.WtEo, TOK, DM, DM, DM}, S, E);
        } else if (ph == 14) {
            pg8::EpiResid E{p.H, p.H, DM}; S.init(TOK, DM, G, c);
            pg8::gemm_phase<pg8::EpiResid, pg8::StaticOrder, true, true>(lds, pg8::Gemm{(bp)(p.Z2 + DRNN), (bp)p.WtOo, TOK, DM, DRNN, Z2LD}, S, E);
        } else if (ph == 10) {
            pg8::EpiH16 E{p.Z2, Z2LD}; S.init(TOK, Z2LD, G, c);
            pg8::gemm_phase<pg8::EpiH16, pg8::StaticOrder, true, true>(lds, pg8::Gemm{(bp)p.HN, (bp)p.WtO, TOK, Z2LD, DM, DM}, S, E);
        } else {
            pg8::EpiH16 E{p.SC, TOK}; S.init(2048, TOK, G, c);
            pg8::gemm_phase<pg8::EpiH16, pg8::StaticOrder, true, true>(lds, pg8::Gemm{(bp)(p.WtQ + (ph == 16 ? (size_t)2048 * 1024 : 0)), (bp)p.HN, 2048, TOK, DM, DM}, S, E);
        }
        return;
    }
    if (ph == 0) phase_prep(p, smem);
    else if (ph == 2) phase_cumsum_compress(p, smem);
    else if (ph == 3) phase_attention(p, smem);
    else if (ph == 5 || ph == 15) phase_rmsnorm(p, ph == 5 ? p.ffn_norm_g : p.ffn_norm_g + DM);
    else if (ph == 8 || ph == 18) phase_peer_topk(p, smem);
    else if (ph == 9 || ph == 19) phase_peer_experts(p, ph == 19 ? 1 : 0, ph == 19 ? p.final_g : p.odd_norm_g, ph == 19 ? 1 : 0, smem);
    else if (ph == 11) phase_rnn_gates(p, smem);
    else if (ph == 13) phase_rnn_scan_b(p);
}

__global__ void __launch_bounds__(512, 2) mega(Params p_by_value) {
    char* smem = dyn_lds + hidx_() * 65536;
    volatile LAS unsigned* hs_all = (volatile LAS unsigned*)(dyn_lds + 131072);
    const __attribute__((address_space(4))) Params* kp = (const __attribute__((address_space(4))) Params*)__builtin_amdgcn_kernarg_segment_ptr();
    const int ph0 = (int)kp->ph0, ph1 = (int)kp->ph1;
    if (threadIdx.x < 12) hs_all[threadIdx.x] = 0u;
    __syncthreads();
    XcdBarrier xb = xcd_barrier_post(kp->BAR, hs_all + 8);
    for (int ph = ph0; ph < ph1; ++ph) {
        if (ph == 12 || ph == 7 || ph == 17) continue;
        const __attribute__((address_space(4))) Params* q = kp;
        asm volatile("" : "+s"(q));
        PRef p = *q;
#if PROBE_PH >= 0
        if (blockIdx.x == 0 && threadIdx.x == 0) p.TS[ph] = __builtin_amdgcn_s_memrealtime();
#endif
        const int reps = ((DUP_MASK >> ph) & 1) ? 2 : 1;
        for (int r = 0; r < reps; ++r) { run_phase(p, ph, smem); if (r + 1 < reps) xcd_barrier(xb); }
        if (ph + 1 < ph1) xcd_barrier(xb);
    }
    PRef p = *kp;
#if PROBE_PH >= 0
    cg::this_grid().sync();
    if (blockIdx.x == 0 && threadIdx.x == 0) { p.TS[NPHASE] = __builtin_amdgcn_s_memrealtime(); __threadfence(); }
    cg::this_grid().sync();
    {
        const unsigned long long t0 = __hip_atomic_load(&p.TS[0], __ATOMIC_RELAXED, __HIP_MEMORY_SCOPE_AGENT), t1 = __hip_atomic_load(&p.TS[NPHASE], __ATOMIC_RELAXED, __HIP_MEMORY_SCOPE_AGENT);
        const unsigned long long a = __hip_atomic_load(&p.TS[PROBE_PH], __ATOMIC_RELAXED, __HIP_MEMORY_SCOPE_AGENT), b = __hip_atomic_load(&p.TS[PROBE_PH + PROBE_N], __ATOMIC_RELAXED, __HIP_MEMORY_SCOPE_AGENT);
        const float frac = (float)(b - a) / (float)(t1 - t0);
        const float scale = 1.1f + frac;
        for (size_t i = (size_t)blockIdx.x * 512 + threadIdx.x; i < (size_t)TOK * DM; i += (size_t)gridDim.x * 512) p.out[i] *= scale;
    }
#endif
}

constexpr int DYN_LDS_BYTES = 131072 + 64;
extern "C" void kernel_launch(void* const* d_in, const int* in_sizes, int n_in, void* d_out, int out_size, void* d_ws, size_t ws_size, hipStream_t stream) {
    Params p; memset(&p, 0, sizeof(p));
    const float* const* in = (const float* const*)d_in;
    p.x = in[0]; p.even_norm_g = in[1]; p.even_w_in = in[2]; p.even_b_f = in[3]; p.even_cmp_pos = in[4]; p.even_w_cmp_k = in[5]; p.even_w_cmp_v = in[6]; p.even_w_out = in[7];
    p.odd_norm_g = in[8]; p.odd_w_in = in[9]; p.odd_conv_w = in[10]; p.odd_conv_b = in[11]; p.odd_w_ra = in[12]; p.odd_b_ra = in[13]; p.odd_w_ri = in[14]; p.odd_b_ri = in[15];
    p.odd_lam = in[16]; p.odd_w_out = in[17]; p.ffn_norm_g = in[18]; p.peer_w_q = in[19]; p.peer_sub_keys = in[20]; p.peer_u = in[21]; p.peer_v = in[22]; p.final_g = in[23];
    p.out = (float*)d_out;
    char* ws = (char*)d_ws; size_t off = 0;
    auto take = [&](size_t bytes) { char* r = ws + off; off += (bytes + 255) & ~(size_t)255; return r; };
    p.WtE = (h16*)take((size_t)ZLD * 1024 * 2); p.WtV = (h16*)take((size_t)768 * 1024 * 2); p.WtEo = (h16*)take((size_t)1024 * 1024 * 2); p.WtO = (h16*)take((size_t)2560 * 1024 * 2); p.WtOo = (h16*)take((size_t)1024 * 1280 * 2);
    p.WtQ = (h16*)take((size_t)2 * 2048 * 1024 * 2); p.Wc = (h16*)take((size_t)2 * 64 * 2048 * 2); p.Wr = (h16*)take((size_t)20 * 16384 * 2); p.Keys = (h16*)take((size_t)2 * 8 * 2 * 128 * 128 * 2);
    p.Pos16 = (h16*)take(4096); p.U8 = (unsigned char*)take((size_t)2 * 16384 * 1024); p.V8 = (unsigned char*)take((size_t)2 * 16384 * 1024);
    p.US = (float*)take((size_t)2 * 16384 * 4); p.VS = (float*)take((size_t)2 * 16384 * 4);
    p.H = (float*)take((size_t)TOK * DM * 4); p.HN = (h16*)take((size_t)TOK * DM * 2);
    const size_t scratch0 = off;
    p.Z = (h16*)take((size_t)TOK * ZLD * 2); p.VtF = (h16*)take((size_t)4 * 8 * 64 * SEQ * 2); p.VtS = (h16*)take((size_t)4 * 2 * 64 * SEQ * 2); p.VtW = (h16*)take((size_t)4 * 2 * 64 * SEQ * 2);
    p.KC = (h16*)take((size_t)8 * 256 * 64 * 2); p.VCt = (h16*)take((size_t)8 * 64 * 256 * 2); p.O = (h16*)take((size_t)TOK * DM * 2); p.FG = (float*)take((size_t)TOK * 32 * 4); p.C2 = (float*)take((size_t)32 * SEQ * 4); p.OACC = (float*)take((size_t)TOK * 512 * 4);
    size_t mx = off;
    off = scratch0;
    p.QP = (h16*)take((size_t)TOK * 2048 * 2); p.SC = (h16*)take((size_t)TOK * 2048 * 2); p.IDS = (int*)take((size_t)TOK * 128 * 4); p.GW = (float*)take((size_t)TOK * 128 * 4);
    if (off > mx) mx = off;
    off = scratch0;
    p.Z2 = (h16*)take((size_t)TOK * Z2LD * 2); p.LA = (h16*)take((size_t)TOK * DRNN * 2); p.RU = (h16*)take((size_t)TOK * DRNN * 2);
    p.AggP = (float*)take((size_t)4 * 64 * DRNN * 4); p.AggH = (float*)take((size_t)4 * 64 * DRNN * 4);
    if (off > mx) mx = off;
    off = mx; p.TS = (unsigned long long*)take(256); p.BAR = (unsigned*)take(XCD_BAR_WORDS * 4 + 256); mx = off;
    if (mx > ws_size) { fprintf(stderr, "workspace too small: need %zu have %zu\n", mx, ws_size); return; }

    static int grid_blocks = 0;
    if (!grid_blocks) {
        int dev = 0, cus = 0, per_cu = 0;
        hipGetDevice(&dev);
        hipDeviceGetAttribute(&cus, hipDeviceAttributeMultiprocessorCount, dev);
        hipFuncSetAttribute((const void*)mega, hipFuncAttributeMaxDynamicSharedMemorySize, DYN_LDS_BYTES);
        hipOccupancyMaxActiveBlocksPerMultiprocessor(&per_cu, mega, 512, DYN_LDS_BYTES);
        if (per_cu > 1) per_cu = 1;
        if (per_cu < 1) per_cu = 1;
        grid_blocks = cus * per_cu;
    }
    hipMemsetAsync(p.BAR, 0, XCD_BAR_WORDS * 4 + 256, stream);
#if SINGLE_LAUNCH
    p.ph0 = 0; p.ph1 = NPHASE;
    void* args[] = {&p};
    hipError_t e = hipLaunchCooperativeKernel((void*)mega, dim3(grid_blocks), dim3(512), args, DYN_LDS_BYTES, stream);
    if (e != hipSuccess) fprintf(stderr, "cooperative launch failed: %s (grid %d)\n", hipGetErrorString(e), grid_blocks);
#else
    for (int ph = 0; ph < NPHASE; ++ph) {
        p.ph0 = ph; p.ph1 = ph + 1;
        hipLaunchKernelGGL(mega, dim3(grid_blocks), dim3(512), DYN_LDS_BYTES, stream, p);
    }
#endif
}
```

```cpp
#include <hip/hip_runtime.h>
#include <hip/hip_cooperative_groups.h>
#include <cstdio>
#include <cstdint>
#include <cstring>
namespace cg = cooperative_groups;

#ifndef SINGLE_LAUNCH
#define SINGLE_LAUNCH 1
#endif
#ifndef PROBE_PH
#define PROBE_PH -1
#endif
#ifndef PROBE_N
#define PROBE_N 1
#endif
#ifndef DUP_MASK
#define DUP_MASK 0
#endif

typedef _Float16 h16;
typedef _Float16 half8 __attribute__((ext_vector_type(8)));
typedef _Float16 half4 __attribute__((ext_vector_type(4)));
typedef _Float16 half2v __attribute__((ext_vector_type(2)));
typedef float f32x4 __attribute__((ext_vector_type(4)));
typedef float f32x16 __attribute__((ext_vector_type(16)));
typedef unsigned long long u64;
typedef int i32x4 __attribute__((ext_vector_type(4)));
typedef float f32x2 __attribute__((ext_vector_type(2)));
typedef float f32x32 __attribute__((ext_vector_type(32)));
typedef _Float16 h16x32 __attribute__((ext_vector_type(32)));
typedef unsigned u32x6 __attribute__((ext_vector_type(6)));
typedef int i32x2 __attribute__((ext_vector_type(2)));
typedef i32x4 __attribute__((aligned(8))) i32x4_a8;

#define NTHR 256
constexpr int BATCH = 4, SEQ = 4096, DM = 1024, TOK = BATCH * SEQ;
constexpr int ZLD = 2304, Z2LD = 2560, DRNN = 1280;
constexpr int EVEN_IN = 2848;
constexpr float LOG2E = 1.4426950408889634f;
constexpr float QSCALE = 0.125f * LOG2E;
constexpr float NEGBIG = -1.0e30f;
constexpr int KST = 72;
constexpr int NPHASE = 20;
constexpr int XCD_BAR_WORDS_C = 3456;

struct Params {
    const float *x, *even_norm_g, *even_w_in, *even_b_f, *even_cmp_pos, *even_w_cmp_k, *even_w_cmp_v, *even_w_out;
    const float *odd_norm_g, *odd_w_in, *odd_conv_w, *odd_conv_b, *odd_w_ra, *odd_b_ra, *odd_w_ri, *odd_b_ri, *odd_lam, *odd_w_out;
    const float *ffn_norm_g, *peer_w_q, *peer_sub_keys, *peer_u, *peer_v, *final_g;
    float* out;
    h16 *WtE, *WtV, *WtEo, *WtO, *WtOo, *WtQ, *Wc, *Wr, *Keys, *Pos16;
    unsigned char *U8, *V8; float *US, *VS;
    float* H; h16* HN;
    h16 *Z, *VtF, *VtS, *VtW, *KC, *VCt, *O; float *FG, *C2, *OACC;
    h16* QP; h16* SC; int* IDS; float* GW;
    h16* Z2; h16 *LA, *RU; float *AggP, *AggH;
    unsigned long long* TS; unsigned* BAR;
    long long ph0, ph1;
};

typedef const __attribute__((address_space(4))) Params& PRef;
extern __shared__ __attribute__((aligned(16))) char dyn_lds[];
#define GRIDV ((int)gridDim.x * 2)
#define LAS __attribute__((address_space(3)))
__device__ __forceinline__ int hidx_() { return __builtin_amdgcn_readfirstlane((int)threadIdx.x >> 8); }
__device__ __forceinline__ int tidx_() { int t = threadIdx.x & 255; asm volatile("" : "+v"(t)); return t; }
__device__ __forceinline__ int bidx_() { int b = blockIdx.x * 2 + hidx_(); asm volatile("" : "+s"(b)); return b; }
__device__ __forceinline__ int widx_() { return __builtin_amdgcn_readfirstlane(((int)threadIdx.x >> 6) & 3); }
__device__ __forceinline__ void hsync() {
    volatile LAS unsigned* w = (volatile LAS unsigned*)(dyn_lds + 131072 + hidx_() * 16);
    asm volatile("s_waitcnt lgkmcnt(0)" ::: "memory");
    if ((threadIdx.x & 63) == 0) {
        const unsigned old = __hip_atomic_fetch_add((LAS unsigned*)w, 1u, __ATOMIC_RELAXED, __HIP_MEMORY_SCOPE_WORKGROUP);
        const unsigned target = (old | 3u) + 1u;
        while ((int)(w[0] - target) < 0) { }
    }
    asm volatile("s_waitcnt lgkmcnt(0)" ::: "memory");
}

__device__ __forceinline__ float wave_sum(float v) {
#pragma unroll
    for (int o = 32; o > 0; o >>= 1) v += __shfl_xor(v, o);
    return v;
}
__device__ __forceinline__ int mbcnt64(u64 m) { return __builtin_amdgcn_mbcnt_hi((unsigned)(m >> 32), __builtin_amdgcn_mbcnt_lo((unsigned)m, 0)); }
__device__ __forceinline__ float gelu_exact(float v) { return 0.5f * v * (1.0f + erff(v * 0.70710678118654752f)); }
__device__ __forceinline__ float sigmoidf_(float v) { return 1.0f / (1.0f + __expf(-v)); }
__device__ __forceinline__ float log_sigmoid(float v) { return v >= 0.f ? -log1pf(expf(-v)) : v - log1pf(expf(v)); }
__device__ __forceinline__ int crow(int r, int hi) { return (r & 3) + 8 * (r >> 2) + 4 * hi; }
__device__ __forceinline__ f32x16 zero16() { f32x16 z;
#pragma unroll
    for (int i = 0; i < 16; ++i) z[i] = 0.f; return z; }

__device__ __forceinline__ void rms_write_h16(const float (&v)[16], const float* __restrict__ g, h16* __restrict__ dst, int lane) {
    float ss = 0.f;
#pragma unroll
    for (int i = 0; i < 16; ++i) ss += v[i] * v[i];
    ss = wave_sum(ss);
    const float rstd = rsqrtf(ss * (1.0f / 1024.0f) + 1e-6f);
#pragma unroll
    for (int hseg = 0; hseg < 2; ++hseg) {
        const int c0 = hseg * 512 + lane * 8;
        const f32x4 g0 = *(const f32x4*)(g + c0), g1 = *(const f32x4*)(g + c0 + 4);
        half8 o;
#pragma unroll
        for (int i = 0; i < 4; ++i) { o[i] = (h16)(v[hseg * 8 + i] * rstd * g0[i]); o[4 + i] = (h16)(v[hseg * 8 + 4 + i] * rstd * g1[i]); }
        *(half8*)(dst + c0) = o;
    }
}
__device__ __forceinline__ void load_row16(const float* __restrict__ src, float (&v)[16], int lane) {
#pragma unroll
    for (int hseg = 0; hseg < 2; ++hseg) {
        const int c0 = hseg * 512 + lane * 8;
        const f32x4 a = *(const f32x4*)(src + c0), b = *(const f32x4*)(src + c0 + 4);
#pragma unroll
        for (int i = 0; i < 4; ++i) { v[hseg * 8 + i] = a[i]; v[hseg * 8 + 4 + i] = b[i]; }
    }
}

__device__ __forceinline__ int even_col_map(int n, int kind) {
    if (kind == 2) {
        if (n < 512) return 1024 + n;
        if (n < 640) return 2056 + 3 * 128 + (n - 512);
        return 2056 + 5 * 128 + (n - 640);
    }
    if (n < 1024) return n;
    if (n < 1536) return 1544 + (n - 1024);
    if (n < 1664) return 2056 + (n - 1536);
    if (n < 1792) return 2056 + 128 + (n - 1664);
    if (n < 1920) return 2056 + 256 + (n - 1792);
    if (n < 2048) return 2056 + 512 + (n - 1920);
    if (n < 2056) return 1536 + (n - 2048);
    if (n < 2080) return 2824 + (n - 2056);
    return -1;
}
__device__ __forceinline__ void transpose_job(const float* __restrict__ src, int K, int N, h16* __restrict__ dst, int Ndst, int mapped, float* tileS, int& base, int b0) {
    const int tid = tidx_(), nb = (int)GRIDV - b0, bid = bidx_() - b0;
    const int nkt = K / 64, nnt = Ndst / 64, ntiles = nkt * nnt;
    int first = (bid - (base % nb) + nb) % nb;
    for (int tile = first; tile < ntiles; tile += nb) {
        const int k0 = (tile % nkt) * 64, n0 = (tile / nkt) * 64;
#pragma unroll
        for (int i = 0; i < 16; ++i) {
            const int e = tid + 256 * i, kk = e >> 6, nn = e & 63;
            const int sc = mapped ? even_col_map(n0 + nn, mapped) : (n0 + nn);
            tileS[kk * 65 + nn] = (sc >= 0) ? src[(size_t)(k0 + kk) * N + sc] : 0.f;
        }
        hsync();
        const int n = tid >> 2, ks = (tid & 3) * 16;
        half8 o0, o1;
#pragma unroll
        for (int i = 0; i < 8; ++i) { o0[i] = (h16)tileS[(ks + i) * 65 + n]; o1[i] = (h16)tileS[(ks + 8 + i) * 65 + n]; }
        h16* d = dst + (size_t)(n0 + n) * K + k0 + ks;
        *(half8*)d = o0; *(half8*)(d + 8) = o1;
        hsync();
    }
    base += ntiles;
}
__device__ __forceinline__ void convert_job(const float* __restrict__ src, h16* __restrict__ dst, size_t n) {
    const size_t n4 = n / 4, stride = (size_t)GRIDV * NTHR;
    for (size_t i = (size_t)bidx_() * NTHR + tidx_(); i < n4; i += stride) {
        const f32x4 v = *(const f32x4*)(src + 4 * i);
        half4 o; o[0] = (h16)v[0]; o[1] = (h16)v[1]; o[2] = (h16)v[2]; o[3] = (h16)v[3];
        *(half4*)(dst + 4 * i) = o;
    }
}
constexpr int ROW6 = 768;
template <int NP>
__device__ __forceinline__ void fp6_rows(const float* __restrict__ src, unsigned char* __restrict__ dst, float* __restrict__ scl, const int (&rps)[NP], int lane) {
    const int hh = lane >> 5, g = lane & 31;
    f32x4 v[NP][8];
#pragma unroll
    for (int q = 0; q < NP; ++q)
#pragma unroll
        for (int c = 0; c < 8; ++c) v[q][c] = *(const f32x4*)(src + (size_t)(rps[q] * 2 + hh) * 1024 + c * 128 + g * 4);
#pragma unroll
    for (int q = 0; q < NP; ++q) {
        float am = 0.f;
#pragma unroll
        for (int c = 0; c < 8; ++c) am = fmaxf(am, fmaxf(fmaxf(fabsf(v[q][c][0]), fabsf(v[q][c][1])), fmaxf(fabsf(v[q][c][2]), fabsf(v[q][c][3]))));
#pragma unroll
        for (int o = 16; o > 0; o >>= 1) am = fmaxf(am, __shfl_xor(am, o));
        const float sc = am > 0.f ? am * (1.0f / 7.5f) : 1.0f, inv = 1.0f / sc;
        h16x32 hv;
#pragma unroll
        for (int c = 0; c < 8; ++c)
#pragma unroll
            for (int j = 0; j < 4; ++j) hv[4 * c + j] = (h16)(v[q][c][j] * inv);
        const u32x6 pk = __builtin_amdgcn_cvt_scalef32_pk32_fp6_f16(hv, 1.0f);
        unsigned char* o = dst + (size_t)(rps[q] * 2 + hh) * ROW6 + g * 24;
        *(i32x4_a8*)o = (i32x4){(int)pk[0], (int)pk[1], (int)pk[2], (int)pk[3]};
        *(i32x2*)(o + 16) = (i32x2){(int)pk[4], (int)pk[5]};
        if (g == 0) scl[rps[q] * 2 + hh] = sc;
    }
}
__device__ __forceinline__ void fp6_rows_job(const float* __restrict__ src, unsigned char* __restrict__ dst, float* __restrict__ scl, int npairs, int wv0) {
    const int lane = tidx_() & 63, wv = bidx_() * 4 + widx_() - wv0, nwv = GRIDV * 4 - wv0;
    if (wv < 0) return;
    int r = wv;
    for (; r + nwv < npairs; r += 2 * nwv) { const int rps[2] = {r, r + nwv}; fp6_rows<2>(src, dst, scl, rps, lane); }
    for (; r < npairs; r += nwv) { const int rps[1] = {r}; fp6_rows<1>(src, dst, scl, rps, lane); }
}
__device__ __forceinline__ void weight_jobs(PRef p, char* smem, bool first_only, int b0) {
    float* tileS = (float*)smem;
    int base = 0;
    const int jlo = 0, jhi = 28;
    for (int job = jlo; job < jhi; ++job) {
        if (first_only != (job == 0 || job == 4 || job == 6 || job == 7)) continue;
        const float* src; int K, N, Nd; h16* dst; int mapped = 0;
        if (job == 0) { src = p.even_w_in; K = 1024; N = EVEN_IN; dst = p.WtE; Nd = ZLD; mapped = 1; }
        else if (job == 1) { src = p.even_w_out; K = 1024; N = 1024; dst = p.WtEo; Nd = 1024; }
        else if (job == 2) { src = p.odd_w_in; K = 1024; N = 2560; dst = p.WtO; Nd = 2560; }
        else if (job == 3) { src = p.odd_w_out; K = 1280; N = 1024; dst = p.WtOo; Nd = 1024; }
        else if (job == 4) { src = p.even_w_in; K = 1024; N = EVEN_IN; dst = p.WtV; Nd = 768; mapped = 2; }
        else if (job == 5) continue;
        else if (job == 6) { src = p.even_w_cmp_k; K = 2048; N = 64; dst = p.Wc; Nd = 64; }
        else if (job == 7) { src = p.even_w_cmp_v; K = 2048; N = 64; dst = p.Wc + 64 * 2048; Nd = 64; }
        else if (job < 18) { const int n = job - 8; src = p.odd_w_ra + n * 16384; K = 128; N = 128; dst = p.Wr + n * 16384; Nd = 128; }
        else { const int n = job - 18; src = p.odd_w_ri + n * 16384; K = 128; N = 128; dst = p.Wr + (10 + n) * 16384; Nd = 128; }
        transpose_job(src, K, N, dst, Nd, mapped, tileS, base, b0);
    }
}
__device__ __forceinline__ void phase_prep(PRef p, char* smem) {
    weight_jobs(p, smem, true, 0);
    convert_job(p.peer_sub_keys, p.Keys, (size_t)2 * 8 * 2 * 128 * 128);
    convert_job(p.even_cmp_pos, p.Pos16, 2048);
    const int lane = tidx_() & 63, wv = bidx_() * 4 + widx_(), nwv = GRIDV * 4;
    for (int row = wv; row < TOK; row += nwv) {
        float v[16]; load_row16(p.x + (size_t)row * DM, v, lane);
        rms_write_h16(v, p.even_norm_g, p.HN + (size_t)row * DM, lane);
    }
}

enum { EPI_EVEN_IN = 0, EPI_F32_RESID = 1, EPI_H16 = 2, EPI_F32T = 3, EPI_QSCORE = 4 };
struct GemmArgs {
    const h16* A; int lda; const h16* Bt; int ldb; int M, N, K; int a_ntile_stride;
    int mode; h16* c16; int ldc16; float* c32; int ldc32; const float* resid; const h16* aux;
};
template <int MODE, int LDC>
__device__ __forceinline__ void gemm_epilogue(PRef p, const GemmArgs& g, int mt, int nt, bool sw, const f32x4 (&acc)[4][4]) {
    const int lane = tidx_() & 63, wid = widx_(), wm = wid >> 1, wn = wid & 1;
    const int l4 = (lane >> 4) * 4, l15 = lane & 15;
    if (MODE == EPI_EVEN_IN) {
        int kind;
        if (nt < 4 || (nt >= 12 && nt < 16)) kind = 0; else if (nt >= 8 && nt < 12) kind = 2; else if (nt == 19) kind = 3; else if (nt == 21) kind = 4; else if (nt == 22) kind = 5; else kind = 1;
#pragma unroll
        for (int i = 0; i < 4; ++i)
#pragma unroll
            for (int j = 0; j < 4; ++j) {
                const f32x4 v = acc[i][j];
                if (kind <= 1) {
                    const int row = mt * 128 + wm * 64 + j * 16 + l15, col = nt * 128 + wn * 64 + i * 16 + l4;
                    const float sc = kind == 0 ? QSCALE : 1.0f;
                    half4 o; o[0] = (h16)(v[0] * sc); o[1] = (h16)(v[1] * sc); o[2] = (h16)(v[2] * sc); o[3] = (h16)(v[3] * sc);
                    *(half4*)(p.Z + (size_t)row * ZLD + col) = o;
                } else if (kind <= 4) {
                    const int row = mt * 128 + wm * 64 + i * 16 + l4, col = nt * 128 + wn * 64 + j * 16 + l15;
                    const int b = row >> 12, s = row & 4095;
                    half4 o; o[0] = (h16)v[0]; o[1] = (h16)v[1]; o[2] = (h16)v[2]; o[3] = (h16)v[3];
                    h16* dst;
                    if (kind == 2) { const int c = col - 1024; dst = p.VtF + ((size_t)(b * 8 + (c >> 6)) * 64 + (c & 63)) * SEQ + s; }
                    else if (kind == 3) { const int c = col - 2432; dst = p.VtS + ((size_t)(b * 2 + (c >> 6)) * 64 + (c & 63)) * SEQ + s; }
                    else { const int c = col - 2688; dst = p.VtW + ((size_t)(b * 2 + (c >> 6)) * 64 + (c & 63)) * SEQ + s; }
                    *(half4*)dst = o;
                } else {
                    const int row = mt * 128 + wm * 64 + j * 16 + l15, c = nt * 128 + wn * 64 + i * 16 + l4 - 2816;
                    if (c < 32) {
                        f32x4 o;
                        if (c < 8) {
#pragma unroll
                            for (int q = 0; q < 4; ++q) o[q] = log_sigmoid(v[q] + p.even_b_f[c + q]) * LOG2E;
                        } else {
#pragma unroll
                            for (int q = 0; q < 4; ++q) o[q] = sigmoidf_(v[q]);
                        }
                        *(f32x4*)(p.FG + (size_t)row * 32 + c) = o;
                    }
                }
            }
    } else {
#pragma unroll
        for (int i = 0; i < 4; ++i)
#pragma unroll
            for (int j = 0; j < 4; ++j) {
                const f32x4 v = acc[i][j];
                if (MODE == EPI_F32T) {
                    const int row = mt * 128 + wm * 64 + i * 16 + l4, col = nt * 128 + wn * 64 + j * 16 + l15;
                    *(f32x4*)(g.c32 + (size_t)col * TOK + row) = v;
                } else {
                    const int row = mt * 128 + wm * 64 + j * 16 + l15, col = nt * 128 + wn * 64 + i * 16 + l4;
                    if (MODE == EPI_F32_RESID) {
                        const f32x4 r = *(const f32x4*)(g.resid + (size_t)row * LDC + col);
                        *(f32x4*)(g.c32 + (size_t)row * LDC + col) = r + v;
                    } else {
                        half4 o; o[0] = (h16)v[0]; o[1] = (h16)v[1]; o[2] = (h16)v[2]; o[3] = (h16)v[3];
                        *(half4*)(g.c16 + (size_t)row * LDC + col) = o;
                    }
                }
            }
    }
}

template <int MODE, int LDA, int LDB, int GN, int GK, int LDC, int ANS>
__device__ __forceinline__ void phase_gemm(PRef p, const GemmArgs& g, char* smem) {
    h16* As = (h16*)smem;
    h16* Bs = As + 2 * 128 * 64;
    const int tid = tidx_(), lane = tid & 63, wid = widx_(), wm = wid >> 1, wn = wid & 1;
    constexpr int nM = TOK / 128, nN = GN / 128, ntiles = nM * nN, nk = GK / 64;
    const int lr = tid >> 3, lc = tid & 7;
    const int st_off = lr * 64 + ((lc ^ ((tid >> 4) & 7)) * 8);
    const int fsw = (lane & 15) >> 1;
    const int fo0 = (lane & 15) * 64 + ((((lane >> 4)) ^ fsw) * 8), fo1 = (lane & 15) * 64 + (((4 + (lane >> 4)) ^ fsw) * 8);
    for (int tile = bidx_(); tile < ntiles; tile += GRIDV) {
        const int mt = tile / nN, nt = tile % nN;
        bool sw = (MODE != EPI_F32T);
        if (MODE == EPI_EVEN_IN) sw = !((nt >= 8 && nt < 12) || nt == 19 || nt == 21);
        const h16* Ag = g.A + (size_t)(mt * 128 + lr) * LDA + (size_t)nt * ANS + lc * 8;
        const h16* Bg = g.Bt + (size_t)(nt * 128 + lr) * LDB + lc * 8;
        constexpr size_t a32 = (size_t)32 * LDA, b32 = (size_t)32 * LDB;
        f32x4 acc[4][4];
#pragma unroll
        for (int m = 0; m < 4; ++m)
#pragma unroll
            for (int n = 0; n < 4; ++n) acc[m][n] = (f32x4){0.f, 0.f, 0.f, 0.f};
        half8 ra[4], rb[4];
#pragma unroll
        for (int i = 0; i < 4; ++i) { ra[i] = *(const half8*)(Ag + i * a32); rb[i] = *(const half8*)(Bg + i * b32); }
#pragma unroll
        for (int i = 0; i < 4; ++i) { *(half8*)(As + st_off + i * 32 * 64) = ra[i]; *(half8*)(Bs + st_off + i * 32 * 64) = rb[i]; }
        hsync();
        const int pofs = (sw ? wn : wm) * 64 * 64, qofs = (sw ? wm : wn) * 64 * 64;
        for (int kt = 0; kt < nk; ++kt) {
            const int cur = kt & 1;
            if (kt + 1 < nk) {
                const int ko = (kt + 1) * 64;
#pragma unroll
                for (int i = 0; i < 4; ++i) { ra[i] = *(const half8*)(Ag + i * a32 + ko); rb[i] = *(const half8*)(Bg + i * b32 + ko); }
            }
            const h16* Pc = (sw ? Bs : As) + cur * 128 * 64 + pofs;
            const h16* Qc = (sw ? As : Bs) + cur * 128 * 64 + qofs;
#pragma unroll
            for (int ks = 0; ks < 2; ++ks) {
                const int fo = ks ? fo1 : fo0;
                half8 pf[4], qf[4];
#pragma unroll
                for (int i = 0; i < 4; ++i) { pf[i] = *(const half8*)(Pc + i * 16 * 64 + fo); qf[i] = *(const half8*)(Qc + i * 16 * 64 + fo); }
                __builtin_amdgcn_s_setprio(1);
#pragma unroll
                for (int i = 0; i < 4; ++i)
#pragma unroll
                    for (int j = 0; j < 4; ++j) acc[i][j] = __builtin_amdgcn_mfma_f32_16x16x32_f16(pf[i], qf[j], acc[i][j], 0, 0, 0);
                __builtin_amdgcn_s_setprio(0);
            }
            if (kt + 1 < nk) {
                const int nx = (cur ^ 1) * 128 * 64;
#pragma unroll
                for (int i = 0; i < 4; ++i) { *(half8*)(As + nx + st_off + i * 32 * 64) = ra[i]; *(half8*)(Bs + nx + st_off + i * 32 * 64) = rb[i]; }
            }
            hsync();
        }
        if (MODE == EPI_QSCORE) {
            constexpr int QST = 136;
            h16* Qs = (h16*)smem;
            const int l4 = (lane >> 4) * 4, l15 = lane & 15;
#pragma unroll
            for (int i = 0; i < 4; ++i)
#pragma unroll
                for (int j = 0; j < 4; ++j) {
                    const f32x4 v = acc[i][j];
                    half4 o; o[0] = (h16)v[0]; o[1] = (h16)v[1]; o[2] = (h16)v[2]; o[3] = (h16)v[3];
                    *(half4*)(Qs + (wm * 64 + j * 16 + l15) * QST + wn * 64 + i * 16 + l4) = o;
                }
            hsync();
            f32x4 sc[4][4];
#pragma unroll
            for (int i = 0; i < 4; ++i)
#pragma unroll
                for (int j = 0; j < 4; ++j) sc[i][j] = (f32x4){0.f, 0.f, 0.f, 0.f};
            const h16* kb = g.aux + (size_t)(nt * 128 + wn * 64 + l15) * 128 + (lane >> 4) * 8;
#pragma unroll
            for (int ks = 0; ks < 4; ++ks) {
                half8 pf[4], qf[4];
#pragma unroll
                for (int i = 0; i < 4; ++i) { pf[i] = *(const half8*)(Qs + (wm * 64 + i * 16 + l15) * QST + ks * 32 + (lane >> 4) * 8); qf[i] = *(const half8*)(kb + (size_t)i * 16 * 128 + ks * 32); }
#pragma unroll
                for (int i = 0; i < 4; ++i)
#pragma unroll
                    for (int j = 0; j < 4; ++j) sc[i][j] = __builtin_amdgcn_mfma_f32_16x16x32_f16(pf[i], qf[j], sc[i][j], 0, 0, 0);
            }
#pragma unroll
            for (int i = 0; i < 4; ++i)
#pragma unroll
                for (int j = 0; j < 4; ++j) {
                    const int row = mt * 128 + wm * 64 + i * 16 + l4, col = nt * 128 + wn * 64 + j * 16 + l15;
                    *(f32x4*)(g.c32 + (size_t)col * TOK + row) = sc[i][j];
                }
            hsync();
        } else
        gemm_epilogue<MODE, LDC>(p, g, mt, nt, sw, acc);
    }
}

__device__ __forceinline__ void wp_job(PRef p, int wv0) {
    const int lane = tidx_() & 63, wv = bidx_() * 4 + widx_() - wv0, nwv = GRIDV * 4 - wv0;
    if (wv < 0) return;
    for (int u = wv; u < 1024; u += nwv) {
        const int l = u >> 9, hc = (u >> 5) & 15, kh = (u >> 4) & 1, jt = u & 15;
        const float* wq = p.peer_w_q + (size_t)l * 1024 * 2048 + (size_t)(jt * 64 + (lane & 15)) * 2048 + hc * 128 + (lane >> 4) * 8;
        const h16* ky = p.Keys + ((size_t)(l * 16 + hc) * 128 + kh * 64 + (lane & 15)) * 128 + (lane >> 4) * 8;
        f32x4 acc[4][4];
#pragma unroll
        for (int a = 0; a < 4; ++a)
#pragma unroll
            for (int b = 0; b < 4; ++b) acc[a][b] = (f32x4){0.f, 0.f, 0.f, 0.f};
#pragma unroll
        for (int ks = 0; ks < 4; ++ks) {
            half8 af[4], bf[4];
#pragma unroll
            for (int a = 0; a < 4; ++a) {
                const f32x4 w0 = *(const f32x4*)(wq + (size_t)a * 16 * 2048 + ks * 32), w1 = *(const f32x4*)(wq + (size_t)a * 16 * 2048 + ks * 32 + 4);
#pragma unroll
                for (int q = 0; q < 4; ++q) { af[a][q] = (h16)w0[q]; af[a][4 + q] = (h16)w1[q]; }
                bf[a] = *(const half8*)(ky + (size_t)a * 16 * 128 + ks * 32);
            }
#pragma unroll
            for (int a = 0; a < 4; ++a)
#pragma unroll
                for (int b = 0; b < 4; ++b) acc[a][b] = __builtin_amdgcn_mfma_f32_16x16x32_f16(af[a], bf[b], acc[a][b], 0, 0, 0);
        }
        h16* wp = p.WtQ + (size_t)l * 2048 * 1024;
#pragma unroll
        for (int a = 0; a < 4; ++a)
#pragma unroll
            for (int b = 0; b < 4; ++b) {
                const int n = hc * 128 + kh * 64 + b * 16 + (lane & 15), j0 = jt * 64 + a * 16 + (lane >> 4) * 4;
                half4 o; o[0] = (h16)acc[a][b][0]; o[1] = (h16)acc[a][b][1]; o[2] = (h16)acc[a][b][2]; o[3] = (h16)acc[a][b][3];
                *(half4*)(wp + (size_t)n * 1024 + j0) = o;
            }
    }
}
__device__ __forceinline__ void phase_cumsum_compress(PRef p, char* smem) {
    const int lane = tidx_() & 63, wid = widx_(), vb = bidx_();
    if (vb >= 256 && vb < 264) {
        const int u = (vb - 256) * 4 + wid, b = u >> 3, h = u & 7;
        const float* src = p.FG + (size_t)(b * SEQ + lane * 64) * 32 + h;
        float loc[64]; float run = 0.f;
#pragma unroll
        for (int i = 0; i < 64; ++i) { run += src[(size_t)i * 32]; loc[i] = run; }
        float incl = run;
#pragma unroll
        for (int o = 1; o < 64; o <<= 1) { const float t = __shfl_up(incl, o); if (lane >= o) incl += t; }
        const float excl = incl - run;
        float* dst = p.C2 + (size_t)(b * 8 + h) * SEQ + lane * 64;
#pragma unroll
        for (int i = 0; i < 64; ++i) dst[i] = excl + loc[i];
    }
    if (vb < 256) {
        const int cu = vb, kv = cu >> 7, bg = (cu >> 4) & 7, nt = cu & 15;
        const int b = bg >> 1, g = bg & 1;
        int n = nt * 16 + (lane & 15); const int nc = n < 255 ? n : 254;
        const h16* Ab = p.Z + (size_t)(b * SEQ + 16 * nc) * ZLD + 1536 + kv * 128 + g * 64 + (lane >> 4) * 8;
        const h16* Wb = p.Wc + (size_t)kv * 64 * 2048 + (size_t)(lane & 15) * 2048 + (lane >> 4) * 8;
        const h16* Pb = p.Pos16 + (lane >> 4) * 8;
        f32x4 acc[4];
#pragma unroll
        for (int e = 0; e < 4; ++e) acc[e] = (f32x4){0.f, 0.f, 0.f, 0.f};
#pragma unroll
        for (int k2 = 0; k2 < 16; ++k2) {
            const int ks = wid * 16 + k2, l = ks >> 1, d0 = (ks & 1) * 32;
            half8 a = *(const half8*)(Ab + (size_t)l * ZLD + d0);
            const half8 ps = *(const half8*)(Pb + ks * 32);
            a = a + ps;
#pragma unroll
            for (int e = 0; e < 4; ++e) {
                const half8 w = *(const half8*)(Wb + (size_t)e * 16 * 2048 + ks * 32);
                acc[e] = __builtin_amdgcn_mfma_f32_16x16x32_f16(a, w, acc[e], 0, 0, 0);
            }
        }
        f32x4* part = (f32x4*)smem;
#pragma unroll
        for (int e = 0; e < 4; ++e) part[(wid * 4 + e) * 64 + lane] = acc[e];
        hsync();
        {
            const int e = wid;
            const f32x4 s = (part[(0 * 4 + e) * 64 + lane] + part[(1 * 4 + e) * 64 + lane]) + (part[(2 * 4 + e) * 64 + lane] + part[(3 * 4 + e) * 64 + lane]);
            const int n0 = nt * 16 + (lane >> 4) * 4, ec = e * 16 + (lane & 15);
            if (kv == 0) {
#pragma unroll
                for (int j = 0; j < 4; ++j) p.KC[((size_t)bg * 256 + n0 + j) * 64 + ec] = (n0 + j < 255) ? (h16)s[j] : (h16)0.f;
            } else {
                half4 o;
#pragma unroll
                for (int j = 0; j < 4; ++j) o[j] = (n0 + j < 255) ? (h16)s[j] : (h16)0.f;
                *(half4*)(p.VCt + ((size_t)bg * 64 + ec) * 256 + n0) = o;
            }
        }
        hsync();
    }
    weight_jobs(p, smem, false, 0);
    wp_job(p, 0);
    fp6_rows_job(p.peer_u, p.U8, p.US, 8192, 0);
    fp6_rows_job(p.peer_v, p.V8, p.VS, 8192, 0);
}

struct RowState { float m, l; f32x16 o0, o1; };
__device__ __forceinline__ void rs_reset(RowState& s) { s.m = NEGBIG; s.l = 0.f; s.o0 = zero16(); s.o1 = zero16(); }

__device__ __forceinline__ void kv_load(const h16* kb, int kst, const h16* vb, int vst, half8 (&kr)[2], half8 (&vr)[2]) {
    const int tid = tidx_();
#pragma unroll
    for (int i = 0; i < 2; ++i) {
        const int c = tid + 256 * i, row = c >> 3, cc = (c & 7) * 8;
        kr[i] = *(const half8*)(kb + (size_t)row * kst + cc);
        vr[i] = *(const half8*)(vb + (size_t)row * vst + cc);
    }
}
__device__ __forceinline__ void kv_store(h16* Ks, h16* Vs, const half8 (&kr)[2], const half8 (&vr)[2]) {
    const int tid = tidx_();
#pragma unroll
    for (int i = 0; i < 2; ++i) {
        const int c = tid + 256 * i, row = c >> 3, cc = (c & 7) * 8;
        *(half8*)(Ks + row * KST + cc) = kr[i];
        *(half8*)(Vs + row * KST + cc) = vr[i];
    }
}
__device__ __forceinline__ void qk_tile(const h16* Ks, const half8 (&qf)[4], f32x16 (&s)[2], int lane) {
    const int r32 = lane & 31, hh = lane >> 5;
#pragma unroll
    for (int kt = 0; kt < 2; ++kt) {
        s[kt] = zero16();
#pragma unroll
        for (int ks = 0; ks < 4; ++ks) {
            const half8 kf = *(const half8*)(Ks + (kt * 32 + r32) * KST + ks * 16 + hh * 8);
            s[kt] = __builtin_amdgcn_mfma_f32_32x32x16_f16(kf, qf[ks], s[kt], 0, 0, 0);
        }
    }
}
__device__ __forceinline__ void pv_tile(const h16* Vs, const f32x16 (&pr)[2], f32x16& o0, f32x16& o1, int lane) {
    const int r32 = lane & 31, hh = lane >> 5;
#pragma unroll
    for (int kt = 0; kt < 2; ++kt)
#pragma unroll
        for (int s2 = 0; s2 < 2; ++s2) {
            half8 pf;
#pragma unroll
            for (int j = 0; j < 8; ++j) pf[j] = (h16)pr[kt][8 * s2 + j];
            const int kof = kt * 32 + 16 * s2 + 4 * hh;
            {
                const half4 a = *(const half4*)(Vs + r32 * KST + kof), b = *(const half4*)(Vs + r32 * KST + kof + 8);
                half8 vf; vf[0] = a[0]; vf[1] = a[1]; vf[2] = a[2]; vf[3] = a[3]; vf[4] = b[0]; vf[5] = b[1]; vf[6] = b[2]; vf[7] = b[3];
                o0 = __builtin_amdgcn_mfma_f32_32x32x16_f16(vf, pf, o0, 0, 0, 0);
            }
            {
                const half4 a = *(const half4*)(Vs + (32 + r32) * KST + kof), b = *(const half4*)(Vs + (32 + r32) * KST + kof + 8);
                half8 vf; vf[0] = a[0]; vf[1] = a[1]; vf[2] = a[2]; vf[3] = a[3]; vf[4] = b[0]; vf[5] = b[1]; vf[6] = b[2]; vf[7] = b[3];
                o1 = __builtin_amdgcn_mfma_f32_32x32x16_f16(vf, pf, o1, 0, 0, 0);
            }
        }
}

enum { M_FOX = 0, M_SLC = 1, M_WIN = 2 };
template <int MODE, bool MASKED>
__device__ __forceinline__ void flash_step(const h16* Ks, const h16* Vs, const float* csS, const half8 (&qf)[4], RowState& st,
                                           int t, int kpos0, float slope2, float ct2, bool selbit, int lane) {
    const int hh = lane >> 5;
    f32x16 s[2];
    qk_tile(Ks, qf, s, lane);
    int dbase = t - kpos0 - 4 * hh;
    asm volatile("" : "+v"(dbase));
    const float off = (MODE == M_FOX) ? ct2 : -slope2 * (float)dbase;
    float mx = NEGBIG;
#pragma unroll
    for (int kt = 0; kt < 2; ++kt)
#pragma unroll
        for (int r = 0; r < 16; ++r) {
            const int c = kt * 32 + (r & 3) + 8 * (r >> 2);
            float v;
            if (MODE == M_FOX) v = s[kt][r] - csS[c + 4 * hh];
            else v = fmaf(slope2, (float)c, s[kt][r]);
            if (MASKED) {
                const int dist = dbase - c;
                bool valid;
                if (MODE == M_FOX) valid = dist >= 0; else if (MODE == M_SLC) valid = selbit && dist >= 0; else valid = dist >= 0 && dist < 512;
                v = valid ? v : NEGBIG;
            }
            s[kt][r] = v;
            mx = fmaxf(mx, v);
        }
    mx += off;
    mx = fmaxf(mx, __shfl_xor(mx, 32));
    const float mn = fmaxf(st.m, mx);
    const float alpha = __builtin_amdgcn_exp2f(st.m - mn);
    st.m = mn;
    const float moff = mn - off;
    float ps = 0.f;
#pragma unroll
    for (int kt = 0; kt < 2; ++kt)
#pragma unroll
        for (int r = 0; r < 16; ++r) {
            const float v = s[kt][r];
            float pe = __builtin_amdgcn_exp2f(v - moff);
            if (MASKED) pe = v > -1.0e29f ? pe : 0.f;
            s[kt][r] = pe; ps += pe;
        }
    st.l = st.l * alpha + ps;
#pragma unroll
    for (int r = 0; r < 16; ++r) { st.o0[r] *= alpha; st.o1[r] *= alpha; }
    pv_tile(Vs, s, st.o0, st.o1, lane);
}

template <int MODE>
__device__ __forceinline__ void run_flash(u64 mask, const h16* Kg, int kst, const h16* Vg, int vst, const float* csg, char* smem,
                                          const half8 (&qf)[4], RowState& st, int t, int twlo, int twhi, float slope2, float ct2, u64 sel, int lane) {
    h16* Kb = (h16*)smem; h16* Vb = Kb + 2 * 64 * KST; float* csb = (float*)(Vb + 2 * 64 * KST);
    if (mask == 0ull) return;
    half8 kr[2], vr[2]; float csr = 0.f;
    int jc = __builtin_ctzll(mask); mask &= mask - 1;
    kv_load(Kg + (size_t)jc * 64 * kst, kst, Vg + jc * 64, vst, kr, vr);
    if (MODE == M_FOX && tidx_() < 64) csr = csg[jc * 64 + tidx_()];
    kv_store(Kb, Vb, kr, vr);
    if (MODE == M_FOX && tidx_() < 64) csb[tidx_()] = csr;
    hsync();
    int buf = 0;
    for (;;) {
        int jn = -1;
        if (mask) { jn = __builtin_ctzll(mask); mask &= mask - 1; }
        if (jn >= 0) {
            kv_load(Kg + (size_t)jn * 64 * kst, kst, Vg + jn * 64, vst, kr, vr);
            if (MODE == M_FOX && tidx_() < 64) csr = csg[jn * 64 + tidx_()];
        }
        bool need = jc * 64 <= twhi;
        if (MODE == M_WIN) need = need && (jc * 64 + 63 >= twlo - 511);
        if (need) {
            const bool selbit = (sel >> jc) & 1ull;
            bool full = jc * 64 + 63 <= twlo;
            if (MODE == M_WIN) full = full && (jc * 64 > twhi - 512);
            if (MODE == M_SLC) full = full && (__ballot(selbit) == ~0ull);
            if (full) flash_step<MODE, false>(Kb + buf * 64 * KST, Vb + buf * 64 * KST, csb + buf * 64, qf, st, t, jc * 64, slope2, ct2, selbit, lane);
            else flash_step<MODE, true>(Kb + buf * 64 * KST, Vb + buf * 64 * KST, csb + buf * 64, qf, st, t, jc * 64, slope2, ct2, selbit, lane);
        }
        if (jn >= 0) {
            kv_store(Kb + (buf ^ 1) * 64 * KST, Vb + (buf ^ 1) * 64 * KST, kr, vr);
            if (MODE == M_FOX && tidx_() < 64) csb[(buf ^ 1) * 64 + tidx_()] = csr;
        }
        hsync();
        if (jn < 0) break;
        jc = jn; buf ^= 1;
    }
}

__device__ __forceinline__ void load_q(const h16* qrow, half8 (&qf)[4], int lane) {
#pragma unroll
    for (int ks = 0; ks < 4; ++ks) qf[ks] = *(const half8*)(qrow + ks * 16 + (lane >> 5) * 8);
}
__device__ __forceinline__ void store_o(h16* orow, const f32x16& o0, const f32x16& o1, int lane) {
    const int hh = lane >> 5;
#pragma unroll
    for (int rg = 0; rg < 4; ++rg) {
        half4 a, b;
#pragma unroll
        for (int j = 0; j < 4; ++j) { a[j] = (h16)o0[4 * rg + j]; b[j] = (h16)o1[4 * rg + j]; }
        *(half4*)(orow + 8 * rg + 4 * hh) = a;
        *(half4*)(orow + 32 + 8 * rg + 4 * hh) = b;
    }
}

__device__ __forceinline__ void oacc_store(float* row, const f32x16& o0, const f32x16& o1, float sc, int lane) {
    const int hh = lane >> 5;
#pragma unroll
    for (int rg = 0; rg < 4; ++rg) {
        *(f32x4*)(row + 8 * rg + 4 * hh) = (f32x4){o0[4 * rg] * sc, o0[4 * rg + 1] * sc, o0[4 * rg + 2] * sc, o0[4 * rg + 3] * sc};
        *(f32x4*)(row + 32 + 8 * rg + 4 * hh) = (f32x4){o1[4 * rg] * sc, o1[4 * rg + 1] * sc, o1[4 * rg + 2] * sc, o1[4 * rg + 3] * sc};
    }
}
__device__ __forceinline__ void oacc_add(float* row, const f32x16& o0, const f32x16& o1, float sc, int lane) {
    const int hh = lane >> 5;
#pragma unroll
    for (int rg = 0; rg < 4; ++rg) {
        f32x4 a = *(const f32x4*)(row + 8 * rg + 4 * hh), b = *(const f32x4*)(row + 32 + 8 * rg + 4 * hh);
#pragma unroll
        for (int j = 0; j < 4; ++j) { a[j] += o0[4 * rg + j] * sc; b[j] += o1[4 * rg + j] * sc; }
        *(f32x4*)(row + 8 * rg + 4 * hh) = a; *(f32x4*)(row + 32 + 8 * rg + 4 * hh) = b;
    }
}
__device__ __forceinline__ void oacc_final(const float* row, h16* orow, const f32x16& o0, const f32x16& o1, float sc, int lane) {
    const int hh = lane >> 5;
#pragma unroll
    for (int rg = 0; rg < 4; ++rg) {
        const f32x4 a = *(const f32x4*)(row + 8 * rg + 4 * hh), b = *(const f32x4*)(row + 32 + 8 * rg + 4 * hh);
        half4 x, y;
#pragma unroll
        for (int j = 0; j < 4; ++j) { x[j] = (h16)(a[j] + o0[4 * rg + j] * sc); y[j] = (h16)(b[j] + o1[4 * rg + j] * sc); }
        *(half4*)(orow + 8 * rg + 4 * hh) = x; *(half4*)(orow + 32 + 8 * rg + 4 * hh) = y;
    }
}

__device__ __forceinline__ void fox_unit(PRef p, int b, int h, int qt, char* smem) {
    const int tid = tidx_(), lane = tid & 63, wid = widx_();
    const int q0 = qt * 128, t0w = q0 + wid * 32, t = t0w + (lane & 31);
    half8 qf[4]; load_q(p.Z + (size_t)(b * SEQ + t) * ZLD + h * 64, qf, lane);
    const float* csg = p.C2 + (size_t)(b * 8 + h) * SEQ;
    const float ct2 = csg[t];
    RowState st; rs_reset(st);
    const int jmax = (q0 + 127) >> 6;
    const u64 mask = (jmax >= 63) ? ~0ull : ((1ull << (jmax + 1)) - 1ull);
    run_flash<M_FOX>(mask, p.Z + (size_t)b * SEQ * ZLD + 512 + h * 64, ZLD, p.VtF + (size_t)(b * 8 + h) * 64 * SEQ, SEQ, csg, smem,
                     qf, st, t, t0w, t0w + 31, 0.f, ct2, 0ull, lane);
    const float lt = st.l + __shfl_xor(st.l, 32);
    const float inv = 1.0f / lt;
#pragma unroll
    for (int r = 0; r < 16; ++r) { st.o0[r] *= inv; st.o1[r] *= inv; }
    store_o(p.O + (size_t)(b * SEQ + t) * DM + h * 64, st.o0, st.o1, lane);
}

__device__ __forceinline__ void nsa_unit(PRef p, int b, int g, int qt32, char* smem) {
    const int tid = tidx_(), lane = tid & 63, wid = widx_(), hh = lane >> 5, r32 = lane & 31;
    const int t0 = qt32 * 32, t = t0 + r32, head = g * 4 + wid, bg = b * 2 + g;
    const float slope2 = exp2f(-(float)(head + 1)) * LOG2E;
    half8 qf[4]; load_q(p.Z + (size_t)(b * SEQ + t) * ZLD + 1024 + head * 64, qf, lane);
    const float* gp = p.FG + (size_t)(b * SEQ + t) * 32 + 8 + head * 3;
    const float gate_c = gp[0], gate_s = gp[1], gate_w = gp[2];
    h16* Kb = (h16*)smem; h16* Vb = Kb + 2 * 64 * KST;
    u64* selS = (u64*)(smem + 37376);
    u64* unS = selS + 32;
    float* oaccrow = p.OACC + (size_t)(b * SEQ + t) * 512 + head * 64;
    unsigned* impS = (unsigned*)(smem + 37888);
    {
        for (int i = tid; i < 32 * 64; i += NTHR) impS[i] = 0u;
        const int nsteps = ((t0 >> 4) >> 6) + 1;
        const h16* Kg = p.KC + (size_t)bg * 256 * 64; const h16* Vg = p.VCt + (size_t)bg * 64 * 256;
        float mrun = NEGBIG, lrun = 0.f;
        for (int i = 0; i < nsteps; ++i) {
            half8 kr[2], vr[2];
            kv_load(Kg + (size_t)i * 64 * 64, 64, Vg + i * 64, 256, kr, vr);
            kv_store(Kb, Vb, kr, vr);
            hsync();
            f32x16 s[2];
            qk_tile(Kb, qf, s, lane);
            float mx = NEGBIG;
            int dbase = t - 31 - 16 * (i * 64 + 4 * hh);
            asm volatile("" : "+v"(dbase));
#pragma unroll
            for (int kt = 0; kt < 2; ++kt)
#pragma unroll
                for (int r = 0; r < 16; ++r) {
                    const int dist = dbase - 16 * (kt * 32 + (r & 3) + 8 * (r >> 2));
                    float v = s[kt][r] - slope2 * (float)dist;
                    v = dist >= 0 ? v : NEGBIG;
                    s[kt][r] = v; mx = fmaxf(mx, v);
                }
            mx = fmaxf(mx, __shfl_xor(mx, 32));
            const float mn = fmaxf(mrun, mx), alpha = __builtin_amdgcn_exp2f(mrun - mn);
            mrun = mn;
            float ps = 0.f;
#pragma unroll
            for (int kt = 0; kt < 2; ++kt)
#pragma unroll
                for (int r = 0; r < 16; ++r) { const float v = s[kt][r]; ps += v > -1.0e29f ? __builtin_amdgcn_exp2f(v - mn) : 0.f; }
            lrun = lrun * alpha + ps;
            hsync();
        }
        const float lt = lrun + __shfl_xor(lrun, 32);
        const float inv = lt > 0.f ? 1.0f / lt : 0.f;
        f32x16 o0 = zero16(), o1 = zero16();
        float carry = 0.f;
        for (int i = 0; i < nsteps; ++i) {
            half8 kr[2], vr[2];
            kv_load(Kg + (size_t)i * 64 * 64, 64, Vg + i * 64, 256, kr, vr);
            kv_store(Kb, Vb, kr, vr);
            hsync();
            f32x16 s[2];
            qk_tile(Kb, qf, s, lane);
            int dbase = t - 31 - 16 * (i * 64 + 4 * hh);
            asm volatile("" : "+v"(dbase));
#pragma unroll
            for (int kt = 0; kt < 2; ++kt)
#pragma unroll
                for (int r = 0; r < 16; ++r) {
                    const int dist = dbase - 16 * (kt * 32 + (r & 3) + 8 * (r >> 2));
                    const float v = s[kt][r] - slope2 * (float)dist;
                    s[kt][r] = dist >= 0 ? __builtin_amdgcn_exp2f(v - mrun) * inv : 0.f;
                }
            float R[2][4];
#pragma unroll
            for (int kt = 0; kt < 2; ++kt)
#pragma unroll
                for (int rg = 0; rg < 4; ++rg) R[kt][rg] = __shfl_xor(s[kt][4 * rg + 3], 32);
#pragma unroll
            for (int kt = 0; kt < 2; ++kt)
#pragma unroll
                for (int rg = 0; rg < 4; ++rg) {
                    const float G = (s[kt][4 * rg] + s[kt][4 * rg + 1]) + (s[kt][4 * rg + 2] + s[kt][4 * rg + 3]);
                    const float prev = (kt == 0 && rg == 0) ? carry : (rg > 0 ? R[kt][rg - 1] : R[kt - 1][3]);
                    const float val = G + (hh ? R[kt][rg] : prev);
                    const int j = 16 * i + 8 * kt + 2 * rg + hh;
                    atomicAdd(&impS[r32 * 64 + j], (unsigned)(val * 67108864.0f + 0.5f));
                }
            carry = R[1][3];
            pv_tile(Vb, s, o0, o1, lane);
            hsync();
        }
        oacc_store(oaccrow, o0, o1, gate_c, lane);
    }
    hsync();
    {
        u64 un = 0ull;
        for (int i = 0; i < 8; ++i) {
            const int tok = wid * 8 + i, tt = t0 + tok, cur = tt >> 6;
            const int j = lane;
            const bool valid = j <= cur;
            const bool forced = (j == 0) || (j == cur) || (j == cur - 1);
            const unsigned key = valid ? impS[tok * 64 + j] + (forced ? 0x40000000u : 0u) : 0u;
            int rank = 0;
            for (int jj = 0; jj < 64; ++jj) {
                const unsigned kv = (unsigned)__builtin_amdgcn_readlane((int)key, jj);
                rank += (kv > key || (kv == key && jj < j)) ? 1 : 0;
            }
            const u64 selm = __ballot(valid && rank < 16);
            if (lane == 0) selS[tok] = selm;
            un |= selm;
        }
        if (lane == 0) unS[wid] = un;
    }
    hsync();
    const u64 mysel = selS[r32];
    const u64 un = unS[0] | unS[1] | unS[2] | unS[3];
    hsync();
    {
        RowState st; rs_reset(st);
        run_flash<M_SLC>(un, p.Z + (size_t)b * SEQ * ZLD + 1792 + g * 64, ZLD, p.VtS + (size_t)bg * 64 * SEQ, SEQ, nullptr, smem,
                         qf, st, t, t0, t0 + 31, slope2, 0.f, mysel, lane);
        const float lt = st.l + __shfl_xor(st.l, 32);
        oacc_add(oaccrow, st.o0, st.o1, gate_s / lt, lane);
    }
    {
        RowState st; rs_reset(st);
        const int lo = t0 - 511, jlo = lo > 0 ? (lo >> 6) : 0, jhi = (t0 + 31) >> 6;
        u64 mask = (jhi >= 63 ? ~0ull : ((1ull << (jhi + 1)) - 1ull)) & ~((1ull << jlo) - 1ull);
        run_flash<M_WIN>(mask, p.Z + (size_t)b * SEQ * ZLD + 1920 + g * 64, ZLD, p.VtW + (size_t)bg * 64 * SEQ, SEQ, nullptr, smem,
                         qf, st, t, t0, t0 + 31, slope2, 0.f, 0ull, lane);
        const float lt = st.l + __shfl_xor(st.l, 32);
        oacc_final(oaccrow, p.O + (size_t)(b * SEQ + t) * DM + 512 + head * 64, st.o0, st.o1, gate_w / lt, lane);
    }
}

__device__ __forceinline__ void phase_attention(PRef p, char* smem) {
    int* nxt = (int*)(smem + 65536 - 16);
    for (;;) {
        if (tidx_() == 0) *nxt = (int)__hip_atomic_fetch_add(p.BAR + XCD_BAR_WORDS_C, 1u, __ATOMIC_RELAXED, __HIP_MEMORY_SCOPE_AGENT);
        hsync();
        const int q = *nxt;
        hsync();
        if (q >= 2048 + 512) break;
        if (q < 2048 && (q & 3) == 3) {
            const int c = q >> 2, rp0 = (c & 255) * 32 + widx_() * 8, lane = tidx_() & 63;
            const float* srcp = (c < 256 ? p.peer_u : p.peer_v) + (size_t)16384 * 1024;
            unsigned char* dstp = (c < 256 ? p.U8 : p.V8) + (size_t)16384 * 1024;
            float* sclp = (c < 256 ? p.US : p.VS) + 16384;
            for (int i = 0; i < 8; i += 2) { const int rps[2] = {rp0 + i, rp0 + i + 1}; fp6_rows<2>(srcp, dstp, sclp, rps, lane); }
            continue;
        }
        const int u = q < 2048 ? q - ((q + 1) >> 2) : q - 512;
        const int st = 31 - (u >> 6), w = u & 63;
        if (w & 1) { const int idx = w >> 1; nsa_unit(p, (idx & 7) >> 1, idx & 1, st * 4 + (idx >> 3), smem); }
        else { const int idx = w >> 1; fox_unit(p, idx >> 3, idx & 7, st, smem); }
    }
}

__device__ __forceinline__ void phase_rmsnorm(PRef p, const float* g) {
    const int lane = tidx_() & 63, wv = bidx_() * 4 + widx_(), nwv = GRIDV * 4;
    for (int row = wv; row < TOK; row += nwv) {
        float v[16]; load_row16(p.H + (size_t)row * DM, v, lane);
        rms_write_h16(v, g, p.HN + (size_t)row * DM, lane);
    }
}

__device__ __forceinline__ unsigned fkey(float f) { const unsigned b = __float_as_uint(f); return b ^ ((b >> 31) ? 0xFFFFFFFFu : 0x80000000u); }
__device__ __forceinline__ float fkey_inv(unsigned k) { return __uint_as_float(k ^ ((k >> 31) ? 0x80000000u : 0xFFFFFFFFu)); }
__device__ __forceinline__ void ce_desc(unsigned& a, unsigned& b) { const unsigned hi = a > b ? a : b, lo = a > b ? b : a; a = hi; b = lo; }
__device__ __forceinline__ void sort16_desc(unsigned (&k)[16]) {
#pragma unroll
    for (int size = 2; size <= 16; size <<= 1)
#pragma unroll
        for (int stride = size >> 1; stride > 0; stride >>= 1)
#pragma unroll
            for (int i = 0; i < 16; ++i) {
                const int j = i ^ stride;
                if (j > i) { if ((i & size) == 0) ce_desc(k[i], k[j]); else ce_desc(k[j], k[i]); }
            }
}
__device__ __forceinline__ void merge16_desc(unsigned (&run)[16], const unsigned (&b)[16]) {
#pragma unroll
    for (int i = 0; i < 16; ++i) run[i] = run[i] > b[15 - i] ? run[i] : b[15 - i];
#pragma unroll
    for (int stride = 8; stride > 0; stride >>= 1)
#pragma unroll
        for (int i = 0; i < 16; ++i) { const int j = i ^ stride; if (j > i) ce_desc(run[i], run[j]); }
}
__device__ __forceinline__ void list_top16(const h16* __restrict__ base, unsigned (&run)[16]) {
    h16 cur[16], nxt[16];
#pragma unroll
    for (int i = 0; i < 16; ++i) cur[i] = base[(size_t)i * TOK];
#pragma unroll 1
    for (int bt = 0; bt < 8; ++bt) {
        if (bt < 7) {
#pragma unroll
            for (int i = 0; i < 16; ++i) nxt[i] = base[(size_t)((bt + 1) * 16 + i) * TOK];
        }
        unsigned kb[16];
#pragma unroll
        for (int i = 0; i < 16; ++i) kb[i] = (fkey((float)cur[i]) & ~127u) | (unsigned)(127 - (bt * 16 + i));
        sort16_desc(kb);
        if (bt == 0) {
#pragma unroll
            for (int i = 0; i < 16; ++i) run[i] = kb[i];
        } else merge16_desc(run, kb);
#pragma unroll
        for (int i = 0; i < 16; ++i) cur[i] = nxt[i];
    }
}
__device__ __forceinline__ void phase_peer_topk(PRef p, char* smem) {
    const int tid = tidx_(), lane = tid & 63, wv = bidx_() * 4 + widx_(), nwv = GRIDV * 4;
    int* idS = (int*)smem; float* evS = (float*)smem + 16 * NTHR;
    for (int u = wv; u < 8 * (TOK / 64); u += nwv) {
        const int h = u >> 8, tk = (u & 255) * 64 + lane;
        const h16* b0 = p.SC + (size_t)(h * 256) * TOK + tk;
        unsigned k0[16], k1[16];
        list_top16(b0, k0);
        list_top16(b0 + (size_t)128 * TOK, k1);
        float v0[16], v1[16]; int i0[16], i1[16];
#pragma unroll
        for (int j = 0; j < 16; ++j) {
            v0[j] = fkey_inv(k0[j] & ~127u); i0[j] = 127 - (int)(k0[j] & 127u);
            v1[j] = fkey_inv(k1[j] & ~127u); i1[j] = 127 - (int)(k1[j] & 127u);
        }
        unsigned run[16];
        {
            unsigned kb[16]; int n = 0, nb = 0;
#pragma unroll
            for (int a = 0; a < 16; ++a)
#pragma unroll
                for (int b = 0; b < 16; ++b)
                    if ((a + 1) * (b + 1) <= 16) {
                        kb[n] = fkey(v0[a] + v1[b]); ++n;
                        if (n == 16) {
                            sort16_desc(kb);
                            if (nb == 0) {
#pragma unroll
                                for (int i = 0; i < 16; ++i) run[i] = kb[i];
                            } else merge16_desc(run, kb);
                            n = 0; ++nb;
                        }
                    }
#pragma unroll
            for (int i = 2; i < 16; ++i) kb[i] = 0u;
            sort16_desc(kb); merge16_desc(run, kb);
        }
        const unsigned tkey = run[15]; const float smax = fkey_inv(run[0]);
        int cnt = 0; float esum = 0.f;
#pragma unroll
        for (int j = 0; j < 16; ++j) { idS[j * NTHR + tid] = 0; evS[j * NTHR + tid] = 0.f; }
#pragma unroll
        for (int pass = 0; pass < 2; ++pass)
#pragma unroll
            for (int a = 0; a < 16; ++a)
#pragma unroll
                for (int b = 0; b < 16; ++b)
                    if ((a + 1) * (b + 1) <= 16) {
                        const float s = v0[a] + v1[b]; const unsigned ks = fkey(s);
                        const bool take = pass == 0 ? (ks > tkey) : (ks == tkey && cnt < 16);
                        if (take) {
                            const float e = __expf(s - smax);
                            idS[cnt * NTHR + tid] = i0[a] * 128 + i1[b]; evS[cnt * NTHR + tid] = e;
                            esum += e; ++cnt;
                        }
                    }
        const float rinv = 1.0f / esum;
        int* ip = p.IDS + (size_t)tk * 128 + h * 16; float* gp = p.GW + (size_t)tk * 128 + h * 16;
#pragma unroll
        for (int q = 0; q < 4; ++q) {
            *(i32x4*)(ip + 4 * q) = (i32x4){idS[(4 * q) * NTHR + tid], idS[(4 * q + 1) * NTHR + tid], idS[(4 * q + 2) * NTHR + tid], idS[(4 * q + 3) * NTHR + tid]};
            *(f32x4*)(gp + 4 * q) = (f32x4){evS[(4 * q) * NTHR + tid] * rinv, evS[(4 * q + 1) * NTHR + tid] * rinv, evS[(4 * q + 2) * NTHR + tid] * rinv, evS[(4 * q + 3) * NTHR + tid] * rinv};
        }
    }
}

struct Q6 { i32x4 a; i32x2 b; };
__device__ __forceinline__ Q6 ld6(const unsigned char* q) { Q6 r; r.a = *(const i32x4_a8*)q; r.b = *(const i32x2*)(q + 16); return r; }
__device__ __forceinline__ u32x6 mk6(const Q6 q) { u32x6 r; r[0] = q.a[0]; r[1] = q.a[1]; r[2] = q.a[2]; r[3] = q.a[3]; r[4] = q.b[0]; r[5] = q.b[1]; return r; }
__device__ __forceinline__ float dot32_fp6h(const h16x32 xv, const Q6 q) {
    const h16x32 uf = __builtin_amdgcn_cvt_scalef32_pk32_f16_fp6(mk6(q), 1.0f);
    float d0 = 0.f, d1 = 0.f;
#pragma unroll
    for (int m = 0; m < 16; m += 2) {
        d0 = __builtin_amdgcn_fdot2((half2v){uf[2 * m], uf[2 * m + 1]}, (half2v){xv[2 * m], xv[2 * m + 1]}, d0, false);
        d1 = __builtin_amdgcn_fdot2((half2v){uf[2 * m + 2], uf[2 * m + 3]}, (half2v){xv[2 * m + 2], xv[2 * m + 3]}, d1, false);
    }
    return d0 + d1;
}
__device__ __forceinline__ void axpy32_fp6(f32x2 (&acc)[16], float w, const Q6 q) {
    const f32x32 vf = __builtin_amdgcn_cvt_scalef32_pk32_f32_fp6(mk6(q), 1.0f);
    const f32x2 ww = {w, w};
#pragma unroll
    for (int m = 0; m < 16; ++m) acc[m] = __builtin_elementwise_fma(ww, (f32x2){vf[2 * m], vf[2 * m + 1]}, acc[m]);
}
constexpr int ET_SHIFT = 9, ET_N = 16384 >> ET_SHIFT;
__device__ __forceinline__ void phase_peer_experts(PRef p, int layer, const float* gnext, int mode, char* smem) {
    const int lane = tidx_() & 63, wid = widx_(), wv = bidx_() * 4 + wid, nwv = GRIDV * 4;
    const int hh = lane >> 5, g = lane & 31, dpl = (lane >> 2) & 7;
    const unsigned char* U = p.U8 + (size_t)layer * 16384 * 1024; const unsigned char* V = p.V8 + (size_t)layer * 16384 * 1024;
    const float* US = p.US + layer * 16384; const float* VS = p.VS + layer * 16384;
    const bool b4 = (lane & 16) != 0, b3 = (lane & 8) != 0, b2 = (lane & 4) != 0;
    int* sid = (int*)smem + wid * 512 + hh * 128;
    float* sgw = (float*)(sid + 256);
    for (int tb = wv * 2; tb < TOK; tb += nwv * 2) {
        const int tk = tb + hh;
        h16x32 xv;
#pragma unroll
        for (int c = 0; c < 8; ++c) {
            const half4 t = *(const half4*)(p.HN + (size_t)tk * DM + c * 128 + g * 4);
#pragma unroll
            for (int j = 0; j < 4; ++j) xv[4 * c + j] = t[j];
        }
        {
            int idv[4]; float gv[4];
#pragma unroll
            for (int s = 0; s < 4; ++s) { idv[s] = p.IDS[(size_t)tk * 128 + s * 32 + g]; gv[s] = p.GW[(size_t)tk * 128 + s * 32 + g]; }
            int cnt = 0;
            const unsigned below = (1u << g) - 1u;
            for (int e = 0; e < ET_N; ++e) {
#pragma unroll
                for (int s = 0; s < 4; ++s) {
                    const bool in = (idv[s] >> ET_SHIFT) == e;
                    const u64 m = __ballot(in);
                    const unsigned mh = hh ? (unsigned)(m >> 32) : (unsigned)m;
                    if (in) { const int pos = cnt + __popc(mh & below); sid[pos] = idv[s]; sgw[pos] = gv[s]; }
                    cnt += __popc(mh);
                }
            }
        }
        f32x2 acc[16];
#pragma unroll
        for (int i = 0; i < 16; ++i) acc[i] = (f32x2){0.f, 0.f};
        for (int bt = 0; bt < 16; ++bt) {
            const int mine = sid[bt * 8 + dpl]; const float gwm = sgw[bt * 8 + dpl];
            const float usm = US[mine], vsm = VS[mine];
            const i32x4 ida = *(const i32x4*)(sid + bt * 8), idb = *(const i32x4*)(sid + bt * 8 + 4);
            Q6 uq[8], vq[8];
#pragma unroll
            for (int k = 0; k < 8; ++k) {
                const unsigned off = (unsigned)(k < 4 ? ida[k & 3] : idb[k & 3]) * ROW6 + g * 24;
                uq[k] = ld6(U + off); vq[k] = ld6(V + off);
            }
            float d[8];
#pragma unroll
            for (int k = 0; k < 8; ++k) d[k] = dot32_fp6h(xv, uq[k]);
            float r4[4], r2[2], z;
#pragma unroll
            for (int i = 0; i < 4; ++i) { const float keep = b4 ? d[i + 4] : d[i], send = b4 ? d[i] : d[i + 4]; r4[i] = keep + __shfl_xor(send, 16); }
#pragma unroll
            for (int i = 0; i < 2; ++i) { const float keep = b3 ? r4[i + 2] : r4[i], send = b3 ? r4[i] : r4[i + 2]; r2[i] = keep + __shfl_xor(send, 8); }
            { const float keep = b2 ? r2[1] : r2[0], send = b2 ? r2[0] : r2[1]; z = keep + __shfl_xor(send, 4); }
            z += __shfl_xor(z, 2); z += __shfl_xor(z, 1);
            const float wm = gwm * gelu_exact(z * usm) * vsm;
#pragma unroll
            for (int k = 0; k < 8; ++k) {
                const float w0 = __builtin_bit_cast(float, __builtin_amdgcn_readlane(__builtin_bit_cast(int, wm), 4 * k));
                const float w1 = __builtin_bit_cast(float, __builtin_amdgcn_readlane(__builtin_bit_cast(int, wm), 32 + 4 * k));
                axpy32_fp6(acc, hh ? w1 : w0, vq[k]);
            }
        }
        float hv[32];
        {
            const float* hr = p.H + (size_t)tk * DM + g * 4;
#pragma unroll
            for (int c = 0; c < 8; ++c) { const f32x4 t = *(const f32x4*)(hr + c * 128); hv[4 * c] = t[0] + acc[2 * c][0]; hv[4 * c + 1] = t[1] + acc[2 * c][1]; hv[4 * c + 2] = t[2] + acc[2 * c + 1][0]; hv[4 * c + 3] = t[3] + acc[2 * c + 1][1]; }
        }
        float ss = 0.f;
#pragma unroll
        for (int i = 0; i < 32; ++i) ss += hv[i] * hv[i];
#pragma unroll
        for (int o = 16; o > 0; o >>= 1) ss += __shfl_xor(ss, o);
        const float rstd = rsqrtf(ss * (1.0f / 1024.0f) + 1e-6f);
        const float* gr = gnext + g * 4;
        if (mode == 0) {
            float* hw = p.H + (size_t)tk * DM + g * 4;
#pragma unroll
            for (int c = 0; c < 8; ++c) {
                *(f32x4*)(hw + c * 128) = (f32x4){hv[4 * c], hv[4 * c + 1], hv[4 * c + 2], hv[4 * c + 3]};
                const f32x4 ga = *(const f32x4*)(gr + c * 128);
                half4 o;
#pragma unroll
                for (int j = 0; j < 4; ++j) o[j] = (h16)(hv[4 * c + j] * rstd * ga[j]);
                *(half4*)(p.HN + (size_t)tk * DM + c * 128 + g * 4) = o;
            }
        } else {
            float* ow = p.out + (size_t)tk * DM + g * 4;
#pragma unroll
            for (int c = 0; c < 8; ++c) { const f32x4 ga = *(const f32x4*)(gr + c * 128); *(f32x4*)(ow + c * 128) = (f32x4){hv[4 * c] * rstd * ga[0], hv[4 * c + 1] * rstd * ga[1], hv[4 * c + 2] * rstd * ga[2], hv[4 * c + 3] * rstd * ga[3]}; }
        }
    }
}

constexpr int XST = 136;
__device__ __forceinline__ float fast_sigmoid(float v) { return __builtin_amdgcn_rcpf(1.0f + __expf(-v)); }
__device__ __forceinline__ float gelu_as(float v) {
    const float av = fabsf(v), t = __builtin_amdgcn_rcpf(av * 0.2316419f + 1.0f);
    float q = t * 0.5307027145f - 0.7265760135f; q = q * t + 0.7107068705f; q = q * t - 0.142248368f; q = q * t + 0.127414796f; q = q * t;
    const float e = __builtin_amdgcn_exp2f(v * v * -0.72134752044f);
    const float m = v * (q * e);
    return v < 0.f ? m : v - m;
}
__device__ __forceinline__ void phase_rnn_gates(PRef p, char* smem) {
    h16* xcS = (h16*)smem;
    float* aggS = (float*)(smem + 64 * XST * 2);
    h16* laS = (h16*)(smem + 64 * XST * 2 + 4096);
    h16* ruS = laS + 64 * XST;
    const int tid = tidx_(), lane = tid & 63, wid = widx_();
    for (int u = bidx_(); u < 4 * 64 * 10; u += GRIDV) {
        const int nb = u % 10, ck = (u / 10) & 63, b = u / 640;
        const int s0 = ck * 64, ch0 = nb * 128;
        {
            const int c8 = (tid & 15) * 8, tq = (tid >> 4) * 4, ch = ch0 + c8;
            float w[4][8], bias[8];
#pragma unroll
            for (int j = 0; j < 4; ++j) {
                const f32x4 w0 = *(const f32x4*)(p.odd_conv_w + j * DRNN + ch), w1 = *(const f32x4*)(p.odd_conv_w + j * DRNN + ch + 4);
#pragma unroll
                for (int i = 0; i < 4; ++i) { w[j][i] = w0[i]; w[j][4 + i] = w1[i]; }
            }
            { const f32x4 b0 = *(const f32x4*)(p.odd_conv_b + ch), b1 = *(const f32x4*)(p.odd_conv_b + ch + 4);
#pragma unroll
              for (int i = 0; i < 4; ++i) { bias[i] = b0[i]; bias[4 + i] = b1[i]; } }
            half8 xin[7];
#pragma unroll
            for (int r = 0; r < 7; ++r) {
                const int sp = s0 + tq - 3 + r;
                if (sp >= 0) xin[r] = *(const half8*)(p.Z2 + (size_t)(b * SEQ + sp) * Z2LD + DRNN + ch);
                else {
#pragma unroll
                    for (int i = 0; i < 8; ++i) xin[r][i] = (h16)0.f;
                }
            }
#pragma unroll
            for (int tt = 0; tt < 4; ++tt) {
                half8 o;
#pragma unroll
                for (int i = 0; i < 8; ++i) {
                    float a = bias[i];
#pragma unroll
                    for (int j = 0; j < 4; ++j) a = fmaf(w[j][i], (float)xin[tt + j][i], a);
                    o[i] = (h16)a;
                }
                *(half8*)(xcS + (tq + tt) * XST + c8) = o;
            }
        }
        hsync();
        float bra8[8], bri8[8], sp8[8];
#pragma unroll
        for (int e = 0; e < 8; ++e) {
            const int chq = ch0 + e * 16 + (lane & 15);
            bra8[e] = p.odd_b_ra[chq]; bri8[e] = p.odd_b_ri[chq];
            const float lam = p.odd_lam[chq];
            sp8[e] = lam >= 0.f ? log1pf(__expf(-lam)) : -lam + log1pf(__expf(lam));
        }
        f32x4 ar[8], ai[8];
#pragma unroll
        for (int e = 0; e < 8; ++e) { ar[e] = (f32x4){0.f, 0.f, 0.f, 0.f}; ai[e] = (f32x4){0.f, 0.f, 0.f, 0.f}; }
        const h16* wr = p.Wr + (size_t)nb * 16384 + (lane & 15) * 128 + (lane >> 4) * 8;
        const h16* wi = p.Wr + (size_t)(10 + nb) * 16384 + (lane & 15) * 128 + (lane >> 4) * 8;
#pragma unroll
        for (int ks = 0; ks < 4; ++ks) {
            const half8 a = *(const half8*)(xcS + (wid * 16 + (lane & 15)) * XST + ks * 32 + (lane >> 4) * 8);
#pragma unroll
            for (int e = 0; e < 8; ++e) {
                const half8 w1 = *(const half8*)(wr + e * 16 * 128 + ks * 32), w2 = *(const half8*)(wi + e * 16 * 128 + ks * 32);
                ar[e] = __builtin_amdgcn_mfma_f32_16x16x32_f16(a, w1, ar[e], 0, 0, 0);
                ai[e] = __builtin_amdgcn_mfma_f32_16x16x32_f16(a, w2, ai[e], 0, 0, 0);
            }
        }
        const int g4 = lane >> 4;
#pragma unroll
        for (int e = 0; e < 8; ++e) {
            const int cl = e * 16 + (lane & 15), ch = ch0 + cl;
            const float bra = bra8[e], bri = bri8[e], sp = sp8[e];
            float A = 1.f, H = 0.f;
#pragma unroll
            for (int j = 0; j < 4; ++j) {
                const int tt = wid * 16 + g4 * 4 + j;
                const float r = fast_sigmoid(ar[e][j] + bra), ig = fast_sigmoid(ai[e][j] + bri);
                const h16 la16 = (h16)(-8.0f * r * sp);
                const float a = __expf((float)la16);
                const float xc = (float)xcS[tt * XST + cl];
                const h16 u16 = (h16)(__builtin_amdgcn_sqrtf(fmaxf(1.0f - a * a, 0.f)) * (ig * xc));
                laS[tt * XST + cl] = la16; ruS[tt * XST + cl] = u16;
                H = a * H + (float)u16; A *= a;
            }
            { const float Al = __shfl_xor(A, 16), Hl = __shfl_xor(H, 16); if (g4 & 1) { H = Hl * A + H; A = Al * A; } }
            { const float Al = __shfl_xor(A, 32), Hl = __shfl_xor(H, 32); if (g4 == 3) { H = Hl * A + H; A = Al * A; } }
            if (g4 == 3) { aggS[(wid * 128 + cl) * 2] = A; aggS[(wid * 128 + cl) * 2 + 1] = H; }
        }
        hsync();
        if (tid < 128) {
            float A = 1.f, H = 0.f;
#pragma unroll
            for (int w = 0; w < 4; ++w) { const float Aw = aggS[(w * 128 + tid) * 2], Hw = aggS[(w * 128 + tid) * 2 + 1]; H = H * Aw + Hw; A *= Aw; }
            p.AggP[(size_t)(b * 64 + ck) * DRNN + ch0 + tid] = A; p.AggH[(size_t)(b * 64 + ck) * DRNN + ch0 + tid] = H;
        }
#pragma unroll
        for (int i = 0; i < 4; ++i) {
            const int q = tid + 256 * i, row = q >> 4, c8 = (q & 15) * 8;
            const size_t o = (size_t)(b * SEQ + s0 + row) * DRNN + ch0 + c8;
            *(half8*)(p.LA + o) = *(const half8*)(laS + row * XST + c8);
            *(half8*)(p.RU + o) = *(const half8*)(ruS + row * XST + c8);
        }
        hsync();
    }
}
__device__ __forceinline__ void phase_rnn_scan_b(PRef p) {
    for (int u = bidx_(); u < 4 * 64 * 5; u += GRIDV) {
        const int cb = u % 5, ck = (u / 5) & 63, b = u / 320;
        const int ch = cb * 256 + tidx_();
        float h = 0.f;
        {
            const float* ap = p.AggP + (size_t)(b * 64) * DRNN + ch; const float* hp = p.AggH + (size_t)(b * 64) * DRNN + ch;
            int c = 0;
            for (; c + 8 <= ck; c += 8) {
                float pa[8], ph[8];
#pragma unroll
                for (int i = 0; i < 8; ++i) { pa[i] = ap[(size_t)(c + i) * DRNN]; ph[i] = hp[(size_t)(c + i) * DRNN]; }
#pragma unroll
                for (int i = 0; i < 8; ++i) h = pa[i] * h + ph[i];
            }
            for (; c < ck; ++c) h = ap[(size_t)c * DRNN] * h + hp[(size_t)c * DRNN];
        }
        const size_t base = (size_t)(b * SEQ + ck * 64) * DRNN + ch;
        h16* zrow = p.Z2 + (size_t)(b * SEQ + ck * 64) * Z2LD;
#pragma unroll 1
        for (int i0 = 0; i0 < 64; i0 += 32) {
            h16 la[32], uu[32], gt[32];
#pragma unroll
            for (int i = 0; i < 32; ++i) { la[i] = p.LA[base + (size_t)(i0 + i) * DRNN]; uu[i] = p.RU[base + (size_t)(i0 + i) * DRNN]; gt[i] = zrow[(size_t)(i0 + i) * Z2LD + ch]; }
#pragma unroll
            for (int i = 0; i < 32; ++i) {
                h = __expf((float)la[i]) * h + (float)uu[i];
                zrow[(size_t)(i0 + i) * Z2LD + DRNN + ch] = (h16)(gelu_as((float)gt[i]) * h);
            }
        }
    }
}

#define XB_TMO      128
#define XB_XCNT(j)  (256  + 64 * (j))
#define XB_XSUB(j)  (1280 + 64 * (j))
#define XB_XGEN(j)  (2304 + 64 * (j))
#define XB_TOP      3328
#define XB_TOPGEN   3392
#define XCD_BAR_WORDS 3456
#define XB_SPIN_CAP (1u << 22)
__device__ __forceinline__ unsigned xb_ld(unsigned* p)              { return __hip_atomic_load(p, __ATOMIC_RELAXED, __HIP_MEMORY_SCOPE_AGENT); }
__device__ __forceinline__ unsigned xb_add(unsigned* p, unsigned v) { return __hip_atomic_fetch_add(p, v, __ATOMIC_RELAXED, __HIP_MEMORY_SCOPE_AGENT); }
__device__ __forceinline__ unsigned xb_xcc_id() { return (unsigned)__builtin_amdgcn_s_getreg((3 << 11) | 20) & 0xFu; }
#define XB_SPIN(cond, bar) do { unsigned _sp = 0; while (cond) { __builtin_amdgcn_s_sleep(1); \
    if ((++_sp & 255u) == 0u) { if (xb_ld(&(bar)[XB_TMO])) break; if (_sp > XB_SPIN_CAP) { atomicAdd(&(bar)[XB_TMO], 1u); break; } } } } while (0)
struct XcdBarrier { unsigned* bar; unsigned x; volatile LAS unsigned* st; };
__device__ __forceinline__ XcdBarrier xcd_barrier_post(unsigned* bar, volatile LAS unsigned* st) {
    XcdBarrier b; b.bar = bar; b.x = xb_xcc_id(); b.st = st;
    if (threadIdx.x == 0) (void)xb_add(&bar[XB_XCNT(b.x)], 1u);
    return b;
}
__device__ __forceinline__ void xcd_barrier_complete(unsigned* bar, unsigned x, unsigned& nloc, unsigned& nx) {
    const unsigned G = gridDim.x * gridDim.y * gridDim.z;
    unsigned sum, cnt, mine, sp = 0u;
    for (;;) {
        sum = 0u; cnt = 0u; mine = 0u;
#pragma unroll
        for (unsigned j = 0; j < 16; ++j) { const unsigned c = xb_ld(&bar[XB_XCNT(j)]); sum += c; cnt += (c > 0u) ? 1u : 0u; mine = (j == x) ? c : mine; }
        if (sum == G) break;
        __builtin_amdgcn_s_sleep(1);
        if ((++sp & 255u) == 0u) { if (xb_ld(&bar[XB_TMO])) break; if (sp > XB_SPIN_CAP) { atomicAdd(&bar[XB_TMO], 1u); break; } }
    }
    nloc = mine > 0u ? mine : 1u; nx = cnt > 0u ? cnt : 1u;
}
__device__ __forceinline__ void xcd_barrier(const XcdBarrier& b) {
    asm volatile("s_waitcnt vmcnt(0)" ::: "memory");
    __syncthreads();
    if (threadIdx.x == 0) {
        unsigned* bar = b.bar;
        __builtin_amdgcn_s_waitcnt(0);
        unsigned nloc = b.st[0], nx = b.st[1];
        if (nloc == 0u) { xcd_barrier_complete(bar, b.x, nloc, nx); b.st[0] = nloc; b.st[1] = nx; }
        const unsigned old = xb_add(&bar[XB_XSUB(b.x)], 1u);
        const unsigned gen = old / nloc;
        if (old + 1u == (gen + 1u) * nloc) {
            __builtin_amdgcn_fence(__ATOMIC_RELEASE, "agent");
            asm volatile("s_waitcnt vmcnt(0)" ::: "memory");
            const unsigned og = xb_add(&bar[XB_TOP], 1u);
            const unsigned tg = og / nx;
            if (og + 1u == (tg + 1u) * nx) xb_add(&bar[XB_TOPGEN], 1u);
            else XB_SPIN(xb_ld(&bar[XB_TOPGEN]) == tg, bar);
            __builtin_amdgcn_fence(__ATOMIC_ACQUIRE, "agent");
            xb_add(&bar[XB_XGEN(b.x)], 1u);
            asm volatile("s_waitcnt vmcnt(0)" ::: "memory");
        } else {
            XB_SPIN(xb_ld(&bar[XB_XGEN(b.x)]) == gen, bar);
            __builtin_amdgcn_fence(__ATOMIC_ACQUIRE, "agent");
            asm volatile("s_waitcnt vmcnt(0)" ::: "memory");
        }
    }
    __syncthreads();
}

namespace pg8 {
#define PG8_LAS __attribute__((address_space(3)))
typedef unsigned short bf16_t;
typedef short bf16x8 __attribute__((ext_vector_type(8)));
typedef unsigned u32x4 __attribute__((ext_vector_type(4)));
constexpr int BM = 256, BK = 64, HALF = 128, HTB = HALF * BK * 2  , STAGE_BYTES = 8 * HTB, NXCD = 8, WGM = 8;

__host__ __device__ __forceinline__ int lds_byte(int r, int c) { const int st = (r >> 4) * 2 + (c >> 5), rr = r & 15, cc = c & 31, ob = rr * 64 + cc * 2; return st * 1024 + (ob ^ (((ob >> 9) & 1) << 5)); }
__host__ __device__ __forceinline__ void stage_rc(int b, int& R, int& C) { const int st = b / 1024, sb = b % 1024, swz = sb ^ (((sb >> 9) & 1) << 5); R = (st >> 1) * 16 + swz / 64; C = (st & 1) * 32 + (swz % 64) / 2; }
__host__ __device__ __forceinline__ int perm32(int rho) { const int n = rho >> 4, i = rho & 15; return 8 * (i >> 2) + 4 * n + (i & 3); }

struct Unit { int pm, pn; };
struct Gemm { const bf16_t* A; const bf16_t* Bt; int M, N, K, lda; };

struct StaticOrder {
    int nM, nN, nwg, G, c;
    __host__ __device__ void init(int M, int N, int G_, int c_) { nM = M / BM; nN = N / BM; nwg = nM * nN; G = G_; c = c_; }
    __host__ __device__ bool next(int i, Unit& u) const {
        const long L = (long)i * G + c; if (L >= nwg) return false;
        int wgid = (int)L; { const int q = nwg / NXCD, r = nwg % NXCD, xcd = wgid % NXCD, off = wgid / NXCD; wgid = (xcd < r ? xcd * (q + 1) : r * (q + 1) + (xcd - r) * q) + off; }
        const int nig = WGM * nN, gid = wgid / nig, fm = gid * WGM, gsz = (nM - fm) < WGM ? (nM - fm) : WGM;
        u.pm = fm + ((wgid % nig) % gsz); u.pn = (wgid % nig) / gsz; return true;
    }
    __device__ __forceinline__ void a_ready(const Unit&) const {}
    __device__ __forceinline__ void done(const Unit&) const {}
};
__device__ __forceinline__ unsigned pk_h16(float lo, float hi) { half2v t; t[0] = (h16)lo; t[1] = (h16)hi; return __builtin_bit_cast(unsigned, t); }
struct EpiResid {
    static constexpr bool PERM = false, AFTER_DRAIN = false;
    const float* resid; float* out; int ldc;
    __device__ __forceinline__ void operator()(const f32x4 (&acc)[2][2][4][2], const Unit& u, int wr, int wc, int fr, int fq) const {
#pragma unroll
        for (int ai = 0; ai < 2; ++ai)
#pragma unroll
            for (int m = 0; m < 4; ++m) { const size_t ro = (size_t)(u.pm * BM + ai * HALF + wr * 64 + m * 16 + fr) * ldc + u.pn * BM + wc * 32 + 4 * fq;
#pragma unroll
                for (int bj = 0; bj < 2; ++bj)
#pragma unroll
                    for (int n = 0; n < 2; ++n) { const size_t o = ro + bj * HALF + n * 16; *(f32x4*)(out + o) = *(const f32x4*)(resid + o) + acc[ai][bj][m][n]; } }
    }
};
struct EpiF32 {
    static constexpr bool PERM = false, AFTER_DRAIN = false;
    float* out; size_t ldc;
    __device__ __forceinline__ void operator()(const f32x4 (&acc)[2][2][4][2], const Unit& u, int wr, int wc, int fr, int fq) const {
#pragma unroll
        for (int ai = 0; ai < 2; ++ai)
#pragma unroll
            for (int m = 0; m < 4; ++m) { const size_t ro = (size_t)(u.pm * BM + ai * HALF + wr * 64 + m * 16 + fr) * ldc + u.pn * BM + wc * 32 + 4 * fq;
#pragma unroll
                for (int bj = 0; bj < 2; ++bj)
#pragma unroll
                    for (int n = 0; n < 2; ++n) *(f32x4*)(out + ro + bj * HALF + n * 16) = acc[ai][bj][m][n]; }
    }
};
struct EpiH16 {
    static constexpr bool PERM = true, AFTER_DRAIN = false;
    h16* out; int ldc;
    __device__ __forceinline__ void operator()(const f32x4 (&acc)[2][2][4][2], const Unit& u, int wr, int wc, int fr, int fq) const {
#pragma unroll
        for (int ai = 0; ai < 2; ++ai)
#pragma unroll
            for (int m = 0; m < 4; ++m) { h16* rowp = out + (size_t)(u.pm * BM + ai * HALF + wr * 64 + m * 16 + fr) * ldc + u.pn * BM + wc * 32 + 8 * fq;
#pragma unroll
                for (int bj = 0; bj < 2; ++bj) { const f32x4 v0 = acc[ai][bj][m][0], v1 = acc[ai][bj][m][1];
                    u32x4 w; w.x = pk_h16(v0[0], v0[1]); w.y = pk_h16(v0[2], v0[3]); w.z = pk_h16(v1[0], v1[1]); w.w = pk_h16(v1[2], v1[3]);
                    *(u32x4*)(rowp + bj * HALF) = w; } }
    }
};
struct EpiEvenMain {
    static constexpr bool PERM = true, AFTER_DRAIN = false;
    h16* Z; float* FG; const float* b_f;
    __device__ __forceinline__ void operator()(const f32x4 (&acc)[2][2][4][2], const Unit& u, int wr, int wc, int fr, int fq) const {
#pragma unroll
        for (int bj = 0; bj < 2; ++bj) {
            const int col0 = u.pn * BM + bj * HALF + wc * 32 + 8 * fq;
            if (col0 < 2048) {
                const float sc = (col0 < 512 || (col0 >= 1024 && col0 < 1536)) ? QSCALE : 1.0f;
#pragma unroll
                for (int ai = 0; ai < 2; ++ai)
#pragma unroll
                    for (int m = 0; m < 4; ++m) { const f32x4 v0 = acc[ai][bj][m][0] * sc, v1 = acc[ai][bj][m][1] * sc;
                        u32x4 w; w.x = pk_h16(v0[0], v0[1]); w.y = pk_h16(v0[2], v0[3]); w.z = pk_h16(v1[0], v1[1]); w.w = pk_h16(v1[2], v1[3]);
                        *(u32x4*)(Z + (size_t)(u.pm * BM + ai * HALF + wr * 64 + m * 16 + fr) * ZLD + col0) = w; }
            } else if (col0 < 2080) {
                const int c = col0 - 2048;
#pragma unroll
                for (int ai = 0; ai < 2; ++ai)
#pragma unroll
                    for (int m = 0; m < 4; ++m) { const f32x4 v0 = acc[ai][bj][m][0], v1 = acc[ai][bj][m][1]; f32x4 o0, o1;
                        if (c == 0) {
#pragma unroll
                            for (int q = 0; q < 4; ++q) { o0[q] = log_sigmoid(v0[q] + b_f[q]) * LOG2E; o1[q] = log_sigmoid(v1[q] + b_f[4 + q]) * LOG2E; }
                        } else {
#pragma unroll
                            for (int q = 0; q < 4; ++q) { o0[q] = sigmoidf_(v0[q]); o1[q] = sigmoidf_(v1[q]); }
                        }
                        float* fr_ = FG + (size_t)(u.pm * BM + ai * HALF + wr * 64 + m * 16 + fr) * 32 + c;
                        *(f32x4*)fr_ = o0; *(f32x4*)(fr_ + 4) = o1; }
            }
        }
    }
};
struct EpiVt {
    static constexpr bool PERM = true, AFTER_DRAIN = false;
    h16 *VtF, *VtS, *VtW;
    __device__ __forceinline__ void operator()(const f32x4 (&acc)[2][2][4][2], const Unit& u, int wr, int wc, int fr, int fq) const {
#pragma unroll
        for (int ai = 0; ai < 2; ++ai)
#pragma unroll
            for (int m = 0; m < 4; ++m) {
                const int n = u.pm * BM + ai * HALF + wr * 64 + m * 16 + fr;
#pragma unroll
                for (int bj = 0; bj < 2; ++bj) {
                    const int t0 = u.pn * BM + bj * HALF + wc * 32 + 8 * fq, b = t0 >> 12, s = t0 & 4095;
                    h16* dst = n < 512 ? VtF + ((size_t)(b * 512 + n)) * SEQ + s : (n < 640 ? VtS + ((size_t)(b * 128 + n - 512)) * SEQ + s : VtW + ((size_t)(b * 128 + n - 640)) * SEQ + s);
                    const f32x4 v0 = acc[ai][bj][m][0], v1 = acc[ai][bj][m][1];
                    u32x4 w; w.x = pk_h16(v0[0], v0[1]); w.y = pk_h16(v0[2], v0[3]); w.z = pk_h16(v1[0], v1[1]); w.w = pk_h16(v1[2], v1[3]);
                    *(u32x4*)dst = w;
                }
            }
    }
};

template <class Epi, class Sched, bool ALIGN_EPI = false, bool SP2 = false>
__device__ __forceinline__ void gemm_phase(PG8_LAS unsigned char* lds, const Gemm g, const Sched& S, const Epi& E) {
    int tid_ = threadIdx.x; asm volatile("" : "+v"(tid_));
    const int tid = tid_, wid = __builtin_amdgcn_readfirstlane(tid >> 6), lane = tid & 63, wr = wid >> 2, wc = wid & 3, fr = lane & 15, fq = lane >> 4;
    const int K = g.K, nt = K / BK;
    unsigned voffA[2], voffB[2];
#pragma unroll
    for (int i = 0; i < 2; ++i) { int R, C; stage_rc(tid * 16 + i * 8192, R, C); const int Rb = Epi::PERM ? ((R & ~31) + perm32(R & 31)) : R;
        voffA[i] = (unsigned)(R * g.lda + C) * 2u; voffB[i] = (unsigned)(Rb * K + C) * 2u; }
    const size_t kstep = (size_t)(BK * 2);
    const size_t hstepA = (size_t)HALF * g.lda * 2, hstepB = (size_t)HALF * K * 2;
    const size_t tstepA = 2 * hstepA, tstepB = 2 * hstepB;
    const unsigned ldsw = (unsigned)wid * 1024u;
    const int aoff = lds_byte(wr * 64 + fr, fq * 8), boff = lds_byte(wc * 32 + fr, fq * 8);
#define PG8_SA(b, h) (((b) * 2 + (h)) * HTB)
#define PG8_SB(b, h) ((4 + (b) * 2 + (h)) * HTB)
#define PG8_STAGE(bufoff, gbase, voff) do { _Pragma("unroll") for (int _i = 0; _i < 2; ++_i) \
        __builtin_amdgcn_global_load_lds((const unsigned*)((const char*)(gbase) + (voff)[_i]), (PG8_LAS unsigned*)(lds + (bufoff) + ldsw + _i * 8192), 16, 0, 0); } while (0)
#define PG8_LDA(dst, b, h) do { _Pragma("unroll") for (int m = 0; m < 4; ++m) _Pragma("unroll") for (int k = 0; k < 2; ++k) dst[m][k] = *(const PG8_LAS bf16x8*)(lds + PG8_SA(b, h) + aoff + m * 2048 + k * 1024); } while (0)
#define PG8_LDB(dst, b, h) do { _Pragma("unroll") for (int n = 0; n < 2; ++n) _Pragma("unroll") for (int k = 0; k < 2; ++k) dst[n][k] = *(const PG8_LAS bf16x8*)(lds + PG8_SB(b, h) + boff + n * 2048 + k * 1024); } while (0)
#define PG8_MMA(ai, bj, At, Bt) do { __builtin_amdgcn_s_setprio(1); _Pragma("unroll") for (int m = 0; m < 4; ++m) _Pragma("unroll") for (int n = 0; n < 2; ++n) _Pragma("unroll") for (int k = 0; k < 2; ++k) \
        acc[ai][bj][m][n] = __builtin_amdgcn_mfma_f32_16x16x32_f16(__builtin_bit_cast(half8, Bt[n][k]), __builtin_bit_cast(half8, At[m][k]), acc[ai][bj][m][n], 0, 0, 0); __builtin_amdgcn_s_setprio(0); } while (0)
#define PG8_WAIT_V(n) asm volatile("s_waitcnt vmcnt(" #n ")" ::: "memory")
#define PG8_WAIT_L(n) asm volatile("s_waitcnt lgkmcnt(" #n ")" ::: "memory")
#define PG8_BAR __builtin_amdgcn_s_barrier()
#define PG8_SCHED __builtin_amdgcn_sched_barrier(0)
    Unit cur, nxt; int ui = 0;
    if (!S.next(0, cur)) return;
    f32x4 acc[2][2][4][2];
#pragma unroll
    for (int a = 0; a < 2; ++a)
#pragma unroll
        for (int b = 0; b < 2; ++b)
#pragma unroll
            for (int m = 0; m < 4; ++m)
#pragma unroll
                for (int n = 0; n < 2; ++n) acc[a][b][m][n] = (f32x4){0.f, 0.f, 0.f, 0.f};
    bf16x8 At[4][2], B0[2][2], B1[2][2];
    const char* cA = (const char*)g.A + (size_t)cur.pm * tstepA; const char* cB = (const char*)g.Bt + (size_t)cur.pn * tstepB;
    S.a_ready(cur);
    if constexpr (SP2) {
        PG8_STAGE(PG8_SB(0, 0), cB, voffB); PG8_STAGE(PG8_SB(0, 1), cB + hstepB, voffB); PG8_STAGE(PG8_SA(0, 0), cA, voffA); PG8_STAGE(PG8_SA(0, 1), cA + hstepA, voffA);
        if (wr == 1) PG8_BAR;
        PG8_WAIT_V(2); PG8_BAR;
        PG8_STAGE(PG8_SB(1, 0), cB + kstep, voffB); PG8_STAGE(PG8_SA(1, 0), cA + kstep, voffA); PG8_STAGE(PG8_SB(1, 1), cB + hstepB + kstep, voffB);
        PG8_WAIT_V(6); PG8_BAR;
    } else {
        PG8_STAGE(PG8_SB(0, 0), cB, voffB); PG8_STAGE(PG8_SA(0, 0), cA, voffA); PG8_STAGE(PG8_SB(0, 1), cB + hstepB, voffB); PG8_STAGE(PG8_SA(0, 1), cA + hstepA, voffA);
        if (wr == 1) PG8_BAR;
        PG8_WAIT_V(4); PG8_BAR;
        PG8_STAGE(PG8_SB(1, 0), cB + kstep, voffB); PG8_STAGE(PG8_SA(1, 0), cA + kstep, voffA); PG8_STAGE(PG8_SB(1, 1), cB + hstepB + kstep, voffB);
        PG8_WAIT_V(6); PG8_BAR;
    }
    for (;;) {
        const bool has_next = S.next(ui + 1, nxt);
        const char* nA = has_next ? (const char*)g.A + (size_t)nxt.pm * tstepA : cA; const char* nB = has_next ? (const char*)g.Bt + (size_t)nxt.pn * tstepB : cB;
        for (int t = 0; t < nt; t += 2) {
            const bool last = (t == nt - 2);
            const char* a1 = cA + (size_t)(t + 1) * kstep;
            const char* a2 = last ? nA : cA + (size_t)(t + 2) * kstep; const char* b2 = last ? nB : cB + (size_t)(t + 2) * kstep;
            const char* a3 = a2 + kstep; const char* b3 = b2 + kstep;
            if (last && has_next) S.a_ready(nxt);
            if constexpr (SP2) {
            PG8_LDB(B0, 0, 0); PG8_LDB(B1, 0, 1); PG8_SCHED; PG8_LDA(At, 0, 0); PG8_STAGE(PG8_SA(1, 1), a1 + hstepA, voffA);
            PG8_WAIT_V(8); PG8_WAIT_L(0); PG8_BAR; PG8_MMA(0, 0, At, B0); PG8_MMA(0, 1, At, B1); PG8_BAR; PG8_SCHED;
            PG8_LDA(At, 0, 1); PG8_STAGE(PG8_SB(0, 0), b2, voffB); PG8_STAGE(PG8_SB(0, 1), b2 + hstepB, voffB); PG8_STAGE(PG8_SA(0, 0), a2, voffA);
            PG8_WAIT_V(8); PG8_WAIT_L(0); PG8_BAR; PG8_MMA(1, 0, At, B0); PG8_MMA(1, 1, At, B1); PG8_BAR; PG8_SCHED;
            PG8_LDB(B0, 1, 0); PG8_LDB(B1, 1, 1); PG8_SCHED; PG8_LDA(At, 1, 0); PG8_STAGE(PG8_SA(0, 1), a2 + hstepA, voffA);
            PG8_WAIT_V(8); PG8_WAIT_L(0); PG8_BAR; PG8_MMA(0, 0, At, B0); PG8_MMA(0, 1, At, B1); PG8_BAR; PG8_SCHED;
            PG8_LDA(At, 1, 1); PG8_STAGE(PG8_SB(1, 0), b3, voffB); PG8_STAGE(PG8_SB(1, 1), b3 + hstepB, voffB); PG8_STAGE(PG8_SA(1, 0), a3, voffA);
            PG8_WAIT_V(8); PG8_WAIT_L(0); PG8_BAR; PG8_MMA(1, 0, At, B0); PG8_MMA(1, 1, At, B1); PG8_BAR; PG8_SCHED;
            } else {
            PG8_LDB(B0, 0, 0); PG8_SCHED; PG8_LDA(At, 0, 0); PG8_STAGE(PG8_SA(1, 1), a1 + hstepA, voffA);
            PG8_WAIT_L(8); PG8_BAR; PG8_WAIT_L(0); PG8_MMA(0, 0, At, B0); PG8_BAR; PG8_SCHED;
            PG8_LDB(B1, 0, 1); PG8_STAGE(PG8_SB(0, 0), b2, voffB);
            PG8_BAR; PG8_WAIT_L(0); PG8_MMA(0, 1, At, B1); PG8_BAR;
            PG8_LDA(At, 0, 1); PG8_STAGE(PG8_SA(0, 0), a2, voffA);
            PG8_BAR; PG8_WAIT_L(0); PG8_MMA(1, 0, At, B0); PG8_BAR; PG8_SCHED;
            PG8_STAGE(PG8_SB(0, 1), b2 + hstepB, voffB);
            PG8_WAIT_V(6); PG8_BAR; PG8_MMA(1, 1, At, B1); PG8_BAR;
            PG8_LDB(B0, 1, 0); PG8_SCHED; PG8_LDA(At, 1, 0); PG8_STAGE(PG8_SA(0, 1), a2 + hstepA, voffA);
            PG8_WAIT_L(8); PG8_BAR; PG8_WAIT_L(0); PG8_MMA(0, 0, At, B0); PG8_BAR; PG8_SCHED;
            PG8_LDB(B1, 1, 1); PG8_STAGE(PG8_SB(1, 0), b3, voffB);
            PG8_BAR; PG8_WAIT_L(0); PG8_MMA(0, 1, At, B1); PG8_BAR;
            PG8_LDA(At, 1, 1); PG8_STAGE(PG8_SA(1, 0), a3, voffA);
            PG8_BAR; PG8_WAIT_L(0); PG8_MMA(1, 0, At, B0); PG8_BAR; PG8_SCHED;
            PG8_STAGE(PG8_SB(1, 1), b3 + hstepB, voffB);
            PG8_WAIT_V(6); PG8_BAR; PG8_MMA(1, 1, At, B1); PG8_BAR;
            }
        }
        if constexpr (ALIGN_EPI) { if (wr == 0) PG8_BAR; }
        if constexpr (!Epi::AFTER_DRAIN) { E(acc, cur, wr, wc, fr, fq); S.done(cur); }
        if (!has_next) break;
#pragma unroll
        for (int a = 0; a < 2; ++a)
#pragma unroll
            for (int b = 0; b < 2; ++b)
#pragma unroll
                for (int m = 0; m < 4; ++m)
#pragma unroll
                    for (int n = 0; n < 2; ++n) acc[a][b][m][n] = (f32x4){0.f, 0.f, 0.f, 0.f};
        cur = nxt; cA = nA; cB = nB; ++ui;
        if constexpr (ALIGN_EPI) { if (wr == 1) PG8_BAR; }
    }
    PG8_WAIT_V(0);
    if constexpr (!ALIGN_EPI) { if (wr == 0) PG8_BAR; }
    PG8_BAR;
    if constexpr (Epi::AFTER_DRAIN) { E.fused(acc, cur, wr, wc, fr, fq, lds, wid, lane); S.done(cur); }
#undef PG8_SA
#undef PG8_SB
#undef PG8_STAGE
#undef PG8_LDA
#undef PG8_LDB
#undef PG8_MMA
#undef PG8_WAIT_V
#undef PG8_WAIT_L
#undef PG8_BAR
#undef PG8_SCHED
}
}

__device__ __forceinline__ GemmArgs mk_gemm(const h16* A, int lda, const h16* Bt, int ldb, int M, int N, int K, int ans, int mode, h16* c16, int ldc16, float* c32, int ldc32, const float* resid) {
    GemmArgs g; g.A = A; g.lda = lda; g.Bt = Bt; g.ldb = ldb; g.M = M; g.N = N; g.K = K; g.a_ntile_stride = ans; g.mode = mode; g.c16 = c16; g.ldc16 = ldc16; g.c32 = c32; g.ldc32 = ldc32; g.resid = resid; g.aux = nullptr; return g;
}

__device__ __forceinline__ void run_phase(PRef p, int ph, char* smem) {
    if (ph == 1 || ph == 4 || ph == 6 || ph == 10 || ph == 14 || ph == 16) {
        PG8_LAS unsigned char* lds = (PG8_LAS unsigned char*)dyn_lds;
        const int G = (int)gridDim.x, c = (int)blockIdx.x;
        pg8::StaticOrder S;
        typedef const pg8::bf16_t* bp;
        if (ph == 1) {
            { pg8::EpiEvenMain E{p.Z, p.FG, p.even_b_f}; S.init(TOK, ZLD, G, c);
              pg8::gemm_phase<pg8::EpiEvenMain, pg8::StaticOrder, true, true>(lds, pg8::Gemm{(bp)p.HN, (bp)p.WtE, TOK, ZLD, DM, DM}, S, E); }
            { pg8::EpiVt E{p.VtF, p.VtS, p.VtW}; S.init(768, TOK, G, (c + 3 * G / 4) % G);
              pg8::gemm_phase<pg8::EpiVt, pg8::StaticOrder, true, true>(lds, pg8::Gemm{(bp)p.WtV, (bp)p.HN, 768, TOK, DM, DM}, S, E); }
        } else if (ph == 4) {
            pg8::EpiResid E{p.x, p.H, DM}; S.init(TOK, DM, G, c);
            pg8::gemm_phase<pg8::EpiResid, pg8::StaticOrder, true, true>(lds, pg8::Gemm{(bp)p.O, (bp)p.WtEo, TOK, DM, DM, DM}, S, E);
        } else if (ph == 14) {
            pg8::EpiResid E{p.H, p.H, DM}; S.init(TOK, DM, G, c);
            pg8::gemm_phase<pg8::EpiResid, pg8::StaticOrder, true, true>(lds, pg8::Gemm{(bp)(p.Z2 + DRNN), (bp)p.WtOo, TOK, DM, DRNN, Z2LD}, S, E);
        } else if (ph == 10) {
            pg8::EpiH16 E{p.Z2, Z2LD}; S.init(TOK, Z2LD, G, c);
            pg8::gemm_phase<pg8::EpiH16, pg8::StaticOrder, true, true>(lds, pg8::Gemm{(bp)p.HN, (bp)p.WtO, TOK, Z2LD, DM, DM}, S, E);
        } else {
            pg8::EpiH16 E{p.SC, TOK}; S.init(2048, TOK, G, c);
            pg8::gemm_phase<pg8::EpiH16, pg8::StaticOrder, true, true>(lds, pg8::Gemm{(bp)(p.WtQ + (ph == 16 ? (size_t)2048 * 1024 : 0)), (bp)p.HN, 2048, TOK, DM, DM}, S, E);
        }
        return;
    }
    if (ph == 0) phase_prep(p, smem);
    else if (ph == 2) phase_cumsum_compress(p, smem);
    else if (ph == 3) phase_attention(p, smem);
    else if (ph == 5 || ph == 15) phase_rmsnorm(p, ph == 5 ? p.ffn_norm_g : p.ffn_norm_g + DM);
    else if (ph == 8 || ph == 18) phase_peer_topk(p, smem);
    else if (ph == 9 || ph == 19) phase_peer_experts(p, ph == 19 ? 1 : 0, ph == 19 ? p.final_g : p.odd_norm_g, ph == 19 ? 1 : 0, smem);
    else if (ph == 11) phase_rnn_gates(p, smem);
    else if (ph == 13) phase_rnn_scan_b(p);
}

__global__ void __launch_bounds__(512, 2) mega(Params p_by_value) {
    char* smem = dyn_lds + hidx_() * 65536;
    volatile LAS unsigned* hs_all = (volatile LAS unsigned*)(dyn_lds + 131072);
    const __attribute__((address_space(4))) Params* kp = (const __attribute__((address_space(4))) Params*)__builtin_amdgcn_kernarg_segment_ptr();
    const int ph0 = (int)kp->ph0, ph1 = (int)kp->ph1;
    if (threadIdx.x < 12) hs_all[threadIdx.x] = 0u;
    __syncthreads();
    XcdBarrier xb = xcd_barrier_post(kp->BAR, hs_all + 8);
    for (int ph = ph0; ph < ph1; ++ph) {
        if (ph == 12 || ph == 7 || ph == 17) continue;
        const __attribute__((address_space(4))) Params* q = kp;
        asm volatile("" : "+s"(q));
        PRef p = *q;
#if PROBE_PH >= 0
        if (blockIdx.x == 0 && threadIdx.x == 0) p.TS[ph] = __builtin_amdgcn_s_memrealtime();
#endif
        const int reps = ((DUP_MASK >> ph) & 1) ? 2 : 1;
        for (int r = 0; r < reps; ++r) { run_phase(p, ph, smem); if (r + 1 < reps) xcd_barrier(xb); }
        if (ph + 1 < ph1) xcd_barrier(xb);
    }
    PRef p = *kp;
#if PROBE_PH >= 0
    cg::this_grid().sync();
    if (blockIdx.x == 0 && threadIdx.x == 0) { p.TS[NPHASE] = __builtin_amdgcn_s_memrealtime(); __threadfence(); }
    cg::this_grid().sync();
    {
        const unsigned long long t0 = __hip_atomic_load(&p.TS[0], __ATOMIC_RELAXED, __HIP_MEMORY_SCOPE_AGENT), t1 = __hip_atomic_load(&p.TS[NPHASE], __ATOMIC_RELAXED, __HIP_MEMORY_SCOPE_AGENT);
        const unsigned long long a = __hip_atomic_load(&p.TS[PROBE_PH], __ATOMIC_RELAXED, __HIP_MEMORY_SCOPE_AGENT), b = __hip_atomic_load(&p.TS[PROBE_PH + PROBE_N], __ATOMIC_RELAXED, __HIP_MEMORY_SCOPE_AGENT);
        const float frac = (float)(b - a) / (float)(t1 - t0);
        const float scale = 1.1f + frac;
        for (size_t i = (size_t)blockIdx.x * 512 + threadIdx.x; i < (size_t)TOK * DM; i += (size_t)gridDim.x * 512) p.out[i] *= scale;
    }
#endif
}

constexpr int DYN_LDS_BYTES = 131072 + 64;
extern "C" void kernel_launch(void* const* d_in, const int* in_sizes, int n_in, void* d_out, int out_size, void* d_ws, size_t ws_size, hipStream_t stream) {
    Params p; memset(&p, 0, sizeof(p));
    const float* const* in = (const float* const*)d_in;
    p.x = in[0]; p.even_norm_g = in[1]; p.even_w_in = in[2]; p.even_b_f = in[3]; p.even_cmp_pos = in[4]; p.even_w_cmp_k = in[5]; p.even_w_cmp_v = in[6]; p.even_w_out = in[7];
    p.odd_norm_g = in[8]; p.odd_w_in = in[9]; p.odd_conv_w = in[10]; p.odd_conv_b = in[11]; p.odd_w_ra = in[12]; p.odd_b_ra = in[13]; p.odd_w_ri = in[14]; p.odd_b_ri = in[15];
    p.odd_lam = in[16]; p.odd_w_out = in[17]; p.ffn_norm_g = in[18]; p.peer_w_q = in[19]; p.peer_sub_keys = in[20]; p.peer_u = in[21]; p.peer_v = in[22]; p.final_g = in[23];
    p.out = (float*)d_out;
    char* ws = (char*)d_ws; size_t off = 0;
    auto take = [&](size_t bytes) { char* r = ws + off; off += (bytes + 255) & ~(size_t)255; return r; };
    p.WtE = (h16*)take((size_t)ZLD * 1024 * 2); p.WtV = (h16*)take((size_t)768 * 1024 * 2); p.WtEo = (h16*)take((size_t)1024 * 1024 * 2); p.WtO = (h16*)take((size_t)2560 * 1024 * 2); p.WtOo = (h16*)take((size_t)1024 * 1280 * 2);
    p.WtQ = (h16*)take((size_t)2 * 2048 * 1024 * 2); p.Wc = (h16*)take((size_t)2 * 64 * 2048 * 2); p.Wr = (h16*)take((size_t)20 * 16384 * 2); p.Keys = (h16*)take((size_t)2 * 8 * 2 * 128 * 128 * 2);
    p.Pos16 = (h16*)take(4096); p.U8 = (unsigned char*)take((size_t)2 * 16384 * 1024); p.V8 = (unsigned char*)take((size_t)2 * 16384 * 1024);
    p.US = (float*)take((size_t)2 * 16384 * 4); p.VS = (float*)take((size_t)2 * 16384 * 4);
    p.H = (float*)take((size_t)TOK * DM * 4); p.HN = (h16*)take((size_t)TOK * DM * 2);
    const size_t scratch0 = off;
    p.Z = (h16*)take((size_t)TOK * ZLD * 2); p.VtF = (h16*)take((size_t)4 * 8 * 64 * SEQ * 2); p.VtS = (h16*)take((size_t)4 * 2 * 64 * SEQ * 2); p.VtW = (h16*)take((size_t)4 * 2 * 64 * SEQ * 2);
    p.KC = (h16*)take((size_t)8 * 256 * 64 * 2); p.VCt = (h16*)take((size_t)8 * 64 * 256 * 2); p.O = (h16*)take((size_t)TOK * DM * 2); p.FG = (float*)take((size_t)TOK * 32 * 4); p.C2 = (float*)take((size_t)32 * SEQ * 4); p.OACC = (float*)take((size_t)TOK * 512 * 4);
    size_t mx = off;
    off = scratch0;
    p.QP = (h16*)take((size_t)TOK * 2048 * 2); p.SC = (h16*)take((size_t)TOK * 2048 * 2); p.IDS = (int*)take((size_t)TOK * 128 * 4); p.GW = (float*)take((size_t)TOK * 128 * 4);
    if (off > mx) mx = off;
    off = scratch0;
    p.Z2 = (h16*)take((size_t)TOK * Z2LD * 2); p.LA = (h16*)take((size_t)TOK * DRNN * 2); p.RU = (h16*)take((size_t)TOK * DRNN * 2);
    p.AggP = (float*)take((size_t)4 * 64 * DRNN * 4); p.AggH = (float*)take((size_t)4 * 64 * DRNN * 4);
    if (off > mx) mx = off;
    off = mx; p.TS = (unsigned long long*)take(256); p.BAR = (unsigned*)take(XCD_BAR_WORDS * 4 + 256); mx = off;
    if (mx > ws_size) { fprintf(stderr, "workspace too small: need %zu have %zu\n", mx, ws_size); return; }

    static int grid_blocks = 0;
    if (!grid_blocks) {
        int dev = 0, cus = 0, per_cu = 0;
        hipGetDevice(&dev);
        hipDeviceGetAttribute(&cus, hipDeviceAttributeMultiprocessorCount, dev);
        hipFuncSetAttribute((const void*)mega, hipFuncAttributeMaxDynamicSharedMemorySize, DYN_LDS_BYTES);
        hipOccupancyMaxActiveBlocksPerMultiprocessor(&per_cu, mega, 512, DYN_LDS_BYTES);
        if (per_cu > 1) per_cu = 1;
        if (per_cu < 1) per_cu = 1;
        grid_blocks = cus * per_cu;
    }
    hipMemsetAsync(p.BAR, 0, XCD_BAR_WORDS * 4 + 256, stream);
#if SINGLE_LAUNCH
    p.ph0 = 0; p.ph1 = NPHASE;
    void* args[] = {&p};
    hipError_t e = hipLaunchCooperativeKernel((void*)mega, dim3(grid_blocks), dim3(512), args, DYN_LDS_BYTES, stream);
    if (e != hipSuccess) fprintf(stderr, "cooperative launch failed: %s (grid %d)\n", hipGetErrorString(e), grid_blocks);
#else
    for (int ph = 0; ph < NPHASE; ++ph) {
        p.ph0 = ph; p.ph1 = ph + 1;
        hipLaunchKernelGGL(mega, dim3(grid_blocks), dim3(512), DYN_LDS_BYTES, stream, p);
    }
#endif
}
```

```cpp
#include <hip/hip_runtime.h>
#include <hip/hip_cooperative_groups.h>
#include <cstdio>
#include <cstdint>
#include <cstring>
namespace cg = cooperative_groups;

#ifndef SINGLE_LAUNCH
#define SINGLE_LAUNCH 1
#endif
#ifndef PROBE_PH
#define PROBE_PH -1
#endif
#ifndef PROBE_N
#define PROBE_N 1
#endif
#ifndef DUP_MASK
#define DUP_MASK 0
#endif

typedef _Float16 h16;
typedef _Float16 half8 __attribute__((ext_vector_type(8)));
typedef _Float16 half4 __attribute__((ext_vector_type(4)));
typedef _Float16 half2v __attribute__((ext_vector_type(2)));
typedef float f32x4 __attribute__((ext_vector_type(4)));
typedef float f32x16 __attribute__((ext_vector_type(16)));
typedef unsigned long long u64;
typedef int i32x4 __attribute__((ext_vector_type(4)));
typedef float f32x2 __attribute__((ext_vector_type(2)));
typedef float f32x32 __attribute__((ext_vector_type(32)));
typedef _Float16 h16x32 __attribute__((ext_vector_type(32)));
typedef unsigned u32x6 __attribute__((ext_vector_type(6)));
typedef int i32x2 __attribute__((ext_vector_type(2)));
typedef i32x4 __attribute__((aligned(8))) i32x4_a8;

#define NTHR 256
constexpr int BATCH = 4, SEQ = 4096, DM = 1024, TOK = BATCH * SEQ;
constexpr int ZLD = 2304, Z2LD = 2560, DRNN = 1280;
constexpr int EVEN_IN = 2848;
constexpr float LOG2E = 1.4426950408889634f;
constexpr float QSCALE = 0.125f * LOG2E;
constexpr float NEGBIG = -1.0e30f;
constexpr int KST = 72;
constexpr int NPHASE = 20;
constexpr int XCD_BAR_WORDS_C = 3456;

struct Params {
    const float *x, *even_norm_g, *even_w_in, *even_b_f, *even_cmp_pos, *even_w_cmp_k, *even_w_cmp_v, *even_w_out;
    const float *odd_norm_g, *odd_w_in, *odd_conv_w, *odd_conv_b, *odd_w_ra, *odd_b_ra, *odd_w_ri, *odd_b_ri, *odd_lam, *odd_w_out;
    const float *ffn_norm_g, *peer_w_q, *peer_sub_keys, *peer_u, *peer_v, *final_g;
    float* out;
    h16 *WtE, *WtV, *WtEo, *WtO, *WtOo, *WtQ, *Wc, *Wr, *Keys, *Pos16;
    unsigned char *U8, *V8; float *US, *VS;
    float* H; h16* HN;
    h16 *Z, *VtF, *VtS, *VtW, *KC, *VCt, *O; float *FG, *C2, *OACC;
    h16* QP; h16* SC; int* IDS; float* GW;
    h16* Z2; h16 *LA, *RU; float *AggP, *AggH;
    unsigned long long* TS; unsigned* BAR;
    long long ph0, ph1;
};

typedef const __attribute__((address_space(4))) Params& PRef;
extern __shared__ __attribute__((aligned(16))) char dyn_lds[];
#define GRIDV ((int)gridDim.x * 2)
#define LAS __attribute__((address_space(3)))
__device__ __forceinline__ int hidx_() { return __builtin_amdgcn_readfirstlane((int)threadIdx.x >> 8); }
__device__ __forceinline__ int tidx_() { int t = threadIdx.x & 255; asm volatile("" : "+v"(t)); return t; }
__device__ __forceinline__ int bidx_() { int b = blockIdx.x * 2 + hidx_(); asm volatile("" : "+s"(b)); return b; }
__device__ __forceinline__ int widx_() { return __builtin_amdgcn_readfirstlane(((int)threadIdx.x >> 6) & 3); }
__device__ __forceinline__ void hsync() {
    volatile LAS unsigned* w = (volatile LAS unsigned*)(dyn_lds + 131072 + hidx_() * 16);
    asm volatile("s_waitcnt lgkmcnt(0)" ::: "memory");
    if ((threadIdx.x & 63) == 0) {
        const unsigned old = __hip_atomic_fetch_add((LAS unsigned*)w, 1u, __ATOMIC_RELAXED, __HIP_MEMORY_SCOPE_WORKGROUP);
        const unsigned target = (old | 3u) + 1u;
        while ((int)(w[0] - target) < 0) { }
    }
    asm volatile("s_waitcnt lgkmcnt(0)" ::: "memory");
}

__device__ __forceinline__ float wave_sum(float v) {
#pragma unroll
    for (int o = 32; o > 0; o >>= 1) v += __shfl_xor(v, o);
    return v;
}
__device__ __forceinline__ int mbcnt64(u64 m) { return __builtin_amdgcn_mbcnt_hi((unsigned)(m >> 32), __builtin_amdgcn_mbcnt_lo((unsigned)m, 0)); }
__device__ __forceinline__ float gelu_exact(float v) { return 0.5f * v * (1.0f + erff(v * 0.70710678118654752f)); }
__device__ __forceinline__ float sigmoidf_(float v) { return 1.0f / (1.0f + __expf(-v)); }
__device__ __forceinline__ float log_sigmoid(float v) { return v >= 0.f ? -log1pf(expf(-v)) : v - log1pf(expf(v)); }
__device__ __forceinline__ int crow(int r, int hi) { return (r & 3) + 8 * (r >> 2) + 4 * hi; }
__device__ __forceinline__ f32x16 zero16() { f32x16 z;
#pragma unroll
    for (int i = 0; i < 16; ++i) z[i] = 0.f; return z; }

__device__ __forceinline__ void rms_write_h16(const float (&v)[16], const float* __restrict__ g, h16* __restrict__ dst, int lane) {
    float ss = 0.f;
#pragma unroll
    for (int i = 0; i < 16; ++i) ss += v[i] * v[i];
    ss = wave_sum(ss);
    const float rstd = rsqrtf(ss * (1.0f / 1024.0f) + 1e-6f);
#pragma unroll
    for (int hseg = 0; hseg < 2; ++hseg) {
        const int c0 = hseg * 512 + lane * 8;
        const f32x4 g0 = *(const f32x4*)(g + c0), g1 = *(const f32x4*)(g + c0 + 4);
        half8 o;
#pragma unroll
        for (int i = 0; i < 4; ++i) { o[i] = (h16)(v[hseg * 8 + i] * rstd * g0[i]); o[4 + i] = (h16)(v[hseg * 8 + 4 + i] * rstd * g1[i]); }
        *(half8*)(dst + c0) = o;
    }
}
__device__ __forceinline__ void load_row16(const float* __restrict__ src, float (&v)[16], int lane) {
#pragma unroll
    for (int hseg = 0; hseg < 2; ++hseg) {
        const int c0 = hseg * 512 + lane * 8;
        const f32x4 a = *(const f32x4*)(src + c0), b = *(const f32x4*)(src + c0 + 4);
#pragma unroll
        for (int i = 0; i < 4; ++i) { v[hseg * 8 + i] = a[i]; v[hseg * 8 + 4 + i] = b[i]; }
    }
}

__device__ __forceinline__ int even_col_map(int n, int kind) {
    if (kind == 2) {
        if (n < 512) return 1024 + n;
        if (n < 640) return 2056 + 3 * 128 + (n - 512);
        return 2056 + 5 * 128 + (n - 640);
    }
    if (n < 1024) return n;
    if (n < 1536) return 1544 + (n - 1024);
    if (n < 1664) return 2056 + (n - 1536);
    if (n < 1792) return 2056 + 128 + (n - 1664);
    if (n < 1920) return 2056 + 256 + (n - 1792);
    if (n < 2048) return 2056 + 512 + (n - 1920);
    if (n < 2056) return 1536 + (n - 2048);
    if (n < 2080) return 2824 + (n - 2056);
    return -1;
}
__device__ __forceinline__ void transpose_job(const float* __restrict__ src, int K, int N, h16* __restrict__ dst, int Ndst, int mapped, float* tileS, int& base, int b0) {
    const int tid = tidx_(), nb = (int)GRIDV - b0, bid = bidx_() - b0;
    const int nkt = K / 64, nnt = Ndst / 64, ntiles = nkt * nnt;
    int first = (bid - (base % nb) + nb) % nb;
    for (int tile = first; tile < ntiles; tile += nb) {
        const int k0 = (tile % nkt) * 64, n0 = (tile / nkt) * 64;
#pragma unroll
        for (int i = 0; i < 16; ++i) {
            const int e = tid + 256 * i, kk = e >> 6, nn = e & 63;
            const int sc = mapped ? even_col_map(n0 + nn, mapped) : (n0 + nn);
            tileS[kk * 65 + nn] = (sc >= 0) ? src[(size_t)(k0 + kk) * N + sc] : 0.f;
        }
        hsync();
        const int n = tid >> 2, ks = (tid & 3) * 16;
        half8 o0, o1;
#pragma unroll
        for (int i = 0; i < 8; ++i) { o0[i] = (h16)tileS[(ks + i) * 65 + n]; o1[i] = (h16)tileS[(ks + 8 + i) * 65 + n]; }
        h16* d = dst + (size_t)(n0 + n) * K + k0 + ks;
        *(half8*)d = o0; *(half8*)(d + 8) = o1;
        hsync();
    }
    base += ntiles;
}
__device__ __forceinline__ void convert_job(const float* __restrict__ src, h16* __restrict__ dst, size_t n) {
    const size_t n4 = n / 4, stride = (size_t)GRIDV * NTHR;
    for (size_t i = (size_t)bidx_() * NTHR + tidx_(); i < n4; i += stride) {
        const f32x4 v = *(const f32x4*)(src + 4 * i);
        half4 o; o[0] = (h16)v[0]; o[1] = (h16)v[1]; o[2] = (h16)v[2]; o[3] = (h16)v[3];
        *(half4*)(dst + 4 * i) = o;
    }
}
constexpr int ROW6 = 768;
template <int NP>
__device__ __forceinline__ void fp6_rows(const float* __restrict__ src, unsigned char* __restrict__ dst, float* __restrict__ scl, const int (&rps)[NP], int lane) {
    const int hh = lane >> 5, g = lane & 31;
    f32x4 v[NP][8];
#pragma unroll
    for (int q = 0; q < NP; ++q)
#pragma unroll
        for (int c = 0; c < 8; ++c) v[q][c] = *(const f32x4*)(src + (size_t)(rps[q] * 2 + hh) * 1024 + c * 128 + g * 4);
#pragma unroll
    for (int q = 0; q < NP; ++q) {
        float am = 0.f;
#pragma unroll
        for (int c = 0; c < 8; ++c) am = fmaxf(am, fmaxf(fmaxf(fabsf(v[q][c][0]), fabsf(v[q][c][1])), fmaxf(fabsf(v[q][c][2]), fabsf(v[q][c][3]))));
#pragma unroll
        for (int o = 16; o > 0; o >>= 1) am = fmaxf(am, __shfl_xor(am, o));
        const float sc = am > 0.f ? am * (1.0f / 7.5f) : 1.0f, inv = 1.0f / sc;
        h16x32 hv;
#pragma unroll
        for (int c = 0; c < 8; ++c)
#pragma unroll
            for (int j = 0; j < 4; ++j) hv[4 * c + j] = (h16)(v[q][c][j] * inv);
        const u32x6 pk = __builtin_amdgcn_cvt_scalef32_pk32_fp6_f16(hv, 1.0f);
        unsigned char* o = dst + (size_t)(rps[q] * 2 + hh) * ROW6;
        *(i32x4*)(o + g * 16) = (i32x4){(int)pk[0], (int)pk[1], (int)pk[2], (int)pk[3]};
        *(i32x2*)(o + 512 + g * 8) = (i32x2){(int)pk[4], (int)pk[5]};
        if (g == 0) scl[rps[q] * 2 + hh] = sc;
    }
}
__device__ __forceinline__ void fp6_rows_job(const float* __restrict__ src, unsigned char* __restrict__ dst, float* __restrict__ scl, int npairs, int wv0) {
    const int lane = tidx_() & 63, wv = bidx_() * 4 + widx_() - wv0, nwv = GRIDV * 4 - wv0;
    if (wv < 0) return;
    int r = wv;
    for (; r + nwv < npairs; r += 2 * nwv) { const int rps[2] = {r, r + nwv}; fp6_rows<2>(src, dst, scl, rps, lane); }
    for (; r < npairs; r += nwv) { const int rps[1] = {r}; fp6_rows<1>(src, dst, scl, rps, lane); }
}
__device__ __forceinline__ void weight_jobs(PRef p, char* smem, bool first_only, int b0) {
    float* tileS = (float*)smem;
    int base = 0;
    const int jlo = 0, jhi = 28;
    for (int job = jlo; job < jhi; ++job) {
        if (first_only != (job == 0 || job == 4 || job == 6 || job == 7)) continue;
        const float* src; int K, N, Nd; h16* dst; int mapped = 0;
        if (job == 0) { src = p.even_w_in; K = 1024; N = EVEN_IN; dst = p.WtE; Nd = ZLD; mapped = 1; }
        else if (job == 1) { src = p.even_w_out; K = 1024; N = 1024; dst = p.WtEo; Nd = 1024; }
        else if (job == 2) { src = p.odd_w_in; K = 1024; N = 2560; dst = p.WtO; Nd = 2560; }
        else if (job == 3) { src = p.odd_w_out; K = 1280; N = 1024; dst = p.WtOo; Nd = 1024; }
        else if (job == 4) { src = p.even_w_in; K = 1024; N = EVEN_IN; dst = p.WtV; Nd = 768; mapped = 2; }
        else if (job == 5) continue;
        else if (job == 6) { src = p.even_w_cmp_k; K = 2048; N = 64; dst = p.Wc; Nd = 64; }
        else if (job == 7) { src = p.even_w_cmp_v; K = 2048; N = 64; dst = p.Wc + 64 * 2048; Nd = 64; }
        else if (job < 18) { const int n = job - 8; src = p.odd_w_ra + n * 16384; K = 128; N = 128; dst = p.Wr + n * 16384; Nd = 128; }
        else { const int n = job - 18; src = p.odd_w_ri + n * 16384; K = 128; N = 128; dst = p.Wr + (10 + n) * 16384; Nd = 128; }
        transpose_job(src, K, N, dst, Nd, mapped, tileS, base, b0);
    }
}
__device__ __forceinline__ void phase_prep(PRef p, char* smem) {
    weight_jobs(p, smem, true, 0);
    convert_job(p.peer_sub_keys, p.Keys, (size_t)2 * 8 * 2 * 128 * 128);
    convert_job(p.even_cmp_pos, p.Pos16, 2048);
    const int lane = tidx_() & 63, wv = bidx_() * 4 + widx_(), nwv = GRIDV * 4;
    for (int row = wv; row < TOK; row += nwv) {
        float v[16]; load_row16(p.x + (size_t)row * DM, v, lane);
        rms_write_h16(v, p.even_norm_g, p.HN + (size_t)row * DM, lane);
    }
}

enum { EPI_EVEN_IN = 0, EPI_F32_RESID = 1, EPI_H16 = 2, EPI_F32T = 3, EPI_QSCORE = 4 };
struct GemmArgs {
    const h16* A; int lda; const h16* Bt; int ldb; int M, N, K; int a_ntile_stride;
    int mode; h16* c16; int ldc16; float* c32; int ldc32; const float* resid; const h16* aux;
};
template <int MODE, int LDC>
__device__ __forceinline__ void gemm_epilogue(PRef p, const GemmArgs& g, int mt, int nt, bool sw, const f32x4 (&acc)[4][4]) {
    const int lane = tidx_() & 63, wid = widx_(), wm = wid >> 1, wn = wid & 1;
    const int l4 = (lane >> 4) * 4, l15 = lane & 15;
    if (MODE == EPI_EVEN_IN) {
        int kind;
        if (nt < 4 || (nt >= 12 && nt < 16)) kind = 0; else if (nt >= 8 && nt < 12) kind = 2; else if (nt == 19) kind = 3; else if (nt == 21) kind = 4; else if (nt == 22) kind = 5; else kind = 1;
#pragma unroll
        for (int i = 0; i < 4; ++i)
#pragma unroll
            for (int j = 0; j < 4; ++j) {
                const f32x4 v = acc[i][j];
                if (kind <= 1) {
                    const int row = mt * 128 + wm * 64 + j * 16 + l15, col = nt * 128 + wn * 64 + i * 16 + l4;
                    const float sc = kind == 0 ? QSCALE : 1.0f;
                    half4 o; o[0] = (h16)(v[0] * sc); o[1] = (h16)(v[1] * sc); o[2] = (h16)(v[2] * sc); o[3] = (h16)(v[3] * sc);
                    *(half4*)(p.Z + (size_t)row * ZLD + col) = o;
                } else if (kind <= 4) {
                    const int row = mt * 128 + wm * 64 + i * 16 + l4, col = nt * 128 + wn * 64 + j * 16 + l15;
                    const int b = row >> 12, s = row & 4095;
                    half4 o; o[0] = (h16)v[0]; o[1] = (h16)v[1]; o[2] = (h16)v[2]; o[3] = (h16)v[3];
                    h16* dst;
                    if (kind == 2) { const int c = col - 1024; dst = p.VtF + ((size_t)(b * 8 + (c >> 6)) * 64 + (c & 63)) * SEQ + s; }
                    else if (kind == 3) { const int c = col - 2432; dst = p.VtS + ((size_t)(b * 2 + (c >> 6)) * 64 + (c & 63)) * SEQ + s; }
                    else { const int c = col - 2688; dst = p.VtW + ((size_t)(b * 2 + (c >> 6)) * 64 + (c & 63)) * SEQ + s; }
                    *(half4*)dst = o;
                } else {
                    const int row = mt * 128 + wm * 64 + j * 16 + l15, c = nt * 128 + wn * 64 + i * 16 + l4 - 2816;
                    if (c < 32) {
                        f32x4 o;
                        if (c < 8) {
#pragma unroll
                            for (int q = 0; q < 4; ++q) o[q] = log_sigmoid(v[q] + p.even_b_f[c + q]) * LOG2E;
                        } else {
#pragma unroll
                            for (int q = 0; q < 4; ++q) o[q] = sigmoidf_(v[q]);
                        }
                        *(f32x4*)(p.FG + (size_t)row * 32 + c) = o;
                    }
                }
            }
    } else {
#pragma unroll
        for (int i = 0; i < 4; ++i)
#pragma unroll
            for (int j = 0; j < 4; ++j) {
                const f32x4 v = acc[i][j];
                if (MODE == EPI_F32T) {
                    const int row = mt * 128 + wm * 64 + i * 16 + l4, col = nt * 128 + wn * 64 + j * 16 + l15;
                    *(f32x4*)(g.c32 + (size_t)col * TOK + row) = v;
                } else {
                    const int row = mt * 128 + wm * 64 + j * 16 + l15, col = nt * 128 + wn * 64 + i * 16 + l4;
                    if (MODE == EPI_F32_RESID) {
                        const f32x4 r = *(const f32x4*)(g.resid + (size_t)row * LDC + col);
                        *(f32x4*)(g.c32 + (size_t)row * LDC + col) = r + v;
                    } else {
                        half4 o; o[0] = (h16)v[0]; o[1] = (h16)v[1]; o[2] = (h16)v[2]; o[3] = (h16)v[3];
                        *(half4*)(g.c16 + (size_t)row * LDC + col) = o;
                    }
                }
            }
    }
}

template <int MODE, int LDA, int LDB, int GN, int GK, int LDC, int ANS>
__device__ __forceinline__ void phase_gemm(PRef p, const GemmArgs& g, char* smem) {
    h16* As = (h16*)smem;
    h16* Bs = As + 2 * 128 * 64;
    const int tid = tidx_(), lane = tid & 63, wid = widx_(), wm = wid >> 1, wn = wid & 1;
    constexpr int nM = TOK / 128, nN = GN / 128, ntiles = nM * nN, nk = GK / 64;
    const int lr = tid >> 3, lc = tid & 7;
    const int st_off = lr * 64 + ((lc ^ ((tid >> 4) & 7)) * 8);
    const int fsw = (lane & 15) >> 1;
    const int fo0 = (lane & 15) * 64 + ((((lane >> 4)) ^ fsw) * 8), fo1 = (lane & 15) * 64 + (((4 + (lane >> 4)) ^ fsw) * 8);
    for (int tile = bidx_(); tile < ntiles; tile += GRIDV) {
        const int mt = tile / nN, nt = tile % nN;
        bool sw = (MODE != EPI_F32T);
        if (MODE == EPI_EVEN_IN) sw = !((nt >= 8 && nt < 12) || nt == 19 || nt == 21);
        const h16* Ag = g.A + (size_t)(mt * 128 + lr) * LDA + (size_t)nt * ANS + lc * 8;
        const h16* Bg = g.Bt + (size_t)(nt * 128 + lr) * LDB + lc * 8;
        constexpr size_t a32 = (size_t)32 * LDA, b32 = (size_t)32 * LDB;
        f32x4 acc[4][4];
#pragma unroll
        for (int m = 0; m < 4; ++m)
#pragma unroll
            for (int n = 0; n < 4; ++n) acc[m][n] = (f32x4){0.f, 0.f, 0.f, 0.f};
        half8 ra[4], rb[4];
#pragma unroll
        for (int i = 0; i < 4; ++i) { ra[i] = *(const half8*)(Ag + i * a32); rb[i] = *(const half8*)(Bg + i * b32); }
#pragma unroll
        for (int i = 0; i < 4; ++i) { *(half8*)(As + st_off + i * 32 * 64) = ra[i]; *(half8*)(Bs + st_off + i * 32 * 64) = rb[i]; }
        hsync();
        const int pofs = (sw ? wn : wm) * 64 * 64, qofs = (sw ? wm : wn) * 64 * 64;
        for (int kt = 0; kt < nk; ++kt) {
            const int cur = kt & 1;
            if (kt + 1 < nk) {
                const int ko = (kt + 1) * 64;
#pragma unroll
                for (int i = 0; i < 4; ++i) { ra[i] = *(const half8*)(Ag + i * a32 + ko); rb[i] = *(const half8*)(Bg + i * b32 + ko); }
            }
            const h16* Pc = (sw ? Bs : As) + cur * 128 * 64 + pofs;
            const h16* Qc = (sw ? As : Bs) + cur * 128 * 64 + qofs;
#pragma unroll
            for (int ks = 0; ks < 2; ++ks) {
                const int fo = ks ? fo1 : fo0;
                half8 pf[4], qf[4];
#pragma unroll
                for (int i = 0; i < 4; ++i) { pf[i] = *(const half8*)(Pc + i * 16 * 64 + fo); qf[i] = *(const half8*)(Qc + i * 16 * 64 + fo); }
                __builtin_amdgcn_s_setprio(1);
#pragma unroll
                for (int i = 0; i < 4; ++i)
#pragma unroll
                    for (int j = 0; j < 4; ++j) acc[i][j] = __builtin_amdgcn_mfma_f32_16x16x32_f16(pf[i], qf[j], acc[i][j], 0, 0, 0);
                __builtin_amdgcn_s_setprio(0);
            }
            if (kt + 1 < nk) {
                const int nx = (cur ^ 1) * 128 * 64;
#pragma unroll
                for (int i = 0; i < 4; ++i) { *(half8*)(As + nx + st_off + i * 32 * 64) = ra[i]; *(half8*)(Bs + nx + st_off + i * 32 * 64) = rb[i]; }
            }
            hsync();
        }
        if (MODE == EPI_QSCORE) {
            constexpr int QST = 136;
            h16* Qs = (h16*)smem;
            const int l4 = (lane >> 4) * 4, l15 = lane & 15;
#pragma unroll
            for (int i = 0; i < 4; ++i)
#pragma unroll
                for (int j = 0; j < 4; ++j) {
                    const f32x4 v = acc[i][j];
                    half4 o; o[0] = (h16)v[0]; o[1] = (h16)v[1]; o[2] = (h16)v[2]; o[3] = (h16)v[3];
                    *(half4*)(Qs + (wm * 64 + j * 16 + l15) * QST + wn * 64 + i * 16 + l4) = o;
                }
            hsync();
            f32x4 sc[4][4];
#pragma unroll
            for (int i = 0; i < 4; ++i)
#pragma unroll
                for (int j = 0; j < 4; ++j) sc[i][j] = (f32x4){0.f, 0.f, 0.f, 0.f};
            const h16* kb = g.aux + (size_t)(nt * 128 + wn * 64 + l15) * 128 + (lane >> 4) * 8;
#pragma unroll
            for (int ks = 0; ks < 4; ++ks) {
                half8 pf[4], qf[4];
#pragma unroll
                for (int i = 0; i < 4; ++i) { pf[i] = *(const half8*)(Qs + (wm * 64 + i * 16 + l15) * QST + ks * 32 + (lane >> 4) * 8); qf[i] = *(const half8*)(kb + (size_t)i * 16 * 128 + ks * 32); }
#pragma unroll
                for (int i = 0; i < 4; ++i)
#pragma unroll
                    for (int j = 0; j < 4; ++j) sc[i][j] = __builtin_amdgcn_mfma_f32_16x16x32_f16(pf[i], qf[j], sc[i][j], 0, 0, 0);
            }
#pragma unroll
            for (int i = 0; i < 4; ++i)
#pragma unroll
                for (int j = 0; j < 4; ++j) {
                    const int row = mt * 128 + wm * 64 + i * 16 + l4, col = nt * 128 + wn * 64 + j * 16 + l15;
                    *(f32x4*)(g.c32 + (size_t)col * TOK + row) = sc[i][j];
                }
            hsync();
        } else
        gemm_epilogue<MODE, LDC>(p, g, mt, nt, sw, acc);
    }
}

__device__ __forceinline__ void wp_job(PRef p, int wv0) {
    const int lane = tidx_() & 63, wv = bidx_() * 4 + widx_() - wv0, nwv = GRIDV * 4 - wv0;
    if (wv < 0) return;
    for (int u = wv; u < 1024; u += nwv) {
        const int l = u >> 9, hc = (u >> 5) & 15, kh = (u >> 4) & 1, jt = u & 15;
        const float* wq = p.peer_w_q + (size_t)l * 1024 * 2048 + (size_t)(jt * 64 + (lane & 15)) * 2048 + hc * 128 + (lane >> 4) * 8;
        const h16* ky = p.Keys + ((size_t)(l * 16 + hc) * 128 + kh * 64 + (lane & 15)) * 128 + (lane >> 4) * 8;
        f32x4 acc[4][4];
#pragma unroll
        for (int a = 0; a < 4; ++a)
#pragma unroll
            for (int b = 0; b < 4; ++b) acc[a][b] = (f32x4){0.f, 0.f, 0.f, 0.f};
#pragma unroll
        for (int ks = 0; ks < 4; ++ks) {
            half8 af[4], bf[4];
#pragma unroll
            for (int a = 0; a < 4; ++a) {
                const f32x4 w0 = *(const f32x4*)(wq + (size_t)a * 16 * 2048 + ks * 32), w1 = *(const f32x4*)(wq + (size_t)a * 16 * 2048 + ks * 32 + 4);
#pragma unroll
                for (int q = 0; q < 4; ++q) { af[a][q] = (h16)w0[q]; af[a][4 + q] = (h16)w1[q]; }
                bf[a] = *(const half8*)(ky + (size_t)a * 16 * 128 + ks * 32);
            }
#pragma unroll
            for (int a = 0; a < 4; ++a)
#pragma unroll
                for (int b = 0; b < 4; ++b) acc[a][b] = __builtin_amdgcn_mfma_f32_16x16x32_f16(af[a], bf[b], acc[a][b], 0, 0, 0);
        }
        h16* wp = p.WtQ + (size_t)l * 2048 * 1024;
#pragma unroll
        for (int a = 0; a < 4; ++a)
#pragma unroll
            for (int b = 0; b < 4; ++b) {
                const int n = hc * 128 + kh * 64 + b * 16 + (lane & 15), j0 = jt * 64 + a * 16 + (lane >> 4) * 4;
                half4 o; o[0] = (h16)acc[a][b][0]; o[1] = (h16)acc[a][b][1]; o[2] = (h16)acc[a][b][2]; o[3] = (h16)acc[a][b][3];
                *(half4*)(wp + (size_t)n * 1024 + j0) = o;
            }
    }
}
__device__ __forceinline__ void phase_cumsum_compress(PRef p, char* smem) {
    const int lane = tidx_() & 63, wid = widx_(), vb = bidx_();
    if (vb >= 256 && vb < 264) {
        const int u = (vb - 256) * 4 + wid, b = u >> 3, h = u & 7;
        const float* src = p.FG + (size_t)(b * SEQ + lane * 64) * 32 + h;
        float loc[64]; float run = 0.f;
#pragma unroll
        for (int i = 0; i < 64; ++i) { run += src[(size_t)i * 32]; loc[i] = run; }
        float incl = run;
#pragma unroll
        for (int o = 1; o < 64; o <<= 1) { const float t = __shfl_up(incl, o); if (lane >= o) incl += t; }
        const float excl = incl - run;
        float* dst = p.C2 + (size_t)(b * 8 + h) * SEQ + lane * 64;
#pragma unroll
        for (int i = 0; i < 64; ++i) dst[i] = excl + loc[i];
    }
    if (vb < 256) {
        const int cu = vb, kv = cu >> 7, bg = (cu >> 4) & 7, nt = cu & 15;
        const int b = bg >> 1, g = bg & 1;
        int n = nt * 16 + (lane & 15); const int nc = n < 255 ? n : 254;
        const h16* Ab = p.Z + (size_t)(b * SEQ + 16 * nc) * ZLD + 1536 + kv * 128 + g * 64 + (lane >> 4) * 8;
        const h16* Wb = p.Wc + (size_t)kv * 64 * 2048 + (size_t)(lane & 15) * 2048 + (lane >> 4) * 8;
        const h16* Pb = p.Pos16 + (lane >> 4) * 8;
        f32x4 acc[4];
#pragma unroll
        for (int e = 0; e < 4; ++e) acc[e] = (f32x4){0.f, 0.f, 0.f, 0.f};
#pragma unroll
        for (int k2 = 0; k2 < 16; ++k2) {
            const int ks = wid * 16 + k2, l = ks >> 1, d0 = (ks & 1) * 32;
            half8 a = *(const half8*)(Ab + (size_t)l * ZLD + d0);
            const half8 ps = *(const half8*)(Pb + ks * 32);
            a = a + ps;
#pragma unroll
            for (int e = 0; e < 4; ++e) {
                const half8 w = *(const half8*)(Wb + (size_t)e * 16 * 2048 + ks * 32);
                acc[e] = __builtin_amdgcn_mfma_f32_16x16x32_f16(a, w, acc[e], 0, 0, 0);
            }
        }
        f32x4* part = (f32x4*)smem;
#pragma unroll
        for (int e = 0; e < 4; ++e) part[(wid * 4 + e) * 64 + lane] = acc[e];
        hsync();
        {
            const int e = wid;
            const f32x4 s = (part[(0 * 4 + e) * 64 + lane] + part[(1 * 4 + e) * 64 + lane]) + (part[(2 * 4 + e) * 64 + lane] + part[(3 * 4 + e) * 64 + lane]);
            const int n0 = nt * 16 + (lane >> 4) * 4, ec = e * 16 + (lane & 15);
            if (kv == 0) {
#pragma unroll
                for (int j = 0; j < 4; ++j) p.KC[((size_t)bg * 256 + n0 + j) * 64 + ec] = (n0 + j < 255) ? (h16)s[j] : (h16)0.f;
            } else {
                half4 o;
#pragma unroll
                for (int j = 0; j < 4; ++j) o[j] = (n0 + j < 255) ? (h16)s[j] : (h16)0.f;
                *(half4*)(p.VCt + ((size_t)bg * 64 + ec) * 256 + n0) = o;
            }
        }
        hsync();
    }
    weight_jobs(p, smem, false, 0);
    wp_job(p, 0);
    fp6_rows_job(p.peer_u, p.U8, p.US, 8192, 0);
    fp6_rows_job(p.peer_v, p.V8, p.VS, 8192, 0);
}

struct RowState { float m, l; f32x16 o0, o1; };
__device__ __forceinline__ void rs_reset(RowState& s) { s.m = NEGBIG; s.l = 0.f; s.o0 = zero16(); s.o1 = zero16(); }

__device__ __forceinline__ void kv_load(const h16* kb, int kst, const h16* vb, int vst, half8 (&kr)[2], half8 (&vr)[2]) {
    const int tid = tidx_();
#pragma unroll
    for (int i = 0; i < 2; ++i) {
        const int c = tid + 256 * i, row = c >> 3, cc = (c & 7) * 8;
        kr[i] = *(const half8*)(kb + (size_t)row * kst + cc);
        vr[i] = *(const half8*)(vb + (size_t)row * vst + cc);
    }
}
__device__ __forceinline__ void kv_store(h16* Ks, h16* Vs, const half8 (&kr)[2], const half8 (&vr)[2]) {
    const int tid = tidx_();
#pragma unroll
    for (int i = 0; i < 2; ++i) {
        const int c = tid + 256 * i, row = c >> 3, cc = (c & 7) * 8;
        *(half8*)(Ks + row * KST + cc) = kr[i];
        *(half8*)(Vs + row * KST + cc) = vr[i];
    }
}
__device__ __forceinline__ void qk_tile(const h16* Ks, const half8 (&qf)[4], f32x16 (&s)[2], int lane) {
    const int r32 = lane & 31, hh = lane >> 5;
#pragma unroll
    for (int kt = 0; kt < 2; ++kt) {
        s[kt] = zero16();
#pragma unroll
        for (int ks = 0; ks < 4; ++ks) {
            const half8 kf = *(const half8*)(Ks + (kt * 32 + r32) * KST + ks * 16 + hh * 8);
            s[kt] = __builtin_amdgcn_mfma_f32_32x32x16_f16(kf, qf[ks], s[kt], 0, 0, 0);
        }
    }
}
__device__ __forceinline__ void pv_tile(const h16* Vs, const f32x16 (&pr)[2], f32x16& o0, f32x16& o1, int lane) {
    const int r32 = lane & 31, hh = lane >> 5;
#pragma unroll
    for (int kt = 0; kt < 2; ++kt)
#pragma unroll
        for (int s2 = 0; s2 < 2; ++s2) {
            half8 pf;
#pragma unroll
            for (int j = 0; j < 8; ++j) pf[j] = (h16)pr[kt][8 * s2 + j];
            const int kof = kt * 32 + 16 * s2 + 4 * hh;
            {
                const half4 a = *(const half4*)(Vs + r32 * KST + kof), b = *(const half4*)(Vs + r32 * KST + kof + 8);
                half8 vf; vf[0] = a[0]; vf[1] = a[1]; vf[2] = a[2]; vf[3] = a[3]; vf[4] = b[0]; vf[5] = b[1]; vf[6] = b[2]; vf[7] = b[3];
                o0 = __builtin_amdgcn_mfma_f32_32x32x16_f16(vf, pf, o0, 0, 0, 0);
            }
            {
                const half4 a = *(const half4*)(Vs + (32 + r32) * KST + kof), b = *(const half4*)(Vs + (32 + r32) * KST + kof + 8);
                half8 vf; vf[0] = a[0]; vf[1] = a[1]; vf[2] = a[2]; vf[3] = a[3]; vf[4] = b[0]; vf[5] = b[1]; vf[6] = b[2]; vf[7] = b[3];
                o1 = __builtin_amdgcn_mfma_f32_32x32x16_f16(vf, pf, o1, 0, 0, 0);
            }
        }
}

enum { M_FOX = 0, M_SLC = 1, M_WIN = 2 };
template <int MODE, bool MASKED>
__device__ __forceinline__ void flash_step(const h16* Ks, const h16* Vs, const float* csS, const half8 (&qf)[4], RowState& st,
                                           int t, int kpos0, float slope2, float ct2, bool selbit, int lane) {
    const int hh = lane >> 5;
    f32x16 s[2];
    qk_tile(Ks, qf, s, lane);
    int dbase = t - kpos0 - 4 * hh;
    asm volatile("" : "+v"(dbase));
    const float off = (MODE == M_FOX) ? ct2 : -slope2 * (float)dbase;
    float mx = NEGBIG;
#pragma unroll
    for (int kt = 0; kt < 2; ++kt)
#pragma unroll
        for (int r = 0; r < 16; ++r) {
            const int c = kt * 32 + (r & 3) + 8 * (r >> 2);
            float v;
            if (MODE == M_FOX) v = s[kt][r] - csS[c + 4 * hh];
            else v = fmaf(slope2, (float)c, s[kt][r]);
            if (MASKED) {
                const int dist = dbase - c;
                bool valid;
                if (MODE == M_FOX) valid = dist >= 0; else if (MODE == M_SLC) valid = selbit && dist >= 0; else valid = dist >= 0 && dist < 512;
                v = valid ? v : NEGBIG;
            }
            s[kt][r] = v;
            mx = fmaxf(mx, v);
        }
    mx += off;
    mx = fmaxf(mx, __shfl_xor(mx, 32));
    const float mn = fmaxf(st.m, mx);
    const float alpha = __builtin_amdgcn_exp2f(st.m - mn);
    st.m = mn;
    const float moff = mn - off;
    float ps = 0.f;
#pragma unroll
    for (int kt = 0; kt < 2; ++kt)
#pragma unroll
        for (int r = 0; r < 16; ++r) {
            const float v = s[kt][r];
            float pe = __builtin_amdgcn_exp2f(v - moff);
            if (MASKED) pe = v > -1.0e29f ? pe : 0.f;
            s[kt][r] = pe; ps += pe;
        }
    st.l = st.l * alpha + ps;
#pragma unroll
    for (int r = 0; r < 16; ++r) { st.o0[r] *= alpha; st.o1[r] *= alpha; }
    pv_tile(Vs, s, st.o0, st.o1, lane);
}

template <int MODE>
__device__ __forceinline__ void run_flash(u64 mask, const h16* Kg, int kst, const h16* Vg, int vst, const float* csg, char* smem,
                                          const half8 (&qf)[4], RowState& st, int t, int twlo, int twhi, float slope2, float ct2, u64 sel, int lane) {
    h16* Kb = (h16*)smem; h16* Vb = Kb + 2 * 64 * KST; float* csb = (float*)(Vb + 2 * 64 * KST);
    if (mask == 0ull) return;
    half8 kr[2], vr[2]; float csr = 0.f;
    int jc = __builtin_ctzll(mask); mask &= mask - 1;
    kv_load(Kg + (size_t)jc * 64 * kst, kst, Vg + jc * 64, vst, kr, vr);
    if (MODE == M_FOX && tidx_() < 64) csr = csg[jc * 64 + tidx_()];
    kv_store(Kb, Vb, kr, vr);
    if (MODE == M_FOX && tidx_() < 64) csb[tidx_()] = csr;
    hsync();
    int buf = 0;
    for (;;) {
        int jn = -1;
        if (mask) { jn = __builtin_ctzll(mask); mask &= mask - 1; }
        if (jn >= 0) {
            kv_load(Kg + (size_t)jn * 64 * kst, kst, Vg + jn * 64, vst, kr, vr);
            if (MODE == M_FOX && tidx_() < 64) csr = csg[jn * 64 + tidx_()];
        }
        bool need = jc * 64 <= twhi;
        if (MODE == M_WIN) need = need && (jc * 64 + 63 >= twlo - 511);
        if (need) {
            const bool selbit = (sel >> jc) & 1ull;
            bool full = jc * 64 + 63 <= twlo;
            if (MODE == M_WIN) full = full && (jc * 64 > twhi - 512);
            if (MODE == M_SLC) full = full && (__ballot(selbit) == ~0ull);
            if (full) flash_step<MODE, false>(Kb + buf * 64 * KST, Vb + buf * 64 * KST, csb + buf * 64, qf, st, t, jc * 64, slope2, ct2, selbit, lane);
            else flash_step<MODE, true>(Kb + buf * 64 * KST, Vb + buf * 64 * KST, csb + buf * 64, qf, st, t, jc * 64, slope2, ct2, selbit, lane);
        }
        if (jn >= 0) {
            kv_store(Kb + (buf ^ 1) * 64 * KST, Vb + (buf ^ 1) * 64 * KST, kr, vr);
            if (MODE == M_FOX && tidx_() < 64) csb[(buf ^ 1) * 64 + tidx_()] = csr;
        }
        hsync();
        if (jn < 0) break;
        jc = jn; buf ^= 1;
    }
}

__device__ __forceinline__ void load_q(const h16* qrow, half8 (&qf)[4], int lane) {
#pragma unroll
    for (int ks = 0; ks < 4; ++ks) qf[ks] = *(const half8*)(qrow + ks * 16 + (lane >> 5) * 8);
}
__device__ __forceinline__ void store_o(h16* orow, const f32x16& o0, const f32x16& o1, int lane) {
    const int hh = lane >> 5;
#pragma unroll
    for (int rg = 0; rg < 4; ++rg) {
        half4 a, b;
#pragma unroll
        for (int j = 0; j < 4; ++j) { a[j] = (h16)o0[4 * rg + j]; b[j] = (h16)o1[4 * rg + j]; }
        *(half4*)(orow + 8 * rg + 4 * hh) = a;
        *(half4*)(orow + 32 + 8 * rg + 4 * hh) = b;
    }
}

__device__ __forceinline__ void oacc_store(float* row, const f32x16& o0, const f32x16& o1, float sc, int lane) {
    const int hh = lane >> 5;
#pragma unroll
    for (int rg = 0; rg < 4; ++rg) {
        *(f32x4*)(row + 8 * rg + 4 * hh) = (f32x4){o0[4 * rg] * sc, o0[4 * rg + 1] * sc, o0[4 * rg + 2] * sc, o0[4 * rg + 3] * sc};
        *(f32x4*)(row + 32 + 8 * rg + 4 * hh) = (f32x4){o1[4 * rg] * sc, o1[4 * rg + 1] * sc, o1[4 * rg + 2] * sc, o1[4 * rg + 3] * sc};
    }
}
__device__ __forceinline__ void oacc_add(float* row, const f32x16& o0, const f32x16& o1, float sc, int lane) {
    const int hh = lane >> 5;
#pragma unroll
    for (int rg = 0; rg < 4; ++rg) {
        f32x4 a = *(const f32x4*)(row + 8 * rg + 4 * hh), b = *(const f32x4*)(row + 32 + 8 * rg + 4 * hh);
#pragma unroll
        for (int j = 0; j < 4; ++j) { a[j] += o0[4 * rg + j] * sc; b[j] += o1[4 * rg + j] * sc; }
        *(f32x4*)(row + 8 * rg + 4 * hh) = a; *(f32x4*)(row + 32 + 8 * rg + 4 * hh) = b;
    }
}
__device__ __forceinline__ void oacc_final(const float* row, h16* orow, const f32x16& o0, const f32x16& o1, float sc, int lane) {
    const int hh = lane >> 5;
#pragma unroll
    for (int rg = 0; rg < 4; ++rg) {
        const f32x4 a = *(const f32x4*)(row + 8 * rg + 4 * hh), b = *(const f32x4*)(row + 32 + 8 * rg + 4 * hh);
        half4 x, y;
#pragma unroll
        for (int j = 0; j < 4; ++j) { x[j] = (h16)(a[j] + o0[4 * rg + j] * sc); y[j] = (h16)(b[j] + o1[4 * rg + j] * sc); }
        *(half4*)(orow + 8 * rg + 4 * hh) = x; *(half4*)(orow + 32 + 8 * rg + 4 * hh) = y;
    }
}

__device__ __forceinline__ void fox_unit(PRef p, int b, int h, int qt, char* smem) {
    const int tid = tidx_(), lane = tid & 63, wid = widx_();
    const int q0 = qt * 128, t0w = q0 + wid * 32, t = t0w + (lane & 31);
    half8 qf[4]; load_q(p.Z + (size_t)(b * SEQ + t) * ZLD + h * 64, qf, lane);
    const float* csg = p.C2 + (size_t)(b * 8 + h) * SEQ;
    const float ct2 = csg[t];
    RowState st; rs_reset(st);
    const int jmax = (q0 + 127) >> 6;
    const u64 mask = (jmax >= 63) ? ~0ull : ((1ull << (jmax + 1)) - 1ull);
    run_flash<M_FOX>(mask, p.Z + (size_t)b * SEQ * ZLD + 512 + h * 64, ZLD, p.VtF + (size_t)(b * 8 + h) * 64 * SEQ, SEQ, csg, smem,
                     qf, st, t, t0w, t0w + 31, 0.f, ct2, 0ull, lane);
    const float lt = st.l + __shfl_xor(st.l, 32);
    const float inv = 1.0f / lt;
#pragma unroll
    for (int r = 0; r < 16; ++r) { st.o0[r] *= inv; st.o1[r] *= inv; }
    store_o(p.O + (size_t)(b * SEQ + t) * DM + h * 64, st.o0, st.o1, lane);
}

__device__ __forceinline__ void nsa_unit(PRef p, int b, int g, int qt32, char* smem) {
    const int tid = tidx_(), lane = tid & 63, wid = widx_(), hh = lane >> 5, r32 = lane & 31;
    const int t0 = qt32 * 32, t = t0 + r32, head = g * 4 + wid, bg = b * 2 + g;
    const float slope2 = exp2f(-(float)(head + 1)) * LOG2E;
    half8 qf[4]; load_q(p.Z + (size_t)(b * SEQ + t) * ZLD + 1024 + head * 64, qf, lane);
    const float* gp = p.FG + (size_t)(b * SEQ + t) * 32 + 8 + head * 3;
    const float gate_c = gp[0], gate_s = gp[1], gate_w = gp[2];
    h16* Kb = (h16*)smem; h16* Vb = Kb + 2 * 64 * KST;
    u64* selS = (u64*)(smem + 37376);
    u64* unS = selS + 32;
    float* oaccrow = p.OACC + (size_t)(b * SEQ + t) * 512 + head * 64;
    unsigned* impS = (unsigned*)(smem + 37888);
    {
        for (int i = tid; i < 32 * 64; i += NTHR) impS[i] = 0u;
        const int nsteps = ((t0 >> 4) >> 6) + 1;
        const h16* Kg = p.KC + (size_t)bg * 256 * 64; const h16* Vg = p.VCt + (size_t)bg * 64 * 256;
        float mrun = NEGBIG, lrun = 0.f;
        for (int i = 0; i < nsteps; ++i) {
            half8 kr[2], vr[2];
            kv_load(Kg + (size_t)i * 64 * 64, 64, Vg + i * 64, 256, kr, vr);
            kv_store(Kb, Vb, kr, vr);
            hsync();
            f32x16 s[2];
            qk_tile(Kb, qf, s, lane);
            float mx = NEGBIG;
            int dbase = t - 31 - 16 * (i * 64 + 4 * hh);
            asm volatile("" : "+v"(dbase));
#pragma unroll
            for (int kt = 0; kt < 2; ++kt)
#pragma unroll
                for (int r = 0; r < 16; ++r) {
                    const int dist = dbase - 16 * (kt * 32 + (r & 3) + 8 * (r >> 2));
                    float v = s[kt][r] - slope2 * (float)dist;
                    v = dist >= 0 ? v : NEGBIG;
                    s[kt][r] = v; mx = fmaxf(mx, v);
                }
            mx = fmaxf(mx, __shfl_xor(mx, 32));
            const float mn = fmaxf(mrun, mx), alpha = __builtin_amdgcn_exp2f(mrun - mn);
            mrun = mn;
            float ps = 0.f;
#pragma unroll
            for (int kt = 0; kt < 2; ++kt)
#pragma unroll
                for (int r = 0; r < 16; ++r) { const float v = s[kt][r]; ps += v > -1.0e29f ? __builtin_amdgcn_exp2f(v - mn) : 0.f; }
            lrun = lrun * alpha + ps;
            hsync();
        }
        const float lt = lrun + __shfl_xor(lrun, 32);
        const float inv = lt > 0.f ? 1.0f / lt : 0.f;
        f32x16 o0 = zero16(), o1 = zero16();
        float carry = 0.f;
        for (int i = 0; i < nsteps; ++i) {
            half8 kr[2], vr[2];
            kv_load(Kg + (size_t)i * 64 * 64, 64, Vg + i * 64, 256, kr, vr);
            kv_store(Kb, Vb, kr, vr);
            hsync();
            f32x16 s[2];
            qk_tile(Kb, qf, s, lane);
            int dbase = t - 31 - 16 * (i * 64 + 4 * hh);
            asm volatile("" : "+v"(dbase));
#pragma unroll
            for (int kt = 0; kt < 2; ++kt)
#pragma unroll
                for (int r = 0; r < 16; ++r) {
                    const int dist = dbase - 16 * (kt * 32 + (r & 3) + 8 * (r >> 2));
                    const float v = s[kt][r] - slope2 * (float)dist;
                    s[kt][r] = dist >= 0 ? __builtin_amdgcn_exp2f(v - mrun) * inv : 0.f;
                }
            float R[2][4];
#pragma unroll
            for (int kt = 0; kt < 2; ++kt)
#pragma unroll
                for (int rg = 0; rg < 4; ++rg) R[kt][rg] = __shfl_xor(s[kt][4 * rg + 3], 32);
#pragma unroll
            for (int kt = 0; kt < 2; ++kt)
#pragma unroll
                for (int rg = 0; rg < 4; ++rg) {
                    const float G = (s[kt][4 * rg] + s[kt][4 * rg + 1]) + (s[kt][4 * rg + 2] + s[kt][4 * rg + 3]);
                    const float prev = (kt == 0 && rg == 0) ? carry : (rg > 0 ? R[kt][rg - 1] : R[kt - 1][3]);
                    const float val = G + (hh ? R[kt][rg] : prev);
                    const int j = 16 * i + 8 * kt + 2 * rg + hh;
                    atomicAdd(&impS[r32 * 64 + j], (unsigned)(val * 67108864.0f + 0.5f));
                }
            carry = R[1][3];
            pv_tile(Vb, s, o0, o1, lane);
            hsync();
        }
        oacc_store(oaccrow, o0, o1, gate_c, lane);
    }
    hsync();
    {
        u64 un = 0ull;
        for (int i = 0; i < 8; ++i) {
            const int tok = wid * 8 + i, tt = t0 + tok, cur = tt >> 6;
            const int j = lane;
            const bool valid = j <= cur;
            const bool forced = (j == 0) || (j == cur) || (j == cur - 1);
            const unsigned key = valid ? impS[tok * 64 + j] + (forced ? 0x40000000u : 0u) : 0u;
            int rank = 0;
            for (int jj = 0; jj < 64; ++jj) {
                const unsigned kv = (unsigned)__builtin_amdgcn_readlane((int)key, jj);
                rank += (kv > key || (kv == key && jj < j)) ? 1 : 0;
            }
            const u64 selm = __ballot(valid && rank < 16);
            if (lane == 0) selS[tok] = selm;
            un |= selm;
        }
        if (lane == 0) unS[wid] = un;
    }
    hsync();
    const u64 mysel = selS[r32];
    const u64 un = unS[0] | unS[1] | unS[2] | unS[3];
    hsync();
    {
        RowState st; rs_reset(st);
        run_flash<M_SLC>(un, p.Z + (size_t)b * SEQ * ZLD + 1792 + g * 64, ZLD, p.VtS + (size_t)bg * 64 * SEQ, SEQ, nullptr, smem,
                         qf, st, t, t0, t0 + 31, slope2, 0.f, mysel, lane);
        const float lt = st.l + __shfl_xor(st.l, 32);
        oacc_add(oaccrow, st.o0, st.o1, gate_s / lt, lane);
    }
    {
        RowState st; rs_reset(st);
        const int lo = t0 - 511, jlo = lo > 0 ? (lo >> 6) : 0, jhi = (t0 + 31) >> 6;
        u64 mask = (jhi >= 63 ? ~0ull : ((1ull << (jhi + 1)) - 1ull)) & ~((1ull << jlo) - 1ull);
        run_flash<M_WIN>(mask, p.Z + (size_t)b * SEQ * ZLD + 1920 + g * 64, ZLD, p.VtW + (size_t)bg * 64 * SEQ, SEQ, nullptr, smem,
                         qf, st, t, t0, t0 + 31, slope2, 0.f, 0ull, lane);
        const float lt = st.l + __shfl_xor(st.l, 32);
        oacc_final(oaccrow, p.O + (size_t)(b * SEQ + t) * DM + 512 + head * 64, st.o0, st.o1, gate_w / lt, lane);
    }
}

__device__ __forceinline__ void phase_attention(PRef p, char* smem) {
    int* nxt = (int*)(smem + 65536 - 16);
    for (;;) {
        if (tidx_() == 0) *nxt = (int)__hip_atomic_fetch_add(p.BAR + XCD_BAR_WORDS_C, 1u, __ATOMIC_RELAXED, __HIP_MEMORY_SCOPE_AGENT);
        hsync();
        const int q = *nxt;
        hsync();
        if (q >= 2048 + 512) break;
        if (q < 2048 && (q & 3) == 3) {
            const int c = q >> 2, rp0 = (c & 255) * 32 + widx_() * 8, lane = tidx_() & 63;
            const float* srcp = (c < 256 ? p.peer_u : p.peer_v) + (size_t)16384 * 1024;
            unsigned char* dstp = (c < 256 ? p.U8 : p.V8) + (size_t)16384 * 1024;
            float* sclp = (c < 256 ? p.US : p.VS) + 16384;
            for (int i = 0; i < 8; i += 2) { const int rps[2] = {rp0 + i, rp0 + i + 1}; fp6_rows<2>(srcp, dstp, sclp, rps, lane); }
            continue;
        }
        const int u = q < 2048 ? q - ((q + 1) >> 2) : q - 512;
        const int st = 31 - (u >> 6), w = u & 63;
        if (w & 1) { const int idx = w >> 1; nsa_unit(p, (idx & 7) >> 1, idx & 1, st * 4 + (idx >> 3), smem); }
        else { const int idx = w >> 1; fox_unit(p, idx >> 3, idx & 7, st, smem); }
    }
}

__device__ __forceinline__ void phase_rmsnorm(PRef p, const float* g) {
    const int lane = tidx_() & 63, wv = bidx_() * 4 + widx_(), nwv = GRIDV * 4;
    for (int row = wv; row < TOK; row += nwv) {
        float v[16]; load_row16(p.H + (size_t)row * DM, v, lane);
        rms_write_h16(v, g, p.HN + (size_t)row * DM, lane);
    }
}

__device__ __forceinline__ unsigned fkey(float f) { const unsigned b = __float_as_uint(f); return b ^ ((b >> 31) ? 0xFFFFFFFFu : 0x80000000u); }
__device__ __forceinline__ float fkey_inv(unsigned k) { return __uint_as_float(k ^ ((k >> 31) ? 0x80000000u : 0xFFFFFFFFu)); }
__device__ __forceinline__ void ce_desc(unsigned& a, unsigned& b) { const unsigned hi = a > b ? a : b, lo = a > b ? b : a; a = hi; b = lo; }
__device__ __forceinline__ void sort16_desc(unsigned (&k)[16]) {
#pragma unroll
    for (int size = 2; size <= 16; size <<= 1)
#pragma unroll
        for (int stride = size >> 1; stride > 0; stride >>= 1)
#pragma unroll
            for (int i = 0; i < 16; ++i) {
                const int j = i ^ stride;
                if (j > i) { if ((i & size) == 0) ce_desc(k[i], k[j]); else ce_desc(k[j], k[i]); }
            }
}
__device__ __forceinline__ void merge16_desc(unsigned (&run)[16], const unsigned (&b)[16]) {
#pragma unroll
    for (int i = 0; i < 16; ++i) run[i] = run[i] > b[15 - i] ? run[i] : b[15 - i];
#pragma unroll
    for (int stride = 8; stride > 0; stride >>= 1)
#pragma unroll
        for (int i = 0; i < 16; ++i) { const int j = i ^ stride; if (j > i) ce_desc(run[i], run[j]); }
}
__device__ __forceinline__ void list_top16(const h16* __restrict__ base, unsigned (&run)[16]) {
    h16 cur[16], nxt[16];
#pragma unroll
    for (int i = 0; i < 16; ++i) cur[i] = base[(size_t)i * TOK];
#pragma unroll 1
    for (int bt = 0; bt < 8; ++bt) {
        if (bt < 7) {
#pragma unroll
            for (int i = 0; i < 16; ++i) nxt[i] = base[(size_t)((bt + 1) * 16 + i) * TOK];
        }
        unsigned kb[16];
#pragma unroll
        for (int i = 0; i < 16; ++i) kb[i] = (fkey((float)cur[i]) & ~127u) | (unsigned)(127 - (bt * 16 + i));
        sort16_desc(kb);
        if (bt == 0) {
#pragma unroll
            for (int i = 0; i < 16; ++i) run[i] = kb[i];
        } else merge16_desc(run, kb);
#pragma unroll
        for (int i = 0; i < 16; ++i) cur[i] = nxt[i];
    }
}
__device__ __forceinline__ void phase_peer_topk(PRef p, char* smem) {
    const int tid = tidx_(), lane = tid & 63, wv = bidx_() * 4 + widx_(), nwv = GRIDV * 4;
    int* idS = (int*)smem; float* evS = (float*)smem + 16 * NTHR;
    for (int u = wv; u < 8 * (TOK / 64); u += nwv) {
        const int h = u >> 8, tk = (u & 255) * 64 + lane;
        const h16* b0 = p.SC + (size_t)(h * 256) * TOK + tk;
        unsigned k0[16], k1[16];
        list_top16(b0, k0);
        list_top16(b0 + (size_t)128 * TOK, k1);
        float v0[16], v1[16]; int i0[16], i1[16];
#pragma unroll
        for (int j = 0; j < 16; ++j) {
            v0[j] = fkey_inv(k0[j] & ~127u); i0[j] = 127 - (int)(k0[j] & 127u);
            v1[j] = fkey_inv(k1[j] & ~127u); i1[j] = 127 - (int)(k1[j] & 127u);
        }
        unsigned run[16];
        {
            unsigned kb[16]; int n = 0, nb = 0;
#pragma unroll
            for (int a = 0; a < 16; ++a)
#pragma unroll
                for (int b = 0; b < 16; ++b)
                    if ((a + 1) * (b + 1) <= 16) {
                        kb[n] = fkey(v0[a] + v1[b]); ++n;
                        if (n == 16) {
                            sort16_desc(kb);
                            if (nb == 0) {
#pragma unroll
                                for (int i = 0; i < 16; ++i) run[i] = kb[i];
                            } else merge16_desc(run, kb);
                            n = 0; ++nb;
                        }
                    }
#pragma unroll
            for (int i = 2; i < 16; ++i) kb[i] = 0u;
            sort16_desc(kb); merge16_desc(run, kb);
        }
        const unsigned tkey = run[15]; const float smax = fkey_inv(run[0]);
        int cnt = 0; float esum = 0.f;
#pragma unroll
        for (int j = 0; j < 16; ++j) { idS[j * NTHR + tid] = 0; evS[j * NTHR + tid] = 0.f; }
#pragma unroll
        for (int pass = 0; pass < 2; ++pass)
#pragma unroll
            for (int a = 0; a < 16; ++a)
#pragma unroll
                for (int b = 0; b < 16; ++b)
                    if ((a + 1) * (b + 1) <= 16) {
                        const float s = v0[a] + v1[b]; const unsigned ks = fkey(s);
                        const bool take = pass == 0 ? (ks > tkey) : (ks == tkey && cnt < 16);
                        if (take) {
                            const float e = __expf(s - smax);
                            idS[cnt * NTHR + tid] = i0[a] * 128 + i1[b]; evS[cnt * NTHR + tid] = e;
                            esum += e; ++cnt;
                        }
                    }
        const float rinv = 1.0f / esum;
        int* ip = p.IDS + (size_t)tk * 128 + h * 16; float* gp = p.GW + (size_t)tk * 128 + h * 16;
#pragma unroll
        for (int q = 0; q < 4; ++q) {
            *(i32x4*)(ip + 4 * q) = (i32x4){idS[(4 * q) * NTHR + tid], idS[(4 * q + 1) * NTHR + tid], idS[(4 * q + 2) * NTHR + tid], idS[(4 * q + 3) * NTHR + tid]};
            *(f32x4*)(gp + 4 * q) = (f32x4){evS[(4 * q) * NTHR + tid] * rinv, evS[(4 * q + 1) * NTHR + tid] * rinv, evS[(4 * q + 2) * NTHR + tid] * rinv, evS[(4 * q + 3) * NTHR + tid] * rinv};
        }
    }
}

struct Q6 { i32x4 a; i32x2 b; };
__device__ __forceinline__ Q6 ld6(const unsigned char* row, int g) { Q6 r; r.a = *(const i32x4*)(row + g * 16); r.b = *(const i32x2*)(row + 512 + g * 8); return r; }
__device__ __forceinline__ u32x6 mk6(const Q6 q) { u32x6 r; r[0] = q.a[0]; r[1] = q.a[1]; r[2] = q.a[2]; r[3] = q.a[3]; r[4] = q.b[0]; r[5] = q.b[1]; return r; }
__device__ __forceinline__ float dot32_fp6h(const h16x32 xv, const Q6 q) {
    const h16x32 uf = __builtin_amdgcn_cvt_scalef32_pk32_f16_fp6(mk6(q), 1.0f);
    float d0 = 0.f, d1 = 0.f;
#pragma unroll
    for (int m = 0; m < 16; m += 2) {
        d0 = __builtin_amdgcn_fdot2((half2v){uf[2 * m], uf[2 * m + 1]}, (half2v){xv[2 * m], xv[2 * m + 1]}, d0, false);
        d1 = __builtin_amdgcn_fdot2((half2v){uf[2 * m + 2], uf[2 * m + 3]}, (half2v){xv[2 * m + 2], xv[2 * m + 3]}, d1, false);
    }
    return d0 + d1;
}
__device__ __forceinline__ void axpy32_fp6(f32x2 (&acc)[16], float w, const Q6 q) {
    const f32x32 vf = __builtin_amdgcn_cvt_scalef32_pk32_f32_fp6(mk6(q), 1.0f);
    const f32x2 ww = {w, w};
#pragma unroll
    for (int m = 0; m < 16; ++m) acc[m] = __builtin_elementwise_fma(ww, (f32x2){vf[2 * m], vf[2 * m + 1]}, acc[m]);
}
constexpr int ET_SHIFT = 9, ET_N = 16384 >> ET_SHIFT;
__device__ __forceinline__ void phase_peer_experts(PRef p, int layer, const float* gnext, int mode, char* smem) {
    const int lane = tidx_() & 63, wid = widx_(), wv = bidx_() * 4 + wid, nwv = GRIDV * 4;
    const int hh = lane >> 5, g = lane & 31, dpl = (lane >> 2) & 7;
    const unsigned char* U = p.U8 + (size_t)layer * 16384 * 1024; const unsigned char* V = p.V8 + (size_t)layer * 16384 * 1024;
    const float* US = p.US + layer * 16384; const float* VS = p.VS + layer * 16384;
    const bool b4 = (lane & 16) != 0, b3 = (lane & 8) != 0, b2 = (lane & 4) != 0;
    int* sid = (int*)smem + wid * 512 + hh * 128;
    float* sgw = (float*)(sid + 256);
    for (int tb = wv * 2; tb < TOK; tb += nwv * 2) {
        const int tk = tb + hh;
        h16x32 xv;
#pragma unroll
        for (int c = 0; c < 8; ++c) {
            const half4 t = *(const half4*)(p.HN + (size_t)tk * DM + c * 128 + g * 4);
#pragma unroll
            for (int j = 0; j < 4; ++j) xv[4 * c + j] = t[j];
        }
        {
            int idv[4]; float gv[4];
#pragma unroll
            for (int s = 0; s < 4; ++s) { idv[s] = p.IDS[(size_t)tk * 128 + s * 32 + g]; gv[s] = p.GW[(size_t)tk * 128 + s * 32 + g]; }
            int cnt = 0;
            const unsigned below = (1u << g) - 1u;
            for (int e = 0; e < ET_N; ++e) {
#pragma unroll
                for (int s = 0; s < 4; ++s) {
                    const bool in = (idv[s] >> ET_SHIFT) == e;
                    const u64 m = __ballot(in);
                    const unsigned mh = hh ? (unsigned)(m >> 32) : (unsigned)m;
                    if (in) { const int pos = cnt + __popc(mh & below); sid[pos] = idv[s]; sgw[pos] = gv[s]; }
                    cnt += __popc(mh);
                }
            }
        }
        f32x2 acc[16];
#pragma unroll
        for (int i = 0; i < 16; ++i) acc[i] = (f32x2){0.f, 0.f};
        for (int bt = 0; bt < 16; ++bt) {
            const int mine = sid[bt * 8 + dpl]; const float gwm = sgw[bt * 8 + dpl];
            const float usm = US[mine], vsm = VS[mine];
            const i32x4 ida = *(const i32x4*)(sid + bt * 8), idb = *(const i32x4*)(sid + bt * 8 + 4);
            Q6 uq[8], vq[8];
#pragma unroll
            for (int k = 0; k < 8; ++k) {
                const unsigned off = (unsigned)(k < 4 ? ida[k & 3] : idb[k & 3]) * ROW6;
                uq[k] = ld6(U + off, g); vq[k] = ld6(V + off, g);
            }
            float d[8];
#pragma unroll
            for (int k = 0; k < 8; ++k) d[k] = dot32_fp6h(xv, uq[k]);
            float r4[4], r2[2], z;
#pragma unroll
            for (int i = 0; i < 4; ++i) { const float keep = b4 ? d[i + 4] : d[i], send = b4 ? d[i] : d[i + 4]; r4[i] = keep + __shfl_xor(send, 16); }
#pragma unroll
            for (int i = 0; i < 2; ++i) { const float keep = b3 ? r4[i + 2] : r4[i], send = b3 ? r4[i] : r4[i + 2]; r2[i] = keep + __shfl_xor(send, 8); }
            { const float keep = b2 ? r2[1] : r2[0], send = b2 ? r2[0] : r2[1]; z = keep + __shfl_xor(send, 4); }
            z += __shfl_xor(z, 2); z += __shfl_xor(z, 1);
            const float wm = gwm * gelu_exact(z * usm) * vsm;
#pragma unroll
            for (int k = 0; k < 8; ++k) {
                const float w0 = __builtin_bit_cast(float, __builtin_amdgcn_readlane(__builtin_bit_cast(int, wm), 4 * k));
                const float w1 = __builtin_bit_cast(float, __builtin_amdgcn_readlane(__builtin_bit_cast(int, wm), 32 + 4 * k));
                axpy32_fp6(acc, hh ? w1 : w0, vq[k]);
            }
        }
        float hv[32];
        {
            const float* hr = p.H + (size_t)tk * DM + g * 4;
#pragma unroll
            for (int c = 0; c < 8; ++c) { const f32x4 t = *(const f32x4*)(hr + c * 128); hv[4 * c] = t[0] + acc[2 * c][0]; hv[4 * c + 1] = t[1] + acc[2 * c][1]; hv[4 * c + 2] = t[2] + acc[2 * c + 1][0]; hv[4 * c + 3] = t[3] + acc[2 * c + 1][1]; }
        }
        float ss = 0.f;
#pragma unroll
        for (int i = 0; i < 32; ++i) ss += hv[i] * hv[i];
#pragma unroll
        for (int o = 16; o > 0; o >>= 1) ss += __shfl_xor(ss, o);
        const float rstd = rsqrtf(ss * (1.0f / 1024.0f) + 1e-6f);
        const float* gr = gnext + g * 4;
        if (mode == 0) {
            float* hw = p.H + (size_t)tk * DM + g * 4;
#pragma unroll
            for (int c = 0; c < 8; ++c) {
                *(f32x4*)(hw + c * 128) = (f32x4){hv[4 * c], hv[4 * c + 1], hv[4 * c + 2], hv[4 * c + 3]};
                const f32x4 ga = *(const f32x4*)(gr + c * 128);
                half4 o;
#pragma unroll
                for (int j = 0; j < 4; ++j) o[j] = (h16)(hv[4 * c + j] * rstd * ga[j]);
                *(half4*)(p.HN + (size_t)tk * DM + c * 128 + g * 4) = o;
            }
        } else {
            float* ow = p.out + (size_t)tk * DM + g * 4;
#pragma unroll
            for (int c = 0; c < 8; ++c) { const f32x4 ga = *(const f32x4*)(gr + c * 128); *(f32x4*)(ow + c * 128) = (f32x4){hv[4 * c] * rstd * ga[0], hv[4 * c + 1] * rstd * ga[1], hv[4 * c + 2] * rstd * ga[2], hv[4 * c + 3] * rstd * ga[3]}; }
        }
    }
}

constexpr int XST = 136;
__device__ __forceinline__ float fast_sigmoid(float v) { return __builtin_amdgcn_rcpf(1.0f + __expf(-v)); }
__device__ __forceinline__ float gelu_as(float v) {
    const float av = fabsf(v), t = __builtin_amdgcn_rcpf(av * 0.2316419f + 1.0f);
    float q = t * 0.5307027145f - 0.7265760135f; q = q * t + 0.7107068705f; q = q * t - 0.142248368f; q = q * t + 0.127414796f; q = q * t;
    const float e = __builtin_amdgcn_exp2f(v * v * -0.72134752044f);
    const float m = v * (q * e);
    return v < 0.f ? m : v - m;
}
__device__ __forceinline__ void phase_rnn_gates(PRef p, char* smem) {
    h16* xcS = (h16*)smem;
    float* aggS = (float*)(smem + 64 * XST * 2);
    h16* laS = (h16*)(smem + 64 * XST * 2 + 4096);
    h16* ruS = laS + 64 * XST;
    const int tid = tidx_(), lane = tid & 63, wid = widx_();
    for (int u = bidx_(); u < 4 * 64 * 10; u += GRIDV) {
        const int nb = u % 10, ck = (u / 10) & 63, b = u / 640;
        const int s0 = ck * 64, ch0 = nb * 128;
        {
            const int c8 = (tid & 15) * 8, tq = (tid >> 4) * 4, ch = ch0 + c8;
            float w[4][8], bias[8];
#pragma unroll
            for (int j = 0; j < 4; ++j) {
                const f32x4 w0 = *(const f32x4*)(p.odd_conv_w + j * DRNN + ch), w1 = *(const f32x4*)(p.odd_conv_w + j * DRNN + ch + 4);
#pragma unroll
                for (int i = 0; i < 4; ++i) { w[j][i] = w0[i]; w[j][4 + i] = w1[i]; }
            }
            { const f32x4 b0 = *(const f32x4*)(p.odd_conv_b + ch), b1 = *(const f32x4*)(p.odd_conv_b + ch + 4);
#pragma unroll
              for (int i = 0; i < 4; ++i) { bias[i] = b0[i]; bias[4 + i] = b1[i]; } }
            half8 xin[7];
#pragma unroll
            for (int r = 0; r < 7; ++r) {
                const int sp = s0 + tq - 3 + r;
                if (sp >= 0) xin[r] = *(const half8*)(p.Z2 + (size_t)(b * SEQ + sp) * Z2LD + DRNN + ch);
                else {
#pragma unroll
                    for (int i = 0; i < 8; ++i) xin[r][i] = (h16)0.f;
                }
            }
#pragma unroll
            for (int tt = 0; tt < 4; ++tt) {
                half8 o;
#pragma unroll
                for (int i = 0; i < 8; ++i) {
                    float a = bias[i];
#pragma unroll
                    for (int j = 0; j < 4; ++j) a = fmaf(w[j][i], (float)xin[tt + j][i], a);
                    o[i] = (h16)a;
                }
                *(half8*)(xcS + (tq + tt) * XST + c8) = o;
            }
        }
        hsync();
        float bra8[8], bri8[8], sp8[8];
#pragma unroll
        for (int e = 0; e < 8; ++e) {
            const int chq = ch0 + e * 16 + (lane & 15);
            bra8[e] = p.odd_b_ra[chq]; bri8[e] = p.odd_b_ri[chq]; sp8[e] = p.odd_lam[chq];
        }
#pragma unroll
        for (int e = 0; e < 8; ++e) sp8[e] = fmaxf(-sp8[e], 0.f) + __logf(1.0f + __expf(-fabsf(sp8[e])));
        f32x4 ar[8], ai[8];
#pragma unroll
        for (int e = 0; e < 8; ++e) { ar[e] = (f32x4){0.f, 0.f, 0.f, 0.f}; ai[e] = (f32x4){0.f, 0.f, 0.f, 0.f}; }
        const h16* wr = p.Wr + (size_t)nb * 16384 + (lane & 15) * 128 + (lane >> 4) * 8;
        const h16* wi = p.Wr + (size_t)(10 + nb) * 16384 + (lane & 15) * 128 + (lane >> 4) * 8;
#pragma unroll
        for (int ks = 0; ks < 4; ++ks) {
            const half8 a = *(const half8*)(xcS + (wid * 16 + (lane & 15)) * XST + ks * 32 + (lane >> 4) * 8);
#pragma unroll
            for (int e = 0; e < 8; ++e) {
                const half8 w1 = *(const half8*)(wr + e * 16 * 128 + ks * 32), w2 = *(const half8*)(wi + e * 16 * 128 + ks * 32);
                ar[e] = __builtin_amdgcn_mfma_f32_16x16x32_f16(a, w1, ar[e], 0, 0, 0);
                ai[e] = __builtin_amdgcn_mfma_f32_16x16x32_f16(a, w2, ai[e], 0, 0, 0);
            }
        }
        const int g4 = lane >> 4;
#pragma unroll
        for (int e = 0; e < 8; ++e) {
            const int cl = e * 16 + (lane & 15), ch = ch0 + cl;
            const float bra = bra8[e], bri = bri8[e], sp = sp8[e];
            float A = 1.f, H = 0.f;
#pragma unroll
            for (int j = 0; j < 4; ++j) {
                const int tt = wid * 16 + g4 * 4 + j;
                const float r = fast_sigmoid(ar[e][j] + bra), ig = fast_sigmoid(ai[e][j] + bri);
                const h16 la16 = (h16)(-8.0f * r * sp);
                const float a = __expf((float)la16);
                const float xc = (float)xcS[tt * XST + cl];
                const h16 u16 = (h16)(__builtin_amdgcn_sqrtf(fmaxf(1.0f - a * a, 0.f)) * (ig * xc));
                laS[tt * XST + cl] = la16; ruS[tt * XST + cl] = u16;
                H = a * H + (float)u16; A *= a;
            }
            { const float Al = __shfl_xor(A, 16), Hl = __shfl_xor(H, 16); if (g4 & 1) { H = Hl * A + H; A = Al * A; } }
            { const float Al = __shfl_xor(A, 32), Hl = __shfl_xor(H, 32); if (g4 == 3) { H = Hl * A + H; A = Al * A; } }
            if (g4 == 3) { aggS[(wid * 128 + cl) * 2] = A; aggS[(wid * 128 + cl) * 2 + 1] = H; }
        }
        hsync();
        if (tid < 128) {
            float A = 1.f, H = 0.f;
#pragma unroll
            for (int w = 0; w < 4; ++w) { const float Aw = aggS[(w * 128 + tid) * 2], Hw = aggS[(w * 128 + tid) * 2 + 1]; H = H * Aw + Hw; A *= Aw; }
            p.AggP[(size_t)(b * 64 + ck) * DRNN + ch0 + tid] = A; p.AggH[(size_t)(b * 64 + ck) * DRNN + ch0 + tid] = H;
        }
#pragma unroll
        for (int i = 0; i < 4; ++i) {
            const int q = tid + 256 * i, row = q >> 4, c8 = (q & 15) * 8;
            const size_t o = (size_t)(b * SEQ + s0 + row) * DRNN + ch0 + c8;
            *(half8*)(p.LA + o) = *(const half8*)(laS + row * XST + c8);
            *(half8*)(p.RU + o) = *(const half8*)(ruS + row * XST + c8);
        }
        hsync();
    }
}
__device__ __forceinline__ void phase_rnn_scan_b(PRef p) {
    for (int u = bidx_(); u < 4 * 64 * 5; u += GRIDV) {
        const int cb = u % 5, ck = (u / 5) & 63, b = u / 320;
        const int ch = cb * 256 + tidx_();
        float h = 0.f;
        {
            const float* ap = p.AggP + (size_t)(b * 64) * DRNN + ch; const float* hp = p.AggH + (size_t)(b * 64) * DRNN + ch;
            for (int c = 0; c < ck; c += 16) {
                float pa[16], ph[16];
#pragma unroll
                for (int i = 0; i < 16; ++i) { const int ci = min(c + i, ck - 1); pa[i] = ap[(size_t)ci * DRNN]; ph[i] = hp[(size_t)ci * DRNN]; }
#pragma unroll
                for (int i = 0; i < 16; ++i) { const bool ok = c + i < ck; h = (ok ? pa[i] : 1.0f) * h + (ok ? ph[i] : 0.f); }
            }
        }
        const size_t base = (size_t)(b * SEQ + ck * 64) * DRNN + ch;
        h16* zrow = p.Z2 + (size_t)(b * SEQ + ck * 64) * Z2LD;
#pragma unroll 1
        for (int i0 = 0; i0 < 64; i0 += 32) {
            h16 la[32], uu[32], gt[32];
#pragma unroll
            for (int i = 0; i < 32; ++i) { la[i] = p.LA[base + (size_t)(i0 + i) * DRNN]; uu[i] = p.RU[base + (size_t)(i0 + i) * DRNN]; gt[i] = zrow[(size_t)(i0 + i) * Z2LD + ch]; }
#pragma unroll
            for (int i = 0; i < 32; ++i) {
                h = __expf((float)la[i]) * h + (float)uu[i];
                zrow[(size_t)(i0 + i) * Z2LD + DRNN + ch] = (h16)(gelu_as((float)gt[i]) * h);
            }
        }
    }
}

#define XB_TMO      128
#define XB_XCNT(j)  (256  + 64 * (j))
#define XB_XSUB(j)  (1280 + 64 * (j))
#define XB_XGEN(j)  (2304 + 64 * (j))
#define XB_TOP      3328
#define XB_TOPGEN   3392
#define XCD_BAR_WORDS 3456
#define XB_SPIN_CAP (1u << 22)
__device__ __forceinline__ unsigned xb_ld(unsigned* p)              { return __hip_atomic_load(p, __ATOMIC_RELAXED, __HIP_MEMORY_SCOPE_AGENT); }
__device__ __forceinline__ unsigned xb_add(unsigned* p, unsigned v) { return __hip_atomic_fetch_add(p, v, __ATOMIC_RELAXED, __HIP_MEMORY_SCOPE_AGENT); }
__device__ __forceinline__ unsigned xb_xcc_id() { return (unsigned)__builtin_amdgcn_s_getreg((3 << 11) | 20) & 0xFu; }
#define XB_SPIN(cond, bar) do { unsigned _sp = 0; while (cond) { __builtin_amdgcn_s_sleep(1); \
    if ((++_sp & 255u) == 0u) { if (xb_ld(&(bar)[XB_TMO])) break; if (_sp > XB_SPIN_CAP) { atomicAdd(&(bar)[XB_TMO], 1u); break; } } } } while (0)
struct XcdBarrier { unsigned* bar; unsigned x; volatile LAS unsigned* st; };
__device__ __forceinline__ XcdBarrier xcd_barrier_post(unsigned* bar, volatile LAS unsigned* st) {
    XcdBarrier b; b.bar = bar; b.x = xb_xcc_id(); b.st = st;
    if (threadIdx.x == 0) (void)xb_add(&bar[XB_XCNT(b.x)], 1u);
    return b;
}
__device__ __forceinline__ void xcd_barrier_complete(unsigned* bar, unsigned x, unsigned& nloc, unsigned& nx) {
    const unsigned G = gridDim.x * gridDim.y * gridDim.z;
    unsigned sum, cnt, mine, sp = 0u;
    for (;;) {
        sum = 0u; cnt = 0u; mine = 0u;
#pragma unroll
        for (unsigned j = 0; j < 16; ++j) { const unsigned c = xb_ld(&bar[XB_XCNT(j)]); sum += c; cnt += (c > 0u) ? 1u : 0u; mine = (j == x) ? c : mine; }
        if (sum == G) break;
        __builtin_amdgcn_s_sleep(1);
        if ((++sp & 255u) == 0u) { if (xb_ld(&bar[XB_TMO])) break; if (sp > XB_SPIN_CAP) { atomicAdd(&bar[XB_TMO], 1u); break; } }
    }
    nloc = mine > 0u ? mine : 1u; nx = cnt > 0u ? cnt : 1u;
}
__device__ __forceinline__ void xcd_barrier(const XcdBarrier& b) {
    asm volatile("s_waitcnt vmcnt(0)" ::: "memory");
    __syncthreads();
    if (threadIdx.x == 0) {
        unsigned* bar = b.bar;
        __builtin_amdgcn_s_waitcnt(0);
        unsigned nloc = b.st[0], nx = b.st[1];
        if (nloc == 0u) { xcd_barrier_complete(bar, b.x, nloc, nx); b.st[0] = nloc; b.st[1] = nx; }
        const unsigned old = xb_add(&bar[XB_XSUB(b.x)], 1u);
        const unsigned gen = old / nloc;
        if (old + 1u == (gen + 1u) * nloc) {
            __builtin_amdgcn_fence(__ATOMIC_RELEASE, "agent");
            asm volatile("s_waitcnt vmcnt(0)" ::: "memory");
            const unsigned og = xb_add(&bar[XB_TOP], 1u);
            const unsigned tg = og / nx;
            if (og + 1u == (tg + 1u) * nx) xb_add(&bar[XB_TOPGEN], 1u);
            else XB_SPIN(xb_ld(&bar[XB_TOPGEN]) == tg, bar);
            __builtin_amdgcn_fence(__ATOMIC_ACQUIRE, "agent");
            xb_add(&bar[XB_XGEN(b.x)], 1u);
            asm volatile("s_waitcnt vmcnt(0)" ::: "memory");
        } else {
            XB_SPIN(xb_ld(&bar[XB_XGEN(b.x)]) == gen, bar);
            __builtin_amdgcn_fence(__ATOMIC_ACQUIRE, "agent");
            asm volatile("s_waitcnt vmcnt(0)" ::: "memory");
        }
    }
    __syncthreads();
}

namespace pg8 {
#define PG8_LAS __attribute__((address_space(3)))
typedef unsigned short bf16_t;
typedef short bf16x8 __attribute__((ext_vector_type(8)));
typedef unsigned u32x4 __attribute__((ext_vector_type(4)));
constexpr int BM = 256, BK = 64, HALF = 128, HTB = HALF * BK * 2  , STAGE_BYTES = 8 * HTB, NXCD = 8, WGM = 8;

__host__ __device__ __forceinline__ int lds_byte(int r, int c) { const int st = (r >> 4) * 2 + (c >> 5), rr = r & 15, cc = c & 31, ob = rr * 64 + cc * 2; return st * 1024 + (ob ^ (((ob >> 9) & 1) << 5)); }
__host__ __device__ __forceinline__ void stage_rc(int b, int& R, int& C) { const int st = b / 1024, sb = b % 1024, swz = sb ^ (((sb >> 9) & 1) << 5); R = (st >> 1) * 16 + swz / 64; C = (st & 1) * 32 + (swz % 64) / 2; }
__host__ __device__ __forceinline__ int perm32(int rho) { const int n = rho >> 4, i = rho & 15; return 8 * (i >> 2) + 4 * n + (i & 3); }

struct Unit { int pm, pn; };
struct Gemm { const bf16_t* A; const bf16_t* Bt; int M, N, K, lda; };

struct StaticOrder {
    int nM, nN, nwg, G, c;
    __host__ __device__ void init(int M, int N, int G_, int c_) { nM = M / BM; nN = N / BM; nwg = nM * nN; G = G_; c = c_; }
    __host__ __device__ bool next(int i, Unit& u) const {
        const long L = (long)i * G + c; if (L >= nwg) return false;
        int wgid = (int)L; { const int q = nwg / NXCD, r = nwg % NXCD, xcd = wgid % NXCD, off = wgid / NXCD; wgid = (xcd < r ? xcd * (q + 1) : r * (q + 1) + (xcd - r) * q) + off; }
        const int nig = WGM * nN, gid = wgid / nig, fm = gid * WGM, gsz = (nM - fm) < WGM ? (nM - fm) : WGM;
        u.pm = fm + ((wgid % nig) % gsz); u.pn = (wgid % nig) / gsz; return true;
    }
    __device__ __forceinline__ void a_ready(const Unit&) const {}
    __device__ __forceinline__ void done(const Unit&) const {}
};
__device__ __forceinline__ unsigned pk_h16(float lo, float hi) { half2v t; t[0] = (h16)lo; t[1] = (h16)hi; return __builtin_bit_cast(unsigned, t); }
struct EpiResid {
    static constexpr bool PERM = false, AFTER_DRAIN = false;
    const float* resid; float* out; int ldc;
    __device__ __forceinline__ void operator()(const f32x4 (&acc)[2][2][4][2], const Unit& u, int wr, int wc, int fr, int fq) const {
#pragma unroll
        for (int ai = 0; ai < 2; ++ai)
#pragma unroll
            for (int m = 0; m < 4; ++m) { const size_t ro = (size_t)(u.pm * BM + ai * HALF + wr * 64 + m * 16 + fr) * ldc + u.pn * BM + wc * 32 + 4 * fq;
#pragma unroll
                for (int bj = 0; bj < 2; ++bj)
#pragma unroll
                    for (int n = 0; n < 2; ++n) { const size_t o = ro + bj * HALF + n * 16; *(f32x4*)(out + o) = *(const f32x4*)(resid + o) + acc[ai][bj][m][n]; } }
    }
};
struct EpiF32 {
    static constexpr bool PERM = false, AFTER_DRAIN = false;
    float* out; size_t ldc;
    __device__ __forceinline__ void operator()(const f32x4 (&acc)[2][2][4][2], const Unit& u, int wr, int wc, int fr, int fq) const {
#pragma unroll
        for (int ai = 0; ai < 2; ++ai)
#pragma unroll
            for (int m = 0; m < 4; ++m) { const size_t ro = (size_t)(u.pm * BM + ai * HALF + wr * 64 + m * 16 + fr) * ldc + u.pn * BM + wc * 32 + 4 * fq;
#pragma unroll
                for (int bj = 0; bj < 2; ++bj)
#pragma unroll
                    for (int n = 0; n < 2; ++n) *(f32x4*)(out + ro + bj * HALF + n * 16) = acc[ai][bj][m][n]; }
    }
};
struct EpiH16 {
    static constexpr bool PERM = true, AFTER_DRAIN = false;
    h16* out; int ldc;
    __device__ __forceinline__ void operator()(const f32x4 (&acc)[2][2][4][2], const Unit& u, int wr, int wc, int fr, int fq) const {
#pragma unroll
        for (int ai = 0; ai < 2; ++ai)
#pragma unroll
            for (int m = 0; m < 4; ++m) { h16* rowp = out + (size_t)(u.pm * BM + ai * HALF + wr * 64 + m * 16 + fr) * ldc + u.pn * BM + wc * 32 + 8 * fq;
#pragma unroll
                for (int bj = 0; bj < 2; ++bj) { const f32x4 v0 = acc[ai][bj][m][0], v1 = acc[ai][bj][m][1];
                    u32x4 w; w.x = pk_h16(v0[0], v0[1]); w.y = pk_h16(v0[2], v0[3]); w.z = pk_h16(v1[0], v1[1]); w.w = pk_h16(v1[2], v1[3]);
                    *(u32x4*)(rowp + bj * HALF) = w; } }
    }
};
struct EpiEvenMain {
    static constexpr bool PERM = true, AFTER_DRAIN = false;
    h16* Z; float* FG; const float* b_f;
    __device__ __forceinline__ void operator()(const f32x4 (&acc)[2][2][4][2], const Unit& u, int wr, int wc, int fr, int fq) const {
#pragma unroll
        for (int bj = 0; bj < 2; ++bj) {
            const int col0 = u.pn * BM + bj * HALF + wc * 32 + 8 * fq;
            if (col0 < 2048) {
                const float sc = (col0 < 512 || (col0 >= 1024 && col0 < 1536)) ? QSCALE : 1.0f;
#pragma unroll
                for (int ai = 0; ai < 2; ++ai)
#pragma unroll
                    for (int m = 0; m < 4; ++m) { const f32x4 v0 = acc[ai][bj][m][0] * sc, v1 = acc[ai][bj][m][1] * sc;
                        u32x4 w; w.x = pk_h16(v0[0], v0[1]); w.y = pk_h16(v0[2], v0[3]); w.z = pk_h16(v1[0], v1[1]); w.w = pk_h16(v1[2], v1[3]);
                        *(u32x4*)(Z + (size_t)(u.pm * BM + ai * HALF + wr * 64 + m * 16 + fr) * ZLD + col0) = w; }
            } else if (col0 < 2080) {
                const int c = col0 - 2048;
#pragma unroll
                for (int ai = 0; ai < 2; ++ai)
#pragma unroll
                    for (int m = 0; m < 4; ++m) { const f32x4 v0 = acc[ai][bj][m][0], v1 = acc[ai][bj][m][1]; f32x4 o0, o1;
                        if (c == 0) {
#pragma unroll
                            for (int q = 0; q < 4; ++q) { o0[q] = log_sigmoid(v0[q] + b_f[q]) * LOG2E; o1[q] = log_sigmoid(v1[q] + b_f[4 + q]) * LOG2E; }
                        } else {
#pragma unroll
                            for (int q = 0; q < 4; ++q) { o0[q] = sigmoidf_(v0[q]); o1[q] = sigmoidf_(v1[q]); }
                        }
                        float* fr_ = FG + (size_t)(u.pm * BM + ai * HALF + wr * 64 + m * 16 + fr) * 32 + c;
                        *(f32x4*)fr_ = o0; *(f32x4*)(fr_ + 4) = o1; }
            }
        }
    }
};
struct EpiVt {
    static constexpr bool PERM = true, AFTER_DRAIN = false;
    h16 *VtF, *VtS, *VtW;
    __device__ __forceinline__ void operator()(const f32x4 (&acc)[2][2][4][2], const Unit& u, int wr, int wc, int fr, int fq) const {
#pragma unroll
        for (int ai = 0; ai < 2; ++ai)
#pragma unroll
            for (int m = 0; m < 4; ++m) {
                const int n = u.pm * BM + ai * HALF + wr * 64 + m * 16 + fr;
#pragma unroll
                for (int bj = 0; bj < 2; ++bj) {
                    const int t0 = u.pn * BM + bj * HALF + wc * 32 + 8 * fq, b = t0 >> 12, s = t0 & 4095;
                    h16* dst = n < 512 ? VtF + ((size_t)(b * 512 + n)) * SEQ + s : (n < 640 ? VtS + ((size_t)(b * 128 + n - 512)) * SEQ + s : VtW + ((size_t)(b * 128 + n - 640)) * SEQ + s);
                    const f32x4 v0 = acc[ai][bj][m][0], v1 = acc[ai][bj][m][1];
                    u32x4 w; w.x = pk_h16(v0[0], v0[1]); w.y = pk_h16(v0[2], v0[3]); w.z = pk_h16(v1[0], v1[1]); w.w = pk_h16(v1[2], v1[3]);
                    *(u32x4*)dst = w;
                }
            }
    }
};

template <class Epi, class Sched, bool ALIGN_EPI = false, bool SP2 = false>
__device__ __forceinline__ void gemm_phase(PG8_LAS unsigned char* lds, const Gemm g, const Sched& S, const Epi& E) {
    int tid_ = threadIdx.x; asm volatile("" : "+v"(tid_));
    const int tid = tid_, wid = __builtin_amdgcn_readfirstlane(tid >> 6), lane = tid & 63, wr = wid >> 2, wc = wid & 3, fr = lane & 15, fq = lane >> 4;
    const int K = g.K, nt = K / BK;
    unsigned voffA[2], voffB[2];
#pragma unroll
    for (int i = 0; i < 2; ++i) { int R, C; stage_rc(tid * 16 + i * 8192, R, C); const int Rb = Epi::PERM ? ((R & ~31) + perm32(R & 31)) : R;
        voffA[i] = (unsigned)(R * g.lda + C) * 2u; voffB[i] = (unsigned)(Rb * K + C) * 2u; }
    const size_t kstep = (size_t)(BK * 2);
    const size_t hstepA = (size_t)HALF * g.lda * 2, hstepB = (size_t)HALF * K * 2;
    const size_t tstepA = 2 * hstepA, tstepB = 2 * hstepB;
    const unsigned ldsw = (unsigned)wid * 1024u;
    const int aoff = lds_byte(wr * 64 + fr, fq * 8), boff = lds_byte(wc * 32 + fr, fq * 8);
#define PG8_SA(b, h) (((b) * 2 + (h)) * HTB)
#define PG8_SB(b, h) ((4 + (b) * 2 + (h)) * HTB)
#define PG8_STAGE(bufoff, gbase, voff) do { _Pragma("unroll") for (int _i = 0; _i < 2; ++_i) \
        __builtin_amdgcn_global_load_lds((const unsigned*)((const char*)(gbase) + (voff)[_i]), (PG8_LAS unsigned*)(lds + (bufoff) + ldsw + _i * 8192), 16, 0, 0); } while (0)
#define PG8_LDA(dst, b, h) do { _Pragma("unroll") for (int m = 0; m < 4; ++m) _Pragma("unroll") for (int k = 0; k < 2; ++k) dst[m][k] = *(const PG8_LAS bf16x8*)(lds + PG8_SA(b, h) + aoff + m * 2048 + k * 1024); } while (0)
#define PG8_LDB(dst, b, h) do { _Pragma("unroll") for (int n = 0; n < 2; ++n) _Pragma("unroll") for (int k = 0; k < 2; ++k) dst[n][k] = *(const PG8_LAS bf16x8*)(lds + PG8_SB(b, h) + boff + n * 2048 + k * 1024); } while (0)
#define PG8_MMA(ai, bj, At, Bt) do { __builtin_amdgcn_s_setprio(1); _Pragma("unroll") for (int m = 0; m < 4; ++m) _Pragma("unroll") for (int n = 0; n < 2; ++n) _Pragma("unroll") for (int k = 0; k < 2; ++k) \
        acc[ai][bj][m][n] = __builtin_amdgcn_mfma_f32_16x16x32_f16(__builtin_bit_cast(half8, Bt[n][k]), __builtin_bit_cast(half8, At[m][k]), acc[ai][bj][m][n], 0, 0, 0); __builtin_amdgcn_s_setprio(0); } while (0)
#define PG8_WAIT_V(n) asm volatile("s_waitcnt vmcnt(" #n ")" ::: "memory")
#define PG8_WAIT_L(n) asm volatile("s_waitcnt lgkmcnt(" #n ")" ::: "memory")
#define PG8_BAR __builtin_amdgcn_s_barrier()
#define PG8_SCHED __builtin_amdgcn_sched_barrier(0)
    Unit cur, nxt; int ui = 0;
    if (!S.next(0, cur)) return;
    f32x4 acc[2][2][4][2];
#pragma unroll
    for (int a = 0; a < 2; ++a)
#pragma unroll
        for (int b = 0; b < 2; ++b)
#pragma unroll
            for (int m = 0; m < 4; ++m)
#pragma unroll
                for (int n = 0; n < 2; ++n) acc[a][b][m][n] = (f32x4){0.f, 0.f, 0.f, 0.f};
    bf16x8 At[4][2], B0[2][2], B1[2][2];
    const char* cA = (const char*)g.A + (size_t)cur.pm * tstepA; const char* cB = (const char*)g.Bt + (size_t)cur.pn * tstepB;
    S.a_ready(cur);
    if constexpr (SP2) {
        PG8_STAGE(PG8_SB(0, 0), cB, voffB); PG8_STAGE(PG8_SB(0, 1), cB + hstepB, voffB); PG8_STAGE(PG8_SA(0, 0), cA, voffA); PG8_STAGE(PG8_SA(0, 1), cA + hstepA, voffA);
        if (wr == 1) PG8_BAR;
        PG8_WAIT_V(2); PG8_BAR;
        PG8_STAGE(PG8_SB(1, 0), cB + kstep, voffB); PG8_STAGE(PG8_SA(1, 0), cA + kstep, voffA); PG8_STAGE(PG8_SB(1, 1), cB + hstepB + kstep, voffB);
        PG8_WAIT_V(6); PG8_BAR;
    } else {
        PG8_STAGE(PG8_SB(0, 0), cB, voffB); PG8_STAGE(PG8_SA(0, 0), cA, voffA); PG8_STAGE(PG8_SB(0, 1), cB + hstepB, voffB); PG8_STAGE(PG8_SA(0, 1), cA + hstepA, voffA);
        if (wr == 1) PG8_BAR;
        PG8_WAIT_V(4); PG8_BAR;
        PG8_STAGE(PG8_SB(1, 0), cB + kstep, voffB); PG8_STAGE(PG8_SA(1, 0), cA + kstep, voffA); PG8_STAGE(PG8_SB(1, 1), cB + hstepB + kstep, voffB);
        PG8_WAIT_V(6); PG8_BAR;
    }
    for (;;) {
        const bool has_next = S.next(ui + 1, nxt);
        const char* nA = has_next ? (const char*)g.A + (size_t)nxt.pm * tstepA : cA; const char* nB = has_next ? (const char*)g.Bt + (size_t)nxt.pn * tstepB : cB;
        for (int t = 0; t < nt; t += 2) {
            const bool last = (t == nt - 2);
            const char* a1 = cA + (size_t)(t + 1) * kstep;
            const char* a2 = last ? nA : cA + (size_t)(t + 2) * kstep; const char* b2 = last ? nB : cB + (size_t)(t + 2) * kstep;
            const char* a3 = a2 + kstep; const char* b3 = b2 + kstep;
            if (last && has_next) S.a_ready(nxt);
            if constexpr (SP2) {
            PG8_LDB(B0, 0, 0); PG8_LDB(B1, 0, 1); PG8_SCHED; PG8_LDA(At, 0, 0); PG8_STAGE(PG8_SA(1, 1), a1 + hstepA, voffA);
            PG8_WAIT_V(8); PG8_WAIT_L(0); PG8_BAR; PG8_MMA(0, 0, At, B0); PG8_MMA(0, 1, At, B1); PG8_BAR; PG8_SCHED;
            PG8_LDA(At, 0, 1); PG8_STAGE(PG8_SB(0, 0), b2, voffB); PG8_STAGE(PG8_SB(0, 1), b2 + hstepB, voffB); PG8_STAGE(PG8_SA(0, 0), a2, voffA);
            PG8_WAIT_V(8); PG8_WAIT_L(0); PG8_BAR; PG8_MMA(1, 0, At, B0); PG8_MMA(1, 1, At, B1); PG8_BAR; PG8_SCHED;
            PG8_LDB(B0, 1, 0); PG8_LDB(B1, 1, 1); PG8_SCHED; PG8_LDA(At, 1, 0); PG8_STAGE(PG8_SA(0, 1), a2 + hstepA, voffA);
            PG8_WAIT_V(8); PG8_WAIT_L(0); PG8_BAR; PG8_MMA(0, 0, At, B0); PG8_MMA(0, 1, At, B1); PG8_BAR; PG8_SCHED;
            PG8_LDA(At, 1, 1); PG8_STAGE(PG8_SB(1, 0), b3, voffB); PG8_STAGE(PG8_SB(1, 1), b3 + hstepB, voffB); PG8_STAGE(PG8_SA(1, 0), a3, voffA);
            PG8_WAIT_V(8); PG8_WAIT_L(0); PG8_BAR; PG8_MMA(1, 0, At, B0); PG8_MMA(1, 1, At, B1); PG8_BAR; PG8_SCHED;
            } else {
            PG8_LDB(B0, 0, 0); PG8_SCHED; PG8_LDA(At, 0, 0); PG8_STAGE(PG8_SA(1, 1), a1 + hstepA, voffA);
            PG8_WAIT_L(8); PG8_BAR; PG8_WAIT_L(0); PG8_MMA(0, 0, At, B0); PG8_BAR; PG8_SCHED;
            PG8_LDB(B1, 0, 1); PG8_STAGE(PG8_SB(0, 0), b2, voffB);
            PG8_BAR; PG8_WAIT_L(0); PG8_MMA(0, 1, At, B1); PG8_BAR;
            PG8_LDA(At, 0, 1); PG8_STAGE(PG8_SA(0, 0), a2, voffA);
            PG8_BAR; PG8_WAIT_L(0); PG8_MMA(1, 0, At, B0); PG8_BAR; PG8_SCHED;
            PG8_STAGE(PG8_SB(0, 1), b2 + hstepB, voffB);
            PG8_WAIT_V(6); PG8_BAR; PG8_MMA(1, 1, At, B1); PG8_BAR;
            PG8_LDB(B0, 1, 0); PG8_SCHED; PG8_LDA(At, 1, 0); PG8_STAGE(PG8_SA(0, 1), a2 + hstepA, voffA);
            PG8_WAIT_L(8); PG8_BAR; PG8_WAIT_L(0); PG8_MMA(0, 0, At, B0); PG8_BAR; PG8_SCHED;
            PG8_LDB(B1, 1, 1); PG8_STAGE(PG8_SB(1, 0), b3, voffB);
            PG8_BAR; PG8_WAIT_L(0); PG8_MMA(0, 1, At, B1); PG8_BAR;
            PG8_LDA(At, 1, 1); PG8_STAGE(PG8_SA(1, 0), a3, voffA);
            PG8_BAR; PG8_WAIT_L(0); PG8_MMA(1, 0, At, B0); PG8_BAR; PG8_SCHED;
            PG8_STAGE(PG8_SB(1, 1), b3 + hstepB, voffB);
            PG8_WAIT_V(6); PG8_BAR; PG8_MMA(1, 1, At, B1); PG8_BAR;
            }
        }
        if constexpr (ALIGN_EPI) { if (wr == 0) PG8_BAR; }
        if constexpr (!Epi::AFTER_DRAIN) { E(acc, cur, wr, wc, fr, fq); S.done(cur); }
        if (!has_next) break;
#pragma unroll
        for (int a = 0; a < 2; ++a)
#pragma unroll
            for (int b = 0; b < 2; ++b)
#pragma unroll
                for (int m = 0; m < 4; ++m)
#pragma unroll
                    for (int n = 0; n < 2; ++n) acc[a][b][m][n] = (f32x4){0.f, 0.f, 0.f, 0.f};
        cur = nxt; cA = nA; cB = nB; ++ui;
        if constexpr (ALIGN_EPI) { if (wr == 1) PG8_BAR; }
    }
    PG8_WAIT_V(0);
    if constexpr (!ALIGN_EPI) { if (wr == 0) PG8_BAR; }
    PG8_BAR;
    if constexpr (Epi::AFTER_DRAIN) { E.fused(acc, cur, wr, wc, fr, fq, lds, wid, lane); S.done(cur); }
#undef PG8_SA
#undef PG8_SB
#undef PG8_STAGE
#undef PG8_LDA
#undef PG8_LDB
#undef PG8_MMA
#undef PG8_WAIT_V
#undef PG8_WAIT_L
#undef PG8_BAR
#undef PG8_SCHED
}
}

__device__ __forceinline__ GemmArgs mk_gemm(const h16* A, int lda, const h16* Bt, int ldb, int M, int N, int K, int ans, int mode, h16* c16, int ldc16, float* c32, int ldc32, const float* resid) {
    GemmArgs g; g.A = A; g.lda = lda; g.Bt = Bt; g.ldb = ldb; g.M = M; g.N = N; g.K = K; g.a_ntile_stride = ans; g.mode = mode; g.c16 = c16; g.ldc16 = ldc16; g.c32 = c32; g.ldc32 = ldc32; g.resid = resid; g.aux = nullptr; return g;
}

__device__ __forceinline__ void run_phase(PRef p, int ph, char* smem) {
    if (ph == 1 || ph == 4 || ph == 6 || ph == 10 || ph == 14 || ph == 16) {
        PG8_LAS unsigned char* lds = (PG8_LAS unsigned char*)dyn_lds;
        const int G = (int)gridDim.x, c = (int)blockIdx.x;
        pg8::StaticOrder S;
        typedef const pg8::bf16_t* bp;
        if (ph == 1) {
            { pg8::EpiEvenMain E{p.Z, p.FG, p.even_b_f}; S.init(TOK, ZLD, G, c);
              pg8::gemm_phase<pg8::EpiEvenMain, pg8::StaticOrder, true, true>(lds, pg8::Gemm{(bp)p.HN, (bp)p.WtE, TOK, ZLD, DM, DM}, S, E); }
            { pg8::EpiVt E{p.VtF, p.VtS, p.VtW}; S.init(768, TOK, G, (c + 3 * G / 4) % G);
              pg8::gemm_phase<pg8::EpiVt, pg8::StaticOrder, true, true>(lds, pg8::Gemm{(bp)p.WtV, (bp)p.HN, 768, TOK, DM, DM}, S, E); }
        } else if (ph == 4) {
            pg8::EpiResid E{p.x, p.H, DM}; S.init(TOK, DM, G, c);
            pg8::gemm_phase<pg8::EpiResid, pg8::StaticOrder, true, true>(lds, pg8::Gemm{(bp)p.O, (bp)p.WtEo, TOK, DM, DM, DM}, S, E);
        } else if (ph == 14) {
            pg8::EpiResid E{p.H, p.H, DM}; S.init(TOK, DM, G, c);
            pg8::gemm_phase<pg8::EpiResid, pg8::StaticOrder, true, true>(lds, pg8::Gemm{(bp)(p.Z2 + DRNN), (bp)p.WtOo, TOK, DM, DRNN, Z2LD}, S, E);
        } else if (ph == 10) {
            pg8::EpiH16 E{p.Z2, Z2LD}; S.init(TOK, Z2LD, G, c);
            pg8::gemm_phase<pg8::EpiH16, pg8::StaticOrder, true, true>(lds, pg8::Gemm{(bp)p.HN, (bp)p.WtO, TOK, Z2LD, DM, DM}, S, E);
        } else {
            pg8::EpiH16 E{p.SC, TOK}; S.init(2048, TOK, G, c);
            pg8::gemm_phase<pg8::EpiH16, pg8::StaticOrder, true, true>(lds, pg8::Gemm{(bp)(p.WtQ + (ph == 16 ? (size_t)2048 * 1024 : 0)), (bp)p.HN, 2048, TOK, DM, DM}, S, E);
        }
        return;
    }
    if (ph == 0) phase_prep(p, smem);
    else if (ph == 2) phase_cumsum_compress(p, smem);
    else if (ph == 3) phase_attention(p, smem);
    else if (ph == 5 || ph == 15) phase_rmsnorm(p, ph == 5 ? p.ffn_norm_g : p.ffn_norm_g + DM);
    else if (ph == 8 || ph == 18) phase_peer_topk(p, smem);
    else if (ph == 9 || ph == 19) phase_peer_experts(p, ph == 19 ? 1 : 0, ph == 19 ? p.final_g : p.odd_norm_g, ph == 19 ? 1 : 0, smem);
    else if (ph == 11) phase_rnn_gates(p, smem);
    else if (ph == 13) phase_rnn_scan_b(p);
}

__global__ void __launch_bounds__(512, 2) mega(Params p_by_value) {
    char* smem = dyn_lds + hidx_() * 65536;
    volatile LAS unsigned* hs_all = (volatile LAS unsigned*)(dyn_lds + 131072);
    const __attribute__((address_space(4))) Params* kp = (const __attribute__((address_space(4))) Params*)__builtin_amdgcn_kernarg_segment_ptr();
    const int ph0 = (int)kp->ph0, ph1 = (int)kp->ph1;
    if (threadIdx.x < 12) hs_all[threadIdx.x] = 0u;
    __syncthreads();
    XcdBarrier xb = xcd_barrier_post(kp->BAR, hs_all + 8);
    for (int ph = ph0; ph < ph1; ++ph) {
        if (ph == 12 || ph == 7 || ph == 17) continue;
        const __attribute__((address_space(4))) Params* q = kp;
        asm volatile("" : "+s"(q));
        PRef p = *q;
#if PROBE_PH >= 0
        if (blockIdx.x == 0 && threadIdx.x == 0) p.TS[ph] = __builtin_amdgcn_s_memrealtime();
#endif
        const int reps = ((DUP_MASK >> ph) & 1) ? 2 : 1;
        for (int r = 0; r < reps; ++r) { run_phase(p, ph, smem); if (r + 1 < reps) xcd_barrier(xb); }
        if (ph + 1 < ph1) xcd_barrier(xb);
    }
    PRef p = *kp;
#if PROBE_PH >= 0
    cg::this_grid().sync();
    if (blockIdx.x == 0 && threadIdx.x == 0) { p.TS[NPHASE] = __builtin_amdgcn_s_memrealtime(); __threadfence(); }
    cg::this_grid().sync();
    {
        const unsigned long long t0 = __hip_atomic_load(&p.TS[0], __ATOMIC_RELAXED, __HIP_MEMORY_SCOPE_AGENT), t1 = __hip_atomic_load(&p.TS[NPHASE], __ATOMIC_RELAXED, __HIP_MEMORY_SCOPE_AGENT);
        const unsigned long long a = __hip_atomic_load(&p.TS[PROBE_PH], __ATOMIC_RELAXED, __HIP_MEMORY_SCOPE_AGENT), b = __hip_atomic_load(&p.TS[PROBE_PH + PROBE_N], __ATOMIC_RELAXED, __HIP_MEMORY_SCOPE_AGENT);
        const float frac = (float)(b - a) / (float)(t1 - t0);
        const float scale = 1.1f + frac;
        for (size_t i = (size_t)blockIdx.x * 512 + threadIdx.x; i < (size_t)TOK * DM; i += (size_t)gridDim.x * 512) p.out[i] *= scale;
    }
#endif
}

constexpr int DYN_LDS_BYTES = 131072 + 64;
extern "C" void kernel_launch(void* const* d_in, const int* in_sizes, int n_in, void* d_out, int out_size, void* d_ws, size_t ws_size, hipStream_t stream) {
    Params p; memset(&p, 0, sizeof(p));
    const float* const* in = (const float* const*)d_in;
    p.x = in[0]; p.even_norm_g = in[1]; p.even_w_in = in[2]; p.even_b_f = in[3]; p.even_cmp_pos = in[4]; p.even_w_cmp_k = in[5]; p.even_w_cmp_v = in[6]; p.even_w_out = in[7];
    p.odd_norm_g = in[8]; p.odd_w_in = in[9]; p.odd_conv_w = in[10]; p.odd_conv_b = in[11]; p.odd_w_ra = in[12]; p.odd_b_ra = in[13]; p.odd_w_ri = in[14]; p.odd_b_ri = in[15];
    p.odd_lam = in[16]; p.odd_w_out = in[17]; p.ffn_norm_g = in[18]; p.peer_w_q = in[19]; p.peer_sub_keys = in[20]; p.peer_u = in[21]; p.peer_v = in[22]; p.final_g = in[23];
    p.out = (float*)d_out;
    char* ws = (char*)d_ws; size_t off = 0;
    auto take = [&](size_t bytes) { char* r = ws + off; off += (bytes + 255) & ~(size_t)255; return r; };
    p.WtE = (h16*)take((size_t)ZLD * 1024 * 2); p.WtV = (h16*)take((size_t)768 * 1024 * 2); p.WtEo = (h16*)take((size_t)1024 * 1024 * 2); p.WtO = (h16*)take((size_t)2560 * 1024 * 2); p.WtOo = (h16*)take((size_t)1024 * 1280 * 2);
    p.WtQ = (h16*)take((size_t)2 * 2048 * 1024 * 2); p.Wc = (h16*)take((size_t)2 * 64 * 2048 * 2); p.Wr = (h16*)take((size_t)20 * 16384 * 2); p.Keys = (h16*)take((size_t)2 * 8 * 2 * 128 * 128 * 2);
    p.Pos16 = (h16*)take(4096); p.U8 = (unsigned char*)take((size_t)2 * 16384 * 1024); p.V8 = (unsigned char*)take((size_t)2 * 16384 * 1024);
    p.US = (float*)take((size_t)2 * 16384 * 4); p.VS = (float*)take((size_t)2 * 16384 * 4);
    p.H = (float*)take((size_t)TOK * DM * 4); p.HN = (h16*)take((size_t)TOK * DM * 2);
    const size_t scratch0 = off;
    p.Z = (h16*)take((size_t)TOK * ZLD * 2); p.VtF = (h16*)take((size_t)4 * 8 * 64 * SEQ * 2); p.VtS = (h16*)take((size_t)4 * 2 * 64 * SEQ * 2); p.VtW = (h16*)take((size_t)4 * 2 * 64 * SEQ * 2);
    p.KC = (h16*)take((size_t)8 * 256 * 64 * 2); p.VCt = (h16*)take((size_t)8 * 64 * 256 * 2); p.O = (h16*)take((size_t)TOK * DM * 2); p.FG = (float*)take((size_t)TOK * 32 * 4); p.C2 = (float*)take((size_t)32 * SEQ * 4); p.OACC = (float*)take((size_t)TOK * 512 * 4);
    size_t mx = off;
    off = scratch0;
    p.QP = (h16*)take((size_t)TOK * 2048 * 2); p.SC = (h16*)take((size_t)TOK * 2048 * 2); p.IDS = (int*)take((size_t)TOK * 128 * 4); p.GW = (float*)take((size_t)TOK * 128 * 4);
    if (off > mx) mx = off;
    off = scratch0;
    p.Z2 = (h16*)take((size_t)TOK * Z2LD * 2); p.LA = (h16*)take((size_t)TOK * DRNN * 2); p.RU = (h16*)take((size_t)TOK * DRNN * 2);
    p.AggP = (float*)take((size_t)4 * 64 * DRNN * 4); p.AggH = (float*)take((size_t)4 * 64 * DRNN * 4);
    if (off > mx) mx = off;
    off = mx; p.TS = (unsigned long long*)take(256); p.BAR = (unsigned*)take(XCD_BAR_WORDS * 4 + 256); mx = off;
    if (mx > ws_size) { fprintf(stderr, "workspace too small: need %zu have %zu\n", mx, ws_size); return; }

    static int grid_blocks = 0;
    if (!grid_blocks) {
        int dev = 0, cus = 0, per_cu = 0;
        hipGetDevice(&dev);
        hipDeviceGetAttribute(&cus, hipDeviceAttributeMultiprocessorCount, dev);
        hipFuncSetAttribute((const void*)mega, hipFuncAttributeMaxDynamicSharedMemorySize, DYN_LDS_BYTES);
        hipOccupancyMaxActiveBlocksPerMultiprocessor(&per_cu, mega, 512, DYN_LDS_BYTES);
        if (per_cu > 1) per_cu = 1;
        if (per_cu < 1) per_cu = 1;
        grid_blocks = cus * per_cu;
    }
    hipMemsetAsync(p.BAR, 0, XCD_BAR_WORDS * 4 + 256, stream);
#if SINGLE_LAUNCH
    p.ph0 = 0; p.ph1 = NPHASE;
    void* args[] = {&p};
    hipError_t e = hipLaunchCooperativeKernel((void*)mega, dim3(grid_blocks), dim3(512), args, DYN_LDS_BYTES, stream);
    if (e != hipSuccess) fprintf(stderr, "cooperative launch failed: %s (grid %d)\n", hipGetErrorString(e), grid_blocks);
#else
    for (int ph = 0; ph < NPHASE; ++ph) {
        p.ph0 = ph; p.ph1 = ph + 1;
        hipLaunchKernelGGL(mega, dim3(grid_blocks), dim3(512), DYN_LDS_BYTES, stream, p);
    }
#endif
}
```

```cpp
#include <hip/hip_runtime.h>
#include <hip/hip_cooperative_groups.h>
#include <cstdio>
#include <cstdint>
#include <cstring>
namespace cg = cooperative_groups;

#ifndef SINGLE_LAUNCH
#define SINGLE_LAUNCH 1
#endif
#ifndef PROBE_PH
#define PROBE_PH -1
#endif
#ifndef PROBE_N
#define PROBE_N 1
#endif
#ifndef DUP_MASK
#define DUP_MASK 0
#endif

typedef _Float16 h16;
typedef _Float16 half8 __attribute__((ext_vector_type(8)));
typedef _Float16 half4 __attribute__((ext_vector_type(4)));
typedef _Float16 half2v __attribute__((ext_vector_type(2)));
typedef float f32x4 __attribute__((ext_vector_type(4)));
typedef float f32x16 __attribute__((ext_vector_type(16)));
typedef unsigned long long u64;
typedef int i32x4 __attribute__((ext_vector_type(4)));
typedef float f32x2 __attribute__((ext_vector_type(2)));
typedef float f32x32 __attribute__((ext_vector_type(32)));
typedef _Float16 h16x32 __attribute__((ext_vector_type(32)));
typedef unsigned u32x6 __attribute__((ext_vector_type(6)));
typedef int i32x2 __attribute__((ext_vector_type(2)));
typedef i32x4 __attribute__((aligned(8))) i32x4_a8;

#define NTHR 256
constexpr int BATCH = 4, SEQ = 4096, DM = 1024, TOK = BATCH * SEQ;
constexpr int ZLD = 2304, Z2LD = 2560, DRNN = 1280;
constexpr int EVEN_IN = 2848;
constexpr float LOG2E = 1.4426950408889634f;
constexpr float QSCALE = 0.125f * LOG2E;
constexpr float NEGBIG = -1.0e30f;
constexpr int KST = 72;
constexpr int NPHASE = 20;
constexpr int XCD_BAR_WORDS_C = 3456;

struct Params {
    const float *x, *even_norm_g, *even_w_in, *even_b_f, *even_cmp_pos, *even_w_cmp_k, *even_w_cmp_v, *even_w_out;
    const float *odd_norm_g, *odd_w_in, *odd_conv_w, *odd_conv_b, *odd_w_ra, *odd_b_ra, *odd_w_ri, *odd_b_ri, *odd_lam, *odd_w_out;
    const float *ffn_norm_g, *peer_w_q, *peer_sub_keys, *peer_u, *peer_v, *final_g;
    float* out;
    h16 *WtE, *WtV, *WtEo, *WtO, *WtOo, *WtQ, *Wc, *Wr, *Keys, *Pos16;
    unsigned char *U8, *V8; float *US, *VS;
    float* H; h16* HN;
    h16 *Z, *VtF, *VtS, *VtW, *KC, *VCt, *O; float *FG, *C2, *OACC;
    h16* QP; h16* SC; int* IDS; float* GW;
    h16* Z2; h16 *LA, *RU; float *AggP, *AggH;
    unsigned long long* TS; unsigned* BAR;
    long long ph0, ph1;
};

typedef const __attribute__((address_space(4))) Params& PRef;
extern __shared__ __attribute__((aligned(16))) char dyn_lds[];
#define GRIDV ((int)gridDim.x * 2)
#define LAS __attribute__((address_space(3)))
__device__ __forceinline__ int hidx_() { return __builtin_amdgcn_readfirstlane((int)threadIdx.x >> 8); }
__device__ __forceinline__ int tidx_() { int t = threadIdx.x & 255; asm volatile("" : "+v"(t)); return t; }
__device__ __forceinline__ int bidx_() { int b = blockIdx.x * 2 + hidx_(); asm volatile("" : "+s"(b)); return b; }
__device__ __forceinline__ int widx_() { return __builtin_amdgcn_readfirstlane(((int)threadIdx.x >> 6) & 3); }
__device__ __forceinline__ void hsync() {
    volatile LAS unsigned* w = (volatile LAS unsigned*)(dyn_lds + 131072 + hidx_() * 16);
    asm volatile("s_waitcnt lgkmcnt(0)" ::: "memory");
    if ((threadIdx.x & 63) == 0) {
        const unsigned old = __hip_atomic_fetch_add((LAS unsigned*)w, 1u, __ATOMIC_RELAXED, __HIP_MEMORY_SCOPE_WORKGROUP);
        const unsigned target = (old | 3u) + 1u;
        while ((int)(w[0] - target) < 0) { }
    }
    asm volatile("s_waitcnt lgkmcnt(0)" ::: "memory");
}

__device__ __forceinline__ float wave_sum(float v) {
#pragma unroll
    for (int o = 32; o > 0; o >>= 1) v += __shfl_xor(v, o);
    return v;
}
__device__ __forceinline__ int mbcnt64(u64 m) { return __builtin_amdgcn_mbcnt_hi((unsigned)(m >> 32), __builtin_amdgcn_mbcnt_lo((unsigned)m, 0)); }
__device__ __forceinline__ float gelu_exact(float v) { return 0.5f * v * (1.0f + erff(v * 0.70710678118654752f)); }
__device__ __forceinline__ float sigmoidf_(float v) { return 1.0f / (1.0f + __expf(-v)); }
__device__ __forceinline__ float log_sigmoid(float v) { return v >= 0.f ? -log1pf(expf(-v)) : v - log1pf(expf(v)); }
__device__ __forceinline__ int crow(int r, int hi) { return (r & 3) + 8 * (r >> 2) + 4 * hi; }
__device__ __forceinline__ f32x16 zero16() { f32x16 z;
#pragma unroll
    for (int i = 0; i < 16; ++i) z[i] = 0.f; return z; }

__device__ __forceinline__ void rms_write_h16(const float (&v)[16], const float* __restrict__ g, h16* __restrict__ dst, int lane) {
    float ss = 0.f;
#pragma unroll
    for (int i = 0; i < 16; ++i) ss += v[i] * v[i];
    ss = wave_sum(ss);
    const float rstd = rsqrtf(ss * (1.0f / 1024.0f) + 1e-6f);
#pragma unroll
    for (int hseg = 0; hseg < 2; ++hseg) {
        const int c0 = hseg * 512 + lane * 8;
        const f32x4 g0 = *(const f32x4*)(g + c0), g1 = *(const f32x4*)(g + c0 + 4);
        half8 o;
#pragma unroll
        for (int i = 0; i < 4; ++i) { o[i] = (h16)(v[hseg * 8 + i] * rstd * g0[i]); o[4 + i] = (h16)(v[hseg * 8 + 4 + i] * rstd * g1[i]); }
        *(half8*)(dst + c0) = o;
    }
}
__device__ __forceinline__ void load_row16(const float* __restrict__ src, float (&v)[16], int lane) {
#pragma unroll
    for (int hseg = 0; hseg < 2; ++hseg) {
        const int c0 = hseg * 512 + lane * 8;
        const f32x4 a = *(const f32x4*)(src + c0), b = *(const f32x4*)(src + c0 + 4);
#pragma unroll
        for (int i = 0; i < 4; ++i) { v[hseg * 8 + i] = a[i]; v[hseg * 8 + 4 + i] = b[i]; }
    }
}

__device__ __forceinline__ int even_col_map(int n, int kind) {
    if (kind == 2) {
        if (n < 512) return 1024 + n;
        if (n < 640) return 2056 + 3 * 128 + (n - 512);
        return 2056 + 5 * 128 + (n - 640);
    }
    if (n < 1024) return n;
    if (n < 1536) return 1544 + (n - 1024);
    if (n < 1664) return 2056 + (n - 1536);
    if (n < 1792) return 2056 + 128 + (n - 1664);
    if (n < 1920) return 2056 + 256 + (n - 1792);
    if (n < 2048) return 2056 + 512 + (n - 1920);
    if (n < 2056) return 1536 + (n - 2048);
    if (n < 2080) return 2824 + (n - 2056);
    return -1;
}
__device__ __forceinline__ void transpose_job(const float* __restrict__ src, int K, int N, h16* __restrict__ dst, int Ndst, int mapped, float* tileS, int& base, int b0) {
    const int tid = tidx_(), nb = (int)GRIDV - b0, bid = bidx_() - b0;
    const int nkt = K / 64, nnt = Ndst / 64, ntiles = nkt * nnt;
    int first = (bid - (base % nb) + nb) % nb;
    for (int tile = first; tile < ntiles; tile += nb) {
        const int k0 = (tile % nkt) * 64, n0 = (tile / nkt) * 64;
#pragma unroll
        for (int i = 0; i < 16; ++i) {
            const int e = tid + 256 * i, kk = e >> 6, nn = e & 63;
            const int sc = mapped ? even_col_map(n0 + nn, mapped) : (n0 + nn);
            tileS[kk * 65 + nn] = (sc >= 0) ? src[(size_t)(k0 + kk) * N + sc] : 0.f;
        }
        hsync();
        const int n = tid >> 2, ks = (tid & 3) * 16;
        half8 o0, o1;
#pragma unroll
        for (int i = 0; i < 8; ++i) { o0[i] = (h16)tileS[(ks + i) * 65 + n]; o1[i] = (h16)tileS[(ks + 8 + i) * 65 + n]; }
        h16* d = dst + (size_t)(n0 + n) * K + k0 + ks;
        *(half8*)d = o0; *(half8*)(d + 8) = o1;
        hsync();
    }
    base += ntiles;
}
__device__ __forceinline__ void convert_job(const float* __restrict__ src, h16* __restrict__ dst, size_t n) {
    const size_t n4 = n / 4, stride = (size_t)GRIDV * NTHR;
    for (size_t i = (size_t)bidx_() * NTHR + tidx_(); i < n4; i += stride) {
        const f32x4 v = *(const f32x4*)(src + 4 * i);
        half4 o; o[0] = (h16)v[0]; o[1] = (h16)v[1]; o[2] = (h16)v[2]; o[3] = (h16)v[3];
        *(half4*)(dst + 4 * i) = o;
    }
}
constexpr int ROW6 = 768;
template <int NP>
__device__ __forceinline__ void fp6_rows(const float* __restrict__ src, unsigned char* __restrict__ dst, float* __restrict__ scl, const int (&rps)[NP], int lane) {
    const int hh = lane >> 5, g = lane & 31;
    f32x4 v[NP][8];
#pragma unroll
    for (int q = 0; q < NP; ++q)
#pragma unroll
        for (int c = 0; c < 8; ++c) v[q][c] = *(const f32x4*)(src + (size_t)(rps[q] * 2 + hh) * 1024 + c * 128 + g * 4);
#pragma unroll
    for (int q = 0; q < NP; ++q) {
        float am = 0.f;
#pragma unroll
        for (int c = 0; c < 8; ++c) am = fmaxf(am, fmaxf(fmaxf(fabsf(v[q][c][0]), fabsf(v[q][c][1])), fmaxf(fabsf(v[q][c][2]), fabsf(v[q][c][3]))));
#pragma unroll
        for (int o = 16; o > 0; o >>= 1) am = fmaxf(am, __shfl_xor(am, o));
        const float sc = am > 0.f ? am * (1.0f / 7.5f) : 1.0f, inv = 1.0f / sc;
        h16x32 hv;
#pragma unroll
        for (int c = 0; c < 8; ++c)
#pragma unroll
            for (int j = 0; j < 4; ++j) hv[4 * c + j] = (h16)(v[q][c][j] * inv);
        const u32x6 pk = __builtin_amdgcn_cvt_scalef32_pk32_fp6_f16(hv, 1.0f);
        unsigned char* o = dst + (size_t)(rps[q] * 2 + hh) * ROW6;
        *(i32x4*)(o + g * 16) = (i32x4){(int)pk[0], (int)pk[1], (int)pk[2], (int)pk[3]};
        *(i32x2*)(o + 512 + g * 8) = (i32x2){(int)pk[4], (int)pk[5]};
        if (g == 0) scl[rps[q] * 2 + hh] = sc;
    }
}
__device__ __forceinline__ void fp6_rows_job(const float* __restrict__ src, unsigned char* __restrict__ dst, float* __restrict__ scl, int npairs, int wv0) {
    const int lane = tidx_() & 63, wv = bidx_() * 4 + widx_() - wv0, nwv = GRIDV * 4 - wv0;
    if (wv < 0) return;
    int r = wv;
    for (; r + nwv < npairs; r += 2 * nwv) { const int rps[2] = {r, r + nwv}; fp6_rows<2>(src, dst, scl, rps, lane); }
    for (; r < npairs; r += nwv) { const int rps[1] = {r}; fp6_rows<1>(src, dst, scl, rps, lane); }
}
__device__ __forceinline__ void weight_jobs(PRef p, char* smem, bool first_only, int b0) {
    float* tileS = (float*)smem;
    int base = 0;
    const int jlo = 0, jhi = 28;
    for (int job = jlo; job < jhi; ++job) {
        if (first_only != (job == 0 || job == 4 || job == 6 || job == 7)) continue;
        const float* src; int K, N, Nd; h16* dst; int mapped = 0;
        if (job == 0) { src = p.even_w_in; K = 1024; N = EVEN_IN; dst = p.WtE; Nd = ZLD; mapped = 1; }
        else if (job == 1) { src = p.even_w_out; K = 1024; N = 1024; dst = p.WtEo; Nd = 1024; }
        else if (job == 2) { src = p.odd_w_in; K = 1024; N = 2560; dst = p.WtO; Nd = 2560; }
        else if (job == 3) { src = p.odd_w_out; K = 1280; N = 1024; dst = p.WtOo; Nd = 1024; }
        else if (job == 4) { src = p.even_w_in; K = 1024; N = EVEN_IN; dst = p.WtV; Nd = 768; mapped = 2; }
        else if (job == 5) continue;
        else if (job == 6) { src = p.even_w_cmp_k; K = 2048; N = 64; dst = p.Wc; Nd = 64; }
        else if (job == 7) { src = p.even_w_cmp_v; K = 2048; N = 64; dst = p.Wc + 64 * 2048; Nd = 64; }
        else if (job < 18) { const int n = job - 8; src = p.odd_w_ra + n * 16384; K = 128; N = 128; dst = p.Wr + n * 16384; Nd = 128; }
        else { const int n = job - 18; src = p.odd_w_ri + n * 16384; K = 128; N = 128; dst = p.Wr + (10 + n) * 16384; Nd = 128; }
        transpose_job(src, K, N, dst, Nd, mapped, tileS, base, b0);
    }
}
__device__ __forceinline__ void phase_prep(PRef p, char* smem) {
    weight_jobs(p, smem, true, 0);
    convert_job(p.peer_sub_keys, p.Keys, (size_t)2 * 8 * 2 * 128 * 128);
    convert_job(p.even_cmp_pos, p.Pos16, 2048);
    const int lane = tidx_() & 63, wv = bidx_() * 4 + widx_(), nwv = GRIDV * 4;
    for (int row = wv; row < TOK; row += nwv) {
        float v[16]; load_row16(p.x + (size_t)row * DM, v, lane);
        rms_write_h16(v, p.even_norm_g, p.HN + (size_t)row * DM, lane);
    }
}

enum { EPI_EVEN_IN = 0, EPI_F32_RESID = 1, EPI_H16 = 2, EPI_F32T = 3, EPI_QSCORE = 4 };
struct GemmArgs {
    const h16* A; int lda; const h16* Bt; int ldb; int M, N, K; int a_ntile_stride;
    int mode; h16* c16; int ldc16; float* c32; int ldc32; const float* resid; const h16* aux;
};
template <int MODE, int LDC>
__device__ __forceinline__ void gemm_epilogue(PRef p, const GemmArgs& g, int mt, int nt, bool sw, const f32x4 (&acc)[4][4]) {
    const int lane = tidx_() & 63, wid = widx_(), wm = wid >> 1, wn = wid & 1;
    const int l4 = (lane >> 4) * 4, l15 = lane & 15;
    if (MODE == EPI_EVEN_IN) {
        int kind;
        if (nt < 4 || (nt >= 12 && nt < 16)) kind = 0; else if (nt >= 8 && nt < 12) kind = 2; else if (nt == 19) kind = 3; else if (nt == 21) kind = 4; else if (nt == 22) kind = 5; else kind = 1;
#pragma unroll
        for (int i = 0; i < 4; ++i)
#pragma unroll
            for (int j = 0; j < 4; ++j) {
                const f32x4 v = acc[i][j];
                if (kind <= 1) {
                    const int row = mt * 128 + wm * 64 + j * 16 + l15, col = nt * 128 + wn * 64 + i * 16 + l4;
                    const float sc = kind == 0 ? QSCALE : 1.0f;
                    half4 o; o[0] = (h16)(v[0] * sc); o[1] = (h16)(v[1] * sc); o[2] = (h16)(v[2] * sc); o[3] = (h16)(v[3] * sc);
                    *(half4*)(p.Z + (size_t)row * ZLD + col) = o;
                } else if (kind <= 4) {
                    const int row = mt * 128 + wm * 64 + i * 16 + l4, col = nt * 128 + wn * 64 + j * 16 + l15;
                    const int b = row >> 12, s = row & 4095;
                    half4 o; o[0] = (h16)v[0]; o[1] = (h16)v[1]; o[2] = (h16)v[2]; o[3] = (h16)v[3];
                    h16* dst;
                    if (kind == 2) { const int c = col - 1024; dst = p.VtF + ((size_t)(b * 8 + (c >> 6)) * 64 + (c & 63)) * SEQ + s; }
                    else if (kind == 3) { const int c = col - 2432; dst = p.VtS + ((size_t)(b * 2 + (c >> 6)) * 64 + (c & 63)) * SEQ + s; }
                    else { const int c = col - 2688; dst = p.VtW + ((size_t)(b * 2 + (c >> 6)) * 64 + (c & 63)) * SEQ + s; }
                    *(half4*)dst = o;
                } else {
                    const int row = mt * 128 + wm * 64 + j * 16 + l15, c = nt * 128 + wn * 64 + i * 16 + l4 - 2816;
                    if (c < 32) {
                        f32x4 o;
                        if (c < 8) {
#pragma unroll
                            for (int q = 0; q < 4; ++q) o[q] = log_sigmoid(v[q] + p.even_b_f[c + q]) * LOG2E;
                        } else {
#pragma unroll
                            for (int q = 0; q < 4; ++q) o[q] = sigmoidf_(v[q]);
                        }
                        *(f32x4*)(p.FG + (size_t)row * 32 + c) = o;
                    }
                }
            }
    } else {
#pragma unroll
        for (int i = 0; i < 4; ++i)
#pragma unroll
            for (int j = 0; j < 4; ++j) {
                const f32x4 v = acc[i][j];
                if (MODE == EPI_F32T) {
                    const int row = mt * 128 + wm * 64 + i * 16 + l4, col = nt * 128 + wn * 64 + j * 16 + l15;
                    *(f32x4*)(g.c32 + (size_t)col * TOK + row) = v;
                } else {
                    const int row = mt * 128 + wm * 64 + j * 16 + l15, col = nt * 128 + wn * 64 + i * 16 + l4;
                    if (MODE == EPI_F32_RESID) {
                        const f32x4 r = *(const f32x4*)(g.resid + (size_t)row * LDC + col);
                        *(f32x4*)(g.c32 + (size_t)row * LDC + col) = r + v;
                    } else {
                        half4 o; o[0] = (h16)v[0]; o[1] = (h16)v[1]; o[2] = (h16)v[2]; o[3] = (h16)v[3];
                        *(half4*)(g.c16 + (size_t)row * LDC + col) = o;
                    }
                }
            }
    }
}

template <int MODE, int LDA, int LDB, int GN, int GK, int LDC, int ANS>
__device__ __forceinline__ void phase_gemm(PRef p, const GemmArgs& g, char* smem) {
    h16* As = (h16*)smem;
    h16* Bs = As + 2 * 128 * 64;
    const int tid = tidx_(), lane = tid & 63, wid = widx_(), wm = wid >> 1, wn = wid & 1;
    constexpr int nM = TOK / 128, nN = GN / 128, ntiles = nM * nN, nk = GK / 64;
    const int lr = tid >> 3, lc = tid & 7;
    const int st_off = lr * 64 + ((lc ^ ((tid >> 4) & 7)) * 8);
    const int fsw = (lane & 15) >> 1;
    const int fo0 = (lane & 15) * 64 + ((((lane >> 4)) ^ fsw) * 8), fo1 = (lane & 15) * 64 + (((4 + (lane >> 4)) ^ fsw) * 8);
    for (int tile = bidx_(); tile < ntiles; tile += GRIDV) {
        const int mt = tile / nN, nt = tile % nN;
        bool sw = (MODE != EPI_F32T);
        if (MODE == EPI_EVEN_IN) sw = !((nt >= 8 && nt < 12) || nt == 19 || nt == 21);
        const h16* Ag = g.A + (size_t)(mt * 128 + lr) * LDA + (size_t)nt * ANS + lc * 8;
        const h16* Bg = g.Bt + (size_t)(nt * 128 + lr) * LDB + lc * 8;
        constexpr size_t a32 = (size_t)32 * LDA, b32 = (size_t)32 * LDB;
        f32x4 acc[4][4];
#pragma unroll
        for (int m = 0; m < 4; ++m)
#pragma unroll
            for (int n = 0; n < 4; ++n) acc[m][n] = (f32x4){0.f, 0.f, 0.f, 0.f};
        half8 ra[4], rb[4];
#pragma unroll
        for (int i = 0; i < 4; ++i) { ra[i] = *(const half8*)(Ag + i * a32); rb[i] = *(const half8*)(Bg + i * b32); }
#pragma unroll
        for (int i = 0; i < 4; ++i) { *(half8*)(As + st_off + i * 32 * 64) = ra[i]; *(half8*)(Bs + st_off + i * 32 * 64) = rb[i]; }
        hsync();
        const int pofs = (sw ? wn : wm) * 64 * 64, qofs = (sw ? wm : wn) * 64 * 64;
        for (int kt = 0; kt < nk; ++kt) {
            const int cur = kt & 1;
            if (kt + 1 < nk) {
                const int ko = (kt + 1) * 64;
#pragma unroll
                for (int i = 0; i < 4; ++i) { ra[i] = *(const half8*)(Ag + i * a32 + ko); rb[i] = *(const half8*)(Bg + i * b32 + ko); }
            }
            const h16* Pc = (sw ? Bs : As) + cur * 128 * 64 + pofs;
            const h16* Qc = (sw ? As : Bs) + cur * 128 * 64 + qofs;
#pragma unroll
            for (int ks = 0; ks < 2; ++ks) {
                const int fo = ks ? fo1 : fo0;
                half8 pf[4], qf[4];
#pragma unroll
                for (int i = 0; i < 4; ++i) { pf[i] = *(const half8*)(Pc + i * 16 * 64 + fo); qf[i] = *(const half8*)(Qc + i * 16 * 64 + fo); }
                __builtin_amdgcn_s_setprio(1);
#pragma unroll
                for (int i = 0; i < 4; ++i)
#pragma unroll
                    for (int j = 0; j < 4; ++j) acc[i][j] = __builtin_amdgcn_mfma_f32_16x16x32_f16(pf[i], qf[j], acc[i][j], 0, 0, 0);
                __builtin_amdgcn_s_setprio(0);
            }
            if (kt + 1 < nk) {
                const int nx = (cur ^ 1) * 128 * 64;
#pragma unroll
                for (int i = 0; i < 4; ++i) { *(half8*)(As + nx + st_off + i * 32 * 64) = ra[i]; *(half8*)(Bs + nx + st_off + i * 32 * 64) = rb[i]; }
            }
            hsync();
        }
        if (MODE == EPI_QSCORE) {
            constexpr int QST = 136;
            h16* Qs = (h16*)smem;
            const int l4 = (lane >> 4) * 4, l15 = lane & 15;
#pragma unroll
            for (int i = 0; i < 4; ++i)
#pragma unroll
                for (int j = 0; j < 4; ++j) {
                    const f32x4 v = acc[i][j];
                    half4 o; o[0] = (h16)v[0]; o[1] = (h16)v[1]; o[2] = (h16)v[2]; o[3] = (h16)v[3];
                    *(half4*)(Qs + (wm * 64 + j * 16 + l15) * QST + wn * 64 + i * 16 + l4) = o;
                }
            hsync();
            f32x4 sc[4][4];
#pragma unroll
            for (int i = 0; i < 4; ++i)
#pragma unroll
                for (int j = 0; j < 4; ++j) sc[i][j] = (f32x4){0.f, 0.f, 0.f, 0.f};
            const h16* kb = g.aux + (size_t)(nt * 128 + wn * 64 + l15) * 128 + (lane >> 4) * 8;
#pragma unroll
            for (int ks = 0; ks < 4; ++ks) {
                half8 pf[4], qf[4];
#pragma unroll
                for (int i = 0; i < 4; ++i) { pf[i] = *(const half8*)(Qs + (wm * 64 + i * 16 + l15) * QST + ks * 32 + (lane >> 4) * 8); qf[i] = *(const half8*)(kb + (size_t)i * 16 * 128 + ks * 32); }
#pragma unroll
                for (int i = 0; i < 4; ++i)
#pragma unroll
                    for (int j = 0; j < 4; ++j) sc[i][j] = __builtin_amdgcn_mfma_f32_16x16x32_f16(pf[i], qf[j], sc[i][j], 0, 0, 0);
            }
#pragma unroll
            for (int i = 0; i < 4; ++i)
#pragma unroll
                for (int j = 0; j < 4; ++j) {
                    const int row = mt * 128 + wm * 64 + i * 16 + l4, col = nt * 128 + wn * 64 + j * 16 + l15;
                    *(f32x4*)(g.c32 + (size_t)col * TOK + row) = sc[i][j];
                }
            hsync();
        } else
        gemm_epilogue<MODE, LDC>(p, g, mt, nt, sw, acc);
    }
}

__device__ __forceinline__ void wp_job(PRef p, int wv0) {
    const int lane = tidx_() & 63, wv = bidx_() * 4 + widx_() - wv0, nwv = GRIDV * 4 - wv0;
    if (wv < 0) return;
    for (int u = wv; u < 1024; u += nwv) {
        const int l = u >> 9, hc = (u >> 5) & 15, kh = (u >> 4) & 1, jt = u & 15;
        const float* wq = p.peer_w_q + (size_t)l * 1024 * 2048 + (size_t)(jt * 64 + (lane & 15)) * 2048 + hc * 128 + (lane >> 4) * 8;
        const h16* ky = p.Keys + ((size_t)(l * 16 + hc) * 128 + kh * 64 + (lane & 15)) * 128 + (lane >> 4) * 8;
        f32x4 acc[4][4];
#pragma unroll
        for (int a = 0; a < 4; ++a)
#pragma unroll
            for (int b = 0; b < 4; ++b) acc[a][b] = (f32x4){0.f, 0.f, 0.f, 0.f};
#pragma unroll
        for (int ks = 0; ks < 4; ++ks) {
            half8 af[4], bf[4];
#pragma unroll
            for (int a = 0; a < 4; ++a) {
                const f32x4 w0 = *(const f32x4*)(wq + (size_t)a * 16 * 2048 + ks * 32), w1 = *(const f32x4*)(wq + (size_t)a * 16 * 2048 + ks * 32 + 4);
#pragma unroll
                for (int q = 0; q < 4; ++q) { af[a][q] = (h16)w0[q]; af[a][4 + q] = (h16)w1[q]; }
                bf[a] = *(const half8*)(ky + (size_t)a * 16 * 128 + ks * 32);
            }
#pragma unroll
            for (int a = 0; a < 4; ++a)
#pragma unroll
                for (int b = 0; b < 4; ++b) acc[a][b] = __builtin_amdgcn_mfma_f32_16x16x32_f16(af[a], bf[b], acc[a][b], 0, 0, 0);
        }
        h16* wp = p.WtQ + (size_t)l * 2048 * 1024;
#pragma unroll
        for (int a = 0; a < 4; ++a)
#pragma unroll
            for (int b = 0; b < 4; ++b) {
                const int n = hc * 128 + kh * 64 + b * 16 + (lane & 15), j0 = jt * 64 + a * 16 + (lane >> 4) * 4;
                half4 o; o[0] = (h16)acc[a][b][0]; o[1] = (h16)acc[a][b][1]; o[2] = (h16)acc[a][b][2]; o[3] = (h16)acc[a][b][3];
                *(half4*)(wp + (size_t)n * 1024 + j0) = o;
            }
    }
}
__device__ __forceinline__ void phase_cumsum_compress(PRef p, char* smem) {
    const int lane = tidx_() & 63, wid = widx_(), vb = bidx_();
    if (vb >= 256 && vb < 264) {
        const int u = (vb - 256) * 4 + wid, b = u >> 3, h = u & 7;
        const float* src = p.FG + (size_t)(b * SEQ + lane * 64) * 32 + h;
        float loc[64]; float run = 0.f;
#pragma unroll
        for (int i = 0; i < 64; ++i) { run += src[(size_t)i * 32]; loc[i] = run; }
        float incl = run;
#pragma unroll
        for (int o = 1; o < 64; o <<= 1) { const float t = __shfl_up(incl, o); if (lane >= o) incl += t; }
        const float excl = incl - run;
        float* dst = p.C2 + (size_t)(b * 8 + h) * SEQ + lane * 64;
#pragma unroll
        for (int i = 0; i < 64; ++i) dst[i] = excl + loc[i];
    }
    if (vb < 256) {
        const int cu = vb, kv = cu >> 7, bg = (cu >> 4) & 7, nt = cu & 15;
        const int b = bg >> 1, g = bg & 1;
        int n = nt * 16 + (lane & 15); const int nc = n < 255 ? n : 254;
        const h16* Ab = p.Z + (size_t)(b * SEQ + 16 * nc) * ZLD + 1536 + kv * 128 + g * 64 + (lane >> 4) * 8;
        const h16* Wb = p.Wc + (size_t)kv * 64 * 2048 + (size_t)(lane & 15) * 2048 + (lane >> 4) * 8;
        const h16* Pb = p.Pos16 + (lane >> 4) * 8;
        f32x4 acc[4];
#pragma unroll
        for (int e = 0; e < 4; ++e) acc[e] = (f32x4){0.f, 0.f, 0.f, 0.f};
#pragma unroll
        for (int k2 = 0; k2 < 16; ++k2) {
            const int ks = wid * 16 + k2, l = ks >> 1, d0 = (ks & 1) * 32;
            half8 a = *(const half8*)(Ab + (size_t)l * ZLD + d0);
            const half8 ps = *(const half8*)(Pb + ks * 32);
            a = a + ps;
#pragma unroll
            for (int e = 0; e < 4; ++e) {
                const half8 w = *(const half8*)(Wb + (size_t)e * 16 * 2048 + ks * 32);
                acc[e] = __builtin_amdgcn_mfma_f32_16x16x32_f16(a, w, acc[e], 0, 0, 0);
            }
        }
        f32x4* part = (f32x4*)smem;
#pragma unroll
        for (int e = 0; e < 4; ++e) part[(wid * 4 + e) * 64 + lane] = acc[e];
        hsync();
        {
            const int e = wid;
            const f32x4 s = (part[(0 * 4 + e) * 64 + lane] + part[(1 * 4 + e) * 64 + lane]) + (part[(2 * 4 + e) * 64 + lane] + part[(3 * 4 + e) * 64 + lane]);
            const int n0 = nt * 16 + (lane >> 4) * 4, ec = e * 16 + (lane & 15);
            if (kv == 0) {
#pragma unroll
                for (int j = 0; j < 4; ++j) p.KC[((size_t)bg * 256 + n0 + j) * 64 + ec] = (n0 + j < 255) ? (h16)s[j] : (h16)0.f;
            } else {
                half4 o;
#pragma unroll
                for (int j = 0; j < 4; ++j) o[j] = (n0 + j < 255) ? (h16)s[j] : (h16)0.f;
                *(half4*)(p.VCt + ((size_t)bg * 64 + ec) * 256 + n0) = o;
            }
        }
        hsync();
    }
    weight_jobs(p, smem, false, 0);
    wp_job(p, 0);
    fp6_rows_job(p.peer_u, p.U8, p.US, 8192, 0);
    fp6_rows_job(p.peer_v, p.V8, p.VS, 8192, 0);
}

struct RowState { float m, l; f32x16 o0, o1; };
__device__ __forceinline__ void rs_reset(RowState& s) { s.m = NEGBIG; s.l = 0.f; s.o0 = zero16(); s.o1 = zero16(); }

__device__ __forceinline__ void kv_load(const h16* kb, int kst, const h16* vb, int vst, half8 (&kr)[2], half8 (&vr)[2]) {
    const int tid = tidx_();
#pragma unroll
    for (int i = 0; i < 2; ++i) {
        const int c = tid + 256 * i, row = c >> 3, cc = (c & 7) * 8;
        kr[i] = *(const half8*)(kb + (size_t)row * kst + cc);
        vr[i] = *(const half8*)(vb + (size_t)row * vst + cc);
    }
}
__device__ __forceinline__ void kv_store(h16* Ks, h16* Vs, const half8 (&kr)[2], const half8 (&vr)[2]) {
    const int tid = tidx_();
#pragma unroll
    for (int i = 0; i < 2; ++i) {
        const int c = tid + 256 * i, row = c >> 3, cc = (c & 7) * 8;
        *(half8*)(Ks + row * KST + cc) = kr[i];
        *(half8*)(Vs + row * KST + cc) = vr[i];
    }
}
__device__ __forceinline__ void qk_tile(const h16* Ks, const half8 (&qf)[4], f32x16 (&s)[2], int lane) {
    const int r32 = lane & 31, hh = lane >> 5;
#pragma unroll
    for (int kt = 0; kt < 2; ++kt) {
        s[kt] = zero16();
#pragma unroll
        for (int ks = 0; ks < 4; ++ks) {
            const half8 kf = *(const half8*)(Ks + (kt * 32 + r32) * KST + ks * 16 + hh * 8);
            s[kt] = __builtin_amdgcn_mfma_f32_32x32x16_f16(kf, qf[ks], s[kt], 0, 0, 0);
        }
    }
}
__device__ __forceinline__ void pv_tile(const h16* Vs, const f32x16 (&pr)[2], f32x16& o0, f32x16& o1, int lane) {
    const int r32 = lane & 31, hh = lane >> 5;
#pragma unroll
    for (int kt = 0; kt < 2; ++kt)
#pragma unroll
        for (int s2 = 0; s2 < 2; ++s2) {
            half8 pf;
#pragma unroll
            for (int j = 0; j < 8; ++j) pf[j] = (h16)pr[kt][8 * s2 + j];
            const int kof = kt * 32 + 16 * s2 + 4 * hh;
            {
                const half4 a = *(const half4*)(Vs + r32 * KST + kof), b = *(const half4*)(Vs + r32 * KST + kof + 8);
                half8 vf; vf[0] = a[0]; vf[1] = a[1]; vf[2] = a[2]; vf[3] = a[3]; vf[4] = b[0]; vf[5] = b[1]; vf[6] = b[2]; vf[7] = b[3];
                o0 = __builtin_amdgcn_mfma_f32_32x32x16_f16(vf, pf, o0, 0, 0, 0);
            }
            {
                const half4 a = *(const half4*)(Vs + (32 + r32) * KST + kof), b = *(const half4*)(Vs + (32 + r32) * KST + kof + 8);
                half8 vf; vf[0] = a[0]; vf[1] = a[1]; vf[2] = a[2]; vf[3] = a[3]; vf[4] = b[0]; vf[5] = b[1]; vf[6] = b[2]; vf[7] = b[3];
                o1 = __builtin_amdgcn_mfma_f32_32x32x16_f16(vf, pf, o1, 0, 0, 0);
            }
        }
}

enum { M_FOX = 0, M_SLC = 1, M_WIN = 2 };
template <int MODE, bool MASKED>
__device__ __forceinline__ void flash_step(const h16* Ks, const h16* Vs, const float* csS, const half8 (&qf)[4], RowState& st,
                                           int t, int kpos0, float slope2, float ct2, bool selbit, int lane) {
    const int hh = lane >> 5;
    f32x16 s[2];
    qk_tile(Ks, qf, s, lane);
    int dbase = t - kpos0 - 4 * hh;
    asm volatile("" : "+v"(dbase));
    const float off = (MODE == M_FOX) ? ct2 : -slope2 * (float)dbase;
    float mx = NEGBIG;
#pragma unroll
    for (int kt = 0; kt < 2; ++kt)
#pragma unroll
        for (int r = 0; r < 16; ++r) {
            const int c = kt * 32 + (r & 3) + 8 * (r >> 2);
            float v;
            if (MODE == M_FOX) v = s[kt][r] - csS[c + 4 * hh];
            else v = fmaf(slope2, (float)c, s[kt][r]);
            if (MASKED) {
                const int dist = dbase - c;
                bool valid;
                if (MODE == M_FOX) valid = dist >= 0; else if (MODE == M_SLC) valid = selbit && dist >= 0; else valid = dist >= 0 && dist < 512;
                v = valid ? v : NEGBIG;
            }
            s[kt][r] = v;
            mx = fmaxf(mx, v);
        }
    mx += off;
    mx = fmaxf(mx, __shfl_xor(mx, 32));
    const float mn = fmaxf(st.m, mx);
    const float alpha = __builtin_amdgcn_exp2f(st.m - mn);
    st.m = mn;
    const float moff = mn - off;
    float ps = 0.f;
#pragma unroll
    for (int kt = 0; kt < 2; ++kt)
#pragma unroll
        for (int r = 0; r < 16; ++r) {
            const float v = s[kt][r];
            float pe = __builtin_amdgcn_exp2f(v - moff);
            if (MASKED) pe = v > -1.0e29f ? pe : 0.f;
            s[kt][r] = pe; ps += pe;
        }
    st.l = st.l * alpha + ps;
#pragma unroll
    for (int r = 0; r < 16; ++r) { st.o0[r] *= alpha; st.o1[r] *= alpha; }
    pv_tile(Vs, s, st.o0, st.o1, lane);
}

template <int MODE>
__device__ __forceinline__ void run_flash(u64 mask, const h16* Kg, int kst, const h16* Vg, int vst, const float* csg, char* smem,
                                          const half8 (&qf)[4], RowState& st, int t, int twlo, int twhi, float slope2, float ct2, u64 sel, int lane) {
    h16* Kb = (h16*)smem; h16* Vb = Kb + 2 * 64 * KST; float* csb = (float*)(Vb + 2 * 64 * KST);
    if (mask == 0ull) return;
    half8 kr[2], vr[2]; float csr = 0.f;
    int jc = __builtin_ctzll(mask); mask &= mask - 1;
    kv_load(Kg + (size_t)jc * 64 * kst, kst, Vg + jc * 64, vst, kr, vr);
    if (MODE == M_FOX && tidx_() < 64) csr = csg[jc * 64 + tidx_()];
    kv_store(Kb, Vb, kr, vr);
    if (MODE == M_FOX && tidx_() < 64) csb[tidx_()] = csr;
    hsync();
    int buf = 0;
    for (;;) {
        int jn = -1;
        if (mask) { jn = __builtin_ctzll(mask); mask &= mask - 1; }
        if (jn >= 0) {
            kv_load(Kg + (size_t)jn * 64 * kst, kst, Vg + jn * 64, vst, kr, vr);
            if (MODE == M_FOX && tidx_() < 64) csr = csg[jn * 64 + tidx_()];
        }
        bool need = jc * 64 <= twhi;
        if (MODE == M_WIN) need = need && (jc * 64 + 63 >= twlo - 511);
        if (need) {
            const bool selbit = (sel >> jc) & 1ull;
            bool full = jc * 64 + 63 <= twlo;
            if (MODE == M_WIN) full = full && (jc * 64 > twhi - 512);
            if (MODE == M_SLC) full = full && (__ballot(selbit) == ~0ull);
            if (full) flash_step<MODE, false>(Kb + buf * 64 * KST, Vb + buf * 64 * KST, csb + buf * 64, qf, st, t, jc * 64, slope2, ct2, selbit, lane);
            else flash_step<MODE, true>(Kb + buf * 64 * KST, Vb + buf * 64 * KST, csb + buf * 64, qf, st, t, jc * 64, slope2, ct2, selbit, lane);
        }
        if (jn >= 0) {
            kv_store(Kb + (buf ^ 1) * 64 * KST, Vb + (buf ^ 1) * 64 * KST, kr, vr);
            if (MODE == M_FOX && tidx_() < 64) csb[(buf ^ 1) * 64 + tidx_()] = csr;
        }
        hsync();
        if (jn < 0) break;
        jc = jn; buf ^= 1;
    }
}

__device__ __forceinline__ void load_q(const h16* qrow, half8 (&qf)[4], int lane) {
#pragma unroll
    for (int ks = 0; ks < 4; ++ks) qf[ks] = *(const half8*)(qrow + ks * 16 + (lane >> 5) * 8);
}
__device__ __forceinline__ void store_o(h16* orow, const f32x16& o0, const f32x16& o1, int lane) {
    const int hh = lane >> 5;
#pragma unroll
    for (int rg = 0; rg < 4; ++rg) {
        half4 a, b;
#pragma unroll
        for (int j = 0; j < 4; ++j) { a[j] = (h16)o0[4 * rg + j]; b[j] = (h16)o1[4 * rg + j]; }
        *(half4*)(orow + 8 * rg + 4 * hh) = a;
        *(half4*)(orow + 32 + 8 * rg + 4 * hh) = b;
    }
}

__device__ __forceinline__ void oacc_store(float* row, const f32x16& o0, const f32x16& o1, float sc, int lane) {
    const int hh = lane >> 5;
#pragma unroll
    for (int rg = 0; rg < 4; ++rg) {
        *(f32x4*)(row + 8 * rg + 4 * hh) = (f32x4){o0[4 * rg] * sc, o0[4 * rg + 1] * sc, o0[4 * rg + 2] * sc, o0[4 * rg + 3] * sc};
        *(f32x4*)(row + 32 + 8 * rg + 4 * hh) = (f32x4){o1[4 * rg] * sc, o1[4 * rg + 1] * sc, o1[4 * rg + 2] * sc, o1[4 * rg + 3] * sc};
    }
}
__device__ __forceinline__ void oacc_add(float* row, const f32x16& o0, const f32x16& o1, float sc, int lane) {
    const int hh = lane >> 5;
#pragma unroll
    for (int rg = 0; rg < 4; ++rg) {
        f32x4 a = *(const f32x4*)(row + 8 * rg + 4 * hh), b = *(const f32x4*)(row + 32 + 8 * rg + 4 * hh);
#pragma unroll
        for (int j = 0; j < 4; ++j) { a[j] += o0[4 * rg + j] * sc; b[j] += o1[4 * rg + j] * sc; }
        *(f32x4*)(row + 8 * rg + 4 * hh) = a; *(f32x4*)(row + 32 + 8 * rg + 4 * hh) = b;
    }
}
__device__ __forceinline__ void oacc_final(const float* row, h16* orow, const f32x16& o0, const f32x16& o1, float sc, int lane) {
    const int hh = lane >> 5;
#pragma unroll
    for (int rg = 0; rg < 4; ++rg) {
        const f32x4 a = *(const f32x4*)(row + 8 * rg + 4 * hh), b = *(const f32x4*)(row + 32 + 8 * rg + 4 * hh);
        half4 x, y;
#pragma unroll
        for (int j = 0; j < 4; ++j) { x[j] = (h16)(a[j] + o0[4 * rg + j] * sc); y[j] = (h16)(b[j] + o1[4 * rg + j] * sc); }
        *(half4*)(orow + 8 * rg + 4 * hh) = x; *(half4*)(orow + 32 + 8 * rg + 4 * hh) = y;
    }
}

__device__ __forceinline__ void fox_unit(PRef p, int b, int h, int qt, char* smem) {
    const int tid = tidx_(), lane = tid & 63, wid = widx_();
    const int q0 = qt * 128, t0w = q0 + wid * 32, t = t0w + (lane & 31);
    half8 qf[4]; load_q(p.Z + (size_t)(b * SEQ + t) * ZLD + h * 64, qf, lane);
    const float* csg = p.C2 + (size_t)(b * 8 + h) * SEQ;
    const float ct2 = csg[t];
    RowState st; rs_reset(st);
    const int jmax = (q0 + 127) >> 6;
    const u64 mask = (jmax >= 63) ? ~0ull : ((1ull << (jmax + 1)) - 1ull);
    run_flash<M_FOX>(mask, p.Z + (size_t)b * SEQ * ZLD + 512 + h * 64, ZLD, p.VtF + (size_t)(b * 8 + h) * 64 * SEQ, SEQ, csg, smem,
                     qf, st, t, t0w, t0w + 31, 0.f, ct2, 0ull, lane);
    const float lt = st.l + __shfl_xor(st.l, 32);
    const float inv = 1.0f / lt;
#pragma unroll
    for (int r = 0; r < 16; ++r) { st.o0[r] *= inv; st.o1[r] *= inv; }
    store_o(p.O + (size_t)(b * SEQ + t) * DM + h * 64, st.o0, st.o1, lane);
}

__device__ __forceinline__ void nsa_unit(PRef p, int b, int g, int qt32, char* smem) {
    const int tid = tidx_(), lane = tid & 63, wid = widx_(), hh = lane >> 5, r32 = lane & 31;
    const int t0 = qt32 * 32, t = t0 + r32, head = g * 4 + wid, bg = b * 2 + g;
    const float slope2 = exp2f(-(float)(head + 1)) * LOG2E;
    half8 qf[4]; load_q(p.Z + (size_t)(b * SEQ + t) * ZLD + 1024 + head * 64, qf, lane);
    const float* gp = p.FG + (size_t)(b * SEQ + t) * 32 + 8 + head * 3;
    const float gate_c = gp[0], gate_s = gp[1], gate_w = gp[2];
    h16* Kb = (h16*)smem; h16* Vb = Kb + 2 * 64 * KST;
    u64* selS = (u64*)(smem + 37376);
    u64* unS = selS + 32;
    float* oaccrow = p.OACC + (size_t)(b * SEQ + t) * 512 + head * 64;
    unsigned* impS = (unsigned*)(smem + 37888);
    {
        for (int i = tid; i < 32 * 64; i += NTHR) impS[i] = 0u;
        const int nsteps = ((t0 >> 4) >> 6) + 1;
        const h16* Kg = p.KC + (size_t)bg * 256 * 64; const h16* Vg = p.VCt + (size_t)bg * 64 * 256;
        float mrun = NEGBIG, lrun = 0.f;
        for (int i = 0; i < nsteps; ++i) {
            half8 kr[2], vr[2];
            kv_load(Kg + (size_t)i * 64 * 64, 64, Vg + i * 64, 256, kr, vr);
            kv_store(Kb, Vb, kr, vr);
            hsync();
            f32x16 s[2];
            qk_tile(Kb, qf, s, lane);
            float mx = NEGBIG;
            int dbase = t - 31 - 16 * (i * 64 + 4 * hh);
            asm volatile("" : "+v"(dbase));
#pragma unroll
            for (int kt = 0; kt < 2; ++kt)
#pragma unroll
                for (int r = 0; r < 16; ++r) {
                    const int dist = dbase - 16 * (kt * 32 + (r & 3) + 8 * (r >> 2));
                    float v = s[kt][r] - slope2 * (float)dist;
                    v = dist >= 0 ? v : NEGBIG;
                    s[kt][r] = v; mx = fmaxf(mx, v);
                }
            mx = fmaxf(mx, __shfl_xor(mx, 32));
            const float mn = fmaxf(mrun, mx), alpha = __builtin_amdgcn_exp2f(mrun - mn);
            mrun = mn;
            float ps = 0.f;
#pragma unroll
            for (int kt = 0; kt < 2; ++kt)
#pragma unroll
                for (int r = 0; r < 16; ++r) { const float v = s[kt][r]; ps += v > -1.0e29f ? __builtin_amdgcn_exp2f(v - mn) : 0.f; }
            lrun = lrun * alpha + ps;
            hsync();
        }
        const float lt = lrun + __shfl_xor(lrun, 32);
        const float inv = lt > 0.f ? 1.0f / lt : 0.f;
        f32x16 o0 = zero16(), o1 = zero16();
        float carry = 0.f;
        for (int i = 0; i < nsteps; ++i) {
            half8 kr[2], vr[2];
            kv_load(Kg + (size_t)i * 64 * 64, 64, Vg + i * 64, 256, kr, vr);
            kv_store(Kb, Vb, kr, vr);
            hsync();
            f32x16 s[2];
            qk_tile(Kb, qf, s, lane);
            int dbase = t - 31 - 16 * (i * 64 + 4 * hh);
            asm volatile("" : "+v"(dbase));
#pragma unroll
            for (int kt = 0; kt < 2; ++kt)
#pragma unroll
                for (int r = 0; r < 16; ++r) {
                    const int dist = dbase - 16 * (kt * 32 + (r & 3) + 8 * (r >> 2));
                    const float v = s[kt][r] - slope2 * (float)dist;
                    s[kt][r] = dist >= 0 ? __builtin_amdgcn_exp2f(v - mrun) * inv : 0.f;
                }
            float R[2][4];
#pragma unroll
            for (int kt = 0; kt < 2; ++kt)
#pragma unroll
                for (int rg = 0; rg < 4; ++rg) R[kt][rg] = __shfl_xor(s[kt][4 * rg + 3], 32);
#pragma unroll
            for (int kt = 0; kt < 2; ++kt)
#pragma unroll
                for (int rg = 0; rg < 4; ++rg) {
                    const float G = (s[kt][4 * rg] + s[kt][4 * rg + 1]) + (s[kt][4 * rg + 2] + s[kt][4 * rg + 3]);
                    const float prev = (kt == 0 && rg == 0) ? carry : (rg > 0 ? R[kt][rg - 1] : R[kt - 1][3]);
                    const float val = G + (hh ? R[kt][rg] : prev);
                    const int j = 16 * i + 8 * kt + 2 * rg + hh;
                    atomicAdd(&impS[r32 * 64 + j], (unsigned)(val * 67108864.0f + 0.5f));
                }
            carry = R[1][3];
            pv_tile(Vb, s, o0, o1, lane);
            hsync();
        }
        oacc_store(oaccrow, o0, o1, gate_c, lane);
    }
    hsync();
    {
        u64 un = 0ull;
        for (int i = 0; i < 8; ++i) {
            const int tok = wid * 8 + i, tt = t0 + tok, cur = tt >> 6;
            const int j = lane;
            const bool valid = j <= cur;
            const bool forced = (j == 0) || (j == cur) || (j == cur - 1);
            const unsigned key = valid ? impS[tok * 64 + j] + (forced ? 0x40000000u : 0u) : 0u;
            int rank = 0;
            for (int jj = 0; jj < 64; ++jj) {
                const unsigned kv = (unsigned)__builtin_amdgcn_readlane((int)key, jj);
                rank += (kv > key || (kv == key && jj < j)) ? 1 : 0;
            }
            const u64 selm = __ballot(valid && rank < 16);
            if (lane == 0) selS[tok] = selm;
            un |= selm;
        }
        if (lane == 0) unS[wid] = un;
    }
    hsync();
    const u64 mysel = selS[r32];
    const u64 un = unS[0] | unS[1] | unS[2] | unS[3];
    hsync();
    {
        RowState st; rs_reset(st);
        run_flash<M_SLC>(un, p.Z + (size_t)b * SEQ * ZLD + 1792 + g * 64, ZLD, p.VtS + (size_t)bg * 64 * SEQ, SEQ, nullptr, smem,
                         qf, st, t, t0, t0 + 31, slope2, 0.f, mysel, lane);
        const float lt = st.l + __shfl_xor(st.l, 32);
        oacc_add(oaccrow, st.o0, st.o1, gate_s / lt, lane);
    }
    {
        RowState st; rs_reset(st);
        const int lo = t0 - 511, jlo = lo > 0 ? (lo >> 6) : 0, jhi = (t0 + 31) >> 6;
        u64 mask = (jhi >= 63 ? ~0ull : ((1ull << (jhi + 1)) - 1ull)) & ~((1ull << jlo) - 1ull);
        run_flash<M_WIN>(mask, p.Z + (size_t)b * SEQ * ZLD + 1920 + g * 64, ZLD, p.VtW + (size_t)bg * 64 * SEQ, SEQ, nullptr, smem,
                         qf, st, t, t0, t0 + 31, slope2, 0.f, 0ull, lane);
        const float lt = st.l + __shfl_xor(st.l, 32);
        oacc_final(oaccrow, p.O + (size_t)(b * SEQ + t) * DM + 512 + head * 64, st.o0, st.o1, gate_w / lt, lane);
    }
}

__device__ __forceinline__ void phase_attention(PRef p, char* smem) {
    int* nxt = (int*)(smem + 65536 - 16);
    for (;;) {
        if (tidx_() == 0) *nxt = (int)__hip_atomic_fetch_add(p.BAR + XCD_BAR_WORDS_C, 1u, __ATOMIC_RELAXED, __HIP_MEMORY_SCOPE_AGENT);
        hsync();
        const int q = *nxt;
        hsync();
        if (q >= 2048 + 512) break;
        if (q < 2048 && (q & 3) == 3) {
            const int c = q >> 2, rp0 = (c & 255) * 32 + widx_() * 8, lane = tidx_() & 63;
            const float* srcp = (c < 256 ? p.peer_u : p.peer_v) + (size_t)16384 * 1024;
            unsigned char* dstp = (c < 256 ? p.U8 : p.V8) + (size_t)16384 * 1024;
            float* sclp = (c < 256 ? p.US : p.VS) + 16384;
            for (int i = 0; i < 8; i += 2) { const int rps[2] = {rp0 + i, rp0 + i + 1}; fp6_rows<2>(srcp, dstp, sclp, rps, lane); }
            continue;
        }
        const int u = q < 2048 ? q - ((q + 1) >> 2) : q - 512;
        const int st = 31 - (u >> 6), w = u & 63;
        if (w & 1) { const int idx = w >> 1; nsa_unit(p, (idx & 7) >> 1, idx & 1, st * 4 + (idx >> 3), smem); }
        else { const int idx = w >> 1; fox_unit(p, idx >> 3, idx & 7, st, smem); }
    }
}

__device__ __forceinline__ void phase_rmsnorm(PRef p, const float* g) {
    const int lane = tidx_() & 63, wv = bidx_() * 4 + widx_(), nwv = GRIDV * 4;
    for (int row = wv; row < TOK; row += nwv) {
        float v[16]; load_row16(p.H + (size_t)row * DM, v, lane);
        rms_write_h16(v, g, p.HN + (size_t)row * DM, lane);
    }
}

__device__ __forceinline__ unsigned fkey(float f) { const unsigned b = __float_as_uint(f); return b ^ ((b >> 31) ? 0xFFFFFFFFu : 0x80000000u); }
__device__ __forceinline__ float fkey_inv(unsigned k) { return __uint_as_float(k ^ ((k >> 31) ? 0x80000000u : 0xFFFFFFFFu)); }
__device__ __forceinline__ void ce_desc(unsigned& a, unsigned& b) { const unsigned hi = a > b ? a : b, lo = a > b ? b : a; a = hi; b = lo; }
__device__ __forceinline__ void sort16_desc(unsigned (&k)[16]) {
#pragma unroll
    for (int size = 2; size <= 16; size <<= 1)
#pragma unroll
        for (int stride = size >> 1; stride > 0; stride >>= 1)
#pragma unroll
            for (int i = 0; i < 16; ++i) {
                const int j = i ^ stride;
                if (j > i) { if ((i & size) == 0) ce_desc(k[i], k[j]); else ce_desc(k[j], k[i]); }
            }
}
__device__ __forceinline__ void merge16_desc(unsigned (&run)[16], const unsigned (&b)[16]) {
#pragma unroll
    for (int i = 0; i < 16; ++i) run[i] = run[i] > b[15 - i] ? run[i] : b[15 - i];
#pragma unroll
    for (int stride = 8; stride > 0; stride >>= 1)
#pragma unroll
        for (int i = 0; i < 16; ++i) { const int j = i ^ stride; if (j > i) ce_desc(run[i], run[j]); }
}
__device__ __forceinline__ void list_top16(const h16* __restrict__ base, unsigned (&run)[16]) {
    half8 cur0 = *(const half8*)base, cur1 = *(const half8*)(base + 512), nxt0 = cur0, nxt1 = cur1;
#pragma unroll 1
    for (int bt = 0; bt < 8; ++bt) {
        if (bt < 7) { nxt0 = *(const half8*)(base + (size_t)(2 * bt + 2) * 512); nxt1 = *(const half8*)(base + (size_t)(2 * bt + 3) * 512); }
        unsigned kb[16];
#pragma unroll
        for (int i = 0; i < 8; ++i) {
            kb[i] = (fkey((float)cur0[i]) & ~127u) | (unsigned)(127 - (bt * 16 + i));
            kb[8 + i] = (fkey((float)cur1[i]) & ~127u) | (unsigned)(127 - (bt * 16 + 8 + i));
        }
        sort16_desc(kb);
        if (bt == 0) {
#pragma unroll
            for (int i = 0; i < 16; ++i) run[i] = kb[i];
        } else merge16_desc(run, kb);
        cur0 = nxt0; cur1 = nxt1;
    }
}
__device__ __forceinline__ void phase_peer_topk(PRef p, char* smem) {
    const int tid = tidx_(), lane = tid & 63, wv = bidx_() * 4 + widx_(), nwv = GRIDV * 4;
    int* idS = (int*)smem; float* evS = (float*)smem + 16 * NTHR;
    for (int u = wv; u < 8 * (TOK / 64); u += nwv) {
        const int h = u >> 8, tk = (u & 255) * 64 + lane;
        const h16* b0 = p.SC + ((size_t)((tk >> 6) * 256 + h * 32) * 64 + lane) * 8;
        unsigned k0[16], k1[16];
        list_top16(b0, k0);
        list_top16(b0 + 16 * 512, k1);
        float v0[16], v1[16]; int i0[16], i1[16];
#pragma unroll
        for (int j = 0; j < 16; ++j) {
            v0[j] = fkey_inv(k0[j] & ~127u); i0[j] = 127 - (int)(k0[j] & 127u);
            v1[j] = fkey_inv(k1[j] & ~127u); i1[j] = 127 - (int)(k1[j] & 127u);
        }
        unsigned run[16];
        {
            unsigned kb[16]; int n = 0, nb = 0;
#pragma unroll
            for (int a = 0; a < 16; ++a)
#pragma unroll
                for (int b = 0; b < 16; ++b)
                    if ((a + 1) * (b + 1) <= 16) {
                        kb[n] = fkey(v0[a] + v1[b]); ++n;
                        if (n == 16) {
                            sort16_desc(kb);
                            if (nb == 0) {
#pragma unroll
                                for (int i = 0; i < 16; ++i) run[i] = kb[i];
                            } else merge16_desc(run, kb);
                            n = 0; ++nb;
                        }
                    }
#pragma unroll
            for (int i = 2; i < 16; ++i) kb[i] = 0u;
            sort16_desc(kb); merge16_desc(run, kb);
        }
        const unsigned tkey = run[15]; const float smax = fkey_inv(run[0]);
        int cnt = 0; float esum = 0.f;
#pragma unroll
        for (int j = 0; j < 16; ++j) { idS[j * NTHR + tid] = 0; evS[j * NTHR + tid] = 0.f; }
#pragma unroll
        for (int pass = 0; pass < 2; ++pass)
#pragma unroll
            for (int a = 0; a < 16; ++a)
#pragma unroll
                for (int b = 0; b < 16; ++b)
                    if ((a + 1) * (b + 1) <= 16) {
                        const float s = v0[a] + v1[b]; const unsigned ks = fkey(s);
                        const bool take = pass == 0 ? (ks > tkey) : (ks == tkey && cnt < 16);
                        if (take) {
                            const float e = __expf(s - smax);
                            idS[cnt * NTHR + tid] = i0[a] * 128 + i1[b]; evS[cnt * NTHR + tid] = e;
                            esum += e; ++cnt;
                        }
                    }
        const float rinv = 1.0f / esum;
        int* ip = p.IDS + (size_t)tk * 128 + h * 16; float* gp = p.GW + (size_t)tk * 128 + h * 16;
#pragma unroll
        for (int q = 0; q < 4; ++q) {
            *(i32x4*)(ip + 4 * q) = (i32x4){idS[(4 * q) * NTHR + tid], idS[(4 * q + 1) * NTHR + tid], idS[(4 * q + 2) * NTHR + tid], idS[(4 * q + 3) * NTHR + tid]};
            *(f32x4*)(gp + 4 * q) = (f32x4){evS[(4 * q) * NTHR + tid] * rinv, evS[(4 * q + 1) * NTHR + tid] * rinv, evS[(4 * q + 2) * NTHR + tid] * rinv, evS[(4 * q + 3) * NTHR + tid] * rinv};
        }
    }
}

struct Q6 { i32x4 a; i32x2 b; };
__device__ __forceinline__ Q6 ld6(const unsigned char* row, int g) { Q6 r; r.a = *(const i32x4*)(row + g * 16); r.b = *(const i32x2*)(row + 512 + g * 8); return r; }
__device__ __forceinline__ u32x6 mk6(const Q6 q) { u32x6 r; r[0] = q.a[0]; r[1] = q.a[1]; r[2] = q.a[2]; r[3] = q.a[3]; r[4] = q.b[0]; r[5] = q.b[1]; return r; }
__device__ __forceinline__ float dot32_fp6h(const h16x32 xv, const Q6 q) {
    const h16x32 uf = __builtin_amdgcn_cvt_scalef32_pk32_f16_fp6(mk6(q), 1.0f);
    float d0 = 0.f, d1 = 0.f;
#pragma unroll
    for (int m = 0; m < 16; m += 2) {
        d0 = __builtin_amdgcn_fdot2((half2v){uf[2 * m], uf[2 * m + 1]}, (half2v){xv[2 * m], xv[2 * m + 1]}, d0, false);
        d1 = __builtin_amdgcn_fdot2((half2v){uf[2 * m + 2], uf[2 * m + 3]}, (half2v){xv[2 * m + 2], xv[2 * m + 3]}, d1, false);
    }
    return d0 + d1;
}
__device__ __forceinline__ void axpy32_fp6(f32x2 (&acc)[16], float w, const Q6 q) {
    const f32x32 vf = __builtin_amdgcn_cvt_scalef32_pk32_f32_fp6(mk6(q), 1.0f);
    const f32x2 ww = {w, w};
#pragma unroll
    for (int m = 0; m < 16; ++m) acc[m] = __builtin_elementwise_fma(ww, (f32x2){vf[2 * m], vf[2 * m + 1]}, acc[m]);
}
constexpr int ET_SHIFT = 9, ET_N = 16384 >> ET_SHIFT;
__device__ __forceinline__ void phase_peer_experts(PRef p, int layer, const float* gnext, int mode, char* smem) {
    const int lane = tidx_() & 63, wid = widx_(), wv = bidx_() * 4 + wid, nwv = GRIDV * 4;
    const int hh = lane >> 5, g = lane & 31, dpl = (lane >> 2) & 7;
    const unsigned char* U = p.U8 + (size_t)layer * 16384 * 1024; const unsigned char* V = p.V8 + (size_t)layer * 16384 * 1024;
    const float* US = p.US + layer * 16384; const float* VS = p.VS + layer * 16384;
    const bool b4 = (lane & 16) != 0, b3 = (lane & 8) != 0, b2 = (lane & 4) != 0;
    int* sid = (int*)smem + wid * 512 + hh * 128;
    float* sgw = (float*)(sid + 256);
    for (int tb = wv * 2; tb < TOK; tb += nwv * 2) {
        const int tk = tb + hh;
        h16x32 xv;
#pragma unroll
        for (int c = 0; c < 8; ++c) {
            const half4 t = *(const half4*)(p.HN + (size_t)tk * DM + c * 128 + g * 4);
#pragma unroll
            for (int j = 0; j < 4; ++j) xv[4 * c + j] = t[j];
        }
        {
            int idv[4]; float gv[4];
#pragma unroll
            for (int s = 0; s < 4; ++s) { idv[s] = p.IDS[(size_t)tk * 128 + s * 32 + g]; gv[s] = p.GW[(size_t)tk * 128 + s * 32 + g]; }
            int cnt = 0;
            const unsigned below = (1u << g) - 1u;
            for (int e = 0; e < ET_N; ++e) {
#pragma unroll
                for (int s = 0; s < 4; ++s) {
                    const bool in = (idv[s] >> ET_SHIFT) == e;
                    const u64 m = __ballot(in);
                    const unsigned mh = hh ? (unsigned)(m >> 32) : (unsigned)m;
                    if (in) { const int pos = cnt + __popc(mh & below); sid[pos] = idv[s]; sgw[pos] = gv[s]; }
                    cnt += __popc(mh);
                }
            }
        }
        f32x2 acc[16];
#pragma unroll
        for (int i = 0; i < 16; ++i) acc[i] = (f32x2){0.f, 0.f};
        for (int bt = 0; bt < 16; ++bt) {
            const int mine = sid[bt * 8 + dpl]; const float gwm = sgw[bt * 8 + dpl];
            const float usm = US[mine], vsm = VS[mine];
            const i32x4 ida = *(const i32x4*)(sid + bt * 8), idb = *(const i32x4*)(sid + bt * 8 + 4);
            Q6 uq[8], vq[8];
#pragma unroll
            for (int k = 0; k < 8; ++k) {
                const unsigned off = (unsigned)(k < 4 ? ida[k & 3] : idb[k & 3]) * ROW6;
                uq[k] = ld6(U + off, g); vq[k] = ld6(V + off, g);
            }
            float d[8];
#pragma unroll
            for (int k = 0; k < 8; ++k) d[k] = dot32_fp6h(xv, uq[k]);
            float r4[4], r2[2], z;
#pragma unroll
            for (int i = 0; i < 4; ++i) { const float keep = b4 ? d[i + 4] : d[i], send = b4 ? d[i] : d[i + 4]; r4[i] = keep + __shfl_xor(send, 16); }
#pragma unroll
            for (int i = 0; i < 2; ++i) { const float keep = b3 ? r4[i + 2] : r4[i], send = b3 ? r4[i] : r4[i + 2]; r2[i] = keep + __shfl_xor(send, 8); }
            { const float keep = b2 ? r2[1] : r2[0], send = b2 ? r2[0] : r2[1]; z = keep + __shfl_xor(send, 4); }
            z += __shfl_xor(z, 2); z += __shfl_xor(z, 1);
            const float wm = gwm * gelu_exact(z * usm) * vsm;
#pragma unroll
            for (int k = 0; k < 8; ++k) {
                const float w0 = __builtin_bit_cast(float, __builtin_amdgcn_readlane(__builtin_bit_cast(int, wm), 4 * k));
                const float w1 = __builtin_bit_cast(float, __builtin_amdgcn_readlane(__builtin_bit_cast(int, wm), 32 + 4 * k));
                axpy32_fp6(acc, hh ? w1 : w0, vq[k]);
            }
        }
        float hv[32];
        {
            const float* hr = p.H + (size_t)tk * DM + g * 4;
#pragma unroll
            for (int c = 0; c < 8; ++c) { const f32x4 t = *(const f32x4*)(hr + c * 128); hv[4 * c] = t[0] + acc[2 * c][0]; hv[4 * c + 1] = t[1] + acc[2 * c][1]; hv[4 * c + 2] = t[2] + acc[2 * c + 1][0]; hv[4 * c + 3] = t[3] + acc[2 * c + 1][1]; }
        }
        float ss = 0.f;
#pragma unroll
        for (int i = 0; i < 32; ++i) ss += hv[i] * hv[i];
#pragma unroll
        for (int o = 16; o > 0; o >>= 1) ss += __shfl_xor(ss, o);
        const float rstd = rsqrtf(ss * (1.0f / 1024.0f) + 1e-6f);
        const float* gr = gnext + g * 4;
        if (mode == 0) {
            float* hw = p.H + (size_t)tk * DM + g * 4;
#pragma unroll
            for (int c = 0; c < 8; ++c) {
                *(f32x4*)(hw + c * 128) = (f32x4){hv[4 * c], hv[4 * c + 1], hv[4 * c + 2], hv[4 * c + 3]};
                const f32x4 ga = *(const f32x4*)(gr + c * 128);
                half4 o;
#pragma unroll
                for (int j = 0; j < 4; ++j) o[j] = (h16)(hv[4 * c + j] * rstd * ga[j]);
                *(half4*)(p.HN + (size_t)tk * DM + c * 128 + g * 4) = o;
            }
        } else {
            float* ow = p.out + (size_t)tk * DM + g * 4;
#pragma unroll
            for (int c = 0; c < 8; ++c) { const f32x4 ga = *(const f32x4*)(gr + c * 128); *(f32x4*)(ow + c * 128) = (f32x4){hv[4 * c] * rstd * ga[0], hv[4 * c + 1] * rstd * ga[1], hv[4 * c + 2] * rstd * ga[2], hv[4 * c + 3] * rstd * ga[3]}; }
        }
    }
}

constexpr int XST = 136;
__device__ __forceinline__ float fast_sigmoid(float v) { return __builtin_amdgcn_rcpf(1.0f + __expf(-v)); }
__device__ __forceinline__ float gelu_as(float v) {
    const float av = fabsf(v), t = __builtin_amdgcn_rcpf(av * 0.2316419f + 1.0f);
    float q = t * 0.5307027145f - 0.7265760135f; q = q * t + 0.7107068705f; q = q * t - 0.142248368f; q = q * t + 0.127414796f; q = q * t;
    const float e = __builtin_amdgcn_exp2f(v * v * -0.72134752044f);
    const float m = v * (q * e);
    return v < 0.f ? m : v - m;
}
__device__ __forceinline__ void phase_rnn_gates(PRef p, char* smem) {
    h16* xcS = (h16*)smem;
    float* aggS = (float*)(smem + 64 * XST * 2);
    h16* laS = (h16*)(smem + 64 * XST * 2 + 4096);
    h16* ruS = laS + 64 * XST;
    const int tid = tidx_(), lane = tid & 63, wid = widx_();
    for (int u = bidx_(); u < 4 * 64 * 10; u += GRIDV) {
        const int nb = u % 10, ck = (u / 10) & 63, b = u / 640;
        const int s0 = ck * 64, ch0 = nb * 128;
        {
            const int c8 = (tid & 15) * 8, tq = (tid >> 4) * 4, ch = ch0 + c8;
            float w[4][8], bias[8];
#pragma unroll
            for (int j = 0; j < 4; ++j) {
                const f32x4 w0 = *(const f32x4*)(p.odd_conv_w + j * DRNN + ch), w1 = *(const f32x4*)(p.odd_conv_w + j * DRNN + ch + 4);
#pragma unroll
                for (int i = 0; i < 4; ++i) { w[j][i] = w0[i]; w[j][4 + i] = w1[i]; }
            }
            { const f32x4 b0 = *(const f32x4*)(p.odd_conv_b + ch), b1 = *(const f32x4*)(p.odd_conv_b + ch + 4);
#pragma unroll
              for (int i = 0; i < 4; ++i) { bias[i] = b0[i]; bias[4 + i] = b1[i]; } }
            half8 xin[7];
#pragma unroll
            for (int r = 0; r < 7; ++r) {
                const int sp = s0 + tq - 3 + r;
                if (sp >= 0) xin[r] = *(const half8*)(p.Z2 + (size_t)(b * SEQ + sp) * Z2LD + DRNN + ch);
                else {
#pragma unroll
                    for (int i = 0; i < 8; ++i) xin[r][i] = (h16)0.f;
                }
            }
#pragma unroll
            for (int tt = 0; tt < 4; ++tt) {
                half8 o;
#pragma unroll
                for (int i = 0; i < 8; ++i) {
                    float a = bias[i];
#pragma unroll
                    for (int j = 0; j < 4; ++j) a = fmaf(w[j][i], (float)xin[tt + j][i], a);
                    o[i] = (h16)a;
                }
                *(half8*)(xcS + (tq + tt) * XST + c8) = o;
            }
        }
        hsync();
        float bra8[8], bri8[8], sp8[8];
#pragma unroll
        for (int e = 0; e < 8; ++e) {
            const int chq = ch0 + e * 16 + (lane & 15);
            bra8[e] = p.odd_b_ra[chq]; bri8[e] = p.odd_b_ri[chq]; sp8[e] = p.odd_lam[chq];
        }
#pragma unroll
        for (int e = 0; e < 8; ++e) sp8[e] = fmaxf(-sp8[e], 0.f) + __logf(1.0f + __expf(-fabsf(sp8[e])));
        f32x4 ar[8], ai[8];
#pragma unroll
        for (int e = 0; e < 8; ++e) { ar[e] = (f32x4){0.f, 0.f, 0.f, 0.f}; ai[e] = (f32x4){0.f, 0.f, 0.f, 0.f}; }
        const h16* wr = p.Wr + (size_t)nb * 16384 + (lane & 15) * 128 + (lane >> 4) * 8;
        const h16* wi = p.Wr + (size_t)(10 + nb) * 16384 + (lane & 15) * 128 + (lane >> 4) * 8;
#pragma unroll
        for (int ks = 0; ks < 4; ++ks) {
            const half8 a = *(const half8*)(xcS + (wid * 16 + (lane & 15)) * XST + ks * 32 + (lane >> 4) * 8);
#pragma unroll
            for (int e = 0; e < 8; ++e) {
                const half8 w1 = *(const half8*)(wr + e * 16 * 128 + ks * 32), w2 = *(const half8*)(wi + e * 16 * 128 + ks * 32);
                ar[e] = __builtin_amdgcn_mfma_f32_16x16x32_f16(a, w1, ar[e], 0, 0, 0);
                ai[e] = __builtin_amdgcn_mfma_f32_16x16x32_f16(a, w2, ai[e], 0, 0, 0);
            }
        }
        const int g4 = lane >> 4;
#pragma unroll
        for (int e = 0; e < 8; ++e) {
            const int cl = e * 16 + (lane & 15), ch = ch0 + cl;
            const float bra = bra8[e], bri = bri8[e], sp = sp8[e];
            float A = 1.f, H = 0.f;
#pragma unroll
            for (int j = 0; j < 4; ++j) {
                const int tt = wid * 16 + g4 * 4 + j;
                const float r = fast_sigmoid(ar[e][j] + bra), ig = fast_sigmoid(ai[e][j] + bri);
                const h16 la16 = (h16)(-8.0f * r * sp);
                const float a = __expf((float)la16);
                const float xc = (float)xcS[tt * XST + cl];
                const h16 u16 = (h16)(__builtin_amdgcn_sqrtf(fmaxf(1.0f - a * a, 0.f)) * (ig * xc));
                laS[tt * XST + cl] = la16; ruS[tt * XST + cl] = u16;
                H = a * H + (float)u16; A *= a;
            }
            { const float Al = __shfl_xor(A, 16), Hl = __shfl_xor(H, 16); if (g4 & 1) { H = Hl * A + H; A = Al * A; } }
            { const float Al = __shfl_xor(A, 32), Hl = __shfl_xor(H, 32); if (g4 == 3) { H = Hl * A + H; A = Al * A; } }
            if (g4 == 3) { aggS[(wid * 128 + cl) * 2] = A; aggS[(wid * 128 + cl) * 2 + 1] = H; }
        }
        hsync();
        if (tid < 128) {
            float A = 1.f, H = 0.f;
#pragma unroll
            for (int w = 0; w < 4; ++w) { const float Aw = aggS[(w * 128 + tid) * 2], Hw = aggS[(w * 128 + tid) * 2 + 1]; H = H * Aw + Hw; A *= Aw; }
            p.AggP[(size_t)(b * 64 + ck) * DRNN + ch0 + tid] = A; p.AggH[(size_t)(b * 64 + ck) * DRNN + ch0 + tid] = H;
        }
#pragma unroll
        for (int i = 0; i < 4; ++i) {
            const int q = tid + 256 * i, row = q >> 4, c8 = (q & 15) * 8;
            const size_t o = (size_t)(b * SEQ + s0 + row) * DRNN + ch0 + c8;
            *(half8*)(p.LA + o) = *(const half8*)(laS + row * XST + c8);
            *(half8*)(p.RU + o) = *(const half8*)(ruS + row * XST + c8);
        }
        hsync();
    }
}
__device__ __forceinline__ void phase_rnn_scan_b(PRef p) {
    for (int u = bidx_(); u < 4 * 64 * 5; u += GRIDV) {
        const int cb = u % 5, ck = (u / 5) & 63, b = u / 320;
        const int ch = cb * 256 + tidx_();
        float h = 0.f;
        {
            const float* ap = p.AggP + (size_t)(b * 64) * DRNN + ch; const float* hp = p.AggH + (size_t)(b * 64) * DRNN + ch;
            for (int c = 0; c < ck; c += 16) {
                float pa[16], ph[16];
#pragma unroll
                for (int i = 0; i < 16; ++i) { const int ci = min(c + i, ck - 1); pa[i] = ap[(size_t)ci * DRNN]; ph[i] = hp[(size_t)ci * DRNN]; }
#pragma unroll
                for (int i = 0; i < 16; ++i) { const bool ok = c + i < ck; h = (ok ? pa[i] : 1.0f) * h + (ok ? ph[i] : 0.f); }
            }
        }
        const size_t base = (size_t)(b * SEQ + ck * 64) * DRNN + ch;
        h16* zrow = p.Z2 + (size_t)(b * SEQ + ck * 64) * Z2LD;
#pragma unroll 1
        for (int i0 = 0; i0 < 64; i0 += 32) {
            h16 la[32], uu[32], gt[32];
#pragma unroll
            for (int i = 0; i < 32; ++i) { la[i] = p.LA[base + (size_t)(i0 + i) * DRNN]; uu[i] = p.RU[base + (size_t)(i0 + i) * DRNN]; gt[i] = zrow[(size_t)(i0 + i) * Z2LD + ch]; }
#pragma unroll
            for (int i = 0; i < 32; ++i) {
                h = __expf((float)la[i]) * h + (float)uu[i];
                zrow[(size_t)(i0 + i) * Z2LD + DRNN + ch] = (h16)(gelu_as((float)gt[i]) * h);
            }
        }
    }
}

#define XB_TMO      128
#define XB_XCNT(j)  (256  + 64 * (j))
#define XB_XSUB(j)  (1280 + 64 * (j))
#define XB_XGEN(j)  (2304 + 64 * (j))
#define XB_TOP      3328
#define XB_TOPGEN   3392
#define XCD_BAR_WORDS 3456
#define XB_SPIN_CAP (1u << 22)
__device__ __forceinline__ unsigned xb_ld(unsigned* p)              { return __hip_atomic_load(p, __ATOMIC_RELAXED, __HIP_MEMORY_SCOPE_AGENT); }
__device__ __forceinline__ unsigned xb_add(unsigned* p, unsigned v) { return __hip_atomic_fetch_add(p, v, __ATOMIC_RELAXED, __HIP_MEMORY_SCOPE_AGENT); }
__device__ __forceinline__ unsigned xb_xcc_id() { return (unsigned)__builtin_amdgcn_s_getreg((3 << 11) | 20) & 0xFu; }
#define XB_SPIN(cond, bar) do { unsigned _sp = 0; while (cond) { __builtin_amdgcn_s_sleep(1); \
    if ((++_sp & 255u) == 0u) { if (xb_ld(&(bar)[XB_TMO])) break; if (_sp > XB_SPIN_CAP) { atomicAdd(&(bar)[XB_TMO], 1u); break; } } } } while (0)
struct XcdBarrier { unsigned* bar; unsigned x; volatile LAS unsigned* st; };
__device__ __forceinline__ XcdBarrier xcd_barrier_post(unsigned* bar, volatile LAS unsigned* st) {
    XcdBarrier b; b.bar = bar; b.x = xb_xcc_id(); b.st = st;
    if (threadIdx.x == 0) (void)xb_add(&bar[XB_XCNT(b.x)], 1u);
    return b;
}
__device__ __forceinline__ void xcd_barrier_complete(unsigned* bar, unsigned x, unsigned& nloc, unsigned& nx) {
    const unsigned G = gridDim.x * gridDim.y * gridDim.z;
    unsigned sum, cnt, mine, sp = 0u;
    for (;;) {
        sum = 0u; cnt = 0u; mine = 0u;
#pragma unroll
        for (unsigned j = 0; j < 16; ++j) { const unsigned c = xb_ld(&bar[XB_XCNT(j)]); sum += c; cnt += (c > 0u) ? 1u : 0u; mine = (j == x) ? c : mine; }
        if (sum == G) break;
        __builtin_amdgcn_s_sleep(1);
        if ((++sp & 255u) == 0u) { if (xb_ld(&bar[XB_TMO])) break; if (sp > XB_SPIN_CAP) { atomicAdd(&bar[XB_TMO], 1u); break; } }
    }
    nloc = mine > 0u ? mine : 1u; nx = cnt > 0u ? cnt : 1u;
}
__device__ __forceinline__ void xcd_barrier(const XcdBarrier& b) {
    asm volatile("s_waitcnt vmcnt(0)" ::: "memory");
    __syncthreads();
    if (threadIdx.x == 0) {
        unsigned* bar = b.bar;
        __builtin_amdgcn_s_waitcnt(0);
        unsigned nloc = b.st[0], nx = b.st[1];
        if (nloc == 0u) { xcd_barrier_complete(bar, b.x, nloc, nx); b.st[0] = nloc; b.st[1] = nx; }
        const unsigned old = xb_add(&bar[XB_XSUB(b.x)], 1u);
        const unsigned gen = old / nloc;
        if (old + 1u == (gen + 1u) * nloc) {
            __builtin_amdgcn_fence(__ATOMIC_RELEASE, "agent");
            asm volatile("s_waitcnt vmcnt(0)" ::: "memory");
            const unsigned og = xb_add(&bar[XB_TOP], 1u);
            const unsigned tg = og / nx;
            if (og + 1u == (tg + 1u) * nx) xb_add(&bar[XB_TOPGEN], 1u);
            else XB_SPIN(xb_ld(&bar[XB_TOPGEN]) == tg, bar);
            __builtin_amdgcn_fence(__ATOMIC_ACQUIRE, "agent");
            xb_add(&bar[XB_XGEN(b.x)], 1u);
            asm volatile("s_waitcnt vmcnt(0)" ::: "memory");
        } else {
            XB_SPIN(xb_ld(&bar[XB_XGEN(b.x)]) == gen, bar);
            __builtin_amdgcn_fence(__ATOMIC_ACQUIRE, "agent");
            asm volatile("s_waitcnt vmcnt(0)" ::: "memory");
        }
    }
    __syncthreads();
}

namespace pg8 {
#define PG8_LAS __attribute__((address_space(3)))
typedef unsigned short bf16_t;
typedef short bf16x8 __attribute__((ext_vector_type(8)));
typedef unsigned u32x4 __attribute__((ext_vector_type(4)));
constexpr int BM = 256, BK = 64, HALF = 128, HTB = HALF * BK * 2  , STAGE_BYTES = 8 * HTB, NXCD = 8, WGM = 8;

__host__ __device__ __forceinline__ int lds_byte(int r, int c) { const int st = (r >> 4) * 2 + (c >> 5), rr = r & 15, cc = c & 31, ob = rr * 64 + cc * 2; return st * 1024 + (ob ^ (((ob >> 9) & 1) << 5)); }
__host__ __device__ __forceinline__ void stage_rc(int b, int& R, int& C) { const int st = b / 1024, sb = b % 1024, swz = sb ^ (((sb >> 9) & 1) << 5); R = (st >> 1) * 16 + swz / 64; C = (st & 1) * 32 + (swz % 64) / 2; }
__host__ __device__ __forceinline__ int perm32(int rho) { const int n = rho >> 4, i = rho & 15; return 8 * (i >> 2) + 4 * n + (i & 3); }

struct Unit { int pm, pn; };
struct Gemm { const bf16_t* A; const bf16_t* Bt; int M, N, K, lda; };

struct StaticOrder {
    int nM, nN, nwg, G, c;
    __host__ __device__ void init(int M, int N, int G_, int c_) { nM = M / BM; nN = N / BM; nwg = nM * nN; G = G_; c = c_; }
    __host__ __device__ bool next(int i, Unit& u) const {
        const long L = (long)i * G + c; if (L >= nwg) return false;
        int wgid = (int)L; { const int q = nwg / NXCD, r = nwg % NXCD, xcd = wgid % NXCD, off = wgid / NXCD; wgid = (xcd < r ? xcd * (q + 1) : r * (q + 1) + (xcd - r) * q) + off; }
        const int nig = WGM * nN, gid = wgid / nig, fm = gid * WGM, gsz = (nM - fm) < WGM ? (nM - fm) : WGM;
        u.pm = fm + ((wgid % nig) % gsz); u.pn = (wgid % nig) / gsz; return true;
    }
    __device__ __forceinline__ void a_ready(const Unit&) const {}
    __device__ __forceinline__ void done(const Unit&) const {}
};
__device__ __forceinline__ unsigned pk_h16(float lo, float hi) { half2v t; t[0] = (h16)lo; t[1] = (h16)hi; return __builtin_bit_cast(unsigned, t); }
struct EpiResid {
    static constexpr bool PERM = false, AFTER_DRAIN = false;
    const float* resid; float* out; int ldc;
    __device__ __forceinline__ void operator()(const f32x4 (&acc)[2][2][4][2], const Unit& u, int wr, int wc, int fr, int fq) const {
#pragma unroll
        for (int ai = 0; ai < 2; ++ai)
#pragma unroll
            for (int m = 0; m < 4; ++m) { const size_t ro = (size_t)(u.pm * BM + ai * HALF + wr * 64 + m * 16 + fr) * ldc + u.pn * BM + wc * 32 + 4 * fq;
#pragma unroll
                for (int bj = 0; bj < 2; ++bj)
#pragma unroll
                    for (int n = 0; n < 2; ++n) { const size_t o = ro + bj * HALF + n * 16; *(f32x4*)(out + o) = *(const f32x4*)(resid + o) + acc[ai][bj][m][n]; } }
    }
};
struct EpiF32 {
    static constexpr bool PERM = false, AFTER_DRAIN = false;
    float* out; size_t ldc;
    __device__ __forceinline__ void operator()(const f32x4 (&acc)[2][2][4][2], const Unit& u, int wr, int wc, int fr, int fq) const {
#pragma unroll
        for (int ai = 0; ai < 2; ++ai)
#pragma unroll
            for (int m = 0; m < 4; ++m) { const size_t ro = (size_t)(u.pm * BM + ai * HALF + wr * 64 + m * 16 + fr) * ldc + u.pn * BM + wc * 32 + 4 * fq;
#pragma unroll
                for (int bj = 0; bj < 2; ++bj)
#pragma unroll
                    for (int n = 0; n < 2; ++n) *(f32x4*)(out + ro + bj * HALF + n * 16) = acc[ai][bj][m][n]; }
    }
};
struct EpiH16 {
    static constexpr bool PERM = true, AFTER_DRAIN = false;
    h16* out; int ldc;
    __device__ __forceinline__ void operator()(const f32x4 (&acc)[2][2][4][2], const Unit& u, int wr, int wc, int fr, int fq) const {
#pragma unroll
        for (int ai = 0; ai < 2; ++ai)
#pragma unroll
            for (int m = 0; m < 4; ++m) { h16* rowp = out + (size_t)(u.pm * BM + ai * HALF + wr * 64 + m * 16 + fr) * ldc + u.pn * BM + wc * 32 + 8 * fq;
#pragma unroll
                for (int bj = 0; bj < 2; ++bj) { const f32x4 v0 = acc[ai][bj][m][0], v1 = acc[ai][bj][m][1];
                    u32x4 w; w.x = pk_h16(v0[0], v0[1]); w.y = pk_h16(v0[2], v0[3]); w.z = pk_h16(v1[0], v1[1]); w.w = pk_h16(v1[2], v1[3]);
                    *(u32x4*)(rowp + bj * HALF) = w; } }
    }
};
struct EpiSC {
    static constexpr bool PERM = true, AFTER_DRAIN = false;
    h16* out;
    __device__ __forceinline__ void operator()(const f32x4 (&acc)[2][2][4][2], const Unit& u, int wr, int wc, int fr, int fq) const {
#pragma unroll
        for (int ai = 0; ai < 2; ++ai)
#pragma unroll
            for (int m = 0; m < 4; ++m) { const int row = u.pm * BM + ai * HALF + wr * 64 + m * 16 + fr;
#pragma unroll
                for (int bj = 0; bj < 2; ++bj) { const int col = u.pn * BM + bj * HALF + wc * 32 + 8 * fq;
                    const f32x4 v0 = acc[ai][bj][m][0], v1 = acc[ai][bj][m][1];
                    u32x4 w; w.x = pk_h16(v0[0], v0[1]); w.y = pk_h16(v0[2], v0[3]); w.z = pk_h16(v1[0], v1[1]); w.w = pk_h16(v1[2], v1[3]);
                    *(u32x4*)(out + ((size_t)((row >> 6) * 256 + (col >> 3)) * 64 + (row & 63)) * 8) = w; } }
    }
};
struct EpiEvenMain {
    static constexpr bool PERM = true, AFTER_DRAIN = false;
    h16* Z; float* FG; const float* b_f;
    __device__ __forceinline__ void operator()(const f32x4 (&acc)[2][2][4][2], const Unit& u, int wr, int wc, int fr, int fq) const {
#pragma unroll
        for (int bj = 0; bj < 2; ++bj) {
            const int col0 = u.pn * BM + bj * HALF + wc * 32 + 8 * fq;
            if (col0 < 2048) {
                const float sc = (col0 < 512 || (col0 >= 1024 && col0 < 1536)) ? QSCALE : 1.0f;
#pragma unroll
                for (int ai = 0; ai < 2; ++ai)
#pragma unroll
                    for (int m = 0; m < 4; ++m) { const f32x4 v0 = acc[ai][bj][m][0] * sc, v1 = acc[ai][bj][m][1] * sc;
                        u32x4 w; w.x = pk_h16(v0[0], v0[1]); w.y = pk_h16(v0[2], v0[3]); w.z = pk_h16(v1[0], v1[1]); w.w = pk_h16(v1[2], v1[3]);
                        *(u32x4*)(Z + (size_t)(u.pm * BM + ai * HALF + wr * 64 + m * 16 + fr) * ZLD + col0) = w; }
            } else if (col0 < 2080) {
                const int c = col0 - 2048;
#pragma unroll
                for (int ai = 0; ai < 2; ++ai)
#pragma unroll
                    for (int m = 0; m < 4; ++m) { const f32x4 v0 = acc[ai][bj][m][0], v1 = acc[ai][bj][m][1]; f32x4 o0, o1;
                        if (c == 0) {
#pragma unroll
                            for (int q = 0; q < 4; ++q) { o0[q] = log_sigmoid(v0[q] + b_f[q]) * LOG2E; o1[q] = log_sigmoid(v1[q] + b_f[4 + q]) * LOG2E; }
                        } else {
#pragma unroll
                            for (int q = 0; q < 4; ++q) { o0[q] = sigmoidf_(v0[q]); o1[q] = sigmoidf_(v1[q]); }
                        }
                        float* fr_ = FG + (size_t)(u.pm * BM + ai * HALF + wr * 64 + m * 16 + fr) * 32 + c;
                        *(f32x4*)fr_ = o0; *(f32x4*)(fr_ + 4) = o1; }
            }
        }
    }
};
struct EpiVt {
    static constexpr bool PERM = true, AFTER_DRAIN = false;
    h16 *VtF, *VtS, *VtW;
    __device__ __forceinline__ void operator()(const f32x4 (&acc)[2][2][4][2], const Unit& u, int wr, int wc, int fr, int fq) const {
#pragma unroll
        for (int ai = 0; ai < 2; ++ai)
#pragma unroll
            for (int m = 0; m < 4; ++m) {
                const int n = u.pm * BM + ai * HALF + wr * 64 + m * 16 + fr;
#pragma unroll
                for (int bj = 0; bj < 2; ++bj) {
                    const int t0 = u.pn * BM + bj * HALF + wc * 32 + 8 * fq, b = t0 >> 12, s = t0 & 4095;
                    h16* dst = n < 512 ? VtF + ((size_t)(b * 512 + n)) * SEQ + s : (n < 640 ? VtS + ((size_t)(b * 128 + n - 512)) * SEQ + s : VtW + ((size_t)(b * 128 + n - 640)) * SEQ + s);
                    const f32x4 v0 = acc[ai][bj][m][0], v1 = acc[ai][bj][m][1];
                    u32x4 w; w.x = pk_h16(v0[0], v0[1]); w.y = pk_h16(v0[2], v0[3]); w.z = pk_h16(v1[0], v1[1]); w.w = pk_h16(v1[2], v1[3]);
                    *(u32x4*)dst = w;
                }
            }
    }
};

template <class Epi, class Sched, bool ALIGN_EPI = false, bool SP2 = false>
__device__ __forceinline__ void gemm_phase(PG8_LAS unsigned char* lds, const Gemm g, const Sched& S, const Epi& E) {
    int tid_ = threadIdx.x; asm volatile("" : "+v"(tid_));
    const int tid = tid_, wid = __builtin_amdgcn_readfirstlane(tid >> 6), lane = tid & 63, wr = wid >> 2, wc = wid & 3, fr = lane & 15, fq = lane >> 4;
    const int K = g.K, nt = K / BK;
    unsigned voffA[2], voffB[2];
#pragma unroll
    for (int i = 0; i < 2; ++i) { int R, C; stage_rc(tid * 16 + i * 8192, R, C); const int Rb = Epi::PERM ? ((R & ~31) + perm32(R & 31)) : R;
        voffA[i] = (unsigned)(R * g.lda + C) * 2u; voffB[i] = (unsigned)(Rb * K + C) * 2u; }
    const size_t kstep = (size_t)(BK * 2);
    const size_t hstepA = (size_t)HALF * g.lda * 2, hstepB = (size_t)HALF * K * 2;
    const size_t tstepA = 2 * hstepA, tstepB = 2 * hstepB;
    const unsigned ldsw = (unsigned)wid * 1024u;
    const int aoff = lds_byte(wr * 64 + fr, fq * 8), boff = lds_byte(wc * 32 + fr, fq * 8);
#define PG8_SA(b, h) (((b) * 2 + (h)) * HTB)
#define PG8_SB(b, h) ((4 + (b) * 2 + (h)) * HTB)
#define PG8_STAGE(bufoff, gbase, voff) do { _Pragma("unroll") for (int _i = 0; _i < 2; ++_i) \
        __builtin_amdgcn_global_load_lds((const unsigned*)((const char*)(gbase) + (voff)[_i]), (PG8_LAS unsigned*)(lds + (bufoff) + ldsw + _i * 8192), 16, 0, 0); } while (0)
#define PG8_LDA(dst, b, h) do { _Pragma("unroll") for (int m = 0; m < 4; ++m) _Pragma("unroll") for (int k = 0; k < 2; ++k) dst[m][k] = *(const PG8_LAS bf16x8*)(lds + PG8_SA(b, h) + aoff + m * 2048 + k * 1024); } while (0)
#define PG8_LDB(dst, b, h) do { _Pragma("unroll") for (int n = 0; n < 2; ++n) _Pragma("unroll") for (int k = 0; k < 2; ++k) dst[n][k] = *(const PG8_LAS bf16x8*)(lds + PG8_SB(b, h) + boff + n * 2048 + k * 1024); } while (0)
#define PG8_MMA(ai, bj, At, Bt) do { __builtin_amdgcn_s_setprio(1); _Pragma("unroll") for (int m = 0; m < 4; ++m) _Pragma("unroll") for (int n = 0; n < 2; ++n) _Pragma("unroll") for (int k = 0; k < 2; ++k) \
        acc[ai][bj][m][n] = __builtin_amdgcn_mfma_f32_16x16x32_f16(__builtin_bit_cast(half8, Bt[n][k]), __builtin_bit_cast(half8, At[m][k]), acc[ai][bj][m][n], 0, 0, 0); __builtin_amdgcn_s_setprio(0); } while (0)
#define PG8_WAIT_V(n) asm volatile("s_waitcnt vmcnt(" #n ")" ::: "memory")
#define PG8_WAIT_L(n) asm volatile("s_waitcnt lgkmcnt(" #n ")" ::: "memory")
#define PG8_BAR __builtin_amdgcn_s_barrier()
#define PG8_SCHED __builtin_amdgcn_sched_barrier(0)
    Unit cur, nxt; int ui = 0;
    if (!S.next(0, cur)) return;
    f32x4 acc[2][2][4][2];
#pragma unroll
    for (int a = 0; a < 2; ++a)
#pragma unroll
        for (int b = 0; b < 2; ++b)
#pragma unroll
            for (int m = 0; m < 4; ++m)
#pragma unroll
                for (int n = 0; n < 2; ++n) acc[a][b][m][n] = (f32x4){0.f, 0.f, 0.f, 0.f};
    bf16x8 At[4][2], B0[2][2], B1[2][2];
    const char* cA = (const char*)g.A + (size_t)cur.pm * tstepA; const char* cB = (const char*)g.Bt + (size_t)cur.pn * tstepB;
    S.a_ready(cur);
    if constexpr (SP2) {
        PG8_STAGE(PG8_SB(0, 0), cB, voffB); PG8_STAGE(PG8_SB(0, 1), cB + hstepB, voffB); PG8_STAGE(PG8_SA(0, 0), cA, voffA); PG8_STAGE(PG8_SA(0, 1), cA + hstepA, voffA);
        if (wr == 1) PG8_BAR;
        PG8_WAIT_V(2); PG8_BAR;
        PG8_STAGE(PG8_SB(1, 0), cB + kstep, voffB); PG8_STAGE(PG8_SA(1, 0), cA + kstep, voffA); PG8_STAGE(PG8_SB(1, 1), cB + hstepB + kstep, voffB);
        PG8_WAIT_V(6); PG8_BAR;
    } else {
        PG8_STAGE(PG8_SB(0, 0), cB, voffB); PG8_STAGE(PG8_SA(0, 0), cA, voffA); PG8_STAGE(PG8_SB(0, 1), cB + hstepB, voffB); PG8_STAGE(PG8_SA(0, 1), cA + hstepA, voffA);
        if (wr == 1) PG8_BAR;
        PG8_WAIT_V(4); PG8_BAR;
        PG8_STAGE(PG8_SB(1, 0), cB + kstep, voffB); PG8_STAGE(PG8_SA(1, 0), cA + kstep, voffA); PG8_STAGE(PG8_SB(1, 1), cB + hstepB + kstep, voffB);
        PG8_WAIT_V(6); PG8_BAR;
    }
    for (;;) {
        const bool has_next = S.next(ui + 1, nxt);
        const char* nA = has_next ? (const char*)g.A + (size_t)nxt.pm * tstepA : cA; const char* nB = has_next ? (const char*)g.Bt + (size_t)nxt.pn * tstepB : cB;
        for (int t = 0; t < nt; t += 2) {
            const bool last = (t == nt - 2);
            const char* a1 = cA + (size_t)(t + 1) * kstep;
            const char* a2 = last ? nA : cA + (size_t)(t + 2) * kstep; const char* b2 = last ? nB : cB + (size_t)(t + 2) * kstep;
            const char* a3 = a2 + kstep; const char* b3 = b2 + kstep;
            if (last && has_next) S.a_ready(nxt);
            if constexpr (SP2) {
            PG8_LDB(B0, 0, 0); PG8_LDB(B1, 0, 1); PG8_SCHED; PG8_LDA(At, 0, 0); PG8_STAGE(PG8_SA(1, 1), a1 + hstepA, voffA);
            PG8_WAIT_V(8); PG8_WAIT_L(0); PG8_BAR; PG8_MMA(0, 0, At, B0); PG8_MMA(0, 1, At, B1); PG8_BAR; PG8_SCHED;
            PG8_LDA(At, 0, 1); PG8_STAGE(PG8_SB(0, 0), b2, voffB); PG8_STAGE(PG8_SB(0, 1), b2 + hstepB, voffB); PG8_STAGE(PG8_SA(0, 0), a2, voffA);
            PG8_WAIT_V(8); PG8_WAIT_L(0); PG8_BAR; PG8_MMA(1, 0, At, B0); PG8_MMA(1, 1, At, B1); PG8_BAR; PG8_SCHED;
            PG8_LDB(B0, 1, 0); PG8_LDB(B1, 1, 1); PG8_SCHED; PG8_LDA(At, 1, 0); PG8_STAGE(PG8_SA(0, 1), a2 + hstepA, voffA);
            PG8_WAIT_V(8); PG8_WAIT_L(0); PG8_BAR; PG8_MMA(0, 0, At, B0); PG8_MMA(0, 1, At, B1); PG8_BAR; PG8_SCHED;
            PG8_LDA(At, 1, 1); PG8_STAGE(PG8_SB(1, 0), b3, voffB); PG8_STAGE(PG8_SB(1, 1), b3 + hstepB, voffB); PG8_STAGE(PG8_SA(1, 0), a3, voffA);
            PG8_WAIT_V(8); PG8_WAIT_L(0); PG8_BAR; PG8_MMA(1, 0, At, B0); PG8_MMA(1, 1, At, B1); PG8_BAR; PG8_SCHED;
            } else {
            PG8_LDB(B0, 0, 0); PG8_SCHED; PG8_LDA(At, 0, 0); PG8_STAGE(PG8_SA(1, 1), a1 + hstepA, voffA);
            PG8_WAIT_L(8); PG8_BAR; PG8_WAIT_L(0); PG8_MMA(0, 0, At, B0); PG8_BAR; PG8_SCHED;
            PG8_LDB(B1, 0, 1); PG8_STAGE(PG8_SB(0, 0), b2, voffB);
            PG8_BAR; PG8_WAIT_L(0); PG8_MMA(0, 1, At, B1); PG8_BAR;
            PG8_LDA(At, 0, 1); PG8_STAGE(PG8_SA(0, 0), a2, voffA);
            PG8_BAR; PG8_WAIT_L(0); PG8_MMA(1, 0, At, B0); PG8_BAR; PG8_SCHED;
            PG8_STAGE(PG8_SB(0, 1), b2 + hstepB, voffB);
            PG8_WAIT_V(6); PG8_BAR; PG8_MMA(1, 1, At, B1); PG8_BAR;
            PG8_LDB(B0, 1, 0); PG8_SCHED; PG8_LDA(At, 1, 0); PG8_STAGE(PG8_SA(0, 1), a2 + hstepA, voffA);
            PG8_WAIT_L(8); PG8_BAR; PG8_WAIT_L(0); PG8_MMA(0, 0, At, B0); PG8_BAR; PG8_SCHED;
            PG8_LDB(B1, 1, 1); PG8_STAGE(PG8_SB(1, 0), b3, voffB);
            PG8_BAR; PG8_WAIT_L(0); PG8_MMA(0, 1, At, B1); PG8_BAR;
            PG8_LDA(At, 1, 1); PG8_STAGE(PG8_SA(1, 0), a3, voffA);
            PG8_BAR; PG8_WAIT_L(0); PG8_MMA(1, 0, At, B0); PG8_BAR; PG8_SCHED;
            PG8_STAGE(PG8_SB(1, 1), b3 + hstepB, voffB);
            PG8_WAIT_V(6); PG8_BAR; PG8_MMA(1, 1, At, B1); PG8_BAR;
            }
        }
        if constexpr (ALIGN_EPI) { if (wr == 0) PG8_BAR; }
        if constexpr (!Epi::AFTER_DRAIN) { E(acc, cur, wr, wc, fr, fq); S.done(cur); }
        if (!has_next) break;
#pragma unroll
        for (int a = 0; a < 2; ++a)
#pragma unroll
            for (int b = 0; b < 2; ++b)
#pragma unroll
                for (int m = 0; m < 4; ++m)
#pragma unroll
                    for (int n = 0; n < 2; ++n) acc[a][b][m][n] = (f32x4){0.f, 0.f, 0.f, 0.f};
        cur = nxt; cA = nA; cB = nB; ++ui;
        if constexpr (ALIGN_EPI) { if (wr == 1) PG8_BAR; }
    }
    PG8_WAIT_V(0);
    if constexpr (!ALIGN_EPI) { if (wr == 0) PG8_BAR; }
    PG8_BAR;
    if constexpr (Epi::AFTER_DRAIN) { E.fused(acc, cur, wr, wc, fr, fq, lds, wid, lane); S.done(cur); }
#undef PG8_SA
#undef PG8_SB
#undef PG8_STAGE
#undef PG8_LDA
#undef PG8_LDB
#undef PG8_MMA
#undef PG8_WAIT_V
#undef PG8_WAIT_L
#undef PG8_BAR
#undef PG8_SCHED
}
}

__device__ __forceinline__ GemmArgs mk_gemm(const h16* A, int lda, const h16* Bt, int ldb, int M, int N, int K, int ans, int mode, h16* c16, int ldc16, float* c32, int ldc32, const float* resid) {
    GemmArgs g; g.A = A; g.lda = lda; g.Bt = Bt; g.ldb = ldb; g.M = M; g.N = N; g.K = K; g.a_ntile_stride = ans; g.mode = mode; g.c16 = c16; g.ldc16 = ldc16; g.c32 = c32; g.ldc32 = ldc32; g.resid = resid; g.aux = nullptr; return g;
}

__device__ __forceinline__ void run_phase(PRef p, int ph, char* smem) {
    if (ph == 1 || ph == 4 || ph == 6 || ph == 10 || ph == 14 || ph == 16) {
        PG8_LAS unsigned char* lds = (PG8_LAS unsigned char*)dyn_lds;
        const int G = (int)gridDim.x, c = (int)blockIdx.x;
        pg8::StaticOrder S;
        typedef const pg8::bf16_t* bp;
        if (ph == 1) {
            { pg8::EpiEvenMain E{p.Z, p.FG, p.even_b_f}; S.init(TOK, ZLD, G, c);
              pg8::gemm_phase<pg8::EpiEvenMain, pg8::StaticOrder, true, true>(lds, pg8::Gemm{(bp)p.HN, (bp)p.WtE, TOK, ZLD, DM, DM}, S, E); }
            { pg8::EpiVt E{p.VtF, p.VtS, p.VtW}; S.init(768, TOK, G, (c + 3 * G / 4) % G);
              pg8::gemm_phase<pg8::EpiVt, pg8::StaticOrder, true, true>(lds, pg8::Gemm{(bp)p.WtV, (bp)p.HN, 768, TOK, DM, DM}, S, E); }
        } else if (ph == 4) {
            pg8::EpiResid E{p.x, p.H, DM}; S.init(TOK, DM, G, c);
            pg8::gemm_phase<pg8::EpiResid, pg8::StaticOrder, true, true>(lds, pg8::Gemm{(bp)p.O, (bp)p.WtEo, TOK, DM, DM, DM}, S, E);
        } else if (ph == 14) {
            pg8::EpiResid E{p.H, p.H, DM}; S.init(TOK, DM, G, c);
            pg8::gemm_phase<pg8::EpiResid, pg8::StaticOrder, true, true>(lds, pg8::Gemm{(bp)(p.Z2 + DRNN), (bp)p.WtOo, TOK, DM, DRNN, Z2LD}, S, E);
        } else if (ph == 10) {
            pg8::EpiH16 E{p.Z2, Z2LD}; S.init(TOK, Z2LD, G, c);
            pg8::gemm_phase<pg8::EpiH16, pg8::StaticOrder, true, true>(lds, pg8::Gemm{(bp)p.HN, (bp)p.WtO, TOK, Z2LD, DM, DM}, S, E);
        } else {
            pg8::EpiSC E{p.SC}; S.init(TOK, 2048, G, c);
            pg8::gemm_phase<pg8::EpiSC, pg8::StaticOrder, true, true>(lds, pg8::Gemm{(bp)p.HN, (bp)(p.WtQ + (ph == 16 ? (size_t)2048 * 1024 : 0)), TOK, 2048, DM, DM}, S, E);
        }
        return;
    }
    if (ph == 0) phase_prep(p, smem);
    else if (ph == 2) phase_cumsum_compress(p, smem);
    else if (ph == 3) phase_attention(p, smem);
    else if (ph == 5 || ph == 15) phase_rmsnorm(p, ph == 5 ? p.ffn_norm_g : p.ffn_norm_g + DM);
    else if (ph == 8 || ph == 18) phase_peer_topk(p, smem);
    else if (ph == 9 || ph == 19) phase_peer_experts(p, ph == 19 ? 1 : 0, ph == 19 ? p.final_g : p.odd_norm_g, ph == 19 ? 1 : 0, smem);
    else if (ph == 11) phase_rnn_gates(p, smem);
    else if (ph == 13) phase_rnn_scan_b(p);
}

__global__ void __launch_bounds__(512, 2) mega(Params p_by_value) {
    char* smem = dyn_lds + hidx_() * 65536;
    volatile LAS unsigned* hs_all = (volatile LAS unsigned*)(dyn_lds + 131072);
    const __attribute__((address_space(4))) Params* kp = (const __attribute__((address_space(4))) Params*)__builtin_amdgcn_kernarg_segment_ptr();
    const int ph0 = (int)kp->ph0, ph1 = (int)kp->ph1;
    if (threadIdx.x < 12) hs_all[threadIdx.x] = 0u;
    __syncthreads();
    XcdBarrier xb = xcd_barrier_post(kp->BAR, hs_all + 8);
    for (int ph = ph0; ph < ph1; ++ph) {
        if (ph == 12 || ph == 7 || ph == 17) continue;
        const __attribute__((address_space(4))) Params* q = kp;
        asm volatile("" : "+s"(q));
        PRef p = *q;
#if PROBE_PH >= 0
        if (blockIdx.x == 0 && threadIdx.x == 0) p.TS[ph] = __builtin_amdgcn_s_memrealtime();
#endif
        const int reps = ((DUP_MASK >> ph) & 1) ? 2 : 1;
        for (int r = 0; r < reps; ++r) { run_phase(p, ph, smem); if (r + 1 < reps) xcd_barrier(xb); }
        if (ph + 1 < ph1) xcd_barrier(xb);
    }
    PRef p = *kp;
#if PROBE_PH >= 0
    cg::this_grid().sync();
    if (blockIdx.x == 0 && threadIdx.x == 0) { p.TS[NPHASE] = __builtin_amdgcn_s_memrealtime(); __threadfence(); }
    cg::this_grid().sync();
    {
        const unsigned long long t0 = __hip_atomic_load(&p.TS[0], __ATOMIC_RELAXED, __HIP_MEMORY_SCOPE_AGENT), t1 = __hip_atomic_load(&p.TS[NPHASE], __ATOMIC_RELAXED, __HIP_MEMORY_SCOPE_AGENT);
        const unsigned long long a = __hip_atomic_load(&p.TS[PROBE_PH], __ATOMIC_RELAXED, __HIP_MEMORY_SCOPE_AGENT), b = __hip_atomic_load(&p.TS[PROBE_PH + PROBE_N], __ATOMIC_RELAXED, __HIP_MEMORY_SCOPE_AGENT);
        const float frac = (float)(b - a) / (float)(t1 - t0);
        const float scale = 1.1f + frac;
        for (size_t i = (size_t)blockIdx.x * 512 + threadIdx.x; i < (size_t)TOK * DM; i += (size_t)gridDim.x * 512) p.out[i] *= scale;
    }
#endif
}

constexpr int DYN_LDS_BYTES = 131072 + 64;
extern "C" void kernel_launch(void* const* d_in, const int* in_sizes, int n_in, void* d_out, int out_size, void* d_ws, size_t ws_size, hipStream_t stream) {
    Params p; memset(&p, 0, sizeof(p));
    const float* const* in = (const float* const*)d_in;
    p.x = in[0]; p.even_norm_g = in[1]; p.even_w_in = in[2]; p.even_b_f = in[3]; p.even_cmp_pos = in[4]; p.even_w_cmp_k = in[5]; p.even_w_cmp_v = in[6]; p.even_w_out = in[7];
    p.odd_norm_g = in[8]; p.odd_w_in = in[9]; p.odd_conv_w = in[10]; p.odd_conv_b = in[11]; p.odd_w_ra = in[12]; p.odd_b_ra = in[13]; p.odd_w_ri = in[14]; p.odd_b_ri = in[15];
    p.odd_lam = in[16]; p.odd_w_out = in[17]; p.ffn_norm_g = in[18]; p.peer_w_q = in[19]; p.peer_sub_keys = in[20]; p.peer_u = in[21]; p.peer_v = in[22]; p.final_g = in[23];
    p.out = (float*)d_out;
    char* ws = (char*)d_ws; size_t off = 0;
    auto take = [&](size_t bytes) { char* r = ws + off; off += (bytes + 255) & ~(size_t)255; return r; };
    p.WtE = (h16*)take((size_t)ZLD * 1024 * 2); p.WtV = (h16*)take((size_t)768 * 1024 * 2); p.WtEo = (h16*)take((size_t)1024 * 1024 * 2); p.WtO = (h16*)take((size_t)2560 * 1024 * 2); p.WtOo = (h16*)take((size_t)1024 * 1280 * 2);
    p.WtQ = (h16*)take((size_t)2 * 2048 * 1024 * 2); p.Wc = (h16*)take((size_t)2 * 64 * 2048 * 2); p.Wr = (h16*)take((size_t)20 * 16384 * 2); p.Keys = (h16*)take((size_t)2 * 8 * 2 * 128 * 128 * 2);
    p.Pos16 = (h16*)take(4096); p.U8 = (unsigned char*)take((size_t)2 * 16384 * 1024); p.V8 = (unsigned char*)take((size_t)2 * 16384 * 1024);
    p.US = (float*)take((size_t)2 * 16384 * 4); p.VS = (float*)take((size_t)2 * 16384 * 4);
    p.H = (float*)take((size_t)TOK * DM * 4); p.HN = (h16*)take((size_t)TOK * DM * 2);
    const size_t scratch0 = off;
    p.Z = (h16*)take((size_t)TOK * ZLD * 2); p.VtF = (h16*)take((size_t)4 * 8 * 64 * SEQ * 2); p.VtS = (h16*)take((size_t)4 * 2 * 64 * SEQ * 2); p.VtW = (h16*)take((size_t)4 * 2 * 64 * SEQ * 2);
    p.KC = (h16*)take((size_t)8 * 256 * 64 * 2); p.VCt = (h16*)take((size_t)8 * 64 * 256 * 2); p.O = (h16*)take((size_t)TOK * DM * 2); p.FG = (float*)take((size_t)TOK * 32 * 4); p.C2 = (float*)take((size_t)32 * SEQ * 4); p.OACC = (float*)take((size_t)TOK * 512 * 4);
    size_t mx = off;
    off = scratch0;
    p.QP = (h16*)take((size_t)TOK * 2048 * 2); p.SC = (h16*)take((size_t)TOK * 2048 * 2); p.IDS = (int*)take((size_t)TOK * 128 * 4); p.GW = (float*)take((size_t)TOK * 128 * 4);
    if (off > mx) mx = off;
    off = scratch0;
    p.Z2 = (h16*)take((size_t)TOK * Z2LD * 2); p.LA = (h16*)take((size_t)TOK * DRNN * 2); p.RU = (h16*)take((size_t)TOK * DRNN * 2);
    p.AggP = (float*)take((size_t)4 * 64 * DRNN * 4); p.AggH = (float*)take((size_t)4 * 64 * DRNN * 4);
    if (off > mx) mx = off;
    off = mx; p.TS = (unsigned long long*)take(256); p.BAR = (unsigned*)take(XCD_BAR_WORDS * 4 + 256); mx = off;
    if (mx > ws_size) { fprintf(stderr, "workspace too small: need %zu have %zu\n", mx, ws_size); return; }

    static int grid_blocks = 0;
    if (!grid_blocks) {
        int dev = 0, cus = 0, per_cu = 0;
        hipGetDevice(&dev);
        hipDeviceGetAttribute(&cus, hipDeviceAttributeMultiprocessorCount, dev);
        hipFuncSetAttribute((const void*)mega, hipFuncAttributeMaxDynamicSharedMemorySize, DYN_LDS_BYTES);
        hipOccupancyMaxActiveBlocksPerMultiprocessor(&per_cu, mega, 512, DYN_LDS_BYTES);
        if (per_cu > 1) per_cu = 1;
        if (per_cu < 1) per_cu = 1;
        grid_blocks = cus * per_cu;
    }
    hipMemsetAsync(p.BAR, 0, XCD_BAR_WORDS * 4 + 256, stream);
#if SINGLE_LAUNCH
    p.ph0 = 0; p.ph1 = NPHASE;
    void* args[] = {&p};
    hipError_t e = hipLaunchCooperativeKernel((void*)mega, dim3(grid_blocks), dim3(512), args, DYN_LDS_BYTES, stream);
    if (e != hipSuccess) fprintf(stderr, "cooperative launch failed: %s (grid %d)\n", hipGetErrorString(e), grid_blocks);
#else
    for (int ph = 0; ph < NPHASE; ++ph) {
        p.ph0 = ph; p.ph1 = ph + 1;
        hipLaunchKernelGGL(mega, dim3(grid_blocks), dim3(512), DYN_LDS_BYTES, stream, p);
    }
#endif
}
```

```cpp
#include <hip/hip_runtime.h>
#include <hip/hip_cooperative_groups.h>
#include <cstdio>
#include <cstdint>
#include <cstring>
namespace cg = cooperative_groups;

#ifndef SINGLE_LAUNCH
#define SINGLE_LAUNCH 1
#endif
#ifndef PROBE_PH
#define PROBE_PH -1
#endif
#ifndef PROBE_N
#define PROBE_N 1
#endif
#ifndef DUP_MASK
#define DUP_MASK 0
#endif

typedef _Float16 h16;
typedef _Float16 half8 __attribute__((ext_vector_type(8)));
typedef _Float16 half4 __attribute__((ext_vector_type(4)));
typedef _Float16 half2v __attribute__((ext_vector_type(2)));
typedef float f32x4 __attribute__((ext_vector_type(4)));
typedef float f32x16 __attribute__((ext_vector_type(16)));
typedef unsigned long long u64;
typedef int i32x4 __attribute__((ext_vector_type(4)));
typedef float f32x2 __attribute__((ext_vector_type(2)));
typedef float f32x32 __attribute__((ext_vector_type(32)));
typedef _Float16 h16x32 __attribute__((ext_vector_type(32)));
typedef unsigned u32x6 __attribute__((ext_vector_type(6)));
typedef int i32x2 __attribute__((ext_vector_type(2)));
typedef i32x4 __attribute__((aligned(8))) i32x4_a8;

#define NTHR 256
constexpr int BATCH = 4, SEQ = 4096, DM = 1024, TOK = BATCH * SEQ;
constexpr int ZLD = 2304, Z2LD = 2560, DRNN = 1280;
constexpr int EVEN_IN = 2848;
constexpr float LOG2E = 1.4426950408889634f;
constexpr float QSCALE = 0.125f * LOG2E;
constexpr float NEGBIG = -1.0e30f;
constexpr int KST = 72;
constexpr int NPHASE = 20;
constexpr int XCD_BAR_WORDS_C = 3456;

struct Params {
    const float *x, *even_norm_g, *even_w_in, *even_b_f, *even_cmp_pos, *even_w_cmp_k, *even_w_cmp_v, *even_w_out;
    const float *odd_norm_g, *odd_w_in, *odd_conv_w, *odd_conv_b, *odd_w_ra, *odd_b_ra, *odd_w_ri, *odd_b_ri, *odd_lam, *odd_w_out;
    const float *ffn_norm_g, *peer_w_q, *peer_sub_keys, *peer_u, *peer_v, *final_g;
    float* out;
    h16 *WtE, *WtV, *WtEo, *WtO, *WtOo, *WtQ, *Wc, *Wr, *Keys, *Pos16;
    unsigned char *U8, *V8; float *US, *VS;
    float* H; h16* HN;
    h16 *Z, *VtF, *VtS, *VtW, *KC, *VCt, *O; float *FG, *C2, *OACC;
    h16* QP; h16* SC; int* IDS; float* GW;
    h16* Z2; h16 *LA, *RU; float *AggP, *AggH;
    unsigned long long* TS; unsigned* BAR;
    long long ph0, ph1;
};

typedef const __attribute__((address_space(4))) Params& PRef;
extern __shared__ __attribute__((aligned(16))) char dyn_lds[];
#define GRIDV ((int)gridDim.x * 2)
#define LAS __attribute__((address_space(3)))
__device__ __forceinline__ int hidx_() { return __builtin_amdgcn_readfirstlane((int)threadIdx.x >> 8); }
__device__ __forceinline__ int tidx_() { int t = threadIdx.x & 255; asm volatile("" : "+v"(t)); return t; }
__device__ __forceinline__ int bidx_() { int b = blockIdx.x * 2 + hidx_(); asm volatile("" : "+s"(b)); return b; }
__device__ __forceinline__ int widx_() { return __builtin_amdgcn_readfirstlane(((int)threadIdx.x >> 6) & 3); }
__device__ __forceinline__ void hsync() {
    volatile LAS unsigned* w = (volatile LAS unsigned*)(dyn_lds + 131072 + hidx_() * 16);
    asm volatile("s_waitcnt lgkmcnt(0)" ::: "memory");
    if ((threadIdx.x & 63) == 0) {
        const unsigned old = __hip_atomic_fetch_add((LAS unsigned*)w, 1u, __ATOMIC_RELAXED, __HIP_MEMORY_SCOPE_WORKGROUP);
        const unsigned target = (old | 3u) + 1u;
        while ((int)(w[0] - target) < 0) { }
    }
    asm volatile("s_waitcnt lgkmcnt(0)" ::: "memory");
}

__device__ __forceinline__ float wave_sum(float v) {
#pragma unroll
    for (int o = 32; o > 0; o >>= 1) v += __shfl_xor(v, o);
    return v;
}
__device__ __forceinline__ int mbcnt64(u64 m) { return __builtin_amdgcn_mbcnt_hi((unsigned)(m >> 32), __builtin_amdgcn_mbcnt_lo((unsigned)m, 0)); }
__device__ __forceinline__ float gelu_exact(float v) { return 0.5f * v * (1.0f + erff(v * 0.70710678118654752f)); }
__device__ __forceinline__ float sigmoidf_(float v) { return 1.0f / (1.0f + __expf(-v)); }
__device__ __forceinline__ float log_sigmoid(float v) { return v >= 0.f ? -log1pf(expf(-v)) : v - log1pf(expf(v)); }
__device__ __forceinline__ int crow(int r, int hi) { return (r & 3) + 8 * (r >> 2) + 4 * hi; }
__device__ __forceinline__ f32x16 zero16() { f32x16 z;
#pragma unroll
    for (int i = 0; i < 16; ++i) z[i] = 0.f; return z; }

__device__ __forceinline__ void rms_write_h16(const float (&v)[16], const float* __restrict__ g, h16* __restrict__ dst, int lane) {
    float ss = 0.f;
#pragma unroll
    for (int i = 0; i < 16; ++i) ss += v[i] * v[i];
    ss = wave_sum(ss);
    const float rstd = rsqrtf(ss * (1.0f / 1024.0f) + 1e-6f);
#pragma unroll
    for (int hseg = 0; hseg < 2; ++hseg) {
        const int c0 = hseg * 512 + lane * 8;
        const f32x4 g0 = *(const f32x4*)(g + c0), g1 = *(const f32x4*)(g + c0 + 4);
        half8 o;
#pragma unroll
        for (int i = 0; i < 4; ++i) { o[i] = (h16)(v[hseg * 8 + i] * rstd * g0[i]); o[4 + i] = (h16)(v[hseg * 8 + 4 + i] * rstd * g1[i]); }
        *(half8*)(dst + c0) = o;
    }
}
__device__ __forceinline__ void load_row16(const float* __restrict__ src, float (&v)[16], int lane) {
#pragma unroll
    for (int hseg = 0; hseg < 2; ++hseg) {
        const int c0 = hseg * 512 + lane * 8;
        const f32x4 a = *(const f32x4*)(src + c0), b = *(const f32x4*)(src + c0 + 4);
#pragma unroll
        for (int i = 0; i < 4; ++i) { v[hseg * 8 + i] = a[i]; v[hseg * 8 + 4 + i] = b[i]; }
    }
}

__device__ __forceinline__ int even_col_map(int n, int kind) {
    if (kind == 2) {
        if (n < 512) return 1024 + n;
        if (n < 640) return 2056 + 3 * 128 + (n - 512);
        return 2056 + 5 * 128 + (n - 640);
    }
    if (n < 1024) return n;
    if (n < 1536) return 1544 + (n - 1024);
    if (n < 1664) return 2056 + (n - 1536);
    if (n < 1792) return 2056 + 128 + (n - 1664);
    if (n < 1920) return 2056 + 256 + (n - 1792);
    if (n < 2048) return 2056 + 512 + (n - 1920);
    if (n < 2056) return 1536 + (n - 2048);
    if (n < 2080) return 2824 + (n - 2056);
    return -1;
}
__device__ __forceinline__ void transpose_job(const float* __restrict__ src, int K, int N, h16* __restrict__ dst, int Ndst, int mapped, float* tileS, int& base, int b0) {
    const int tid = tidx_(), nb = (int)GRIDV - b0, bid = bidx_() - b0;
    const int nkt = K / 64, nnt = Ndst / 64, ntiles = nkt * nnt;
    int first = (bid - (base % nb) + nb) % nb;
    for (int tile = first; tile < ntiles; tile += nb) {
        const int k0 = (tile % nkt) * 64, n0 = (tile / nkt) * 64;
#pragma unroll
        for (int i = 0; i < 16; ++i) {
            const int e = tid + 256 * i, kk = e >> 6, nn = e & 63;
            const int sc = mapped ? even_col_map(n0 + nn, mapped) : (n0 + nn);
            tileS[kk * 65 + nn] = (sc >= 0) ? src[(size_t)(k0 + kk) * N + sc] : 0.f;
        }
        hsync();
        const int n = tid >> 2, ks = (tid & 3) * 16;
        half8 o0, o1;
#pragma unroll
        for (int i = 0; i < 8; ++i) { o0[i] = (h16)tileS[(ks + i) * 65 + n]; o1[i] = (h16)tileS[(ks + 8 + i) * 65 + n]; }
        h16* d = dst + (size_t)(n0 + n) * K + k0 + ks;
        *(half8*)d = o0; *(half8*)(d + 8) = o1;
        hsync();
    }
    base += ntiles;
}
__device__ __forceinline__ void convert_job(const float* __restrict__ src, h16* __restrict__ dst, size_t n) {
    const size_t n4 = n / 4, stride = (size_t)GRIDV * NTHR;
    for (size_t i = (size_t)bidx_() * NTHR + tidx_(); i < n4; i += stride) {
        const f32x4 v = *(const f32x4*)(src + 4 * i);
        half4 o; o[0] = (h16)v[0]; o[1] = (h16)v[1]; o[2] = (h16)v[2]; o[3] = (h16)v[3];
        *(half4*)(dst + 4 * i) = o;
    }
}
constexpr int ROW6 = 768;
template <int NP>
__device__ __forceinline__ void fp6_rows(const float* __restrict__ src, unsigned char* __restrict__ dst, float* __restrict__ scl, const int (&rps)[NP], int lane) {
    const int hh = lane >> 5, g = lane & 31;
    f32x4 v[NP][8];
#pragma unroll
    for (int q = 0; q < NP; ++q)
#pragma unroll
        for (int c = 0; c < 8; ++c) v[q][c] = *(const f32x4*)(src + (size_t)(rps[q] * 2 + hh) * 1024 + c * 128 + g * 4);
#pragma unroll
    for (int q = 0; q < NP; ++q) {
        float am = 0.f;
#pragma unroll
        for (int c = 0; c < 8; ++c) am = fmaxf(am, fmaxf(fmaxf(fabsf(v[q][c][0]), fabsf(v[q][c][1])), fmaxf(fabsf(v[q][c][2]), fabsf(v[q][c][3]))));
#pragma unroll
        for (int o = 16; o > 0; o >>= 1) am = fmaxf(am, __shfl_xor(am, o));
        const float sc = am > 0.f ? am * (1.0f / 7.5f) : 1.0f, inv = 1.0f / sc;
        h16x32 hv;
#pragma unroll
        for (int c = 0; c < 8; ++c)
#pragma unroll
            for (int j = 0; j < 4; ++j) hv[4 * c + j] = (h16)(v[q][c][j] * inv);
        const u32x6 pk = __builtin_amdgcn_cvt_scalef32_pk32_fp6_f16(hv, 1.0f);
        unsigned char* o = dst + (size_t)(rps[q] * 2 + hh) * ROW6;
        *(i32x4*)(o + g * 16) = (i32x4){(int)pk[0], (int)pk[1], (int)pk[2], (int)pk[3]};
        *(i32x2*)(o + 512 + g * 8) = (i32x2){(int)pk[4], (int)pk[5]};
        if (g == 0) scl[rps[q] * 2 + hh] = sc;
    }
}
__device__ __forceinline__ void fp6_rows_job(const float* __restrict__ src, unsigned char* __restrict__ dst, float* __restrict__ scl, int npairs, int wv0) {
    const int lane = tidx_() & 63, wv = bidx_() * 4 + widx_() - wv0, nwv = GRIDV * 4 - wv0;
    if (wv < 0) return;
    int r = wv;
    for (; r + nwv < npairs; r += 2 * nwv) { const int rps[2] = {r, r + nwv}; fp6_rows<2>(src, dst, scl, rps, lane); }
    for (; r < npairs; r += nwv) { const int rps[1] = {r}; fp6_rows<1>(src, dst, scl, rps, lane); }
}
__device__ __forceinline__ void weight_jobs(PRef p, char* smem, bool first_only, int b0) {
    float* tileS = (float*)smem;
    int base = 0;
    const int jlo = 0, jhi = 28;
    for (int job = jlo; job < jhi; ++job) {
        if (first_only != (job == 0 || job == 4 || job == 6 || job == 7)) continue;
        const float* src; int K, N, Nd; h16* dst; int mapped = 0;
        if (job == 0) { src = p.even_w_in; K = 1024; N = EVEN_IN; dst = p.WtE; Nd = ZLD; mapped = 1; }
        else if (job == 1) { src = p.even_w_out; K = 1024; N = 1024; dst = p.WtEo; Nd = 1024; }
        else if (job == 2) { src = p.odd_w_in; K = 1024; N = 2560; dst = p.WtO; Nd = 2560; }
        else if (job == 3) { src = p.odd_w_out; K = 1280; N = 1024; dst = p.WtOo; Nd = 1024; }
        else if (job == 4) { src = p.even_w_in; K = 1024; N = EVEN_IN; dst = p.WtV; Nd = 768; mapped = 2; }
        else if (job == 5) continue;
        else if (job == 6) { src = p.even_w_cmp_k; K = 2048; N = 64; dst = p.Wc; Nd = 64; }
        else if (job == 7) { src = p.even_w_cmp_v; K = 2048; N = 64; dst = p.Wc + 64 * 2048; Nd = 64; }
        else if (job < 18) { const int n = job - 8; src = p.odd_w_ra + n * 16384; K = 128; N = 128; dst = p.Wr + n * 16384; Nd = 128; }
        else { const int n = job - 18; src = p.odd_w_ri + n * 16384; K = 128; N = 128; dst = p.Wr + (10 + n) * 16384; Nd = 128; }
        transpose_job(src, K, N, dst, Nd, mapped, tileS, base, b0);
    }
}
__device__ __forceinline__ void phase_prep(PRef p, char* smem) {
    weight_jobs(p, smem, true, 0);
    convert_job(p.peer_sub_keys, p.Keys, (size_t)2 * 8 * 2 * 128 * 128);
    convert_job(p.even_cmp_pos, p.Pos16, 2048);
    const int lane = tidx_() & 63, wv = bidx_() * 4 + widx_(), nwv = GRIDV * 4;
    for (int row = wv; row < TOK; row += nwv) {
        float v[16]; load_row16(p.x + (size_t)row * DM, v, lane);
        rms_write_h16(v, p.even_norm_g, p.HN + (size_t)row * DM, lane);
    }
}

enum { EPI_EVEN_IN = 0, EPI_F32_RESID = 1, EPI_H16 = 2, EPI_F32T = 3, EPI_QSCORE = 4 };
struct GemmArgs {
    const h16* A; int lda; const h16* Bt; int ldb; int M, N, K; int a_ntile_stride;
    int mode; h16* c16; int ldc16; float* c32; int ldc32; const float* resid; const h16* aux;
};
template <int MODE, int LDC>
__device__ __forceinline__ void gemm_epilogue(PRef p, const GemmArgs& g, int mt, int nt, bool sw, const f32x4 (&acc)[4][4]) {
    const int lane = tidx_() & 63, wid = widx_(), wm = wid >> 1, wn = wid & 1;
    const int l4 = (lane >> 4) * 4, l15 = lane & 15;
    if (MODE == EPI_EVEN_IN) {
        int kind;
        if (nt < 4 || (nt >= 12 && nt < 16)) kind = 0; else if (nt >= 8 && nt < 12) kind = 2; else if (nt == 19) kind = 3; else if (nt == 21) kind = 4; else if (nt == 22) kind = 5; else kind = 1;
#pragma unroll
        for (int i = 0; i < 4; ++i)
#pragma unroll
            for (int j = 0; j < 4; ++j) {
                const f32x4 v = acc[i][j];
                if (kind <= 1) {
                    const int row = mt * 128 + wm * 64 + j * 16 + l15, col = nt * 128 + wn * 64 + i * 16 + l4;
                    const float sc = kind == 0 ? QSCALE : 1.0f;
                    half4 o; o[0] = (h16)(v[0] * sc); o[1] = (h16)(v[1] * sc); o[2] = (h16)(v[2] * sc); o[3] = (h16)(v[3] * sc);
                    *(half4*)(p.Z + (size_t)row * ZLD + col) = o;
                } else if (kind <= 4) {
                    const int row = mt * 128 + wm * 64 + i * 16 + l4, col = nt * 128 + wn * 64 + j * 16 + l15;
                    const int b = row >> 12, s = row & 4095;
                    half4 o; o[0] = (h16)v[0]; o[1] = (h16)v[1]; o[2] = (h16)v[2]; o[3] = (h16)v[3];
                    h16* dst;
                    if (kind == 2) { const int c = col - 1024; dst = p.VtF + ((size_t)(b * 8 + (c >> 6)) * 64 + (c & 63)) * SEQ + s; }
                    else if (kind == 3) { const int c = col - 2432; dst = p.VtS + ((size_t)(b * 2 + (c >> 6)) * 64 + (c & 63)) * SEQ + s; }
                    else { const int c = col - 2688; dst = p.VtW + ((size_t)(b * 2 + (c >> 6)) * 64 + (c & 63)) * SEQ + s; }
                    *(half4*)dst = o;
                } else {
                    const int row = mt * 128 + wm * 64 + j * 16 + l15, c = nt * 128 + wn * 64 + i * 16 + l4 - 2816;
                    if (c < 32) {
                        f32x4 o;
                        if (c < 8) {
#pragma unroll
                            for (int q = 0; q < 4; ++q) o[q] = log_sigmoid(v[q] + p.even_b_f[c + q]) * LOG2E;
                        } else {
#pragma unroll
                            for (int q = 0; q < 4; ++q) o[q] = sigmoidf_(v[q]);
                        }
                        *(f32x4*)(p.FG + (size_t)row * 32 + c) = o;
                    }
                }
            }
    } else {
#pragma unroll
        for (int i = 0; i < 4; ++i)
#pragma unroll
            for (int j = 0; j < 4; ++j) {
                const f32x4 v = acc[i][j];
                if (MODE == EPI_F32T) {
                    const int row = mt * 128 + wm * 64 + i * 16 + l4, col = nt * 128 + wn * 64 + j * 16 + l15;
                    *(f32x4*)(g.c32 + (size_t)col * TOK + row) = v;
                } else {
                    const int row = mt * 128 + wm * 64 + j * 16 + l15, col = nt * 128 + wn * 64 + i * 16 + l4;
                    if (MODE == EPI_F32_RESID) {
                        const f32x4 r = *(const f32x4*)(g.resid + (size_t)row * LDC + col);
                        *(f32x4*)(g.c32 + (size_t)row * LDC + col) = r + v;
                    } else {
                        half4 o; o[0] = (h16)v[0]; o[1] = (h16)v[1]; o[2] = (h16)v[2]; o[3] = (h16)v[3];
                        *(half4*)(g.c16 + (size_t)row * LDC + col) = o;
                    }
                }
            }
    }
}

template <int MODE, int LDA, int LDB, int GN, int GK, int LDC, int ANS>
__device__ __forceinline__ void phase_gemm(PRef p, const GemmArgs& g, char* smem) {
    h16* As = (h16*)smem;
    h16* Bs = As + 2 * 128 * 64;
    const int tid = tidx_(), lane = tid & 63, wid = widx_(), wm = wid >> 1, wn = wid & 1;
    constexpr int nM = TOK / 128, nN = GN / 128, ntiles = nM * nN, nk = GK / 64;
    const int lr = tid >> 3, lc = tid & 7;
    const int st_off = lr * 64 + ((lc ^ ((tid >> 4) & 7)) * 8);
    const int fsw = (lane & 15) >> 1;
    const int fo0 = (lane & 15) * 64 + ((((lane >> 4)) ^ fsw) * 8), fo1 = (lane & 15) * 64 + (((4 + (lane >> 4)) ^ fsw) * 8);
    for (int tile = bidx_(); tile < ntiles; tile += GRIDV) {
        const int mt = tile / nN, nt = tile % nN;
        bool sw = (MODE != EPI_F32T);
        if (MODE == EPI_EVEN_IN) sw = !((nt >= 8 && nt < 12) || nt == 19 || nt == 21);
        const h16* Ag = g.A + (size_t)(mt * 128 + lr) * LDA + (size_t)nt * ANS + lc * 8;
        const h16* Bg = g.Bt + (size_t)(nt * 128 + lr) * LDB + lc * 8;
        constexpr size_t a32 = (size_t)32 * LDA, b32 = (size_t)32 * LDB;
        f32x4 acc[4][4];
#pragma unroll
        for (int m = 0; m < 4; ++m)
#pragma unroll
            for (int n = 0; n < 4; ++n) acc[m][n] = (f32x4){0.f, 0.f, 0.f, 0.f};
        half8 ra[4], rb[4];
#pragma unroll
        for (int i = 0; i < 4; ++i) { ra[i] = *(const half8*)(Ag + i * a32); rb[i] = *(const half8*)(Bg + i * b32); }
#pragma unroll
        for (int i = 0; i < 4; ++i) { *(half8*)(As + st_off + i * 32 * 64) = ra[i]; *(half8*)(Bs + st_off + i * 32 * 64) = rb[i]; }
        hsync();
        const int pofs = (sw ? wn : wm) * 64 * 64, qofs = (sw ? wm : wn) * 64 * 64;
        for (int kt = 0; kt < nk; ++kt) {
            const int cur = kt & 1;
            if (kt + 1 < nk) {
                const int ko = (kt + 1) * 64;
#pragma unroll
                for (int i = 0; i < 4; ++i) { ra[i] = *(const half8*)(Ag + i * a32 + ko); rb[i] = *(const half8*)(Bg + i * b32 + ko); }
            }
            const h16* Pc = (sw ? Bs : As) + cur * 128 * 64 + pofs;
            const h16* Qc = (sw ? As : Bs) + cur * 128 * 64 + qofs;
#pragma unroll
            for (int ks = 0; ks < 2; ++ks) {
                const int fo = ks ? fo1 : fo0;
                half8 pf[4], qf[4];
#pragma unroll
                for (int i = 0; i < 4; ++i) { pf[i] = *(const half8*)(Pc + i * 16 * 64 + fo); qf[i] = *(const half8*)(Qc + i * 16 * 64 + fo); }
                __builtin_amdgcn_s_setprio(1);
#pragma unroll
                for (int i = 0; i < 4; ++i)
#pragma unroll
                    for (int j = 0; j < 4; ++j) acc[i][j] = __builtin_amdgcn_mfma_f32_16x16x32_f16(pf[i], qf[j], acc[i][j], 0, 0, 0);
                __builtin_amdgcn_s_setprio(0);
            }
            if (kt + 1 < nk) {
                const int nx = (cur ^ 1) * 128 * 64;
#pragma unroll
                for (int i = 0; i < 4; ++i) { *(half8*)(As + nx + st_off + i * 32 * 64) = ra[i]; *(half8*)(Bs + nx + st_off + i * 32 * 64) = rb[i]; }
            }
            hsync();
        }
        if (MODE == EPI_QSCORE) {
            constexpr int QST = 136;
            h16* Qs = (h16*)smem;
            const int l4 = (lane >> 4) * 4, l15 = lane & 15;
#pragma unroll
            for (int i = 0; i < 4; ++i)
#pragma unroll
                for (int j = 0; j < 4; ++j) {
                    const f32x4 v = acc[i][j];
                    half4 o; o[0] = (h16)v[0]; o[1] = (h16)v[1]; o[2] = (h16)v[2]; o[3] = (h16)v[3];
                    *(half4*)(Qs + (wm * 64 + j * 16 + l15) * QST + wn * 64 + i * 16 + l4) = o;
                }
            hsync();
            f32x4 sc[4][4];
#pragma unroll
            for (int i = 0; i < 4; ++i)
#pragma unroll
                for (int j = 0; j < 4; ++j) sc[i][j] = (f32x4){0.f, 0.f, 0.f, 0.f};
            const h16* kb = g.aux + (size_t)(nt * 128 + wn * 64 + l15) * 128 + (lane >> 4) * 8;
#pragma unroll
            for (int ks = 0; ks < 4; ++ks) {
                half8 pf[4], qf[4];
#pragma unroll
                for (int i = 0; i < 4; ++i) { pf[i] = *(const half8*)(Qs + (wm * 64 + i * 16 + l15) * QST + ks * 32 + (lane >> 4) * 8); qf[i] = *(const half8*)(kb + (size_t)i * 16 * 128 + ks * 32); }
#pragma unroll
                for (int i = 0; i < 4; ++i)
#pragma unroll
                    for (int j = 0; j < 4; ++j) sc[i][j] = __builtin_amdgcn_mfma_f32_16x16x32_f16(pf[i], qf[j], sc[i][j], 0, 0, 0);
            }
#pragma unroll
            for (int i = 0; i < 4; ++i)
#pragma unroll
                for (int j = 0; j < 4; ++j) {
                    const int row = mt * 128 + wm * 64 + i * 16 + l4, col = nt * 128 + wn * 64 + j * 16 + l15;
                    *(f32x4*)(g.c32 + (size_t)col * TOK + row) = sc[i][j];
                }
            hsync();
        } else
        gemm_epilogue<MODE, LDC>(p, g, mt, nt, sw, acc);
    }
}

__device__ __forceinline__ void wp_job(PRef p, int wv0) {
    const int lane = tidx_() & 63, wv = bidx_() * 4 + widx_() - wv0, nwv = GRIDV * 4 - wv0;
    if (wv < 0) return;
    for (int u = wv; u < 1024; u += nwv) {
        const int l = u >> 9, hc = (u >> 5) & 15, kh = (u >> 4) & 1, jt = u & 15;
        const float* wq = p.peer_w_q + (size_t)l * 1024 * 2048 + (size_t)(jt * 64 + (lane & 15)) * 2048 + hc * 128 + (lane >> 4) * 8;
        const h16* ky = p.Keys + ((size_t)(l * 16 + hc) * 128 + kh * 64 + (lane & 15)) * 128 + (lane >> 4) * 8;
        f32x4 acc[4][4];
#pragma unroll
        for (int a = 0; a < 4; ++a)
#pragma unroll
            for (int b = 0; b < 4; ++b) acc[a][b] = (f32x4){0.f, 0.f, 0.f, 0.f};
#pragma unroll
        for (int ks = 0; ks < 4; ++ks) {
            half8 af[4], bf[4];
#pragma unroll
            for (int a = 0; a < 4; ++a) {
                const f32x4 w0 = *(const f32x4*)(wq + (size_t)a * 16 * 2048 + ks * 32), w1 = *(const f32x4*)(wq + (size_t)a * 16 * 2048 + ks * 32 + 4);
#pragma unroll
                for (int q = 0; q < 4; ++q) { af[a][q] = (h16)w0[q]; af[a][4 + q] = (h16)w1[q]; }
                bf[a] = *(const half8*)(ky + (size_t)a * 16 * 128 + ks * 32);
            }
#pragma unroll
            for (int a = 0; a < 4; ++a)
#pragma unroll
                for (int b = 0; b < 4; ++b) acc[a][b] = __builtin_amdgcn_mfma_f32_16x16x32_f16(af[a], bf[b], acc[a][b], 0, 0, 0);
        }
        h16* wp = p.WtQ + (size_t)l * 2048 * 1024;
#pragma unroll
        for (int a = 0; a < 4; ++a)
#pragma unroll
            for (int b = 0; b < 4; ++b) {
                const int n = hc * 128 + kh * 64 + b * 16 + (lane & 15), j0 = jt * 64 + a * 16 + (lane >> 4) * 4;
                half4 o; o[0] = (h16)acc[a][b][0]; o[1] = (h16)acc[a][b][1]; o[2] = (h16)acc[a][b][2]; o[3] = (h16)acc[a][b][3];
                *(half4*)(wp + (size_t)n * 1024 + j0) = o;
            }
    }
}
__device__ __forceinline__ void phase_cumsum_compress(PRef p, char* smem) {
    const int lane = tidx_() & 63, wid = widx_(), vb = bidx_();
    if (vb >= 256 && vb < 264) {
        const int u = (vb - 256) * 4 + wid, b = u >> 3, h = u & 7;
        const float* src = p.FG + (size_t)(b * SEQ + lane * 64) * 32 + h;
        float loc[64]; float run = 0.f;
#pragma unroll
        for (int i = 0; i < 64; ++i) { run += src[(size_t)i * 32]; loc[i] = run; }
        float incl = run;
#pragma unroll
        for (int o = 1; o < 64; o <<= 1) { const float t = __shfl_up(incl, o); if (lane >= o) incl += t; }
        const float excl = incl - run;
        float* dst = p.C2 + (size_t)(b * 8 + h) * SEQ + lane * 64;
#pragma unroll
        for (int i = 0; i < 64; ++i) dst[i] = excl + loc[i];
    }
    if (vb < 256) {
        const int cu = vb, kv = cu >> 7, bg = (cu >> 4) & 7, nt = cu & 15;
        const int b = bg >> 1, g = bg & 1;
        int n = nt * 16 + (lane & 15); const int nc = n < 255 ? n : 254;
        const h16* Ab = p.Z + (size_t)(b * SEQ + 16 * nc) * ZLD + 1536 + kv * 128 + g * 64 + (lane >> 4) * 8;
        const h16* Wb = p.Wc + (size_t)kv * 64 * 2048 + (size_t)(lane & 15) * 2048 + (lane >> 4) * 8;
        const h16* Pb = p.Pos16 + (lane >> 4) * 8;
        f32x4 acc[4];
#pragma unroll
        for (int e = 0; e < 4; ++e) acc[e] = (f32x4){0.f, 0.f, 0.f, 0.f};
#pragma unroll
        for (int k2 = 0; k2 < 16; ++k2) {
            const int ks = wid * 16 + k2, l = ks >> 1, d0 = (ks & 1) * 32;
            half8 a = *(const half8*)(Ab + (size_t)l * ZLD + d0);
            const half8 ps = *(const half8*)(Pb + ks * 32);
            a = a + ps;
#pragma unroll
            for (int e = 0; e < 4; ++e) {
                const half8 w = *(const half8*)(Wb + (size_t)e * 16 * 2048 + ks * 32);
                acc[e] = __builtin_amdgcn_mfma_f32_16x16x32_f16(a, w, acc[e], 0, 0, 0);
            }
        }
        f32x4* part = (f32x4*)smem;
#pragma unroll
        for (int e = 0; e < 4; ++e) part[(wid * 4 + e) * 64 + lane] = acc[e];
        hsync();
        {
            const int e = wid;
            const f32x4 s = (part[(0 * 4 + e) * 64 + lane] + part[(1 * 4 + e) * 64 + lane]) + (part[(2 * 4 + e) * 64 + lane] + part[(3 * 4 + e) * 64 + lane]);
            const int n0 = nt * 16 + (lane >> 4) * 4, ec = e * 16 + (lane & 15);
            if (kv == 0) {
#pragma unroll
                for (int j = 0; j < 4; ++j) p.KC[((size_t)bg * 256 + n0 + j) * 64 + ec] = (n0 + j < 255) ? (h16)s[j] : (h16)0.f;
            } else {
                half4 o;
#pragma unroll
                for (int j = 0; j < 4; ++j) o[j] = (n0 + j < 255) ? (h16)s[j] : (h16)0.f;
                *(half4*)(p.VCt + ((size_t)bg * 64 + ec) * 256 + n0) = o;
            }
        }
        hsync();
    }
    weight_jobs(p, smem, false, 0);
    wp_job(p, 0);
    fp6_rows_job(p.peer_u, p.U8, p.US, 8192, 0);
    fp6_rows_job(p.peer_v, p.V8, p.VS, 8192, 0);
}

struct RowState { float m, l; f32x16 o0, o1; };
__device__ __forceinline__ void rs_reset(RowState& s) { s.m = NEGBIG; s.l = 0.f; s.o0 = zero16(); s.o1 = zero16(); }

__device__ __forceinline__ void kv_load(const h16* kb, int kst, const h16* vb, int vst, half8 (&kr)[2], half8 (&vr)[2]) {
    const int tid = tidx_();
#pragma unroll
    for (int i = 0; i < 2; ++i) {
        const int c = tid + 256 * i, row = c >> 3, cc = (c & 7) * 8;
        kr[i] = *(const half8*)(kb + (size_t)row * kst + cc);
        vr[i] = *(const half8*)(vb + (size_t)row * vst + cc);
    }
}
__device__ __forceinline__ void kv_store(h16* Ks, h16* Vs, const half8 (&kr)[2], const half8 (&vr)[2]) {
    const int tid = tidx_();
#pragma unroll
    for (int i = 0; i < 2; ++i) {
        const int c = tid + 256 * i, row = c >> 3, cc = (c & 7) * 8;
        *(half8*)(Ks + row * KST + cc) = kr[i];
        *(half8*)(Vs + row * KST + cc) = vr[i];
    }
}
__device__ __forceinline__ void qk_tile(const h16* Ks, const half8 (&qf)[4], f32x16 (&s)[2], int lane) {
    const int r32 = lane & 31, hh = lane >> 5;
#pragma unroll
    for (int kt = 0; kt < 2; ++kt) {
        s[kt] = zero16();
#pragma unroll
        for (int ks = 0; ks < 4; ++ks) {
            const half8 kf = *(const half8*)(Ks + (kt * 32 + r32) * KST + ks * 16 + hh * 8);
            s[kt] = __builtin_amdgcn_mfma_f32_32x32x16_f16(kf, qf[ks], s[kt], 0, 0, 0);
        }
    }
}
__device__ __forceinline__ void pv_tile(const h16* Vs, const f32x16 (&pr)[2], f32x16& o0, f32x16& o1, int lane) {
    const int r32 = lane & 31, hh = lane >> 5;
#pragma unroll
    for (int kt = 0; kt < 2; ++kt)
#pragma unroll
        for (int s2 = 0; s2 < 2; ++s2) {
            half8 pf;
#pragma unroll
            for (int j = 0; j < 8; ++j) pf[j] = (h16)pr[kt][8 * s2 + j];
            const int kof = kt * 32 + 16 * s2 + 4 * hh;
            {
                const half4 a = *(const half4*)(Vs + r32 * KST + kof), b = *(const half4*)(Vs + r32 * KST + kof + 8);
                half8 vf; vf[0] = a[0]; vf[1] = a[1]; vf[2] = a[2]; vf[3] = a[3]; vf[4] = b[0]; vf[5] = b[1]; vf[6] = b[2]; vf[7] = b[3];
                o0 = __builtin_amdgcn_mfma_f32_32x32x16_f16(vf, pf, o0, 0, 0, 0);
            }
            {
                const half4 a = *(const half4*)(Vs + (32 + r32) * KST + kof), b = *(const half4*)(Vs + (32 + r32) * KST + kof + 8);
                half8 vf; vf[0] = a[0]; vf[1] = a[1]; vf[2] = a[2]; vf[3] = a[3]; vf[4] = b[0]; vf[5] = b[1]; vf[6] = b[2]; vf[7] = b[3];
                o1 = __builtin_amdgcn_mfma_f32_32x32x16_f16(vf, pf, o1, 0, 0, 0);
            }
        }
}

enum { M_FOX = 0, M_SLC = 1, M_WIN = 2 };
template <int MODE, bool MASKED>
__device__ __forceinline__ void flash_step(const h16* Ks, const h16* Vs, const float* csS, const half8 (&qf)[4], RowState& st,
                                           int t, int kpos0, float slope2, float ct2, bool selbit, int lane) {
    const int hh = lane >> 5;
    f32x16 s[2];
    qk_tile(Ks, qf, s, lane);
    int dbase = t - kpos0 - 4 * hh;
    asm volatile("" : "+v"(dbase));
    const float off = (MODE == M_FOX) ? ct2 : -slope2 * (float)dbase;
    float mx = NEGBIG;
#pragma unroll
    for (int kt = 0; kt < 2; ++kt)
#pragma unroll
        for (int r = 0; r < 16; ++r) {
            const int c = kt * 32 + (r & 3) + 8 * (r >> 2);
            float v;
            if (MODE == M_FOX) v = s[kt][r] - csS[c + 4 * hh];
            else v = fmaf(slope2, (float)c, s[kt][r]);
            if (MASKED) {
                const int dist = dbase - c;
                bool valid;
                if (MODE == M_FOX) valid = dist >= 0; else if (MODE == M_SLC) valid = selbit && dist >= 0; else valid = dist >= 0 && dist < 512;
                v = valid ? v : NEGBIG;
            }
            s[kt][r] = v;
            mx = fmaxf(mx, v);
        }
    mx += off;
    mx = fmaxf(mx, __shfl_xor(mx, 32));
    const float mn = fmaxf(st.m, mx);
    const float alpha = __builtin_amdgcn_exp2f(st.m - mn);
    st.m = mn;
    const float moff = mn - off;
    float ps = 0.f;
#pragma unroll
    for (int kt = 0; kt < 2; ++kt)
#pragma unroll
        for (int r = 0; r < 16; ++r) {
            const float v = s[kt][r];
            float pe = __builtin_amdgcn_exp2f(v - moff);
            if (MASKED) pe = v > -1.0e29f ? pe : 0.f;
            s[kt][r] = pe; ps += pe;
        }
    st.l = st.l * alpha + ps;
#pragma unroll
    for (int r = 0; r < 16; ++r) { st.o0[r] *= alpha; st.o1[r] *= alpha; }
    pv_tile(Vs, s, st.o0, st.o1, lane);
}

template <int MODE>
__device__ __forceinline__ void run_flash(u64 mask, const h16* Kg, int kst, const h16* Vg, int vst, const float* csg, char* smem,
                                          const half8 (&qf)[4], RowState& st, int t, int twlo, int twhi, float slope2, float ct2, u64 sel, int lane) {
    h16* Kb = (h16*)smem; h16* Vb = Kb + 2 * 64 * KST; float* csb = (float*)(Vb + 2 * 64 * KST);
    if (mask == 0ull) return;
    half8 kr[2], vr[2]; float csr = 0.f;
    int jc = __builtin_ctzll(mask); mask &= mask - 1;
    kv_load(Kg + (size_t)jc * 64 * kst, kst, Vg + jc * 64, vst, kr, vr);
    if (MODE == M_FOX && tidx_() < 64) csr = csg[jc * 64 + tidx_()];
    kv_store(Kb, Vb, kr, vr);
    if (MODE == M_FOX && tidx_() < 64) csb[tidx_()] = csr;
    hsync();
    int buf = 0;
    for (;;) {
        int jn = -1;
        if (mask) { jn = __builtin_ctzll(mask); mask &= mask - 1; }
        if (jn >= 0) {
            kv_load(Kg + (size_t)jn * 64 * kst, kst, Vg + jn * 64, vst, kr, vr);
            if (MODE == M_FOX && tidx_() < 64) csr = csg[jn * 64 + tidx_()];
        }
        bool need = jc * 64 <= twhi;
        if (MODE == M_WIN) need = need && (jc * 64 + 63 >= twlo - 511);
        if (need) {
            const bool selbit = (sel >> jc) & 1ull;
            bool full = jc * 64 + 63 <= twlo;
            if (MODE == M_WIN) full = full && (jc * 64 > twhi - 512);
            if (MODE == M_SLC) full = full && (__ballot(selbit) == ~0ull);
            if (full) flash_step<MODE, false>(Kb + buf * 64 * KST, Vb + buf * 64 * KST, csb + buf * 64, qf, st, t, jc * 64, slope2, ct2, selbit, lane);
            else flash_step<MODE, true>(Kb + buf * 64 * KST, Vb + buf * 64 * KST, csb + buf * 64, qf, st, t, jc * 64, slope2, ct2, selbit, lane);
        }
        if (jn >= 0) {
            kv_store(Kb + (buf ^ 1) * 64 * KST, Vb + (buf ^ 1) * 64 * KST, kr, vr);
            if (MODE == M_FOX && tidx_() < 64) csb[(buf ^ 1) * 64 + tidx_()] = csr;
        }
        hsync();
        if (jn < 0) break;
        jc = jn; buf ^= 1;
    }
}

__device__ __forceinline__ void load_q(const h16* qrow, half8 (&qf)[4], int lane) {
#pragma unroll
    for (int ks = 0; ks < 4; ++ks) qf[ks] = *(const half8*)(qrow + ks * 16 + (lane >> 5) * 8);
}
__device__ __forceinline__ void store_o(h16* orow, const f32x16& o0, const f32x16& o1, int lane) {
    const int hh = lane >> 5;
#pragma unroll
    for (int rg = 0; rg < 4; ++rg) {
        half4 a, b;
#pragma unroll
        for (int j = 0; j < 4; ++j) { a[j] = (h16)o0[4 * rg + j]; b[j] = (h16)o1[4 * rg + j]; }
        *(half4*)(orow + 8 * rg + 4 * hh) = a;
        *(half4*)(orow + 32 + 8 * rg + 4 * hh) = b;
    }
}

__device__ __forceinline__ void oacc_store(float* row, const f32x16& o0, const f32x16& o1, float sc, int lane) {
    const int hh = lane >> 5;
#pragma unroll
    for (int rg = 0; rg < 4; ++rg) {
        *(f32x4*)(row + 8 * rg + 4 * hh) = (f32x4){o0[4 * rg] * sc, o0[4 * rg + 1] * sc, o0[4 * rg + 2] * sc, o0[4 * rg + 3] * sc};
        *(f32x4*)(row + 32 + 8 * rg + 4 * hh) = (f32x4){o1[4 * rg] * sc, o1[4 * rg + 1] * sc, o1[4 * rg + 2] * sc, o1[4 * rg + 3] * sc};
    }
}
__device__ __forceinline__ void oacc_add(float* row, const f32x16& o0, const f32x16& o1, float sc, int lane) {
    const int hh = lane >> 5;
#pragma unroll
    for (int rg = 0; rg < 4; ++rg) {
        f32x4 a = *(const f32x4*)(row + 8 * rg + 4 * hh), b = *(const f32x4*)(row + 32 + 8 * rg + 4 * hh);
#pragma unroll
        for (int j = 0; j < 4; ++j) { a[j] += o0[4 * rg + j] * sc; b[j] += o1[4 * rg + j] * sc; }
        *(f32x4*)(row + 8 * rg + 4 * hh) = a; *(f32x4*)(row + 32 + 8 * rg + 4 * hh) = b;
    }
}
__device__ __forceinline__ void oacc_final(const float* row, h16* orow, const f32x16& o0, const f32x16& o1, float sc, int lane) {
    const int hh = lane >> 5;
#pragma unroll
    for (int rg = 0; rg < 4; ++rg) {
        const f32x4 a = *(const f32x4*)(row + 8 * rg + 4 * hh), b = *(const f32x4*)(row + 32 + 8 * rg + 4 * hh);
        half4 x, y;
#pragma unroll
        for (int j = 0; j < 4; ++j) { x[j] = (h16)(a[j] + o0[4 * rg + j] * sc); y[j] = (h16)(b[j] + o1[4 * rg + j] * sc); }
        *(half4*)(orow + 8 * rg + 4 * hh) = x; *(half4*)(orow + 32 + 8 * rg + 4 * hh) = y;
    }
}

__device__ __forceinline__ void fox_unit(PRef p, int b, int h, int qt, char* smem) {
    const int tid = tidx_(), lane = tid & 63, wid = widx_();
    const int q0 = qt * 128, t0w = q0 + wid * 32, t = t0w + (lane & 31);
    half8 qf[4]; load_q(p.Z + (size_t)(b * SEQ + t) * ZLD + h * 64, qf, lane);
    const float* csg = p.C2 + (size_t)(b * 8 + h) * SEQ;
    const float ct2 = csg[t];
    RowState st; rs_reset(st);
    const int jmax = (q0 + 127) >> 6;
    const u64 mask = (jmax >= 63) ? ~0ull : ((1ull << (jmax + 1)) - 1ull);
    run_flash<M_FOX>(mask, p.Z + (size_t)b * SEQ * ZLD + 512 + h * 64, ZLD, p.VtF + (size_t)(b * 8 + h) * 64 * SEQ, SEQ, csg, smem,
                     qf, st, t, t0w, t0w + 31, 0.f, ct2, 0ull, lane);
    const float lt = st.l + __shfl_xor(st.l, 32);
    const float inv = 1.0f / lt;
#pragma unroll
    for (int r = 0; r < 16; ++r) { st.o0[r] *= inv; st.o1[r] *= inv; }
    store_o(p.O + (size_t)(b * SEQ + t) * DM + h * 64, st.o0, st.o1, lane);
}

__device__ __forceinline__ void nsa_unit(PRef p, int b, int g, int qt32, char* smem) {
    const int tid = tidx_(), lane = tid & 63, wid = widx_(), hh = lane >> 5, r32 = lane & 31;
    const int t0 = qt32 * 32, t = t0 + r32, head = g * 4 + wid, bg = b * 2 + g;
    const float slope2 = exp2f(-(float)(head + 1)) * LOG2E;
    half8 qf[4]; load_q(p.Z + (size_t)(b * SEQ + t) * ZLD + 1024 + head * 64, qf, lane);
    const float* gp = p.FG + (size_t)(b * SEQ + t) * 32 + 8 + head * 3;
    const float gate_c = gp[0], gate_s = gp[1], gate_w = gp[2];
    h16* Kb = (h16*)smem; h16* Vb = Kb + 2 * 64 * KST;
    u64* selS = (u64*)(smem + 37376);
    u64* unS = selS + 32;
    float* oaccrow = p.OACC + (size_t)(b * SEQ + t) * 512 + head * 64;
    unsigned* impS = (unsigned*)(smem + 37888);
    {
        for (int i = tid; i < 32 * 64; i += NTHR) impS[i] = 0u;
        const int nsteps = ((t0 >> 4) >> 6) + 1;
        const h16* Kg = p.KC + (size_t)bg * 256 * 64; const h16* Vg = p.VCt + (size_t)bg * 64 * 256;
        float mrun = NEGBIG, lrun = 0.f;
        for (int i = 0; i < nsteps; ++i) {
            half8 kr[2], vr[2];
            kv_load(Kg + (size_t)i * 64 * 64, 64, Vg + i * 64, 256, kr, vr);
            kv_store(Kb, Vb, kr, vr);
            hsync();
            f32x16 s[2];
            qk_tile(Kb, qf, s, lane);
            float mx = NEGBIG;
            int dbase = t - 31 - 16 * (i * 64 + 4 * hh);
            asm volatile("" : "+v"(dbase));
#pragma unroll
            for (int kt = 0; kt < 2; ++kt)
#pragma unroll
                for (int r = 0; r < 16; ++r) {
                    const int dist = dbase - 16 * (kt * 32 + (r & 3) + 8 * (r >> 2));
                    float v = s[kt][r] - slope2 * (float)dist;
                    v = dist >= 0 ? v : NEGBIG;
                    s[kt][r] = v; mx = fmaxf(mx, v);
                }
            mx = fmaxf(mx, __shfl_xor(mx, 32));
            const float mn = fmaxf(mrun, mx), alpha = __builtin_amdgcn_exp2f(mrun - mn);
            mrun = mn;
            float ps = 0.f;
#pragma unroll
            for (int kt = 0; kt < 2; ++kt)
#pragma unroll
                for (int r = 0; r < 16; ++r) { const float v = s[kt][r]; ps += v > -1.0e29f ? __builtin_amdgcn_exp2f(v - mn) : 0.f; }
            lrun = lrun * alpha + ps;
            hsync();
        }
        const float lt = lrun + __shfl_xor(lrun, 32);
        const float inv = lt > 0.f ? 1.0f / lt : 0.f;
        f32x16 o0 = zero16(), o1 = zero16();
        float carry = 0.f;
        for (int i = 0; i < nsteps; ++i) {
            half8 kr[2], vr[2];
            kv_load(Kg + (size_t)i * 64 * 64, 64, Vg + i * 64, 256, kr, vr);
            kv_store(Kb, Vb, kr, vr);
            hsync();
            f32x16 s[2];
            qk_tile(Kb, qf, s, lane);
            int dbase = t - 31 - 16 * (i * 64 + 4 * hh);
            asm volatile("" : "+v"(dbase));
#pragma unroll
            for (int kt = 0; kt < 2; ++kt)
#pragma unroll
                for (int r = 0; r < 16; ++r) {
                    const int dist = dbase - 16 * (kt * 32 + (r & 3) + 8 * (r >> 2));
                    const float v = s[kt][r] - slope2 * (float)dist;
                    s[kt][r] = dist >= 0 ? __builtin_amdgcn_exp2f(v - mrun) * inv : 0.f;
                }
            float R[2][4];
#pragma unroll
            for (int kt = 0; kt < 2; ++kt)
#pragma unroll
                for (int rg = 0; rg < 4; ++rg) R[kt][rg] = __shfl_xor(s[kt][4 * rg + 3], 32);
#pragma unroll
            for (int kt = 0; kt < 2; ++kt)
#pragma unroll
                for (int rg = 0; rg < 4; ++rg) {
                    const float G = (s[kt][4 * rg] + s[kt][4 * rg + 1]) + (s[kt][4 * rg + 2] + s[kt][4 * rg + 3]);
                    const float prev = (kt == 0 && rg == 0) ? carry : (rg > 0 ? R[kt][rg - 1] : R[kt - 1][3]);
                    const float val = G + (hh ? R[kt][rg] : prev);
                    const int j = 16 * i + 8 * kt + 2 * rg + hh;
                    atomicAdd(&impS[r32 * 64 + j], (unsigned)(val * 67108864.0f + 0.5f));
                }
            carry = R[1][3];
            pv_tile(Vb, s, o0, o1, lane);
            hsync();
        }
        oacc_store(oaccrow, o0, o1, gate_c, lane);
    }
    hsync();
    {
        u64 un = 0ull;
        for (int i = 0; i < 8; ++i) {
            const int tok = wid * 8 + i, tt = t0 + tok, cur = tt >> 6;
            const int j = lane;
            const bool valid = j <= cur;
            const bool forced = (j == 0) || (j == cur) || (j == cur - 1);
            const unsigned key = valid ? impS[tok * 64 + j] + (forced ? 0x40000000u : 0u) : 0u;
            int rank = 0;
            for (int jj = 0; jj < 64; ++jj) {
                const unsigned kv = (unsigned)__builtin_amdgcn_readlane((int)key, jj);
                rank += (kv > key || (kv == key && jj < j)) ? 1 : 0;
            }
            const u64 selm = __ballot(valid && rank < 16);
            if (lane == 0) selS[tok] = selm;
            un |= selm;
        }
        if (lane == 0) unS[wid] = un;
    }
    hsync();
    const u64 mysel = selS[r32];
    const u64 un = unS[0] | unS[1] | unS[2] | unS[3];
    hsync();
    {
        RowState st; rs_reset(st);
        run_flash<M_SLC>(un, p.Z + (size_t)b * SEQ * ZLD + 1792 + g * 64, ZLD, p.VtS + (size_t)bg * 64 * SEQ, SEQ, nullptr, smem,
                         qf, st, t, t0, t0 + 31, slope2, 0.f, mysel, lane);
        const float lt = st.l + __shfl_xor(st.l, 32);
        oacc_add(oaccrow, st.o0, st.o1, gate_s / lt, lane);
    }
    {
        RowState st; rs_reset(st);
        const int lo = t0 - 511, jlo = lo > 0 ? (lo >> 6) : 0, jhi = (t0 + 31) >> 6;
        u64 mask = (jhi >= 63 ? ~0ull : ((1ull << (jhi + 1)) - 1ull)) & ~((1ull << jlo) - 1ull);
        run_flash<M_WIN>(mask, p.Z + (size_t)b * SEQ * ZLD + 1920 + g * 64, ZLD, p.VtW + (size_t)bg * 64 * SEQ, SEQ, nullptr, smem,
                         qf, st, t, t0, t0 + 31, slope2, 0.f, 0ull, lane);
        const float lt = st.l + __shfl_xor(st.l, 32);
        oacc_final(oaccrow, p.O + (size_t)(b * SEQ + t) * DM + 512 + head * 64, st.o0, st.o1, gate_w / lt, lane);
    }
}

__device__ __forceinline__ void phase_attention(PRef p, char* smem) {
    int* nxt = (int*)(smem + 65536 - 16);
    for (;;) {
        if (tidx_() == 0) *nxt = (int)__hip_atomic_fetch_add(p.BAR + XCD_BAR_WORDS_C, 1u, __ATOMIC_RELAXED, __HIP_MEMORY_SCOPE_AGENT);
        hsync();
        const int q = *nxt;
        hsync();
        if (q >= 2048 + 512) break;
        if (q < 2048 && (q & 3) == 3) {
            const int c = q >> 2, rp0 = (c & 255) * 32 + widx_() * 8, lane = tidx_() & 63;
            const float* srcp = (c < 256 ? p.peer_u : p.peer_v) + (size_t)16384 * 1024;
            unsigned char* dstp = (c < 256 ? p.U8 : p.V8) + (size_t)16384 * 1024;
            float* sclp = (c < 256 ? p.US : p.VS) + 16384;
            for (int i = 0; i < 8; i += 2) { const int rps[2] = {rp0 + i, rp0 + i + 1}; fp6_rows<2>(srcp, dstp, sclp, rps, lane); }
            continue;
        }
        const int u = q < 2048 ? q - ((q + 1) >> 2) : q - 512;
        const int st = 31 - (u >> 6), w = u & 63;
        if (w & 1) { const int idx = w >> 1; nsa_unit(p, (idx & 7) >> 1, idx & 1, st * 4 + (idx >> 3), smem); }
        else { const int idx = w >> 1; fox_unit(p, idx >> 3, idx & 7, st, smem); }
    }
}

__device__ __forceinline__ void phase_rmsnorm(PRef p, const float* g) {
    const int lane = tidx_() & 63, wv = bidx_() * 4 + widx_(), nwv = GRIDV * 4;
    for (int row = wv; row < TOK; row += nwv) {
        float v[16]; load_row16(p.H + (size_t)row * DM, v, lane);
        rms_write_h16(v, g, p.HN + (size_t)row * DM, lane);
    }
}

__device__ __forceinline__ unsigned fkey(float f) { const unsigned b = __float_as_uint(f); return b ^ ((b >> 31) ? 0xFFFFFFFFu : 0x80000000u); }
__device__ __forceinline__ float fkey_inv(unsigned k) { return __uint_as_float(k ^ ((k >> 31) ? 0x80000000u : 0xFFFFFFFFu)); }
__device__ __forceinline__ void ce_desc(unsigned& a, unsigned& b) { const unsigned hi = a > b ? a : b, lo = a > b ? b : a; a = hi; b = lo; }
__device__ __forceinline__ void sort16_desc(unsigned (&k)[16]) {
#pragma unroll
    for (int size = 2; size <= 16; size <<= 1)
#pragma unroll
        for (int stride = size >> 1; stride > 0; stride >>= 1)
#pragma unroll
            for (int i = 0; i < 16; ++i) {
                const int j = i ^ stride;
                if (j > i) { if ((i & size) == 0) ce_desc(k[i], k[j]); else ce_desc(k[j], k[i]); }
            }
}
__device__ __forceinline__ void merge16_desc(unsigned (&run)[16], const unsigned (&b)[16]) {
#pragma unroll
    for (int i = 0; i < 16; ++i) run[i] = run[i] > b[15 - i] ? run[i] : b[15 - i];
#pragma unroll
    for (int stride = 8; stride > 0; stride >>= 1)
#pragma unroll
        for (int i = 0; i < 16; ++i) { const int j = i ^ stride; if (j > i) ce_desc(run[i], run[j]); }
}
__device__ __forceinline__ void list_top16(const h16* __restrict__ base, unsigned (&run)[16]) {
    half8 cur0 = *(const half8*)base, cur1 = *(const half8*)(base + 512), nxt0 = cur0, nxt1 = cur1;
#pragma unroll 1
    for (int bt = 0; bt < 8; ++bt) {
        if (bt < 7) { nxt0 = *(const half8*)(base + (size_t)(2 * bt + 2) * 512); nxt1 = *(const half8*)(base + (size_t)(2 * bt + 3) * 512); }
        unsigned kb[16];
#pragma unroll
        for (int i = 0; i < 8; ++i) {
            kb[i] = (fkey((float)cur0[i]) & ~127u) | (unsigned)(127 - (bt * 16 + i));
            kb[8 + i] = (fkey((float)cur1[i]) & ~127u) | (unsigned)(127 - (bt * 16 + 8 + i));
        }
        sort16_desc(kb);
        if (bt == 0) {
#pragma unroll
            for (int i = 0; i < 16; ++i) run[i] = kb[i];
        } else merge16_desc(run, kb);
        cur0 = nxt0; cur1 = nxt1;
    }
}
__device__ __forceinline__ void phase_peer_topk(PRef p, char* smem) {
    const int tid = tidx_(), lane = tid & 63, wv = bidx_() * 4 + widx_(), nwv = GRIDV * 4;
    int* idS = (int*)smem; float* evS = (float*)smem + 16 * NTHR;
    for (int u = wv; u < 8 * (TOK / 64); u += nwv) {
        const int h = u >> 8, tk = (u & 255) * 64 + lane;
        const h16* b0 = p.SC + ((size_t)((tk >> 6) * 256 + h * 32) * 64 + lane) * 8;
        unsigned k0[16], k1[16];
        list_top16(b0, k0);
        list_top16(b0 + 16 * 512, k1);
        float v0[16], v1[16]; int i0[16], i1[16];
#pragma unroll
        for (int j = 0; j < 16; ++j) {
            v0[j] = fkey_inv(k0[j] & ~127u); i0[j] = 127 - (int)(k0[j] & 127u);
            v1[j] = fkey_inv(k1[j] & ~127u); i1[j] = 127 - (int)(k1[j] & 127u);
        }
        unsigned run[16];
        {
            unsigned kb[16]; int n = 0, nb = 0;
#pragma unroll
            for (int a = 0; a < 16; ++a)
#pragma unroll
                for (int b = 0; b < 16; ++b)
                    if ((a + 1) * (b + 1) <= 16) {
                        kb[n] = fkey(v0[a] + v1[b]); ++n;
                        if (n == 16) {
                            sort16_desc(kb);
                            if (nb == 0) {
#pragma unroll
                                for (int i = 0; i < 16; ++i) run[i] = kb[i];
                            } else merge16_desc(run, kb);
                            n = 0; ++nb;
                        }
                    }
#pragma unroll
            for (int i = 2; i < 16; ++i) kb[i] = 0u;
            sort16_desc(kb); merge16_desc(run, kb);
        }
        const unsigned tkey = run[15]; const float smax = fkey_inv(run[0]);
        int cnt = 0; float esum = 0.f;
#pragma unroll
        for (int j = 0; j < 16; ++j) { idS[j * NTHR + tid] = 0; evS[j * NTHR + tid] = 0.f; }
#pragma unroll
        for (int pass = 0; pass < 2; ++pass)
#pragma unroll
            for (int a = 0; a < 16; ++a)
#pragma unroll
                for (int b = 0; b < 16; ++b)
                    if ((a + 1) * (b + 1) <= 16) {
                        const float s = v0[a] + v1[b]; const unsigned ks = fkey(s);
                        const bool take = pass == 0 ? (ks > tkey) : (ks == tkey && cnt < 16);
                        if (take) {
                            const float e = __expf(s - smax);
                            idS[cnt * NTHR + tid] = i0[a] * 128 + i1[b]; evS[cnt * NTHR + tid] = e;
                            esum += e; ++cnt;
                        }
                    }
        const float rinv = 1.0f / esum;
        int* ip = p.IDS + (size_t)tk * 128 + h * 16; float* gp = p.GW + (size_t)tk * 128 + h * 16;
#pragma unroll
        for (int q = 0; q < 4; ++q) {
            *(i32x4*)(ip + 4 * q) = (i32x4){idS[(4 * q) * NTHR + tid], idS[(4 * q + 1) * NTHR + tid], idS[(4 * q + 2) * NTHR + tid], idS[(4 * q + 3) * NTHR + tid]};
            *(f32x4*)(gp + 4 * q) = (f32x4){evS[(4 * q) * NTHR + tid] * rinv, evS[(4 * q + 1) * NTHR + tid] * rinv, evS[(4 * q + 2) * NTHR + tid] * rinv, evS[(4 * q + 3) * NTHR + tid] * rinv};
        }
    }
}

struct Q6 { i32x4 a; i32x2 b; };
__device__ __forceinline__ Q6 ld6(const unsigned char* row, int g) { Q6 r; r.a = *(const i32x4*)(row + g * 16); r.b = *(const i32x2*)(row + 512 + g * 8); return r; }
__device__ __forceinline__ u32x6 mk6(const Q6 q) { u32x6 r; r[0] = q.a[0]; r[1] = q.a[1]; r[2] = q.a[2]; r[3] = q.a[3]; r[4] = q.b[0]; r[5] = q.b[1]; return r; }
__device__ __forceinline__ float dot32_fp6h(const h16x32 xv, const Q6 q) {
    const h16x32 uf = __builtin_amdgcn_cvt_scalef32_pk32_f16_fp6(mk6(q), 1.0f);
    float d0 = 0.f, d1 = 0.f;
#pragma unroll
    for (int m = 0; m < 16; m += 2) {
        d0 = __builtin_amdgcn_fdot2((half2v){uf[2 * m], uf[2 * m + 1]}, (half2v){xv[2 * m], xv[2 * m + 1]}, d0, false);
        d1 = __builtin_amdgcn_fdot2((half2v){uf[2 * m + 2], uf[2 * m + 3]}, (half2v){xv[2 * m + 2], xv[2 * m + 3]}, d1, false);
    }
    return d0 + d1;
}
__device__ __forceinline__ void axpy32_fp6(f32x2 (&acc)[16], float w, const Q6 q) {
    const f32x32 vf = __builtin_amdgcn_cvt_scalef32_pk32_f32_fp6(mk6(q), 1.0f);
    const f32x2 ww = {w, w};
#pragma unroll
    for (int m = 0; m < 16; ++m) acc[m] = __builtin_elementwise_fma(ww, (f32x2){vf[2 * m], vf[2 * m + 1]}, acc[m]);
}
constexpr int ET_SHIFT = 9, ET_N = 16384 >> ET_SHIFT;
__device__ __forceinline__ void phase_peer_experts(PRef p, int layer, const float* gnext, int mode, char* smem) {
    const int lane = tidx_() & 63, wid = widx_(), wv = bidx_() * 4 + wid, nwv = GRIDV * 4;
    const int hh = lane >> 5, g = lane & 31, dpl = (lane >> 2) & 7;
    const unsigned char* U = p.U8 + (size_t)layer * 16384 * 1024; const unsigned char* V = p.V8 + (size_t)layer * 16384 * 1024;
    const float* US = p.US + layer * 16384; const float* VS = p.VS + layer * 16384;
    const bool b4 = (lane & 16) != 0, b3 = (lane & 8) != 0, b2 = (lane & 4) != 0;
    int* sid = (int*)smem + wid * 512 + hh * 128;
    float* sgw = (float*)(sid + 256);
    for (int tb = wv * 2; tb < TOK; tb += nwv * 2) {
        const int tk = tb + hh;
        h16x32 xv;
#pragma unroll
        for (int c = 0; c < 8; ++c) {
            const half4 t = *(const half4*)(p.HN + (size_t)tk * DM + c * 128 + g * 4);
#pragma unroll
            for (int j = 0; j < 4; ++j) xv[4 * c + j] = t[j];
        }
        {
            int idv[4]; float gv[4];
#pragma unroll
            for (int s = 0; s < 4; ++s) { idv[s] = p.IDS[(size_t)tk * 128 + s * 32 + g]; gv[s] = p.GW[(size_t)tk * 128 + s * 32 + g]; }
            int cnt = 0;
            const unsigned below = (1u << g) - 1u;
            for (int e = 0; e < ET_N; ++e) {
#pragma unroll
                for (int s = 0; s < 4; ++s) {
                    const bool in = (idv[s] >> ET_SHIFT) == e;
                    const u64 m = __ballot(in);
                    const unsigned mh = hh ? (unsigned)(m >> 32) : (unsigned)m;
                    if (in) { const int pos = cnt + __popc(mh & below); sid[pos] = idv[s]; sgw[pos] = gv[s]; }
                    cnt += __popc(mh);
                }
            }
        }
        f32x2 acc[16];
#pragma unroll
        for (int i = 0; i < 16; ++i) acc[i] = (f32x2){0.f, 0.f};
        for (int bt = 0; bt < 16; ++bt) {
            const int mine = sid[bt * 8 + dpl]; const float gwm = sgw[bt * 8 + dpl];
            const float usm = US[mine], vsm = VS[mine];
            const i32x4 ida = *(const i32x4*)(sid + bt * 8), idb = *(const i32x4*)(sid + bt * 8 + 4);
            Q6 uq[8], vq[8];
#pragma unroll
            for (int k = 0; k < 8; ++k) {
                const unsigned off = (unsigned)(k < 4 ? ida[k & 3] : idb[k & 3]) * ROW6;
                uq[k] = ld6(U + off, g); vq[k] = ld6(V + off, g);
            }
            float d[8];
#pragma unroll
            for (int k = 0; k < 8; ++k) d[k] = dot32_fp6h(xv, uq[k]);
            float r4[4], r2[2], z;
#pragma unroll
            for (int i = 0; i < 4; ++i) { const float keep = b4 ? d[i + 4] : d[i], send = b4 ? d[i] : d[i + 4]; r4[i] = keep + __shfl_xor(send, 16); }
#pragma unroll
            for (int i = 0; i < 2; ++i) { const float keep = b3 ? r4[i + 2] : r4[i], send = b3 ? r4[i] : r4[i + 2]; r2[i] = keep + __shfl_xor(send, 8); }
            { const float keep = b2 ? r2[1] : r2[0], send = b2 ? r2[0] : r2[1]; z = keep + __shfl_xor(send, 4); }
            z += __shfl_xor(z, 2); z += __shfl_xor(z, 1);
            const float wm = gwm * gelu_exact(z * usm) * vsm;
#pragma unroll
            for (int k = 0; k < 8; ++k) {
                const float w0 = __builtin_bit_cast(float, __builtin_amdgcn_readlane(__builtin_bit_cast(int, wm), 4 * k));
                const float w1 = __builtin_bit_cast(float, __builtin_amdgcn_readlane(__builtin_bit_cast(int, wm), 32 + 4 * k));
                axpy32_fp6(acc, hh ? w1 : w0, vq[k]);
            }
        }
        float hv[32];
        {
            const float* hr = p.H + (size_t)tk * DM + g * 4;
#pragma unroll
            for (int c = 0; c < 8; ++c) { const f32x4 t = *(const f32x4*)(hr + c * 128); hv[4 * c] = t[0] + acc[2 * c][0]; hv[4 * c + 1] = t[1] + acc[2 * c][1]; hv[4 * c + 2] = t[2] + acc[2 * c + 1][0]; hv[4 * c + 3] = t[3] + acc[2 * c + 1][1]; }
        }
        float ss = 0.f;
#pragma unroll
        for (int i = 0; i < 32; ++i) ss += hv[i] * hv[i];
#pragma unroll
        for (int o = 16; o > 0; o >>= 1) ss += __shfl_xor(ss, o);
        const float rstd = rsqrtf(ss * (1.0f / 1024.0f) + 1e-6f);
        const float* gr = gnext + g * 4;
        if (mode == 0) {
            float* hw = p.H + (size_t)tk * DM + g * 4;
#pragma unroll
            for (int c = 0; c < 8; ++c) {
                *(f32x4*)(hw + c * 128) = (f32x4){hv[4 * c], hv[4 * c + 1], hv[4 * c + 2], hv[4 * c + 3]};
                const f32x4 ga = *(const f32x4*)(gr + c * 128);
                half4 o;
#pragma unroll
                for (int j = 0; j < 4; ++j) o[j] = (h16)(hv[4 * c + j] * rstd * ga[j]);
                *(half4*)(p.HN + (size_t)tk * DM + c * 128 + g * 4) = o;
            }
        } else {
            float* ow = p.out + (size_t)tk * DM + g * 4;
#pragma unroll
            for (int c = 0; c < 8; ++c) { const f32x4 ga = *(const f32x4*)(gr + c * 128); *(f32x4*)(ow + c * 128) = (f32x4){hv[4 * c] * rstd * ga[0], hv[4 * c + 1] * rstd * ga[1], hv[4 * c + 2] * rstd * ga[2], hv[4 * c + 3] * rstd * ga[3]}; }
        }
    }
}

constexpr int XST = 136;
__device__ __forceinline__ float fast_sigmoid(float v) { return __builtin_amdgcn_rcpf(1.0f + __expf(-v)); }
__device__ __forceinline__ float gelu_as(float v) {
    const float av = fabsf(v), t = __builtin_amdgcn_rcpf(av * 0.2316419f + 1.0f);
    float q = t * 0.5307027145f - 0.7265760135f; q = q * t + 0.7107068705f; q = q * t - 0.142248368f; q = q * t + 0.127414796f; q = q * t;
    const float e = __builtin_amdgcn_exp2f(v * v * -0.72134752044f);
    const float m = v * (q * e);
    return v < 0.f ? m : v - m;
}
__device__ __forceinline__ void phase_rnn_gates(PRef p, char* smem) {
    h16* xcS = (h16*)smem;
    float* aggS = (float*)(smem + 64 * XST * 2);
    h16* laS = (h16*)(smem + 64 * XST * 2 + 4096);
    h16* ruS = laS + 64 * XST;
    const int tid = tidx_(), lane = tid & 63, wid = widx_();
    for (int u = bidx_(); u < 4 * 64 * 10; u += GRIDV) {
        const int nb = u % 10, ck = (u / 10) & 63, b = u / 640;
        const int s0 = ck * 64, ch0 = nb * 128;
        {
            const int c8 = (tid & 15) * 8, tq = (tid >> 4) * 4, ch = ch0 + c8;
            float w[4][8], bias[8];
#pragma unroll
            for (int j = 0; j < 4; ++j) {
                const f32x4 w0 = *(const f32x4*)(p.odd_conv_w + j * DRNN + ch), w1 = *(const f32x4*)(p.odd_conv_w + j * DRNN + ch + 4);
#pragma unroll
                for (int i = 0; i < 4; ++i) { w[j][i] = w0[i]; w[j][4 + i] = w1[i]; }
            }
            { const f32x4 b0 = *(const f32x4*)(p.odd_conv_b + ch), b1 = *(const f32x4*)(p.odd_conv_b + ch + 4);
#pragma unroll
              for (int i = 0; i < 4; ++i) { bias[i] = b0[i]; bias[4 + i] = b1[i]; } }
            half8 xin[7];
#pragma unroll
            for (int r = 0; r < 7; ++r) {
                const int sp = s0 + tq - 3 + r;
                if (sp >= 0) xin[r] = *(const half8*)(p.Z2 + (size_t)(b * SEQ + sp) * Z2LD + DRNN + ch);
                else {
#pragma unroll
                    for (int i = 0; i < 8; ++i) xin[r][i] = (h16)0.f;
                }
            }
#pragma unroll
            for (int tt = 0; tt < 4; ++tt) {
                half8 o;
#pragma unroll
                for (int i = 0; i < 8; ++i) {
                    float a = bias[i];
#pragma unroll
                    for (int j = 0; j < 4; ++j) a = fmaf(w[j][i], (float)xin[tt + j][i], a);
                    o[i] = (h16)a;
                }
                *(half8*)(xcS + (tq + tt) * XST + c8) = o;
            }
        }
        hsync();
        float bra2[2], bri2[2], sp2[2];
#pragma unroll
        for (int e = 0; e < 2; ++e) {
            const int chq = ch0 + (wid * 2 + e) * 16 + (lane & 15);
            bra2[e] = p.odd_b_ra[chq]; bri2[e] = p.odd_b_ri[chq]; sp2[e] = p.odd_lam[chq];
        }
#pragma unroll
        for (int e = 0; e < 2; ++e) sp2[e] = fmaxf(-sp2[e], 0.f) + __logf(1.0f + __expf(-fabsf(sp2[e])));
        f32x4 ar[4][2], ai[4][2];
#pragma unroll
        for (int m = 0; m < 4; ++m)
#pragma unroll
            for (int e = 0; e < 2; ++e) { ar[m][e] = (f32x4){0.f, 0.f, 0.f, 0.f}; ai[m][e] = (f32x4){0.f, 0.f, 0.f, 0.f}; }
        const h16* wr = p.Wr + (size_t)nb * 16384 + (wid * 32 + (lane & 15)) * 128 + (lane >> 4) * 8;
        const h16* wi = p.Wr + (size_t)(10 + nb) * 16384 + (wid * 32 + (lane & 15)) * 128 + (lane >> 4) * 8;
#pragma unroll
        for (int ks = 0; ks < 4; ++ks) {
            half8 a[4];
#pragma unroll
            for (int m = 0; m < 4; ++m) a[m] = *(const half8*)(xcS + (m * 16 + (lane & 15)) * XST + ks * 32 + (lane >> 4) * 8);
#pragma unroll
            for (int e = 0; e < 2; ++e) {
                const half8 w1 = *(const half8*)(wr + e * 16 * 128 + ks * 32), w2 = *(const half8*)(wi + e * 16 * 128 + ks * 32);
#pragma unroll
                for (int m = 0; m < 4; ++m) {
                    ar[m][e] = __builtin_amdgcn_mfma_f32_16x16x32_f16(a[m], w1, ar[m][e], 0, 0, 0);
                    ai[m][e] = __builtin_amdgcn_mfma_f32_16x16x32_f16(a[m], w2, ai[m][e], 0, 0, 0);
                }
            }
        }
        const int g4 = lane >> 4;
#pragma unroll
        for (int e = 0; e < 2; ++e) {
            const int cl = (wid * 2 + e) * 16 + (lane & 15);
            const float bra = bra2[e], bri = bri2[e], sp = sp2[e];
            float Ac = 1.f, Hc = 0.f;
#pragma unroll
            for (int m = 0; m < 4; ++m) {
                float A = 1.f, H = 0.f;
#pragma unroll
                for (int j = 0; j < 4; ++j) {
                    const int tt = m * 16 + g4 * 4 + j;
                    const float r = fast_sigmoid(ar[m][e][j] + bra), ig = fast_sigmoid(ai[m][e][j] + bri);
                    const h16 la16 = (h16)(-8.0f * r * sp);
                    const float a = __expf((float)la16);
                    const float xc = (float)xcS[tt * XST + cl];
                    const h16 u16 = (h16)(__builtin_amdgcn_sqrtf(fmaxf(1.0f - a * a, 0.f)) * (ig * xc));
                    laS[tt * XST + cl] = la16; ruS[tt * XST + cl] = u16;
                    H = a * H + (float)u16; A *= a;
                }
                { const float Al = __shfl_xor(A, 16), Hl = __shfl_xor(H, 16); if (g4 & 1) { H = Hl * A + H; A = Al * A; } }
                { const float Al = __shfl_xor(A, 32), Hl = __shfl_xor(H, 32); if (g4 == 3) { H = Hl * A + H; A = Al * A; } }
                Hc = Hc * A + H; Ac *= A;
            }
            if (g4 == 3) { p.AggP[(size_t)(b * 64 + ck) * DRNN + ch0 + cl] = Ac; p.AggH[(size_t)(b * 64 + ck) * DRNN + ch0 + cl] = Hc; }
        }
        hsync();
#pragma unroll
        for (int i = 0; i < 4; ++i) {
            const int q = tid + 256 * i, row = q >> 4, c8 = (q & 15) * 8;
            const size_t o = (size_t)(b * SEQ + s0 + row) * DRNN + ch0 + c8;
            *(half8*)(p.LA + o) = *(const half8*)(laS + row * XST + c8);
            *(half8*)(p.RU + o) = *(const half8*)(ruS + row * XST + c8);
        }
    }
}
__device__ __forceinline__ void phase_rnn_scan_b(PRef p) {
    for (int u = bidx_(); u < 4 * 64 * 5; u += GRIDV) {
        const int cb = u % 5, ck = (u / 5) & 63, b = u / 320;
        const int ch = cb * 256 + tidx_();
        float h = 0.f;
        {
            const float* ap = p.AggP + (size_t)(b * 64) * DRNN + ch; const float* hp = p.AggH + (size_t)(b * 64) * DRNN + ch;
            for (int c = 0; c < ck; c += 16) {
                float pa[16], ph[16];
#pragma unroll
                for (int i = 0; i < 16; ++i) { const int ci = min(c + i, ck - 1); pa[i] = ap[(size_t)ci * DRNN]; ph[i] = hp[(size_t)ci * DRNN]; }
#pragma unroll
                for (int i = 0; i < 16; ++i) { const bool ok = c + i < ck; h = (ok ? pa[i] : 1.0f) * h + (ok ? ph[i] : 0.f); }
            }
        }
        const size_t base = (size_t)(b * SEQ + ck * 64) * DRNN + ch;
        h16* zrow = p.Z2 + (size_t)(b * SEQ + ck * 64) * Z2LD;
#pragma unroll 1
        for (int i0 = 0; i0 < 64; i0 += 32) {
            h16 la[32], uu[32], gt[32];
#pragma unroll
            for (int i = 0; i < 32; ++i) { la[i] = p.LA[base + (size_t)(i0 + i) * DRNN]; uu[i] = p.RU[base + (size_t)(i0 + i) * DRNN]; gt[i] = zrow[(size_t)(i0 + i) * Z2LD + ch]; }
#pragma unroll
            for (int i = 0; i < 32; ++i) {
                h = __expf((float)la[i]) * h + (float)uu[i];
                zrow[(size_t)(i0 + i) * Z2LD + DRNN + ch] = (h16)(gelu_as((float)gt[i]) * h);
            }
        }
    }
}

#define XB_TMO      128
#define XB_XCNT(j)  (256  + 64 * (j))
#define XB_XSUB(j)  (1280 + 64 * (j))
#define XB_XGEN(j)  (2304 + 64 * (j))
#define XB_TOP      3328
#define XB_TOPGEN   3392
#define XCD_BAR_WORDS 3456
#define XB_SPIN_CAP (1u << 22)
__device__ __forceinline__ unsigned xb_ld(unsigned* p)              { return __hip_atomic_load(p, __ATOMIC_RELAXED, __HIP_MEMORY_SCOPE_AGENT); }
__device__ __forceinline__ unsigned xb_add(unsigned* p, unsigned v) { return __hip_atomic_fetch_add(p, v, __ATOMIC_RELAXED, __HIP_MEMORY_SCOPE_AGENT); }
__device__ __forceinline__ unsigned xb_xcc_id() { return (unsigned)__builtin_amdgcn_s_getreg((3 << 11) | 20) & 0xFu; }
#define XB_SPIN(cond, bar) do { unsigned _sp = 0; while (cond) { __builtin_amdgcn_s_sleep(1); \
    if ((++_sp & 255u) == 0u) { if (xb_ld(&(bar)[XB_TMO])) break; if (_sp > XB_SPIN_CAP) { atomicAdd(&(bar)[XB_TMO], 1u); break; } } } } while (0)
struct XcdBarrier { unsigned* bar; unsigned x; volatile LAS unsigned* st; };
__device__ __forceinline__ XcdBarrier xcd_barrier_post(unsigned* bar, volatile LAS unsigned* st) {
    XcdBarrier b; b.bar = bar; b.x = xb_xcc_id(); b.st = st;
    if (threadIdx.x == 0) (void)xb_add(&bar[XB_XCNT(b.x)], 1u);
    return b;
}
__device__ __forceinline__ void xcd_barrier_complete(unsigned* bar, unsigned x, unsigned& nloc, unsigned& nx) {
    const unsigned G = gridDim.x * gridDim.y * gridDim.z;
    unsigned sum, cnt, mine, sp = 0u;
    for (;;) {
        sum = 0u; cnt = 0u; mine = 0u;
#pragma unroll
        for (unsigned j = 0; j < 16; ++j) { const unsigned c = xb_ld(&bar[XB_XCNT(j)]); sum += c; cnt += (c > 0u) ? 1u : 0u; mine = (j == x) ? c : mine; }
        if (sum == G) break;
        __builtin_amdgcn_s_sleep(1);
        if ((++sp & 255u) == 0u) { if (xb_ld(&bar[XB_TMO])) break; if (sp > XB_SPIN_CAP) { atomicAdd(&bar[XB_TMO], 1u); break; } }
    }
    nloc = mine > 0u ? mine : 1u; nx = cnt > 0u ? cnt : 1u;
}
__device__ __forceinline__ void xcd_barrier(const XcdBarrier& b) {
    asm volatile("s_waitcnt vmcnt(0)" ::: "memory");
    __syncthreads();
    if (threadIdx.x == 0) {
        unsigned* bar = b.bar;
        __builtin_amdgcn_s_waitcnt(0);
        unsigned nloc = b.st[0], nx = b.st[1];
        if (nloc == 0u) { xcd_barrier_complete(bar, b.x, nloc, nx); b.st[0] = nloc; b.st[1] = nx; }
        const unsigned old = xb_add(&bar[XB_XSUB(b.x)], 1u);
        const unsigned gen = old / nloc;
        if (old + 1u == (gen + 1u) * nloc) {
            __builtin_amdgcn_fence(__ATOMIC_RELEASE, "agent");
            asm volatile("s_waitcnt vmcnt(0)" ::: "memory");
            const unsigned og = xb_add(&bar[XB_TOP], 1u);
            const unsigned tg = og / nx;
            if (og + 1u == (tg + 1u) * nx) xb_add(&bar[XB_TOPGEN], 1u);
            else XB_SPIN(xb_ld(&bar[XB_TOPGEN]) == tg, bar);
            __builtin_amdgcn_fence(__ATOMIC_ACQUIRE, "agent");
            xb_add(&bar[XB_XGEN(b.x)], 1u);
            asm volatile("s_waitcnt vmcnt(0)" ::: "memory");
        } else {
            XB_SPIN(xb_ld(&bar[XB_XGEN(b.x)]) == gen, bar);
            __builtin_amdgcn_fence(__ATOMIC_ACQUIRE, "agent");
            asm volatile("s_waitcnt vmcnt(0)" ::: "memory");
        }
    }
    __syncthreads();
}

namespace pg8 {
#define PG8_LAS __attribute__((address_space(3)))
typedef unsigned short bf16_t;
typedef short bf16x8 __attribute__((ext_vector_type(8)));
typedef unsigned u32x4 __attribute__((ext_vector_type(4)));
constexpr int BM = 256, BK = 64, HALF = 128, HTB = HALF * BK * 2  , STAGE_BYTES = 8 * HTB, NXCD = 8, WGM = 8;

__host__ __device__ __forceinline__ int lds_byte(int r, int c) { const int st = (r >> 4) * 2 + (c >> 5), rr = r & 15, cc = c & 31, ob = rr * 64 + cc * 2; return st * 1024 + (ob ^ (((ob >> 9) & 1) << 5)); }
__host__ __device__ __forceinline__ void stage_rc(int b, int& R, int& C) { const int st = b / 1024, sb = b % 1024, swz = sb ^ (((sb >> 9) & 1) << 5); R = (st >> 1) * 16 + swz / 64; C = (st & 1) * 32 + (swz % 64) / 2; }
__host__ __device__ __forceinline__ int perm32(int rho) { const int n = rho >> 4, i = rho & 15; return 8 * (i >> 2) + 4 * n + (i & 3); }

struct Unit { int pm, pn; };
struct Gemm { const bf16_t* A; const bf16_t* Bt; int M, N, K, lda; };

struct StaticOrder {
    int nM, nN, nwg, G, c;
    __host__ __device__ void init(int M, int N, int G_, int c_) { nM = M / BM; nN = N / BM; nwg = nM * nN; G = G_; c = c_; }
    __host__ __device__ bool next(int i, Unit& u) const {
        const long L = (long)i * G + c; if (L >= nwg) return false;
        int wgid = (int)L; { const int q = nwg / NXCD, r = nwg % NXCD, xcd = wgid % NXCD, off = wgid / NXCD; wgid = (xcd < r ? xcd * (q + 1) : r * (q + 1) + (xcd - r) * q) + off; }
        const int nig = WGM * nN, gid = wgid / nig, fm = gid * WGM, gsz = (nM - fm) < WGM ? (nM - fm) : WGM;
        u.pm = fm + ((wgid % nig) % gsz); u.pn = (wgid % nig) / gsz; return true;
    }
    __device__ __forceinline__ void a_ready(const Unit&) const {}
    __device__ __forceinline__ void done(const Unit&) const {}
};
__device__ __forceinline__ unsigned pk_h16(float lo, float hi) { half2v t; t[0] = (h16)lo; t[1] = (h16)hi; return __builtin_bit_cast(unsigned, t); }
struct EpiResid {
    static constexpr bool PERM = false, AFTER_DRAIN = false;
    const float* resid; float* out; int ldc;
    __device__ __forceinline__ void operator()(const f32x4 (&acc)[2][2][4][2], const Unit& u, int wr, int wc, int fr, int fq) const {
#pragma unroll
        for (int ai = 0; ai < 2; ++ai)
#pragma unroll
            for (int m = 0; m < 4; ++m) { const size_t ro = (size_t)(u.pm * BM + ai * HALF + wr * 64 + m * 16 + fr) * ldc + u.pn * BM + wc * 32 + 4 * fq;
#pragma unroll
                for (int bj = 0; bj < 2; ++bj)
#pragma unroll
                    for (int n = 0; n < 2; ++n) { const size_t o = ro + bj * HALF + n * 16; *(f32x4*)(out + o) = *(const f32x4*)(resid + o) + acc[ai][bj][m][n]; } }
    }
};
struct EpiF32 {
    static constexpr bool PERM = false, AFTER_DRAIN = false;
    float* out; size_t ldc;
    __device__ __forceinline__ void operator()(const f32x4 (&acc)[2][2][4][2], const Unit& u, int wr, int wc, int fr, int fq) const {
#pragma unroll
        for (int ai = 0; ai < 2; ++ai)
#pragma unroll
            for (int m = 0; m < 4; ++m) { const size_t ro = (size_t)(u.pm * BM + ai * HALF + wr * 64 + m * 16 + fr) * ldc + u.pn * BM + wc * 32 + 4 * fq;
#pragma unroll
                for (int bj = 0; bj < 2; ++bj)
#pragma unroll
                    for (int n = 0; n < 2; ++n) *(f32x4*)(out + ro + bj * HALF + n * 16) = acc[ai][bj][m][n]; }
    }
};
struct EpiH16 {
    static constexpr bool PERM = true, AFTER_DRAIN = false;
    h16* out; int ldc;
    __device__ __forceinline__ void operator()(const f32x4 (&acc)[2][2][4][2], const Unit& u, int wr, int wc, int fr, int fq) const {
#pragma unroll
        for (int ai = 0; ai < 2; ++ai)
#pragma unroll
            for (int m = 0; m < 4; ++m) { h16* rowp = out + (size_t)(u.pm * BM + ai * HALF + wr * 64 + m * 16 + fr) * ldc + u.pn * BM + wc * 32 + 8 * fq;
#pragma unroll
                for (int bj = 0; bj < 2; ++bj) { const f32x4 v0 = acc[ai][bj][m][0], v1 = acc[ai][bj][m][1];
                    u32x4 w; w.x = pk_h16(v0[0], v0[1]); w.y = pk_h16(v0[2], v0[3]); w.z = pk_h16(v1[0], v1[1]); w.w = pk_h16(v1[2], v1[3]);
                    *(u32x4*)(rowp + bj * HALF) = w; } }
    }
};
struct EpiSC {
    static constexpr bool PERM = true, AFTER_DRAIN = false;
    h16* out;
    __device__ __forceinline__ void operator()(const f32x4 (&acc)[2][2][4][2], const Unit& u, int wr, int wc, int fr, int fq) const {
#pragma unroll
        for (int ai = 0; ai < 2; ++ai)
#pragma unroll
            for (int m = 0; m < 4; ++m) { const int row = u.pm * BM + ai * HALF + wr * 64 + m * 16 + fr;
#pragma unroll
                for (int bj = 0; bj < 2; ++bj) { const int col = u.pn * BM + bj * HALF + wc * 32 + 8 * fq;
                    const f32x4 v0 = acc[ai][bj][m][0], v1 = acc[ai][bj][m][1];
                    u32x4 w; w.x = pk_h16(v0[0], v0[1]); w.y = pk_h16(v0[2], v0[3]); w.z = pk_h16(v1[0], v1[1]); w.w = pk_h16(v1[2], v1[3]);
                    *(u32x4*)(out + ((size_t)((row >> 6) * 256 + (col >> 3)) * 64 + (row & 63)) * 8) = w; } }
    }
};
struct EpiEvenMain {
    static constexpr bool PERM = true, AFTER_DRAIN = false;
    h16* Z; float* FG; const float* b_f;
    __device__ __forceinline__ void operator()(const f32x4 (&acc)[2][2][4][2], const Unit& u, int wr, int wc, int fr, int fq) const {
#pragma unroll
        for (int bj = 0; bj < 2; ++bj) {
            const int col0 = u.pn * BM + bj * HALF + wc * 32 + 8 * fq;
            if (col0 < 2048) {
                const float sc = (col0 < 512 || (col0 >= 1024 && col0 < 1536)) ? QSCALE : 1.0f;
#pragma unroll
                for (int ai = 0; ai < 2; ++ai)
#pragma unroll
                    for (int m = 0; m < 4; ++m) { const f32x4 v0 = acc[ai][bj][m][0] * sc, v1 = acc[ai][bj][m][1] * sc;
                        u32x4 w; w.x = pk_h16(v0[0], v0[1]); w.y = pk_h16(v0[2], v0[3]); w.z = pk_h16(v1[0], v1[1]); w.w = pk_h16(v1[2], v1[3]);
                        *(u32x4*)(Z + (size_t)(u.pm * BM + ai * HALF + wr * 64 + m * 16 + fr) * ZLD + col0) = w; }
            } else if (col0 < 2080) {
                const int c = col0 - 2048;
#pragma unroll
                for (int ai = 0; ai < 2; ++ai)
#pragma unroll
                    for (int m = 0; m < 4; ++m) { const f32x4 v0 = acc[ai][bj][m][0], v1 = acc[ai][bj][m][1]; f32x4 o0, o1;
                        if (c == 0) {
#pragma unroll
                            for (int q = 0; q < 4; ++q) { o0[q] = log_sigmoid(v0[q] + b_f[q]) * LOG2E; o1[q] = log_sigmoid(v1[q] + b_f[4 + q]) * LOG2E; }
                        } else {
#pragma unroll
                            for (int q = 0; q < 4; ++q) { o0[q] = sigmoidf_(v0[q]); o1[q] = sigmoidf_(v1[q]); }
                        }
                        float* fr_ = FG + (size_t)(u.pm * BM + ai * HALF + wr * 64 + m * 16 + fr) * 32 + c;
                        *(f32x4*)fr_ = o0; *(f32x4*)(fr_ + 4) = o1; }
            }
        }
    }
};
struct EpiVt {
    static constexpr bool PERM = true, AFTER_DRAIN = false;
    h16 *VtF, *VtS, *VtW;
    __device__ __forceinline__ void operator()(const f32x4 (&acc)[2][2][4][2], const Unit& u, int wr, int wc, int fr, int fq) const {
#pragma unroll
        for (int ai = 0; ai < 2; ++ai)
#pragma unroll
            for (int m = 0; m < 4; ++m) {
                const int n = u.pm * BM + ai * HALF + wr * 64 + m * 16 + fr;
#pragma unroll
                for (int bj = 0; bj < 2; ++bj) {
                    const int t0 = u.pn * BM + bj * HALF + wc * 32 + 8 * fq, b = t0 >> 12, s = t0 & 4095;
                    h16* dst = n < 512 ? VtF + ((size_t)(b * 512 + n)) * SEQ + s : (n < 640 ? VtS + ((size_t)(b * 128 + n - 512)) * SEQ + s : VtW + ((size_t)(b * 128 + n - 640)) * SEQ + s);
                    const f32x4 v0 = acc[ai][bj][m][0], v1 = acc[ai][bj][m][1];
                    u32x4 w; w.x = pk_h16(v0[0], v0[1]); w.y = pk_h16(v0[2], v0[3]); w.z = pk_h16(v1[0], v1[1]); w.w = pk_h16(v1[2], v1[3]);
                    *(u32x4*)dst = w;
                }
            }
    }
};

template <class Epi, class Sched, bool ALIGN_EPI = false, bool SP2 = false>
__device__ __forceinline__ void gemm_phase(PG8_LAS unsigned char* lds, const Gemm g, const Sched& S, const Epi& E) {
    int tid_ = threadIdx.x; asm volatile("" : "+v"(tid_));
    const int tid = tid_, wid = __builtin_amdgcn_readfirstlane(tid >> 6), lane = tid & 63, wr = wid >> 2, wc = wid & 3, fr = lane & 15, fq = lane >> 4;
    const int K = g.K, nt = K / BK;
    unsigned voffA[2], voffB[2];
#pragma unroll
    for (int i = 0; i < 2; ++i) { int R, C; stage_rc(tid * 16 + i * 8192, R, C); const int Rb = Epi::PERM ? ((R & ~31) + perm32(R & 31)) : R;
        voffA[i] = (unsigned)(R * g.lda + C) * 2u; voffB[i] = (unsigned)(Rb * K + C) * 2u; }
    const size_t kstep = (size_t)(BK * 2);
    const size_t hstepA = (size_t)HALF * g.lda * 2, hstepB = (size_t)HALF * K * 2;
    const size_t tstepA = 2 * hstepA, tstepB = 2 * hstepB;
    const unsigned ldsw = (unsigned)wid * 1024u;
    const int aoff = lds_byte(wr * 64 + fr, fq * 8), boff = lds_byte(wc * 32 + fr, fq * 8);
#define PG8_SA(b, h) (((b) * 2 + (h)) * HTB)
#define PG8_SB(b, h) ((4 + (b) * 2 + (h)) * HTB)
#define PG8_STAGE(bufoff, gbase, voff) do { _Pragma("unroll") for (int _i = 0; _i < 2; ++_i) \
        __builtin_amdgcn_global_load_lds((const unsigned*)((const char*)(gbase) + (voff)[_i]), (PG8_LAS unsigned*)(lds + (bufoff) + ldsw + _i * 8192), 16, 0, 0); } while (0)
#define PG8_LDA(dst, b, h) do { _Pragma("unroll") for (int m = 0; m < 4; ++m) _Pragma("unroll") for (int k = 0; k < 2; ++k) dst[m][k] = *(const PG8_LAS bf16x8*)(lds + PG8_SA(b, h) + aoff + m * 2048 + k * 1024); } while (0)
#define PG8_LDB(dst, b, h) do { _Pragma("unroll") for (int n = 0; n < 2; ++n) _Pragma("unroll") for (int k = 0; k < 2; ++k) dst[n][k] = *(const PG8_LAS bf16x8*)(lds + PG8_SB(b, h) + boff + n * 2048 + k * 1024); } while (0)
#define PG8_MMA(ai, bj, At, Bt) do { __builtin_amdgcn_s_setprio(1); _Pragma("unroll") for (int m = 0; m < 4; ++m) _Pragma("unroll") for (int n = 0; n < 2; ++n) _Pragma("unroll") for (int k = 0; k < 2; ++k) \
        acc[ai][bj][m][n] = __builtin_amdgcn_mfma_f32_16x16x32_f16(__builtin_bit_cast(half8, Bt[n][k]), __builtin_bit_cast(half8, At[m][k]), acc[ai][bj][m][n], 0, 0, 0); __builtin_amdgcn_s_setprio(0); } while (0)
#define PG8_WAIT_V(n) asm volatile("s_waitcnt vmcnt(" #n ")" ::: "memory")
#define PG8_WAIT_L(n) asm volatile("s_waitcnt lgkmcnt(" #n ")" ::: "memory")
#define PG8_BAR __builtin_amdgcn_s_barrier()
#define PG8_SCHED __builtin_amdgcn_sched_barrier(0)
    Unit cur, nxt; int ui = 0;
    if (!S.next(0, cur)) return;
    f32x4 acc[2][2][4][2];
#pragma unroll
    for (int a = 0; a < 2; ++a)
#pragma unroll
        for (int b = 0; b < 2; ++b)
#pragma unroll
            for (int m = 0; m < 4; ++m)
#pragma unroll
                for (int n = 0; n < 2; ++n) acc[a][b][m][n] = (f32x4){0.f, 0.f, 0.f, 0.f};
    bf16x8 At[4][2], B0[2][2], B1[2][2];
    const char* cA = (const char*)g.A + (size_t)cur.pm * tstepA; const char* cB = (const char*)g.Bt + (size_t)cur.pn * tstepB;
    S.a_ready(cur);
    if constexpr (SP2) {
        PG8_STAGE(PG8_SB(0, 0), cB, voffB); PG8_STAGE(PG8_SB(0, 1), cB + hstepB, voffB); PG8_STAGE(PG8_SA(0, 0), cA, voffA); PG8_STAGE(PG8_SA(0, 1), cA + hstepA, voffA);
        if (wr == 1) PG8_BAR;
        PG8_WAIT_V(2); PG8_BAR;
        PG8_STAGE(PG8_SB(1, 0), cB + kstep, voffB); PG8_STAGE(PG8_SA(1, 0), cA + kstep, voffA); PG8_STAGE(PG8_SB(1, 1), cB + hstepB + kstep, voffB);
        PG8_WAIT_V(6); PG8_BAR;
    } else {
        PG8_STAGE(PG8_SB(0, 0), cB, voffB); PG8_STAGE(PG8_SA(0, 0), cA, voffA); PG8_STAGE(PG8_SB(0, 1), cB + hstepB, voffB); PG8_STAGE(PG8_SA(0, 1), cA + hstepA, voffA);
        if (wr == 1) PG8_BAR;
        PG8_WAIT_V(4); PG8_BAR;
        PG8_STAGE(PG8_SB(1, 0), cB + kstep, voffB); PG8_STAGE(PG8_SA(1, 0), cA + kstep, voffA); PG8_STAGE(PG8_SB(1, 1), cB + hstepB + kstep, voffB);
        PG8_WAIT_V(6); PG8_BAR;
    }
    for (;;) {
        const bool has_next = S.next(ui + 1, nxt);
        const char* nA = has_next ? (const char*)g.A + (size_t)nxt.pm * tstepA : cA; const char* nB = has_next ? (const char*)g.Bt + (size_t)nxt.pn * tstepB : cB;
        for (int t = 0; t < nt; t += 2) {
            const bool last = (t == nt - 2);
            const char* a1 = cA + (size_t)(t + 1) * kstep;
            const char* a2 = last ? nA : cA + (size_t)(t + 2) * kstep; const char* b2 = last ? nB : cB + (size_t)(t + 2) * kstep;
            const char* a3 = a2 + kstep; const char* b3 = b2 + kstep;
            if (last && has_next) S.a_ready(nxt);
            if constexpr (SP2) {
            PG8_LDB(B0, 0, 0); PG8_LDB(B1, 0, 1); PG8_SCHED; PG8_LDA(At, 0, 0); PG8_STAGE(PG8_SA(1, 1), a1 + hstepA, voffA);
            PG8_WAIT_V(8); PG8_WAIT_L(0); PG8_BAR; PG8_MMA(0, 0, At, B0); PG8_MMA(0, 1, At, B1); PG8_BAR; PG8_SCHED;
            PG8_LDA(At, 0, 1); PG8_STAGE(PG8_SB(0, 0), b2, voffB); PG8_STAGE(PG8_SB(0, 1), b2 + hstepB, voffB); PG8_STAGE(PG8_SA(0, 0), a2, voffA);
            PG8_WAIT_V(8); PG8_WAIT_L(0); PG8_BAR; PG8_MMA(1, 0, At, B0); PG8_MMA(1, 1, At, B1); PG8_BAR; PG8_SCHED;
            PG8_LDB(B0, 1, 0); PG8_LDB(B1, 1, 1); PG8_SCHED; PG8_LDA(At, 1, 0); PG8_STAGE(PG8_SA(0, 1), a2 + hstepA, voffA);
            PG8_WAIT_V(8); PG8_WAIT_L(0); PG8_BAR; PG8_MMA(0, 0, At, B0); PG8_MMA(0, 1, At, B1); PG8_BAR; PG8_SCHED;
            PG8_LDA(At, 1, 1); PG8_STAGE(PG8_SB(1, 0), b3, voffB); PG8_STAGE(PG8_SB(1, 1), b3 + hstepB, voffB); PG8_STAGE(PG8_SA(1, 0), a3, voffA);
            PG8_WAIT_V(8); PG8_WAIT_L(0); PG8_BAR; PG8_MMA(1, 0, At, B0); PG8_MMA(1, 1, At, B1); PG8_BAR; PG8_SCHED;
            } else {
            PG8_LDB(B0, 0, 0); PG8_SCHED; PG8_LDA(At, 0, 0); PG8_STAGE(PG8_SA(1, 1), a1 + hstepA, voffA);
            PG8_WAIT_L(8); PG8_BAR; PG8_WAIT_L(0); PG8_MMA(0, 0, At, B0); PG8_BAR; PG8_SCHED;
            PG8_LDB(B1, 0, 1); PG8_STAGE(PG8_SB(0, 0), b2, voffB);
            PG8_BAR; PG8_WAIT_L(0); PG8_MMA(0, 1, At, B1); PG8_BAR;
            PG8_LDA(At, 0, 1); PG8_STAGE(PG8_SA(0, 0), a2, voffA);
            PG8_BAR; PG8_WAIT_L(0); PG8_MMA(1, 0, At, B0); PG8_BAR; PG8_SCHED;
            PG8_STAGE(PG8_SB(0, 1), b2 + hstepB, voffB);
            PG8_WAIT_V(6); PG8_BAR; PG8_MMA(1, 1, At, B1); PG8_BAR;
            PG8_LDB(B0, 1, 0); PG8_SCHED; PG8_LDA(At, 1, 0); PG8_STAGE(PG8_SA(0, 1), a2 + hstepA, voffA);
            PG8_WAIT_L(8); PG8_BAR; PG8_WAIT_L(0); PG8_MMA(0, 0, At, B0); PG8_BAR; PG8_SCHED;
            PG8_LDB(B1, 1, 1); PG8_STAGE(PG8_SB(1, 0), b3, voffB);
            PG8_BAR; PG8_WAIT_L(0); PG8_MMA(0, 1, At, B1); PG8_BAR;
            PG8_LDA(At, 1, 1); PG8_STAGE(PG8_SA(1, 0), a3, voffA);
            PG8_BAR; PG8_WAIT_L(0); PG8_MMA(1, 0, At, B0); PG8_BAR; PG8_SCHED;
            PG8_STAGE(PG8_SB(1, 1), b3 + hstepB, voffB);
            PG8_WAIT_V(6); PG8_BAR; PG8_MMA(1, 1, At, B1); PG8_BAR;
            }
        }
        if constexpr (ALIGN_EPI) { if (wr == 0) PG8_BAR; }
        if constexpr (!Epi::AFTER_DRAIN) { E(acc, cur, wr, wc, fr, fq); S.done(cur); }
        if (!has_next) break;
#pragma unroll
        for (int a = 0; a < 2; ++a)
#pragma unroll
            for (int b = 0; b < 2; ++b)
#pragma unroll
                for (int m = 0; m < 4; ++m)
#pragma unroll
                    for (int n = 0; n < 2; ++n) acc[a][b][m][n] = (f32x4){0.f, 0.f, 0.f, 0.f};
        cur = nxt; cA = nA; cB = nB; ++ui;
        if constexpr (ALIGN_EPI) { if (wr == 1) PG8_BAR; }
    }
    PG8_WAIT_V(0);
    if constexpr (!ALIGN_EPI) { if (wr == 0) PG8_BAR; }
    PG8_BAR;
    if constexpr (Epi::AFTER_DRAIN) { E.fused(acc, cur, wr, wc, fr, fq, lds, wid, lane); S.done(cur); }
#undef PG8_SA
#undef PG8_SB
#undef PG8_STAGE
#undef PG8_LDA
#undef PG8_LDB
#undef PG8_MMA
#undef PG8_WAIT_V
#undef PG8_WAIT_L
#undef PG8_BAR
#undef PG8_SCHED
}
}

__device__ __forceinline__ GemmArgs mk_gemm(const h16* A, int lda, const h16* Bt, int ldb, int M, int N, int K, int ans, int mode, h16* c16, int ldc16, float* c32, int ldc32, const float* resid) {
    GemmArgs g; g.A = A; g.lda = lda; g.Bt = Bt; g.ldb = ldb; g.M = M; g.N = N; g.K = K; g.a_ntile_stride = ans; g.mode = mode; g.c16 = c16; g.ldc16 = ldc16; g.c32 = c32; g.ldc32 = ldc32; g.resid = resid; g.aux = nullptr; return g;
}

__device__ __forceinline__ void run_phase(PRef p, int ph, char* smem) {
    if (ph == 1 || ph == 4 || ph == 6 || ph == 10 || ph == 14 || ph == 16) {
        PG8_LAS unsigned char* lds = (PG8_LAS unsigned char*)dyn_lds;
        const int G = (int)gridDim.x, c = (int)blockIdx.x;
        pg8::StaticOrder S;
        typedef const pg8::bf16_t* bp;
        if (ph == 1) {
            { pg8::EpiEvenMain E{p.Z, p.FG, p.even_b_f}; S.init(TOK, ZLD, G, c);
              pg8::gemm_phase<pg8::EpiEvenMain, pg8::StaticOrder, true, true>(lds, pg8::Gemm{(bp)p.HN, (bp)p.WtE, TOK, ZLD, DM, DM}, S, E); }
            { pg8::EpiVt E{p.VtF, p.VtS, p.VtW}; S.init(768, TOK, G, (c + 3 * G / 4) % G);
              pg8::gemm_phase<pg8::EpiVt, pg8::StaticOrder, true, true>(lds, pg8::Gemm{(bp)p.WtV, (bp)p.HN, 768, TOK, DM, DM}, S, E); }
        } else if (ph == 4) {
            pg8::EpiResid E{p.x, p.H, DM}; S.init(TOK, DM, G, c);
            pg8::gemm_phase<pg8::EpiResid, pg8::StaticOrder, true, true>(lds, pg8::Gemm{(bp)p.O, (bp)p.WtEo, TOK, DM, DM, DM}, S, E);
        } else if (ph == 14) {
            pg8::EpiResid E{p.H, p.H, DM}; S.init(TOK, DM, G, c);
            pg8::gemm_phase<pg8::EpiResid, pg8::StaticOrder, true, true>(lds, pg8::Gemm{(bp)(p.Z2 + DRNN), (bp)p.WtOo, TOK, DM, DRNN, Z2LD}, S, E);
        } else if (ph == 10) {
            pg8::EpiH16 E{p.Z2, Z2LD}; S.init(TOK, Z2LD, G, c);
            pg8::gemm_phase<pg8::EpiH16, pg8::StaticOrder, true, true>(lds, pg8::Gemm{(bp)p.HN, (bp)p.WtO, TOK, Z2LD, DM, DM}, S, E);
        } else {
            pg8::EpiSC E{p.SC}; S.init(TOK, 2048, G, c);
            pg8::gemm_phase<pg8::EpiSC, pg8::StaticOrder, true, true>(lds, pg8::Gemm{(bp)p.HN, (bp)(p.WtQ + (ph == 16 ? (size_t)2048 * 1024 : 0)), TOK, 2048, DM, DM}, S, E);
        }
        return;
    }
    if (ph == 0) phase_prep(p, smem);
    else if (ph == 2) phase_cumsum_compress(p, smem);
    else if (ph == 3) phase_attention(p, smem);
    else if (ph == 5 || ph == 15) phase_rmsnorm(p, ph == 5 ? p.ffn_norm_g : p.ffn_norm_g + DM);
    else if (ph == 8 || ph == 18) phase_peer_topk(p, smem);
    else if (ph == 9 || ph == 19) phase_peer_experts(p, ph == 19 ? 1 : 0, ph == 19 ? p.final_g : p.odd_norm_g, ph == 19 ? 1 : 0, smem);
    else if (ph == 11) phase_rnn_gates(p, smem);
    else if (ph == 13) phase_rnn_scan_b(p);
}

__global__ void __launch_bounds__(512, 2) mega(Params p_by_value) {
    char* smem = dyn_lds + hidx_() * 65536;
    volatile LAS unsigned* hs_all = (volatile LAS unsigned*)(dyn_lds + 131072);
    const __attribute__((address_space(4))) Params* kp = (const __attribute__((address_space(4))) Params*)__builtin_amdgcn_kernarg_segment_ptr();
    const int ph0 = (int)kp->ph0, ph1 = (int)kp->ph1;
    if (threadIdx.x < 12) hs_all[threadIdx.x] = 0u;
    __syncthreads();
    XcdBarrier xb = xcd_barrier_post(kp->BAR, hs_all + 8);
    for (int ph = ph0; ph < ph1; ++ph) {
        if (ph == 12 || ph == 7 || ph == 17) continue;
        const __attribute__((address_space(4))) Params* q = kp;
        asm volatile("" : "+s"(q));
        PRef p = *q;
#if PROBE_PH >= 0
        if (blockIdx.x == 0 && threadIdx.x == 0) p.TS[ph] = __builtin_amdgcn_s_memrealtime();
#endif
        const int reps = ((DUP_MASK >> ph) & 1) ? 2 : 1;
        for (int r = 0; r < reps; ++r) { run_phase(p, ph, smem); if (r + 1 < reps) xcd_barrier(xb); }
        if (ph + 1 < ph1) xcd_barrier(xb);
    }
    PRef p = *kp;
#if PROBE_PH >= 0
    cg::this_grid().sync();
    if (blockIdx.x == 0 && threadIdx.x == 0) { p.TS[NPHASE] = __builtin_amdgcn_s_memrealtime(); __threadfence(); }
    cg::this_grid().sync();
    {
        const unsigned long long t0 = __hip_atomic_load(&p.TS[0], __ATOMIC_RELAXED, __HIP_MEMORY_SCOPE_AGENT), t1 = __hip_atomic_load(&p.TS[NPHASE], __ATOMIC_RELAXED, __HIP_MEMORY_SCOPE_AGENT);
        const unsigned long long a = __hip_atomic_load(&p.TS[PROBE_PH], __ATOMIC_RELAXED, __HIP_MEMORY_SCOPE_AGENT), b = __hip_atomic_load(&p.TS[PROBE_PH + PROBE_N], __ATOMIC_RELAXED, __HIP_MEMORY_SCOPE_AGENT);
        const float frac = (float)(b - a) / (float)(t1 - t0);
        const float scale = 1.1f + frac;
        for (size_t i = (size_t)blockIdx.x * 512 + threadIdx.x; i < (size_t)TOK * DM; i += (size_t)gridDim.x * 512) p.out[i] *= scale;
    }
#endif
}

constexpr int DYN_LDS_BYTES = 131072 + 64;
extern "C" void kernel_launch(void* const* d_in, const int* in_sizes, int n_in, void* d_out, int out_size, void* d_ws, size_t ws_size, hipStream_t stream) {
    Params p; memset(&p, 0, sizeof(p));
    const float* const* in = (const float* const*)d_in;
    p.x = in[0]; p.even_norm_g = in[1]; p.even_w_in = in[2]; p.even_b_f = in[3]; p.even_cmp_pos = in[4]; p.even_w_cmp_k = in[5]; p.even_w_cmp_v = in[6]; p.even_w_out = in[7];
    p.odd_norm_g = in[8]; p.odd_w_in = in[9]; p.odd_conv_w = in[10]; p.odd_conv_b = in[11]; p.odd_w_ra = in[12]; p.odd_b_ra = in[13]; p.odd_w_ri = in[14]; p.odd_b_ri = in[15];
    p.odd_lam = in[16]; p.odd_w_out = in[17]; p.ffn_norm_g = in[18]; p.peer_w_q = in[19]; p.peer_sub_keys = in[20]; p.peer_u = in[21]; p.peer_v = in[22]; p.final_g = in[23];
    p.out = (float*)d_out;
    char* ws = (char*)d_ws; size_t off = 0;
    auto take = [&](size_t bytes) { char* r = ws + off; off += (bytes + 255) & ~(size_t)255; return r; };
    p.WtE = (h16*)take((size_t)ZLD * 1024 * 2); p.WtV = (h16*)take((size_t)768 * 1024 * 2); p.WtEo = (h16*)take((size_t)1024 * 1024 * 2); p.WtO = (h16*)take((size_t)2560 * 1024 * 2); p.WtOo = (h16*)take((size_t)1024 * 1280 * 2);
    p.WtQ = (h16*)take((size_t)2 * 2048 * 1024 * 2); p.Wc = (h16*)take((size_t)2 * 64 * 2048 * 2); p.Wr = (h16*)take((size_t)20 * 16384 * 2); p.Keys = (h16*)take((size_t)2 * 8 * 2 * 128 * 128 * 2);
    p.Pos16 = (h16*)take(4096); p.U8 = (unsigned char*)take((size_t)2 * 16384 * 1024); p.V8 = (unsigned char*)take((size_t)2 * 16384 * 1024);
    p.US = (float*)take((size_t)2 * 16384 * 4); p.VS = (float*)take((size_t)2 * 16384 * 4);
    p.H = (float*)take((size_t)TOK * DM * 4); p.HN = (h16*)take((size_t)TOK * DM * 2);
    const size_t scratch0 = off;
    p.Z = (h16*)take((size_t)TOK * ZLD * 2); p.VtF = (h16*)take((size_t)4 * 8 * 64 * SEQ * 2); p.VtS = (h16*)take((size_t)4 * 2 * 64 * SEQ * 2); p.VtW = (h16*)take((size_t)4 * 2 * 64 * SEQ * 2);
    p.KC = (h16*)take((size_t)8 * 256 * 64 * 2); p.VCt = (h16*)take((size_t)8 * 64 * 256 * 2); p.O = (h16*)take((size_t)TOK * DM * 2); p.FG = (float*)take((size_t)TOK * 32 * 4); p.C2 = (float*)take((size_t)32 * SEQ * 4); p.OACC = (float*)take((size_t)TOK * 512 * 4);
    size_t mx = off;
    off = scratch0;
    p.QP = (h16*)take((size_t)TOK * 2048 * 2); p.SC = (h16*)take((size_t)TOK * 2048 * 2); p.IDS = (int*)take((size_t)TOK * 128 * 4); p.GW = (float*)take((size_t)TOK * 128 * 4);
    if (off > mx) mx = off;
    off = scratch0;
    p.Z2 = (h16*)take((size_t)TOK * Z2LD * 2); p.LA = (h16*)take((size_t)TOK * DRNN * 2); p.RU = (h16*)take((size_t)TOK * DRNN * 2);
    p.AggP = (float*)take((size_t)4 * 64 * DRNN * 4); p.AggH = (float*)take((size_t)4 * 64 * DRNN * 4);
    if (off > mx) mx = off;
    off = mx; p.TS = (unsigned long long*)take(256); p.BAR = (unsigned*)take(XCD_BAR_WORDS * 4 + 256); mx = off;
    if (mx > ws_size) { fprintf(stderr, "workspace too small: need %zu have %zu\n", mx, ws_size); return; }

    static int grid_blocks = 0;
    if (!grid_blocks) {
        int dev = 0, cus = 0, per_cu = 0;
        hipGetDevice(&dev);
        hipDeviceGetAttribute(&cus, hipDeviceAttributeMultiprocessorCount, dev);
        hipFuncSetAttribute((const void*)mega, hipFuncAttributeMaxDynamicSharedMemorySize, DYN_LDS_BYTES);
        hipOccupancyMaxActiveBlocksPerMultiprocessor(&per_cu, mega, 512, DYN_LDS_BYTES);
        if (per_cu > 1) per_cu = 1;
        if (per_cu < 1) per_cu = 1;
        grid_blocks = cus * per_cu;
    }
    hipMemsetAsync(p.BAR, 0, XCD_BAR_WORDS * 4 + 256, stream);
#if SINGLE_LAUNCH
    p.ph0 = 0; p.ph1 = NPHASE;
    void* args[] = {&p};
    hipError_t e = hipLaunchCooperativeKernel((void*)mega, dim3(grid_blocks), dim3(512), args, DYN_LDS_BYTES, stream);
    if (e != hipSuccess) fprintf(stderr, "cooperative launch failed: %s (grid %d)\n", hipGetErrorString(e), grid_blocks);
#else
    for (int ph = 0; ph < NPHASE; ++ph) {
        p.ph0 = ph; p.ph1 = ph + 1;
        hipLaunchKernelGGL(mega, dim3(grid_blocks), dim3(512), DYN_LDS_BYTES, stream, p);
    }
#endif
}
```

```cpp
#include <hip/hip_runtime.h>
#include <hip/hip_cooperative_groups.h>
#include <cstdio>
#include <cstdint>
#include <cstring>
namespace cg = cooperative_groups;

#ifndef SINGLE_LAUNCH
#define SINGLE_LAUNCH 1
#endif
#ifndef PROBE_PH
#define PROBE_PH -1
#endif
#ifndef PROBE_N
#define PROBE_N 1
#endif
#ifndef DUP_MASK
#define DUP_MASK 0
#endif

typedef _Float16 h16;
typedef _Float16 half8 __attribute__((ext_vector_type(8)));
typedef _Float16 half4 __attribute__((ext_vector_type(4)));
typedef _Float16 half2v __attribute__((ext_vector_type(2)));
typedef float f32x4 __attribute__((ext_vector_type(4)));
typedef float f32x16 __attribute__((ext_vector_type(16)));
typedef unsigned long long u64;
typedef int i32x4 __attribute__((ext_vector_type(4)));
typedef float f32x2 __attribute__((ext_vector_type(2)));
typedef float f32x32 __attribute__((ext_vector_type(32)));
typedef _Float16 h16x32 __attribute__((ext_vector_type(32)));
typedef unsigned u32x6 __attribute__((ext_vector_type(6)));
typedef int i32x2 __attribute__((ext_vector_type(2)));
typedef i32x4 __attribute__((aligned(8))) i32x4_a8;

#define NTHR 256
constexpr int BATCH = 4, SEQ = 4096, DM = 1024, TOK = BATCH * SEQ;
constexpr int ZLD = 2304, Z2LD = 2560, DRNN = 1280;
constexpr int EVEN_IN = 2848;
constexpr float LOG2E = 1.4426950408889634f;
constexpr float QSCALE = 0.125f * LOG2E;
constexpr float NEGBIG = -1.0e30f;
constexpr int KST = 72;
constexpr int NPHASE = 20;
constexpr int XCD_BAR_WORDS_C = 3456;

struct Params {
    const float *x, *even_norm_g, *even_w_in, *even_b_f, *even_cmp_pos, *even_w_cmp_k, *even_w_cmp_v, *even_w_out;
    const float *odd_norm_g, *odd_w_in, *odd_conv_w, *odd_conv_b, *odd_w_ra, *odd_b_ra, *odd_w_ri, *odd_b_ri, *odd_lam, *odd_w_out;
    const float *ffn_norm_g, *peer_w_q, *peer_sub_keys, *peer_u, *peer_v, *final_g;
    float* out;
    h16 *WtE, *WtV, *WtEo, *WtO, *WtOo, *WtQ, *Wc, *Wr, *Keys, *Pos16;
    unsigned char *U8, *V8; float *US, *VS;
    float* H; h16* HN;
    h16 *Z, *VtF, *VtS, *VtW, *KC, *VCt, *O; float *FG, *C2, *OACC;
    h16* QP; h16* SC; int* IDS; float* GW;
    h16* Z2; h16 *LA, *RU; float *AggP, *AggH;
    unsigned long long* TS; unsigned* BAR;
    long long ph0, ph1;
};

typedef const __attribute__((address_space(4))) Params& PRef;
extern __shared__ __attribute__((aligned(16))) char dyn_lds[];
#define GRIDV ((int)gridDim.x * 2)
#define LAS __attribute__((address_space(3)))
__device__ __forceinline__ int hidx_() { return __builtin_amdgcn_readfirstlane((int)threadIdx.x >> 8); }
__device__ __forceinline__ int tidx_() { int t = threadIdx.x & 255; asm volatile("" : "+v"(t)); return t; }
__device__ __forceinline__ int bidx_() { int b = blockIdx.x * 2 + hidx_(); asm volatile("" : "+s"(b)); return b; }
__device__ __forceinline__ int widx_() { return __builtin_amdgcn_readfirstlane(((int)threadIdx.x >> 6) & 3); }
__device__ __forceinline__ void hsync() {
    volatile LAS unsigned* w = (volatile LAS unsigned*)(dyn_lds + 131072 + hidx_() * 16);
    asm volatile("s_waitcnt lgkmcnt(0)" ::: "memory");
    if ((threadIdx.x & 63) == 0) {
        const unsigned old = __hip_atomic_fetch_add((LAS unsigned*)w, 1u, __ATOMIC_RELAXED, __HIP_MEMORY_SCOPE_WORKGROUP);
        const unsigned target = (old | 3u) + 1u;
        while ((int)(w[0] - target) < 0) { }
    }
    asm volatile("s_waitcnt lgkmcnt(0)" ::: "memory");
}

__device__ __forceinline__ float wave_sum(float v) {
#pragma unroll
    for (int o = 32; o > 0; o >>= 1) v += __shfl_xor(v, o);
    return v;
}
__device__ __forceinline__ int mbcnt64(u64 m) { return __builtin_amdgcn_mbcnt_hi((unsigned)(m >> 32), __builtin_amdgcn_mbcnt_lo((unsigned)m, 0)); }
__device__ __forceinline__ float gelu_exact(float v) { return 0.5f * v * (1.0f + erff(v * 0.70710678118654752f)); }
__device__ __forceinline__ float sigmoidf_(float v) { return 1.0f / (1.0f + __expf(-v)); }
__device__ __forceinline__ float log_sigmoid(float v) { return v >= 0.f ? -log1pf(expf(-v)) : v - log1pf(expf(v)); }
__device__ __forceinline__ int crow(int r, int hi) { return (r & 3) + 8 * (r >> 2) + 4 * hi; }
__device__ __forceinline__ f32x16 zero16() { f32x16 z;
#pragma unroll
    for (int i = 0; i < 16; ++i) z[i] = 0.f; return z; }

__device__ __forceinline__ void rms_write_h16(const float (&v)[16], const float* __restrict__ g, h16* __restrict__ dst, int lane) {
    float ss = 0.f;
#pragma unroll
    for (int i = 0; i < 16; ++i) ss += v[i] * v[i];
    ss = wave_sum(ss);
    const float rstd = rsqrtf(ss * (1.0f / 1024.0f) + 1e-6f);
#pragma unroll
    for (int hseg = 0; hseg < 2; ++hseg) {
        const int c0 = hseg * 512 + lane * 8;
        const f32x4 g0 = *(const f32x4*)(g + c0), g1 = *(const f32x4*)(g + c0 + 4);
        half8 o;
#pragma unroll
        for (int i = 0; i < 4; ++i) { o[i] = (h16)(v[hseg * 8 + i] * rstd * g0[i]); o[4 + i] = (h16)(v[hseg * 8 + 4 + i] * rstd * g1[i]); }
        *(half8*)(dst + c0) = o;
    }
}
__device__ __forceinline__ void load_row16(const float* __restrict__ src, float (&v)[16], int lane) {
#pragma unroll
    for (int hseg = 0; hseg < 2; ++hseg) {
        const int c0 = hseg * 512 + lane * 8;
        const f32x4 a = *(const f32x4*)(src + c0), b = *(const f32x4*)(src + c0 + 4);
#pragma unroll
        for (int i = 0; i < 4; ++i) { v[hseg * 8 + i] = a[i]; v[hseg * 8 + 4 + i] = b[i]; }
    }
}

__device__ __forceinline__ int even_col_map(int n, int kind) {
    if (kind == 2) {
        if (n < 512) return 1024 + n;
        if (n < 640) return 2056 + 3 * 128 + (n - 512);
        return 2056 + 5 * 128 + (n - 640);
    }
    if (n < 1024) return n;
    if (n < 1536) return 1544 + (n - 1024);
    if (n < 1664) return 2056 + (n - 1536);
    if (n < 1792) return 2056 + 128 + (n - 1664);
    if (n < 1920) return 2056 + 256 + (n - 1792);
    if (n < 2048) return 2056 + 512 + (n - 1920);
    if (n < 2056) return 1536 + (n - 2048);
    if (n < 2080) return 2824 + (n - 2056);
    return -1;
}
__device__ __forceinline__ void transpose_job(const float* __restrict__ src, int K, int N, h16* __restrict__ dst, int Ndst, int mapped, float* tileS, int& base, int b0) {
    const int tid = tidx_(), nb = (int)GRIDV - b0, bid = bidx_() - b0;
    const int nkt = K / 64, nnt = Ndst / 64, ntiles = nkt * nnt;
    int first = (bid - (base % nb) + nb) % nb;
    for (int tile = first; tile < ntiles; tile += nb) {
        const int k0 = (tile % nkt) * 64, n0 = (tile / nkt) * 64;
#pragma unroll
        for (int i = 0; i < 16; ++i) {
            const int e = tid + 256 * i, kk = e >> 6, nn = e & 63;
            const int sc = mapped ? even_col_map(n0 + nn, mapped) : (n0 + nn);
            tileS[kk * 65 + nn] = (sc >= 0) ? src[(size_t)(k0 + kk) * N + sc] : 0.f;
        }
        hsync();
        const int n = tid >> 2, ks = (tid & 3) * 16;
        half8 o0, o1;
#pragma unroll
        for (int i = 0; i < 8; ++i) { o0[i] = (h16)tileS[(ks + i) * 65 + n]; o1[i] = (h16)tileS[(ks + 8 + i) * 65 + n]; }
        h16* d = dst + (size_t)(n0 + n) * K + k0 + ks;
        *(half8*)d = o0; *(half8*)(d + 8) = o1;
        hsync();
    }
    base += ntiles;
}
__device__ __forceinline__ void convert_job(const float* __restrict__ src, h16* __restrict__ dst, size_t n) {
    const size_t n4 = n / 4, stride = (size_t)GRIDV * NTHR;
    for (size_t i = (size_t)bidx_() * NTHR + tidx_(); i < n4; i += stride) {
        const f32x4 v = *(const f32x4*)(src + 4 * i);
        half4 o; o[0] = (h16)v[0]; o[1] = (h16)v[1]; o[2] = (h16)v[2]; o[3] = (h16)v[3];
        *(half4*)(dst + 4 * i) = o;
    }
}
constexpr int ROW6 = 768;
template <int NP>
__device__ __forceinline__ void fp6_rows(const float* __restrict__ src, unsigned char* __restrict__ dst, float* __restrict__ scl, const int (&rps)[NP], int lane) {
    const int hh = lane >> 5, g = lane & 31;
    f32x4 v[NP][8];
#pragma unroll
    for (int q = 0; q < NP; ++q)
#pragma unroll
        for (int c = 0; c < 8; ++c) v[q][c] = *(const f32x4*)(src + (size_t)(rps[q] * 2 + hh) * 1024 + c * 128 + g * 4);
#pragma unroll
    for (int q = 0; q < NP; ++q) {
        float am = 0.f;
#pragma unroll
        for (int c = 0; c < 8; ++c) am = fmaxf(am, fmaxf(fmaxf(fabsf(v[q][c][0]), fabsf(v[q][c][1])), fmaxf(fabsf(v[q][c][2]), fabsf(v[q][c][3]))));
#pragma unroll
        for (int o = 16; o > 0; o >>= 1) am = fmaxf(am, __shfl_xor(am, o));
        const float sc = am > 0.f ? am * (1.0f / 7.5f) : 1.0f, inv = 1.0f / sc;
        h16x32 hv;
#pragma unroll
        for (int c = 0; c < 8; ++c)
#pragma unroll
            for (int j = 0; j < 4; ++j) hv[4 * c + j] = (h16)(v[q][c][j] * inv);
        const u32x6 pk = __builtin_amdgcn_cvt_scalef32_pk32_fp6_f16(hv, 1.0f);
        unsigned char* o = dst + (size_t)(rps[q] * 2 + hh) * ROW6;
        *(i32x4*)(o + g * 16) = (i32x4){(int)pk[0], (int)pk[1], (int)pk[2], (int)pk[3]};
        *(i32x2*)(o + 512 + g * 8) = (i32x2){(int)pk[4], (int)pk[5]};
        if (g == 0) scl[rps[q] * 2 + hh] = sc;
    }
}
__device__ __forceinline__ void fp6_rows_job(const float* __restrict__ src, unsigned char* __restrict__ dst, float* __restrict__ scl, int npairs, int wv0) {
    const int lane = tidx_() & 63, wv = bidx_() * 4 + widx_() - wv0, nwv = GRIDV * 4 - wv0;
    if (wv < 0) return;
    int r = wv;
    for (; r + nwv < npairs; r += 2 * nwv) { const int rps[2] = {r, r + nwv}; fp6_rows<2>(src, dst, scl, rps, lane); }
    for (; r < npairs; r += nwv) { const int rps[1] = {r}; fp6_rows<1>(src, dst, scl, rps, lane); }
}
__device__ __forceinline__ void weight_jobs(PRef p, char* smem, bool first_only, int b0) {
    float* tileS = (float*)smem;
    int base = 0;
    const int jlo = 0, jhi = 28;
    for (int job = jlo; job < jhi; ++job) {
        if (first_only != (job == 0 || job == 4 || job == 6 || job == 7)) continue;
        const float* src; int K, N, Nd; h16* dst; int mapped = 0;
        if (job == 0) { src = p.even_w_in; K = 1024; N = EVEN_IN; dst = p.WtE; Nd = ZLD; mapped = 1; }
        else if (job == 1) { src = p.even_w_out; K = 1024; N = 1024; dst = p.WtEo; Nd = 1024; }
        else if (job == 2) { src = p.odd_w_in; K = 1024; N = 2560; dst = p.WtO; Nd = 2560; }
        else if (job == 3) { src = p.odd_w_out; K = 1280; N = 1024; dst = p.WtOo; Nd = 1024; }
        else if (job == 4) { src = p.even_w_in; K = 1024; N = EVEN_IN; dst = p.WtV; Nd = 768; mapped = 2; }
        else if (job == 5) continue;
        else if (job == 6) { src = p.even_w_cmp_k; K = 2048; N = 64; dst = p.Wc; Nd = 64; }
        else if (job == 7) { src = p.even_w_cmp_v; K = 2048; N = 64; dst = p.Wc + 64 * 2048; Nd = 64; }
        else if (job < 18) { const int n = job - 8; src = p.odd_w_ra + n * 16384; K = 128; N = 128; dst = p.Wr + n * 16384; Nd = 128; }
        else { const int n = job - 18; src = p.odd_w_ri + n * 16384; K = 128; N = 128; dst = p.Wr + (10 + n) * 16384; Nd = 128; }
        transpose_job(src, K, N, dst, Nd, mapped, tileS, base, b0);
    }
}
__device__ __forceinline__ void phase_prep(PRef p, char* smem) {
    weight_jobs(p, smem, true, 0);
    convert_job(p.peer_sub_keys, p.Keys, (size_t)2 * 8 * 2 * 128 * 128);
    convert_job(p.even_cmp_pos, p.Pos16, 2048);
    const int lane = tidx_() & 63, wv = bidx_() * 4 + widx_(), nwv = GRIDV * 4;
    for (int row = wv; row < TOK; row += nwv) {
        float v[16]; load_row16(p.x + (size_t)row * DM, v, lane);
        rms_write_h16(v, p.even_norm_g, p.HN + (size_t)row * DM, lane);
    }
}

enum { EPI_EVEN_IN = 0, EPI_F32_RESID = 1, EPI_H16 = 2, EPI_F32T = 3, EPI_QSCORE = 4 };
struct GemmArgs {
    const h16* A; int lda; const h16* Bt; int ldb; int M, N, K; int a_ntile_stride;
    int mode; h16* c16; int ldc16; float* c32; int ldc32; const float* resid; const h16* aux;
};
template <int MODE, int LDC>
__device__ __forceinline__ void gemm_epilogue(PRef p, const GemmArgs& g, int mt, int nt, bool sw, const f32x4 (&acc)[4][4]) {
    const int lane = tidx_() & 63, wid = widx_(), wm = wid >> 1, wn = wid & 1;
    const int l4 = (lane >> 4) * 4, l15 = lane & 15;
    if (MODE == EPI_EVEN_IN) {
        int kind;
        if (nt < 4 || (nt >= 12 && nt < 16)) kind = 0; else if (nt >= 8 && nt < 12) kind = 2; else if (nt == 19) kind = 3; else if (nt == 21) kind = 4; else if (nt == 22) kind = 5; else kind = 1;
#pragma unroll
        for (int i = 0; i < 4; ++i)
#pragma unroll
            for (int j = 0; j < 4; ++j) {
                const f32x4 v = acc[i][j];
                if (kind <= 1) {
                    const int row = mt * 128 + wm * 64 + j * 16 + l15, col = nt * 128 + wn * 64 + i * 16 + l4;
                    const float sc = kind == 0 ? QSCALE : 1.0f;
                    half4 o; o[0] = (h16)(v[0] * sc); o[1] = (h16)(v[1] * sc); o[2] = (h16)(v[2] * sc); o[3] = (h16)(v[3] * sc);
                    *(half4*)(p.Z + (size_t)row * ZLD + col) = o;
                } else if (kind <= 4) {
                    const int row = mt * 128 + wm * 64 + i * 16 + l4, col = nt * 128 + wn * 64 + j * 16 + l15;
                    const int b = row >> 12, s = row & 4095;
                    half4 o; o[0] = (h16)v[0]; o[1] = (h16)v[1]; o[2] = (h16)v[2]; o[3] = (h16)v[3];
                    h16* dst;
                    if (kind == 2) { const int c = col - 1024; dst = p.VtF + ((size_t)(b * 8 + (c >> 6)) * 64 + (c & 63)) * SEQ + s; }
                    else if (kind == 3) { const int c = col - 2432; dst = p.VtS + ((size_t)(b * 2 + (c >> 6)) * 64 + (c & 63)) * SEQ + s; }
                    else { const int c = col - 2688; dst = p.VtW + ((size_t)(b * 2 + (c >> 6)) * 64 + (c & 63)) * SEQ + s; }
                    *(half4*)dst = o;
                } else {
                    const int row = mt * 128 + wm * 64 + j * 16 + l15, c = nt * 128 + wn * 64 + i * 16 + l4 - 2816;
                    if (c < 32) {
                        f32x4 o;
                        if (c < 8) {
#pragma unroll
                            for (int q = 0; q < 4; ++q) o[q] = log_sigmoid(v[q] + p.even_b_f[c + q]) * LOG2E;
                        } else {
#pragma unroll
                            for (int q = 0; q < 4; ++q) o[q] = sigmoidf_(v[q]);
                        }
                        *(f32x4*)(p.FG + (size_t)row * 32 + c) = o;
                    }
                }
            }
    } else {
#pragma unroll
        for (int i = 0; i < 4; ++i)
#pragma unroll
            for (int j = 0; j < 4; ++j) {
                const f32x4 v = acc[i][j];
                if (MODE == EPI_F32T) {
                    const int row = mt * 128 + wm * 64 + i * 16 + l4, col = nt * 128 + wn * 64 + j * 16 + l15;
                    *(f32x4*)(g.c32 + (size_t)col * TOK + row) = v;
                } else {
                    const int row = mt * 128 + wm * 64 + j * 16 + l15, col = nt * 128 + wn * 64 + i * 16 + l4;
                    if (MODE == EPI_F32_RESID) {
                        const f32x4 r = *(const f32x4*)(g.resid + (size_t)row * LDC + col);
                        *(f32x4*)(g.c32 + (size_t)row * LDC + col) = r + v;
                    } else {
                        half4 o; o[0] = (h16)v[0]; o[1] = (h16)v[1]; o[2] = (h16)v[2]; o[3] = (h16)v[3];
                        *(half4*)(g.c16 + (size_t)row * LDC + col) = o;
                    }
                }
            }
    }
}

template <int MODE, int LDA, int LDB, int GN, int GK, int LDC, int ANS>
__device__ __forceinline__ void phase_gemm(PRef p, const GemmArgs& g, char* smem) {
    h16* As = (h16*)smem;
    h16* Bs = As + 2 * 128 * 64;
    const int tid = tidx_(), lane = tid & 63, wid = widx_(), wm = wid >> 1, wn = wid & 1;
    constexpr int nM = TOK / 128, nN = GN / 128, ntiles = nM * nN, nk = GK / 64;
    const int lr = tid >> 3, lc = tid & 7;
    const int st_off = lr * 64 + ((lc ^ ((tid >> 4) & 7)) * 8);
    const int fsw = (lane & 15) >> 1;
    const int fo0 = (lane & 15) * 64 + ((((lane >> 4)) ^ fsw) * 8), fo1 = (lane & 15) * 64 + (((4 + (lane >> 4)) ^ fsw) * 8);
    for (int tile = bidx_(); tile < ntiles; tile += GRIDV) {
        const int mt = tile / nN, nt = tile % nN;
        bool sw = (MODE != EPI_F32T);
        if (MODE == EPI_EVEN_IN) sw = !((nt >= 8 && nt < 12) || nt == 19 || nt == 21);
        const h16* Ag = g.A + (size_t)(mt * 128 + lr) * LDA + (size_t)nt * ANS + lc * 8;
        const h16* Bg = g.Bt + (size_t)(nt * 128 + lr) * LDB + lc * 8;
        constexpr size_t a32 = (size_t)32 * LDA, b32 = (size_t)32 * LDB;
        f32x4 acc[4][4];
#pragma unroll
        for (int m = 0; m < 4; ++m)
#pragma unroll
            for (int n = 0; n < 4; ++n) acc[m][n] = (f32x4){0.f, 0.f, 0.f, 0.f};
        half8 ra[4], rb[4];
#pragma unroll
        for (int i = 0; i < 4; ++i) { ra[i] = *(const half8*)(Ag + i * a32); rb[i] = *(const half8*)(Bg + i * b32); }
#pragma unroll
        for (int i = 0; i < 4; ++i) { *(half8*)(As + st_off + i * 32 * 64) = ra[i]; *(half8*)(Bs + st_off + i * 32 * 64) = rb[i]; }
        hsync();
        const int pofs = (sw ? wn : wm) * 64 * 64, qofs = (sw ? wm : wn) * 64 * 64;
        for (int kt = 0; kt < nk; ++kt) {
            const int cur = kt & 1;
            if (kt + 1 < nk) {
                const int ko = (kt + 1) * 64;
#pragma unroll
                for (int i = 0; i < 4; ++i) { ra[i] = *(const half8*)(Ag + i * a32 + ko); rb[i] = *(const half8*)(Bg + i * b32 + ko); }
            }
            const h16* Pc = (sw ? Bs : As) + cur * 128 * 64 + pofs;
            const h16* Qc = (sw ? As : Bs) + cur * 128 * 64 + qofs;
#pragma unroll
            for (int ks = 0; ks < 2; ++ks) {
                const int fo = ks ? fo1 : fo0;
                half8 pf[4], qf[4];
#pragma unroll
                for (int i = 0; i < 4; ++i) { pf[i] = *(const half8*)(Pc + i * 16 * 64 + fo); qf[i] = *(const half8*)(Qc + i * 16 * 64 + fo); }
                __builtin_amdgcn_s_setprio(1);
#pragma unroll
                for (int i = 0; i < 4; ++i)
#pragma unroll
                    for (int j = 0; j < 4; ++j) acc[i][j] = __builtin_amdgcn_mfma_f32_16x16x32_f16(pf[i], qf[j], acc[i][j], 0, 0, 0);
                __builtin_amdgcn_s_setprio(0);
            }
            if (kt + 1 < nk) {
                const int nx = (cur ^ 1) * 128 * 64;
#pragma unroll
                for (int i = 0; i < 4; ++i) { *(half8*)(As + nx + st_off + i * 32 * 64) = ra[i]; *(half8*)(Bs + nx + st_off + i * 32 * 64) = rb[i]; }
            }
            hsync();
        }
        if (MODE == EPI_QSCORE) {
            constexpr int QST = 136;
            h16* Qs = (h16*)smem;
            const int l4 = (lane >> 4) * 4, l15 = lane & 15;
#pragma unroll
            for (int i = 0; i < 4; ++i)
#pragma unroll
                for (int j = 0; j < 4; ++j) {
                    const f32x4 v = acc[i][j];
                    half4 o; o[0] = (h16)v[0]; o[1] = (h16)v[1]; o[2] = (h16)v[2]; o[3] = (h16)v[3];
                    *(half4*)(Qs + (wm * 64 + j * 16 + l15) * QST + wn * 64 + i * 16 + l4) = o;
                }
            hsync();
            f32x4 sc[4][4];
#pragma unroll
            for (int i = 0; i < 4; ++i)
#pragma unroll
                for (int j = 0; j < 4; ++j) sc[i][j] = (f32x4){0.f, 0.f, 0.f, 0.f};
            const h16* kb = g.aux + (size_t)(nt * 128 + wn * 64 + l15) * 128 + (lane >> 4) * 8;
#pragma unroll
            for (int ks = 0; ks < 4; ++ks) {
                half8 pf[4], qf[4];
#pragma unroll
                for (int i = 0; i < 4; ++i) { pf[i] = *(const half8*)(Qs + (wm * 64 + i * 16 + l15) * QST + ks * 32 + (lane >> 4) * 8); qf[i] = *(const half8*)(kb + (size_t)i * 16 * 128 + ks * 32); }
#pragma unroll
                for (int i = 0; i < 4; ++i)
#pragma unroll
                    for (int j = 0; j < 4; ++j) sc[i][j] = __builtin_amdgcn_mfma_f32_16x16x32_f16(pf[i], qf[j], sc[i][j], 0, 0, 0);
            }
#pragma unroll
            for (int i = 0; i < 4; ++i)
#pragma unroll
                for (int j = 0; j < 4; ++j) {
                    const int row = mt * 128 + wm * 64 + i * 16 + l4, col = nt * 128 + wn * 64 + j * 16 + l15;
                    *(f32x4*)(g.c32 + (size_t)col * TOK + row) = sc[i][j];
                }
            hsync();
        } else
        gemm_epilogue<MODE, LDC>(p, g, mt, nt, sw, acc);
    }
}

__device__ __forceinline__ void wp_job(PRef p, int wv0) {
    const int lane = tidx_() & 63, wv = bidx_() * 4 + widx_() - wv0, nwv = GRIDV * 4 - wv0;
    if (wv < 0) return;
    for (int u = wv; u < 1024; u += nwv) {
        const int l = u >> 9, hc = (u >> 5) & 15, kh = (u >> 4) & 1, jt = u & 15;
        const float* wq = p.peer_w_q + (size_t)l * 1024 * 2048 + (size_t)(jt * 64 + (lane & 15)) * 2048 + hc * 128 + (lane >> 4) * 8;
        const h16* ky = p.Keys + ((size_t)(l * 16 + hc) * 128 + kh * 64 + (lane & 15)) * 128 + (lane >> 4) * 8;
        f32x4 acc[4][4];
#pragma unroll
        for (int a = 0; a < 4; ++a)
#pragma unroll
            for (int b = 0; b < 4; ++b) acc[a][b] = (f32x4){0.f, 0.f, 0.f, 0.f};
#pragma unroll
        for (int ks = 0; ks < 4; ++ks) {
            half8 af[4], bf[4];
#pragma unroll
            for (int a = 0; a < 4; ++a) {
                const f32x4 w0 = *(const f32x4*)(wq + (size_t)a * 16 * 2048 + ks * 32), w1 = *(const f32x4*)(wq + (size_t)a * 16 * 2048 + ks * 32 + 4);
#pragma unroll
                for (int q = 0; q < 4; ++q) { af[a][q] = (h16)w0[q]; af[a][4 + q] = (h16)w1[q]; }
                bf[a] = *(const half8*)(ky + (size_t)a * 16 * 128 + ks * 32);
            }
#pragma unroll
            for (int a = 0; a < 4; ++a)
#pragma unroll
                for (int b = 0; b < 4; ++b) acc[a][b] = __builtin_amdgcn_mfma_f32_16x16x32_f16(af[a], bf[b], acc[a][b], 0, 0, 0);
        }
        h16* wp = p.WtQ + (size_t)l * 2048 * 1024;
#pragma unroll
        for (int a = 0; a < 4; ++a)
#pragma unroll
            for (int b = 0; b < 4; ++b) {
                const int n = hc * 128 + kh * 64 + b * 16 + (lane & 15), j0 = jt * 64 + a * 16 + (lane >> 4) * 4;
                half4 o; o[0] = (h16)acc[a][b][0]; o[1] = (h16)acc[a][b][1]; o[2] = (h16)acc[a][b][2]; o[3] = (h16)acc[a][b][3];
                *(half4*)(wp + (size_t)n * 1024 + j0) = o;
            }
    }
}
__device__ __forceinline__ void phase_cumsum_compress(PRef p, char* smem) {
    const int lane = tidx_() & 63, wid = widx_(), vb = bidx_();
    if (vb >= 256 && vb < 264) {
        const int u = (vb - 256) * 4 + wid, b = u >> 3, h = u & 7;
        const float* src = p.FG + (size_t)(b * SEQ + lane * 64) * 32 + h;
        float loc[64]; float run = 0.f;
#pragma unroll
        for (int i = 0; i < 64; ++i) { run += src[(size_t)i * 32]; loc[i] = run; }
        float incl = run;
#pragma unroll
        for (int o = 1; o < 64; o <<= 1) { const float t = __shfl_up(incl, o); if (lane >= o) incl += t; }
        const float excl = incl - run;
        float* dst = p.C2 + (size_t)(b * 8 + h) * SEQ + lane * 64;
#pragma unroll
        for (int i = 0; i < 64; ++i) dst[i] = excl + loc[i];
    }
    if (vb < 256) {
        const int cu = vb, kv = cu >> 7, bg = (cu >> 4) & 7, nt = cu & 15;
        const int b = bg >> 1, g = bg & 1;
        int n = nt * 16 + (lane & 15); const int nc = n < 255 ? n : 254;
        const h16* Ab = p.Z + (size_t)(b * SEQ + 16 * nc) * ZLD + 1536 + kv * 128 + g * 64 + (lane >> 4) * 8;
        const h16* Wb = p.Wc + (size_t)kv * 64 * 2048 + (size_t)(lane & 15) * 2048 + (lane >> 4) * 8;
        const h16* Pb = p.Pos16 + (lane >> 4) * 8;
        f32x4 acc[4];
#pragma unroll
        for (int e = 0; e < 4; ++e) acc[e] = (f32x4){0.f, 0.f, 0.f, 0.f};
#pragma unroll
        for (int k2 = 0; k2 < 16; ++k2) {
            const int ks = wid * 16 + k2, l = ks >> 1, d0 = (ks & 1) * 32;
            half8 a = *(const half8*)(Ab + (size_t)l * ZLD + d0);
            const half8 ps = *(const half8*)(Pb + ks * 32);
            a = a + ps;
#pragma unroll
            for (int e = 0; e < 4; ++e) {
                const half8 w = *(const half8*)(Wb + (size_t)e * 16 * 2048 + ks * 32);
                acc[e] = __builtin_amdgcn_mfma_f32_16x16x32_f16(a, w, acc[e], 0, 0, 0);
            }
        }
        f32x4* part = (f32x4*)smem;
#pragma unroll
        for (int e = 0; e < 4; ++e) part[(wid * 4 + e) * 64 + lane] = acc[e];
        hsync();
        {
            const int e = wid;
            const f32x4 s = (part[(0 * 4 + e) * 64 + lane] + part[(1 * 4 + e) * 64 + lane]) + (part[(2 * 4 + e) * 64 + lane] + part[(3 * 4 + e) * 64 + lane]);
            const int n0 = nt * 16 + (lane >> 4) * 4, ec = e * 16 + (lane & 15);
            if (kv == 0) {
#pragma unroll
                for (int j = 0; j < 4; ++j) p.KC[((size_t)bg * 256 + n0 + j) * 64 + ec] = (n0 + j < 255) ? (h16)s[j] : (h16)0.f;
            } else {
                half4 o;
#pragma unroll
                for (int j = 0; j < 4; ++j) o[j] = (n0 + j < 255) ? (h16)s[j] : (h16)0.f;
                *(half4*)(p.VCt + ((size_t)bg * 64 + ec) * 256 + n0) = o;
            }
        }
        hsync();
    }
    weight_jobs(p, smem, false, 0);
    wp_job(p, 0);
    fp6_rows_job(p.peer_u, p.U8, p.US, 8192, 0);
    fp6_rows_job(p.peer_v, p.V8, p.VS, 8192, 0);
}

struct RowState { float m, l; f32x16 o0, o1; };
__device__ __forceinline__ void rs_reset(RowState& s) { s.m = NEGBIG; s.l = 0.f; s.o0 = zero16(); s.o1 = zero16(); }

__device__ __forceinline__ void kv_load(const h16* kb, int kst, const h16* vb, int vst, half8 (&kr)[2], half8 (&vr)[2]) {
    const int tid = tidx_();
#pragma unroll
    for (int i = 0; i < 2; ++i) {
        const int c = tid + 256 * i, row = c >> 3, cc = (c & 7) * 8;
        kr[i] = *(const half8*)(kb + (size_t)row * kst + cc);
        vr[i] = *(const half8*)(vb + (size_t)row * vst + cc);
    }
}
__device__ __forceinline__ void kv_store(h16* Ks, h16* Vs, const half8 (&kr)[2], const half8 (&vr)[2]) {
    const int tid = tidx_();
#pragma unroll
    for (int i = 0; i < 2; ++i) {
        const int c = tid + 256 * i, row = c >> 3, cc = (c & 7) * 8;
        *(half8*)(Ks + row * KST + cc) = kr[i];
        *(half8*)(Vs + row * KST + cc) = vr[i];
    }
}
__device__ __forceinline__ void qk_tile(const h16* Ks, const half8 (&qf)[4], f32x16 (&s)[2], int lane) {
    const int r32 = lane & 31, hh = lane >> 5;
#pragma unroll
    for (int kt = 0; kt < 2; ++kt) {
        s[kt] = zero16();
#pragma unroll
        for (int ks = 0; ks < 4; ++ks) {
            const half8 kf = *(const half8*)(Ks + (kt * 32 + r32) * KST + ks * 16 + hh * 8);
            s[kt] = __builtin_amdgcn_mfma_f32_32x32x16_f16(kf, qf[ks], s[kt], 0, 0, 0);
        }
    }
}
__device__ __forceinline__ void pv_tile(const h16* Vs, const f32x16 (&pr)[2], f32x16& o0, f32x16& o1, int lane) {
    const int r32 = lane & 31, hh = lane >> 5;
#pragma unroll
    for (int kt = 0; kt < 2; ++kt)
#pragma unroll
        for (int s2 = 0; s2 < 2; ++s2) {
            half8 pf;
#pragma unroll
            for (int j = 0; j < 8; ++j) pf[j] = (h16)pr[kt][8 * s2 + j];
            const int kof = kt * 32 + 16 * s2 + 4 * hh;
            {
                const half4 a = *(const half4*)(Vs + r32 * KST + kof), b = *(const half4*)(Vs + r32 * KST + kof + 8);
                half8 vf; vf[0] = a[0]; vf[1] = a[1]; vf[2] = a[2]; vf[3] = a[3]; vf[4] = b[0]; vf[5] = b[1]; vf[6] = b[2]; vf[7] = b[3];
                o0 = __builtin_amdgcn_mfma_f32_32x32x16_f16(vf, pf, o0, 0, 0, 0);
            }
            {
                const half4 a = *(const half4*)(Vs + (32 + r32) * KST + kof), b = *(const half4*)(Vs + (32 + r32) * KST + kof + 8);
                half8 vf; vf[0] = a[0]; vf[1] = a[1]; vf[2] = a[2]; vf[3] = a[3]; vf[4] = b[0]; vf[5] = b[1]; vf[6] = b[2]; vf[7] = b[3];
                o1 = __builtin_amdgcn_mfma_f32_32x32x16_f16(vf, pf, o1, 0, 0, 0);
            }
        }
}

enum { M_FOX = 0, M_SLC = 1, M_WIN = 2 };
template <int MODE, bool MASKED>
__device__ __forceinline__ void flash_step(const h16* Ks, const h16* Vs, const float* csS, const half8 (&qf)[4], RowState& st,
                                           int t, int kpos0, float slope2, float ct2, bool selbit, int lane) {
    const int hh = lane >> 5;
    f32x16 s[2];
    qk_tile(Ks, qf, s, lane);
    int dbase = t - kpos0 - 4 * hh;
    asm volatile("" : "+v"(dbase));
    const float off = (MODE == M_FOX) ? ct2 : -slope2 * (float)dbase;
    float mx = NEGBIG;
#pragma unroll
    for (int kt = 0; kt < 2; ++kt)
#pragma unroll
        for (int r = 0; r < 16; ++r) {
            const int c = kt * 32 + (r & 3) + 8 * (r >> 2);
            float v;
            if (MODE == M_FOX) v = s[kt][r] - csS[c + 4 * hh];
            else v = fmaf(slope2, (float)c, s[kt][r]);
            if (MASKED) {
                const int dist = dbase - c;
                bool valid;
                if (MODE == M_FOX) valid = dist >= 0; else if (MODE == M_SLC) valid = selbit && dist >= 0; else valid = dist >= 0 && dist < 512;
                v = valid ? v : NEGBIG;
            }
            s[kt][r] = v;
            mx = fmaxf(mx, v);
        }
    mx += off;
    mx = fmaxf(mx, __shfl_xor(mx, 32));
    const bool rowoff = (MODE == M_SLC) && !MASKED && !selbit;
    if (rowoff) mx = NEGBIG;
    const float mn = fmaxf(st.m, mx);
    const float alpha = __builtin_amdgcn_exp2f(st.m - mn);
    st.m = mn;
    const float moff = rowoff ? 1.0e30f : mn - off;
    float ps = 0.f;
#pragma unroll
    for (int kt = 0; kt < 2; ++kt)
#pragma unroll
        for (int r = 0; r < 16; ++r) {
            const float v = s[kt][r];
            float pe = __builtin_amdgcn_exp2f(v - moff);
            if (MASKED) pe = v > -1.0e29f ? pe : 0.f;
            s[kt][r] = pe; ps += pe;
        }
    st.l = st.l * alpha + ps;
#pragma unroll
    for (int r = 0; r < 16; ++r) { st.o0[r] *= alpha; st.o1[r] *= alpha; }
    pv_tile(Vs, s, st.o0, st.o1, lane);
}

template <int MODE>
__device__ __forceinline__ void run_flash(u64 mask, const h16* Kg, int kst, const h16* Vg, int vst, const float* csg, char* smem,
                                          const half8 (&qf)[4], RowState& st, int t, int twlo, int twhi, float slope2, float ct2, u64 sel, int lane) {
    h16* Kb = (h16*)smem; h16* Vb = Kb + 2 * 64 * KST; float* csb = (float*)(Vb + 2 * 64 * KST);
    if (mask == 0ull) return;
    half8 kr[2], vr[2]; float csr = 0.f;
    int jc = __builtin_ctzll(mask); mask &= mask - 1;
    kv_load(Kg + (size_t)jc * 64 * kst, kst, Vg + jc * 64, vst, kr, vr);
    if (MODE == M_FOX && tidx_() < 64) csr = csg[jc * 64 + tidx_()];
    kv_store(Kb, Vb, kr, vr);
    if (MODE == M_FOX && tidx_() < 64) csb[tidx_()] = csr;
    hsync();
    int buf = 0;
    for (;;) {
        int jn = -1;
        if (mask) { jn = __builtin_ctzll(mask); mask &= mask - 1; }
        if (jn >= 0) {
            kv_load(Kg + (size_t)jn * 64 * kst, kst, Vg + jn * 64, vst, kr, vr);
            if (MODE == M_FOX && tidx_() < 64) csr = csg[jn * 64 + tidx_()];
        }
        bool need = jc * 64 <= twhi;
        if (MODE == M_WIN) need = need && (jc * 64 + 63 >= twlo - 511);
        if (need) {
            const bool selbit = (sel >> jc) & 1ull;
            bool full = jc * 64 + 63 <= twlo;
            if (MODE == M_WIN) full = full && (jc * 64 > twhi - 512);
            if (full) flash_step<MODE, false>(Kb + buf * 64 * KST, Vb + buf * 64 * KST, csb + buf * 64, qf, st, t, jc * 64, slope2, ct2, selbit, lane);
            else flash_step<MODE, true>(Kb + buf * 64 * KST, Vb + buf * 64 * KST, csb + buf * 64, qf, st, t, jc * 64, slope2, ct2, selbit, lane);
        }
        if (jn >= 0) {
            kv_store(Kb + (buf ^ 1) * 64 * KST, Vb + (buf ^ 1) * 64 * KST, kr, vr);
            if (MODE == M_FOX && tidx_() < 64) csb[(buf ^ 1) * 64 + tidx_()] = csr;
        }
        hsync();
        if (jn < 0) break;
        jc = jn; buf ^= 1;
    }
}

__device__ __forceinline__ void load_q(const h16* qrow, half8 (&qf)[4], int lane) {
#pragma unroll
    for (int ks = 0; ks < 4; ++ks) qf[ks] = *(const half8*)(qrow + ks * 16 + (lane >> 5) * 8);
}
__device__ __forceinline__ void store_o(h16* orow, const f32x16& o0, const f32x16& o1, int lane) {
    const int hh = lane >> 5;
#pragma unroll
    for (int rg = 0; rg < 4; ++rg) {
        half4 a, b;
#pragma unroll
        for (int j = 0; j < 4; ++j) { a[j] = (h16)o0[4 * rg + j]; b[j] = (h16)o1[4 * rg + j]; }
        *(half4*)(orow + 8 * rg + 4 * hh) = a;
        *(half4*)(orow + 32 + 8 * rg + 4 * hh) = b;
    }
}

__device__ __forceinline__ void oacc_store(float* row, const f32x16& o0, const f32x16& o1, float sc, int lane) {
    const int hh = lane >> 5;
#pragma unroll
    for (int rg = 0; rg < 4; ++rg) {
        *(f32x4*)(row + 8 * rg + 4 * hh) = (f32x4){o0[4 * rg] * sc, o0[4 * rg + 1] * sc, o0[4 * rg + 2] * sc, o0[4 * rg + 3] * sc};
        *(f32x4*)(row + 32 + 8 * rg + 4 * hh) = (f32x4){o1[4 * rg] * sc, o1[4 * rg + 1] * sc, o1[4 * rg + 2] * sc, o1[4 * rg + 3] * sc};
    }
}
__device__ __forceinline__ void oacc_add(float* row, const f32x16& o0, const f32x16& o1, float sc, int lane) {
    const int hh = lane >> 5;
#pragma unroll
    for (int rg = 0; rg < 4; ++rg) {
        f32x4 a = *(const f32x4*)(row + 8 * rg + 4 * hh), b = *(const f32x4*)(row + 32 + 8 * rg + 4 * hh);
#pragma unroll
        for (int j = 0; j < 4; ++j) { a[j] += o0[4 * rg + j] * sc; b[j] += o1[4 * rg + j] * sc; }
        *(f32x4*)(row + 8 * rg + 4 * hh) = a; *(f32x4*)(row + 32 + 8 * rg + 4 * hh) = b;
    }
}
__device__ __forceinline__ void oacc_final(const float* row, h16* orow, const f32x16& o0, const f32x16& o1, float sc, int lane) {
    const int hh = lane >> 5;
#pragma unroll
    for (int rg = 0; rg < 4; ++rg) {
        const f32x4 a = *(const f32x4*)(row + 8 * rg + 4 * hh), b = *(const f32x4*)(row + 32 + 8 * rg + 4 * hh);
        half4 x, y;
#pragma unroll
        for (int j = 0; j < 4; ++j) { x[j] = (h16)(a[j] + o0[4 * rg + j] * sc); y[j] = (h16)(b[j] + o1[4 * rg + j] * sc); }
        *(half4*)(orow + 8 * rg + 4 * hh) = x; *(half4*)(orow + 32 + 8 * rg + 4 * hh) = y;
    }
}

__device__ __forceinline__ void fox_unit(PRef p, int b, int h, int qt, char* smem) {
    const int tid = tidx_(), lane = tid & 63, wid = widx_();
    const int q0 = qt * 128, t0w = q0 + wid * 32, t = t0w + (lane & 31);
    half8 qf[4]; load_q(p.Z + (size_t)(b * SEQ + t) * ZLD + h * 64, qf, lane);
    const float* csg = p.C2 + (size_t)(b * 8 + h) * SEQ;
    const float ct2 = csg[t];
    RowState st; rs_reset(st);
    const int jmax = (q0 + 127) >> 6;
    const u64 mask = (jmax >= 63) ? ~0ull : ((1ull << (jmax + 1)) - 1ull);
    run_flash<M_FOX>(mask, p.Z + (size_t)b * SEQ * ZLD + 512 + h * 64, ZLD, p.VtF + (size_t)(b * 8 + h) * 64 * SEQ, SEQ, csg, smem,
                     qf, st, t, t0w, t0w + 31, 0.f, ct2, 0ull, lane);
    const float lt = st.l + __shfl_xor(st.l, 32);
    const float inv = 1.0f / lt;
#pragma unroll
    for (int r = 0; r < 16; ++r) { st.o0[r] *= inv; st.o1[r] *= inv; }
    store_o(p.O + (size_t)(b * SEQ + t) * DM + h * 64, st.o0, st.o1, lane);
}

__device__ __forceinline__ void nsa_unit(PRef p, int b, int g, int qt32, char* smem) {
    const int tid = tidx_(), lane = tid & 63, wid = widx_(), hh = lane >> 5, r32 = lane & 31;
    const int t0 = qt32 * 32, t = t0 + r32, head = g * 4 + wid, bg = b * 2 + g;
    const float slope2 = exp2f(-(float)(head + 1)) * LOG2E;
    half8 qf[4]; load_q(p.Z + (size_t)(b * SEQ + t) * ZLD + 1024 + head * 64, qf, lane);
    const float* gp = p.FG + (size_t)(b * SEQ + t) * 32 + 8 + head * 3;
    const float gate_c = gp[0], gate_s = gp[1], gate_w = gp[2];
    h16* Kb = (h16*)smem; h16* Vb = Kb + 2 * 64 * KST;
    u64* selS = (u64*)(smem + 37376);
    u64* unS = selS + 32;
    float* oaccrow = p.OACC + (size_t)(b * SEQ + t) * 512 + head * 64;
    unsigned* impS = (unsigned*)(smem + 37888);
    {
        for (int i = tid; i < 32 * 64; i += NTHR) impS[i] = 0u;
        const int nsteps = ((t0 >> 4) >> 6) + 1;
        const h16* Kg = p.KC + (size_t)bg * 256 * 64; const h16* Vg = p.VCt + (size_t)bg * 64 * 256;
        float mrun = NEGBIG, lrun = 0.f;
        for (int i = 0; i < nsteps; ++i) {
            half8 kr[2], vr[2];
            kv_load(Kg + (size_t)i * 64 * 64, 64, Vg + i * 64, 256, kr, vr);
            kv_store(Kb, Vb, kr, vr);
            hsync();
            f32x16 s[2];
            qk_tile(Kb, qf, s, lane);
            float mx = NEGBIG;
            int dbase = t - 31 - 16 * (i * 64 + 4 * hh);
            asm volatile("" : "+v"(dbase));
#pragma unroll
            for (int kt = 0; kt < 2; ++kt)
#pragma unroll
                for (int r = 0; r < 16; ++r) {
                    const int dist = dbase - 16 * (kt * 32 + (r & 3) + 8 * (r >> 2));
                    float v = s[kt][r] - slope2 * (float)dist;
                    v = dist >= 0 ? v : NEGBIG;
                    s[kt][r] = v; mx = fmaxf(mx, v);
                }
            mx = fmaxf(mx, __shfl_xor(mx, 32));
            const float mn = fmaxf(mrun, mx), alpha = __builtin_amdgcn_exp2f(mrun - mn);
            mrun = mn;
            float ps = 0.f;
#pragma unroll
            for (int kt = 0; kt < 2; ++kt)
#pragma unroll
                for (int r = 0; r < 16; ++r) { const float v = s[kt][r]; ps += v > -1.0e29f ? __builtin_amdgcn_exp2f(v - mn) : 0.f; }
            lrun = lrun * alpha + ps;
            hsync();
        }
        const float lt = lrun + __shfl_xor(lrun, 32);
        const float inv = lt > 0.f ? 1.0f / lt : 0.f;
        f32x16 o0 = zero16(), o1 = zero16();
        float carry = 0.f;
        for (int i = 0; i < nsteps; ++i) {
            half8 kr[2], vr[2];
            kv_load(Kg + (size_t)i * 64 * 64, 64, Vg + i * 64, 256, kr, vr);
            kv_store(Kb, Vb, kr, vr);
            hsync();
            f32x16 s[2];
            qk_tile(Kb, qf, s, lane);
            int dbase = t - 31 - 16 * (i * 64 + 4 * hh);
            asm volatile("" : "+v"(dbase));
#pragma unroll
            for (int kt = 0; kt < 2; ++kt)
#pragma unroll
                for (int r = 0; r < 16; ++r) {
                    const int dist = dbase - 16 * (kt * 32 + (r & 3) + 8 * (r >> 2));
                    const float v = s[kt][r] - slope2 * (float)dist;
                    s[kt][r] = dist >= 0 ? __builtin_amdgcn_exp2f(v - mrun) * inv : 0.f;
                }
            float R[2][4];
#pragma unroll
            for (int kt = 0; kt < 2; ++kt)
#pragma unroll
                for (int rg = 0; rg < 4; ++rg) R[kt][rg] = __shfl_xor(s[kt][4 * rg + 3], 32);
#pragma unroll
            for (int kt = 0; kt < 2; ++kt)
#pragma unroll
                for (int rg = 0; rg < 4; ++rg) {
                    const float G = (s[kt][4 * rg] + s[kt][4 * rg + 1]) + (s[kt][4 * rg + 2] + s[kt][4 * rg + 3]);
                    const float prev = (kt == 0 && rg == 0) ? carry : (rg > 0 ? R[kt][rg - 1] : R[kt - 1][3]);
                    const float val = G + (hh ? R[kt][rg] : prev);
                    const int j = 16 * i + 8 * kt + 2 * rg + hh;
                    atomicAdd(&impS[r32 * 64 + j], (unsigned)(val * 67108864.0f + 0.5f));
                }
            carry = R[1][3];
            pv_tile(Vb, s, o0, o1, lane);
            hsync();
        }
        oacc_store(oaccrow, o0, o1, gate_c, lane);
    }
    hsync();
    {
        u64 un = 0ull;
        for (int i = 0; i < 8; ++i) {
            const int tok = wid * 8 + i, tt = t0 + tok, cur = tt >> 6;
            const int j = lane;
            const bool valid = j <= cur;
            const bool forced = (j == 0) || (j == cur) || (j == cur - 1);
            const unsigned key = valid ? impS[tok * 64 + j] + (forced ? 0x40000000u : 0u) : 0u;
            int rank = 0;
            for (int jj = 0; jj < 64; ++jj) {
                const unsigned kv = (unsigned)__builtin_amdgcn_readlane((int)key, jj);
                rank += (kv > key || (kv == key && jj < j)) ? 1 : 0;
            }
            const u64 selm = __ballot(valid && rank < 16);
            if (lane == 0) selS[tok] = selm;
            un |= selm;
        }
        if (lane == 0) unS[wid] = un;
    }
    hsync();
    const u64 mysel = selS[r32];
    const u64 un = unS[0] | unS[1] | unS[2] | unS[3];
    hsync();
    {
        RowState st; rs_reset(st);
        run_flash<M_SLC>(un, p.Z + (size_t)b * SEQ * ZLD + 1792 + g * 64, ZLD, p.VtS + (size_t)bg * 64 * SEQ, SEQ, nullptr, smem,
                         qf, st, t, t0, t0 + 31, slope2, 0.f, mysel, lane);
        const float lt = st.l + __shfl_xor(st.l, 32);
        oacc_add(oaccrow, st.o0, st.o1, gate_s / lt, lane);
    }
    {
        RowState st; rs_reset(st);
        const int lo = t0 - 511, jlo = lo > 0 ? (lo >> 6) : 0, jhi = (t0 + 31) >> 6;
        u64 mask = (jhi >= 63 ? ~0ull : ((1ull << (jhi + 1)) - 1ull)) & ~((1ull << jlo) - 1ull);
        run_flash<M_WIN>(mask, p.Z + (size_t)b * SEQ * ZLD + 1920 + g * 64, ZLD, p.VtW + (size_t)bg * 64 * SEQ, SEQ, nullptr, smem,
                         qf, st, t, t0, t0 + 31, slope2, 0.f, 0ull, lane);
        const float lt = st.l + __shfl_xor(st.l, 32);
        oacc_final(oaccrow, p.O + (size_t)(b * SEQ + t) * DM + 512 + head * 64, st.o0, st.o1, gate_w / lt, lane);
    }
}

__device__ __forceinline__ void phase_attention(PRef p, char* smem) {
    int* nxt = (int*)(smem + 65536 - 16);
    for (;;) {
        if (tidx_() == 0) *nxt = (int)__hip_atomic_fetch_add(p.BAR + XCD_BAR_WORDS_C, 1u, __ATOMIC_RELAXED, __HIP_MEMORY_SCOPE_AGENT);
        hsync();
        const int q = *nxt;
        hsync();
        if (q >= 2048 + 512) break;
        if (q < 2048 && (q & 3) == 3) {
            const int c = q >> 2, rp0 = (c & 255) * 32 + widx_() * 8, lane = tidx_() & 63;
            const float* srcp = (c < 256 ? p.peer_u : p.peer_v) + (size_t)16384 * 1024;
            unsigned char* dstp = (c < 256 ? p.U8 : p.V8) + (size_t)16384 * 1024;
            float* sclp = (c < 256 ? p.US : p.VS) + 16384;
            for (int i = 0; i < 8; i += 2) { const int rps[2] = {rp0 + i, rp0 + i + 1}; fp6_rows<2>(srcp, dstp, sclp, rps, lane); }
            continue;
        }
        const int u = q < 2048 ? q - ((q + 1) >> 2) : q - 512;
        const int st = 31 - (u >> 6), w = u & 63;
        if (w & 1) { const int idx = w >> 1; nsa_unit(p, (idx & 7) >> 1, idx & 1, st * 4 + (idx >> 3), smem); }
        else { const int idx = w >> 1; fox_unit(p, idx >> 3, idx & 7, st, smem); }
    }
}

__device__ __forceinline__ void phase_rmsnorm(PRef p, const float* g) {
    const int lane = tidx_() & 63, wv = bidx_() * 4 + widx_(), nwv = GRIDV * 4;
    for (int row = wv; row < TOK; row += nwv) {
        float v[16]; load_row16(p.H + (size_t)row * DM, v, lane);
        rms_write_h16(v, g, p.HN + (size_t)row * DM, lane);
    }
}

__device__ __forceinline__ unsigned fkey(float f) { const unsigned b = __float_as_uint(f); return b ^ ((b >> 31) ? 0xFFFFFFFFu : 0x80000000u); }
__device__ __forceinline__ float fkey_inv(unsigned k) { return __uint_as_float(k ^ ((k >> 31) ? 0x80000000u : 0xFFFFFFFFu)); }
__device__ __forceinline__ void ce_desc(unsigned& a, unsigned& b) { const unsigned hi = a > b ? a : b, lo = a > b ? b : a; a = hi; b = lo; }
__device__ __forceinline__ void sort16_desc(unsigned (&k)[16]) {
#pragma unroll
    for (int size = 2; size <= 16; size <<= 1)
#pragma unroll
        for (int stride = size >> 1; stride > 0; stride >>= 1)
#pragma unroll
            for (int i = 0; i < 16; ++i) {
                const int j = i ^ stride;
                if (j > i) { if ((i & size) == 0) ce_desc(k[i], k[j]); else ce_desc(k[j], k[i]); }
            }
}
__device__ __forceinline__ void merge16_desc(unsigned (&run)[16], const unsigned (&b)[16]) {
#pragma unroll
    for (int i = 0; i < 16; ++i) run[i] = run[i] > b[15 - i] ? run[i] : b[15 - i];
#pragma unroll
    for (int stride = 8; stride > 0; stride >>= 1)
#pragma unroll
        for (int i = 0; i < 16; ++i) { const int j = i ^ stride; if (j > i) ce_desc(run[i], run[j]); }
}
__device__ __forceinline__ void list_top16(const h16* __restrict__ base, unsigned (&run)[16]) {
    half8 cur0 = *(const half8*)base, cur1 = *(const half8*)(base + 512), nxt0 = cur0, nxt1 = cur1;
#pragma unroll 1
    for (int bt = 0; bt < 8; ++bt) {
        if (bt < 7) { nxt0 = *(const half8*)(base + (size_t)(2 * bt + 2) * 512); nxt1 = *(const half8*)(base + (size_t)(2 * bt + 3) * 512); }
        unsigned kb[16];
#pragma unroll
        for (int i = 0; i < 8; ++i) {
            kb[i] = (fkey((float)cur0[i]) & ~127u) | (unsigned)(127 - (bt * 16 + i));
            kb[8 + i] = (fkey((float)cur1[i]) & ~127u) | (unsigned)(127 - (bt * 16 + 8 + i));
        }
        sort16_desc(kb);
        if (bt == 0) {
#pragma unroll
            for (int i = 0; i < 16; ++i) run[i] = kb[i];
        } else merge16_desc(run, kb);
        cur0 = nxt0; cur1 = nxt1;
    }
}
__device__ __forceinline__ void phase_peer_topk(PRef p, char* smem) {
    const int tid = tidx_(), lane = tid & 63, wv = bidx_() * 4 + widx_(), nwv = GRIDV * 4;
    int* idS = (int*)smem; float* evS = (float*)smem + 16 * NTHR;
    for (int u = wv; u < 8 * (TOK / 64); u += nwv) {
        const int h = u >> 8, tk = (u & 255) * 64 + lane;
        const h16* b0 = p.SC + ((size_t)((tk >> 6) * 256 + h * 32) * 64 + lane) * 8;
        unsigned k0[16], k1[16];
        list_top16(b0, k0);
        list_top16(b0 + 16 * 512, k1);
        float v0[16], v1[16]; int i0[16], i1[16];
#pragma unroll
        for (int j = 0; j < 16; ++j) {
            v0[j] = fkey_inv(k0[j] & ~127u); i0[j] = 127 - (int)(k0[j] & 127u);
            v1[j] = fkey_inv(k1[j] & ~127u); i1[j] = 127 - (int)(k1[j] & 127u);
        }
        unsigned run[16];
        {
            unsigned kb[16]; int n = 0, nb = 0;
#pragma unroll
            for (int a = 0; a < 16; ++a)
#pragma unroll
                for (int b = 0; b < 16; ++b)
                    if ((a + 1) * (b + 1) <= 16) {
                        kb[n] = fkey(v0[a] + v1[b]); ++n;
                        if (n == 16) {
                            sort16_desc(kb);
                            if (nb == 0) {
#pragma unroll
                                for (int i = 0; i < 16; ++i) run[i] = kb[i];
                            } else merge16_desc(run, kb);
                            n = 0; ++nb;
                        }
                    }
#pragma unroll
            for (int i = 2; i < 16; ++i) kb[i] = 0u;
            sort16_desc(kb); merge16_desc(run, kb);
        }
        const unsigned tkey = run[15]; const float smax = fkey_inv(run[0]);
        int cnt = 0; float esum = 0.f;
#pragma unroll
        for (int j = 0; j < 16; ++j) { idS[j * NTHR + tid] = 0; evS[j * NTHR + tid] = 0.f; }
#pragma unroll
        for (int pass = 0; pass < 2; ++pass)
#pragma unroll
            for (int a = 0; a < 16; ++a)
#pragma unroll
                for (int b = 0; b < 16; ++b)
                    if ((a + 1) * (b + 1) <= 16) {
                        const float s = v0[a] + v1[b]; const unsigned ks = fkey(s);
                        const bool take = pass == 0 ? (ks > tkey) : (ks == tkey && cnt < 16);
                        if (take) {
                            const float e = __expf(s - smax);
                            idS[cnt * NTHR + tid] = i0[a] * 128 + i1[b]; evS[cnt * NTHR + tid] = e;
                            esum += e; ++cnt;
                        }
                    }
        const float rinv = 1.0f / esum;
        int* ip = p.IDS + (size_t)tk * 128 + h * 16; float* gp = p.GW + (size_t)tk * 128 + h * 16;
#pragma unroll
        for (int q = 0; q < 4; ++q) {
            *(i32x4*)(ip + 4 * q) = (i32x4){idS[(4 * q) * NTHR + tid], idS[(4 * q + 1) * NTHR + tid], idS[(4 * q + 2) * NTHR + tid], idS[(4 * q + 3) * NTHR + tid]};
            *(f32x4*)(gp + 4 * q) = (f32x4){evS[(4 * q) * NTHR + tid] * rinv, evS[(4 * q + 1) * NTHR + tid] * rinv, evS[(4 * q + 2) * NTHR + tid] * rinv, evS[(4 * q + 3) * NTHR + tid] * rinv};
        }
    }
}

struct Q6 { i32x4 a; i32x2 b; };
__device__ __forceinline__ Q6 ld6(const unsigned char* row, int g) { Q6 r; r.a = *(const i32x4*)(row + g * 16); r.b = *(const i32x2*)(row + 512 + g * 8); return r; }
__device__ __forceinline__ u32x6 mk6(const Q6 q) { u32x6 r; r[0] = q.a[0]; r[1] = q.a[1]; r[2] = q.a[2]; r[3] = q.a[3]; r[4] = q.b[0]; r[5] = q.b[1]; return r; }
__device__ __forceinline__ float dot32_fp6h(const h16x32 xv, const Q6 q) {
    const h16x32 uf = __builtin_amdgcn_cvt_scalef32_pk32_f16_fp6(mk6(q), 1.0f);
    float d0 = 0.f, d1 = 0.f;
#pragma unroll
    for (int m = 0; m < 16; m += 2) {
        d0 = __builtin_amdgcn_fdot2((half2v){uf[2 * m], uf[2 * m + 1]}, (half2v){xv[2 * m], xv[2 * m + 1]}, d0, false);
        d1 = __builtin_amdgcn_fdot2((half2v){uf[2 * m + 2], uf[2 * m + 3]}, (half2v){xv[2 * m + 2], xv[2 * m + 3]}, d1, false);
    }
    return d0 + d1;
}
__device__ __forceinline__ void axpy32_fp6(f32x2 (&acc)[16], float w, const Q6 q) {
    const f32x32 vf = __builtin_amdgcn_cvt_scalef32_pk32_f32_fp6(mk6(q), 1.0f);
    const f32x2 ww = {w, w};
#pragma unroll
    for (int m = 0; m < 16; ++m) acc[m] = __builtin_elementwise_fma(ww, (f32x2){vf[2 * m], vf[2 * m + 1]}, acc[m]);
}
constexpr int ET_SHIFT = 9, ET_N = 16384 >> ET_SHIFT;
__device__ __forceinline__ void phase_peer_experts(PRef p, int layer, const float* gnext, int mode, char* smem) {
    const int lane = tidx_() & 63, wid = widx_(), wv = bidx_() * 4 + wid, nwv = GRIDV * 4;
    const int hh = lane >> 5, g = lane & 31, dpl = (lane >> 2) & 7;
    const unsigned char* U = p.U8 + (size_t)layer * 16384 * 1024; const unsigned char* V = p.V8 + (size_t)layer * 16384 * 1024;
    const float* US = p.US + layer * 16384; const float* VS = p.VS + layer * 16384;
    const bool b4 = (lane & 16) != 0, b3 = (lane & 8) != 0, b2 = (lane & 4) != 0;
    int* sid = (int*)smem + wid * 512 + hh * 128;
    float* sgw = (float*)(sid + 256);
    for (int tb = wv * 2; tb < TOK; tb += nwv * 2) {
        const int tk = tb + hh;
        h16x32 xv;
#pragma unroll
        for (int c = 0; c < 8; ++c) {
            const half4 t = *(const half4*)(p.HN + (size_t)tk * DM + c * 128 + g * 4);
#pragma unroll
            for (int j = 0; j < 4; ++j) xv[4 * c + j] = t[j];
        }
        {
            int idv[4]; float gv[4];
#pragma unroll
            for (int s = 0; s < 4; ++s) { idv[s] = p.IDS[(size_t)tk * 128 + s * 32 + g]; gv[s] = p.GW[(size_t)tk * 128 + s * 32 + g]; }
            int cnt = 0;
            const unsigned below = (1u << g) - 1u;
            for (int e = 0; e < ET_N; ++e) {
#pragma unroll
                for (int s = 0; s < 4; ++s) {
                    const bool in = (idv[s] >> ET_SHIFT) == e;
                    const u64 m = __ballot(in);
                    const unsigned mh = hh ? (unsigned)(m >> 32) : (unsigned)m;
                    if (in) { const int pos = cnt + __popc(mh & below); sid[pos] = idv[s]; sgw[pos] = gv[s]; }
                    cnt += __popc(mh);
                }
            }
        }
        f32x2 acc[16];
#pragma unroll
        for (int i = 0; i < 16; ++i) acc[i] = (f32x2){0.f, 0.f};
        for (int bt = 0; bt < 16; ++bt) {
            const int mine = sid[bt * 8 + dpl]; const float gwm = sgw[bt * 8 + dpl];
            const float usm = US[mine], vsm = VS[mine];
            const i32x4 ida = *(const i32x4*)(sid + bt * 8), idb = *(const i32x4*)(sid + bt * 8 + 4);
            Q6 uq[8], vq[8];
#pragma unroll
            for (int k = 0; k < 8; ++k) {
                const unsigned off = (unsigned)(k < 4 ? ida[k & 3] : idb[k & 3]) * ROW6;
                uq[k] = ld6(U + off, g); vq[k] = ld6(V + off, g);
            }
            float d[8];
#pragma unroll
            for (int k = 0; k < 8; ++k) d[k] = dot32_fp6h(xv, uq[k]);
            float r4[4], r2[2], z;
#pragma unroll
            for (int i = 0; i < 4; ++i) { const float keep = b4 ? d[i + 4] : d[i], send = b4 ? d[i] : d[i + 4]; r4[i] = keep + __shfl_xor(send, 16); }
#pragma unroll
            for (int i = 0; i < 2; ++i) { const float keep = b3 ? r4[i + 2] : r4[i], send = b3 ? r4[i] : r4[i + 2]; r2[i] = keep + __shfl_xor(send, 8); }
            { const float keep = b2 ? r2[1] : r2[0], send = b2 ? r2[0] : r2[1]; z = keep + __shfl_xor(send, 4); }
            z += __shfl_xor(z, 2); z += __shfl_xor(z, 1);
            const float wm = gwm * gelu_exact(z * usm) * vsm;
#pragma unroll
            for (int k = 0; k < 8; ++k) {
                const float w0 = __builtin_bit_cast(float, __builtin_amdgcn_readlane(__builtin_bit_cast(int, wm), 4 * k));
                const float w1 = __builtin_bit_cast(float, __builtin_amdgcn_readlane(__builtin_bit_cast(int, wm), 32 + 4 * k));
                axpy32_fp6(acc, hh ? w1 : w0, vq[k]);
            }
        }
        float hv[32];
        {
            const float* hr = p.H + (size_t)tk * DM + g * 4;
#pragma unroll
            for (int c = 0; c < 8; ++c) { const f32x4 t = *(const f32x4*)(hr + c * 128); hv[4 * c] = t[0] + acc[2 * c][0]; hv[4 * c + 1] = t[1] + acc[2 * c][1]; hv[4 * c + 2] = t[2] + acc[2 * c + 1][0]; hv[4 * c + 3] = t[3] + acc[2 * c + 1][1]; }
        }
        float ss = 0.f;
#pragma unroll
        for (int i = 0; i < 32; ++i) ss += hv[i] * hv[i];
#pragma unroll
        for (int o = 16; o > 0; o >>= 1) ss += __shfl_xor(ss, o);
        const float rstd = rsqrtf(ss * (1.0f / 1024.0f) + 1e-6f);
        const float* gr = gnext + g * 4;
        if (mode == 0) {
            float* hw = p.H + (size_t)tk * DM + g * 4;
#pragma unroll
            for (int c = 0; c < 8; ++c) {
                *(f32x4*)(hw + c * 128) = (f32x4){hv[4 * c], hv[4 * c + 1], hv[4 * c + 2], hv[4 * c + 3]};
                const f32x4 ga = *(const f32x4*)(gr + c * 128);
                half4 o;
#pragma unroll
                for (int j = 0; j < 4; ++j) o[j] = (h16)(hv[4 * c + j] * rstd * ga[j]);
                *(half4*)(p.HN + (size_t)tk * DM + c * 128 + g * 4) = o;
            }
        } else {
            float* ow = p.out + (size_t)tk * DM + g * 4;
#pragma unroll
            for (int c = 0; c < 8; ++c) { const f32x4 ga = *(const f32x4*)(gr + c * 128); *(f32x4*)(ow + c * 128) = (f32x4){hv[4 * c] * rstd * ga[0], hv[4 * c + 1] * rstd * ga[1], hv[4 * c + 2] * rstd * ga[2], hv[4 * c + 3] * rstd * ga[3]}; }
        }
    }
}

constexpr int XST = 136;
__device__ __forceinline__ float fast_sigmoid(float v) { return __builtin_amdgcn_rcpf(1.0f + __expf(-v)); }
__device__ __forceinline__ float gelu_as(float v) {
    const float av = fabsf(v), t = __builtin_amdgcn_rcpf(av * 0.2316419f + 1.0f);
    float q = t * 0.5307027145f - 0.7265760135f; q = q * t + 0.7107068705f; q = q * t - 0.142248368f; q = q * t + 0.127414796f; q = q * t;
    const float e = __builtin_amdgcn_exp2f(v * v * -0.72134752044f);
    const float m = v * (q * e);
    return v < 0.f ? m : v - m;
}
__device__ __forceinline__ void phase_rnn_gates(PRef p, char* smem) {
    h16* xcS = (h16*)smem;
    float* aggS = (float*)(smem + 64 * XST * 2);
    h16* laS = (h16*)(smem + 64 * XST * 2 + 4096);
    h16* ruS = laS + 64 * XST;
    const int tid = tidx_(), lane = tid & 63, wid = widx_();
    for (int u = bidx_(); u < 4 * 64 * 10; u += GRIDV) {
        const int nb = u % 10, ck = (u / 10) & 63, b = u / 640;
        const int s0 = ck * 64, ch0 = nb * 128;
        {
            const int c8 = (tid & 15) * 8, tq = (tid >> 4) * 4, ch = ch0 + c8;
            float w[4][8], bias[8];
#pragma unroll
            for (int j = 0; j < 4; ++j) {
                const f32x4 w0 = *(const f32x4*)(p.odd_conv_w + j * DRNN + ch), w1 = *(const f32x4*)(p.odd_conv_w + j * DRNN + ch + 4);
#pragma unroll
                for (int i = 0; i < 4; ++i) { w[j][i] = w0[i]; w[j][4 + i] = w1[i]; }
            }
            { const f32x4 b0 = *(const f32x4*)(p.odd_conv_b + ch), b1 = *(const f32x4*)(p.odd_conv_b + ch + 4);
#pragma unroll
              for (int i = 0; i < 4; ++i) { bias[i] = b0[i]; bias[4 + i] = b1[i]; } }
            half8 xin[7];
#pragma unroll
            for (int r = 0; r < 7; ++r) {
                const int sp = s0 + tq - 3 + r;
                if (sp >= 0) xin[r] = *(const half8*)(p.Z2 + (size_t)(b * SEQ + sp) * Z2LD + DRNN + ch);
                else {
#pragma unroll
                    for (int i = 0; i < 8; ++i) xin[r][i] = (h16)0.f;
                }
            }
#pragma unroll
            for (int tt = 0; tt < 4; ++tt) {
                half8 o;
#pragma unroll
                for (int i = 0; i < 8; ++i) {
                    float a = bias[i];
#pragma unroll
                    for (int j = 0; j < 4; ++j) a = fmaf(w[j][i], (float)xin[tt + j][i], a);
                    o[i] = (h16)a;
                }
                *(half8*)(xcS + (tq + tt) * XST + c8) = o;
            }
        }
        hsync();
        float bra2[2], bri2[2], sp2[2];
#pragma unroll
        for (int e = 0; e < 2; ++e) {
            const int chq = ch0 + (wid * 2 + e) * 16 + (lane & 15);
            bra2[e] = p.odd_b_ra[chq]; bri2[e] = p.odd_b_ri[chq]; sp2[e] = p.odd_lam[chq];
        }
#pragma unroll
        for (int e = 0; e < 2; ++e) sp2[e] = fmaxf(-sp2[e], 0.f) + __logf(1.0f + __expf(-fabsf(sp2[e])));
        f32x4 ar[4][2], ai[4][2];
#pragma unroll
        for (int m = 0; m < 4; ++m)
#pragma unroll
            for (int e = 0; e < 2; ++e) { ar[m][e] = (f32x4){0.f, 0.f, 0.f, 0.f}; ai[m][e] = (f32x4){0.f, 0.f, 0.f, 0.f}; }
        const h16* wr = p.Wr + (size_t)nb * 16384 + (wid * 32 + (lane & 15)) * 128 + (lane >> 4) * 8;
        const h16* wi = p.Wr + (size_t)(10 + nb) * 16384 + (wid * 32 + (lane & 15)) * 128 + (lane >> 4) * 8;
#pragma unroll
        for (int ks = 0; ks < 4; ++ks) {
            half8 a[4];
#pragma unroll
            for (int m = 0; m < 4; ++m) a[m] = *(const half8*)(xcS + (m * 16 + (lane & 15)) * XST + ks * 32 + (lane >> 4) * 8);
#pragma unroll
            for (int e = 0; e < 2; ++e) {
                const half8 w1 = *(const half8*)(wr + e * 16 * 128 + ks * 32), w2 = *(const half8*)(wi + e * 16 * 128 + ks * 32);
#pragma unroll
                for (int m = 0; m < 4; ++m) {
                    ar[m][e] = __builtin_amdgcn_mfma_f32_16x16x32_f16(a[m], w1, ar[m][e], 0, 0, 0);
                    ai[m][e] = __builtin_amdgcn_mfma_f32_16x16x32_f16(a[m], w2, ai[m][e], 0, 0, 0);
                }
            }
        }
        const int g4 = lane >> 4;
#pragma unroll
        for (int e = 0; e < 2; ++e) {
            const int cl = (wid * 2 + e) * 16 + (lane & 15);
            const float bra = bra2[e], bri = bri2[e], sp = sp2[e];
            float Ac = 1.f, Hc = 0.f;
#pragma unroll
            for (int m = 0; m < 4; ++m) {
                float A = 1.f, H = 0.f;
#pragma unroll
                for (int j = 0; j < 4; ++j) {
                    const int tt = m * 16 + g4 * 4 + j;
                    const float r = fast_sigmoid(ar[m][e][j] + bra), ig = fast_sigmoid(ai[m][e][j] + bri);
                    const h16 la16 = (h16)(-8.0f * r * sp);
                    const float a = __expf((float)la16);
                    const float xc = (float)xcS[tt * XST + cl];
                    const h16 u16 = (h16)(__builtin_amdgcn_sqrtf(fmaxf(1.0f - a * a, 0.f)) * (ig * xc));
                    laS[tt * XST + cl] = la16; ruS[tt * XST + cl] = u16;
                    H = a * H + (float)u16; A *= a;
                }
                { const float Al = __shfl_xor(A, 16), Hl = __shfl_xor(H, 16); if (g4 & 1) { H = Hl * A + H; A = Al * A; } }
                { const float Al = __shfl_xor(A, 32), Hl = __shfl_xor(H, 32); if (g4 == 3) { H = Hl * A + H; A = Al * A; } }
                Hc = Hc * A + H; Ac *= A;
            }
            if (g4 == 3) { p.AggP[(size_t)(b * 64 + ck) * DRNN + ch0 + cl] = Ac; p.AggH[(size_t)(b * 64 + ck) * DRNN + ch0 + cl] = Hc; }
        }
        hsync();
#pragma unroll
        for (int i = 0; i < 4; ++i) {
            const int q = tid + 256 * i, row = q >> 4, c8 = (q & 15) * 8;
            const size_t o = (size_t)(b * SEQ + s0 + row) * DRNN + ch0 + c8;
            *(half8*)(p.LA + o) = *(const half8*)(laS + row * XST + c8);
            *(half8*)(p.RU + o) = *(const half8*)(ruS + row * XST + c8);
        }
    }
}
__device__ __forceinline__ void phase_rnn_scan_b(PRef p) {
    for (int u = bidx_(); u < 4 * 64 * 5; u += GRIDV) {
        const int cb = u % 5, ck = (u / 5) & 63, b = u / 320;
        const int ch = cb * 256 + tidx_();
        float h = 0.f;
        {
            const float* ap = p.AggP + (size_t)(b * 64) * DRNN + ch; const float* hp = p.AggH + (size_t)(b * 64) * DRNN + ch;
            for (int c = 0; c < ck; c += 16) {
                float pa[16], ph[16];
#pragma unroll
                for (int i = 0; i < 16; ++i) { const int ci = min(c + i, ck - 1); pa[i] = ap[(size_t)ci * DRNN]; ph[i] = hp[(size_t)ci * DRNN]; }
#pragma unroll
                for (int i = 0; i < 16; ++i) { const bool ok = c + i < ck; h = (ok ? pa[i] : 1.0f) * h + (ok ? ph[i] : 0.f); }
            }
        }
        const size_t base = (size_t)(b * SEQ + ck * 64) * DRNN + ch;
        h16* zrow = p.Z2 + (size_t)(b * SEQ + ck * 64) * Z2LD;
#pragma unroll 1
        for (int i0 = 0; i0 < 64; i0 += 32) {
            h16 la[32], uu[32], gt[32];
#pragma unroll
            for (int i = 0; i < 32; ++i) { la[i] = p.LA[base + (size_t)(i0 + i) * DRNN]; uu[i] = p.RU[base + (size_t)(i0 + i) * DRNN]; gt[i] = zrow[(size_t)(i0 + i) * Z2LD + ch]; }
#pragma unroll
            for (int i = 0; i < 32; ++i) {
                h = __expf((float)la[i]) * h + (float)uu[i];
                zrow[(size_t)(i0 + i) * Z2LD + DRNN + ch] = (h16)(gelu_as((float)gt[i]) * h);
            }
        }
    }
}

#define XB_TMO      128
#define XB_XCNT(j)  (256  + 64 * (j))
#define XB_XSUB(j)  (1280 + 64 * (j))
#define XB_XGEN(j)  (2304 + 64 * (j))
#define XB_TOP      3328
#define XB_TOPGEN   3392
#define XCD_BAR_WORDS 3456
#define XB_SPIN_CAP (1u << 22)
__device__ __forceinline__ unsigned xb_ld(unsigned* p)              { return __hip_atomic_load(p, __ATOMIC_RELAXED, __HIP_MEMORY_SCOPE_AGENT); }
__device__ __forceinline__ unsigned xb_add(unsigned* p, unsigned v) { return __hip_atomic_fetch_add(p, v, __ATOMIC_RELAXED, __HIP_MEMORY_SCOPE_AGENT); }
__device__ __forceinline__ unsigned xb_xcc_id() { return (unsigned)__builtin_amdgcn_s_getreg((3 << 11) | 20) & 0xFu; }
#define XB_SPIN(cond, bar) do { unsigned _sp = 0; while (cond) { __builtin_amdgcn_s_sleep(1); \
    if ((++_sp & 255u) == 0u) { if (xb_ld(&(bar)[XB_TMO])) break; if (_sp > XB_SPIN_CAP) { atomicAdd(&(bar)[XB_TMO], 1u); break; } } } } while (0)
struct XcdBarrier { unsigned* bar; unsigned x; volatile LAS unsigned* st; };
__device__ __forceinline__ XcdBarrier xcd_barrier_post(unsigned* bar, volatile LAS unsigned* st) {
    XcdBarrier b; b.bar = bar; b.x = xb_xcc_id(); b.st = st;
    if (threadIdx.x == 0) (void)xb_add(&bar[XB_XCNT(b.x)], 1u);
    return b;
}
__device__ __forceinline__ void xcd_barrier_complete(unsigned* bar, unsigned x, unsigned& nloc, unsigned& nx) {
    const unsigned G = gridDim.x * gridDim.y * gridDim.z;
    unsigned sum, cnt, mine, sp = 0u;
    for (;;) {
        sum = 0u; cnt = 0u; mine = 0u;
#pragma unroll
        for (unsigned j = 0; j < 16; ++j) { const unsigned c = xb_ld(&bar[XB_XCNT(j)]); sum += c; cnt += (c > 0u) ? 1u : 0u; mine = (j == x) ? c : mine; }
        if (sum == G) break;
        __builtin_amdgcn_s_sleep(1);
        if ((++sp & 255u) == 0u) { if (xb_ld(&bar[XB_TMO])) break; if (sp > XB_SPIN_CAP) { atomicAdd(&bar[XB_TMO], 1u); break; } }
    }
    nloc = mine > 0u ? mine : 1u; nx = cnt > 0u ? cnt : 1u;
}
__device__ __forceinline__ void xcd_barrier(const XcdBarrier& b) {
    asm volatile("s_waitcnt vmcnt(0)" ::: "memory");
    __syncthreads();
    if (threadIdx.x == 0) {
        unsigned* bar = b.bar;
        __builtin_amdgcn_s_waitcnt(0);
        unsigned nloc = b.st[0], nx = b.st[1];
        if (nloc == 0u) { xcd_barrier_complete(bar, b.x, nloc, nx); b.st[0] = nloc; b.st[1] = nx; }
        const unsigned old = xb_add(&bar[XB_XSUB(b.x)], 1u);
        const unsigned gen = old / nloc;
        if (old + 1u == (gen + 1u) * nloc) {
            __builtin_amdgcn_fence(__ATOMIC_RELEASE, "agent");
            asm volatile("s_waitcnt vmcnt(0)" ::: "memory");
            const unsigned og = xb_add(&bar[XB_TOP], 1u);
            const unsigned tg = og / nx;
            if (og + 1u == (tg + 1u) * nx) xb_add(&bar[XB_TOPGEN], 1u);
            else XB_SPIN(xb_ld(&bar[XB_TOPGEN]) == tg, bar);
            __builtin_amdgcn_fence(__ATOMIC_ACQUIRE, "agent");
            xb_add(&bar[XB_XGEN(b.x)], 1u);
            asm volatile("s_waitcnt vmcnt(0)" ::: "memory");
        } else {
            XB_SPIN(xb_ld(&bar[XB_XGEN(b.x)]) == gen, bar);
            __builtin_amdgcn_fence(__ATOMIC_ACQUIRE, "agent");
            asm volatile("s_waitcnt vmcnt(0)" ::: "memory");
        }
    }
    __syncthreads();
}

namespace pg8 {
#define PG8_LAS __attribute__((address_space(3)))
typedef unsigned short bf16_t;
typedef short bf16x8 __attribute__((ext_vector_type(8)));
typedef unsigned u32x4 __attribute__((ext_vector_type(4)));
constexpr int BM = 256, BK = 64, HALF = 128, HTB = HALF * BK * 2  , STAGE_BYTES = 8 * HTB, NXCD = 8, WGM = 8;

__host__ __device__ __forceinline__ int lds_byte(int r, int c) { const int st = (r >> 4) * 2 + (c >> 5), rr = r & 15, cc = c & 31, ob = rr * 64 + cc * 2; return st * 1024 + (ob ^ (((ob >> 9) & 1) << 5)); }
__host__ __device__ __forceinline__ void stage_rc(int b, int& R, int& C) { const int st = b / 1024, sb = b % 1024, swz = sb ^ (((sb >> 9) & 1) << 5); R = (st >> 1) * 16 + swz / 64; C = (st & 1) * 32 + (swz % 64) / 2; }
__host__ __device__ __forceinline__ int perm32(int rho) { const int n = rho >> 4, i = rho & 15; return 8 * (i >> 2) + 4 * n + (i & 3); }

struct Unit { int pm, pn; };
struct Gemm { const bf16_t* A; const bf16_t* Bt; int M, N, K, lda; };

struct StaticOrder {
    int nM, nN, nwg, G, c;
    __host__ __device__ void init(int M, int N, int G_, int c_) { nM = M / BM; nN = N / BM; nwg = nM * nN; G = G_; c = c_; }
    __host__ __device__ bool next(int i, Unit& u) const {
        const long L = (long)i * G + c; if (L >= nwg) return false;
        int wgid = (int)L; { const int q = nwg / NXCD, r = nwg % NXCD, xcd = wgid % NXCD, off = wgid / NXCD; wgid = (xcd < r ? xcd * (q + 1) : r * (q + 1) + (xcd - r) * q) + off; }
        const int nig = WGM * nN, gid = wgid / nig, fm = gid * WGM, gsz = (nM - fm) < WGM ? (nM - fm) : WGM;
        u.pm = fm + ((wgid % nig) % gsz); u.pn = (wgid % nig) / gsz; return true;
    }
    __device__ __forceinline__ void a_ready(const Unit&) const {}
    __device__ __forceinline__ void done(const Unit&) const {}
};
__device__ __forceinline__ unsigned pk_h16(float lo, float hi) { half2v t; t[0] = (h16)lo; t[1] = (h16)hi; return __builtin_bit_cast(unsigned, t); }
struct EpiResid {
    static constexpr bool PERM = false, AFTER_DRAIN = false;
    const float* resid; float* out; int ldc;
    __device__ __forceinline__ void operator()(const f32x4 (&acc)[2][2][4][2], const Unit& u, int wr, int wc, int fr, int fq) const {
#pragma unroll
        for (int ai = 0; ai < 2; ++ai)
#pragma unroll
            for (int m = 0; m < 4; ++m) { const size_t ro = (size_t)(u.pm * BM + ai * HALF + wr * 64 + m * 16 + fr) * ldc + u.pn * BM + wc * 32 + 4 * fq;
#pragma unroll
                for (int bj = 0; bj < 2; ++bj)
#pragma unroll
                    for (int n = 0; n < 2; ++n) { const size_t o = ro + bj * HALF + n * 16; *(f32x4*)(out + o) = *(const f32x4*)(resid + o) + acc[ai][bj][m][n]; } }
    }
};
struct EpiF32 {
    static constexpr bool PERM = false, AFTER_DRAIN = false;
    float* out; size_t ldc;
    __device__ __forceinline__ void operator()(const f32x4 (&acc)[2][2][4][2], const Unit& u, int wr, int wc, int fr, int fq) const {
#pragma unroll
        for (int ai = 0; ai < 2; ++ai)
#pragma unroll
            for (int m = 0; m < 4; ++m) { const size_t ro = (size_t)(u.pm * BM + ai * HALF + wr * 64 + m * 16 + fr) * ldc + u.pn * BM + wc * 32 + 4 * fq;
#pragma unroll
                for (int bj = 0; bj < 2; ++bj)
#pragma unroll
                    for (int n = 0; n < 2; ++n) *(f32x4*)(out + ro + bj * HALF + n * 16) = acc[ai][bj][m][n]; }
    }
};
struct EpiH16 {
    static constexpr bool PERM = true, AFTER_DRAIN = false;
    h16* out; int ldc;
    __device__ __forceinline__ void operator()(const f32x4 (&acc)[2][2][4][2], const Unit& u, int wr, int wc, int fr, int fq) const {
#pragma unroll
        for (int ai = 0; ai < 2; ++ai)
#pragma unroll
            for (int m = 0; m < 4; ++m) { h16* rowp = out + (size_t)(u.pm * BM + ai * HALF + wr * 64 + m * 16 + fr) * ldc + u.pn * BM + wc * 32 + 8 * fq;
#pragma unroll
                for (int bj = 0; bj < 2; ++bj) { const f32x4 v0 = acc[ai][bj][m][0], v1 = acc[ai][bj][m][1];
                    u32x4 w; w.x = pk_h16(v0[0], v0[1]); w.y = pk_h16(v0[2], v0[3]); w.z = pk_h16(v1[0], v1[1]); w.w = pk_h16(v1[2], v1[3]);
                    *(u32x4*)(rowp + bj * HALF) = w; } }
    }
};
struct EpiSC {
    static constexpr bool PERM = true, AFTER_DRAIN = false;
    h16* out;
    __device__ __forceinline__ void operator()(const f32x4 (&acc)[2][2][4][2], const Unit& u, int wr, int wc, int fr, int fq) const {
#pragma unroll
        for (int ai = 0; ai < 2; ++ai)
#pragma unroll
            for (int m = 0; m < 4; ++m) { const int row = u.pm * BM + ai * HALF + wr * 64 + m * 16 + fr;
#pragma unroll
                for (int bj = 0; bj < 2; ++bj) { const int col = u.pn * BM + bj * HALF + wc * 32 + 8 * fq;
                    const f32x4 v0 = acc[ai][bj][m][0], v1 = acc[ai][bj][m][1];
                    u32x4 w; w.x = pk_h16(v0[0], v0[1]); w.y = pk_h16(v0[2], v0[3]); w.z = pk_h16(v1[0], v1[1]); w.w = pk_h16(v1[2], v1[3]);
                    *(u32x4*)(out + ((size_t)((row >> 6) * 256 + (col >> 3)) * 64 + (row & 63)) * 8) = w; } }
    }
};
struct EpiEvenMain {
    static constexpr bool PERM = true, AFTER_DRAIN = false;
    h16* Z; float* FG; const float* b_f;
    __device__ __forceinline__ void operator()(const f32x4 (&acc)[2][2][4][2], const Unit& u, int wr, int wc, int fr, int fq) const {
#pragma unroll
        for (int bj = 0; bj < 2; ++bj) {
            const int col0 = u.pn * BM + bj * HALF + wc * 32 + 8 * fq;
            if (col0 < 2048) {
                const float sc = (col0 < 512 || (col0 >= 1024 && col0 < 1536)) ? QSCALE : 1.0f;
#pragma unroll
                for (int ai = 0; ai < 2; ++ai)
#pragma unroll
                    for (int m = 0; m < 4; ++m) { const f32x4 v0 = acc[ai][bj][m][0] * sc, v1 = acc[ai][bj][m][1] * sc;
                        u32x4 w; w.x = pk_h16(v0[0], v0[1]); w.y = pk_h16(v0[2], v0[3]); w.z = pk_h16(v1[0], v1[1]); w.w = pk_h16(v1[2], v1[3]);
                        *(u32x4*)(Z + (size_t)(u.pm * BM + ai * HALF + wr * 64 + m * 16 + fr) * ZLD + col0) = w; }
            } else if (col0 < 2080) {
                const int c = col0 - 2048;
#pragma unroll
                for (int ai = 0; ai < 2; ++ai)
#pragma unroll
                    for (int m = 0; m < 4; ++m) { const f32x4 v0 = acc[ai][bj][m][0], v1 = acc[ai][bj][m][1]; f32x4 o0, o1;
                        if (c == 0) {
#pragma unroll
                            for (int q = 0; q < 4; ++q) { o0[q] = log_sigmoid(v0[q] + b_f[q]) * LOG2E; o1[q] = log_sigmoid(v1[q] + b_f[4 + q]) * LOG2E; }
                        } else {
#pragma unroll
                            for (int q = 0; q < 4; ++q) { o0[q] = sigmoidf_(v0[q]); o1[q] = sigmoidf_(v1[q]); }
                        }
                        float* fr_ = FG + (size_t)(u.pm * BM + ai * HALF + wr * 64 + m * 16 + fr) * 32 + c;
                        *(f32x4*)fr_ = o0; *(f32x4*)(fr_ + 4) = o1; }
            }
        }
    }
};
struct EpiVt {
    static constexpr bool PERM = true, AFTER_DRAIN = false;
    h16 *VtF, *VtS, *VtW;
    __device__ __forceinline__ void operator()(const f32x4 (&acc)[2][2][4][2], const Unit& u, int wr, int wc, int fr, int fq) const {
#pragma unroll
        for (int ai = 0; ai < 2; ++ai)
#pragma unroll
            for (int m = 0; m < 4; ++m) {
                const int n = u.pm * BM + ai * HALF + wr * 64 + m * 16 + fr;
#pragma unroll
                for (int bj = 0; bj < 2; ++bj) {
                    const int t0 = u.pn * BM + bj * HALF + wc * 32 + 8 * fq, b = t0 >> 12, s = t0 & 4095;
                    h16* dst = n < 512 ? VtF + ((size_t)(b * 512 + n)) * SEQ + s : (n < 640 ? VtS + ((size_t)(b * 128 + n - 512)) * SEQ + s : VtW + ((size_t)(b * 128 + n - 640)) * SEQ + s);
                    const f32x4 v0 = acc[ai][bj][m][0], v1 = acc[ai][bj][m][1];
                    u32x4 w; w.x = pk_h16(v0[0], v0[1]); w.y = pk_h16(v0[2], v0[3]); w.z = pk_h16(v1[0], v1[1]); w.w = pk_h16(v1[2], v1[3]);
                    *(u32x4*)dst = w;
                }
            }
    }
};

template <class Epi, class Sched, bool ALIGN_EPI = false, bool SP2 = false>
__device__ __forceinline__ void gemm_phase(PG8_LAS unsigned char* lds, const Gemm g, const Sched& S, const Epi& E) {
    int tid_ = threadIdx.x; asm volatile("" : "+v"(tid_));
    const int tid = tid_, wid = __builtin_amdgcn_readfirstlane(tid >> 6), lane = tid & 63, wr = wid >> 2, wc = wid & 3, fr = lane & 15, fq = lane >> 4;
    const int K = g.K, nt = K / BK;
    unsigned voffA[2], voffB[2];
#pragma unroll
    for (int i = 0; i < 2; ++i) { int R, C; stage_rc(tid * 16 + i * 8192, R, C); const int Rb = Epi::PERM ? ((R & ~31) + perm32(R & 31)) : R;
        voffA[i] = (unsigned)(R * g.lda + C) * 2u; voffB[i] = (unsigned)(Rb * K + C) * 2u; }
    const size_t kstep = (size_t)(BK * 2);
    const size_t hstepA = (size_t)HALF * g.lda * 2, hstepB = (size_t)HALF * K * 2;
    const size_t tstepA = 2 * hstepA, tstepB = 2 * hstepB;
    const unsigned ldsw = (unsigned)wid * 1024u;
    const int aoff = lds_byte(wr * 64 + fr, fq * 8), boff = lds_byte(wc * 32 + fr, fq * 8);
#define PG8_SA(b, h) (((b) * 2 + (h)) * HTB)
#define PG8_SB(b, h) ((4 + (b) * 2 + (h)) * HTB)
#define PG8_STAGE(bufoff, gbase, voff) do { _Pragma("unroll") for (int _i = 0; _i < 2; ++_i) \
        __builtin_amdgcn_global_load_lds((const unsigned*)((const char*)(gbase) + (voff)[_i]), (PG8_LAS unsigned*)(lds + (bufoff) + ldsw + _i * 8192), 16, 0, 0); } while (0)
#define PG8_LDA(dst, b, h) do { _Pragma("unroll") for (int m = 0; m < 4; ++m) _Pragma("unroll") for (int k = 0; k < 2; ++k) dst[m][k] = *(const PG8_LAS bf16x8*)(lds + PG8_SA(b, h) + aoff + m * 2048 + k * 1024); } while (0)
#define PG8_LDB(dst, b, h) do { _Pragma("unroll") for (int n = 0; n < 2; ++n) _Pragma("unroll") for (int k = 0; k < 2; ++k) dst[n][k] = *(const PG8_LAS bf16x8*)(lds + PG8_SB(b, h) + boff + n * 2048 + k * 1024); } while (0)
#define PG8_MMA(ai, bj, At, Bt) do { __builtin_amdgcn_s_setprio(1); _Pragma("unroll") for (int m = 0; m < 4; ++m) _Pragma("unroll") for (int n = 0; n < 2; ++n) _Pragma("unroll") for (int k = 0; k < 2; ++k) \
        acc[ai][bj][m][n] = __builtin_amdgcn_mfma_f32_16x16x32_f16(__builtin_bit_cast(half8, Bt[n][k]), __builtin_bit_cast(half8, At[m][k]), acc[ai][bj][m][n], 0, 0, 0); __builtin_amdgcn_s_setprio(0); } while (0)
#define PG8_WAIT_V(n) asm volatile("s_waitcnt vmcnt(" #n ")" ::: "memory")
#define PG8_WAIT_L(n) asm volatile("s_waitcnt lgkmcnt(" #n ")" ::: "memory")
#define PG8_BAR __builtin_amdgcn_s_barrier()
#define PG8_SCHED __builtin_amdgcn_sched_barrier(0)
    Unit cur, nxt; int ui = 0;
    if (!S.next(0, cur)) return;
    f32x4 acc[2][2][4][2];
#pragma unroll
    for (int a = 0; a < 2; ++a)
#pragma unroll
        for (int b = 0; b < 2; ++b)
#pragma unroll
            for (int m = 0; m < 4; ++m)
#pragma unroll
                for (int n = 0; n < 2; ++n) acc[a][b][m][n] = (f32x4){0.f, 0.f, 0.f, 0.f};
    bf16x8 At[4][2], B0[2][2], B1[2][2];
    const char* cA = (const char*)g.A + (size_t)cur.pm * tstepA; const char* cB = (const char*)g.Bt + (size_t)cur.pn * tstepB;
    S.a_ready(cur);
    if constexpr (SP2) {
        PG8_STAGE(PG8_SB(0, 0), cB, voffB); PG8_STAGE(PG8_SB(0, 1), cB + hstepB, voffB); PG8_STAGE(PG8_SA(0, 0), cA, voffA); PG8_STAGE(PG8_SA(0, 1), cA + hstepA, voffA);
        if (wr == 1) PG8_BAR;
        PG8_WAIT_V(2); PG8_BAR;
        PG8_STAGE(PG8_SB(1, 0), cB + kstep, voffB); PG8_STAGE(PG8_SA(1, 0), cA + kstep, voffA); PG8_STAGE(PG8_SB(1, 1), cB + hstepB + kstep, voffB);
        PG8_WAIT_V(6); PG8_BAR;
    } else {
        PG8_STAGE(PG8_SB(0, 0), cB, voffB); PG8_STAGE(PG8_SA(0, 0), cA, voffA); PG8_STAGE(PG8_SB(0, 1), cB + hstepB, voffB); PG8_STAGE(PG8_SA(0, 1), cA + hstepA, voffA);
        if (wr == 1) PG8_BAR;
        PG8_WAIT_V(4); PG8_BAR;
        PG8_STAGE(PG8_SB(1, 0), cB + kstep, voffB); PG8_STAGE(PG8_SA(1, 0), cA + kstep, voffA); PG8_STAGE(PG8_SB(1, 1), cB + hstepB + kstep, voffB);
        PG8_WAIT_V(6); PG8_BAR;
    }
    for (;;) {
        const bool has_next = S.next(ui + 1, nxt);
        const char* nA = has_next ? (const char*)g.A + (size_t)nxt.pm * tstepA : cA; const char* nB = has_next ? (const char*)g.Bt + (size_t)nxt.pn * tstepB : cB;
        for (int t = 0; t < nt; t += 2) {
            const bool last = (t == nt - 2);
            const char* a1 = cA + (size_t)(t + 1) * kstep;
            const char* a2 = last ? nA : cA + (size_t)(t + 2) * kstep; const char* b2 = last ? nB : cB + (size_t)(t + 2) * kstep;
            const char* a3 = a2 + kstep; const char* b3 = b2 + kstep;
            if (last && has_next) S.a_ready(nxt);
            if constexpr (SP2) {
            PG8_LDB(B0, 0, 0); PG8_LDB(B1, 0, 1); PG8_SCHED; PG8_LDA(At, 0, 0); PG8_STAGE(PG8_SA(1, 1), a1 + hstepA, voffA);
            PG8_WAIT_V(8); PG8_WAIT_L(0); PG8_BAR; PG8_MMA(0, 0, At, B0); PG8_MMA(0, 1, At, B1); PG8_BAR; PG8_SCHED;
            PG8_LDA(At, 0, 1); PG8_STAGE(PG8_SB(0, 0), b2, voffB); PG8_STAGE(PG8_SB(0, 1), b2 + hstepB, voffB); PG8_STAGE(PG8_SA(0, 0), a2, voffA);
            PG8_WAIT_V(8); PG8_WAIT_L(0); PG8_BAR; PG8_MMA(1, 0, At, B0); PG8_MMA(1, 1, At, B1); PG8_BAR; PG8_SCHED;
            PG8_LDB(B0, 1, 0); PG8_LDB(B1, 1, 1); PG8_SCHED; PG8_LDA(At, 1, 0); PG8_STAGE(PG8_SA(0, 1), a2 + hstepA, voffA);
            PG8_WAIT_V(8); PG8_WAIT_L(0); PG8_BAR; PG8_MMA(0, 0, At, B0); PG8_MMA(0, 1, At, B1); PG8_BAR; PG8_SCHED;
            PG8_LDA(At, 1, 1); PG8_STAGE(PG8_SB(1, 0), b3, voffB); PG8_STAGE(PG8_SB(1, 1), b3 + hstepB, voffB); PG8_STAGE(PG8_SA(1, 0), a3, voffA);
            PG8_WAIT_V(8); PG8_WAIT_L(0); PG8_BAR; PG8_MMA(1, 0, At, B0); PG8_MMA(1, 1, At, B1); PG8_BAR; PG8_SCHED;
            } else {
            PG8_LDB(B0, 0, 0); PG8_SCHED; PG8_LDA(At, 0, 0); PG8_STAGE(PG8_SA(1, 1), a1 + hstepA, voffA);
            PG8_WAIT_L(8); PG8_BAR; PG8_WAIT_L(0); PG8_MMA(0, 0, At, B0); PG8_BAR; PG8_SCHED;
            PG8_LDB(B1, 0, 1); PG8_STAGE(PG8_SB(0, 0), b2, voffB);
            PG8_BAR; PG8_WAIT_L(0); PG8_MMA(0, 1, At, B1); PG8_BAR;
            PG8_LDA(At, 0, 1); PG8_STAGE(PG8_SA(0, 0), a2, voffA);
            PG8_BAR; PG8_WAIT_L(0); PG8_MMA(1, 0, At, B0); PG8_BAR; PG8_SCHED;
            PG8_STAGE(PG8_SB(0, 1), b2 + hstepB, voffB);
            PG8_WAIT_V(6); PG8_BAR; PG8_MMA(1, 1, At, B1); PG8_BAR;
            PG8_LDB(B0, 1, 0); PG8_SCHED; PG8_LDA(At, 1, 0); PG8_STAGE(PG8_SA(0, 1), a2 + hstepA, voffA);
            PG8_WAIT_L(8); PG8_BAR; PG8_WAIT_L(0); PG8_MMA(0, 0, At, B0); PG8_BAR; PG8_SCHED;
            PG8_LDB(B1, 1, 1); PG8_STAGE(PG8_SB(1, 0), b3, voffB);
            PG8_BAR; PG8_WAIT_L(0); PG8_MMA(0, 1, At, B1); PG8_BAR;
            PG8_LDA(At, 1, 1); PG8_STAGE(PG8_SA(1, 0), a3, voffA);
            PG8_BAR; PG8_WAIT_L(0); PG8_MMA(1, 0, At, B0); PG8_BAR; PG8_SCHED;
            PG8_STAGE(PG8_SB(1, 1), b3 + hstepB, voffB);
            PG8_WAIT_V(6); PG8_BAR; PG8_MMA(1, 1, At, B1); PG8_BAR;
            }
        }
        if constexpr (ALIGN_EPI) { if (wr == 0) PG8_BAR; }
        if constexpr (!Epi::AFTER_DRAIN) { E(acc, cur, wr, wc, fr, fq); S.done(cur); }
        if (!has_next) break;
#pragma unroll
        for (int a = 0; a < 2; ++a)
#pragma unroll
            for (int b = 0; b < 2; ++b)
#pragma unroll
                for (int m = 0; m < 4; ++m)
#pragma unroll
                    for (int n = 0; n < 2; ++n) acc[a][b][m][n] = (f32x4){0.f, 0.f, 0.f, 0.f};
        cur = nxt; cA = nA; cB = nB; ++ui;
        if constexpr (ALIGN_EPI) { if (wr == 1) PG8_BAR; }
    }
    PG8_WAIT_V(0);
    if constexpr (!ALIGN_EPI) { if (wr == 0) PG8_BAR; }
    PG8_BAR;
    if constexpr (Epi::AFTER_DRAIN) { E.fused(acc, cur, wr, wc, fr, fq, lds, wid, lane); S.done(cur); }
#undef PG8_SA
#undef PG8_SB
#undef PG8_STAGE
#undef PG8_LDA
#undef PG8_LDB
#undef PG8_MMA
#undef PG8_WAIT_V
#undef PG8_WAIT_L
#undef PG8_BAR
#undef PG8_SCHED
}
}

__device__ __forceinline__ GemmArgs mk_gemm(const h16* A, int lda, const h16* Bt, int ldb, int M, int N, int K, int ans, int mode, h16* c16, int ldc16, float* c32, int ldc32, const float* resid) {
    GemmArgs g; g.A = A; g.lda = lda; g.Bt = Bt; g.ldb = ldb; g.M = M; g.N = N; g.K = K; g.a_ntile_stride = ans; g.mode = mode; g.c16 = c16; g.ldc16 = ldc16; g.c32 = c32; g.ldc32 = ldc32; g.resid = resid; g.aux = nullptr; return g;
}

__device__ __forceinline__ void run_phase(PRef p, int ph, char* smem) {
    if (ph == 1 || ph == 4 || ph == 6 || ph == 10 || ph == 14 || ph == 16) {
        PG8_LAS unsigned char* lds = (PG8_LAS unsigned char*)dyn_lds;
        const int G = (int)gridDim.x, c = (int)blockIdx.x;
        pg8::StaticOrder S;
        typedef const pg8::bf16_t* bp;
        if (ph == 1) {
            { pg8::EpiEvenMain E{p.Z, p.FG, p.even_b_f}; S.init(TOK, ZLD, G, c);
              pg8::gemm_phase<pg8::EpiEvenMain, pg8::StaticOrder, true, true>(lds, pg8::Gemm{(bp)p.HN, (bp)p.WtE, TOK, ZLD, DM, DM}, S, E); }
            { pg8::EpiVt E{p.VtF, p.VtS, p.VtW}; S.init(768, TOK, G, (c + 3 * G / 4) % G);
              pg8::gemm_phase<pg8::EpiVt, pg8::StaticOrder, true, true>(lds, pg8::Gemm{(bp)p.WtV, (bp)p.HN, 768, TOK, DM, DM}, S, E); }
        } else if (ph == 4) {
            pg8::EpiResid E{p.x, p.H, DM}; S.init(TOK, DM, G, c);
            pg8::gemm_phase<pg8::EpiResid, pg8::StaticOrder, true, true>(lds, pg8::Gemm{(bp)p.O, (bp)p.WtEo, TOK, DM, DM, DM}, S, E);
        } else if (ph == 14) {
            pg8::EpiResid E{p.H, p.H, DM}; S.init(TOK, DM, G, c);
            pg8::gemm_phase<pg8::EpiResid, pg8::StaticOrder, true, true>(lds, pg8::Gemm{(bp)(p.Z2 + DRNN), (bp)p.WtOo, TOK, DM, DRNN, Z2LD}, S, E);
        } else if (ph == 10) {
            pg8::EpiH16 E{p.Z2, Z2LD}; S.init(TOK, Z2LD, G, c);
            pg8::gemm_phase<pg8::EpiH16, pg8::StaticOrder, true, true>(lds, pg8::Gemm{(bp)p.HN, (bp)p.WtO, TOK, Z2LD, DM, DM}, S, E);
        } else {
            pg8::EpiSC E{p.SC}; S.init(TOK, 2048, G, c);
            pg8::gemm_phase<pg8::EpiSC, pg8::StaticOrder, true, true>(lds, pg8::Gemm{(bp)p.HN, (bp)(p.WtQ + (ph == 16 ? (size_t)2048 * 1024 : 0)), TOK, 2048, DM, DM}, S, E);
        }
        return;
    }
    if (ph == 0) phase_prep(p, smem);
    else if (ph == 2) phase_cumsum_compress(p, smem);
    else if (ph == 3) phase_attention(p, smem);
    else if (ph == 5 || ph == 15) phase_rmsnorm(p, ph == 5 ? p.ffn_norm_g : p.ffn_norm_g + DM);
    else if (ph == 8 || ph == 18) phase_peer_topk(p, smem);
    else if (ph == 9 || ph == 19) phase_peer_experts(p, ph == 19 ? 1 : 0, ph == 19 ? p.final_g : p.odd_norm_g, ph == 19 ? 1 : 0, smem);
    else if (ph == 11) phase_rnn_gates(p, smem);
    else if (ph == 13) phase_rnn_scan_b(p);
}

__global__ void __launch_bounds__(512, 2) mega(Params p_by_value) {
    char* smem = dyn_lds + hidx_() * 65536;
    volatile LAS unsigned* hs_all = (volatile LAS unsigned*)(dyn_lds + 131072);
    const __attribute__((address_space(4))) Params* kp = (const __attribute__((address_space(4))) Params*)__builtin_amdgcn_kernarg_segment_ptr();
    const int ph0 = (int)kp->ph0, ph1 = (int)kp->ph1;
    if (threadIdx.x < 12) hs_all[threadIdx.x] = 0u;
    __syncthreads();
    XcdBarrier xb = xcd_barrier_post(kp->BAR, hs_all + 8);
    for (int ph = ph0; ph < ph1; ++ph) {
        if (ph == 12 || ph == 7 || ph == 17) continue;
        const __attribute__((address_space(4))) Params* q = kp;
        asm volatile("" : "+s"(q));
        PRef p = *q;
#if PROBE_PH >= 0
        if (blockIdx.x == 0 && threadIdx.x == 0) p.TS[ph] = __builtin_amdgcn_s_memrealtime();
#endif
        const int reps = ((DUP_MASK >> ph) & 1) ? 2 : 1;
        for (int r = 0; r < reps; ++r) { run_phase(p, ph, smem); if (r + 1 < reps) xcd_barrier(xb); }
        if (ph + 1 < ph1) xcd_barrier(xb);
    }
    PRef p = *kp;
#if PROBE_PH >= 0
    cg::this_grid().sync();
    if (blockIdx.x == 0 && threadIdx.x == 0) { p.TS[NPHASE] = __builtin_amdgcn_s_memrealtime(); __threadfence(); }
    cg::this_grid().sync();
    {
        const unsigned long long t0 = __hip_atomic_load(&p.TS[0], __ATOMIC_RELAXED, __HIP_MEMORY_SCOPE_AGENT), t1 = __hip_atomic_load(&p.TS[NPHASE], __ATOMIC_RELAXED, __HIP_MEMORY_SCOPE_AGENT);
        const unsigned long long a = __hip_atomic_load(&p.TS[PROBE_PH], __ATOMIC_RELAXED, __HIP_MEMORY_SCOPE_AGENT), b = __hip_atomic_load(&p.TS[PROBE_PH + PROBE_N], __ATOMIC_RELAXED, __HIP_MEMORY_SCOPE_AGENT);
        const float frac = (float)(b - a) / (float)(t1 - t0);
        const float scale = 1.1f + frac;
        for (size_t i = (size_t)blockIdx.x * 512 + threadIdx.x; i < (size_t)TOK * DM; i += (size_t)gridDim.x * 512) p.out[i] *= scale;
    }
#endif
}

constexpr int DYN_LDS_BYTES = 131072 + 64;
extern "C" void kernel_launch(void* const* d_in, const int* in_sizes, int n_in, void* d_out, int out_size, void* d_ws, size_t ws_size, hipStream_t stream) {
    Params p; memset(&p, 0, sizeof(p));
    const float* const* in = (const float* const*)d_in;
    p.x = in[0]; p.even_norm_g = in[1]; p.even_w_in = in[2]; p.even_b_f = in[3]; p.even_cmp_pos = in[4]; p.even_w_cmp_k = in[5]; p.even_w_cmp_v = in[6]; p.even_w_out = in[7];
    p.odd_norm_g = in[8]; p.odd_w_in = in[9]; p.odd_conv_w = in[10]; p.odd_conv_b = in[11]; p.odd_w_ra = in[12]; p.odd_b_ra = in[13]; p.odd_w_ri = in[14]; p.odd_b_ri = in[15];
    p.odd_lam = in[16]; p.odd_w_out = in[17]; p.ffn_norm_g = in[18]; p.peer_w_q = in[19]; p.peer_sub_keys = in[20]; p.peer_u = in[21]; p.peer_v = in[22]; p.final_g = in[23];
    p.out = (float*)d_out;
    char* ws = (char*)d_ws; size_t off = 0;
    auto take = [&](size_t bytes) { char* r = ws + off; off += (bytes + 255) & ~(size_t)255; return r; };
    p.WtE = (h16*)take((size_t)ZLD * 1024 * 2); p.WtV = (h16*)take((size_t)768 * 1024 * 2); p.WtEo = (h16*)take((size_t)1024 * 1024 * 2); p.WtO = (h16*)take((size_t)2560 * 1024 * 2); p.WtOo = (h16*)take((size_t)1024 * 1280 * 2);
    p.WtQ = (h16*)take((size_t)2 * 2048 * 1024 * 2); p.Wc = (h16*)take((size_t)2 * 64 * 2048 * 2); p.Wr = (h16*)take((size_t)20 * 16384 * 2); p.Keys = (h16*)take((size_t)2 * 8 * 2 * 128 * 128 * 2);
    p.Pos16 = (h16*)take(4096); p.U8 = (unsigned char*)take((size_t)2 * 16384 * 1024); p.V8 = (unsigned char*)take((size_t)2 * 16384 * 1024);
    p.US = (float*)take((size_t)2 * 16384 * 4); p.VS = (float*)take((size_t)2 * 16384 * 4);
    p.H = (float*)take((size_t)TOK * DM * 4); p.HN = (h16*)take((size_t)TOK * DM * 2);
    const size_t scratch0 = off;
    p.Z = (h16*)take((size_t)TOK * ZLD * 2); p.VtF = (h16*)take((size_t)4 * 8 * 64 * SEQ * 2); p.VtS = (h16*)take((size_t)4 * 2 * 64 * SEQ * 2); p.VtW = (h16*)take((size_t)4 * 2 * 64 * SEQ * 2);
    p.KC = (h16*)take((size_t)8 * 256 * 64 * 2); p.VCt = (h16*)take((size_t)8 * 64 * 256 * 2); p.O = (h16*)take((size_t)TOK * DM * 2); p.FG = (float*)take((size_t)TOK * 32 * 4); p.C2 = (float*)take((size_t)32 * SEQ * 4); p.OACC = (float*)take((size_t)TOK * 512 * 4);
    size_t mx = off;
    off = scratch0;
    p.QP = (h16*)take((size_t)TOK * 2048 * 2); p.SC = (h16*)take((size_t)TOK * 2048 * 2); p.IDS = (int*)take((size_t)TOK * 128 * 4); p.GW = (float*)take((size_t)TOK * 128 * 4);
    if (off > mx) mx = off;
    off = scratch0;
    p.Z2 = (h16*)take((size_t)TOK * Z2LD * 2); p.LA = (h16*)take((size_t)TOK * DRNN * 2); p.RU = (h16*)take((size_t)TOK * DRNN * 2);
    p.AggP = (float*)take((size_t)4 * 64 * DRNN * 4); p.AggH = (float*)take((size_t)4 * 64 * DRNN * 4);
    if (off > mx) mx = off;
    off = mx; p.TS = (unsigned long long*)take(256); p.BAR = (unsigned*)take(XCD_BAR_WORDS * 4 + 256); mx = off;
    if (mx > ws_size) { fprintf(stderr, "workspace too small: need %zu have %zu\n", mx, ws_size); return; }

    static int grid_blocks = 0;
    if (!grid_blocks) {
        int dev = 0, cus = 0, per_cu = 0;
        hipGetDevice(&dev);
        hipDeviceGetAttribute(&cus, hipDeviceAttributeMultiprocessorCount, dev);
        hipFuncSetAttribute((const void*)mega, hipFuncAttributeMaxDynamicSharedMemorySize, DYN_LDS_BYTES);
        hipOccupancyMaxActiveBlocksPerMultiprocessor(&per_cu, mega, 512, DYN_LDS_BYTES);
        if (per_cu > 1) per_cu = 1;
        if (per_cu < 1) per_cu = 1;
        grid_blocks = cus * per_cu;
    }
    hipMemsetAsync(p.BAR, 0, XCD_BAR_WORDS * 4 + 256, stream);
#if SINGLE_LAUNCH
    p.ph0 = 0; p.ph1 = NPHASE;
    void* args[] = {&p};
    hipError_t e = hipLaunchCooperativeKernel((void*)mega, dim3(grid_blocks), dim3(512), args, DYN_LDS_BYTES, stream);
    if (e != hipSuccess) fprintf(stderr, "cooperative launch failed: %s (grid %d)\n", hipGetErrorString(e), grid_blocks);
#else
    for (int ph = 0; ph < NPHASE; ++ph) {
        p.ph0 = ph; p.ph1 = ph + 1;
        hipLaunchKernelGGL(mega, dim3(grid_blocks), dim3(512), DYN_LDS_BYTES, stream, p);
    }
#endif
}
```

```cpp
#include <hip/hip_runtime.h>
#include <hip/hip_cooperative_groups.h>
#include <cstdio>
#include <cstdint>
#include <cstring>
namespace cg = cooperative_groups;

#ifndef SINGLE_LAUNCH
#define SINGLE_LAUNCH 1
#endif
#ifndef PROBE_PH
#define PROBE_PH -1
#endif
#ifndef PROBE_N
#define PROBE_N 1
#endif
#ifndef DUP_MASK
#define DUP_MASK 0
#endif

typedef _Float16 h16;
typedef _Float16 half8 __attribute__((ext_vector_type(8)));
typedef _Float16 half4 __attribute__((ext_vector_type(4)));
typedef _Float16 half2v __attribute__((ext_vector_type(2)));
typedef float f32x4 __attribute__((ext_vector_type(4)));
typedef float f32x16 __attribute__((ext_vector_type(16)));
typedef unsigned long long u64;
typedef int i32x4 __attribute__((ext_vector_type(4)));
typedef float f32x2 __attribute__((ext_vector_type(2)));
typedef float f32x32 __attribute__((ext_vector_type(32)));
typedef _Float16 h16x32 __attribute__((ext_vector_type(32)));
typedef unsigned u32x6 __attribute__((ext_vector_type(6)));
typedef int i32x2 __attribute__((ext_vector_type(2)));
typedef i32x4 __attribute__((aligned(8))) i32x4_a8;

#define NTHR 256
constexpr int BATCH = 4, SEQ = 4096, DM = 1024, TOK = BATCH * SEQ;
constexpr int ZLD = 2304, Z2LD = 2560, DRNN = 1280;
constexpr int EVEN_IN = 2848;
constexpr float LOG2E = 1.4426950408889634f;
constexpr float QSCALE = 0.125f * LOG2E;
constexpr float NEGBIG = -1.0e30f;
constexpr int KST = 72;
constexpr int NPHASE = 20;
constexpr int XCD_BAR_WORDS_C = 3456;

struct Params {
    const float *x, *even_norm_g, *even_w_in, *even_b_f, *even_cmp_pos, *even_w_cmp_k, *even_w_cmp_v, *even_w_out;
    const float *odd_norm_g, *odd_w_in, *odd_conv_w, *odd_conv_b, *odd_w_ra, *odd_b_ra, *odd_w_ri, *odd_b_ri, *odd_lam, *odd_w_out;
    const float *ffn_norm_g, *peer_w_q, *peer_sub_keys, *peer_u, *peer_v, *final_g;
    float* out;
    h16 *WtE, *WtV, *WtEo, *WtO, *WtOo, *WtQ, *Wc, *Wr, *Keys, *Pos16;
    unsigned char *U8, *V8; float *US, *VS;
    h16* H; h16* HN;
    h16 *Z, *VtF, *VtS, *VtW, *KC, *VCt, *O; float *FG, *C2, *OACC;
    h16* QP; h16* SC; int* IDS; float* GW;
    h16* Z2; h16 *LA, *RU; float *AggP, *AggH;
    unsigned long long* TS; unsigned* BAR;
    long long ph0, ph1;
};

typedef const __attribute__((address_space(4))) Params& PRef;
extern __shared__ __attribute__((aligned(16))) char dyn_lds[];
#define GRIDV ((int)gridDim.x * 2)
#define LAS __attribute__((address_space(3)))
__device__ __forceinline__ int hidx_() { return __builtin_amdgcn_readfirstlane((int)threadIdx.x >> 8); }
__device__ __forceinline__ int tidx_() { int t = threadIdx.x & 255; asm volatile("" : "+v"(t)); return t; }
__device__ __forceinline__ int bidx_() { int b = blockIdx.x * 2 + hidx_(); asm volatile("" : "+s"(b)); return b; }
__device__ __forceinline__ int widx_() { return __builtin_amdgcn_readfirstlane(((int)threadIdx.x >> 6) & 3); }
__device__ __forceinline__ void hsync() {
    volatile LAS unsigned* w = (volatile LAS unsigned*)(dyn_lds + 131072 + hidx_() * 16);
    asm volatile("s_waitcnt lgkmcnt(0)" ::: "memory");
    if ((threadIdx.x & 63) == 0) {
        const unsigned old = __hip_atomic_fetch_add((LAS unsigned*)w, 1u, __ATOMIC_RELAXED, __HIP_MEMORY_SCOPE_WORKGROUP);
        const unsigned target = (old | 3u) + 1u;
        while ((int)(w[0] - target) < 0) { }
    }
    asm volatile("s_waitcnt lgkmcnt(0)" ::: "memory");
}

__device__ __forceinline__ float wave_sum(float v) {
#pragma unroll
    for (int o = 32; o > 0; o >>= 1) v += __shfl_xor(v, o);
    return v;
}
__device__ __forceinline__ int mbcnt64(u64 m) { return __builtin_amdgcn_mbcnt_hi((unsigned)(m >> 32), __builtin_amdgcn_mbcnt_lo((unsigned)m, 0)); }
__device__ __forceinline__ float gelu_exact(float v) { return 0.5f * v * (1.0f + erff(v * 0.70710678118654752f)); }
__device__ __forceinline__ float sigmoidf_(float v) { return 1.0f / (1.0f + __expf(-v)); }
__device__ __forceinline__ float log_sigmoid(float v) { return v >= 0.f ? -log1pf(expf(-v)) : v - log1pf(expf(v)); }
__device__ __forceinline__ int crow(int r, int hi) { return (r & 3) + 8 * (r >> 2) + 4 * hi; }
__device__ __forceinline__ f32x16 zero16() { f32x16 z;
#pragma unroll
    for (int i = 0; i < 16; ++i) z[i] = 0.f; return z; }

__device__ __forceinline__ void rms_write_h16(const float (&v)[16], const float* __restrict__ g, h16* __restrict__ dst, int lane) {
    float ss = 0.f;
#pragma unroll
    for (int i = 0; i < 16; ++i) ss += v[i] * v[i];
    ss = wave_sum(ss);
    const float rstd = rsqrtf(ss * (1.0f / 1024.0f) + 1e-6f);
#pragma unroll
    for (int hseg = 0; hseg < 2; ++hseg) {
        const int c0 = hseg * 512 + lane * 8;
        const f32x4 g0 = *(const f32x4*)(g + c0), g1 = *(const f32x4*)(g + c0 + 4);
        half8 o;
#pragma unroll
        for (int i = 0; i < 4; ++i) { o[i] = (h16)(v[hseg * 8 + i] * rstd * g0[i]); o[4 + i] = (h16)(v[hseg * 8 + 4 + i] * rstd * g1[i]); }
        *(half8*)(dst + c0) = o;
    }
}
__device__ __forceinline__ void load_row16(const float* __restrict__ src, float (&v)[16], int lane) {
#pragma unroll
    for (int hseg = 0; hseg < 2; ++hseg) {
        const int c0 = hseg * 512 + lane * 8;
        const f32x4 a = *(const f32x4*)(src + c0), b = *(const f32x4*)(src + c0 + 4);
#pragma unroll
        for (int i = 0; i < 4; ++i) { v[hseg * 8 + i] = a[i]; v[hseg * 8 + 4 + i] = b[i]; }
    }
}

__device__ __forceinline__ void load_row16(const h16* __restrict__ src, float (&v)[16], int lane) {
#pragma unroll
    for (int hseg = 0; hseg < 2; ++hseg) {
        const half8 a = *(const half8*)(src + hseg * 512 + lane * 8);
#pragma unroll
        for (int i = 0; i < 8; ++i) v[hseg * 8 + i] = (float)a[i];
    }
}

__device__ __forceinline__ int even_col_map(int n, int kind) {
    if (kind == 2) {
        if (n < 512) return 1024 + n;
        if (n < 640) return 2056 + 3 * 128 + (n - 512);
        return 2056 + 5 * 128 + (n - 640);
    }
    if (n < 1024) return n;
    if (n < 1536) return 1544 + (n - 1024);
    if (n < 1664) return 2056 + (n - 1536);
    if (n < 1792) return 2056 + 128 + (n - 1664);
    if (n < 1920) return 2056 + 256 + (n - 1792);
    if (n < 2048) return 2056 + 512 + (n - 1920);
    if (n < 2056) return 1536 + (n - 2048);
    if (n < 2080) return 2824 + (n - 2056);
    return -1;
}
__device__ __forceinline__ void transpose_job(const float* __restrict__ src, int K, int N, h16* __restrict__ dst, int Ndst, int mapped, float* tileS, int& base, int b0) {
    const int tid = tidx_(), nb = (int)GRIDV - b0, bid = bidx_() - b0;
    const int nkt = K / 64, nnt = Ndst / 64, ntiles = nkt * nnt;
    int first = (bid - (base % nb) + nb) % nb;
    for (int tile = first; tile < ntiles; tile += nb) {
        const int k0 = (tile % nkt) * 64, n0 = (tile / nkt) * 64;
#pragma unroll
        for (int i = 0; i < 16; ++i) {
            const int e = tid + 256 * i, kk = e >> 6, nn = e & 63;
            const int sc = mapped ? even_col_map(n0 + nn, mapped) : (n0 + nn);
            tileS[kk * 65 + nn] = (sc >= 0) ? src[(size_t)(k0 + kk) * N + sc] : 0.f;
        }
        hsync();
        const int n = tid >> 2, ks = (tid & 3) * 16;
        half8 o0, o1;
#pragma unroll
        for (int i = 0; i < 8; ++i) { o0[i] = (h16)tileS[(ks + i) * 65 + n]; o1[i] = (h16)tileS[(ks + 8 + i) * 65 + n]; }
        h16* d = dst + (size_t)(n0 + n) * K + k0 + ks;
        *(half8*)d = o0; *(half8*)(d + 8) = o1;
        hsync();
    }
    base += ntiles;
}
__device__ __forceinline__ void convert_job(const float* __restrict__ src, h16* __restrict__ dst, size_t n) {
    const size_t n4 = n / 4, stride = (size_t)GRIDV * NTHR;
    for (size_t i = (size_t)bidx_() * NTHR + tidx_(); i < n4; i += stride) {
        const f32x4 v = *(const f32x4*)(src + 4 * i);
        half4 o; o[0] = (h16)v[0]; o[1] = (h16)v[1]; o[2] = (h16)v[2]; o[3] = (h16)v[3];
        *(half4*)(dst + 4 * i) = o;
    }
}
constexpr int ROW6 = 768;
template <int NP>
__device__ __forceinline__ void fp6_rows(const float* __restrict__ src, unsigned char* __restrict__ dst, float* __restrict__ scl, const int (&rps)[NP], int lane) {
    const int hh = lane >> 5, g = lane & 31;
    f32x4 v[NP][8];
#pragma unroll
    for (int q = 0; q < NP; ++q)
#pragma unroll
        for (int c = 0; c < 8; ++c) v[q][c] = *(const f32x4*)(src + (size_t)(rps[q] * 2 + hh) * 1024 + c * 128 + g * 4);
#pragma unroll
    for (int q = 0; q < NP; ++q) {
        float am = 0.f;
#pragma unroll
        for (int c = 0; c < 8; ++c) am = fmaxf(am, fmaxf(fmaxf(fabsf(v[q][c][0]), fabsf(v[q][c][1])), fmaxf(fabsf(v[q][c][2]), fabsf(v[q][c][3]))));
#pragma unroll
        for (int o = 16; o > 0; o >>= 1) am = fmaxf(am, __shfl_xor(am, o));
        const float sc = am > 0.f ? am * (1.0f / 7.5f) : 1.0f, inv = 1.0f / sc;
        h16x32 hv;
#pragma unroll
        for (int c = 0; c < 8; ++c)
#pragma unroll
            for (int j = 0; j < 4; ++j) hv[4 * c + j] = (h16)(v[q][c][j] * inv);
        const u32x6 pk = __builtin_amdgcn_cvt_scalef32_pk32_fp6_f16(hv, 1.0f);
        unsigned char* o = dst + (size_t)(rps[q] * 2 + hh) * ROW6;
        *(i32x4*)(o + g * 16) = (i32x4){(int)pk[0], (int)pk[1], (int)pk[2], (int)pk[3]};
        *(i32x2*)(o + 512 + g * 8) = (i32x2){(int)pk[4], (int)pk[5]};
        if (g == 0) scl[rps[q] * 2 + hh] = sc;
    }
}
__device__ __forceinline__ void fp6_rows_job(const float* __restrict__ src, unsigned char* __restrict__ dst, float* __restrict__ scl, int npairs, int wv0) {
    const int lane = tidx_() & 63, wv = bidx_() * 4 + widx_() - wv0, nwv = GRIDV * 4 - wv0;
    if (wv < 0) return;
    int r = wv;
    for (; r + nwv < npairs; r += 2 * nwv) { const int rps[2] = {r, r + nwv}; fp6_rows<2>(src, dst, scl, rps, lane); }
    for (; r < npairs; r += nwv) { const int rps[1] = {r}; fp6_rows<1>(src, dst, scl, rps, lane); }
}
__device__ __forceinline__ void weight_jobs(PRef p, char* smem, bool first_only, int b0) {
    float* tileS = (float*)smem;
    int base = 0;
    const int jlo = 0, jhi = 28;
    for (int job = jlo; job < jhi; ++job) {
        if (first_only != (job == 0 || job == 4 || job == 6 || job == 7)) continue;
        const float* src; int K, N, Nd; h16* dst; int mapped = 0;
        if (job == 0) { src = p.even_w_in; K = 1024; N = EVEN_IN; dst = p.WtE; Nd = ZLD; mapped = 1; }
        else if (job == 1) { src = p.even_w_out; K = 1024; N = 1024; dst = p.WtEo; Nd = 1024; }
        else if (job == 2) { src = p.odd_w_in; K = 1024; N = 2560; dst = p.WtO; Nd = 2560; }
        else if (job == 3) { src = p.odd_w_out; K = 1280; N = 1024; dst = p.WtOo; Nd = 1024; }
        else if (job == 4) { src = p.even_w_in; K = 1024; N = EVEN_IN; dst = p.WtV; Nd = 768; mapped = 2; }
        else if (job == 5) continue;
        else if (job == 6) { src = p.even_w_cmp_k; K = 2048; N = 64; dst = p.Wc; Nd = 64; }
        else if (job == 7) { src = p.even_w_cmp_v; K = 2048; N = 64; dst = p.Wc + 64 * 2048; Nd = 64; }
        else if (job < 18) { const int n = job - 8; src = p.odd_w_ra + n * 16384; K = 128; N = 128; dst = p.Wr + n * 16384; Nd = 128; }
        else { const int n = job - 18; src = p.odd_w_ri + n * 16384; K = 128; N = 128; dst = p.Wr + (10 + n) * 16384; Nd = 128; }
        transpose_job(src, K, N, dst, Nd, mapped, tileS, base, b0);
    }
}
__device__ __forceinline__ void phase_prep(PRef p, char* smem) {
    weight_jobs(p, smem, true, 0);
    convert_job(p.peer_sub_keys, p.Keys, (size_t)2 * 8 * 2 * 128 * 128);
    convert_job(p.even_cmp_pos, p.Pos16, 2048);
    const int lane = tidx_() & 63, wv = bidx_() * 4 + widx_(), nwv = GRIDV * 4;
    for (int row = wv; row < TOK; row += nwv) {
        float v[16]; load_row16(p.x + (size_t)row * DM, v, lane);
        rms_write_h16(v, p.even_norm_g, p.HN + (size_t)row * DM, lane);
    }
}

enum { EPI_EVEN_IN = 0, EPI_F32_RESID = 1, EPI_H16 = 2, EPI_F32T = 3, EPI_QSCORE = 4 };
struct GemmArgs {
    const h16* A; int lda; const h16* Bt; int ldb; int M, N, K; int a_ntile_stride;
    int mode; h16* c16; int ldc16; float* c32; int ldc32; const float* resid; const h16* aux;
};
template <int MODE, int LDC>
__device__ __forceinline__ void gemm_epilogue(PRef p, const GemmArgs& g, int mt, int nt, bool sw, const f32x4 (&acc)[4][4]) {
    const int lane = tidx_() & 63, wid = widx_(), wm = wid >> 1, wn = wid & 1;
    const int l4 = (lane >> 4) * 4, l15 = lane & 15;
    if (MODE == EPI_EVEN_IN) {
        int kind;
        if (nt < 4 || (nt >= 12 && nt < 16)) kind = 0; else if (nt >= 8 && nt < 12) kind = 2; else if (nt == 19) kind = 3; else if (nt == 21) kind = 4; else if (nt == 22) kind = 5; else kind = 1;
#pragma unroll
        for (int i = 0; i < 4; ++i)
#pragma unroll
            for (int j = 0; j < 4; ++j) {
                const f32x4 v = acc[i][j];
                if (kind <= 1) {
                    const int row = mt * 128 + wm * 64 + j * 16 + l15, col = nt * 128 + wn * 64 + i * 16 + l4;
                    const float sc = kind == 0 ? QSCALE : 1.0f;
                    half4 o; o[0] = (h16)(v[0] * sc); o[1] = (h16)(v[1] * sc); o[2] = (h16)(v[2] * sc); o[3] = (h16)(v[3] * sc);
                    *(half4*)(p.Z + (size_t)row * ZLD + col) = o;
                } else if (kind <= 4) {
                    const int row = mt * 128 + wm * 64 + i * 16 + l4, col = nt * 128 + wn * 64 + j * 16 + l15;
                    const int b = row >> 12, s = row & 4095;
                    half4 o; o[0] = (h16)v[0]; o[1] = (h16)v[1]; o[2] = (h16)v[2]; o[3] = (h16)v[3];
                    h16* dst;
                    if (kind == 2) { const int c = col - 1024; dst = p.VtF + ((size_t)(b * 8 + (c >> 6)) * 64 + (c & 63)) * SEQ + s; }
                    else if (kind == 3) { const int c = col - 2432; dst = p.VtS + ((size_t)(b * 2 + (c >> 6)) * 64 + (c & 63)) * SEQ + s; }
                    else { const int c = col - 2688; dst = p.VtW + ((size_t)(b * 2 + (c >> 6)) * 64 + (c & 63)) * SEQ + s; }
                    *(half4*)dst = o;
                } else {
                    const int row = mt * 128 + wm * 64 + j * 16 + l15, c = nt * 128 + wn * 64 + i * 16 + l4 - 2816;
                    if (c < 32) {
                        f32x4 o;
                        if (c < 8) {
#pragma unroll
                            for (int q = 0; q < 4; ++q) o[q] = log_sigmoid(v[q] + p.even_b_f[c + q]) * LOG2E;
                        } else {
#pragma unroll
                            for (int q = 0; q < 4; ++q) o[q] = sigmoidf_(v[q]);
                        }
                        *(f32x4*)(p.FG + (size_t)row * 32 + c) = o;
                    }
                }
            }
    } else {
#pragma unroll
        for (int i = 0; i < 4; ++i)
#pragma unroll
            for (int j = 0; j < 4; ++j) {
                const f32x4 v = acc[i][j];
                if (MODE == EPI_F32T) {
                    const int row = mt * 128 + wm * 64 + i * 16 + l4, col = nt * 128 + wn * 64 + j * 16 + l15;
                    *(f32x4*)(g.c32 + (size_t)col * TOK + row) = v;
                } else {
                    const int row = mt * 128 + wm * 64 + j * 16 + l15, col = nt * 128 + wn * 64 + i * 16 + l4;
                    if (MODE == EPI_F32_RESID) {
                        const f32x4 r = *(const f32x4*)(g.resid + (size_t)row * LDC + col);
                        *(f32x4*)(g.c32 + (size_t)row * LDC + col) = r + v;
                    } else {
                        half4 o; o[0] = (h16)v[0]; o[1] = (h16)v[1]; o[2] = (h16)v[2]; o[3] = (h16)v[3];
                        *(half4*)(g.c16 + (size_t)row * LDC + col) = o;
                    }
                }
            }
    }
}

template <int MODE, int LDA, int LDB, int GN, int GK, int LDC, int ANS>
__device__ __forceinline__ void phase_gemm(PRef p, const GemmArgs& g, char* smem) {
    h16* As = (h16*)smem;
    h16* Bs = As + 2 * 128 * 64;
    const int tid = tidx_(), lane = tid & 63, wid = widx_(), wm = wid >> 1, wn = wid & 1;
    constexpr int nM = TOK / 128, nN = GN / 128, ntiles = nM * nN, nk = GK / 64;
    const int lr = tid >> 3, lc = tid & 7;
    const int st_off = lr * 64 + ((lc ^ ((tid >> 4) & 7)) * 8);
    const int fsw = (lane & 15) >> 1;
    const int fo0 = (lane & 15) * 64 + ((((lane >> 4)) ^ fsw) * 8), fo1 = (lane & 15) * 64 + (((4 + (lane >> 4)) ^ fsw) * 8);
    for (int tile = bidx_(); tile < ntiles; tile += GRIDV) {
        const int mt = tile / nN, nt = tile % nN;
        bool sw = (MODE != EPI_F32T);
        if (MODE == EPI_EVEN_IN) sw = !((nt >= 8 && nt < 12) || nt == 19 || nt == 21);
        const h16* Ag = g.A + (size_t)(mt * 128 + lr) * LDA + (size_t)nt * ANS + lc * 8;
        const h16* Bg = g.Bt + (size_t)(nt * 128 + lr) * LDB + lc * 8;
        constexpr size_t a32 = (size_t)32 * LDA, b32 = (size_t)32 * LDB;
        f32x4 acc[4][4];
#pragma unroll
        for (int m = 0; m < 4; ++m)
#pragma unroll
            for (int n = 0; n < 4; ++n) acc[m][n] = (f32x4){0.f, 0.f, 0.f, 0.f};
        half8 ra[4], rb[4];
#pragma unroll
        for (int i = 0; i < 4; ++i) { ra[i] = *(const half8*)(Ag + i * a32); rb[i] = *(const half8*)(Bg + i * b32); }
#pragma unroll
        for (int i = 0; i < 4; ++i) { *(half8*)(As + st_off + i * 32 * 64) = ra[i]; *(half8*)(Bs + st_off + i * 32 * 64) = rb[i]; }
        hsync();
        const int pofs = (sw ? wn : wm) * 64 * 64, qofs = (sw ? wm : wn) * 64 * 64;
        for (int kt = 0; kt < nk; ++kt) {
            const int cur = kt & 1;
            if (kt + 1 < nk) {
                const int ko = (kt + 1) * 64;
#pragma unroll
                for (int i = 0; i < 4; ++i) { ra[i] = *(const half8*)(Ag + i * a32 + ko); rb[i] = *(const half8*)(Bg + i * b32 + ko); }
            }
            const h16* Pc = (sw ? Bs : As) + cur * 128 * 64 + pofs;
            const h16* Qc = (sw ? As : Bs) + cur * 128 * 64 + qofs;
#pragma unroll
            for (int ks = 0; ks < 2; ++ks) {
                const int fo = ks ? fo1 : fo0;
                half8 pf[4], qf[4];
#pragma unroll
                for (int i = 0; i < 4; ++i) { pf[i] = *(const half8*)(Pc + i * 16 * 64 + fo); qf[i] = *(const half8*)(Qc + i * 16 * 64 + fo); }
                __builtin_amdgcn_s_setprio(1);
#pragma unroll
                for (int i = 0; i < 4; ++i)
#pragma unroll
                    for (int j = 0; j < 4; ++j) acc[i][j] = __builtin_amdgcn_mfma_f32_16x16x32_f16(pf[i], qf[j], acc[i][j], 0, 0, 0);
                __builtin_amdgcn_s_setprio(0);
            }
            if (kt + 1 < nk) {
                const int nx = (cur ^ 1) * 128 * 64;
#pragma unroll
                for (int i = 0; i < 4; ++i) { *(half8*)(As + nx + st_off + i * 32 * 64) = ra[i]; *(half8*)(Bs + nx + st_off + i * 32 * 64) = rb[i]; }
            }
            hsync();
        }
        if (MODE == EPI_QSCORE) {
            constexpr int QST = 136;
            h16* Qs = (h16*)smem;
            const int l4 = (lane >> 4) * 4, l15 = lane & 15;
#pragma unroll
            for (int i = 0; i < 4; ++i)
#pragma unroll
                for (int j = 0; j < 4; ++j) {
                    const f32x4 v = acc[i][j];
                    half4 o; o[0] = (h16)v[0]; o[1] = (h16)v[1]; o[2] = (h16)v[2]; o[3] = (h16)v[3];
                    *(half4*)(Qs + (wm * 64 + j * 16 + l15) * QST + wn * 64 + i * 16 + l4) = o;
                }
            hsync();
            f32x4 sc[4][4];
#pragma unroll
            for (int i = 0; i < 4; ++i)
#pragma unroll
                for (int j = 0; j < 4; ++j) sc[i][j] = (f32x4){0.f, 0.f, 0.f, 0.f};
            const h16* kb = g.aux + (size_t)(nt * 128 + wn * 64 + l15) * 128 + (lane >> 4) * 8;
#pragma unroll
            for (int ks = 0; ks < 4; ++ks) {
                half8 pf[4], qf[4];
#pragma unroll
                for (int i = 0; i < 4; ++i) { pf[i] = *(const half8*)(Qs + (wm * 64 + i * 16 + l15) * QST + ks * 32 + (lane >> 4) * 8); qf[i] = *(const half8*)(kb + (size_t)i * 16 * 128 + ks * 32); }
#pragma unroll
                for (int i = 0; i < 4; ++i)
#pragma unroll
                    for (int j = 0; j < 4; ++j) sc[i][j] = __builtin_amdgcn_mfma_f32_16x16x32_f16(pf[i], qf[j], sc[i][j], 0, 0, 0);
            }
#pragma unroll
            for (int i = 0; i < 4; ++i)
#pragma unroll
                for (int j = 0; j < 4; ++j) {
                    const int row = mt * 128 + wm * 64 + i * 16 + l4, col = nt * 128 + wn * 64 + j * 16 + l15;
                    *(f32x4*)(g.c32 + (size_t)col * TOK + row) = sc[i][j];
                }
            hsync();
        } else
        gemm_epilogue<MODE, LDC>(p, g, mt, nt, sw, acc);
    }
}

__device__ __forceinline__ void wp_job(PRef p, int wv0) {
    const int lane = tidx_() & 63, wv = bidx_() * 4 + widx_() - wv0, nwv = GRIDV * 4 - wv0;
    if (wv < 0) return;
    for (int u = wv; u < 1024; u += nwv) {
        const int l = u >> 9, hc = (u >> 5) & 15, kh = (u >> 4) & 1, jt = u & 15;
        const float* wq = p.peer_w_q + (size_t)l * 1024 * 2048 + (size_t)(jt * 64 + (lane & 15)) * 2048 + hc * 128 + (lane >> 4) * 8;
        const h16* ky = p.Keys + ((size_t)(l * 16 + hc) * 128 + kh * 64 + (lane & 15)) * 128 + (lane >> 4) * 8;
        f32x4 acc[4][4];
#pragma unroll
        for (int a = 0; a < 4; ++a)
#pragma unroll
            for (int b = 0; b < 4; ++b) acc[a][b] = (f32x4){0.f, 0.f, 0.f, 0.f};
#pragma unroll
        for (int ks = 0; ks < 4; ++ks) {
            half8 af[4], bf[4];
#pragma unroll
            for (int a = 0; a < 4; ++a) {
                const f32x4 w0 = *(const f32x4*)(wq + (size_t)a * 16 * 2048 + ks * 32), w1 = *(const f32x4*)(wq + (size_t)a * 16 * 2048 + ks * 32 + 4);
#pragma unroll
                for (int q = 0; q < 4; ++q) { af[a][q] = (h16)w0[q]; af[a][4 + q] = (h16)w1[q]; }
                bf[a] = *(const half8*)(ky + (size_t)a * 16 * 128 + ks * 32);
            }
#pragma unroll
            for (int a = 0; a < 4; ++a)
#pragma unroll
                for (int b = 0; b < 4; ++b) acc[a][b] = __builtin_amdgcn_mfma_f32_16x16x32_f16(af[a], bf[b], acc[a][b], 0, 0, 0);
        }
        h16* wp = p.WtQ + (size_t)l * 2048 * 1024;
#pragma unroll
        for (int a = 0; a < 4; ++a)
#pragma unroll
            for (int b = 0; b < 4; ++b) {
                const int n = hc * 128 + kh * 64 + b * 16 + (lane & 15), j0 = jt * 64 + a * 16 + (lane >> 4) * 4;
                half4 o; o[0] = (h16)acc[a][b][0]; o[1] = (h16)acc[a][b][1]; o[2] = (h16)acc[a][b][2]; o[3] = (h16)acc[a][b][3];
                *(half4*)(wp + (size_t)n * 1024 + j0) = o;
            }
    }
}
__device__ __forceinline__ void phase_cumsum_compress(PRef p, char* smem) {
    const int lane = tidx_() & 63, wid = widx_(), vb = bidx_();
    if (vb >= 256 && vb < 264) {
        const int u = (vb - 256) * 4 + wid, b = u >> 3, h = u & 7;
        const float* src = p.FG + (size_t)(b * SEQ + lane * 64) * 32 + h;
        float loc[64]; float run = 0.f;
#pragma unroll
        for (int i = 0; i < 64; ++i) { run += src[(size_t)i * 32]; loc[i] = run; }
        float incl = run;
#pragma unroll
        for (int o = 1; o < 64; o <<= 1) { const float t = __shfl_up(incl, o); if (lane >= o) incl += t; }
        const float excl = incl - run;
        float* dst = p.C2 + (size_t)(b * 8 + h) * SEQ + lane * 64;
#pragma unroll
        for (int i = 0; i < 64; ++i) dst[i] = excl + loc[i];
    }
    if (vb < 256) {
        const int cu = vb, kv = cu >> 7, bg = (cu >> 4) & 7, nt = cu & 15;
        const int b = bg >> 1, g = bg & 1;
        int n = nt * 16 + (lane & 15); const int nc = n < 255 ? n : 254;
        const h16* Ab = p.Z + (size_t)(b * SEQ + 16 * nc) * ZLD + 1536 + kv * 128 + g * 64 + (lane >> 4) * 8;
        const h16* Wb = p.Wc + (size_t)kv * 64 * 2048 + (size_t)(lane & 15) * 2048 + (lane >> 4) * 8;
        const h16* Pb = p.Pos16 + (lane >> 4) * 8;
        f32x4 acc[4];
#pragma unroll
        for (int e = 0; e < 4; ++e) acc[e] = (f32x4){0.f, 0.f, 0.f, 0.f};
#pragma unroll
        for (int k2 = 0; k2 < 16; ++k2) {
            const int ks = wid * 16 + k2, l = ks >> 1, d0 = (ks & 1) * 32;
            half8 a = *(const half8*)(Ab + (size_t)l * ZLD + d0);
            const half8 ps = *(const half8*)(Pb + ks * 32);
            a = a + ps;
#pragma unroll
            for (int e = 0; e < 4; ++e) {
                const half8 w = *(const half8*)(Wb + (size_t)e * 16 * 2048 + ks * 32);
                acc[e] = __builtin_amdgcn_mfma_f32_16x16x32_f16(a, w, acc[e], 0, 0, 0);
            }
        }
        f32x4* part = (f32x4*)smem;
#pragma unroll
        for (int e = 0; e < 4; ++e) part[(wid * 4 + e) * 64 + lane] = acc[e];
        hsync();
        {
            const int e = wid;
            const f32x4 s = (part[(0 * 4 + e) * 64 + lane] + part[(1 * 4 + e) * 64 + lane]) + (part[(2 * 4 + e) * 64 + lane] + part[(3 * 4 + e) * 64 + lane]);
            const int n0 = nt * 16 + (lane >> 4) * 4, ec = e * 16 + (lane & 15);
            if (kv == 0) {
#pragma unroll
                for (int j = 0; j < 4; ++j) p.KC[((size_t)bg * 256 + n0 + j) * 64 + ec] = (n0 + j < 255) ? (h16)s[j] : (h16)0.f;
            } else {
                half4 o;
#pragma unroll
                for (int j = 0; j < 4; ++j) o[j] = (n0 + j < 255) ? (h16)s[j] : (h16)0.f;
                *(half4*)(p.VCt + ((size_t)bg * 64 + ec) * 256 + n0) = o;
            }
        }
        hsync();
    }
    weight_jobs(p, smem, false, 0);
    wp_job(p, 0);
}

struct RowState { float m, l; f32x16 o0, o1; };
__device__ __forceinline__ void rs_reset(RowState& s) { s.m = NEGBIG; s.l = 0.f; s.o0 = zero16(); s.o1 = zero16(); }

__device__ __forceinline__ void kv_load(const h16* kb, int kst, const h16* vb, int vst, half8 (&kr)[2], half8 (&vr)[2]) {
    const int tid = tidx_();
#pragma unroll
    for (int i = 0; i < 2; ++i) {
        const int c = tid + 256 * i, row = c >> 3, cc = (c & 7) * 8;
        kr[i] = *(const half8*)(kb + (size_t)row * kst + cc);
        vr[i] = *(const half8*)(vb + (size_t)row * vst + cc);
    }
}
__device__ __forceinline__ void kv_store(h16* Ks, h16* Vs, const half8 (&kr)[2], const half8 (&vr)[2]) {
    const int tid = tidx_();
#pragma unroll
    for (int i = 0; i < 2; ++i) {
        const int c = tid + 256 * i, row = c >> 3, cc = (c & 7) * 8;
        *(half8*)(Ks + row * KST + cc) = kr[i];
        *(half8*)(Vs + row * KST + cc) = vr[i];
    }
}
__device__ __forceinline__ void qk_tile(const h16* Ks, const half8 (&qf)[4], f32x16 (&s)[2], int lane) {
    const int r32 = lane & 31, hh = lane >> 5;
#pragma unroll
    for (int kt = 0; kt < 2; ++kt) {
        s[kt] = zero16();
#pragma unroll
        for (int ks = 0; ks < 4; ++ks) {
            const half8 kf = *(const half8*)(Ks + (kt * 32 + r32) * KST + ks * 16 + hh * 8);
            s[kt] = __builtin_amdgcn_mfma_f32_32x32x16_f16(kf, qf[ks], s[kt], 0, 0, 0);
        }
    }
}
__device__ __forceinline__ void pv_tile(const h16* Vs, const f32x16 (&pr)[2], f32x16& o0, f32x16& o1, int lane) {
    const int r32 = lane & 31, hh = lane >> 5;
#pragma unroll
    for (int kt = 0; kt < 2; ++kt)
#pragma unroll
        for (int s2 = 0; s2 < 2; ++s2) {
            half8 pf;
#pragma unroll
            for (int j = 0; j < 8; ++j) pf[j] = (h16)pr[kt][8 * s2 + j];
            const int kof = kt * 32 + 16 * s2 + 4 * hh;
            {
                const half4 a = *(const half4*)(Vs + r32 * KST + kof), b = *(const half4*)(Vs + r32 * KST + kof + 8);
                half8 vf; vf[0] = a[0]; vf[1] = a[1]; vf[2] = a[2]; vf[3] = a[3]; vf[4] = b[0]; vf[5] = b[1]; vf[6] = b[2]; vf[7] = b[3];
                o0 = __builtin_amdgcn_mfma_f32_32x32x16_f16(vf, pf, o0, 0, 0, 0);
            }
            {
                const half4 a = *(const half4*)(Vs + (32 + r32) * KST + kof), b = *(const half4*)(Vs + (32 + r32) * KST + kof + 8);
                half8 vf; vf[0] = a[0]; vf[1] = a[1]; vf[2] = a[2]; vf[3] = a[3]; vf[4] = b[0]; vf[5] = b[1]; vf[6] = b[2]; vf[7] = b[3];
                o1 = __builtin_amdgcn_mfma_f32_32x32x16_f16(vf, pf, o1, 0, 0, 0);
            }
        }
}

enum { M_FOX = 0, M_SLC = 1, M_WIN = 2 };
template <int MODE, bool MASKED>
__device__ __forceinline__ void flash_step(const h16* Ks, const h16* Vs, const float* csS, const half8 (&qf)[4], RowState& st,
                                           int t, int kpos0, float slope2, float ct2, bool selbit, int lane) {
    const int hh = lane >> 5;
    f32x16 s[2];
    qk_tile(Ks, qf, s, lane);
    int dbase = t - kpos0 - 4 * hh;
    asm volatile("" : "+v"(dbase));
    const float off = (MODE == M_FOX) ? ct2 : -slope2 * (float)dbase;
    float mx = NEGBIG;
#pragma unroll
    for (int kt = 0; kt < 2; ++kt)
#pragma unroll
        for (int r = 0; r < 16; ++r) {
            const int c = kt * 32 + (r & 3) + 8 * (r >> 2);
            float v;
            if (MODE == M_FOX) v = s[kt][r] - csS[c + 4 * hh];
            else v = fmaf(slope2, (float)c, s[kt][r]);
            if (MASKED) {
                const int dist = dbase - c;
                bool valid;
                if (MODE == M_FOX) valid = dist >= 0; else if (MODE == M_SLC) valid = selbit && dist >= 0; else valid = dist >= 0 && dist < 512;
                v = valid ? v : NEGBIG;
            }
            s[kt][r] = v;
            mx = fmaxf(mx, v);
        }
    mx += off;
    mx = fmaxf(mx, __shfl_xor(mx, 32));
    const bool rowoff = (MODE == M_SLC) && !MASKED && !selbit;
    if (rowoff) mx = NEGBIG;
    const float mn = fmaxf(st.m, mx);
    const float alpha = __builtin_amdgcn_exp2f(st.m - mn);
    st.m = mn;
    const float moff = rowoff ? 1.0e30f : mn - off;
    float ps = 0.f;
#pragma unroll
    for (int kt = 0; kt < 2; ++kt)
#pragma unroll
        for (int r = 0; r < 16; ++r) {
            const float v = s[kt][r];
            float pe = __builtin_amdgcn_exp2f(v - moff);
            if (MASKED) pe = v > -1.0e29f ? pe : 0.f;
            s[kt][r] = pe; ps += pe;
        }
    st.l = st.l * alpha + ps;
#pragma unroll
    for (int r = 0; r < 16; ++r) { st.o0[r] *= alpha; st.o1[r] *= alpha; }
    pv_tile(Vs, s, st.o0, st.o1, lane);
}

template <int MODE>
__device__ __forceinline__ void run_flash(u64 mask, const h16* Kg, int kst, const h16* Vg, int vst, const float* csg, char* smem,
                                          const half8 (&qf)[4], RowState& st, int t, int twlo, int twhi, float slope2, float ct2, u64 sel, int lane) {
    h16* Kb = (h16*)smem; h16* Vb = Kb + 2 * 64 * KST; float* csb = (float*)(Vb + 2 * 64 * KST);
    if (mask == 0ull) return;
    half8 kr[2], vr[2]; float csr = 0.f;
    int jc = __builtin_ctzll(mask); mask &= mask - 1;
    kv_load(Kg + (size_t)jc * 64 * kst, kst, Vg + jc * 64, vst, kr, vr);
    if (MODE == M_FOX && tidx_() < 64) csr = csg[jc * 64 + tidx_()];
    kv_store(Kb, Vb, kr, vr);
    if (MODE == M_FOX && tidx_() < 64) csb[tidx_()] = csr;
    hsync();
    int buf = 0;
    for (;;) {
        int jn = -1;
        if (mask) { jn = __builtin_ctzll(mask); mask &= mask - 1; }
        if (jn >= 0) {
            kv_load(Kg + (size_t)jn * 64 * kst, kst, Vg + jn * 64, vst, kr, vr);
            if (MODE == M_FOX && tidx_() < 64) csr = csg[jn * 64 + tidx_()];
        }
        bool need = jc * 64 <= twhi;
        if (MODE == M_WIN) need = need && (jc * 64 + 63 >= twlo - 511);
        if (need) {
            const bool selbit = (sel >> jc) & 1ull;
            bool full = jc * 64 + 63 <= twlo;
            if (MODE == M_WIN) full = full && (jc * 64 > twhi - 512);
            if (full) flash_step<MODE, false>(Kb + buf * 64 * KST, Vb + buf * 64 * KST, csb + buf * 64, qf, st, t, jc * 64, slope2, ct2, selbit, lane);
            else flash_step<MODE, true>(Kb + buf * 64 * KST, Vb + buf * 64 * KST, csb + buf * 64, qf, st, t, jc * 64, slope2, ct2, selbit, lane);
        }
        if (jn >= 0) {
            kv_store(Kb + (buf ^ 1) * 64 * KST, Vb + (buf ^ 1) * 64 * KST, kr, vr);
            if (MODE == M_FOX && tidx_() < 64) csb[(buf ^ 1) * 64 + tidx_()] = csr;
        }
        hsync();
        if (jn < 0) break;
        jc = jn; buf ^= 1;
    }
}

__device__ __forceinline__ void load_q(const h16* qrow, half8 (&qf)[4], int lane) {
#pragma unroll
    for (int ks = 0; ks < 4; ++ks) qf[ks] = *(const half8*)(qrow + ks * 16 + (lane >> 5) * 8);
}
__device__ __forceinline__ void store_o(h16* orow, const f32x16& o0, const f32x16& o1, int lane) {
    const int hh = lane >> 5;
#pragma unroll
    for (int rg = 0; rg < 4; ++rg) {
        half4 a, b;
#pragma unroll
        for (int j = 0; j < 4; ++j) { a[j] = (h16)o0[4 * rg + j]; b[j] = (h16)o1[4 * rg + j]; }
        *(half4*)(orow + 8 * rg + 4 * hh) = a;
        *(half4*)(orow + 32 + 8 * rg + 4 * hh) = b;
    }
}

__device__ __forceinline__ void oacc_store(float* row, const f32x16& o0, const f32x16& o1, float sc, int lane) {
    const int hh = lane >> 5;
#pragma unroll
    for (int rg = 0; rg < 4; ++rg) {
        *(f32x4*)(row + 8 * rg + 4 * hh) = (f32x4){o0[4 * rg] * sc, o0[4 * rg + 1] * sc, o0[4 * rg + 2] * sc, o0[4 * rg + 3] * sc};
        *(f32x4*)(row + 32 + 8 * rg + 4 * hh) = (f32x4){o1[4 * rg] * sc, o1[4 * rg + 1] * sc, o1[4 * rg + 2] * sc, o1[4 * rg + 3] * sc};
    }
}
__device__ __forceinline__ void oacc_add(float* row, const f32x16& o0, const f32x16& o1, float sc, int lane) {
    const int hh = lane >> 5;
#pragma unroll
    for (int rg = 0; rg < 4; ++rg) {
        f32x4 a = *(const f32x4*)(row + 8 * rg + 4 * hh), b = *(const f32x4*)(row + 32 + 8 * rg + 4 * hh);
#pragma unroll
        for (int j = 0; j < 4; ++j) { a[j] += o0[4 * rg + j] * sc; b[j] += o1[4 * rg + j] * sc; }
        *(f32x4*)(row + 8 * rg + 4 * hh) = a; *(f32x4*)(row + 32 + 8 * rg + 4 * hh) = b;
    }
}
__device__ __forceinline__ void oacc_final(const float* row, h16* orow, const f32x16& o0, const f32x16& o1, float sc, int lane) {
    const int hh = lane >> 5;
#pragma unroll
    for (int rg = 0; rg < 4; ++rg) {
        const f32x4 a = *(const f32x4*)(row + 8 * rg + 4 * hh), b = *(const f32x4*)(row + 32 + 8 * rg + 4 * hh);
        half4 x, y;
#pragma unroll
        for (int j = 0; j < 4; ++j) { x[j] = (h16)(a[j] + o0[4 * rg + j] * sc); y[j] = (h16)(b[j] + o1[4 * rg + j] * sc); }
        *(half4*)(orow + 8 * rg + 4 * hh) = x; *(half4*)(orow + 32 + 8 * rg + 4 * hh) = y;
    }
}

__device__ __forceinline__ void fox_unit(PRef p, int b, int h, int qt, char* smem) {
    const int tid = tidx_(), lane = tid & 63, wid = widx_();
    const int q0 = qt * 128, t0w = q0 + wid * 32, t = t0w + (lane & 31);
    half8 qf[4]; load_q(p.Z + (size_t)(b * SEQ + t) * ZLD + h * 64, qf, lane);
    const float* csg = p.C2 + (size_t)(b * 8 + h) * SEQ;
    const float ct2 = csg[t];
    RowState st; rs_reset(st);
    const int jmax = (q0 + 127) >> 6;
    const u64 mask = (jmax >= 63) ? ~0ull : ((1ull << (jmax + 1)) - 1ull);
    run_flash<M_FOX>(mask, p.Z + (size_t)b * SEQ * ZLD + 512 + h * 64, ZLD, p.VtF + (size_t)(b * 8 + h) * 64 * SEQ, SEQ, csg, smem,
                     qf, st, t, t0w, t0w + 31, 0.f, ct2, 0ull, lane);
    const float lt = st.l + __shfl_xor(st.l, 32);
    const float inv = 1.0f / lt;
#pragma unroll
    for (int r = 0; r < 16; ++r) { st.o0[r] *= inv; st.o1[r] *= inv; }
    store_o(p.O + (size_t)(b * SEQ + t) * DM + h * 64, st.o0, st.o1, lane);
}

__device__ __forceinline__ void nsa_unit(PRef p, int b, int g, int qt32, char* smem) {
    const int tid = tidx_(), lane = tid & 63, wid = widx_(), hh = lane >> 5, r32 = lane & 31;
    const int t0 = qt32 * 32, t = t0 + r32, head = g * 4 + wid, bg = b * 2 + g;
    const float slope2 = exp2f(-(float)(head + 1)) * LOG2E;
    half8 qf[4]; load_q(p.Z + (size_t)(b * SEQ + t) * ZLD + 1024 + head * 64, qf, lane);
    const float* gp = p.FG + (size_t)(b * SEQ + t) * 32 + 8 + head * 3;
    const float gate_c = gp[0], gate_s = gp[1], gate_w = gp[2];
    h16* Kb = (h16*)smem; h16* Vb = Kb + 2 * 64 * KST;
    u64* selS = (u64*)(smem + 37376);
    u64* unS = selS + 32;
    float* oaccrow = p.OACC + (size_t)(b * SEQ + t) * 512 + head * 64;
    unsigned* impS = (unsigned*)(smem + 37888);
    {
        for (int i = tid; i < 32 * 64; i += NTHR) impS[i] = 0u;
        const int nsteps = ((t0 >> 4) >> 6) + 1;
        const h16* Kg = p.KC + (size_t)bg * 256 * 64; const h16* Vg = p.VCt + (size_t)bg * 64 * 256;
        float mrun = NEGBIG, lrun = 0.f;
        for (int i = 0; i < nsteps; ++i) {
            half8 kr[2], vr[2];
            kv_load(Kg + (size_t)i * 64 * 64, 64, Vg + i * 64, 256, kr, vr);
            kv_store(Kb, Vb, kr, vr);
            hsync();
            f32x16 s[2];
            qk_tile(Kb, qf, s, lane);
            float mx = NEGBIG;
            int dbase = t - 31 - 16 * (i * 64 + 4 * hh);
            asm volatile("" : "+v"(dbase));
#pragma unroll
            for (int kt = 0; kt < 2; ++kt)
#pragma unroll
                for (int r = 0; r < 16; ++r) {
                    const int dist = dbase - 16 * (kt * 32 + (r & 3) + 8 * (r >> 2));
                    float v = s[kt][r] - slope2 * (float)dist;
                    v = dist >= 0 ? v : NEGBIG;
                    s[kt][r] = v; mx = fmaxf(mx, v);
                }
            mx = fmaxf(mx, __shfl_xor(mx, 32));
            const float mn = fmaxf(mrun, mx), alpha = __builtin_amdgcn_exp2f(mrun - mn);
            mrun = mn;
            float ps = 0.f;
#pragma unroll
            for (int kt = 0; kt < 2; ++kt)
#pragma unroll
                for (int r = 0; r < 16; ++r) { const float v = s[kt][r]; ps += v > -1.0e29f ? __builtin_amdgcn_exp2f(v - mn) : 0.f; }
            lrun = lrun * alpha + ps;
            hsync();
        }
        const float lt = lrun + __shfl_xor(lrun, 32);
        const float inv = lt > 0.f ? 1.0f / lt : 0.f;
        f32x16 o0 = zero16(), o1 = zero16();
        float carry = 0.f;
        for (int i = 0; i < nsteps; ++i) {
            half8 kr[2], vr[2];
            kv_load(Kg + (size_t)i * 64 * 64, 64, Vg + i * 64, 256, kr, vr);
            kv_store(Kb, Vb, kr, vr);
            hsync();
            f32x16 s[2];
            qk_tile(Kb, qf, s, lane);
            int dbase = t - 31 - 16 * (i * 64 + 4 * hh);
            asm volatile("" : "+v"(dbase));
#pragma unroll
            for (int kt = 0; kt < 2; ++kt)
#pragma unroll
                for (int r = 0; r < 16; ++r) {
                    const int dist = dbase - 16 * (kt * 32 + (r & 3) + 8 * (r >> 2));
                    const float v = s[kt][r] - slope2 * (float)dist;
                    s[kt][r] = dist >= 0 ? __builtin_amdgcn_exp2f(v - mrun) * inv : 0.f;
                }
            float R[2][4];
#pragma unroll
            for (int kt = 0; kt < 2; ++kt)
#pragma unroll
                for (int rg = 0; rg < 4; ++rg) R[kt][rg] = __shfl_xor(s[kt][4 * rg + 3], 32);
#pragma unroll
            for (int kt = 0; kt < 2; ++kt)
#pragma unroll
                for (int rg = 0; rg < 4; ++rg) {
                    const float G = (s[kt][4 * rg] + s[kt][4 * rg + 1]) + (s[kt][4 * rg + 2] + s[kt][4 * rg + 3]);
                    const float prev = (kt == 0 && rg == 0) ? carry : (rg > 0 ? R[kt][rg - 1] : R[kt - 1][3]);
                    const float val = G + (hh ? R[kt][rg] : prev);
                    const int j = 16 * i + 8 * kt + 2 * rg + hh;
                    atomicAdd(&impS[r32 * 64 + j], (unsigned)(val * 67108864.0f + 0.5f));
                }
            carry = R[1][3];
            pv_tile(Vb, s, o0, o1, lane);
            hsync();
        }
        oacc_store(oaccrow, o0, o1, gate_c, lane);
    }
    hsync();
    {
        u64 un = 0ull;
        for (int i = 0; i < 8; ++i) {
            const int tok = wid * 8 + i, tt = t0 + tok, cur = tt >> 6;
            const int j = lane;
            const bool valid = j <= cur;
            const bool forced = (j == 0) || (j == cur) || (j == cur - 1);
            const unsigned key = valid ? impS[tok * 64 + j] + (forced ? 0x40000000u : 0u) : 0u;
            int rank = 0;
            for (int jj = 0; jj < 64; ++jj) {
                const unsigned kv = (unsigned)__builtin_amdgcn_readlane((int)key, jj);
                rank += (kv > key || (kv == key && jj < j)) ? 1 : 0;
            }
            const u64 selm = __ballot(valid && rank < 16);
            if (lane == 0) selS[tok] = selm;
            un |= selm;
        }
        if (lane == 0) unS[wid] = un;
    }
    hsync();
    const u64 mysel = selS[r32];
    const u64 un = unS[0] | unS[1] | unS[2] | unS[3];
    hsync();
    {
        RowState st; rs_reset(st);
        run_flash<M_SLC>(un, p.Z + (size_t)b * SEQ * ZLD + 1792 + g * 64, ZLD, p.VtS + (size_t)bg * 64 * SEQ, SEQ, nullptr, smem,
                         qf, st, t, t0, t0 + 31, slope2, 0.f, mysel, lane);
        const float lt = st.l + __shfl_xor(st.l, 32);
        oacc_add(oaccrow, st.o0, st.o1, gate_s / lt, lane);
    }
    {
        RowState st; rs_reset(st);
        const int lo = t0 - 511, jlo = lo > 0 ? (lo >> 6) : 0, jhi = (t0 + 31) >> 6;
        u64 mask = (jhi >= 63 ? ~0ull : ((1ull << (jhi + 1)) - 1ull)) & ~((1ull << jlo) - 1ull);
        run_flash<M_WIN>(mask, p.Z + (size_t)b * SEQ * ZLD + 1920 + g * 64, ZLD, p.VtW + (size_t)bg * 64 * SEQ, SEQ, nullptr, smem,
                         qf, st, t, t0, t0 + 31, slope2, 0.f, 0ull, lane);
        const float lt = st.l + __shfl_xor(st.l, 32);
        oacc_final(oaccrow, p.O + (size_t)(b * SEQ + t) * DM + 512 + head * 64, st.o0, st.o1, gate_w / lt, lane);
    }
}

__device__ __forceinline__ void phase_attention(PRef p, char* smem) {
    int* nxt = (int*)(smem + 65536 - 16);
    for (;;) {
        if (tidx_() == 0) *nxt = (int)__hip_atomic_fetch_add(p.BAR + XCD_BAR_WORDS_C, 1u, __ATOMIC_RELAXED, __HIP_MEMORY_SCOPE_AGENT);
        hsync();
        const int q = *nxt;
        hsync();
        if (q >= 2048 + 1024) break;
        const int q5 = q % 5, blk = q / 5;
        if (q < 2560 && (q5 == 2 || q5 == 4)) {
            const int c = blk * 2 + (q5 == 4 ? 1 : 0), tbl = c >> 8, layer = tbl >> 1, rp0 = (c & 255) * 32 + widx_() * 8, lane = tidx_() & 63;
            const float* srcp = ((tbl & 1) ? p.peer_v : p.peer_u) + (size_t)layer * 16384 * 1024;
            unsigned char* dstp = ((tbl & 1) ? p.V8 : p.U8) + (size_t)layer * 16384 * 1024;
            float* sclp = ((tbl & 1) ? p.VS : p.US) + layer * 16384;
            for (int i = 0; i < 8; i += 2) { const int rps[2] = {rp0 + i, rp0 + i + 1}; fp6_rows<2>(srcp, dstp, sclp, rps, lane); }
            continue;
        }
        const int u = q < 2560 ? blk * 3 + (q5 == 3 ? 2 : q5) : q - 1024;
        const int st = 31 - (u >> 6), w = u & 63;
        if (w & 1) { const int idx = w >> 1; nsa_unit(p, (idx & 7) >> 1, idx & 1, st * 4 + (idx >> 3), smem); }
        else { const int idx = w >> 1; fox_unit(p, idx >> 3, idx & 7, st, smem); }
    }
}

__device__ __forceinline__ void phase_rmsnorm(PRef p, const float* g) {
    const int lane = tidx_() & 63, wv = bidx_() * 4 + widx_(), nwv = GRIDV * 4;
    for (int row = wv; row < TOK; row += nwv) {
        float v[16]; load_row16(p.H + (size_t)row * DM, v, lane);
        rms_write_h16(v, g, p.HN + (size_t)row * DM, lane);
    }
}

__device__ __forceinline__ unsigned fkey(float f) { const unsigned b = __float_as_uint(f); return b ^ ((b >> 31) ? 0xFFFFFFFFu : 0x80000000u); }
__device__ __forceinline__ float fkey_inv(unsigned k) { return __uint_as_float(k ^ ((k >> 31) ? 0x80000000u : 0xFFFFFFFFu)); }
__device__ __forceinline__ void ce_desc(unsigned& a, unsigned& b) { const unsigned hi = a > b ? a : b, lo = a > b ? b : a; a = hi; b = lo; }
__device__ __forceinline__ void sort16_desc(unsigned (&k)[16]) {
#pragma unroll
    for (int size = 2; size <= 16; size <<= 1)
#pragma unroll
        for (int stride = size >> 1; stride > 0; stride >>= 1)
#pragma unroll
            for (int i = 0; i < 16; ++i) {
                const int j = i ^ stride;
                if (j > i) { if ((i & size) == 0) ce_desc(k[i], k[j]); else ce_desc(k[j], k[i]); }
            }
}
__device__ __forceinline__ void merge16_desc(unsigned (&run)[16], const unsigned (&b)[16]) {
#pragma unroll
    for (int i = 0; i < 16; ++i) run[i] = run[i] > b[15 - i] ? run[i] : b[15 - i];
#pragma unroll
    for (int stride = 8; stride > 0; stride >>= 1)
#pragma unroll
        for (int i = 0; i < 16; ++i) { const int j = i ^ stride; if (j > i) ce_desc(run[i], run[j]); }
}
__device__ __forceinline__ void list_top16(const h16* __restrict__ base, unsigned (&run)[16]) {
    half8 cur0 = *(const half8*)base, cur1 = *(const half8*)(base + 512), nxt0 = cur0, nxt1 = cur1;
#pragma unroll 1
    for (int bt = 0; bt < 8; ++bt) {
        if (bt < 7) { nxt0 = *(const half8*)(base + (size_t)(2 * bt + 2) * 512); nxt1 = *(const half8*)(base + (size_t)(2 * bt + 3) * 512); }
        unsigned kb[16];
#pragma unroll
        for (int i = 0; i < 8; ++i) {
            kb[i] = (fkey((float)cur0[i]) & ~127u) | (unsigned)(127 - (bt * 16 + i));
            kb[8 + i] = (fkey((float)cur1[i]) & ~127u) | (unsigned)(127 - (bt * 16 + 8 + i));
        }
        sort16_desc(kb);
        if (bt == 0) {
#pragma unroll
            for (int i = 0; i < 16; ++i) run[i] = kb[i];
        } else merge16_desc(run, kb);
        cur0 = nxt0; cur1 = nxt1;
    }
}
__device__ __forceinline__ void phase_peer_topk(PRef p, char* smem) {
    const int tid = tidx_(), lane = tid & 63, wv = bidx_() * 4 + widx_(), nwv = GRIDV * 4;
    int* idS = (int*)smem; float* evS = (float*)smem + 16 * NTHR;
    for (int u = wv; u < 8 * (TOK / 64); u += nwv) {
        const int h = u >> 8, tk = (u & 255) * 64 + lane;
        const h16* b0 = p.SC + ((size_t)((tk >> 6) * 256 + h * 32) * 64 + lane) * 8;
        unsigned k0[16], k1[16];
        list_top16(b0, k0);
        list_top16(b0 + 16 * 512, k1);
        float v0[16], v1[16]; int i0[16], i1[16];
#pragma unroll
        for (int j = 0; j < 16; ++j) {
            v0[j] = fkey_inv(k0[j] & ~127u); i0[j] = 127 - (int)(k0[j] & 127u);
            v1[j] = fkey_inv(k1[j] & ~127u); i1[j] = 127 - (int)(k1[j] & 127u);
        }
        unsigned run[16];
        {
            unsigned kb[16]; int n = 0, nb = 0;
#pragma unroll
            for (int a = 0; a < 16; ++a)
#pragma unroll
                for (int b = 0; b < 16; ++b)
                    if ((a + 1) * (b + 1) <= 16) {
                        kb[n] = fkey(v0[a] + v1[b]); ++n;
                        if (n == 16) {
                            sort16_desc(kb);
                            if (nb == 0) {
#pragma unroll
                                for (int i = 0; i < 16; ++i) run[i] = kb[i];
                            } else merge16_desc(run, kb);
                            n = 0; ++nb;
                        }
                    }
#pragma unroll
            for (int i = 2; i < 16; ++i) kb[i] = 0u;
            sort16_desc(kb); merge16_desc(run, kb);
        }
        const unsigned tkey = run[15]; const float smax = fkey_inv(run[0]);
        int cnt = 0; float esum = 0.f;
#pragma unroll
        for (int j = 0; j < 16; ++j) { idS[j * NTHR + tid] = 0; evS[j * NTHR + tid] = 0.f; }
#pragma unroll
        for (int pass = 0; pass < 2; ++pass)
#pragma unroll
            for (int a = 0; a < 16; ++a)
#pragma unroll
                for (int b = 0; b < 16; ++b)
                    if ((a + 1) * (b + 1) <= 16) {
                        const float s = v0[a] + v1[b]; const unsigned ks = fkey(s);
                        const bool take = pass == 0 ? (ks > tkey) : (ks == tkey && cnt < 16);
                        if (take) {
                            const float e = __expf(s - smax);
                            idS[cnt * NTHR + tid] = i0[a] * 128 + i1[b]; evS[cnt * NTHR + tid] = e;
                            esum += e; ++cnt;
                        }
                    }
        const float rinv = 1.0f / esum;
        int* ip = p.IDS + (size_t)tk * 128 + h * 16; float* gp = p.GW + (size_t)tk * 128 + h * 16;
#pragma unroll
        for (int q = 0; q < 4; ++q) {
            *(i32x4*)(ip + 4 * q) = (i32x4){idS[(4 * q) * NTHR + tid], idS[(4 * q + 1) * NTHR + tid], idS[(4 * q + 2) * NTHR + tid], idS[(4 * q + 3) * NTHR + tid]};
            *(f32x4*)(gp + 4 * q) = (f32x4){evS[(4 * q) * NTHR + tid] * rinv, evS[(4 * q + 1) * NTHR + tid] * rinv, evS[(4 * q + 2) * NTHR + tid] * rinv, evS[(4 * q + 3) * NTHR + tid] * rinv};
        }
    }
}

struct Q6 { i32x4 a; i32x2 b; };
__device__ __forceinline__ Q6 ld6(const unsigned char* row, int g) { Q6 r; r.a = *(const i32x4*)(row + g * 16); r.b = *(const i32x2*)(row + 512 + g * 8); return r; }
__device__ __forceinline__ u32x6 mk6(const Q6 q) { u32x6 r; r[0] = q.a[0]; r[1] = q.a[1]; r[2] = q.a[2]; r[3] = q.a[3]; r[4] = q.b[0]; r[5] = q.b[1]; return r; }
__device__ __forceinline__ float dot32_fp6h(const h16x32 xv, const Q6 q) {
    const h16x32 uf = __builtin_amdgcn_cvt_scalef32_pk32_f16_fp6(mk6(q), 1.0f);
    float d0 = 0.f, d1 = 0.f;
#pragma unroll
    for (int m = 0; m < 16; m += 2) {
        d0 = __builtin_amdgcn_fdot2((half2v){uf[2 * m], uf[2 * m + 1]}, (half2v){xv[2 * m], xv[2 * m + 1]}, d0, false);
        d1 = __builtin_amdgcn_fdot2((half2v){uf[2 * m + 2], uf[2 * m + 3]}, (half2v){xv[2 * m + 2], xv[2 * m + 3]}, d1, false);
    }
    return d0 + d1;
}
__device__ __forceinline__ void axpy32_fp6(f32x2 (&acc)[16], float w, const Q6 q) {
    const f32x32 vf = __builtin_amdgcn_cvt_scalef32_pk32_f32_fp6(mk6(q), 1.0f);
    const f32x2 ww = {w, w};
#pragma unroll
    for (int m = 0; m < 16; ++m) acc[m] = __builtin_elementwise_fma(ww, (f32x2){vf[2 * m], vf[2 * m + 1]}, acc[m]);
}
constexpr int ET_SHIFT = 9, ET_N = 16384 >> ET_SHIFT;
__device__ __forceinline__ void phase_peer_experts(PRef p, int layer, const float* gnext, int mode, char* smem) {
    const int lane = tidx_() & 63, wid = widx_(), wv = bidx_() * 4 + wid, nwv = GRIDV * 4;
    const int hh = lane >> 5, g = lane & 31, dpl = (lane >> 2) & 7;
    const unsigned char* U = p.U8 + (size_t)layer * 16384 * 1024; const unsigned char* V = p.V8 + (size_t)layer * 16384 * 1024;
    const float* US = p.US + layer * 16384; const float* VS = p.VS + layer * 16384;
    const bool b4 = (lane & 16) != 0, b3 = (lane & 8) != 0, b2 = (lane & 4) != 0;
    int* sid = (int*)smem + wid * 512 + hh * 128;
    float* sgw = (float*)(sid + 256);
    for (int tb = wv * 2; tb < TOK; tb += nwv * 2) {
        const int tk = tb + hh;
        h16x32 xv;
#pragma unroll
        for (int c = 0; c < 8; ++c) {
            const half4 t = *(const half4*)(p.HN + (size_t)tk * DM + c * 128 + g * 4);
#pragma unroll
            for (int j = 0; j < 4; ++j) xv[4 * c + j] = t[j];
        }
        {
            int idv[4]; float gv[4];
#pragma unroll
            for (int s = 0; s < 4; ++s) { idv[s] = p.IDS[(size_t)tk * 128 + s * 32 + g]; gv[s] = p.GW[(size_t)tk * 128 + s * 32 + g]; }
            int cnt = 0;
            const unsigned below = (1u << g) - 1u;
            for (int e = 0; e < ET_N; ++e) {
#pragma unroll
                for (int s = 0; s < 4; ++s) {
                    const bool in = (idv[s] >> ET_SHIFT) == e;
                    const u64 m = __ballot(in);
                    const unsigned mh = hh ? (unsigned)(m >> 32) : (unsigned)m;
                    if (in) { const int pos = cnt + __popc(mh & below); sid[pos] = idv[s]; sgw[pos] = gv[s]; }
                    cnt += __popc(mh);
                }
            }
        }
        f32x2 acc[16];
#pragma unroll
        for (int i = 0; i < 16; ++i) acc[i] = (f32x2){0.f, 0.f};
        for (int bt = 0; bt < 16; ++bt) {
            const int mine = sid[bt * 8 + dpl]; const float gwm = sgw[bt * 8 + dpl];
            const float usm = US[mine], vsm = VS[mine];
            const i32x4 ida = *(const i32x4*)(sid + bt * 8), idb = *(const i32x4*)(sid + bt * 8 + 4);
            Q6 uq[8], vq[8];
#pragma unroll
            for (int k = 0; k < 8; ++k) {
                const unsigned off = (unsigned)(k < 4 ? ida[k & 3] : idb[k & 3]) * ROW6;
                uq[k] = ld6(U + off, g); vq[k] = ld6(V + off, g);
            }
            float d[8];
#pragma unroll
            for (int k = 0; k < 8; ++k) d[k] = dot32_fp6h(xv, uq[k]);
            float r4[4], r2[2], z;
#pragma unroll
            for (int i = 0; i < 4; ++i) { const float keep = b4 ? d[i + 4] : d[i], send = b4 ? d[i] : d[i + 4]; r4[i] = keep + __shfl_xor(send, 16); }
#pragma unroll
            for (int i = 0; i < 2; ++i) { const float keep = b3 ? r4[i + 2] : r4[i], send = b3 ? r4[i] : r4[i + 2]; r2[i] = keep + __shfl_xor(send, 8); }
            { const float keep = b2 ? r2[1] : r2[0], send = b2 ? r2[0] : r2[1]; z = keep + __shfl_xor(send, 4); }
            z += __shfl_xor(z, 2); z += __shfl_xor(z, 1);
            const float wm = gwm * gelu_exact(z * usm) * vsm;
#pragma unroll
            for (int k = 0; k < 8; ++k) {
                const float w0 = __builtin_bit_cast(float, __builtin_amdgcn_readlane(__builtin_bit_cast(int, wm), 4 * k));
                const float w1 = __builtin_bit_cast(float, __builtin_amdgcn_readlane(__builtin_bit_cast(int, wm), 32 + 4 * k));
                axpy32_fp6(acc, hh ? w1 : w0, vq[k]);
            }
        }
        float hv[32];
        {
            const h16* hr = p.H + (size_t)tk * DM + g * 4;
#pragma unroll
            for (int c = 0; c < 8; ++c) { const half4 t = *(const half4*)(hr + c * 128); hv[4 * c] = (float)t[0] + acc[2 * c][0]; hv[4 * c + 1] = (float)t[1] + acc[2 * c][1]; hv[4 * c + 2] = (float)t[2] + acc[2 * c + 1][0]; hv[4 * c + 3] = (float)t[3] + acc[2 * c + 1][1]; }
        }
        float ss = 0.f;
#pragma unroll
        for (int i = 0; i < 32; ++i) ss += hv[i] * hv[i];
#pragma unroll
        for (int o = 16; o > 0; o >>= 1) ss += __shfl_xor(ss, o);
        const float rstd = rsqrtf(ss * (1.0f / 1024.0f) + 1e-6f);
        const float* gr = gnext + g * 4;
        if (mode == 0) {
            h16* hw = p.H + (size_t)tk * DM + g * 4;
#pragma unroll
            for (int c = 0; c < 8; ++c) {
                { half4 t; t[0] = (h16)hv[4 * c]; t[1] = (h16)hv[4 * c + 1]; t[2] = (h16)hv[4 * c + 2]; t[3] = (h16)hv[4 * c + 3]; *(half4*)(hw + c * 128) = t; }
                const f32x4 ga = *(const f32x4*)(gr + c * 128);
                half4 o;
#pragma unroll
                for (int j = 0; j < 4; ++j) o[j] = (h16)(hv[4 * c + j] * rstd * ga[j]);
                *(half4*)(p.HN + (size_t)tk * DM + c * 128 + g * 4) = o;
            }
        } else {
            float* ow = p.out + (size_t)tk * DM + g * 4;
#pragma unroll
            for (int c = 0; c < 8; ++c) { const f32x4 ga = *(const f32x4*)(gr + c * 128); *(f32x4*)(ow + c * 128) = (f32x4){hv[4 * c] * rstd * ga[0], hv[4 * c + 1] * rstd * ga[1], hv[4 * c + 2] * rstd * ga[2], hv[4 * c + 3] * rstd * ga[3]}; }
        }
    }
}

constexpr int XST = 136;
__device__ __forceinline__ float fast_sigmoid(float v) { return __builtin_amdgcn_rcpf(1.0f + __expf(-v)); }
__device__ __forceinline__ float gelu_as(float v) {
    const float av = fabsf(v), t = __builtin_amdgcn_rcpf(av * 0.2316419f + 1.0f);
    float q = t * 0.5307027145f - 0.7265760135f; q = q * t + 0.7107068705f; q = q * t - 0.142248368f; q = q * t + 0.127414796f; q = q * t;
    const float e = __builtin_amdgcn_exp2f(v * v * -0.72134752044f);
    const float m = v * (q * e);
    return v < 0.f ? m : v - m;
}
__device__ __forceinline__ void phase_rnn_gates(PRef p, char* smem) {
    h16* xcS = (h16*)smem;
    float* aggS = (float*)(smem + 64 * XST * 2);
    h16* laS = (h16*)(smem + 64 * XST * 2 + 4096);
    h16* ruS = laS + 64 * XST;
    const int tid = tidx_(), lane = tid & 63, wid = widx_();
    for (int u = bidx_(); u < 4 * 64 * 10; u += GRIDV) {
        const int nb = u % 10, ck = (u / 10) & 63, b = u / 640;
        const int s0 = ck * 64, ch0 = nb * 128;
        {
            const int c8 = (tid & 15) * 8, tq = (tid >> 4) * 4, ch = ch0 + c8;
            float w[4][8], bias[8];
#pragma unroll
            for (int j = 0; j < 4; ++j) {
                const f32x4 w0 = *(const f32x4*)(p.odd_conv_w + j * DRNN + ch), w1 = *(const f32x4*)(p.odd_conv_w + j * DRNN + ch + 4);
#pragma unroll
                for (int i = 0; i < 4; ++i) { w[j][i] = w0[i]; w[j][4 + i] = w1[i]; }
            }
            { const f32x4 b0 = *(const f32x4*)(p.odd_conv_b + ch), b1 = *(const f32x4*)(p.odd_conv_b + ch + 4);
#pragma unroll
              for (int i = 0; i < 4; ++i) { bias[i] = b0[i]; bias[4 + i] = b1[i]; } }
            half8 xin[7];
#pragma unroll
            for (int r = 0; r < 7; ++r) {
                const int sp = s0 + tq - 3 + r;
                if (sp >= 0) xin[r] = *(const half8*)(p.Z2 + (size_t)(b * SEQ + sp) * Z2LD + DRNN + ch);
                else {
#pragma unroll
                    for (int i = 0; i < 8; ++i) xin[r][i] = (h16)0.f;
                }
            }
#pragma unroll
            for (int tt = 0; tt < 4; ++tt) {
                half8 o;
#pragma unroll
                for (int i = 0; i < 8; ++i) {
                    float a = bias[i];
#pragma unroll
                    for (int j = 0; j < 4; ++j) a = fmaf(w[j][i], (float)xin[tt + j][i], a);
                    o[i] = (h16)a;
                }
                *(half8*)(xcS + (tq + tt) * XST + c8) = o;
            }
        }
        hsync();
        float bra2[2], bri2[2], sp2[2];
#pragma unroll
        for (int e = 0; e < 2; ++e) {
            const int chq = ch0 + (wid * 2 + e) * 16 + (lane & 15);
            bra2[e] = p.odd_b_ra[chq]; bri2[e] = p.odd_b_ri[chq]; sp2[e] = p.odd_lam[chq];
        }
#pragma unroll
        for (int e = 0; e < 2; ++e) sp2[e] = fmaxf(-sp2[e], 0.f) + __logf(1.0f + __expf(-fabsf(sp2[e])));
        f32x4 ar[4][2], ai[4][2];
#pragma unroll
        for (int m = 0; m < 4; ++m)
#pragma unroll
            for (int e = 0; e < 2; ++e) { ar[m][e] = (f32x4){0.f, 0.f, 0.f, 0.f}; ai[m][e] = (f32x4){0.f, 0.f, 0.f, 0.f}; }
        const h16* wr = p.Wr + (size_t)nb * 16384 + (wid * 32 + (lane & 15)) * 128 + (lane >> 4) * 8;
        const h16* wi = p.Wr + (size_t)(10 + nb) * 16384 + (wid * 32 + (lane & 15)) * 128 + (lane >> 4) * 8;
#pragma unroll
        for (int ks = 0; ks < 4; ++ks) {
            half8 a[4];
#pragma unroll
            for (int m = 0; m < 4; ++m) a[m] = *(const half8*)(xcS + (m * 16 + (lane & 15)) * XST + ks * 32 + (lane >> 4) * 8);
#pragma unroll
            for (int e = 0; e < 2; ++e) {
                const half8 w1 = *(const half8*)(wr + e * 16 * 128 + ks * 32), w2 = *(const half8*)(wi + e * 16 * 128 + ks * 32);
#pragma unroll
                for (int m = 0; m < 4; ++m) {
                    ar[m][e] = __builtin_amdgcn_mfma_f32_16x16x32_f16(a[m], w1, ar[m][e], 0, 0, 0);
                    ai[m][e] = __builtin_amdgcn_mfma_f32_16x16x32_f16(a[m], w2, ai[m][e], 0, 0, 0);
                }
            }
        }
        const int g4 = lane >> 4;
#pragma unroll
        for (int e = 0; e < 2; ++e) {
            const int cl = (wid * 2 + e) * 16 + (lane & 15);
            const float bra = bra2[e], bri = bri2[e], sp = sp2[e];
            float Ac = 1.f, Hc = 0.f;
#pragma unroll
            for (int m = 0; m < 4; ++m) {
                float A = 1.f, H = 0.f;
#pragma unroll
                for (int j = 0; j < 4; ++j) {
                    const int tt = m * 16 + g4 * 4 + j;
                    const float r = fast_sigmoid(ar[m][e][j] + bra), ig = fast_sigmoid(ai[m][e][j] + bri);
                    const h16 la16 = (h16)(-8.0f * r * sp);
                    const float a = __expf((float)la16);
                    const float xc = (float)xcS[tt * XST + cl];
                    const h16 u16 = (h16)(__builtin_amdgcn_sqrtf(fmaxf(1.0f - a * a, 0.f)) * (ig * xc));
                    laS[tt * XST + cl] = la16; ruS[tt * XST + cl] = u16;
                    H = a * H + (float)u16; A *= a;
                }
                { const float Al = __shfl_xor(A, 16), Hl = __shfl_xor(H, 16); if (g4 & 1) { H = Hl * A + H; A = Al * A; } }
                { const float Al = __shfl_xor(A, 32), Hl = __shfl_xor(H, 32); if (g4 == 3) { H = Hl * A + H; A = Al * A; } }
                Hc = Hc * A + H; Ac *= A;
            }
            if (g4 == 3) { p.AggP[(size_t)(b * 64 + ck) * DRNN + ch0 + cl] = Ac; p.AggH[(size_t)(b * 64 + ck) * DRNN + ch0 + cl] = Hc; }
        }
        hsync();
#pragma unroll
        for (int i = 0; i < 4; ++i) {
            const int q = tid + 256 * i, row = q >> 4, c8 = (q & 15) * 8;
            const size_t o = (size_t)(b * SEQ + s0 + row) * DRNN + ch0 + c8;
            *(half8*)(p.LA + o) = *(const half8*)(laS + row * XST + c8);
            *(half8*)(p.RU + o) = *(const half8*)(ruS + row * XST + c8);
        }
    }
}
__device__ __forceinline__ void phase_rnn_scan_b(PRef p) {
    for (int u = bidx_(); u < 4 * 64 * 5; u += GRIDV) {
        const int cb = u % 5, ck = (u / 5) & 63, b = u / 320;
        const int ch = cb * 256 + tidx_();
        float h = 0.f;
        {
            const float* ap = p.AggP + (size_t)(b * 64) * DRNN + ch; const float* hp = p.AggH + (size_t)(b * 64) * DRNN + ch;
            for (int c = 0; c < ck; c += 16) {
                float pa[16], ph[16];
#pragma unroll
                for (int i = 0; i < 16; ++i) { const int ci = min(c + i, ck - 1); pa[i] = ap[(size_t)ci * DRNN]; ph[i] = hp[(size_t)ci * DRNN]; }
#pragma unroll
                for (int i = 0; i < 16; ++i) { const bool ok = c + i < ck; h = (ok ? pa[i] : 1.0f) * h + (ok ? ph[i] : 0.f); }
            }
        }
        const size_t base = (size_t)(b * SEQ + ck * 64) * DRNN + ch;
        h16* zrow = p.Z2 + (size_t)(b * SEQ + ck * 64) * Z2LD;
#pragma unroll 1
        for (int i0 = 0; i0 < 64; i0 += 32) {
            h16 la[32], uu[32], gt[32];
#pragma unroll
            for (int i = 0; i < 32; ++i) { la[i] = p.LA[base + (size_t)(i0 + i) * DRNN]; uu[i] = p.RU[base + (size_t)(i0 + i) * DRNN]; gt[i] = zrow[(size_t)(i0 + i) * Z2LD + ch]; }
#pragma unroll
            for (int i = 0; i < 32; ++i) {
                h = __expf((float)la[i]) * h + (float)uu[i];
                zrow[(size_t)(i0 + i) * Z2LD + DRNN + ch] = (h16)(gelu_as((float)gt[i]) * h);
            }
        }
    }
}

#define XB_TMO      128
#define XB_XCNT(j)  (256  + 64 * (j))
#define XB_XSUB(j)  (1280 + 64 * (j))
#define XB_XGEN(j)  (2304 + 64 * (j))
#define XB_TOP      3328
#define XB_TOPGEN   3392
#define XCD_BAR_WORDS 3456
#define XB_SPIN_CAP (1u << 22)
__device__ __forceinline__ unsigned xb_ld(unsigned* p)              { return __hip_atomic_load(p, __ATOMIC_RELAXED, __HIP_MEMORY_SCOPE_AGENT); }
__device__ __forceinline__ unsigned xb_add(unsigned* p, unsigned v) { return __hip_atomic_fetch_add(p, v, __ATOMIC_RELAXED, __HIP_MEMORY_SCOPE_AGENT); }
__device__ __forceinline__ unsigned xb_xcc_id() { return (unsigned)__builtin_amdgcn_s_getreg((3 << 11) | 20) & 0xFu; }
#define XB_SPIN(cond, bar) do { unsigned _sp = 0; while (cond) { __builtin_amdgcn_s_sleep(1); \
    if ((++_sp & 255u) == 0u) { if (xb_ld(&(bar)[XB_TMO])) break; if (_sp > XB_SPIN_CAP) { atomicAdd(&(bar)[XB_TMO], 1u); break; } } } } while (0)
struct XcdBarrier { unsigned* bar; unsigned x; volatile LAS unsigned* st; };
__device__ __forceinline__ XcdBarrier xcd_barrier_post(unsigned* bar, volatile LAS unsigned* st) {
    XcdBarrier b; b.bar = bar; b.x = xb_xcc_id(); b.st = st;
    if (threadIdx.x == 0) (void)xb_add(&bar[XB_XCNT(b.x)], 1u);
    return b;
}
__device__ __forceinline__ void xcd_barrier_complete(unsigned* bar, unsigned x, unsigned& nloc, unsigned& nx) {
    const unsigned G = gridDim.x * gridDim.y * gridDim.z;
    unsigned sum, cnt, mine, sp = 0u;
    for (;;) {
        sum = 0u; cnt = 0u; mine = 0u;
#pragma unroll
        for (unsigned j = 0; j < 16; ++j) { const unsigned c = xb_ld(&bar[XB_XCNT(j)]); sum += c; cnt += (c > 0u) ? 1u : 0u; mine = (j == x) ? c : mine; }
        if (sum == G) break;
        __builtin_amdgcn_s_sleep(1);
        if ((++sp & 255u) == 0u) { if (xb_ld(&bar[XB_TMO])) break; if (sp > XB_SPIN_CAP) { atomicAdd(&bar[XB_TMO], 1u); break; } }
    }
    nloc = mine > 0u ? mine : 1u; nx = cnt > 0u ? cnt : 1u;
}
__device__ __forceinline__ void xcd_barrier(const XcdBarrier& b) {
    asm volatile("s_waitcnt vmcnt(0)" ::: "memory");
    __syncthreads();
    if (threadIdx.x == 0) {
        unsigned* bar = b.bar;
        __builtin_amdgcn_s_waitcnt(0);
        unsigned nloc = b.st[0], nx = b.st[1];
        if (nloc == 0u) { xcd_barrier_complete(bar, b.x, nloc, nx); b.st[0] = nloc; b.st[1] = nx; }
        const unsigned old = xb_add(&bar[XB_XSUB(b.x)], 1u);
        const unsigned gen = old / nloc;
        if (old + 1u == (gen + 1u) * nloc) {
            __builtin_amdgcn_fence(__ATOMIC_RELEASE, "agent");
            asm volatile("s_waitcnt vmcnt(0)" ::: "memory");
            const unsigned og = xb_add(&bar[XB_TOP], 1u);
            const unsigned tg = og / nx;
            if (og + 1u == (tg + 1u) * nx) xb_add(&bar[XB_TOPGEN], 1u);
            else XB_SPIN(xb_ld(&bar[XB_TOPGEN]) == tg, bar);
            __builtin_amdgcn_fence(__ATOMIC_ACQUIRE, "agent");
            xb_add(&bar[XB_XGEN(b.x)], 1u);
            asm volatile("s_waitcnt vmcnt(0)" ::: "memory");
        } else {
            XB_SPIN(xb_ld(&bar[XB_XGEN(b.x)]) == gen, bar);
            __builtin_amdgcn_fence(__ATOMIC_ACQUIRE, "agent");
            asm volatile("s_waitcnt vmcnt(0)" ::: "memory");
        }
    }
    __syncthreads();
}

namespace pg8 {
#define PG8_LAS __attribute__((address_space(3)))
typedef unsigned short bf16_t;
typedef short bf16x8 __attribute__((ext_vector_type(8)));
typedef unsigned u32x4 __attribute__((ext_vector_type(4)));
constexpr int BM = 256, BK = 64, HALF = 128, HTB = HALF * BK * 2  , STAGE_BYTES = 8 * HTB, NXCD = 8, WGM = 8;

__host__ __device__ __forceinline__ int lds_byte(int r, int c) { const int st = (r >> 4) * 2 + (c >> 5), rr = r & 15, cc = c & 31, ob = rr * 64 + cc * 2; return st * 1024 + (ob ^ (((ob >> 9) & 1) << 5)); }
__host__ __device__ __forceinline__ void stage_rc(int b, int& R, int& C) { const int st = b / 1024, sb = b % 1024, swz = sb ^ (((sb >> 9) & 1) << 5); R = (st >> 1) * 16 + swz / 64; C = (st & 1) * 32 + (swz % 64) / 2; }
__host__ __device__ __forceinline__ int perm32(int rho) { const int n = rho >> 4, i = rho & 15; return 8 * (i >> 2) + 4 * n + (i & 3); }

struct Unit { int pm, pn; };
struct Gemm { const bf16_t* A; const bf16_t* Bt; int M, N, K, lda; };

struct StaticOrder {
    int nM, nN, nwg, G, c;
    __host__ __device__ void init(int M, int N, int G_, int c_) { nM = M / BM; nN = N / BM; nwg = nM * nN; G = G_; c = c_; }
    __host__ __device__ bool next(int i, Unit& u) const {
        const long L = (long)i * G + c; if (L >= nwg) return false;
        int wgid = (int)L; { const int q = nwg / NXCD, r = nwg % NXCD, xcd = wgid % NXCD, off = wgid / NXCD; wgid = (xcd < r ? xcd * (q + 1) : r * (q + 1) + (xcd - r) * q) + off; }
        const int nig = WGM * nN, gid = wgid / nig, fm = gid * WGM, gsz = (nM - fm) < WGM ? (nM - fm) : WGM;
        u.pm = fm + ((wgid % nig) % gsz); u.pn = (wgid % nig) / gsz; return true;
    }
    __device__ __forceinline__ void a_ready(const Unit&) const {}
    __device__ __forceinline__ void done(const Unit&) const {}
};
__device__ __forceinline__ unsigned pk_h16(float lo, float hi) { half2v t; t[0] = (h16)lo; t[1] = (h16)hi; return __builtin_bit_cast(unsigned, t); }
template <bool R16>
struct EpiResid {
    static constexpr bool PERM = true, AFTER_DRAIN = false;
    const void* resid; h16* out; int ldc;
    __device__ __forceinline__ void operator()(const f32x4 (&acc)[2][2][4][2], const Unit& u, int wr, int wc, int fr, int fq) const {
#pragma unroll
        for (int ai = 0; ai < 2; ++ai)
#pragma unroll
            for (int m = 0; m < 4; ++m) { const size_t ro = (size_t)(u.pm * BM + ai * HALF + wr * 64 + m * 16 + fr) * ldc + u.pn * BM + wc * 32 + 8 * fq;
#pragma unroll
                for (int bj = 0; bj < 2; ++bj) { const size_t o = ro + bj * HALF;
                    f32x4 v0 = acc[ai][bj][m][0], v1 = acc[ai][bj][m][1];
                    if (R16) { const half8 r = *(const half8*)((const h16*)resid + o);
#pragma unroll
                        for (int i = 0; i < 4; ++i) { v0[i] += (float)r[i]; v1[i] += (float)r[4 + i]; } }
                    else { v0 += *(const f32x4*)((const float*)resid + o); v1 += *(const f32x4*)((const float*)resid + o + 4); }
                    u32x4 w; w.x = pk_h16(v0[0], v0[1]); w.y = pk_h16(v0[2], v0[3]); w.z = pk_h16(v1[0], v1[1]); w.w = pk_h16(v1[2], v1[3]);
                    *(u32x4*)(out + o) = w; } }
    }
};
struct EpiF32 {
    static constexpr bool PERM = false, AFTER_DRAIN = false;
    float* out; size_t ldc;
    __device__ __forceinline__ void operator()(const f32x4 (&acc)[2][2][4][2], const Unit& u, int wr, int wc, int fr, int fq) const {
#pragma unroll
        for (int ai = 0; ai < 2; ++ai)
#pragma unroll
            for (int m = 0; m < 4; ++m) { const size_t ro = (size_t)(u.pm * BM + ai * HALF + wr * 64 + m * 16 + fr) * ldc + u.pn * BM + wc * 32 + 4 * fq;
#pragma unroll
                for (int bj = 0; bj < 2; ++bj)
#pragma unroll
                    for (int n = 0; n < 2; ++n) *(f32x4*)(out + ro + bj * HALF + n * 16) = acc[ai][bj][m][n]; }
    }
};
struct EpiH16 {
    static constexpr bool PERM = true, AFTER_DRAIN = false;
    h16* out; int ldc;
    __device__ __forceinline__ void operator()(const f32x4 (&acc)[2][2][4][2], const Unit& u, int wr, int wc, int fr, int fq) const {
#pragma unroll
        for (int ai = 0; ai < 2; ++ai)
#pragma unroll
            for (int m = 0; m < 4; ++m) { h16* rowp = out + (size_t)(u.pm * BM + ai * HALF + wr * 64 + m * 16 + fr) * ldc + u.pn * BM + wc * 32 + 8 * fq;
#pragma unroll
                for (int bj = 0; bj < 2; ++bj) { const f32x4 v0 = acc[ai][bj][m][0], v1 = acc[ai][bj][m][1];
                    u32x4 w; w.x = pk_h16(v0[0], v0[1]); w.y = pk_h16(v0[2], v0[3]); w.z = pk_h16(v1[0], v1[1]); w.w = pk_h16(v1[2], v1[3]);
                    *(u32x4*)(rowp + bj * HALF) = w; } }
    }
};
struct EpiSC {
    static constexpr bool PERM = true, AFTER_DRAIN = false;
    h16* out;
    __device__ __forceinline__ void operator()(const f32x4 (&acc)[2][2][4][2], const Unit& u, int wr, int wc, int fr, int fq) const {
#pragma unroll
        for (int ai = 0; ai < 2; ++ai)
#pragma unroll
            for (int m = 0; m < 4; ++m) { const int row = u.pm * BM + ai * HALF + wr * 64 + m * 16 + fr;
#pragma unroll
                for (int bj = 0; bj < 2; ++bj) { const int col = u.pn * BM + bj * HALF + wc * 32 + 8 * fq;
                    const f32x4 v0 = acc[ai][bj][m][0], v1 = acc[ai][bj][m][1];
                    u32x4 w; w.x = pk_h16(v0[0], v0[1]); w.y = pk_h16(v0[2], v0[3]); w.z = pk_h16(v1[0], v1[1]); w.w = pk_h16(v1[2], v1[3]);
                    *(u32x4*)(out + ((size_t)((row >> 6) * 256 + (col >> 3)) * 64 + (row & 63)) * 8) = w; } }
    }
};
struct EpiEvenMain {
    static constexpr bool PERM = true, AFTER_DRAIN = false;
    h16* Z; float* FG; const float* b_f;
    __device__ __forceinline__ void operator()(const f32x4 (&acc)[2][2][4][2], const Unit& u, int wr, int wc, int fr, int fq) const {
#pragma unroll
        for (int bj = 0; bj < 2; ++bj) {
            const int col0 = u.pn * BM + bj * HALF + wc * 32 + 8 * fq;
            if (col0 < 2048) {
                const float sc = (col0 < 512 || (col0 >= 1024 && col0 < 1536)) ? QSCALE : 1.0f;
#pragma unroll
                for (int ai = 0; ai < 2; ++ai)
#pragma unroll
                    for (int m = 0; m < 4; ++m) { const f32x4 v0 = acc[ai][bj][m][0] * sc, v1 = acc[ai][bj][m][1] * sc;
                        u32x4 w; w.x = pk_h16(v0[0], v0[1]); w.y = pk_h16(v0[2], v0[3]); w.z = pk_h16(v1[0], v1[1]); w.w = pk_h16(v1[2], v1[3]);
                        *(u32x4*)(Z + (size_t)(u.pm * BM + ai * HALF + wr * 64 + m * 16 + fr) * ZLD + col0) = w; }
            } else if (col0 < 2080) {
                const int c = col0 - 2048;
#pragma unroll
                for (int ai = 0; ai < 2; ++ai)
#pragma unroll
                    for (int m = 0; m < 4; ++m) { const f32x4 v0 = acc[ai][bj][m][0], v1 = acc[ai][bj][m][1]; f32x4 o0, o1;
                        if (c == 0) {
#pragma unroll
                            for (int q = 0; q < 4; ++q) { o0[q] = log_sigmoid(v0[q] + b_f[q]) * LOG2E; o1[q] = log_sigmoid(v1[q] + b_f[4 + q]) * LOG2E; }
                        } else {
#pragma unroll
                            for (int q = 0; q < 4; ++q) { o0[q] = sigmoidf_(v0[q]); o1[q] = sigmoidf_(v1[q]); }
                        }
                        float* fr_ = FG + (size_t)(u.pm * BM + ai * HALF + wr * 64 + m * 16 + fr) * 32 + c;
                        *(f32x4*)fr_ = o0; *(f32x4*)(fr_ + 4) = o1; }
            }
        }
    }
};
struct EpiVt {
    static constexpr bool PERM = true, AFTER_DRAIN = false;
    h16 *VtF, *VtS, *VtW;
    __device__ __forceinline__ void operator()(const f32x4 (&acc)[2][2][4][2], const Unit& u, int wr, int wc, int fr, int fq) const {
#pragma unroll
        for (int ai = 0; ai < 2; ++ai)
#pragma unroll
            for (int m = 0; m < 4; ++m) {
                const int n = u.pm * BM + ai * HALF + wr * 64 + m * 16 + fr;
#pragma unroll
                for (int bj = 0; bj < 2; ++bj) {
                    const int t0 = u.pn * BM + bj * HALF + wc * 32 + 8 * fq, b = t0 >> 12, s = t0 & 4095;
                    h16* dst = n < 512 ? VtF + ((size_t)(b * 512 + n)) * SEQ + s : (n < 640 ? VtS + ((size_t)(b * 128 + n - 512)) * SEQ + s : VtW + ((size_t)(b * 128 + n - 640)) * SEQ + s);
                    const f32x4 v0 = acc[ai][bj][m][0], v1 = acc[ai][bj][m][1];
                    u32x4 w; w.x = pk_h16(v0[0], v0[1]); w.y = pk_h16(v0[2], v0[3]); w.z = pk_h16(v1[0], v1[1]); w.w = pk_h16(v1[2], v1[3]);
                    *(u32x4*)dst = w;
                }
            }
    }
};

template <class Epi, class Sched, bool ALIGN_EPI = false, bool SP2 = false>
__device__ __forceinline__ void gemm_phase(PG8_LAS unsigned char* lds, const Gemm g, const Sched& S, const Epi& E) {
    int tid_ = threadIdx.x; asm volatile("" : "+v"(tid_));
    const int tid = tid_, wid = __builtin_amdgcn_readfirstlane(tid >> 6), lane = tid & 63, wr = wid >> 2, wc = wid & 3, fr = lane & 15, fq = lane >> 4;
    const int K = g.K, nt = K / BK;
    unsigned voffA[2], voffB[2];
#pragma unroll
    for (int i = 0; i < 2; ++i) { int R, C; stage_rc(tid * 16 + i * 8192, R, C); const int Rb = Epi::PERM ? ((R & ~31) + perm32(R & 31)) : R;
        voffA[i] = (unsigned)(R * g.lda + C) * 2u; voffB[i] = (unsigned)(Rb * K + C) * 2u; }
    const size_t kstep = (size_t)(BK * 2);
    const size_t hstepA = (size_t)HALF * g.lda * 2, hstepB = (size_t)HALF * K * 2;
    const size_t tstepA = 2 * hstepA, tstepB = 2 * hstepB;
    const unsigned ldsw = (unsigned)wid * 1024u;
    const int aoff = lds_byte(wr * 64 + fr, fq * 8), boff = lds_byte(wc * 32 + fr, fq * 8);
#define PG8_SA(b, h) (((b) * 2 + (h)) * HTB)
#define PG8_SB(b, h) ((4 + (b) * 2 + (h)) * HTB)
#define PG8_STAGE(bufoff, gbase, voff) do { _Pragma("unroll") for (int _i = 0; _i < 2; ++_i) \
        __builtin_amdgcn_global_load_lds((const unsigned*)((const char*)(gbase) + (voff)[_i]), (PG8_LAS unsigned*)(lds + (bufoff) + ldsw + _i * 8192), 16, 0, 0); } while (0)
#define PG8_LDA(dst, b, h) do { _Pragma("unroll") for (int m = 0; m < 4; ++m) _Pragma("unroll") for (int k = 0; k < 2; ++k) dst[m][k] = *(const PG8_LAS bf16x8*)(lds + PG8_SA(b, h) + aoff + m * 2048 + k * 1024); } while (0)
#define PG8_LDB(dst, b, h) do { _Pragma("unroll") for (int n = 0; n < 2; ++n) _Pragma("unroll") for (int k = 0; k < 2; ++k) dst[n][k] = *(const PG8_LAS bf16x8*)(lds + PG8_SB(b, h) + boff + n * 2048 + k * 1024); } while (0)
#define PG8_MMA(ai, bj, At, Bt) do { __builtin_amdgcn_s_setprio(1); _Pragma("unroll") for (int m = 0; m < 4; ++m) _Pragma("unroll") for (int n = 0; n < 2; ++n) _Pragma("unroll") for (int k = 0; k < 2; ++k) \
        acc[ai][bj][m][n] = __builtin_amdgcn_mfma_f32_16x16x32_f16(__builtin_bit_cast(half8, Bt[n][k]), __builtin_bit_cast(half8, At[m][k]), acc[ai][bj][m][n], 0, 0, 0); __builtin_amdgcn_s_setprio(0); } while (0)
#define PG8_WAIT_V(n) asm volatile("s_waitcnt vmcnt(" #n ")" ::: "memory")
#define PG8_WAIT_L(n) asm volatile("s_waitcnt lgkmcnt(" #n ")" ::: "memory")
#define PG8_BAR __builtin_amdgcn_s_barrier()
#define PG8_SCHED __builtin_amdgcn_sched_barrier(0)
    Unit cur, nxt; int ui = 0;
    if (!S.next(0, cur)) return;
    f32x4 acc[2][2][4][2];
#pragma unroll
    for (int a = 0; a < 2; ++a)
#pragma unroll
        for (int b = 0; b < 2; ++b)
#pragma unroll
            for (int m = 0; m < 4; ++m)
#pragma unroll
                for (int n = 0; n < 2; ++n) acc[a][b][m][n] = (f32x4){0.f, 0.f, 0.f, 0.f};
    bf16x8 At[4][2], B0[2][2], B1[2][2];
    const char* cA = (const char*)g.A + (size_t)cur.pm * tstepA; const char* cB = (const char*)g.Bt + (size_t)cur.pn * tstepB;
    S.a_ready(cur);
    if constexpr (SP2) {
        PG8_STAGE(PG8_SB(0, 0), cB, voffB); PG8_STAGE(PG8_SB(0, 1), cB + hstepB, voffB); PG8_STAGE(PG8_SA(0, 0), cA, voffA); PG8_STAGE(PG8_SA(0, 1), cA + hstepA, voffA);
        if (wr == 1) PG8_BAR;
        PG8_WAIT_V(2); PG8_BAR;
        PG8_STAGE(PG8_SB(1, 0), cB + kstep, voffB); PG8_STAGE(PG8_SA(1, 0), cA + kstep, voffA); PG8_STAGE(PG8_SB(1, 1), cB + hstepB + kstep, voffB);
        PG8_WAIT_V(6); PG8_BAR;
    } else {
        PG8_STAGE(PG8_SB(0, 0), cB, voffB); PG8_STAGE(PG8_SA(0, 0), cA, voffA); PG8_STAGE(PG8_SB(0, 1), cB + hstepB, voffB); PG8_STAGE(PG8_SA(0, 1), cA + hstepA, voffA);
        if (wr == 1) PG8_BAR;
        PG8_WAIT_V(4); PG8_BAR;
        PG8_STAGE(PG8_SB(1, 0), cB + kstep, voffB); PG8_STAGE(PG8_SA(1, 0), cA + kstep, voffA); PG8_STAGE(PG8_SB(1, 1), cB + hstepB + kstep, voffB);
        PG8_WAIT_V(6); PG8_BAR;
    }
    for (;;) {
        const bool has_next = S.next(ui + 1, nxt);
        const char* nA = has_next ? (const char*)g.A + (size_t)nxt.pm * tstepA : cA; const char* nB = has_next ? (const char*)g.Bt + (size_t)nxt.pn * tstepB : cB;
        for (int t = 0; t < nt; t += 2) {
            const bool last = (t == nt - 2);
            const char* a1 = cA + (size_t)(t + 1) * kstep;
            const char* a2 = last ? nA : cA + (size_t)(t + 2) * kstep; const char* b2 = last ? nB : cB + (size_t)(t + 2) * kstep;
            const char* a3 = a2 + kstep; const char* b3 = b2 + kstep;
            if (last && has_next) S.a_ready(nxt);
            if constexpr (SP2) {
            PG8_LDB(B0, 0, 0); PG8_LDB(B1, 0, 1); PG8_SCHED; PG8_LDA(At, 0, 0); PG8_STAGE(PG8_SA(1, 1), a1 + hstepA, voffA);
            PG8_WAIT_V(8); PG8_WAIT_L(0); PG8_BAR; PG8_MMA(0, 0, At, B0); PG8_MMA(0, 1, At, B1); PG8_BAR; PG8_SCHED;
            PG8_LDA(At, 0, 1); PG8_STAGE(PG8_SB(0, 0), b2, voffB); PG8_STAGE(PG8_SB(0, 1), b2 + hstepB, voffB); PG8_STAGE(PG8_SA(0, 0), a2, voffA);
            PG8_WAIT_V(8); PG8_WAIT_L(0); PG8_BAR; PG8_MMA(1, 0, At, B0); PG8_MMA(1, 1, At, B1); PG8_BAR; PG8_SCHED;
            PG8_LDB(B0, 1, 0); PG8_LDB(B1, 1, 1); PG8_SCHED; PG8_LDA(At, 1, 0); PG8_STAGE(PG8_SA(0, 1), a2 + hstepA, voffA);
            PG8_WAIT_V(8); PG8_WAIT_L(0); PG8_BAR; PG8_MMA(0, 0, At, B0); PG8_MMA(0, 1, At, B1); PG8_BAR; PG8_SCHED;
            PG8_LDA(At, 1, 1); PG8_STAGE(PG8_SB(1, 0), b3, voffB); PG8_STAGE(PG8_SB(1, 1), b3 + hstepB, voffB); PG8_STAGE(PG8_SA(1, 0), a3, voffA);
            PG8_WAIT_V(8); PG8_WAIT_L(0); PG8_BAR; PG8_MMA(1, 0, At, B0); PG8_MMA(1, 1, At, B1); PG8_BAR; PG8_SCHED;
            } else {
            PG8_LDB(B0, 0, 0); PG8_SCHED; PG8_LDA(At, 0, 0); PG8_STAGE(PG8_SA(1, 1), a1 + hstepA, voffA);
            PG8_WAIT_L(8); PG8_BAR; PG8_WAIT_L(0); PG8_MMA(0, 0, At, B0); PG8_BAR; PG8_SCHED;
            PG8_LDB(B1, 0, 1); PG8_STAGE(PG8_SB(0, 0), b2, voffB);
            PG8_BAR; PG8_WAIT_L(0); PG8_MMA(0, 1, At, B1); PG8_BAR;
            PG8_LDA(At, 0, 1); PG8_STAGE(PG8_SA(0, 0), a2, voffA);
            PG8_BAR; PG8_WAIT_L(0); PG8_MMA(1, 0, At, B0); PG8_BAR; PG8_SCHED;
            PG8_STAGE(PG8_SB(0, 1), b2 + hstepB, voffB);
            PG8_WAIT_V(6); PG8_BAR; PG8_MMA(1, 1, At, B1); PG8_BAR;
            PG8_LDB(B0, 1, 0); PG8_SCHED; PG8_LDA(At, 1, 0); PG8_STAGE(PG8_SA(0, 1), a2 + hstepA, voffA);
            PG8_WAIT_L(8); PG8_BAR; PG8_WAIT_L(0); PG8_MMA(0, 0, At, B0); PG8_BAR; PG8_SCHED;
            PG8_LDB(B1, 1, 1); PG8_STAGE(PG8_SB(1, 0), b3, voffB);
            PG8_BAR; PG8_WAIT_L(0); PG8_MMA(0, 1, At, B1); PG8_BAR;
            PG8_LDA(At, 1, 1); PG8_STAGE(PG8_SA(1, 0), a3, voffA);
            PG8_BAR; PG8_WAIT_L(0); PG8_MMA(1, 0, At, B0); PG8_BAR; PG8_SCHED;
            PG8_STAGE(PG8_SB(1, 1), b3 + hstepB, voffB);
            PG8_WAIT_V(6); PG8_BAR; PG8_MMA(1, 1, At, B1); PG8_BAR;
            }
        }
        if constexpr (ALIGN_EPI) { if (wr == 0) PG8_BAR; }
        if constexpr (!Epi::AFTER_DRAIN) { E(acc, cur, wr, wc, fr, fq); S.done(cur); }
        if (!has_next) break;
#pragma unroll
        for (int a = 0; a < 2; ++a)
#pragma unroll
            for (int b = 0; b < 2; ++b)
#pragma unroll
                for (int m = 0; m < 4; ++m)
#pragma unroll
                    for (int n = 0; n < 2; ++n) acc[a][b][m][n] = (f32x4){0.f, 0.f, 0.f, 0.f};
        cur = nxt; cA = nA; cB = nB; ++ui;
        if constexpr (ALIGN_EPI) { if (wr == 1) PG8_BAR; }
    }
    PG8_WAIT_V(0);
    if constexpr (!ALIGN_EPI) { if (wr == 0) PG8_BAR; }
    PG8_BAR;
    if constexpr (Epi::AFTER_DRAIN) { E.fused(acc, cur, wr, wc, fr, fq, lds, wid, lane); S.done(cur); }
#undef PG8_SA
#undef PG8_SB
#undef PG8_STAGE
#undef PG8_LDA
#undef PG8_LDB
#undef PG8_MMA
#undef PG8_WAIT_V
#undef PG8_WAIT_L
#undef PG8_BAR
#undef PG8_SCHED
}
}

__device__ __forceinline__ GemmArgs mk_gemm(const h16* A, int lda, const h16* Bt, int ldb, int M, int N, int K, int ans, int mode, h16* c16, int ldc16, float* c32, int ldc32, const float* resid) {
    GemmArgs g; g.A = A; g.lda = lda; g.Bt = Bt; g.ldb = ldb; g.M = M; g.N = N; g.K = K; g.a_ntile_stride = ans; g.mode = mode; g.c16 = c16; g.ldc16 = ldc16; g.c32 = c32; g.ldc32 = ldc32; g.resid = resid; g.aux = nullptr; return g;
}

__device__ __forceinline__ void run_phase(PRef p, int ph, char* smem) {
    if (ph == 1 || ph == 4 || ph == 6 || ph == 10 || ph == 14 || ph == 16) {
        PG8_LAS unsigned char* lds = (PG8_LAS unsigned char*)dyn_lds;
        const int G = (int)gridDim.x, c = (int)blockIdx.x;
        pg8::StaticOrder S;
        typedef const pg8::bf16_t* bp;
        if (ph == 1) {
            { pg8::EpiEvenMain E{p.Z, p.FG, p.even_b_f}; S.init(TOK, ZLD, G, c);
              pg8::gemm_phase<pg8::EpiEvenMain, pg8::StaticOrder, true, true>(lds, pg8::Gemm{(bp)p.HN, (bp)p.WtE, TOK, ZLD, DM, DM}, S, E); }
            { pg8::EpiVt E{p.VtF, p.VtS, p.VtW}; S.init(768, TOK, G, (c + 3 * G / 4) % G);
              pg8::gemm_phase<pg8::EpiVt, pg8::StaticOrder, true, true>(lds, pg8::Gemm{(bp)p.WtV, (bp)p.HN, 768, TOK, DM, DM}, S, E); }
        } else if (ph == 4) {
            pg8::EpiResid<false> E{p.x, p.H, DM}; S.init(TOK, DM, G, c);
            pg8::gemm_phase<pg8::EpiResid<false>, pg8::StaticOrder, true, true>(lds, pg8::Gemm{(bp)p.O, (bp)p.WtEo, TOK, DM, DM, DM}, S, E);
        } else if (ph == 14) {
            pg8::EpiResid<true> E{p.H, p.H, DM}; S.init(TOK, DM, G, c);
            pg8::gemm_phase<pg8::EpiResid<true>, pg8::StaticOrder, true, true>(lds, pg8::Gemm{(bp)(p.Z2 + DRNN), (bp)p.WtOo, TOK, DM, DRNN, Z2LD}, S, E);
        } else if (ph == 10) {
            pg8::EpiH16 E{p.Z2, Z2LD}; S.init(TOK, Z2LD, G, c);
            pg8::gemm_phase<pg8::EpiH16, pg8::StaticOrder, true, true>(lds, pg8::Gemm{(bp)p.HN, (bp)p.WtO, TOK, Z2LD, DM, DM}, S, E);
        } else {
            pg8::EpiSC E{p.SC}; S.init(TOK, 2048, G, c);
            pg8::gemm_phase<pg8::EpiSC, pg8::StaticOrder, true, true>(lds, pg8::Gemm{(bp)p.HN, (bp)(p.WtQ + (ph == 16 ? (size_t)2048 * 1024 : 0)), TOK, 2048, DM, DM}, S, E);
        }
        return;
    }
    if (ph == 0) phase_prep(p, smem);
    else if (ph == 2) phase_cumsum_compress(p, smem);
    else if (ph == 3) phase_attention(p, smem);
    else if (ph == 5 || ph == 15) phase_rmsnorm(p, ph == 5 ? p.ffn_norm_g : p.ffn_norm_g + DM);
    else if (ph == 8 || ph == 18) phase_peer_topk(p, smem);
    else if (ph == 9 || ph == 19) phase_peer_experts(p, ph == 19 ? 1 : 0, ph == 19 ? p.final_g : p.odd_norm_g, ph == 19 ? 1 : 0, smem);
    else if (ph == 11) phase_rnn_gates(p, smem);
    else if (ph == 13) phase_rnn_scan_b(p);
}

__global__ void __launch_bounds__(512, 2) mega(Params p_by_value) {
    char* smem = dyn_lds + hidx_() * 65536;
    volatile LAS unsigned* hs_all = (volatile LAS unsigned*)(dyn_lds + 131072);
    const __attribute__((address_space(4))) Params* kp = (const __attribute__((address_space(4))) Params*)__builtin_amdgcn_kernarg_segment_ptr();
    const int ph0 = (int)kp->ph0, ph1 = (int)kp->ph1;
    if (threadIdx.x < 12) hs_all[threadIdx.x] = 0u;
    __syncthreads();
    XcdBarrier xb = xcd_barrier_post(kp->BAR, hs_all + 8);
    for (int ph = ph0; ph < ph1; ++ph) {
        if (ph == 12 || ph == 7 || ph == 17) continue;
        const __attribute__((address_space(4))) Params* q = kp;
        asm volatile("" : "+s"(q));
        PRef p = *q;
#if PROBE_PH >= 0
        if (blockIdx.x == 0 && threadIdx.x == 0) p.TS[ph] = __builtin_amdgcn_s_memrealtime();
#endif
        const int reps = ((DUP_MASK >> ph) & 1) ? 2 : 1;
        for (int r = 0; r < reps; ++r) { run_phase(p, ph, smem); if (r + 1 < reps) xcd_barrier(xb); }
        if (ph + 1 < ph1) xcd_barrier(xb);
    }
    PRef p = *kp;
#if PROBE_PH >= 0
    cg::this_grid().sync();
    if (blockIdx.x == 0 && threadIdx.x == 0) { p.TS[NPHASE] = __builtin_amdgcn_s_memrealtime(); __threadfence(); }
    cg::this_grid().sync();
    {
        const unsigned long long t0 = __hip_atomic_load(&p.TS[0], __ATOMIC_RELAXED, __HIP_MEMORY_SCOPE_AGENT), t1 = __hip_atomic_load(&p.TS[NPHASE], __ATOMIC_RELAXED, __HIP_MEMORY_SCOPE_AGENT);
        const unsigned long long a = __hip_atomic_load(&p.TS[PROBE_PH], __ATOMIC_RELAXED, __HIP_MEMORY_SCOPE_AGENT), b = __hip_atomic_load(&p.TS[PROBE_PH + PROBE_N], __ATOMIC_RELAXED, __HIP_MEMORY_SCOPE_AGENT);
        const float frac = (float)(b - a) / (float)(t1 - t0);
        const float scale = 1.1f + frac;
        for (size_t i = (size_t)blockIdx.x * 512 + threadIdx.x; i < (size_t)TOK * DM; i += (size_t)gridDim.x * 512) p.out[i] *= scale;
    }
#endif
}

constexpr int DYN_LDS_BYTES = 131072 + 64;
extern "C" void kernel_launch(void* const* d_in, const int* in_sizes, int n_in, void* d_out, int out_size, void* d_ws, size_t ws_size, hipStream_t stream) {
    Params p; memset(&p, 0, sizeof(p));
    const float* const* in = (const float* const*)d_in;
    p.x = in[0]; p.even_norm_g = in[1]; p.even_w_in = in[2]; p.even_b_f = in[3]; p.even_cmp_pos = in[4]; p.even_w_cmp_k = in[5]; p.even_w_cmp_v = in[6]; p.even_w_out = in[7];
    p.odd_norm_g = in[8]; p.odd_w_in = in[9]; p.odd_conv_w = in[10]; p.odd_conv_b = in[11]; p.odd_w_ra = in[12]; p.odd_b_ra = in[13]; p.odd_w_ri = in[14]; p.odd_b_ri = in[15];
    p.odd_lam = in[16]; p.odd_w_out = in[17]; p.ffn_norm_g = in[18]; p.peer_w_q = in[19]; p.peer_sub_keys = in[20]; p.peer_u = in[21]; p.peer_v = in[22]; p.final_g = in[23];
    p.out = (float*)d_out;
    char* ws = (char*)d_ws; size_t off = 0;
    auto take = [&](size_t bytes) { char* r = ws + off; off += (bytes + 255) & ~(size_t)255; return r; };
    p.WtE = (h16*)take((size_t)ZLD * 1024 * 2); p.WtV = (h16*)take((size_t)768 * 1024 * 2); p.WtEo = (h16*)take((size_t)1024 * 1024 * 2); p.WtO = (h16*)take((size_t)2560 * 1024 * 2); p.WtOo = (h16*)take((size_t)1024 * 1280 * 2);
    p.WtQ = (h16*)take((size_t)2 * 2048 * 1024 * 2); p.Wc = (h16*)take((size_t)2 * 64 * 2048 * 2); p.Wr = (h16*)take((size_t)20 * 16384 * 2); p.Keys = (h16*)take((size_t)2 * 8 * 2 * 128 * 128 * 2);
    p.Pos16 = (h16*)take(4096); p.U8 = (unsigned char*)take((size_t)2 * 16384 * 1024); p.V8 = (unsigned char*)take((size_t)2 * 16384 * 1024);
    p.US = (float*)take((size_t)2 * 16384 * 4); p.VS = (float*)take((size_t)2 * 16384 * 4);
    p.H = (h16*)take((size_t)TOK * DM * 2); p.HN = (h16*)take((size_t)TOK * DM * 2);
    const size_t scratch0 = off;
    p.Z = (h16*)take((size_t)TOK * ZLD * 2); p.VtF = (h16*)take((size_t)4 * 8 * 64 * SEQ * 2); p.VtS = (h16*)take((size_t)4 * 2 * 64 * SEQ * 2); p.VtW = (h16*)take((size_t)4 * 2 * 64 * SEQ * 2);
    p.KC = (h16*)take((size_t)8 * 256 * 64 * 2); p.VCt = (h16*)take((size_t)8 * 64 * 256 * 2); p.O = (h16*)take((size_t)TOK * DM * 2); p.FG = (float*)take((size_t)TOK * 32 * 4); p.C2 = (float*)take((size_t)32 * SEQ * 4); p.OACC = (float*)take((size_t)TOK * 512 * 4);
    size_t mx = off;
    off = scratch0;
    p.QP = (h16*)take((size_t)TOK * 2048 * 2); p.SC = (h16*)take((size_t)TOK * 2048 * 2); p.IDS = (int*)take((size_t)TOK * 128 * 4); p.GW = (float*)take((size_t)TOK * 128 * 4);
    if (off > mx) mx = off;
    off = scratch0;
    p.Z2 = (h16*)take((size_t)TOK * Z2LD * 2); p.LA = (h16*)take((size_t)TOK * DRNN * 2); p.RU = (h16*)take((size_t)TOK * DRNN * 2);
    p.AggP = (float*)take((size_t)4 * 64 * DRNN * 4); p.AggH = (float*)take((size_t)4 * 64 * DRNN * 4);
    if (off > mx) mx = off;
    off = mx; p.TS = (unsigned long long*)take(256); p.BAR = (unsigned*)take(XCD_BAR_WORDS * 4 + 256); mx = off;
    if (mx > ws_size) { fprintf(stderr, "workspace too small: need %zu have %zu\n", mx, ws_size); return; }

    static int grid_blocks = 0;
    if (!grid_blocks) {
        int dev = 0, cus = 0, per_cu = 0;
        hipGetDevice(&dev);
        hipDeviceGetAttribute(&cus, hipDeviceAttributeMultiprocessorCount, dev);
        hipFuncSetAttribute((const void*)mega, hipFuncAttributeMaxDynamicSharedMemorySize, DYN_LDS_BYTES);
        hipOccupancyMaxActiveBlocksPerMultiprocessor(&per_cu, mega, 512, DYN_LDS_BYTES);
        if (per_cu > 1) per_cu = 1;
        if (per_cu < 1) per_cu = 1;
        grid_blocks = cus * per_cu;
    }
    hipMemsetAsync(p.BAR, 0, XCD_BAR_WORDS * 4 + 256, stream);
#if SINGLE_LAUNCH
    p.ph0 = 0; p.ph1 = NPHASE;
    void* args[] = {&p};
    hipError_t e = hipLaunchCooperativeKernel((void*)mega, dim3(grid_blocks), dim3(512), args, DYN_LDS_BYTES, stream);
    if (e != hipSuccess) fprintf(stderr, "cooperative launch failed: %s (grid %d)\n", hipGetErrorString(e), grid_blocks);
#else
    for (int ph = 0; ph < NPHASE; ++ph) {
        p.ph0 = ph; p.ph1 = ph + 1;
        hipLaunchKernelGGL(mega, dim3(grid_blocks), dim3(512), DYN_LDS_BYTES, stream, p);
    }
#endif
}
```

```cpp
#include <hip/hip_runtime.h>
#include <hip/hip_cooperative_groups.h>
#include <cstdio>
#include <cstdint>
#include <cstring>
namespace cg = cooperative_groups;

#ifndef SINGLE_LAUNCH
#define SINGLE_LAUNCH 1
#endif
#ifndef PROBE_PH
#define PROBE_PH -1
#endif
#ifndef PROBE_N
#define PROBE_N 1
#endif
#ifndef DUP_MASK
#define DUP_MASK 0
#endif

typedef _Float16 h16;
typedef _Float16 half8 __attribute__((ext_vector_type(8)));
typedef _Float16 half4 __attribute__((ext_vector_type(4)));
typedef _Float16 half2v __attribute__((ext_vector_type(2)));
typedef float f32x4 __attribute__((ext_vector_type(4)));
typedef float f32x16 __attribute__((ext_vector_type(16)));
typedef unsigned long long u64;
typedef int i32x4 __attribute__((ext_vector_type(4)));
typedef float f32x2 __attribute__((ext_vector_type(2)));
typedef float f32x32 __attribute__((ext_vector_type(32)));
typedef _Float16 h16x32 __attribute__((ext_vector_type(32)));
typedef unsigned u32x6 __attribute__((ext_vector_type(6)));
typedef int i32x2 __attribute__((ext_vector_type(2)));
typedef i32x4 __attribute__((aligned(8))) i32x4_a8;

#define NTHR 256
constexpr int BATCH = 4, SEQ = 4096, DM = 1024, TOK = BATCH * SEQ;
constexpr int ZLD = 2304, Z2LD = 2560, DRNN = 1280;
constexpr int EVEN_IN = 2848;
constexpr float LOG2E = 1.4426950408889634f;
constexpr float QSCALE = 0.125f * LOG2E;
constexpr float NEGBIG = -1.0e30f;
constexpr int KST = 72;
constexpr int NPHASE = 20;
constexpr int XCD_BAR_WORDS_C = 3456;

struct Params {
    const float *x, *even_norm_g, *even_w_in, *even_b_f, *even_cmp_pos, *even_w_cmp_k, *even_w_cmp_v, *even_w_out;
    const float *odd_norm_g, *odd_w_in, *odd_conv_w, *odd_conv_b, *odd_w_ra, *odd_b_ra, *odd_w_ri, *odd_b_ri, *odd_lam, *odd_w_out;
    const float *ffn_norm_g, *peer_w_q, *peer_sub_keys, *peer_u, *peer_v, *final_g;
    float* out;
    h16 *WtE, *WtV, *WtEo, *WtO, *WtOo, *WtQ, *Wc, *Wr, *Keys, *Pos16;
    unsigned char *U8, *V8; float *US, *VS;
    h16* H; h16* HN;
    h16 *Z, *VtF, *VtS, *VtW, *KC, *VCt, *O; float *FG, *C2, *OACC;
    float* SSQ;
    h16* QP; h16* SC; int* IDS; float* GW;
    h16* Z2; h16 *LA, *RU; float *AggP, *AggH;
    unsigned long long* TS; unsigned* BAR;
    long long ph0, ph1;
};

typedef const __attribute__((address_space(4))) Params& PRef;
extern __shared__ __attribute__((aligned(16))) char dyn_lds[];
#define GRIDV ((int)gridDim.x * 2)
#define LAS __attribute__((address_space(3)))
__device__ __forceinline__ int hidx_() { return __builtin_amdgcn_readfirstlane((int)threadIdx.x >> 8); }
__device__ __forceinline__ int tidx_() { int t = threadIdx.x & 255; asm volatile("" : "+v"(t)); return t; }
__device__ __forceinline__ int bidx_() { int b = blockIdx.x * 2 + hidx_(); asm volatile("" : "+s"(b)); return b; }
__device__ __forceinline__ int widx_() { return __builtin_amdgcn_readfirstlane(((int)threadIdx.x >> 6) & 3); }
__device__ __forceinline__ void hsync() {
    volatile LAS unsigned* w = (volatile LAS unsigned*)(dyn_lds + 131072 + hidx_() * 16);
    asm volatile("s_waitcnt lgkmcnt(0)" ::: "memory");
    if ((threadIdx.x & 63) == 0) {
        const unsigned old = __hip_atomic_fetch_add((LAS unsigned*)w, 1u, __ATOMIC_RELAXED, __HIP_MEMORY_SCOPE_WORKGROUP);
        const unsigned target = (old | 3u) + 1u;
        while ((int)(w[0] - target) < 0) { }
    }
    asm volatile("s_waitcnt lgkmcnt(0)" ::: "memory");
}

__device__ __forceinline__ float wave_sum(float v) {
#pragma unroll
    for (int o = 32; o > 0; o >>= 1) v += __shfl_xor(v, o);
    return v;
}
__device__ __forceinline__ int mbcnt64(u64 m) { return __builtin_amdgcn_mbcnt_hi((unsigned)(m >> 32), __builtin_amdgcn_mbcnt_lo((unsigned)m, 0)); }
__device__ __forceinline__ float gelu_exact(float v) { return 0.5f * v * (1.0f + erff(v * 0.70710678118654752f)); }
__device__ __forceinline__ float sigmoidf_(float v) { return 1.0f / (1.0f + __expf(-v)); }
__device__ __forceinline__ float log_sigmoid(float v) { return v >= 0.f ? -log1pf(expf(-v)) : v - log1pf(expf(v)); }
__device__ __forceinline__ int crow(int r, int hi) { return (r & 3) + 8 * (r >> 2) + 4 * hi; }
__device__ __forceinline__ f32x16 zero16() { f32x16 z;
#pragma unroll
    for (int i = 0; i < 16; ++i) z[i] = 0.f; return z; }

__device__ __forceinline__ void rms_write_h16(const float (&v)[16], const float* __restrict__ g, h16* __restrict__ dst, int lane) {
    float ss = 0.f;
#pragma unroll
    for (int i = 0; i < 16; ++i) ss += v[i] * v[i];
    ss = wave_sum(ss);
    const float rstd = rsqrtf(ss * (1.0f / 1024.0f) + 1e-6f);
#pragma unroll
    for (int hseg = 0; hseg < 2; ++hseg) {
        const int c0 = hseg * 512 + lane * 8;
        const f32x4 g0 = *(const f32x4*)(g + c0), g1 = *(const f32x4*)(g + c0 + 4);
        half8 o;
#pragma unroll
        for (int i = 0; i < 4; ++i) { o[i] = (h16)(v[hseg * 8 + i] * rstd * g0[i]); o[4 + i] = (h16)(v[hseg * 8 + 4 + i] * rstd * g1[i]); }
        *(half8*)(dst + c0) = o;
    }
}
__device__ __forceinline__ void load_row16(const float* __restrict__ src, float (&v)[16], int lane) {
#pragma unroll
    for (int hseg = 0; hseg < 2; ++hseg) {
        const int c0 = hseg * 512 + lane * 8;
        const f32x4 a = *(const f32x4*)(src + c0), b = *(const f32x4*)(src + c0 + 4);
#pragma unroll
        for (int i = 0; i < 4; ++i) { v[hseg * 8 + i] = a[i]; v[hseg * 8 + 4 + i] = b[i]; }
    }
}

__device__ __forceinline__ void load_row16(const h16* __restrict__ src, float (&v)[16], int lane) {
#pragma unroll
    for (int hseg = 0; hseg < 2; ++hseg) {
        const half8 a = *(const half8*)(src + hseg * 512 + lane * 8);
#pragma unroll
        for (int i = 0; i < 8; ++i) v[hseg * 8 + i] = (float)a[i];
    }
}

__device__ __forceinline__ int even_col_map(int n, int kind) {
    if (kind == 2) {
        if (n < 512) return 1024 + n;
        if (n < 640) return 2056 + 3 * 128 + (n - 512);
        return 2056 + 5 * 128 + (n - 640);
    }
    if (n < 1024) return n;
    if (n < 1536) return 1544 + (n - 1024);
    if (n < 1664) return 2056 + (n - 1536);
    if (n < 1792) return 2056 + 128 + (n - 1664);
    if (n < 1920) return 2056 + 256 + (n - 1792);
    if (n < 2048) return 2056 + 512 + (n - 1920);
    if (n < 2056) return 1536 + (n - 2048);
    if (n < 2080) return 2824 + (n - 2056);
    return -1;
}
__device__ __forceinline__ void transpose_job(const float* __restrict__ src, int K, int N, h16* __restrict__ dst, int Ndst, int mapped, float* tileS, int& base, int b0) {
    const int tid = tidx_(), nb = (int)GRIDV - b0, bid = bidx_() - b0;
    const int nkt = K / 64, nnt = Ndst / 64, ntiles = nkt * nnt;
    int first = (bid - (base % nb) + nb) % nb;
    for (int tile = first; tile < ntiles; tile += nb) {
        const int k0 = (tile % nkt) * 64, n0 = (tile / nkt) * 64;
#pragma unroll
        for (int i = 0; i < 16; ++i) {
            const int e = tid + 256 * i, kk = e >> 6, nn = e & 63;
            const int sc = mapped ? even_col_map(n0 + nn, mapped) : (n0 + nn);
            tileS[kk * 65 + nn] = (sc >= 0) ? src[(size_t)(k0 + kk) * N + sc] : 0.f;
        }
        hsync();
        const int n = tid >> 2, ks = (tid & 3) * 16;
        half8 o0, o1;
#pragma unroll
        for (int i = 0; i < 8; ++i) { o0[i] = (h16)tileS[(ks + i) * 65 + n]; o1[i] = (h16)tileS[(ks + 8 + i) * 65 + n]; }
        h16* d = dst + (size_t)(n0 + n) * K + k0 + ks;
        *(half8*)d = o0; *(half8*)(d + 8) = o1;
        hsync();
    }
    base += ntiles;
}
__device__ __forceinline__ void convert_job(const float* __restrict__ src, h16* __restrict__ dst, size_t n) {
    const size_t n4 = n / 4, stride = (size_t)GRIDV * NTHR;
    for (size_t i = (size_t)bidx_() * NTHR + tidx_(); i < n4; i += stride) {
        const f32x4 v = *(const f32x4*)(src + 4 * i);
        half4 o; o[0] = (h16)v[0]; o[1] = (h16)v[1]; o[2] = (h16)v[2]; o[3] = (h16)v[3];
        *(half4*)(dst + 4 * i) = o;
    }
}
constexpr int ROW6 = 768;
template <int NP>
__device__ __forceinline__ void fp6_rows(const float* __restrict__ src, unsigned char* __restrict__ dst, float* __restrict__ scl, const int (&rps)[NP], int lane) {
    const int hh = lane >> 5, g = lane & 31;
    f32x4 v[NP][8];
#pragma unroll
    for (int q = 0; q < NP; ++q)
#pragma unroll
        for (int c = 0; c < 8; ++c) v[q][c] = *(const f32x4*)(src + (size_t)(rps[q] * 2 + hh) * 1024 + c * 128 + g * 4);
#pragma unroll
    for (int q = 0; q < NP; ++q) {
        float am = 0.f;
#pragma unroll
        for (int c = 0; c < 8; ++c) am = fmaxf(am, fmaxf(fmaxf(fabsf(v[q][c][0]), fabsf(v[q][c][1])), fmaxf(fabsf(v[q][c][2]), fabsf(v[q][c][3]))));
#pragma unroll
        for (int o = 16; o > 0; o >>= 1) am = fmaxf(am, __shfl_xor(am, o));
        const float sc = am > 0.f ? am * (1.0f / 7.5f) : 1.0f, inv = 1.0f / sc;
        h16x32 hv;
#pragma unroll
        for (int c = 0; c < 8; ++c)
#pragma unroll
            for (int j = 0; j < 4; ++j) hv[4 * c + j] = (h16)(v[q][c][j] * inv);
        const u32x6 pk = __builtin_amdgcn_cvt_scalef32_pk32_fp6_f16(hv, 1.0f);
        unsigned char* o = dst + (size_t)(rps[q] * 2 + hh) * ROW6;
        *(i32x4*)(o + g * 16) = (i32x4){(int)pk[0], (int)pk[1], (int)pk[2], (int)pk[3]};
        *(i32x2*)(o + 512 + g * 8) = (i32x2){(int)pk[4], (int)pk[5]};
        if (g == 0) scl[rps[q] * 2 + hh] = sc;
    }
}
__device__ __forceinline__ void fp6_rows_job(const float* __restrict__ src, unsigned char* __restrict__ dst, float* __restrict__ scl, int npairs, int wv0) {
    const int lane = tidx_() & 63, wv = bidx_() * 4 + widx_() - wv0, nwv = GRIDV * 4 - wv0;
    if (wv < 0) return;
    int r = wv;
    for (; r + nwv < npairs; r += 2 * nwv) { const int rps[2] = {r, r + nwv}; fp6_rows<2>(src, dst, scl, rps, lane); }
    for (; r < npairs; r += nwv) { const int rps[1] = {r}; fp6_rows<1>(src, dst, scl, rps, lane); }
}
__device__ __forceinline__ void weight_jobs(PRef p, char* smem, bool first_only, int b0) {
    float* tileS = (float*)smem;
    int base = 0;
    const int jlo = 0, jhi = 28;
    for (int job = jlo; job < jhi; ++job) {
        if (first_only != (job == 0 || job == 4 || job == 6 || job == 7)) continue;
        const float* src; int K, N, Nd; h16* dst; int mapped = 0;
        if (job == 0) { src = p.even_w_in; K = 1024; N = EVEN_IN; dst = p.WtE; Nd = ZLD; mapped = 1; }
        else if (job == 1) { src = p.even_w_out; K = 1024; N = 1024; dst = p.WtEo; Nd = 1024; }
        else if (job == 2) { src = p.odd_w_in; K = 1024; N = 2560; dst = p.WtO; Nd = 2560; }
        else if (job == 3) { src = p.odd_w_out; K = 1280; N = 1024; dst = p.WtOo; Nd = 1024; }
        else if (job == 4) { src = p.even_w_in; K = 1024; N = EVEN_IN; dst = p.WtV; Nd = 768; mapped = 2; }
        else if (job == 5) continue;
        else if (job == 6) { src = p.even_w_cmp_k; K = 2048; N = 64; dst = p.Wc; Nd = 64; }
        else if (job == 7) { src = p.even_w_cmp_v; K = 2048; N = 64; dst = p.Wc + 64 * 2048; Nd = 64; }
        else if (job < 18) { const int n = job - 8; src = p.odd_w_ra + n * 16384; K = 128; N = 128; dst = p.Wr + n * 16384; Nd = 128; }
        else { const int n = job - 18; src = p.odd_w_ri + n * 16384; K = 128; N = 128; dst = p.Wr + (10 + n) * 16384; Nd = 128; }
        transpose_job(src, K, N, dst, Nd, mapped, tileS, base, b0);
    }
}
__device__ __forceinline__ void phase_prep(PRef p, char* smem) {
    weight_jobs(p, smem, true, 0);
    convert_job(p.peer_sub_keys, p.Keys, (size_t)2 * 8 * 2 * 128 * 128);
    convert_job(p.even_cmp_pos, p.Pos16, 2048);
    const int lane = tidx_() & 63, wv = bidx_() * 4 + widx_(), nwv = GRIDV * 4;
    for (int row = wv; row < TOK; row += nwv) {
        float v[16]; load_row16(p.x + (size_t)row * DM, v, lane);
        rms_write_h16(v, p.even_norm_g, p.HN + (size_t)row * DM, lane);
    }
}

enum { EPI_EVEN_IN = 0, EPI_F32_RESID = 1, EPI_H16 = 2, EPI_F32T = 3, EPI_QSCORE = 4 };
struct GemmArgs {
    const h16* A; int lda; const h16* Bt; int ldb; int M, N, K; int a_ntile_stride;
    int mode; h16* c16; int ldc16; float* c32; int ldc32; const float* resid; const h16* aux;
};
template <int MODE, int LDC>
__device__ __forceinline__ void gemm_epilogue(PRef p, const GemmArgs& g, int mt, int nt, bool sw, const f32x4 (&acc)[4][4]) {
    const int lane = tidx_() & 63, wid = widx_(), wm = wid >> 1, wn = wid & 1;
    const int l4 = (lane >> 4) * 4, l15 = lane & 15;
    if (MODE == EPI_EVEN_IN) {
        int kind;
        if (nt < 4 || (nt >= 12 && nt < 16)) kind = 0; else if (nt >= 8 && nt < 12) kind = 2; else if (nt == 19) kind = 3; else if (nt == 21) kind = 4; else if (nt == 22) kind = 5; else kind = 1;
#pragma unroll
        for (int i = 0; i < 4; ++i)
#pragma unroll
            for (int j = 0; j < 4; ++j) {
                const f32x4 v = acc[i][j];
                if (kind <= 1) {
                    const int row = mt * 128 + wm * 64 + j * 16 + l15, col = nt * 128 + wn * 64 + i * 16 + l4;
                    const float sc = kind == 0 ? QSCALE : 1.0f;
                    half4 o; o[0] = (h16)(v[0] * sc); o[1] = (h16)(v[1] * sc); o[2] = (h16)(v[2] * sc); o[3] = (h16)(v[3] * sc);
                    *(half4*)(p.Z + (size_t)row * ZLD + col) = o;
                } else if (kind <= 4) {
                    const int row = mt * 128 + wm * 64 + i * 16 + l4, col = nt * 128 + wn * 64 + j * 16 + l15;
                    const int b = row >> 12, s = row & 4095;
                    half4 o; o[0] = (h16)v[0]; o[1] = (h16)v[1]; o[2] = (h16)v[2]; o[3] = (h16)v[3];
                    h16* dst;
                    if (kind == 2) { const int c = col - 1024; dst = p.VtF + ((size_t)(b * 8 + (c >> 6)) * 64 + (c & 63)) * SEQ + s; }
                    else if (kind == 3) { const int c = col - 2432; dst = p.VtS + ((size_t)(b * 2 + (c >> 6)) * 64 + (c & 63)) * SEQ + s; }
                    else { const int c = col - 2688; dst = p.VtW + ((size_t)(b * 2 + (c >> 6)) * 64 + (c & 63)) * SEQ + s; }
                    *(half4*)dst = o;
                } else {
                    const int row = mt * 128 + wm * 64 + j * 16 + l15, c = nt * 128 + wn * 64 + i * 16 + l4 - 2816;
                    if (c < 32) {
                        f32x4 o;
                        if (c < 8) {
#pragma unroll
                            for (int q = 0; q < 4; ++q) o[q] = log_sigmoid(v[q] + p.even_b_f[c + q]) * LOG2E;
                        } else {
#pragma unroll
                            for (int q = 0; q < 4; ++q) o[q] = sigmoidf_(v[q]);
                        }
                        *(f32x4*)(p.FG + (size_t)row * 32 + c) = o;
                    }
                }
            }
    } else {
#pragma unroll
        for (int i = 0; i < 4; ++i)
#pragma unroll
            for (int j = 0; j < 4; ++j) {
                const f32x4 v = acc[i][j];
                if (MODE == EPI_F32T) {
                    const int row = mt * 128 + wm * 64 + i * 16 + l4, col = nt * 128 + wn * 64 + j * 16 + l15;
                    *(f32x4*)(g.c32 + (size_t)col * TOK + row) = v;
                } else {
                    const int row = mt * 128 + wm * 64 + j * 16 + l15, col = nt * 128 + wn * 64 + i * 16 + l4;
                    if (MODE == EPI_F32_RESID) {
                        const f32x4 r = *(const f32x4*)(g.resid + (size_t)row * LDC + col);
                        *(f32x4*)(g.c32 + (size_t)row * LDC + col) = r + v;
                    } else {
                        half4 o; o[0] = (h16)v[0]; o[1] = (h16)v[1]; o[2] = (h16)v[2]; o[3] = (h16)v[3];
                        *(half4*)(g.c16 + (size_t)row * LDC + col) = o;
                    }
                }
            }
    }
}

template <int MODE, int LDA, int LDB, int GN, int GK, int LDC, int ANS>
__device__ __forceinline__ void phase_gemm(PRef p, const GemmArgs& g, char* smem) {
    h16* As = (h16*)smem;
    h16* Bs = As + 2 * 128 * 64;
    const int tid = tidx_(), lane = tid & 63, wid = widx_(), wm = wid >> 1, wn = wid & 1;
    constexpr int nM = TOK / 128, nN = GN / 128, ntiles = nM * nN, nk = GK / 64;
    const int lr = tid >> 3, lc = tid & 7;
    const int st_off = lr * 64 + ((lc ^ ((tid >> 4) & 7)) * 8);
    const int fsw = (lane & 15) >> 1;
    const int fo0 = (lane & 15) * 64 + ((((lane >> 4)) ^ fsw) * 8), fo1 = (lane & 15) * 64 + (((4 + (lane >> 4)) ^ fsw) * 8);
    for (int tile = bidx_(); tile < ntiles; tile += GRIDV) {
        const int mt = tile / nN, nt = tile % nN;
        bool sw = (MODE != EPI_F32T);
        if (MODE == EPI_EVEN_IN) sw = !((nt >= 8 && nt < 12) || nt == 19 || nt == 21);
        const h16* Ag = g.A + (size_t)(mt * 128 + lr) * LDA + (size_t)nt * ANS + lc * 8;
        const h16* Bg = g.Bt + (size_t)(nt * 128 + lr) * LDB + lc * 8;
        constexpr size_t a32 = (size_t)32 * LDA, b32 = (size_t)32 * LDB;
        f32x4 acc[4][4];
#pragma unroll
        for (int m = 0; m < 4; ++m)
#pragma unroll
            for (int n = 0; n < 4; ++n) acc[m][n] = (f32x4){0.f, 0.f, 0.f, 0.f};
        half8 ra[4], rb[4];
#pragma unroll
        for (int i = 0; i < 4; ++i) { ra[i] = *(const half8*)(Ag + i * a32); rb[i] = *(const half8*)(Bg + i * b32); }
#pragma unroll
        for (int i = 0; i < 4; ++i) { *(half8*)(As + st_off + i * 32 * 64) = ra[i]; *(half8*)(Bs + st_off + i * 32 * 64) = rb[i]; }
        hsync();
        const int pofs = (sw ? wn : wm) * 64 * 64, qofs = (sw ? wm : wn) * 64 * 64;
        for (int kt = 0; kt < nk; ++kt) {
            const int cur = kt & 1;
            if (kt + 1 < nk) {
                const int ko = (kt + 1) * 64;
#pragma unroll
                for (int i = 0; i < 4; ++i) { ra[i] = *(const half8*)(Ag + i * a32 + ko); rb[i] = *(const half8*)(Bg + i * b32 + ko); }
            }
            const h16* Pc = (sw ? Bs : As) + cur * 128 * 64 + pofs;
            const h16* Qc = (sw ? As : Bs) + cur * 128 * 64 + qofs;
#pragma unroll
            for (int ks = 0; ks < 2; ++ks) {
                const int fo = ks ? fo1 : fo0;
                half8 pf[4], qf[4];
#pragma unroll
                for (int i = 0; i < 4; ++i) { pf[i] = *(const half8*)(Pc + i * 16 * 64 + fo); qf[i] = *(const half8*)(Qc + i * 16 * 64 + fo); }
                __builtin_amdgcn_s_setprio(1);
#pragma unroll
                for (int i = 0; i < 4; ++i)
#pragma unroll
                    for (int j = 0; j < 4; ++j) acc[i][j] = __builtin_amdgcn_mfma_f32_16x16x32_f16(pf[i], qf[j], acc[i][j], 0, 0, 0);
                __builtin_amdgcn_s_setprio(0);
            }
            if (kt + 1 < nk) {
                const int nx = (cur ^ 1) * 128 * 64;
#pragma unroll
                for (int i = 0; i < 4; ++i) { *(half8*)(As + nx + st_off + i * 32 * 64) = ra[i]; *(half8*)(Bs + nx + st_off + i * 32 * 64) = rb[i]; }
            }
            hsync();
        }
        if (MODE == EPI_QSCORE) {
            constexpr int QST = 136;
            h16* Qs = (h16*)smem;
            const int l4 = (lane >> 4) * 4, l15 = lane & 15;
#pragma unroll
            for (int i = 0; i < 4; ++i)
#pragma unroll
                for (int j = 0; j < 4; ++j) {
                    const f32x4 v = acc[i][j];
                    half4 o; o[0] = (h16)v[0]; o[1] = (h16)v[1]; o[2] = (h16)v[2]; o[3] = (h16)v[3];
                    *(half4*)(Qs + (wm * 64 + j * 16 + l15) * QST + wn * 64 + i * 16 + l4) = o;
                }
            hsync();
            f32x4 sc[4][4];
#pragma unroll
            for (int i = 0; i < 4; ++i)
#pragma unroll
                for (int j = 0; j < 4; ++j) sc[i][j] = (f32x4){0.f, 0.f, 0.f, 0.f};
            const h16* kb = g.aux + (size_t)(nt * 128 + wn * 64 + l15) * 128 + (lane >> 4) * 8;
#pragma unroll
            for (int ks = 0; ks < 4; ++ks) {
                half8 pf[4], qf[4];
#pragma unroll
                for (int i = 0; i < 4; ++i) { pf[i] = *(const half8*)(Qs + (wm * 64 + i * 16 + l15) * QST + ks * 32 + (lane >> 4) * 8); qf[i] = *(const half8*)(kb + (size_t)i * 16 * 128 + ks * 32); }
#pragma unroll
                for (int i = 0; i < 4; ++i)
#pragma unroll
                    for (int j = 0; j < 4; ++j) sc[i][j] = __builtin_amdgcn_mfma_f32_16x16x32_f16(pf[i], qf[j], sc[i][j], 0, 0, 0);
            }
#pragma unroll
            for (int i = 0; i < 4; ++i)
#pragma unroll
                for (int j = 0; j < 4; ++j) {
                    const int row = mt * 128 + wm * 64 + i * 16 + l4, col = nt * 128 + wn * 64 + j * 16 + l15;
                    *(f32x4*)(g.c32 + (size_t)col * TOK + row) = sc[i][j];
                }
            hsync();
        } else
        gemm_epilogue<MODE, LDC>(p, g, mt, nt, sw, acc);
    }
}

__device__ __forceinline__ void wp_job(PRef p, int wv0) {
    const int lane = tidx_() & 63, wv = bidx_() * 4 + widx_() - wv0, nwv = GRIDV * 4 - wv0;
    if (wv < 0) return;
    for (int u = wv; u < 1024; u += nwv) {
        const int l = u >> 9, hc = (u >> 5) & 15, kh = (u >> 4) & 1, jt = u & 15;
        const float* wq = p.peer_w_q + (size_t)l * 1024 * 2048 + (size_t)(jt * 64 + (lane & 15)) * 2048 + hc * 128 + (lane >> 4) * 8;
        const h16* ky = p.Keys + ((size_t)(l * 16 + hc) * 128 + kh * 64 + (lane & 15)) * 128 + (lane >> 4) * 8;
        f32x4 acc[4][4];
#pragma unroll
        for (int a = 0; a < 4; ++a)
#pragma unroll
            for (int b = 0; b < 4; ++b) acc[a][b] = (f32x4){0.f, 0.f, 0.f, 0.f};
#pragma unroll
        for (int ks = 0; ks < 4; ++ks) {
            half8 af[4], bf[4];
#pragma unroll
            for (int a = 0; a < 4; ++a) {
                const f32x4 w0 = *(const f32x4*)(wq + (size_t)a * 16 * 2048 + ks * 32), w1 = *(const f32x4*)(wq + (size_t)a * 16 * 2048 + ks * 32 + 4);
#pragma unroll
                for (int q = 0; q < 4; ++q) { af[a][q] = (h16)w0[q]; af[a][4 + q] = (h16)w1[q]; }
                bf[a] = *(const half8*)(ky + (size_t)a * 16 * 128 + ks * 32);
            }
#pragma unroll
            for (int a = 0; a < 4; ++a)
#pragma unroll
                for (int b = 0; b < 4; ++b) acc[a][b] = __builtin_amdgcn_mfma_f32_16x16x32_f16(af[a], bf[b], acc[a][b], 0, 0, 0);
        }
        h16* wp = p.WtQ + (size_t)l * 2048 * 1024;
#pragma unroll
        for (int a = 0; a < 4; ++a)
#pragma unroll
            for (int b = 0; b < 4; ++b) {
                const int n = hc * 128 + kh * 64 + b * 16 + (lane & 15), j0 = jt * 64 + a * 16 + (lane >> 4) * 4;
                const f32x4 gq = *(const f32x4*)(p.ffn_norm_g + l * DM + j0);
                half4 o; o[0] = (h16)(acc[a][b][0] * gq[0]); o[1] = (h16)(acc[a][b][1] * gq[1]); o[2] = (h16)(acc[a][b][2] * gq[2]); o[3] = (h16)(acc[a][b][3] * gq[3]);
                *(half4*)(wp + (size_t)n * 1024 + j0) = o;
            }
    }
}
__device__ __forceinline__ void phase_cumsum_compress(PRef p, char* smem) {
    const int lane = tidx_() & 63, wid = widx_(), vb = bidx_();
    if (vb >= 256 && vb < 264) {
        const int u = (vb - 256) * 4 + wid, b = u >> 3, h = u & 7;
        const float* src = p.FG + (size_t)(b * SEQ + lane * 64) * 32 + h;
        float loc[64]; float run = 0.f;
#pragma unroll
        for (int i = 0; i < 64; ++i) { run += src[(size_t)i * 32]; loc[i] = run; }
        float incl = run;
#pragma unroll
        for (int o = 1; o < 64; o <<= 1) { const float t = __shfl_up(incl, o); if (lane >= o) incl += t; }
        const float excl = incl - run;
        float* dst = p.C2 + (size_t)(b * 8 + h) * SEQ + lane * 64;
#pragma unroll
        for (int i = 0; i < 64; ++i) dst[i] = excl + loc[i];
    }
    if (vb < 256) {
        const int cu = vb, kv = cu >> 7, bg = (cu >> 4) & 7, nt = cu & 15;
        const int b = bg >> 1, g = bg & 1;
        int n = nt * 16 + (lane & 15); const int nc = n < 255 ? n : 254;
        const h16* Ab = p.Z + (size_t)(b * SEQ + 16 * nc) * ZLD + 1536 + kv * 128 + g * 64 + (lane >> 4) * 8;
        const h16* Wb = p.Wc + (size_t)kv * 64 * 2048 + (size_t)(lane & 15) * 2048 + (lane >> 4) * 8;
        const h16* Pb = p.Pos16 + (lane >> 4) * 8;
        f32x4 acc[4];
#pragma unroll
        for (int e = 0; e < 4; ++e) acc[e] = (f32x4){0.f, 0.f, 0.f, 0.f};
#pragma unroll
        for (int k2 = 0; k2 < 16; ++k2) {
            const int ks = wid * 16 + k2, l = ks >> 1, d0 = (ks & 1) * 32;
            half8 a = *(const half8*)(Ab + (size_t)l * ZLD + d0);
            const half8 ps = *(const half8*)(Pb + ks * 32);
            a = a + ps;
#pragma unroll
            for (int e = 0; e < 4; ++e) {
                const half8 w = *(const half8*)(Wb + (size_t)e * 16 * 2048 + ks * 32);
                acc[e] = __builtin_amdgcn_mfma_f32_16x16x32_f16(a, w, acc[e], 0, 0, 0);
            }
        }
        f32x4* part = (f32x4*)smem;
#pragma unroll
        for (int e = 0; e < 4; ++e) part[(wid * 4 + e) * 64 + lane] = acc[e];
        hsync();
        {
            const int e = wid;
            const f32x4 s = (part[(0 * 4 + e) * 64 + lane] + part[(1 * 4 + e) * 64 + lane]) + (part[(2 * 4 + e) * 64 + lane] + part[(3 * 4 + e) * 64 + lane]);
            const int n0 = nt * 16 + (lane >> 4) * 4, ec = e * 16 + (lane & 15);
            if (kv == 0) {
#pragma unroll
                for (int j = 0; j < 4; ++j) p.KC[((size_t)bg * 256 + n0 + j) * 64 + ec] = (n0 + j < 255) ? (h16)s[j] : (h16)0.f;
            } else {
                half4 o;
#pragma unroll
                for (int j = 0; j < 4; ++j) o[j] = (n0 + j < 255) ? (h16)s[j] : (h16)0.f;
                *(half4*)(p.VCt + ((size_t)bg * 64 + ec) * 256 + n0) = o;
            }
        }
        hsync();
    }
    weight_jobs(p, smem, false, 0);
    wp_job(p, 0);
}

struct RowState { float m, l; f32x16 o0, o1; };
__device__ __forceinline__ void rs_reset(RowState& s) { s.m = NEGBIG; s.l = 0.f; s.o0 = zero16(); s.o1 = zero16(); }

__device__ __forceinline__ void kv_load(const h16* kb, int kst, const h16* vb, int vst, half8 (&kr)[2], half8 (&vr)[2]) {
    const int tid = tidx_();
#pragma unroll
    for (int i = 0; i < 2; ++i) {
        const int c = tid + 256 * i, row = c >> 3, cc = (c & 7) * 8;
        kr[i] = *(const half8*)(kb + (size_t)row * kst + cc);
        vr[i] = *(const half8*)(vb + (size_t)row * vst + cc);
    }
}
__device__ __forceinline__ void kv_store(h16* Ks, h16* Vs, const half8 (&kr)[2], const half8 (&vr)[2]) {
    const int tid = tidx_();
#pragma unroll
    for (int i = 0; i < 2; ++i) {
        const int c = tid + 256 * i, row = c >> 3, cc = (c & 7) * 8;
        *(half8*)(Ks + row * KST + cc) = kr[i];
        *(half8*)(Vs + row * KST + cc) = vr[i];
    }
}
__device__ __forceinline__ void qk_tile(const h16* Ks, const half8 (&qf)[4], f32x16 (&s)[2], int lane) {
    const int r32 = lane & 31, hh = lane >> 5;
#pragma unroll
    for (int kt = 0; kt < 2; ++kt) {
        s[kt] = zero16();
#pragma unroll
        for (int ks = 0; ks < 4; ++ks) {
            const half8 kf = *(const half8*)(Ks + (kt * 32 + r32) * KST + ks * 16 + hh * 8);
            s[kt] = __builtin_amdgcn_mfma_f32_32x32x16_f16(kf, qf[ks], s[kt], 0, 0, 0);
        }
    }
}
__device__ __forceinline__ void pv_tile(const h16* Vs, const f32x16 (&pr)[2], f32x16& o0, f32x16& o1, int lane) {
    const int r32 = lane & 31, hh = lane >> 5;
#pragma unroll
    for (int kt = 0; kt < 2; ++kt)
#pragma unroll
        for (int s2 = 0; s2 < 2; ++s2) {
            half8 pf;
#pragma unroll
            for (int j = 0; j < 8; ++j) pf[j] = (h16)pr[kt][8 * s2 + j];
            const int kof = kt * 32 + 16 * s2 + 4 * hh;
            {
                const half4 a = *(const half4*)(Vs + r32 * KST + kof), b = *(const half4*)(Vs + r32 * KST + kof + 8);
                half8 vf; vf[0] = a[0]; vf[1] = a[1]; vf[2] = a[2]; vf[3] = a[3]; vf[4] = b[0]; vf[5] = b[1]; vf[6] = b[2]; vf[7] = b[3];
                o0 = __builtin_amdgcn_mfma_f32_32x32x16_f16(vf, pf, o0, 0, 0, 0);
            }
            {
                const half4 a = *(const half4*)(Vs + (32 + r32) * KST + kof), b = *(const half4*)(Vs + (32 + r32) * KST + kof + 8);
                half8 vf; vf[0] = a[0]; vf[1] = a[1]; vf[2] = a[2]; vf[3] = a[3]; vf[4] = b[0]; vf[5] = b[1]; vf[6] = b[2]; vf[7] = b[3];
                o1 = __builtin_amdgcn_mfma_f32_32x32x16_f16(vf, pf, o1, 0, 0, 0);
            }
        }
}

enum { M_FOX = 0, M_SLC = 1, M_WIN = 2 };
template <int MODE, bool MASKED>
__device__ __forceinline__ void flash_step(const h16* Ks, const h16* Vs, const float* csS, const half8 (&qf)[4], RowState& st,
                                           int t, int kpos0, float slope2, float ct2, bool selbit, int lane) {
    const int hh = lane >> 5;
    f32x16 s[2];
    qk_tile(Ks, qf, s, lane);
    int dbase = t - kpos0 - 4 * hh;
    asm volatile("" : "+v"(dbase));
    const float off = (MODE == M_FOX) ? ct2 : -slope2 * (float)dbase;
    float mx = NEGBIG;
#pragma unroll
    for (int kt = 0; kt < 2; ++kt)
#pragma unroll
        for (int r = 0; r < 16; ++r) {
            const int c = kt * 32 + (r & 3) + 8 * (r >> 2);
            float v;
            if (MODE == M_FOX) v = s[kt][r] - csS[c + 4 * hh];
            else v = fmaf(slope2, (float)c, s[kt][r]);
            if (MASKED) {
                const int dist = dbase - c;
                bool valid;
                if (MODE == M_FOX) valid = dist >= 0; else if (MODE == M_SLC) valid = selbit && dist >= 0; else valid = dist >= 0 && dist < 512;
                v = valid ? v : NEGBIG;
            }
            s[kt][r] = v;
            mx = fmaxf(mx, v);
        }
    mx += off;
    mx = fmaxf(mx, __shfl_xor(mx, 32));
    const bool rowoff = (MODE == M_SLC) && !MASKED && !selbit;
    if (rowoff) mx = NEGBIG;
    const float mn = fmaxf(st.m, mx);
    const float alpha = __builtin_amdgcn_exp2f(st.m - mn);
    st.m = mn;
    const float moff = rowoff ? 1.0e30f : mn - off;
    float ps = 0.f;
#pragma unroll
    for (int kt = 0; kt < 2; ++kt)
#pragma unroll
        for (int r = 0; r < 16; ++r) {
            const float v = s[kt][r];
            float pe = __builtin_amdgcn_exp2f(v - moff);
            if (MASKED) pe = v > -1.0e29f ? pe : 0.f;
            s[kt][r] = pe; ps += pe;
        }
    st.l = st.l * alpha + ps;
#pragma unroll
    for (int r = 0; r < 16; ++r) { st.o0[r] *= alpha; st.o1[r] *= alpha; }
    pv_tile(Vs, s, st.o0, st.o1, lane);
}

template <int MODE>
__device__ __forceinline__ void run_flash(u64 mask, const h16* Kg, int kst, const h16* Vg, int vst, const float* csg, char* smem,
                                          const half8 (&qf)[4], RowState& st, int t, int twlo, int twhi, float slope2, float ct2, u64 sel, int lane) {
    h16* Kb = (h16*)smem; h16* Vb = Kb + 2 * 64 * KST; float* csb = (float*)(Vb + 2 * 64 * KST);
    if (mask == 0ull) return;
    half8 kr[2], vr[2]; float csr = 0.f;
    int jc = __builtin_ctzll(mask); mask &= mask - 1;
    kv_load(Kg + (size_t)jc * 64 * kst, kst, Vg + jc * 64, vst, kr, vr);
    if (MODE == M_FOX && tidx_() < 64) csr = csg[jc * 64 + tidx_()];
    kv_store(Kb, Vb, kr, vr);
    if (MODE == M_FOX && tidx_() < 64) csb[tidx_()] = csr;
    hsync();
    int buf = 0;
    for (;;) {
        int jn = -1;
        if (mask) { jn = __builtin_ctzll(mask); mask &= mask - 1; }
        if (jn >= 0) {
            kv_load(Kg + (size_t)jn * 64 * kst, kst, Vg + jn * 64, vst, kr, vr);
            if (MODE == M_FOX && tidx_() < 64) csr = csg[jn * 64 + tidx_()];
        }
        bool need = jc * 64 <= twhi;
        if (MODE == M_WIN) need = need && (jc * 64 + 63 >= twlo - 511);
        if (need) {
            const bool selbit = (sel >> jc) & 1ull;
            bool full = jc * 64 + 63 <= twlo;
            if (MODE == M_WIN) full = full && (jc * 64 > twhi - 512);
            if (full) flash_step<MODE, false>(Kb + buf * 64 * KST, Vb + buf * 64 * KST, csb + buf * 64, qf, st, t, jc * 64, slope2, ct2, selbit, lane);
            else flash_step<MODE, true>(Kb + buf * 64 * KST, Vb + buf * 64 * KST, csb + buf * 64, qf, st, t, jc * 64, slope2, ct2, selbit, lane);
        }
        if (jn >= 0) {
            kv_store(Kb + (buf ^ 1) * 64 * KST, Vb + (buf ^ 1) * 64 * KST, kr, vr);
            if (MODE == M_FOX && tidx_() < 64) csb[(buf ^ 1) * 64 + tidx_()] = csr;
        }
        hsync();
        if (jn < 0) break;
        jc = jn; buf ^= 1;
    }
}

__device__ __forceinline__ void load_q(const h16* qrow, half8 (&qf)[4], int lane) {
#pragma unroll
    for (int ks = 0; ks < 4; ++ks) qf[ks] = *(const half8*)(qrow + ks * 16 + (lane >> 5) * 8);
}
__device__ __forceinline__ void store_o(h16* orow, const f32x16& o0, const f32x16& o1, int lane) {
    const int hh = lane >> 5;
#pragma unroll
    for (int rg = 0; rg < 4; ++rg) {
        half4 a, b;
#pragma unroll
        for (int j = 0; j < 4; ++j) { a[j] = (h16)o0[4 * rg + j]; b[j] = (h16)o1[4 * rg + j]; }
        *(half4*)(orow + 8 * rg + 4 * hh) = a;
        *(half4*)(orow + 32 + 8 * rg + 4 * hh) = b;
    }
}

__device__ __forceinline__ void oacc_store(float* row, const f32x16& o0, const f32x16& o1, float sc, int lane) {
    const int hh = lane >> 5;
#pragma unroll
    for (int rg = 0; rg < 4; ++rg) {
        *(f32x4*)(row + 8 * rg + 4 * hh) = (f32x4){o0[4 * rg] * sc, o0[4 * rg + 1] * sc, o0[4 * rg + 2] * sc, o0[4 * rg + 3] * sc};
        *(f32x4*)(row + 32 + 8 * rg + 4 * hh) = (f32x4){o1[4 * rg] * sc, o1[4 * rg + 1] * sc, o1[4 * rg + 2] * sc, o1[4 * rg + 3] * sc};
    }
}
__device__ __forceinline__ void oacc_add(float* row, const f32x16& o0, const f32x16& o1, float sc, int lane) {
    const int hh = lane >> 5;
#pragma unroll
    for (int rg = 0; rg < 4; ++rg) {
        f32x4 a = *(const f32x4*)(row + 8 * rg + 4 * hh), b = *(const f32x4*)(row + 32 + 8 * rg + 4 * hh);
#pragma unroll
        for (int j = 0; j < 4; ++j) { a[j] += o0[4 * rg + j] * sc; b[j] += o1[4 * rg + j] * sc; }
        *(f32x4*)(row + 8 * rg + 4 * hh) = a; *(f32x4*)(row + 32 + 8 * rg + 4 * hh) = b;
    }
}
__device__ __forceinline__ void oacc_final(const float* row, h16* orow, const f32x16& o0, const f32x16& o1, float sc, int lane) {
    const int hh = lane >> 5;
#pragma unroll
    for (int rg = 0; rg < 4; ++rg) {
        const f32x4 a = *(const f32x4*)(row + 8 * rg + 4 * hh), b = *(const f32x4*)(row + 32 + 8 * rg + 4 * hh);
        half4 x, y;
#pragma unroll
        for (int j = 0; j < 4; ++j) { x[j] = (h16)(a[j] + o0[4 * rg + j] * sc); y[j] = (h16)(b[j] + o1[4 * rg + j] * sc); }
        *(half4*)(orow + 8 * rg + 4 * hh) = x; *(half4*)(orow + 32 + 8 * rg + 4 * hh) = y;
    }
}

__device__ __forceinline__ void fox_unit(PRef p, int b, int h, int qt, char* smem) {
    const int tid = tidx_(), lane = tid & 63, wid = widx_();
    const int q0 = qt * 128, t0w = q0 + wid * 32, t = t0w + (lane & 31);
    half8 qf[4]; load_q(p.Z + (size_t)(b * SEQ + t) * ZLD + h * 64, qf, lane);
    const float* csg = p.C2 + (size_t)(b * 8 + h) * SEQ;
    const float ct2 = csg[t];
    RowState st; rs_reset(st);
    const int jmax = (q0 + 127) >> 6;
    const u64 mask = (jmax >= 63) ? ~0ull : ((1ull << (jmax + 1)) - 1ull);
    run_flash<M_FOX>(mask, p.Z + (size_t)b * SEQ * ZLD + 512 + h * 64, ZLD, p.VtF + (size_t)(b * 8 + h) * 64 * SEQ, SEQ, csg, smem,
                     qf, st, t, t0w, t0w + 31, 0.f, ct2, 0ull, lane);
    const float lt = st.l + __shfl_xor(st.l, 32);
    const float inv = 1.0f / lt;
#pragma unroll
    for (int r = 0; r < 16; ++r) { st.o0[r] *= inv; st.o1[r] *= inv; }
    store_o(p.O + (size_t)(b * SEQ + t) * DM + h * 64, st.o0, st.o1, lane);
}

__device__ __forceinline__ void nsa_unit(PRef p, int b, int g, int qt32, char* smem) {
    const int tid = tidx_(), lane = tid & 63, wid = widx_(), hh = lane >> 5, r32 = lane & 31;
    const int t0 = qt32 * 32, t = t0 + r32, head = g * 4 + wid, bg = b * 2 + g;
    const float slope2 = exp2f(-(float)(head + 1)) * LOG2E;
    half8 qf[4]; load_q(p.Z + (size_t)(b * SEQ + t) * ZLD + 1024 + head * 64, qf, lane);
    const float* gp = p.FG + (size_t)(b * SEQ + t) * 32 + 8 + head * 3;
    const float gate_c = gp[0], gate_s = gp[1], gate_w = gp[2];
    h16* Kb = (h16*)smem; h16* Vb = Kb + 2 * 64 * KST;
    u64* selS = (u64*)(smem + 37376);
    u64* unS = selS + 32;
    float* oaccrow = p.OACC + (size_t)(b * SEQ + t) * 512 + head * 64;
    unsigned* impS = (unsigned*)(smem + 37888);
    {
        for (int i = tid; i < 32 * 64; i += NTHR) impS[i] = 0u;
        const int nsteps = ((t0 >> 4) >> 6) + 1;
        const h16* Kg = p.KC + (size_t)bg * 256 * 64; const h16* Vg = p.VCt + (size_t)bg * 64 * 256;
        float mrun = NEGBIG, lrun = 0.f;
        for (int i = 0; i < nsteps; ++i) {
            half8 kr[2], vr[2];
            kv_load(Kg + (size_t)i * 64 * 64, 64, Vg + i * 64, 256, kr, vr);
            kv_store(Kb, Vb, kr, vr);
            hsync();
            f32x16 s[2];
            qk_tile(Kb, qf, s, lane);
            float mx = NEGBIG;
            int dbase = t - 31 - 16 * (i * 64 + 4 * hh);
            asm volatile("" : "+v"(dbase));
#pragma unroll
            for (int kt = 0; kt < 2; ++kt)
#pragma unroll
                for (int r = 0; r < 16; ++r) {
                    const int dist = dbase - 16 * (kt * 32 + (r & 3) + 8 * (r >> 2));
                    float v = s[kt][r] - slope2 * (float)dist;
                    v = dist >= 0 ? v : NEGBIG;
                    s[kt][r] = v; mx = fmaxf(mx, v);
                }
            mx = fmaxf(mx, __shfl_xor(mx, 32));
            const float mn = fmaxf(mrun, mx), alpha = __builtin_amdgcn_exp2f(mrun - mn);
            mrun = mn;
            float ps = 0.f;
#pragma unroll
            for (int kt = 0; kt < 2; ++kt)
#pragma unroll
                for (int r = 0; r < 16; ++r) { const float v = s[kt][r]; ps += v > -1.0e29f ? __builtin_amdgcn_exp2f(v - mn) : 0.f; }
            lrun = lrun * alpha + ps;
            hsync();
        }
        const float lt = lrun + __shfl_xor(lrun, 32);
        const float inv = lt > 0.f ? 1.0f / lt : 0.f;
        f32x16 o0 = zero16(), o1 = zero16();
        float carry = 0.f;
        for (int i = 0; i < nsteps; ++i) {
            half8 kr[2], vr[2];
            kv_load(Kg + (size_t)i * 64 * 64, 64, Vg + i * 64, 256, kr, vr);
            kv_store(Kb, Vb, kr, vr);
            hsync();
            f32x16 s[2];
            qk_tile(Kb, qf, s, lane);
            int dbase = t - 31 - 16 * (i * 64 + 4 * hh);
            asm volatile("" : "+v"(dbase));
#pragma unroll
            for (int kt = 0; kt < 2; ++kt)
#pragma unroll
                for (int r = 0; r < 16; ++r) {
                    const int dist = dbase - 16 * (kt * 32 + (r & 3) + 8 * (r >> 2));
                    const float v = s[kt][r] - slope2 * (float)dist;
                    s[kt][r] = dist >= 0 ? __builtin_amdgcn_exp2f(v - mrun) * inv : 0.f;
                }
            float R[2][4];
#pragma unroll
            for (int kt = 0; kt < 2; ++kt)
#pragma unroll
                for (int rg = 0; rg < 4; ++rg) R[kt][rg] = __shfl_xor(s[kt][4 * rg + 3], 32);
#pragma unroll
            for (int kt = 0; kt < 2; ++kt)
#pragma unroll
                for (int rg = 0; rg < 4; ++rg) {
                    const float G = (s[kt][4 * rg] + s[kt][4 * rg + 1]) + (s[kt][4 * rg + 2] + s[kt][4 * rg + 3]);
                    const float prev = (kt == 0 && rg == 0) ? carry : (rg > 0 ? R[kt][rg - 1] : R[kt - 1][3]);
                    const float val = G + (hh ? R[kt][rg] : prev);
                    const int j = 16 * i + 8 * kt + 2 * rg + hh;
                    atomicAdd(&impS[r32 * 64 + j], (unsigned)(val * 67108864.0f + 0.5f));
                }
            carry = R[1][3];
            pv_tile(Vb, s, o0, o1, lane);
            hsync();
        }
        oacc_store(oaccrow, o0, o1, gate_c, lane);
    }
    hsync();
    {
        u64 un = 0ull;
        for (int i = 0; i < 8; ++i) {
            const int tok = wid * 8 + i, tt = t0 + tok, cur = tt >> 6;
            const int j = lane;
            const bool valid = j <= cur;
            const bool forced = (j == 0) || (j == cur) || (j == cur - 1);
            const unsigned key = valid ? impS[tok * 64 + j] + (forced ? 0x40000000u : 0u) : 0u;
            int rank = 0;
            for (int jj = 0; jj < 64; ++jj) {
                const unsigned kv = (unsigned)__builtin_amdgcn_readlane((int)key, jj);
                rank += (kv > key || (kv == key && jj < j)) ? 1 : 0;
            }
            const u64 selm = __ballot(valid && rank < 16);
            if (lane == 0) selS[tok] = selm;
            un |= selm;
        }
        if (lane == 0) unS[wid] = un;
    }
    hsync();
    const u64 mysel = selS[r32];
    const u64 un = unS[0] | unS[1] | unS[2] | unS[3];
    hsync();
    {
        RowState st; rs_reset(st);
        run_flash<M_SLC>(un, p.Z + (size_t)b * SEQ * ZLD + 1792 + g * 64, ZLD, p.VtS + (size_t)bg * 64 * SEQ, SEQ, nullptr, smem,
                         qf, st, t, t0, t0 + 31, slope2, 0.f, mysel, lane);
        const float lt = st.l + __shfl_xor(st.l, 32);
        oacc_add(oaccrow, st.o0, st.o1, gate_s / lt, lane);
    }
    {
        RowState st; rs_reset(st);
        const int lo = t0 - 511, jlo = lo > 0 ? (lo >> 6) : 0, jhi = (t0 + 31) >> 6;
        u64 mask = (jhi >= 63 ? ~0ull : ((1ull << (jhi + 1)) - 1ull)) & ~((1ull << jlo) - 1ull);
        run_flash<M_WIN>(mask, p.Z + (size_t)b * SEQ * ZLD + 1920 + g * 64, ZLD, p.VtW + (size_t)bg * 64 * SEQ, SEQ, nullptr, smem,
                         qf, st, t, t0, t0 + 31, slope2, 0.f, 0ull, lane);
        const float lt = st.l + __shfl_xor(st.l, 32);
        oacc_final(oaccrow, p.O + (size_t)(b * SEQ + t) * DM + 512 + head * 64, st.o0, st.o1, gate_w / lt, lane);
    }
}

__device__ __forceinline__ void phase_attention(PRef p, char* smem) {
    int* nxt = (int*)(smem + 65536 - 16);
    for (;;) {
        if (tidx_() == 0) *nxt = (int)__hip_atomic_fetch_add(p.BAR + XCD_BAR_WORDS_C, 1u, __ATOMIC_RELAXED, __HIP_MEMORY_SCOPE_AGENT);
        hsync();
        const int q = *nxt;
        hsync();
        if (q >= 2048 + 1024) break;
        const int q5 = q % 5, blk = q / 5;
        if (q < 2560 && (q5 == 2 || q5 == 4)) {
            const int c = blk * 2 + (q5 == 4 ? 1 : 0), tbl = c >> 8, layer = tbl >> 1, rp0 = (c & 255) * 32 + widx_() * 8, lane = tidx_() & 63;
            const float* srcp = ((tbl & 1) ? p.peer_v : p.peer_u) + (size_t)layer * 16384 * 1024;
            unsigned char* dstp = ((tbl & 1) ? p.V8 : p.U8) + (size_t)layer * 16384 * 1024;
            float* sclp = ((tbl & 1) ? p.VS : p.US) + layer * 16384;
            for (int i = 0; i < 8; i += 2) { const int rps[2] = {rp0 + i, rp0 + i + 1}; fp6_rows<2>(srcp, dstp, sclp, rps, lane); }
            continue;
        }
        const int u = q < 2560 ? blk * 3 + (q5 == 3 ? 2 : q5) : q - 1024;
        const int st = 31 - (u >> 6), w = u & 63;
        if (w & 1) { const int idx = w >> 1; nsa_unit(p, (idx & 7) >> 1, idx & 1, st * 4 + (idx >> 3), smem); }
        else { const int idx = w >> 1; fox_unit(p, idx >> 3, idx & 7, st, smem); }
    }
}

__device__ __forceinline__ void phase_rmsnorm(PRef p, const float* g) {
    const int lane = tidx_() & 63, wv = bidx_() * 4 + widx_(), nwv = GRIDV * 4;
    for (int row = wv; row < TOK; row += nwv) {
        float v[16]; load_row16(p.H + (size_t)row * DM, v, lane);
        rms_write_h16(v, g, p.HN + (size_t)row * DM, lane);
    }
}

__device__ __forceinline__ unsigned fkey(float f) { const unsigned b = __float_as_uint(f); return b ^ ((b >> 31) ? 0xFFFFFFFFu : 0x80000000u); }
__device__ __forceinline__ float fkey_inv(unsigned k) { return __uint_as_float(k ^ ((k >> 31) ? 0x80000000u : 0xFFFFFFFFu)); }
__device__ __forceinline__ void ce_desc(unsigned& a, unsigned& b) { const unsigned hi = a > b ? a : b, lo = a > b ? b : a; a = hi; b = lo; }
__device__ __forceinline__ void sort16_desc(unsigned (&k)[16]) {
#pragma unroll
    for (int size = 2; size <= 16; size <<= 1)
#pragma unroll
        for (int stride = size >> 1; stride > 0; stride >>= 1)
#pragma unroll
            for (int i = 0; i < 16; ++i) {
                const int j = i ^ stride;
                if (j > i) { if ((i & size) == 0) ce_desc(k[i], k[j]); else ce_desc(k[j], k[i]); }
            }
}
__device__ __forceinline__ void merge16_desc(unsigned (&run)[16], const unsigned (&b)[16]) {
#pragma unroll
    for (int i = 0; i < 16; ++i) run[i] = run[i] > b[15 - i] ? run[i] : b[15 - i];
#pragma unroll
    for (int stride = 8; stride > 0; stride >>= 1)
#pragma unroll
        for (int i = 0; i < 16; ++i) { const int j = i ^ stride; if (j > i) ce_desc(run[i], run[j]); }
}
__device__ __forceinline__ void list_top16(const h16* __restrict__ base, unsigned (&run)[16]) {
    half8 cur0 = *(const half8*)base, cur1 = *(const half8*)(base + 512), nxt0 = cur0, nxt1 = cur1;
#pragma unroll 1
    for (int bt = 0; bt < 8; ++bt) {
        if (bt < 7) { nxt0 = *(const half8*)(base + (size_t)(2 * bt + 2) * 512); nxt1 = *(const half8*)(base + (size_t)(2 * bt + 3) * 512); }
        unsigned kb[16];
#pragma unroll
        for (int i = 0; i < 8; ++i) {
            kb[i] = (fkey((float)cur0[i]) & ~127u) | (unsigned)(127 - (bt * 16 + i));
            kb[8 + i] = (fkey((float)cur1[i]) & ~127u) | (unsigned)(127 - (bt * 16 + 8 + i));
        }
        sort16_desc(kb);
        if (bt == 0) {
#pragma unroll
            for (int i = 0; i < 16; ++i) run[i] = kb[i];
        } else merge16_desc(run, kb);
        cur0 = nxt0; cur1 = nxt1;
    }
}
__device__ __forceinline__ void phase_peer_topk(PRef p, char* smem) {
    const int tid = tidx_(), lane = tid & 63, wv = bidx_() * 4 + widx_(), nwv = GRIDV * 4;
    int* idS = (int*)smem; float* evS = (float*)smem + 16 * NTHR;
    for (int u = wv; u < 8 * (TOK / 64); u += nwv) {
        const int h = u >> 8, tk = (u & 255) * 64 + lane;
        const h16* b0 = p.SC + ((size_t)((tk >> 6) * 256 + h * 32) * 64 + lane) * 8;
        unsigned k0[16], k1[16];
        list_top16(b0, k0);
        list_top16(b0 + 16 * 512, k1);
        float v0[16], v1[16]; int i0[16], i1[16];
#pragma unroll
        for (int j = 0; j < 16; ++j) {
            v0[j] = fkey_inv(k0[j] & ~127u); i0[j] = 127 - (int)(k0[j] & 127u);
            v1[j] = fkey_inv(k1[j] & ~127u); i1[j] = 127 - (int)(k1[j] & 127u);
        }
        unsigned run[16];
        {
            unsigned kb[16]; int n = 0, nb = 0;
#pragma unroll
            for (int a = 0; a < 16; ++a)
#pragma unroll
                for (int b = 0; b < 16; ++b)
                    if ((a + 1) * (b + 1) <= 16) {
                        kb[n] = fkey(v0[a] + v1[b]); ++n;
                        if (n == 16) {
                            sort16_desc(kb);
                            if (nb == 0) {
#pragma unroll
                                for (int i = 0; i < 16; ++i) run[i] = kb[i];
                            } else merge16_desc(run, kb);
                            n = 0; ++nb;
                        }
                    }
#pragma unroll
            for (int i = 2; i < 16; ++i) kb[i] = 0u;
            sort16_desc(kb); merge16_desc(run, kb);
        }
        const unsigned tkey = run[15]; const float smax = fkey_inv(run[0]);
        int cnt = 0; float esum = 0.f;
#pragma unroll
        for (int j = 0; j < 16; ++j) { idS[j * NTHR + tid] = 0; evS[j * NTHR + tid] = 0.f; }
#pragma unroll
        for (int pass = 0; pass < 2; ++pass)
#pragma unroll
            for (int a = 0; a < 16; ++a)
#pragma unroll
                for (int b = 0; b < 16; ++b)
                    if ((a + 1) * (b + 1) <= 16) {
                        const float s = v0[a] + v1[b]; const unsigned ks = fkey(s);
                        const bool take = pass == 0 ? (ks > tkey) : (ks == tkey && cnt < 16);
                        if (take) {
                            const float e = __expf(s - smax);
                            idS[cnt * NTHR + tid] = i0[a] * 128 + i1[b]; evS[cnt * NTHR + tid] = e;
                            esum += e; ++cnt;
                        }
                    }
        const float rinv = 1.0f / esum;
        int* ip = p.IDS + (size_t)tk * 128 + h * 16; float* gp = p.GW + (size_t)tk * 128 + h * 16;
#pragma unroll
        for (int q = 0; q < 4; ++q) {
            *(i32x4*)(ip + 4 * q) = (i32x4){idS[(4 * q) * NTHR + tid], idS[(4 * q + 1) * NTHR + tid], idS[(4 * q + 2) * NTHR + tid], idS[(4 * q + 3) * NTHR + tid]};
            *(f32x4*)(gp + 4 * q) = (f32x4){evS[(4 * q) * NTHR + tid] * rinv, evS[(4 * q + 1) * NTHR + tid] * rinv, evS[(4 * q + 2) * NTHR + tid] * rinv, evS[(4 * q + 3) * NTHR + tid] * rinv};
        }
    }
}

struct Q6 { i32x4 a; i32x2 b; };
__device__ __forceinline__ Q6 ld6(const unsigned char* row, int g) { Q6 r; r.a = *(const i32x4*)(row + g * 16); r.b = *(const i32x2*)(row + 512 + g * 8); return r; }
__device__ __forceinline__ u32x6 mk6(const Q6 q) { u32x6 r; r[0] = q.a[0]; r[1] = q.a[1]; r[2] = q.a[2]; r[3] = q.a[3]; r[4] = q.b[0]; r[5] = q.b[1]; return r; }
__device__ __forceinline__ float dot32_fp6h(const h16x32 xv, const Q6 q) {
    const h16x32 uf = __builtin_amdgcn_cvt_scalef32_pk32_f16_fp6(mk6(q), 1.0f);
    float d0 = 0.f, d1 = 0.f;
#pragma unroll
    for (int m = 0; m < 16; m += 2) {
        d0 = __builtin_amdgcn_fdot2((half2v){uf[2 * m], uf[2 * m + 1]}, (half2v){xv[2 * m], xv[2 * m + 1]}, d0, false);
        d1 = __builtin_amdgcn_fdot2((half2v){uf[2 * m + 2], uf[2 * m + 3]}, (half2v){xv[2 * m + 2], xv[2 * m + 3]}, d1, false);
    }
    return d0 + d1;
}
__device__ __forceinline__ void axpy32_fp6(f32x2 (&acc)[16], float w, const Q6 q) {
    const f32x32 vf = __builtin_amdgcn_cvt_scalef32_pk32_f32_fp6(mk6(q), 1.0f);
    const f32x2 ww = {w, w};
#pragma unroll
    for (int m = 0; m < 16; ++m) acc[m] = __builtin_elementwise_fma(ww, (f32x2){vf[2 * m], vf[2 * m + 1]}, acc[m]);
}
constexpr int ET_SHIFT = 9, ET_N = 16384 >> ET_SHIFT;
__device__ __forceinline__ void phase_peer_experts(PRef p, int layer, const float* gnext, int mode, char* smem) {
    const int lane = tidx_() & 63, wid = widx_(), wv = bidx_() * 4 + wid, nwv = GRIDV * 4;
    const int hh = lane >> 5, g = lane & 31, dpl = (lane >> 2) & 7;
    const unsigned char* U = p.U8 + (size_t)layer * 16384 * 1024; const unsigned char* V = p.V8 + (size_t)layer * 16384 * 1024;
    const float* US = p.US + layer * 16384; const float* VS = p.VS + layer * 16384;
    const bool b4 = (lane & 16) != 0, b3 = (lane & 8) != 0, b2 = (lane & 4) != 0;
    int* sid = (int*)smem + wid * 512 + hh * 128;
    float* sgw = (float*)(sid + 256);
    for (int tb = wv * 2; tb < TOK; tb += nwv * 2) {
        const int tk = tb + hh;
        h16x32 xv;
        {
            half4 hx[8]; float ssx = 0.f;
#pragma unroll
            for (int c = 0; c < 8; ++c) {
                hx[c] = *(const half4*)(p.H + (size_t)tk * DM + c * 128 + g * 4);
                const float a0 = (float)hx[c][0], a1 = (float)hx[c][1], a2 = (float)hx[c][2], a3 = (float)hx[c][3];
                ssx += (a0 * a0 + a1 * a1) + (a2 * a2 + a3 * a3);
            }
#pragma unroll
            for (int o = 16; o > 0; o >>= 1) ssx += __shfl_xor(ssx, o);
            const float rstdx = rsqrtf(ssx * (1.0f / 1024.0f) + 1e-6f);
            const float* gx = p.ffn_norm_g + layer * DM + g * 4;
#pragma unroll
            for (int c = 0; c < 8; ++c) {
                const f32x4 ga = *(const f32x4*)(gx + c * 128);
#pragma unroll
                for (int j = 0; j < 4; ++j) xv[4 * c + j] = (h16)((float)hx[c][j] * rstdx * ga[j]);
            }
        }
        {
            int idv[4]; float gv[4];
#pragma unroll
            for (int s = 0; s < 4; ++s) { idv[s] = p.IDS[(size_t)tk * 128 + s * 32 + g]; gv[s] = p.GW[(size_t)tk * 128 + s * 32 + g]; }
            int cnt = 0;
            const unsigned below = (1u << g) - 1u;
            for (int e = 0; e < ET_N; ++e) {
#pragma unroll
                for (int s = 0; s < 4; ++s) {
                    const bool in = (idv[s] >> ET_SHIFT) == e;
                    const u64 m = __ballot(in);
                    const unsigned mh = hh ? (unsigned)(m >> 32) : (unsigned)m;
                    if (in) { const int pos = cnt + __popc(mh & below); sid[pos] = idv[s]; sgw[pos] = gv[s]; }
                    cnt += __popc(mh);
                }
            }
        }
        f32x2 acc[16];
#pragma unroll
        for (int i = 0; i < 16; ++i) acc[i] = (f32x2){0.f, 0.f};
        for (int bt = 0; bt < 16; ++bt) {
            const int mine = sid[bt * 8 + dpl]; const float gwm = sgw[bt * 8 + dpl];
            const float usm = US[mine], vsm = VS[mine];
            const i32x4 ida = *(const i32x4*)(sid + bt * 8), idb = *(const i32x4*)(sid + bt * 8 + 4);
            Q6 uq[8], vq[8];
#pragma unroll
            for (int k = 0; k < 8; ++k) {
                const unsigned off = (unsigned)(k < 4 ? ida[k & 3] : idb[k & 3]) * ROW6;
                uq[k] = ld6(U + off, g); vq[k] = ld6(V + off, g);
            }
            float d[8];
#pragma unroll
            for (int k = 0; k < 8; ++k) d[k] = dot32_fp6h(xv, uq[k]);
            float r4[4], r2[2], z;
#pragma unroll
            for (int i = 0; i < 4; ++i) { const float keep = b4 ? d[i + 4] : d[i], send = b4 ? d[i] : d[i + 4]; r4[i] = keep + __shfl_xor(send, 16); }
#pragma unroll
            for (int i = 0; i < 2; ++i) { const float keep = b3 ? r4[i + 2] : r4[i], send = b3 ? r4[i] : r4[i + 2]; r2[i] = keep + __shfl_xor(send, 8); }
            { const float keep = b2 ? r2[1] : r2[0], send = b2 ? r2[0] : r2[1]; z = keep + __shfl_xor(send, 4); }
            z += __shfl_xor(z, 2); z += __shfl_xor(z, 1);
            const float wm = gwm * gelu_exact(z * usm) * vsm;
#pragma unroll
            for (int k = 0; k < 8; ++k) {
                const float w0 = __builtin_bit_cast(float, __builtin_amdgcn_readlane(__builtin_bit_cast(int, wm), 4 * k));
                const float w1 = __builtin_bit_cast(float, __builtin_amdgcn_readlane(__builtin_bit_cast(int, wm), 32 + 4 * k));
                axpy32_fp6(acc, hh ? w1 : w0, vq[k]);
            }
        }
        float hv[32];
        {
            const h16* hr = p.H + (size_t)tk * DM + g * 4;
#pragma unroll
            for (int c = 0; c < 8; ++c) { const half4 t = *(const half4*)(hr + c * 128); hv[4 * c] = (float)t[0] + acc[2 * c][0]; hv[4 * c + 1] = (float)t[1] + acc[2 * c][1]; hv[4 * c + 2] = (float)t[2] + acc[2 * c + 1][0]; hv[4 * c + 3] = (float)t[3] + acc[2 * c + 1][1]; }
        }
        float ss = 0.f;
#pragma unroll
        for (int i = 0; i < 32; ++i) ss += hv[i] * hv[i];
#pragma unroll
        for (int o = 16; o > 0; o >>= 1) ss += __shfl_xor(ss, o);
        const float rstd = rsqrtf(ss * (1.0f / 1024.0f) + 1e-6f);
        const float* gr = gnext + g * 4;
        if (mode == 0) {
            h16* hw = p.H + (size_t)tk * DM + g * 4;
#pragma unroll
            for (int c = 0; c < 8; ++c) {
                { half4 t; t[0] = (h16)hv[4 * c]; t[1] = (h16)hv[4 * c + 1]; t[2] = (h16)hv[4 * c + 2]; t[3] = (h16)hv[4 * c + 3]; *(half4*)(hw + c * 128) = t; }
                const f32x4 ga = *(const f32x4*)(gr + c * 128);
                half4 o;
#pragma unroll
                for (int j = 0; j < 4; ++j) o[j] = (h16)(hv[4 * c + j] * rstd * ga[j]);
                *(half4*)(p.HN + (size_t)tk * DM + c * 128 + g * 4) = o;
            }
        } else {
            float* ow = p.out + (size_t)tk * DM + g * 4;
#pragma unroll
            for (int c = 0; c < 8; ++c) { const f32x4 ga = *(const f32x4*)(gr + c * 128); *(f32x4*)(ow + c * 128) = (f32x4){hv[4 * c] * rstd * ga[0], hv[4 * c + 1] * rstd * ga[1], hv[4 * c + 2] * rstd * ga[2], hv[4 * c + 3] * rstd * ga[3]}; }
        }
    }
}

constexpr int XST = 136;
__device__ __forceinline__ float fast_sigmoid(float v) { return __builtin_amdgcn_rcpf(1.0f + __expf(-v)); }
__device__ __forceinline__ float gelu_as(float v) {
    const float av = fabsf(v), t = __builtin_amdgcn_rcpf(av * 0.2316419f + 1.0f);
    float q = t * 0.5307027145f - 0.7265760135f; q = q * t + 0.7107068705f; q = q * t - 0.142248368f; q = q * t + 0.127414796f; q = q * t;
    const float e = __builtin_amdgcn_exp2f(v * v * -0.72134752044f);
    const float m = v * (q * e);
    return v < 0.f ? m : v - m;
}
__device__ __forceinline__ void phase_rnn_gates(PRef p, char* smem) {
    h16* xcS = (h16*)smem;
    float* aggS = (float*)(smem + 64 * XST * 2);
    h16* laS = (h16*)(smem + 64 * XST * 2 + 4096);
    h16* ruS = laS + 64 * XST;
    const int tid = tidx_(), lane = tid & 63, wid = widx_();
    for (int u = bidx_(); u < 4 * 64 * 10; u += GRIDV) {
        const int nb = u % 10, ck = (u / 10) & 63, b = u / 640;
        const int s0 = ck * 64, ch0 = nb * 128;
        {
            const int c8 = (tid & 15) * 8, tq = (tid >> 4) * 4, ch = ch0 + c8;
            float w[4][8], bias[8];
#pragma unroll
            for (int j = 0; j < 4; ++j) {
                const f32x4 w0 = *(const f32x4*)(p.odd_conv_w + j * DRNN + ch), w1 = *(const f32x4*)(p.odd_conv_w + j * DRNN + ch + 4);
#pragma unroll
                for (int i = 0; i < 4; ++i) { w[j][i] = w0[i]; w[j][4 + i] = w1[i]; }
            }
            { const f32x4 b0 = *(const f32x4*)(p.odd_conv_b + ch), b1 = *(const f32x4*)(p.odd_conv_b + ch + 4);
#pragma unroll
              for (int i = 0; i < 4; ++i) { bias[i] = b0[i]; bias[4 + i] = b1[i]; } }
            half8 xin[7];
#pragma unroll
            for (int r = 0; r < 7; ++r) {
                const int sp = s0 + tq - 3 + r;
                if (sp >= 0) xin[r] = *(const half8*)(p.Z2 + (size_t)(b * SEQ + sp) * Z2LD + DRNN + ch);
                else {
#pragma unroll
                    for (int i = 0; i < 8; ++i) xin[r][i] = (h16)0.f;
                }
            }
#pragma unroll
            for (int tt = 0; tt < 4; ++tt) {
                half8 o;
#pragma unroll
                for (int i = 0; i < 8; ++i) {
                    float a = bias[i];
#pragma unroll
                    for (int j = 0; j < 4; ++j) a = fmaf(w[j][i], (float)xin[tt + j][i], a);
                    o[i] = (h16)a;
                }
                *(half8*)(xcS + (tq + tt) * XST + c8) = o;
            }
        }
        hsync();
        float bra2[2], bri2[2], sp2[2];
#pragma unroll
        for (int e = 0; e < 2; ++e) {
            const int chq = ch0 + (wid * 2 + e) * 16 + (lane & 15);
            bra2[e] = p.odd_b_ra[chq]; bri2[e] = p.odd_b_ri[chq]; sp2[e] = p.odd_lam[chq];
        }
#pragma unroll
        for (int e = 0; e < 2; ++e) sp2[e] = fmaxf(-sp2[e], 0.f) + __logf(1.0f + __expf(-fabsf(sp2[e])));
        f32x4 ar[4][2], ai[4][2];
#pragma unroll
        for (int m = 0; m < 4; ++m)
#pragma unroll
            for (int e = 0; e < 2; ++e) { ar[m][e] = (f32x4){0.f, 0.f, 0.f, 0.f}; ai[m][e] = (f32x4){0.f, 0.f, 0.f, 0.f}; }
        const h16* wr = p.Wr + (size_t)nb * 16384 + (wid * 32 + (lane & 15)) * 128 + (lane >> 4) * 8;
        const h16* wi = p.Wr + (size_t)(10 + nb) * 16384 + (wid * 32 + (lane & 15)) * 128 + (lane >> 4) * 8;
#pragma unroll
        for (int ks = 0; ks < 4; ++ks) {
            half8 a[4];
#pragma unroll
            for (int m = 0; m < 4; ++m) a[m] = *(const half8*)(xcS + (m * 16 + (lane & 15)) * XST + ks * 32 + (lane >> 4) * 8);
#pragma unroll
            for (int e = 0; e < 2; ++e) {
                const half8 w1 = *(const half8*)(wr + e * 16 * 128 + ks * 32), w2 = *(const half8*)(wi + e * 16 * 128 + ks * 32);
#pragma unroll
                for (int m = 0; m < 4; ++m) {
                    ar[m][e] = __builtin_amdgcn_mfma_f32_16x16x32_f16(a[m], w1, ar[m][e], 0, 0, 0);
                    ai[m][e] = __builtin_amdgcn_mfma_f32_16x16x32_f16(a[m], w2, ai[m][e], 0, 0, 0);
                }
            }
        }
        const int g4 = lane >> 4;
#pragma unroll
        for (int e = 0; e < 2; ++e) {
            const int cl = (wid * 2 + e) * 16 + (lane & 15);
            const float bra = bra2[e], bri = bri2[e], sp = sp2[e];
            float Ac = 1.f, Hc = 0.f;
#pragma unroll
            for (int m = 0; m < 4; ++m) {
                float A = 1.f, H = 0.f;
#pragma unroll
                for (int j = 0; j < 4; ++j) {
                    const int tt = m * 16 + g4 * 4 + j;
                    const float r = fast_sigmoid(ar[m][e][j] + bra), ig = fast_sigmoid(ai[m][e][j] + bri);
                    const h16 la16 = (h16)(-8.0f * r * sp);
                    const float a = __expf((float)la16);
                    const float xc = (float)xcS[tt * XST + cl];
                    const h16 u16 = (h16)(__builtin_amdgcn_sqrtf(fmaxf(1.0f - a * a, 0.f)) * (ig * xc));
                    laS[tt * XST + cl] = la16; ruS[tt * XST + cl] = u16;
                    H = a * H + (float)u16; A *= a;
                }
                { const float Al = __shfl_xor(A, 16), Hl = __shfl_xor(H, 16); if (g4 & 1) { H = Hl * A + H; A = Al * A; } }
                { const float Al = __shfl_xor(A, 32), Hl = __shfl_xor(H, 32); if (g4 == 3) { H = Hl * A + H; A = Al * A; } }
                Hc = Hc * A + H; Ac *= A;
            }
            if (g4 == 3) { p.AggP[(size_t)(b * 64 + ck) * DRNN + ch0 + cl] = Ac; p.AggH[(size_t)(b * 64 + ck) * DRNN + ch0 + cl] = Hc; }
        }
        hsync();
#pragma unroll
        for (int i = 0; i < 4; ++i) {
            const int q = tid + 256 * i, row = q >> 4, c8 = (q & 15) * 8;
            const size_t o = (size_t)(b * SEQ + s0 + row) * DRNN + ch0 + c8;
            *(half8*)(p.LA + o) = *(const half8*)(laS + row * XST + c8);
            *(half8*)(p.RU + o) = *(const half8*)(ruS + row * XST + c8);
        }
    }
}
__device__ __forceinline__ void phase_rnn_scan_b(PRef p) {
    for (int u = bidx_(); u < 4 * 64 * 5; u += GRIDV) {
        const int cb = u % 5, ck = (u / 5) & 63, b = u / 320;
        const int ch = cb * 256 + tidx_();
        float h = 0.f;
        {
            const float* ap = p.AggP + (size_t)(b * 64) * DRNN + ch; const float* hp = p.AggH + (size_t)(b * 64) * DRNN + ch;
            for (int c = 0; c < ck; c += 16) {
                float pa[16], ph[16];
#pragma unroll
                for (int i = 0; i < 16; ++i) { const int ci = min(c + i, ck - 1); pa[i] = ap[(size_t)ci * DRNN]; ph[i] = hp[(size_t)ci * DRNN]; }
#pragma unroll
                for (int i = 0; i < 16; ++i) { const bool ok = c + i < ck; h = (ok ? pa[i] : 1.0f) * h + (ok ? ph[i] : 0.f); }
            }
        }
        const size_t base = (size_t)(b * SEQ + ck * 64) * DRNN + ch;
        h16* zrow = p.Z2 + (size_t)(b * SEQ + ck * 64) * Z2LD;
#pragma unroll 1
        for (int i0 = 0; i0 < 64; i0 += 32) {
            h16 la[32], uu[32], gt[32];
#pragma unroll
            for (int i = 0; i < 32; ++i) { la[i] = p.LA[base + (size_t)(i0 + i) * DRNN]; uu[i] = p.RU[base + (size_t)(i0 + i) * DRNN]; gt[i] = zrow[(size_t)(i0 + i) * Z2LD + ch]; }
#pragma unroll
            for (int i = 0; i < 32; ++i) {
                h = __expf((float)la[i]) * h + (float)uu[i];
                zrow[(size_t)(i0 + i) * Z2LD + DRNN + ch] = (h16)(gelu_as((float)gt[i]) * h);
            }
        }
    }
}

#define XB_TMO      128
#define XB_XCNT(j)  (256  + 64 * (j))
#define XB_XSUB(j)  (1280 + 64 * (j))
#define XB_XGEN(j)  (2304 + 64 * (j))
#define XB_TOP      3328
#define XB_TOPGEN   3392
#define XCD_BAR_WORDS 3456
#define XB_SPIN_CAP (1u << 22)
__device__ __forceinline__ unsigned xb_ld(unsigned* p)              { return __hip_atomic_load(p, __ATOMIC_RELAXED, __HIP_MEMORY_SCOPE_AGENT); }
__device__ __forceinline__ unsigned xb_add(unsigned* p, unsigned v) { return __hip_atomic_fetch_add(p, v, __ATOMIC_RELAXED, __HIP_MEMORY_SCOPE_AGENT); }
__device__ __forceinline__ unsigned xb_xcc_id() { return (unsigned)__builtin_amdgcn_s_getreg((3 << 11) | 20) & 0xFu; }
#define XB_SPIN(cond, bar) do { unsigned _sp = 0; while (cond) { __builtin_amdgcn_s_sleep(1); \
    if ((++_sp & 255u) == 0u) { if (xb_ld(&(bar)[XB_TMO])) break; if (_sp > XB_SPIN_CAP) { atomicAdd(&(bar)[XB_TMO], 1u); break; } } } } while (0)
struct XcdBarrier { unsigned* bar; unsigned x; volatile LAS unsigned* st; };
__device__ __forceinline__ XcdBarrier xcd_barrier_post(unsigned* bar, volatile LAS unsigned* st) {
    XcdBarrier b; b.bar = bar; b.x = xb_xcc_id(); b.st = st;
    if (threadIdx.x == 0) (void)xb_add(&bar[XB_XCNT(b.x)], 1u);
    return b;
}
__device__ __forceinline__ void xcd_barrier_complete(unsigned* bar, unsigned x, unsigned& nloc, unsigned& nx) {
    const unsigned G = gridDim.x * gridDim.y * gridDim.z;
    unsigned sum, cnt, mine, sp = 0u;
    for (;;) {
        sum = 0u; cnt = 0u; mine = 0u;
#pragma unroll
        for (unsigned j = 0; j < 16; ++j) { const unsigned c = xb_ld(&bar[XB_XCNT(j)]); sum += c; cnt += (c > 0u) ? 1u : 0u; mine = (j == x) ? c : mine; }
        if (sum == G) break;
        __builtin_amdgcn_s_sleep(1);
        if ((++sp & 255u) == 0u) { if (xb_ld(&bar[XB_TMO])) break; if (sp > XB_SPIN_CAP) { atomicAdd(&bar[XB_TMO], 1u); break; } }
    }
    nloc = mine > 0u ? mine : 1u; nx = cnt > 0u ? cnt : 1u;
}
__device__ __forceinline__ void xcd_barrier(const XcdBarrier& b) {
    asm volatile("s_waitcnt vmcnt(0)" ::: "memory");
    __syncthreads();
    if (threadIdx.x == 0) {
        unsigned* bar = b.bar;
        __builtin_amdgcn_s_waitcnt(0);
        unsigned nloc = b.st[0], nx = b.st[1];
        if (nloc == 0u) { xcd_barrier_complete(bar, b.x, nloc, nx); b.st[0] = nloc; b.st[1] = nx; }
        const unsigned old = xb_add(&bar[XB_XSUB(b.x)], 1u);
        const unsigned gen = old / nloc;
        if (old + 1u == (gen + 1u) * nloc) {
            __builtin_amdgcn_fence(__ATOMIC_RELEASE, "agent");
            asm volatile("s_waitcnt vmcnt(0)" ::: "memory");
            const unsigned og = xb_add(&bar[XB_TOP], 1u);
            const unsigned tg = og / nx;
            if (og + 1u == (tg + 1u) * nx) xb_add(&bar[XB_TOPGEN], 1u);
            else XB_SPIN(xb_ld(&bar[XB_TOPGEN]) == tg, bar);
            __builtin_amdgcn_fence(__ATOMIC_ACQUIRE, "agent");
            xb_add(&bar[XB_XGEN(b.x)], 1u);
            asm volatile("s_waitcnt vmcnt(0)" ::: "memory");
        } else {
            XB_SPIN(xb_ld(&bar[XB_XGEN(b.x)]) == gen, bar);
            __builtin_amdgcn_fence(__ATOMIC_ACQUIRE, "agent");
            asm volatile("s_waitcnt vmcnt(0)" ::: "memory");
        }
    }
    __syncthreads();
}

namespace pg8 {
#define PG8_LAS __attribute__((address_space(3)))
typedef unsigned short bf16_t;
typedef short bf16x8 __attribute__((ext_vector_type(8)));
typedef unsigned u32x4 __attribute__((ext_vector_type(4)));
constexpr int BM = 256, BK = 64, HALF = 128, HTB = HALF * BK * 2  , STAGE_BYTES = 8 * HTB, NXCD = 8, WGM = 8;

__host__ __device__ __forceinline__ int lds_byte(int r, int c) { const int st = (r >> 4) * 2 + (c >> 5), rr = r & 15, cc = c & 31, ob = rr * 64 + cc * 2; return st * 1024 + (ob ^ (((ob >> 9) & 1) << 5)); }
__host__ __device__ __forceinline__ void stage_rc(int b, int& R, int& C) { const int st = b / 1024, sb = b % 1024, swz = sb ^ (((sb >> 9) & 1) << 5); R = (st >> 1) * 16 + swz / 64; C = (st & 1) * 32 + (swz % 64) / 2; }
__host__ __device__ __forceinline__ int perm32(int rho) { const int n = rho >> 4, i = rho & 15; return 8 * (i >> 2) + 4 * n + (i & 3); }

struct Unit { int pm, pn; };
struct Gemm { const bf16_t* A; const bf16_t* Bt; int M, N, K, lda; };

struct StaticOrder {
    int nM, nN, nwg, G, c;
    __host__ __device__ void init(int M, int N, int G_, int c_) { nM = M / BM; nN = N / BM; nwg = nM * nN; G = G_; c = c_; }
    __host__ __device__ bool next(int i, Unit& u) const {
        const long L = (long)i * G + c; if (L >= nwg) return false;
        int wgid = (int)L; { const int q = nwg / NXCD, r = nwg % NXCD, xcd = wgid % NXCD, off = wgid / NXCD; wgid = (xcd < r ? xcd * (q + 1) : r * (q + 1) + (xcd - r) * q) + off; }
        const int nig = WGM * nN, gid = wgid / nig, fm = gid * WGM, gsz = (nM - fm) < WGM ? (nM - fm) : WGM;
        u.pm = fm + ((wgid % nig) % gsz); u.pn = (wgid % nig) / gsz; return true;
    }
    __device__ __forceinline__ void a_ready(const Unit&) const {}
    __device__ __forceinline__ void done(const Unit&) const {}
};
__device__ __forceinline__ unsigned pk_h16(float lo, float hi) { half2v t; t[0] = (h16)lo; t[1] = (h16)hi; return __builtin_bit_cast(unsigned, t); }
template <bool R16>
struct EpiResid {
    static constexpr bool PERM = true, AFTER_DRAIN = false;
    const void* resid; h16* out; float* ssq; int ldc;
    __device__ __forceinline__ void operator()(const f32x4 (&acc)[2][2][4][2], const Unit& u, int wr, int wc, int fr, int fq) const {
#pragma unroll
        for (int ai = 0; ai < 2; ++ai)
#pragma unroll
            for (int m = 0; m < 4; ++m) { const int row = u.pm * BM + ai * HALF + wr * 64 + m * 16 + fr; const size_t ro = (size_t)row * ldc + u.pn * BM + wc * 32 + 8 * fq;
                float ss = 0.f;
#pragma unroll
                for (int bj = 0; bj < 2; ++bj) { const size_t o = ro + bj * HALF;
                    f32x4 v0 = acc[ai][bj][m][0], v1 = acc[ai][bj][m][1];
                    if (R16) { const half8 r = *(const half8*)((const h16*)resid + o);
#pragma unroll
                        for (int i = 0; i < 4; ++i) { v0[i] += (float)r[i]; v1[i] += (float)r[4 + i]; } }
                    else { v0 += *(const f32x4*)((const float*)resid + o); v1 += *(const f32x4*)((const float*)resid + o + 4); }
                    ss += ((v0[0] * v0[0] + v0[1] * v0[1]) + (v0[2] * v0[2] + v0[3] * v0[3])) + ((v1[0] * v1[0] + v1[1] * v1[1]) + (v1[2] * v1[2] + v1[3] * v1[3]));
                    u32x4 w; w.x = pk_h16(v0[0], v0[1]); w.y = pk_h16(v0[2], v0[3]); w.z = pk_h16(v1[0], v1[1]); w.w = pk_h16(v1[2], v1[3]);
                    *(u32x4*)(out + o) = w; }
                ss += __shfl_xor(ss, 16); ss += __shfl_xor(ss, 32);
                if (fq == 0) ssq[(size_t)row * 16 + u.pn * 4 + wc] = ss; }
    }
};
struct EpiF32 {
    static constexpr bool PERM = false, AFTER_DRAIN = false;
    float* out; size_t ldc;
    __device__ __forceinline__ void operator()(const f32x4 (&acc)[2][2][4][2], const Unit& u, int wr, int wc, int fr, int fq) const {
#pragma unroll
        for (int ai = 0; ai < 2; ++ai)
#pragma unroll
            for (int m = 0; m < 4; ++m) { const size_t ro = (size_t)(u.pm * BM + ai * HALF + wr * 64 + m * 16 + fr) * ldc + u.pn * BM + wc * 32 + 4 * fq;
#pragma unroll
                for (int bj = 0; bj < 2; ++bj)
#pragma unroll
                    for (int n = 0; n < 2; ++n) *(f32x4*)(out + ro + bj * HALF + n * 16) = acc[ai][bj][m][n]; }
    }
};
struct EpiH16 {
    static constexpr bool PERM = true, AFTER_DRAIN = false;
    h16* out; int ldc;
    __device__ __forceinline__ void operator()(const f32x4 (&acc)[2][2][4][2], const Unit& u, int wr, int wc, int fr, int fq) const {
#pragma unroll
        for (int ai = 0; ai < 2; ++ai)
#pragma unroll
            for (int m = 0; m < 4; ++m) { h16* rowp = out + (size_t)(u.pm * BM + ai * HALF + wr * 64 + m * 16 + fr) * ldc + u.pn * BM + wc * 32 + 8 * fq;
#pragma unroll
                for (int bj = 0; bj < 2; ++bj) { const f32x4 v0 = acc[ai][bj][m][0], v1 = acc[ai][bj][m][1];
                    u32x4 w; w.x = pk_h16(v0[0], v0[1]); w.y = pk_h16(v0[2], v0[3]); w.z = pk_h16(v1[0], v1[1]); w.w = pk_h16(v1[2], v1[3]);
                    *(u32x4*)(rowp + bj * HALF) = w; } }
    }
};
struct EpiSC {
    static constexpr bool PERM = true, AFTER_DRAIN = false;
    h16* out; const float* ssq;
    __device__ __forceinline__ void operator()(const f32x4 (&acc)[2][2][4][2], const Unit& u, int wr, int wc, int fr, int fq) const {
#pragma unroll
        for (int ai = 0; ai < 2; ++ai)
#pragma unroll
            for (int m = 0; m < 4; ++m) { const int row = u.pm * BM + ai * HALF + wr * 64 + m * 16 + fr;
                const f32x4 s0 = *(const f32x4*)(ssq + (size_t)row * 16), s1 = *(const f32x4*)(ssq + (size_t)row * 16 + 4), s2 = *(const f32x4*)(ssq + (size_t)row * 16 + 8), s3 = *(const f32x4*)(ssq + (size_t)row * 16 + 12);
                const float ssr = (((s0[0] + s0[1]) + (s0[2] + s0[3])) + ((s1[0] + s1[1]) + (s1[2] + s1[3]))) + (((s2[0] + s2[1]) + (s2[2] + s2[3])) + ((s3[0] + s3[1]) + (s3[2] + s3[3])));
                const float rstd = rsqrtf(ssr * (1.0f / 1024.0f) + 1e-6f);
#pragma unroll
                for (int bj = 0; bj < 2; ++bj) { const int col = u.pn * BM + bj * HALF + wc * 32 + 8 * fq;
                    const f32x4 v0 = acc[ai][bj][m][0] * rstd, v1 = acc[ai][bj][m][1] * rstd;
                    u32x4 w; w.x = pk_h16(v0[0], v0[1]); w.y = pk_h16(v0[2], v0[3]); w.z = pk_h16(v1[0], v1[1]); w.w = pk_h16(v1[2], v1[3]);
                    *(u32x4*)(out + ((size_t)((row >> 6) * 256 + (col >> 3)) * 64 + (row & 63)) * 8) = w; } }
    }
};
struct EpiEvenMain {
    static constexpr bool PERM = true, AFTER_DRAIN = false;
    h16* Z; float* FG; const float* b_f;
    __device__ __forceinline__ void operator()(const f32x4 (&acc)[2][2][4][2], const Unit& u, int wr, int wc, int fr, int fq) const {
#pragma unroll
        for (int bj = 0; bj < 2; ++bj) {
            const int col0 = u.pn * BM + bj * HALF + wc * 32 + 8 * fq;
            if (col0 < 2048) {
                const float sc = (col0 < 512 || (col0 >= 1024 && col0 < 1536)) ? QSCALE : 1.0f;
#pragma unroll
                for (int ai = 0; ai < 2; ++ai)
#pragma unroll
                    for (int m = 0; m < 4; ++m) { const f32x4 v0 = acc[ai][bj][m][0] * sc, v1 = acc[ai][bj][m][1] * sc;
                        u32x4 w; w.x = pk_h16(v0[0], v0[1]); w.y = pk_h16(v0[2], v0[3]); w.z = pk_h16(v1[0], v1[1]); w.w = pk_h16(v1[2], v1[3]);
                        *(u32x4*)(Z + (size_t)(u.pm * BM + ai * HALF + wr * 64 + m * 16 + fr) * ZLD + col0) = w; }
            } else if (col0 < 2080) {
                const int c = col0 - 2048;
#pragma unroll
                for (int ai = 0; ai < 2; ++ai)
#pragma unroll
                    for (int m = 0; m < 4; ++m) { const f32x4 v0 = acc[ai][bj][m][0], v1 = acc[ai][bj][m][1]; f32x4 o0, o1;
                        if (c == 0) {
#pragma unroll
                            for (int q = 0; q < 4; ++q) { o0[q] = log_sigmoid(v0[q] + b_f[q]) * LOG2E; o1[q] = log_sigmoid(v1[q] + b_f[4 + q]) * LOG2E; }
                        } else {
#pragma unroll
                            for (int q = 0; q < 4; ++q) { o0[q] = sigmoidf_(v0[q]); o1[q] = sigmoidf_(v1[q]); }
                        }
                        float* fr_ = FG + (size_t)(u.pm * BM + ai * HALF + wr * 64 + m * 16 + fr) * 32 + c;
                        *(f32x4*)fr_ = o0; *(f32x4*)(fr_ + 4) = o1; }
            }
        }
    }
};
struct EpiVt {
    static constexpr bool PERM = true, AFTER_DRAIN = false;
    h16 *VtF, *VtS, *VtW;
    __device__ __forceinline__ void operator()(const f32x4 (&acc)[2][2][4][2], const Unit& u, int wr, int wc, int fr, int fq) const {
#pragma unroll
        for (int ai = 0; ai < 2; ++ai)
#pragma unroll
            for (int m = 0; m < 4; ++m) {
                const int n = u.pm * BM + ai * HALF + wr * 64 + m * 16 + fr;
#pragma unroll
                for (int bj = 0; bj < 2; ++bj) {
                    const int t0 = u.pn * BM + bj * HALF + wc * 32 + 8 * fq, b = t0 >> 12, s = t0 & 4095;
                    h16* dst = n < 512 ? VtF + ((size_t)(b * 512 + n)) * SEQ + s : (n < 640 ? VtS + ((size_t)(b * 128 + n - 512)) * SEQ + s : VtW + ((size_t)(b * 128 + n - 640)) * SEQ + s);
                    const f32x4 v0 = acc[ai][bj][m][0], v1 = acc[ai][bj][m][1];
                    u32x4 w; w.x = pk_h16(v0[0], v0[1]); w.y = pk_h16(v0[2], v0[3]); w.z = pk_h16(v1[0], v1[1]); w.w = pk_h16(v1[2], v1[3]);
                    *(u32x4*)dst = w;
                }
            }
    }
};

template <class Epi, class Sched, bool ALIGN_EPI = false, bool SP2 = false>
__device__ __forceinline__ void gemm_phase(PG8_LAS unsigned char* lds, const Gemm g, const Sched& S, const Epi& E) {
    int tid_ = threadIdx.x; asm volatile("" : "+v"(tid_));
    const int tid = tid_, wid = __builtin_amdgcn_readfirstlane(tid >> 6), lane = tid & 63, wr = wid >> 2, wc = wid & 3, fr = lane & 15, fq = lane >> 4;
    const int K = g.K, nt = K / BK;
    unsigned voffA[2], voffB[2];
#pragma unroll
    for (int i = 0; i < 2; ++i) { int R, C; stage_rc(tid * 16 + i * 8192, R, C); const int Rb = Epi::PERM ? ((R & ~31) + perm32(R & 31)) : R;
        voffA[i] = (unsigned)(R * g.lda + C) * 2u; voffB[i] = (unsigned)(Rb * K + C) * 2u; }
    const size_t kstep = (size_t)(BK * 2);
    const size_t hstepA = (size_t)HALF * g.lda * 2, hstepB = (size_t)HALF * K * 2;
    const size_t tstepA = 2 * hstepA, tstepB = 2 * hstepB;
    const unsigned ldsw = (unsigned)wid * 1024u;
    const int aoff = lds_byte(wr * 64 + fr, fq * 8), boff = lds_byte(wc * 32 + fr, fq * 8);
#define PG8_SA(b, h) (((b) * 2 + (h)) * HTB)
#define PG8_SB(b, h) ((4 + (b) * 2 + (h)) * HTB)
#define PG8_STAGE(bufoff, gbase, voff) do { _Pragma("unroll") for (int _i = 0; _i < 2; ++_i) \
        __builtin_amdgcn_global_load_lds((const unsigned*)((const char*)(gbase) + (voff)[_i]), (PG8_LAS unsigned*)(lds + (bufoff) + ldsw + _i * 8192), 16, 0, 0); } while (0)
#define PG8_LDA(dst, b, h) do { _Pragma("unroll") for (int m = 0; m < 4; ++m) _Pragma("unroll") for (int k = 0; k < 2; ++k) dst[m][k] = *(const PG8_LAS bf16x8*)(lds + PG8_SA(b, h) + aoff + m * 2048 + k * 1024); } while (0)
#define PG8_LDB(dst, b, h) do { _Pragma("unroll") for (int n = 0; n < 2; ++n) _Pragma("unroll") for (int k = 0; k < 2; ++k) dst[n][k] = *(const PG8_LAS bf16x8*)(lds + PG8_SB(b, h) + boff + n * 2048 + k * 1024); } while (0)
#define PG8_MMA(ai, bj, At, Bt) do { __builtin_amdgcn_s_setprio(1); _Pragma("unroll") for (int m = 0; m < 4; ++m) _Pragma("unroll") for (int n = 0; n < 2; ++n) _Pragma("unroll") for (int k = 0; k < 2; ++k) \
        acc[ai][bj][m][n] = __builtin_amdgcn_mfma_f32_16x16x32_f16(__builtin_bit_cast(half8, Bt[n][k]), __builtin_bit_cast(half8, At[m][k]), acc[ai][bj][m][n], 0, 0, 0); __builtin_amdgcn_s_setprio(0); } while (0)
#define PG8_WAIT_V(n) asm volatile("s_waitcnt vmcnt(" #n ")" ::: "memory")
#define PG8_WAIT_L(n) asm volatile("s_waitcnt lgkmcnt(" #n ")" ::: "memory")
#define PG8_BAR __builtin_amdgcn_s_barrier()
#define PG8_SCHED __builtin_amdgcn_sched_barrier(0)
    Unit cur, nxt; int ui = 0;
    if (!S.next(0, cur)) return;
    f32x4 acc[2][2][4][2];
#pragma unroll
    for (int a = 0; a < 2; ++a)
#pragma unroll
        for (int b = 0; b < 2; ++b)
#pragma unroll
            for (int m = 0; m < 4; ++m)
#pragma unroll
                for (int n = 0; n < 2; ++n) acc[a][b][m][n] = (f32x4){0.f, 0.f, 0.f, 0.f};
    bf16x8 At[4][2], B0[2][2], B1[2][2];
    const char* cA = (const char*)g.A + (size_t)cur.pm * tstepA; const char* cB = (const char*)g.Bt + (size_t)cur.pn * tstepB;
    S.a_ready(cur);
    if constexpr (SP2) {
        PG8_STAGE(PG8_SB(0, 0), cB, voffB); PG8_STAGE(PG8_SB(0, 1), cB + hstepB, voffB); PG8_STAGE(PG8_SA(0, 0), cA, voffA); PG8_STAGE(PG8_SA(0, 1), cA + hstepA, voffA);
        if (wr == 1) PG8_BAR;
        PG8_WAIT_V(2); PG8_BAR;
        PG8_STAGE(PG8_SB(1, 0), cB + kstep, voffB); PG8_STAGE(PG8_SA(1, 0), cA + kstep, voffA); PG8_STAGE(PG8_SB(1, 1), cB + hstepB + kstep, voffB);
        PG8_WAIT_V(6); PG8_BAR;
    } else {
        PG8_STAGE(PG8_SB(0, 0), cB, voffB); PG8_STAGE(PG8_SA(0, 0), cA, voffA); PG8_STAGE(PG8_SB(0, 1), cB + hstepB, voffB); PG8_STAGE(PG8_SA(0, 1), cA + hstepA, voffA);
        if (wr == 1) PG8_BAR;
        PG8_WAIT_V(4); PG8_BAR;
        PG8_STAGE(PG8_SB(1, 0), cB + kstep, voffB); PG8_STAGE(PG8_SA(1, 0), cA + kstep, voffA); PG8_STAGE(PG8_SB(1, 1), cB + hstepB + kstep, voffB);
        PG8_WAIT_V(6); PG8_BAR;
    }
    for (;;) {
        const bool has_next = S.next(ui + 1, nxt);
        const char* nA = has_next ? (const char*)g.A + (size_t)nxt.pm * tstepA : cA; const char* nB = has_next ? (const char*)g.Bt + (size_t)nxt.pn * tstepB : cB;
        for (int t = 0; t < nt; t += 2) {
            const bool last = (t == nt - 2);
            const char* a1 = cA + (size_t)(t + 1) * kstep;
            const char* a2 = last ? nA : cA + (size_t)(t + 2) * kstep; const char* b2 = last ? nB : cB + (size_t)(t + 2) * kstep;
            const char* a3 = a2 + kstep; const char* b3 = b2 + kstep;
            if (last && has_next) S.a_ready(nxt);
            if constexpr (SP2) {
            PG8_LDB(B0, 0, 0); PG8_LDB(B1, 0, 1); PG8_SCHED; PG8_LDA(At, 0, 0); PG8_STAGE(PG8_SA(1, 1), a1 + hstepA, voffA);
            PG8_WAIT_V(8); PG8_WAIT_L(0); PG8_BAR; PG8_MMA(0, 0, At, B0); PG8_MMA(0, 1, At, B1); PG8_BAR; PG8_SCHED;
            PG8_LDA(At, 0, 1); PG8_STAGE(PG8_SB(0, 0), b2, voffB); PG8_STAGE(PG8_SB(0, 1), b2 + hstepB, voffB); PG8_STAGE(PG8_SA(0, 0), a2, voffA);
            PG8_WAIT_V(8); PG8_WAIT_L(0); PG8_BAR; PG8_MMA(1, 0, At, B0); PG8_MMA(1, 1, At, B1); PG8_BAR; PG8_SCHED;
            PG8_LDB(B0, 1, 0); PG8_LDB(B1, 1, 1); PG8_SCHED; PG8_LDA(At, 1, 0); PG8_STAGE(PG8_SA(0, 1), a2 + hstepA, voffA);
            PG8_WAIT_V(8); PG8_WAIT_L(0); PG8_BAR; PG8_MMA(0, 0, At, B0); PG8_MMA(0, 1, At, B1); PG8_BAR; PG8_SCHED;
            PG8_LDA(At, 1, 1); PG8_STAGE(PG8_SB(1, 0), b3, voffB); PG8_STAGE(PG8_SB(1, 1), b3 + hstepB, voffB); PG8_STAGE(PG8_SA(1, 0), a3, voffA);
            PG8_WAIT_V(8); PG8_WAIT_L(0); PG8_BAR; PG8_MMA(1, 0, At, B0); PG8_MMA(1, 1, At, B1); PG8_BAR; PG8_SCHED;
            } else {
            PG8_LDB(B0, 0, 0); PG8_SCHED; PG8_LDA(At, 0, 0); PG8_STAGE(PG8_SA(1, 1), a1 + hstepA, voffA);
            PG8_WAIT_L(8); PG8_BAR; PG8_WAIT_L(0); PG8_MMA(0, 0, At, B0); PG8_BAR; PG8_SCHED;
            PG8_LDB(B1, 0, 1); PG8_STAGE(PG8_SB(0, 0), b2, voffB);
            PG8_BAR; PG8_WAIT_L(0); PG8_MMA(0, 1, At, B1); PG8_BAR;
            PG8_LDA(At, 0, 1); PG8_STAGE(PG8_SA(0, 0), a2, voffA);
            PG8_BAR; PG8_WAIT_L(0); PG8_MMA(1, 0, At, B0); PG8_BAR; PG8_SCHED;
            PG8_STAGE(PG8_SB(0, 1), b2 + hstepB, voffB);
            PG8_WAIT_V(6); PG8_BAR; PG8_MMA(1, 1, At, B1); PG8_BAR;
            PG8_LDB(B0, 1, 0); PG8_SCHED; PG8_LDA(At, 1, 0); PG8_STAGE(PG8_SA(0, 1), a2 + hstepA, voffA);
            PG8_WAIT_L(8); PG8_BAR; PG8_WAIT_L(0); PG8_MMA(0, 0, At, B0); PG8_BAR; PG8_SCHED;
            PG8_LDB(B1, 1, 1); PG8_STAGE(PG8_SB(1, 0), b3, voffB);
            PG8_BAR; PG8_WAIT_L(0); PG8_MMA(0, 1, At, B1); PG8_BAR;
            PG8_LDA(At, 1, 1); PG8_STAGE(PG8_SA(1, 0), a3, voffA);
            PG8_BAR; PG8_WAIT_L(0); PG8_MMA(1, 0, At, B0); PG8_BAR; PG8_SCHED;
            PG8_STAGE(PG8_SB(1, 1), b3 + hstepB, voffB);
            PG8_WAIT_V(6); PG8_BAR; PG8_MMA(1, 1, At, B1); PG8_BAR;
            }
        }
        if constexpr (ALIGN_EPI) { if (wr == 0) PG8_BAR; }
        if constexpr (!Epi::AFTER_DRAIN) { E(acc, cur, wr, wc, fr, fq); S.done(cur); }
        if (!has_next) break;
#pragma unroll
        for (int a = 0; a < 2; ++a)
#pragma unroll
            for (int b = 0; b < 2; ++b)
#pragma unroll
                for (int m = 0; m < 4; ++m)
#pragma unroll
                    for (int n = 0; n < 2; ++n) acc[a][b][m][n] = (f32x4){0.f, 0.f, 0.f, 0.f};
        cur = nxt; cA = nA; cB = nB; ++ui;
        if constexpr (ALIGN_EPI) { if (wr == 1) PG8_BAR; }
    }
    PG8_WAIT_V(0);
    if constexpr (!ALIGN_EPI) { if (wr == 0) PG8_BAR; }
    PG8_BAR;
    if constexpr (Epi::AFTER_DRAIN) { E.fused(acc, cur, wr, wc, fr, fq, lds, wid, lane); S.done(cur); }
#undef PG8_SA
#undef PG8_SB
#undef PG8_STAGE
#undef PG8_LDA
#undef PG8_LDB
#undef PG8_MMA
#undef PG8_WAIT_V
#undef PG8_WAIT_L
#undef PG8_BAR
#undef PG8_SCHED
}
}

__device__ __forceinline__ GemmArgs mk_gemm(const h16* A, int lda, const h16* Bt, int ldb, int M, int N, int K, int ans, int mode, h16* c16, int ldc16, float* c32, int ldc32, const float* resid) {
    GemmArgs g; g.A = A; g.lda = lda; g.Bt = Bt; g.ldb = ldb; g.M = M; g.N = N; g.K = K; g.a_ntile_stride = ans; g.mode = mode; g.c16 = c16; g.ldc16 = ldc16; g.c32 = c32; g.ldc32 = ldc32; g.resid = resid; g.aux = nullptr; return g;
}

__device__ __forceinline__ void run_phase(PRef p, int ph, char* smem) {
    if (ph == 1 || ph == 4 || ph == 6 || ph == 10 || ph == 14 || ph == 16) {
        PG8_LAS unsigned char* lds = (PG8_LAS unsigned char*)dyn_lds;
        const int G = (int)gridDim.x, c = (int)blockIdx.x;
        pg8::StaticOrder S;
        typedef const pg8::bf16_t* bp;
        if (ph == 1) {
            { pg8::EpiEvenMain E{p.Z, p.FG, p.even_b_f}; S.init(TOK, ZLD, G, c);
              pg8::gemm_phase<pg8::EpiEvenMain, pg8::StaticOrder, true, true>(lds, pg8::Gemm{(bp)p.HN, (bp)p.WtE, TOK, ZLD, DM, DM}, S, E); }
            { pg8::EpiVt E{p.VtF, p.VtS, p.VtW}; S.init(768, TOK, G, (c + 3 * G / 4) % G);
              pg8::gemm_phase<pg8::EpiVt, pg8::StaticOrder, true, true>(lds, pg8::Gemm{(bp)p.WtV, (bp)p.HN, 768, TOK, DM, DM}, S, E); }
        } else if (ph == 4) {
            pg8::EpiResid<false> E{p.x, p.H, p.SSQ, DM}; S.init(TOK, DM, G, c);
            pg8::gemm_phase<pg8::EpiResid<false>, pg8::StaticOrder, true, true>(lds, pg8::Gemm{(bp)p.O, (bp)p.WtEo, TOK, DM, DM, DM}, S, E);
        } else if (ph == 14) {
            pg8::EpiResid<true> E{p.H, p.H, p.SSQ, DM}; S.init(TOK, DM, G, c);
            pg8::gemm_phase<pg8::EpiResid<true>, pg8::StaticOrder, true, true>(lds, pg8::Gemm{(bp)(p.Z2 + DRNN), (bp)p.WtOo, TOK, DM, DRNN, Z2LD}, S, E);
        } else if (ph == 10) {
            pg8::EpiH16 E{p.Z2, Z2LD}; S.init(TOK, Z2LD, G, c);
            pg8::gemm_phase<pg8::EpiH16, pg8::StaticOrder, true, true>(lds, pg8::Gemm{(bp)p.HN, (bp)p.WtO, TOK, Z2LD, DM, DM}, S, E);
        } else {
            pg8::EpiSC E{p.SC, p.SSQ}; S.init(TOK, 2048, G, c);
            pg8::gemm_phase<pg8::EpiSC, pg8::StaticOrder, true, true>(lds, pg8::Gemm{(bp)p.H, (bp)(p.WtQ + (ph == 16 ? (size_t)2048 * 1024 : 0)), TOK, 2048, DM, DM}, S, E);
        }
        return;
    }
    if (ph == 0) phase_prep(p, smem);
    else if (ph == 2) phase_cumsum_compress(p, smem);
    else if (ph == 3) phase_attention(p, smem);
    else if (ph == 8 || ph == 18) phase_peer_topk(p, smem);
    else if (ph == 9 || ph == 19) phase_peer_experts(p, ph == 19 ? 1 : 0, ph == 19 ? p.final_g : p.odd_norm_g, ph == 19 ? 1 : 0, smem);
    else if (ph == 11) phase_rnn_gates(p, smem);
    else if (ph == 13) phase_rnn_scan_b(p);
}

__global__ void __launch_bounds__(512, 2) mega(Params p_by_value) {
    char* smem = dyn_lds + hidx_() * 65536;
    volatile LAS unsigned* hs_all = (volatile LAS unsigned*)(dyn_lds + 131072);
    const __attribute__((address_space(4))) Params* kp = (const __attribute__((address_space(4))) Params*)__builtin_amdgcn_kernarg_segment_ptr();
    const int ph0 = (int)kp->ph0, ph1 = (int)kp->ph1;
    if (threadIdx.x < 12) hs_all[threadIdx.x] = 0u;
    __syncthreads();
    XcdBarrier xb = xcd_barrier_post(kp->BAR, hs_all + 8);
    for (int ph = ph0; ph < ph1; ++ph) {
        if (ph == 12 || ph == 7 || ph == 17 || ph == 5 || ph == 15) continue;
        const __attribute__((address_space(4))) Params* q = kp;
        asm volatile("" : "+s"(q));
        PRef p = *q;
#if PROBE_PH >= 0
        if (blockIdx.x == 0 && threadIdx.x == 0) p.TS[ph] = __builtin_amdgcn_s_memrealtime();
#endif
        const int reps = ((DUP_MASK >> ph) & 1) ? 2 : 1;
        for (int r = 0; r < reps; ++r) { run_phase(p, ph, smem); if (r + 1 < reps) xcd_barrier(xb); }
        if (ph + 1 < ph1) xcd_barrier(xb);
    }
    PRef p = *kp;
#if PROBE_PH >= 0
    cg::this_grid().sync();
    if (blockIdx.x == 0 && threadIdx.x == 0) { p.TS[NPHASE] = __builtin_amdgcn_s_memrealtime(); __threadfence(); }
    cg::this_grid().sync();
    {
        const unsigned long long t0 = __hip_atomic_load(&p.TS[0], __ATOMIC_RELAXED, __HIP_MEMORY_SCOPE_AGENT), t1 = __hip_atomic_load(&p.TS[NPHASE], __ATOMIC_RELAXED, __HIP_MEMORY_SCOPE_AGENT);
        const unsigned long long a = __hip_atomic_load(&p.TS[PROBE_PH], __ATOMIC_RELAXED, __HIP_MEMORY_SCOPE_AGENT), b = __hip_atomic_load(&p.TS[PROBE_PH + PROBE_N], __ATOMIC_RELAXED, __HIP_MEMORY_SCOPE_AGENT);
        const float frac = (float)(b - a) / (float)(t1 - t0);
        const float scale = 1.1f + frac;
        for (size_t i = (size_t)blockIdx.x * 512 + threadIdx.x; i < (size_t)TOK * DM; i += (size_t)gridDim.x * 512) p.out[i] *= scale;
    }
#endif
}

constexpr int DYN_LDS_BYTES = 131072 + 64;
extern "C" void kernel_launch(void* const* d_in, const int* in_sizes, int n_in, void* d_out, int out_size, void* d_ws, size_t ws_size, hipStream_t stream) {
    Params p; memset(&p, 0, sizeof(p));
    const float* const* in = (const float* const*)d_in;
    p.x = in[0]; p.even_norm_g = in[1]; p.even_w_in = in[2]; p.even_b_f = in[3]; p.even_cmp_pos = in[4]; p.even_w_cmp_k = in[5]; p.even_w_cmp_v = in[6]; p.even_w_out = in[7];
    p.odd_norm_g = in[8]; p.odd_w_in = in[9]; p.odd_conv_w = in[10]; p.odd_conv_b = in[11]; p.odd_w_ra = in[12]; p.odd_b_ra = in[13]; p.odd_w_ri = in[14]; p.odd_b_ri = in[15];
    p.odd_lam = in[16]; p.odd_w_out = in[17]; p.ffn_norm_g = in[18]; p.peer_w_q = in[19]; p.peer_sub_keys = in[20]; p.peer_u = in[21]; p.peer_v = in[22]; p.final_g = in[23];
    p.out = (float*)d_out;
    char* ws = (char*)d_ws; size_t off = 0;
    auto take = [&](size_t bytes) { char* r = ws + off; off += (bytes + 255) & ~(size_t)255; return r; };
    p.WtE = (h16*)take((size_t)ZLD * 1024 * 2); p.WtV = (h16*)take((size_t)768 * 1024 * 2); p.WtEo = (h16*)take((size_t)1024 * 1024 * 2); p.WtO = (h16*)take((size_t)2560 * 1024 * 2); p.WtOo = (h16*)take((size_t)1024 * 1280 * 2);
    p.WtQ = (h16*)take((size_t)2 * 2048 * 1024 * 2); p.Wc = (h16*)take((size_t)2 * 64 * 2048 * 2); p.Wr = (h16*)take((size_t)20 * 16384 * 2); p.Keys = (h16*)take((size_t)2 * 8 * 2 * 128 * 128 * 2);
    p.Pos16 = (h16*)take(4096); p.U8 = (unsigned char*)take((size_t)2 * 16384 * 1024); p.V8 = (unsigned char*)take((size_t)2 * 16384 * 1024);
    p.US = (float*)take((size_t)2 * 16384 * 4); p.VS = (float*)take((size_t)2 * 16384 * 4);
    p.H = (h16*)take((size_t)TOK * DM * 2); p.HN = (h16*)take((size_t)TOK * DM * 2); p.SSQ = (float*)take((size_t)TOK * 16 * 4);
    const size_t scratch0 = off;
    p.Z = (h16*)take((size_t)TOK * ZLD * 2); p.VtF = (h16*)take((size_t)4 * 8 * 64 * SEQ * 2); p.VtS = (h16*)take((size_t)4 * 2 * 64 * SEQ * 2); p.VtW = (h16*)take((size_t)4 * 2 * 64 * SEQ * 2);
    p.KC = (h16*)take((size_t)8 * 256 * 64 * 2); p.VCt = (h16*)take((size_t)8 * 64 * 256 * 2); p.O = (h16*)take((size_t)TOK * DM * 2); p.FG = (float*)take((size_t)TOK * 32 * 4); p.C2 = (float*)take((size_t)32 * SEQ * 4); p.OACC = (float*)take((size_t)TOK * 512 * 4);
    size_t mx = off;
    off = scratch0;
    p.QP = (h16*)take((size_t)TOK * 2048 * 2); p.SC = (h16*)take((size_t)TOK * 2048 * 2); p.IDS = (int*)take((size_t)TOK * 128 * 4); p.GW = (float*)take((size_t)TOK * 128 * 4);
    if (off > mx) mx = off;
    off = scratch0;
    p.Z2 = (h16*)take((size_t)TOK * Z2LD * 2); p.LA = (h16*)take((size_t)TOK * DRNN * 2); p.RU = (h16*)take((size_t)TOK * DRNN * 2);
    p.AggP = (float*)take((size_t)4 * 64 * DRNN * 4); p.AggH = (float*)take((size_t)4 * 64 * DRNN * 4);
    if (off > mx) mx = off;
    off = mx; p.TS = (unsigned long long*)take(256); p.BAR = (unsigned*)take(XCD_BAR_WORDS * 4 + 256); mx = off;
    if (mx > ws_size) { fprintf(stderr, "workspace too small: need %zu have %zu\n", mx, ws_size); return; }

    static int grid_blocks = 0;
    if (!grid_blocks) {
        int dev = 0, cus = 0, per_cu = 0;
        hipGetDevice(&dev);
        hipDeviceGetAttribute(&cus, hipDeviceAttributeMultiprocessorCount, dev);
        hipFuncSetAttribute((const void*)mega, hipFuncAttributeMaxDynamicSharedMemorySize, DYN_LDS_BYTES);
        hipOccupancyMaxActiveBlocksPerMultiprocessor(&per_cu, mega, 512, DYN_LDS_BYTES);
        if (per_cu > 1) per_cu = 1;
        if (per_cu < 1) per_cu = 1;
        grid_blocks = cus * per_cu;
    }
    hipMemsetAsync(p.BAR, 0, XCD_BAR_WORDS * 4 + 256, stream);
#if SINGLE_LAUNCH
    p.ph0 = 0; p.ph1 = NPHASE;
    void* args[] = {&p};
    hipError_t e = hipLaunchCooperativeKernel((void*)mega, dim3(grid_blocks), dim3(512), args, DYN_LDS_BYTES, stream);
    if (e != hipSuccess) fprintf(stderr, "cooperative launch failed: %s (grid %d)\n", hipGetErrorString(e), grid_blocks);
#else
    for (int ph = 0; ph < NPHASE; ++ph) {
        p.ph0 = ph; p.ph1 = ph + 1;
        hipLaunchKernelGGL(mega, dim3(grid_blocks), dim3(512), DYN_LDS_BYTES, stream, p);
    }
#endif
}
```

```cpp
#include <hip/hip_runtime.h>
#include <hip/hip_cooperative_groups.h>
#include <cstdio>
#include <cstdint>
#include <cstring>
namespace cg = cooperative_groups;

#ifndef SINGLE_LAUNCH
#define SINGLE_LAUNCH 1
#endif
#ifndef PROBE_PH
#define PROBE_PH -1
#endif
#ifndef PROBE_N
#define PROBE_N 1
#endif
#ifndef DUP_MASK
#define DUP_MASK 0
#endif

typedef _Float16 h16;
typedef _Float16 half8 __attribute__((ext_vector_type(8)));
typedef _Float16 half4 __attribute__((ext_vector_type(4)));
typedef _Float16 half2v __attribute__((ext_vector_type(2)));
typedef float f32x4 __attribute__((ext_vector_type(4)));
typedef float f32x16 __attribute__((ext_vector_type(16)));
typedef unsigned long long u64;
typedef int i32x4 __attribute__((ext_vector_type(4)));
typedef float f32x2 __attribute__((ext_vector_type(2)));
typedef float f32x32 __attribute__((ext_vector_type(32)));
typedef _Float16 h16x32 __attribute__((ext_vector_type(32)));
typedef unsigned u32x6 __attribute__((ext_vector_type(6)));
typedef int i32x2 __attribute__((ext_vector_type(2)));
typedef i32x4 __attribute__((aligned(8))) i32x4_a8;

#define NTHR 256
constexpr int BATCH = 4, SEQ = 4096, DM = 1024, TOK = BATCH * SEQ;
constexpr int ZLD = 2304, Z2LD = 2560, DRNN = 1280;
constexpr int EVEN_IN = 2848;
constexpr float LOG2E = 1.4426950408889634f;
constexpr float QSCALE = 0.125f * LOG2E;
constexpr float NEGBIG = -1.0e30f;
constexpr int KST = 72;
constexpr int NPHASE = 20;
constexpr int XCD_BAR_WORDS_C = 3456;

struct Params {
    const float *x, *even_norm_g, *even_w_in, *even_b_f, *even_cmp_pos, *even_w_cmp_k, *even_w_cmp_v, *even_w_out;
    const float *odd_norm_g, *odd_w_in, *odd_conv_w, *odd_conv_b, *odd_w_ra, *odd_b_ra, *odd_w_ri, *odd_b_ri, *odd_lam, *odd_w_out;
    const float *ffn_norm_g, *peer_w_q, *peer_sub_keys, *peer_u, *peer_v, *final_g;
    float* out;
    h16 *WtE, *WtV, *WtEo, *WtO, *WtOo, *WtQ, *Wc, *Wr, *Keys, *Pos16;
    unsigned char *U8, *V8; float *US, *VS;
    h16* H; h16* HN;
    h16 *Z, *VtF, *VtS, *VtW, *KC, *VCt, *O; float *FG, *C2, *OACC;
    float* SSQ;
    h16* QP; h16* SC; int* IDS; float* GW;
    h16* Z2; h16 *LA, *RU; float *AggP, *AggH;
    unsigned long long* TS; unsigned* BAR;
    long long ph0, ph1;
};

typedef const __attribute__((address_space(4))) Params& PRef;
extern __shared__ __attribute__((aligned(16))) char dyn_lds[];
#define GRIDV ((int)gridDim.x * 2)
#define LAS __attribute__((address_space(3)))
__device__ __forceinline__ int hidx_() { return __builtin_amdgcn_readfirstlane((int)threadIdx.x >> 8); }
__device__ __forceinline__ int tidx_() { int t = threadIdx.x & 255; asm volatile("" : "+v"(t)); return t; }
__device__ __forceinline__ int bidx_() { int b = blockIdx.x * 2 + hidx_(); asm volatile("" : "+s"(b)); return b; }
__device__ __forceinline__ int widx_() { return __builtin_amdgcn_readfirstlane(((int)threadIdx.x >> 6) & 3); }
__device__ __forceinline__ void hsync() {
    volatile LAS unsigned* w = (volatile LAS unsigned*)(dyn_lds + 131072 + hidx_() * 16);
    asm volatile("s_waitcnt lgkmcnt(0)" ::: "memory");
    if ((threadIdx.x & 63) == 0) {
        const unsigned old = __hip_atomic_fetch_add((LAS unsigned*)w, 1u, __ATOMIC_RELAXED, __HIP_MEMORY_SCOPE_WORKGROUP);
        const unsigned target = (old | 3u) + 1u;
        while ((int)(w[0] - target) < 0) { }
    }
    asm volatile("s_waitcnt lgkmcnt(0)" ::: "memory");
}

__device__ __forceinline__ float wave_sum(float v) {
#pragma unroll
    for (int o = 32; o > 0; o >>= 1) v += __shfl_xor(v, o);
    return v;
}
__device__ __forceinline__ int mbcnt64(u64 m) { return __builtin_amdgcn_mbcnt_hi((unsigned)(m >> 32), __builtin_amdgcn_mbcnt_lo((unsigned)m, 0)); }
__device__ __forceinline__ float gelu_exact(float v) { return 0.5f * v * (1.0f + erff(v * 0.70710678118654752f)); }
__device__ __forceinline__ float sigmoidf_(float v) { return 1.0f / (1.0f + __expf(-v)); }
__device__ __forceinline__ float log_sigmoid(float v) { return v >= 0.f ? -log1pf(expf(-v)) : v - log1pf(expf(v)); }
__device__ __forceinline__ int crow(int r, int hi) { return (r & 3) + 8 * (r >> 2) + 4 * hi; }
__device__ __forceinline__ f32x16 zero16() { f32x16 z;
#pragma unroll
    for (int i = 0; i < 16; ++i) z[i] = 0.f; return z; }

__device__ __forceinline__ void rms_write_h16(const float (&v)[16], const float* __restrict__ g, h16* __restrict__ dst, int lane) {
    float ss = 0.f;
#pragma unroll
    for (int i = 0; i < 16; ++i) ss += v[i] * v[i];
    ss = wave_sum(ss);
    const float rstd = rsqrtf(ss * (1.0f / 1024.0f) + 1e-6f);
#pragma unroll
    for (int hseg = 0; hseg < 2; ++hseg) {
        const int c0 = hseg * 512 + lane * 8;
        const f32x4 g0 = *(const f32x4*)(g + c0), g1 = *(const f32x4*)(g + c0 + 4);
        half8 o;
#pragma unroll
        for (int i = 0; i < 4; ++i) { o[i] = (h16)(v[hseg * 8 + i] * rstd * g0[i]); o[4 + i] = (h16)(v[hseg * 8 + 4 + i] * rstd * g1[i]); }
        *(half8*)(dst + c0) = o;
    }
}
__device__ __forceinline__ void load_row16(const float* __restrict__ src, float (&v)[16], int lane) {
#pragma unroll
    for (int hseg = 0; hseg < 2; ++hseg) {
        const int c0 = hseg * 512 + lane * 8;
        const f32x4 a = *(const f32x4*)(src + c0), b = *(const f32x4*)(src + c0 + 4);
#pragma unroll
        for (int i = 0; i < 4; ++i) { v[hseg * 8 + i] = a[i]; v[hseg * 8 + 4 + i] = b[i]; }
    }
}

__device__ __forceinline__ void load_row16(const h16* __restrict__ src, float (&v)[16], int lane) {
#pragma unroll
    for (int hseg = 0; hseg < 2; ++hseg) {
        const half8 a = *(const half8*)(src + hseg * 512 + lane * 8);
#pragma unroll
        for (int i = 0; i < 8; ++i) v[hseg * 8 + i] = (float)a[i];
    }
}

__device__ __forceinline__ int even_col_map(int n, int kind) {
    if (kind == 2) {
        if (n < 512) return 1024 + n;
        if (n < 640) return 2056 + 3 * 128 + (n - 512);
        return 2056 + 5 * 128 + (n - 640);
    }
    if (n < 1024) return n;
    if (n < 1536) return 1544 + (n - 1024);
    if (n < 1664) return 2056 + (n - 1536);
    if (n < 1792) return 2056 + 128 + (n - 1664);
    if (n < 1920) return 2056 + 256 + (n - 1792);
    if (n < 2048) return 2056 + 512 + (n - 1920);
    if (n < 2056) return 1536 + (n - 2048);
    if (n < 2080) return 2824 + (n - 2056);
    return -1;
}
__device__ __forceinline__ void transpose_tile(const float* __restrict__ src, int K, int N, h16* __restrict__ dst, int mapped, float* tileS, int tile) {
    const int tid = tidx_(), nkt = K / 64;
    const int k0 = (tile % nkt) * 64, n0 = (tile / nkt) * 64;
#pragma unroll
    for (int i = 0; i < 16; ++i) {
        const int e = tid + 256 * i, kk = e >> 6, nn = e & 63;
        const int sc = mapped ? even_col_map(n0 + nn, mapped) : (n0 + nn);
        tileS[kk * 65 + nn] = (sc >= 0) ? src[(size_t)(k0 + kk) * N + sc] : 0.f;
    }
    hsync();
    const int n = tid >> 2, ks = (tid & 3) * 16;
    half8 o0, o1;
#pragma unroll
    for (int i = 0; i < 8; ++i) { o0[i] = (h16)tileS[(ks + i) * 65 + n]; o1[i] = (h16)tileS[(ks + 8 + i) * 65 + n]; }
    h16* d = dst + (size_t)(n0 + n) * K + k0 + ks;
    *(half8*)d = o0; *(half8*)(d + 8) = o1;
    hsync();
}
__device__ __forceinline__ void transpose_job(const float* __restrict__ src, int K, int N, h16* __restrict__ dst, int Ndst, int mapped, float* tileS, int& base, int b0) {
    const int tid = tidx_(), nb = (int)GRIDV - b0, bid = bidx_() - b0;
    const int nkt = K / 64, nnt = Ndst / 64, ntiles = nkt * nnt;
    int first = (bid - (base % nb) + nb) % nb;
    for (int tile = first; tile < ntiles; tile += nb) transpose_tile(src, K, N, dst, mapped, tileS, tile);
    base += ntiles;
}
__device__ __forceinline__ void convert_job(const float* __restrict__ src, h16* __restrict__ dst, size_t n) {
    const size_t n4 = n / 4, stride = (size_t)GRIDV * NTHR;
    for (size_t i = (size_t)bidx_() * NTHR + tidx_(); i < n4; i += stride) {
        const f32x4 v = *(const f32x4*)(src + 4 * i);
        half4 o; o[0] = (h16)v[0]; o[1] = (h16)v[1]; o[2] = (h16)v[2]; o[3] = (h16)v[3];
        *(half4*)(dst + 4 * i) = o;
    }
}
constexpr int ROW6 = 768;
template <int NP>
__device__ __forceinline__ void fp6_rows(const float* __restrict__ src, unsigned char* __restrict__ dst, float* __restrict__ scl, const int (&rps)[NP], int lane) {
    const int hh = lane >> 5, g = lane & 31;
    f32x4 v[NP][8];
#pragma unroll
    for (int q = 0; q < NP; ++q)
#pragma unroll
        for (int c = 0; c < 8; ++c) v[q][c] = *(const f32x4*)(src + (size_t)(rps[q] * 2 + hh) * 1024 + c * 128 + g * 4);
#pragma unroll
    for (int q = 0; q < NP; ++q) {
        float am = 0.f;
#pragma unroll
        for (int c = 0; c < 8; ++c) am = fmaxf(am, fmaxf(fmaxf(fabsf(v[q][c][0]), fabsf(v[q][c][1])), fmaxf(fabsf(v[q][c][2]), fabsf(v[q][c][3]))));
#pragma unroll
        for (int o = 16; o > 0; o >>= 1) am = fmaxf(am, __shfl_xor(am, o));
        const float sc = am > 0.f ? am * (1.0f / 7.5f) : 1.0f, inv = 1.0f / sc;
        h16x32 hv;
#pragma unroll
        for (int c = 0; c < 8; ++c)
#pragma unroll
            for (int j = 0; j < 4; ++j) hv[4 * c + j] = (h16)(v[q][c][j] * inv);
        const u32x6 pk = __builtin_amdgcn_cvt_scalef32_pk32_fp6_f16(hv, 1.0f);
        unsigned char* o = dst + (size_t)(rps[q] * 2 + hh) * ROW6;
        *(i32x4*)(o + g * 16) = (i32x4){(int)pk[0], (int)pk[1], (int)pk[2], (int)pk[3]};
        *(i32x2*)(o + 512 + g * 8) = (i32x2){(int)pk[4], (int)pk[5]};
        if (g == 0) scl[rps[q] * 2 + hh] = sc;
    }
}
__device__ __forceinline__ void fp6_rows_job(const float* __restrict__ src, unsigned char* __restrict__ dst, float* __restrict__ scl, int npairs, int wv0) {
    const int lane = tidx_() & 63, wv = bidx_() * 4 + widx_() - wv0, nwv = GRIDV * 4 - wv0;
    if (wv < 0) return;
    int r = wv;
    for (; r + nwv < npairs; r += 2 * nwv) { const int rps[2] = {r, r + nwv}; fp6_rows<2>(src, dst, scl, rps, lane); }
    for (; r < npairs; r += nwv) { const int rps[1] = {r}; fp6_rows<1>(src, dst, scl, rps, lane); }
}
__device__ __forceinline__ void weight_jobs(PRef p, char* smem, bool first_only, int b0) {
    float* tileS = (float*)smem;
    int base = 0;
    const int jlo = 0, jhi = 28;
    for (int job = jlo; job < jhi; ++job) {
        if (first_only != (job == 0 || job == 4 || job == 6 || job == 7)) continue;
        const float* src; int K, N, Nd; h16* dst; int mapped = 0;
        if (job == 0) { src = p.even_w_in; K = 1024; N = EVEN_IN; dst = p.WtE; Nd = ZLD; mapped = 1; }
        else if (job == 1) { src = p.even_w_out; K = 1024; N = 1024; dst = p.WtEo; Nd = 1024; }
        else if (job == 2) { src = p.odd_w_in; K = 1024; N = 2560; dst = p.WtO; Nd = 2560; }
        else if (job == 3) { src = p.odd_w_out; K = 1280; N = 1024; dst = p.WtOo; Nd = 1024; }
        else if (job == 4) { src = p.even_w_in; K = 1024; N = EVEN_IN; dst = p.WtV; Nd = 768; mapped = 2; }
        else if (job == 5) continue;
        else if (job == 6) { src = p.even_w_cmp_k; K = 2048; N = 64; dst = p.Wc; Nd = 64; }
        else if (job == 7) { src = p.even_w_cmp_v; K = 2048; N = 64; dst = p.Wc + 64 * 2048; Nd = 64; }
        else if (job < 18) { const int n = job - 8; src = p.odd_w_ra + n * 16384; K = 128; N = 128; dst = p.Wr + n * 16384; Nd = 128; }
        else { const int n = job - 18; src = p.odd_w_ri + n * 16384; K = 128; N = 128; dst = p.Wr + (10 + n) * 16384; Nd = 128; }
        transpose_job(src, K, N, dst, Nd, mapped, tileS, base, b0);
    }
}
__device__ __forceinline__ void deferred_transpose_tile(PRef p, float* tileS, int t) {
    const float* src; int K, N; h16* dst;
    if (t < 256) { src = p.even_w_out; K = 1024; N = 1024; dst = p.WtEo; }
    else if (t < 896) { t -= 256; src = p.odd_w_in; K = 1024; N = 2560; dst = p.WtO; }
    else if (t < 1216) { t -= 896; src = p.odd_w_out; K = 1280; N = 1024; dst = p.WtOo; }
    else { t -= 1216; const int n = t >> 2; t &= 3; src = (n < 10 ? p.odd_w_ra + n * 16384 : p.odd_w_ri + (n - 10) * 16384); K = 128; N = 128; dst = p.Wr + n * 16384; }
    transpose_tile(src, K, N, dst, 0, tileS, t);
}
__device__ __forceinline__ void deferred_transpose_item(PRef p, float* tileS, int t0) {
    const int tid = tidx_();
    float v[4][16]; const float* srcs[4]; h16* dsts[4]; int Ks[4], k0s[4], n0s[4];
#pragma unroll
    for (int q = 0; q < 4; ++q) {
        int t = t0 + q; const float* src; int K, N; h16* dst;
        if (t < 256) { src = p.even_w_out; K = 1024; N = 1024; dst = p.WtEo; }
        else if (t < 896) { t -= 256; src = p.odd_w_in; K = 1024; N = 2560; dst = p.WtO; }
        else if (t < 1216) { t -= 896; src = p.odd_w_out; K = 1280; N = 1024; dst = p.WtOo; }
        else { t -= 1216; const int n = t >> 2; t &= 3; src = (n < 10 ? p.odd_w_ra + n * 16384 : p.odd_w_ri + (n - 10) * 16384); K = 128; N = 128; dst = p.Wr + n * 16384; }
        const int nkt = K / 64, k0 = (t % nkt) * 64, n0 = (t / nkt) * 64;
        dsts[q] = dst; Ks[q] = K; k0s[q] = k0; n0s[q] = n0;
#pragma unroll
        for (int i = 0; i < 16; ++i) { const int e = tid + 256 * i, kk = e >> 6, nn = e & 63; v[q][i] = src[(size_t)(k0 + kk) * N + n0 + nn]; }
    }
#pragma unroll
    for (int q = 0; q < 4; ++q) {
#pragma unroll
        for (int i = 0; i < 16; ++i) { const int e = tid + 256 * i, kk = e >> 6, nn = e & 63; tileS[kk * 65 + nn] = v[q][i]; }
        hsync();
        const int n = tid >> 2, ks = (tid & 3) * 16;
        half8 o0, o1;
#pragma unroll
        for (int i = 0; i < 8; ++i) { o0[i] = (h16)tileS[(ks + i) * 65 + n]; o1[i] = (h16)tileS[(ks + 8 + i) * 65 + n]; }
        h16* d = dsts[q] + (size_t)(n0s[q] + n) * Ks[q] + k0s[q] + ks;
        *(half8*)d = o0; *(half8*)(d + 8) = o1;
        hsync();
    }
}
__device__ __forceinline__ void phase_prep(PRef p, char* smem) {
    weight_jobs(p, smem, true, 0);
    convert_job(p.peer_sub_keys, p.Keys, (size_t)2 * 8 * 2 * 128 * 128);
    convert_job(p.even_cmp_pos, p.Pos16, 2048);
    const int lane = tidx_() & 63, wv = bidx_() * 4 + widx_(), nwv = GRIDV * 4;
    for (int row = wv; row < TOK; row += nwv) {
        float v[16]; load_row16(p.x + (size_t)row * DM, v, lane);
        rms_write_h16(v, p.even_norm_g, p.HN + (size_t)row * DM, lane);
    }
}

enum { EPI_EVEN_IN = 0, EPI_F32_RESID = 1, EPI_H16 = 2, EPI_F32T = 3, EPI_QSCORE = 4 };
struct GemmArgs {
    const h16* A; int lda; const h16* Bt; int ldb; int M, N, K; int a_ntile_stride;
    int mode; h16* c16; int ldc16; float* c32; int ldc32; const float* resid; const h16* aux;
};
template <int MODE, int LDC>
__device__ __forceinline__ void gemm_epilogue(PRef p, const GemmArgs& g, int mt, int nt, bool sw, const f32x4 (&acc)[4][4]) {
    const int lane = tidx_() & 63, wid = widx_(), wm = wid >> 1, wn = wid & 1;
    const int l4 = (lane >> 4) * 4, l15 = lane & 15;
    if (MODE == EPI_EVEN_IN) {
        int kind;
        if (nt < 4 || (nt >= 12 && nt < 16)) kind = 0; else if (nt >= 8 && nt < 12) kind = 2; else if (nt == 19) kind = 3; else if (nt == 21) kind = 4; else if (nt == 22) kind = 5; else kind = 1;
#pragma unroll
        for (int i = 0; i < 4; ++i)
#pragma unroll
            for (int j = 0; j < 4; ++j) {
                const f32x4 v = acc[i][j];
                if (kind <= 1) {
                    const int row = mt * 128 + wm * 64 + j * 16 + l15, col = nt * 128 + wn * 64 + i * 16 + l4;
                    const float sc = kind == 0 ? QSCALE : 1.0f;
                    half4 o; o[0] = (h16)(v[0] * sc); o[1] = (h16)(v[1] * sc); o[2] = (h16)(v[2] * sc); o[3] = (h16)(v[3] * sc);
                    *(half4*)(p.Z + (size_t)row * ZLD + col) = o;
                } else if (kind <= 4) {
                    const int row = mt * 128 + wm * 64 + i * 16 + l4, col = nt * 128 + wn * 64 + j * 16 + l15;
                    const int b = row >> 12, s = row & 4095;
                    half4 o; o[0] = (h16)v[0]; o[1] = (h16)v[1]; o[2] = (h16)v[2]; o[3] = (h16)v[3];
                    h16* dst;
                    if (kind == 2) { const int c = col - 1024; dst = p.VtF + ((size_t)(b * 8 + (c >> 6)) * 64 + (c & 63)) * SEQ + s; }
                    else if (kind == 3) { const int c = col - 2432; dst = p.VtS + ((size_t)(b * 2 + (c >> 6)) * 64 + (c & 63)) * SEQ + s; }
                    else { const int c = col - 2688; dst = p.VtW + ((size_t)(b * 2 + (c >> 6)) * 64 + (c & 63)) * SEQ + s; }
                    *(half4*)dst = o;
                } else {
                    const int row = mt * 128 + wm * 64 + j * 16 + l15, c = nt * 128 + wn * 64 + i * 16 + l4 - 2816;
                    if (c < 32) {
                        f32x4 o;
                        if (c < 8) {
#pragma unroll
                            for (int q = 0; q < 4; ++q) o[q] = log_sigmoid(v[q] + p.even_b_f[c + q]) * LOG2E;
                        } else {
#pragma unroll
                            for (int q = 0; q < 4; ++q) o[q] = sigmoidf_(v[q]);
                        }
                        *(f32x4*)(p.FG + (size_t)row * 32 + c) = o;
                    }
                }
            }
    } else {
#pragma unroll
        for (int i = 0; i < 4; ++i)
#pragma unroll
            for (int j = 0; j < 4; ++j) {
                const f32x4 v = acc[i][j];
                if (MODE == EPI_F32T) {
                    const int row = mt * 128 + wm * 64 + i * 16 + l4, col = nt * 128 + wn * 64 + j * 16 + l15;
                    *(f32x4*)(g.c32 + (size_t)col * TOK + row) = v;
                } else {
                    const int row = mt * 128 + wm * 64 + j * 16 + l15, col = nt * 128 + wn * 64 + i * 16 + l4;
                    if (MODE == EPI_F32_RESID) {
                        const f32x4 r = *(const f32x4*)(g.resid + (size_t)row * LDC + col);
                        *(f32x4*)(g.c32 + (size_t)row * LDC + col) = r + v;
                    } else {
                        half4 o; o[0] = (h16)v[0]; o[1] = (h16)v[1]; o[2] = (h16)v[2]; o[3] = (h16)v[3];
                        *(half4*)(g.c16 + (size_t)row * LDC + col) = o;
                    }
                }
            }
    }
}

template <int MODE, int LDA, int LDB, int GN, int GK, int LDC, int ANS>
__device__ __forceinline__ void phase_gemm(PRef p, const GemmArgs& g, char* smem) {
    h16* As = (h16*)smem;
    h16* Bs = As + 2 * 128 * 64;
    const int tid = tidx_(), lane = tid & 63, wid = widx_(), wm = wid >> 1, wn = wid & 1;
    constexpr int nM = TOK / 128, nN = GN / 128, ntiles = nM * nN, nk = GK / 64;
    const int lr = tid >> 3, lc = tid & 7;
    const int st_off = lr * 64 + ((lc ^ ((tid >> 4) & 7)) * 8);
    const int fsw = (lane & 15) >> 1;
    const int fo0 = (lane & 15) * 64 + ((((lane >> 4)) ^ fsw) * 8), fo1 = (lane & 15) * 64 + (((4 + (lane >> 4)) ^ fsw) * 8);
    for (int tile = bidx_(); tile < ntiles; tile += GRIDV) {
        const int mt = tile / nN, nt = tile % nN;
        bool sw = (MODE != EPI_F32T);
        if (MODE == EPI_EVEN_IN) sw = !((nt >= 8 && nt < 12) || nt == 19 || nt == 21);
        const h16* Ag = g.A + (size_t)(mt * 128 + lr) * LDA + (size_t)nt * ANS + lc * 8;
        const h16* Bg = g.Bt + (size_t)(nt * 128 + lr) * LDB + lc * 8;
        constexpr size_t a32 = (size_t)32 * LDA, b32 = (size_t)32 * LDB;
        f32x4 acc[4][4];
#pragma unroll
        for (int m = 0; m < 4; ++m)
#pragma unroll
            for (int n = 0; n < 4; ++n) acc[m][n] = (f32x4){0.f, 0.f, 0.f, 0.f};
        half8 ra[4], rb[4];
#pragma unroll
        for (int i = 0; i < 4; ++i) { ra[i] = *(const half8*)(Ag + i * a32); rb[i] = *(const half8*)(Bg + i * b32); }
#pragma unroll
        for (int i = 0; i < 4; ++i) { *(half8*)(As + st_off + i * 32 * 64) = ra[i]; *(half8*)(Bs + st_off + i * 32 * 64) = rb[i]; }
        hsync();
        const int pofs = (sw ? wn : wm) * 64 * 64, qofs = (sw ? wm : wn) * 64 * 64;
        for (int kt = 0; kt < nk; ++kt) {
            const int cur = kt & 1;
            if (kt + 1 < nk) {
                const int ko = (kt + 1) * 64;
#pragma unroll
                for (int i = 0; i < 4; ++i) { ra[i] = *(const half8*)(Ag + i * a32 + ko); rb[i] = *(const half8*)(Bg + i * b32 + ko); }
            }
            const h16* Pc = (sw ? Bs : As) + cur * 128 * 64 + pofs;
            const h16* Qc = (sw ? As : Bs) + cur * 128 * 64 + qofs;
#pragma unroll
            for (int ks = 0; ks < 2; ++ks) {
                const int fo = ks ? fo1 : fo0;
                half8 pf[4], qf[4];
#pragma unroll
                for (int i = 0; i < 4; ++i) { pf[i] = *(const half8*)(Pc + i * 16 * 64 + fo); qf[i] = *(const half8*)(Qc + i * 16 * 64 + fo); }
                __builtin_amdgcn_s_setprio(1);
#pragma unroll
                for (int i = 0; i < 4; ++i)
#pragma unroll
                    for (int j = 0; j < 4; ++j) acc[i][j] = __builtin_amdgcn_mfma_f32_16x16x32_f16(pf[i], qf[j], acc[i][j], 0, 0, 0);
                __builtin_amdgcn_s_setprio(0);
            }
            if (kt + 1 < nk) {
                const int nx = (cur ^ 1) * 128 * 64;
#pragma unroll
                for (int i = 0; i < 4; ++i) { *(half8*)(As + nx + st_off + i * 32 * 64) = ra[i]; *(half8*)(Bs + nx + st_off + i * 32 * 64) = rb[i]; }
            }
            hsync();
        }
        if (MODE == EPI_QSCORE) {
            constexpr int QST = 136;
            h16* Qs = (h16*)smem;
            const int l4 = (lane >> 4) * 4, l15 = lane & 15;
#pragma unroll
            for (int i = 0; i < 4; ++i)
#pragma unroll
                for (int j = 0; j < 4; ++j) {
                    const f32x4 v = acc[i][j];
                    half4 o; o[0] = (h16)v[0]; o[1] = (h16)v[1]; o[2] = (h16)v[2]; o[3] = (h16)v[3];
                    *(half4*)(Qs + (wm * 64 + j * 16 + l15) * QST + wn * 64 + i * 16 + l4) = o;
                }
            hsync();
            f32x4 sc[4][4];
#pragma unroll
            for (int i = 0; i < 4; ++i)
#pragma unroll
                for (int j = 0; j < 4; ++j) sc[i][j] = (f32x4){0.f, 0.f, 0.f, 0.f};
            const h16* kb = g.aux + (size_t)(nt * 128 + wn * 64 + l15) * 128 + (lane >> 4) * 8;
#pragma unroll
            for (int ks = 0; ks < 4; ++ks) {
                half8 pf[4], qf[4];
#pragma unroll
                for (int i = 0; i < 4; ++i) { pf[i] = *(const half8*)(Qs + (wm * 64 + i * 16 + l15) * QST + ks * 32 + (lane >> 4) * 8); qf[i] = *(const half8*)(kb + (size_t)i * 16 * 128 + ks * 32); }
#pragma unroll
                for (int i = 0; i < 4; ++i)
#pragma unroll
                    for (int j = 0; j < 4; ++j) sc[i][j] = __builtin_amdgcn_mfma_f32_16x16x32_f16(pf[i], qf[j], sc[i][j], 0, 0, 0);
            }
#pragma unroll
            for (int i = 0; i < 4; ++i)
#pragma unroll
                for (int j = 0; j < 4; ++j) {
                    const int row = mt * 128 + wm * 64 + i * 16 + l4, col = nt * 128 + wn * 64 + j * 16 + l15;
                    *(f32x4*)(g.c32 + (size_t)col * TOK + row) = sc[i][j];
                }
            hsync();
        } else
        gemm_epilogue<MODE, LDC>(p, g, mt, nt, sw, acc);
    }
}

__device__ __forceinline__ void wp_unit(PRef p, int u) {
    const int lane = tidx_() & 63;
    {
        const int l = u >> 9, hc = (u >> 5) & 15, kh = (u >> 4) & 1, jt = u & 15;
        const float* wq = p.peer_w_q + (size_t)l * 1024 * 2048 + (size_t)(jt * 64 + (lane & 15)) * 2048 + hc * 128 + (lane >> 4) * 8;
        const h16* ky = p.Keys + ((size_t)(l * 16 + hc) * 128 + kh * 64 + (lane & 15)) * 128 + (lane >> 4) * 8;
        f32x4 acc[4][4];
#pragma unroll
        for (int a = 0; a < 4; ++a)
#pragma unroll
            for (int b = 0; b < 4; ++b) acc[a][b] = (f32x4){0.f, 0.f, 0.f, 0.f};
        f32x4 wv[4][4][2];
#pragma unroll
        for (int ks = 0; ks < 4; ++ks)
#pragma unroll
            for (int a = 0; a < 4; ++a) { wv[ks][a][0] = *(const f32x4*)(wq + (size_t)a * 16 * 2048 + ks * 32); wv[ks][a][1] = *(const f32x4*)(wq + (size_t)a * 16 * 2048 + ks * 32 + 4); }
#pragma unroll
        for (int ks = 0; ks < 4; ++ks) {
            half8 af[4], bf[4];
#pragma unroll
            for (int a = 0; a < 4; ++a) {
#pragma unroll
                for (int q = 0; q < 4; ++q) { af[a][q] = (h16)wv[ks][a][0][q]; af[a][4 + q] = (h16)wv[ks][a][1][q]; }
                bf[a] = *(const half8*)(ky + (size_t)a * 16 * 128 + ks * 32);
            }
#pragma unroll
            for (int a = 0; a < 4; ++a)
#pragma unroll
                for (int b = 0; b < 4; ++b) acc[a][b] = __builtin_amdgcn_mfma_f32_16x16x32_f16(af[a], bf[b], acc[a][b], 0, 0, 0);
        }
        h16* wp = p.WtQ + (size_t)l * 2048 * 1024;
#pragma unroll
        for (int a = 0; a < 4; ++a)
#pragma unroll
            for (int b = 0; b < 4; ++b) {
                const int n = hc * 128 + kh * 64 + b * 16 + (lane & 15), j0 = jt * 64 + a * 16 + (lane >> 4) * 4;
                const f32x4 gq = *(const f32x4*)(p.ffn_norm_g + l * DM + j0);
                half4 o; o[0] = (h16)(acc[a][b][0] * gq[0]); o[1] = (h16)(acc[a][b][1] * gq[1]); o[2] = (h16)(acc[a][b][2] * gq[2]); o[3] = (h16)(acc[a][b][3] * gq[3]);
                *(half4*)(wp + (size_t)n * 1024 + j0) = o;
            }
    }
}
__device__ __forceinline__ void phase_cumsum_compress(PRef p, char* smem) {
    const int lane = tidx_() & 63, wid = widx_(), vb = bidx_();
    if (vb >= 256 && vb < 264) {
        const int u = (vb - 256) * 4 + wid, b = u >> 3, h = u & 7;
        const float* src = p.FG + (size_t)(b * SEQ + lane * 64) * 32 + h;
        float loc[64]; float run = 0.f;
#pragma unroll
        for (int i = 0; i < 64; ++i) { run += src[(size_t)i * 32]; loc[i] = run; }
        float incl = run;
#pragma unroll
        for (int o = 1; o < 64; o <<= 1) { const float t = __shfl_up(incl, o); if (lane >= o) incl += t; }
        const float excl = incl - run;
        float* dst = p.C2 + (size_t)(b * 8 + h) * SEQ + lane * 64;
#pragma unroll
        for (int i = 0; i < 64; ++i) dst[i] = excl + loc[i];
    }
    if (vb < 256) {
        const int cu = vb, kv = cu >> 7, bg = (cu >> 4) & 7, nt = cu & 15;
        const int b = bg >> 1, g = bg & 1;
        int n = nt * 16 + (lane & 15); const int nc = n < 255 ? n : 254;
        const h16* Ab = p.Z + (size_t)(b * SEQ + 16 * nc) * ZLD + 1536 + kv * 128 + g * 64 + (lane >> 4) * 8;
        const h16* Wb = p.Wc + (size_t)kv * 64 * 2048 + (size_t)(lane & 15) * 2048 + (lane >> 4) * 8;
        const h16* Pb = p.Pos16 + (lane >> 4) * 8;
        f32x4 acc[4];
#pragma unroll
        for (int e = 0; e < 4; ++e) acc[e] = (f32x4){0.f, 0.f, 0.f, 0.f};
#pragma unroll
        for (int k2 = 0; k2 < 16; ++k2) {
            const int ks = wid * 16 + k2, l = ks >> 1, d0 = (ks & 1) * 32;
            half8 a = *(const half8*)(Ab + (size_t)l * ZLD + d0);
            const half8 ps = *(const half8*)(Pb + ks * 32);
            a = a + ps;
#pragma unroll
            for (int e = 0; e < 4; ++e) {
                const half8 w = *(const half8*)(Wb + (size_t)e * 16 * 2048 + ks * 32);
                acc[e] = __builtin_amdgcn_mfma_f32_16x16x32_f16(a, w, acc[e], 0, 0, 0);
            }
        }
        f32x4* part = (f32x4*)smem;
#pragma unroll
        for (int e = 0; e < 4; ++e) part[(wid * 4 + e) * 64 + lane] = acc[e];
        hsync();
        {
            const int e = wid;
            const f32x4 s = (part[(0 * 4 + e) * 64 + lane] + part[(1 * 4 + e) * 64 + lane]) + (part[(2 * 4 + e) * 64 + lane] + part[(3 * 4 + e) * 64 + lane]);
            const int n0 = nt * 16 + (lane >> 4) * 4, ec = e * 16 + (lane & 15);
            if (kv == 0) {
#pragma unroll
                for (int j = 0; j < 4; ++j) p.KC[((size_t)bg * 256 + n0 + j) * 64 + ec] = (n0 + j < 255) ? (h16)s[j] : (h16)0.f;
            } else {
                half4 o;
#pragma unroll
                for (int j = 0; j < 4; ++j) o[j] = (n0 + j < 255) ? (h16)s[j] : (h16)0.f;
                *(half4*)(p.VCt + ((size_t)bg * 64 + ec) * 256 + n0) = o;
            }
        }
        hsync();
    }
}

struct RowState { float m, l; f32x16 o0, o1; };
__device__ __forceinline__ void rs_reset(RowState& s) { s.m = NEGBIG; s.l = 0.f; s.o0 = zero16(); s.o1 = zero16(); }

__device__ __forceinline__ void kv_load(const h16* kb, int kst, const h16* vb, int vst, half8 (&kr)[2], half8 (&vr)[2]) {
    const int tid = tidx_();
#pragma unroll
    for (int i = 0; i < 2; ++i) {
        const int c = tid + 256 * i, row = c >> 3, cc = (c & 7) * 8;
        kr[i] = *(const half8*)(kb + (size_t)row * kst + cc);
        vr[i] = *(const half8*)(vb + (size_t)row * vst + cc);
    }
}
__device__ __forceinline__ void kv_store(h16* Ks, h16* Vs, const half8 (&kr)[2], const half8 (&vr)[2]) {
    const int tid = tidx_();
#pragma unroll
    for (int i = 0; i < 2; ++i) {
        const int c = tid + 256 * i, row = c >> 3, cc = (c & 7) * 8;
        *(half8*)(Ks + row * KST + cc) = kr[i];
        *(half8*)(Vs + row * KST + cc) = vr[i];
    }
}
__device__ __forceinline__ void qk_tile(const h16* Ks, const half8 (&qf)[4], f32x16 (&s)[2], int lane) {
    const int r32 = lane & 31, hh = lane >> 5;
#pragma unroll
    for (int kt = 0; kt < 2; ++kt) {
        s[kt] = zero16();
#pragma unroll
        for (int ks = 0; ks < 4; ++ks) {
            const half8 kf = *(const half8*)(Ks + (kt * 32 + r32) * KST + ks * 16 + hh * 8);
            s[kt] = __builtin_amdgcn_mfma_f32_32x32x16_f16(kf, qf[ks], s[kt], 0, 0, 0);
        }
    }
}
__device__ __forceinline__ void pv_tile(const h16* Vs, const f32x16 (&pr)[2], f32x16& o0, f32x16& o1, int lane) {
    const int r32 = lane & 31, hh = lane >> 5;
#pragma unroll
    for (int kt = 0; kt < 2; ++kt)
#pragma unroll
        for (int s2 = 0; s2 < 2; ++s2) {
            half8 pf;
#pragma unroll
            for (int j = 0; j < 8; ++j) pf[j] = (h16)pr[kt][8 * s2 + j];
            const int kof = kt * 32 + 16 * s2 + 4 * hh;
            {
                const half4 a = *(const half4*)(Vs + r32 * KST + kof), b = *(const half4*)(Vs + r32 * KST + kof + 8);
                half8 vf; vf[0] = a[0]; vf[1] = a[1]; vf[2] = a[2]; vf[3] = a[3]; vf[4] = b[0]; vf[5] = b[1]; vf[6] = b[2]; vf[7] = b[3];
                o0 = __builtin_amdgcn_mfma_f32_32x32x16_f16(vf, pf, o0, 0, 0, 0);
            }
            {
                const half4 a = *(const half4*)(Vs + (32 + r32) * KST + kof), b = *(const half4*)(Vs + (32 + r32) * KST + kof + 8);
                half8 vf; vf[0] = a[0]; vf[1] = a[1]; vf[2] = a[2]; vf[3] = a[3]; vf[4] = b[0]; vf[5] = b[1]; vf[6] = b[2]; vf[7] = b[3];
                o1 = __builtin_amdgcn_mfma_f32_32x32x16_f16(vf, pf, o1, 0, 0, 0);
            }
        }
}

enum { M_FOX = 0, M_SLC = 1, M_WIN = 2 };
template <int MODE, bool MASKED>
__device__ __forceinline__ void flash_step(const h16* Ks, const h16* Vs, const float* csS, const half8 (&qf)[4], RowState& st,
                                           int t, int kpos0, float slope2, float ct2, bool selbit, int lane) {
    const int hh = lane >> 5;
    f32x16 s[2];
    qk_tile(Ks, qf, s, lane);
    int dbase = t - kpos0 - 4 * hh;
    asm volatile("" : "+v"(dbase));
    const float off = (MODE == M_FOX) ? ct2 : -slope2 * (float)dbase;
    float mx = NEGBIG;
#pragma unroll
    for (int kt = 0; kt < 2; ++kt)
#pragma unroll
        for (int r = 0; r < 16; ++r) {
            const int c = kt * 32 + (r & 3) + 8 * (r >> 2);
            float v;
            if (MODE == M_FOX) v = s[kt][r] - csS[c + 4 * hh];
            else v = fmaf(slope2, (float)c, s[kt][r]);
            if (MASKED) {
                const int dist = dbase - c;
                bool valid;
                if (MODE == M_FOX) valid = dist >= 0; else if (MODE == M_SLC) valid = selbit && dist >= 0; else valid = dist >= 0 && dist < 512;
                v = valid ? v : NEGBIG;
            }
            s[kt][r] = v;
            mx = fmaxf(mx, v);
        }
    mx += off;
    mx = fmaxf(mx, __shfl_xor(mx, 32));
    const bool rowoff = (MODE == M_SLC) && !MASKED && !selbit;
    if (rowoff) mx = NEGBIG;
    const float mn = fmaxf(st.m, mx);
    const float alpha = __builtin_amdgcn_exp2f(st.m - mn);
    st.m = mn;
    const float moff = rowoff ? 1.0e30f : mn - off;
    float ps = 0.f;
#pragma unroll
    for (int kt = 0; kt < 2; ++kt)
#pragma unroll
        for (int r = 0; r < 16; ++r) {
            const float v = s[kt][r];
            float pe = __builtin_amdgcn_exp2f(v - moff);
            if (MASKED) pe = v > -1.0e29f ? pe : 0.f;
            s[kt][r] = pe; ps += pe;
        }
    st.l = st.l * alpha + ps;
#pragma unroll
    for (int r = 0; r < 16; ++r) { st.o0[r] *= alpha; st.o1[r] *= alpha; }
    pv_tile(Vs, s, st.o0, st.o1, lane);
}

template <int MODE>
__device__ __forceinline__ void run_flash(u64 mask, const h16* Kg, int kst, const h16* Vg, int vst, const float* csg, char* smem,
                                          const half8 (&qf)[4], RowState& st, int t, int twlo, int twhi, float slope2, float ct2, u64 sel, int lane) {
    h16* Kb = (h16*)smem; h16* Vb = Kb + 2 * 64 * KST; float* csb = (float*)(Vb + 2 * 64 * KST);
    if (mask == 0ull) return;
    half8 kr[2], vr[2]; float csr = 0.f;
    int jc = __builtin_ctzll(mask); mask &= mask - 1;
    kv_load(Kg + (size_t)jc * 64 * kst, kst, Vg + jc * 64, vst, kr, vr);
    if (MODE == M_FOX && tidx_() < 64) csr = csg[jc * 64 + tidx_()];
    kv_store(Kb, Vb, kr, vr);
    if (MODE == M_FOX && tidx_() < 64) csb[tidx_()] = csr;
    hsync();
    int buf = 0;
    for (;;) {
        int jn = -1;
        if (mask) { jn = __builtin_ctzll(mask); mask &= mask - 1; }
        if (jn >= 0) {
            kv_load(Kg + (size_t)jn * 64 * kst, kst, Vg + jn * 64, vst, kr, vr);
            if (MODE == M_FOX && tidx_() < 64) csr = csg[jn * 64 + tidx_()];
        }
        bool need = jc * 64 <= twhi;
        if (MODE == M_WIN) need = need && (jc * 64 + 63 >= twlo - 511);
        if (need) {
            const bool selbit = (sel >> jc) & 1ull;
            bool full = jc * 64 + 63 <= twlo;
            if (MODE == M_WIN) full = full && (jc * 64 > twhi - 512);
            if (full) flash_step<MODE, false>(Kb + buf * 64 * KST, Vb + buf * 64 * KST, csb + buf * 64, qf, st, t, jc * 64, slope2, ct2, selbit, lane);
            else flash_step<MODE, true>(Kb + buf * 64 * KST, Vb + buf * 64 * KST, csb + buf * 64, qf, st, t, jc * 64, slope2, ct2, selbit, lane);
        }
        if (jn >= 0) {
            kv_store(Kb + (buf ^ 1) * 64 * KST, Vb + (buf ^ 1) * 64 * KST, kr, vr);
            if (MODE == M_FOX && tidx_() < 64) csb[(buf ^ 1) * 64 + tidx_()] = csr;
        }
        hsync();
        if (jn < 0) break;
        jc = jn; buf ^= 1;
    }
}

__device__ __forceinline__ void load_q(const h16* qrow, half8 (&qf)[4], int lane) {
#pragma unroll
    for (int ks = 0; ks < 4; ++ks) qf[ks] = *(const half8*)(qrow + ks * 16 + (lane >> 5) * 8);
}
__device__ __forceinline__ void store_o(h16* orow, const f32x16& o0, const f32x16& o1, int lane) {
    const int hh = lane >> 5;
#pragma unroll
    for (int rg = 0; rg < 4; ++rg) {
        half4 a, b;
#pragma unroll
        for (int j = 0; j < 4; ++j) { a[j] = (h16)o0[4 * rg + j]; b[j] = (h16)o1[4 * rg + j]; }
        *(half4*)(orow + 8 * rg + 4 * hh) = a;
        *(half4*)(orow + 32 + 8 * rg + 4 * hh) = b;
    }
}

__device__ __forceinline__ void oacc_store(float* row, const f32x16& o0, const f32x16& o1, float sc, int lane) {
    const int hh = lane >> 5;
#pragma unroll
    for (int rg = 0; rg < 4; ++rg) {
        *(f32x4*)(row + 8 * rg + 4 * hh) = (f32x4){o0[4 * rg] * sc, o0[4 * rg + 1] * sc, o0[4 * rg + 2] * sc, o0[4 * rg + 3] * sc};
        *(f32x4*)(row + 32 + 8 * rg + 4 * hh) = (f32x4){o1[4 * rg] * sc, o1[4 * rg + 1] * sc, o1[4 * rg + 2] * sc, o1[4 * rg + 3] * sc};
    }
}
__device__ __forceinline__ void oacc_add(float* row, const f32x16& o0, const f32x16& o1, float sc, int lane) {
    const int hh = lane >> 5;
#pragma unroll
    for (int rg = 0; rg < 4; ++rg) {
        f32x4 a = *(const f32x4*)(row + 8 * rg + 4 * hh), b = *(const f32x4*)(row + 32 + 8 * rg + 4 * hh);
#pragma unroll
        for (int j = 0; j < 4; ++j) { a[j] += o0[4 * rg + j] * sc; b[j] += o1[4 * rg + j] * sc; }
        *(f32x4*)(row + 8 * rg + 4 * hh) = a; *(f32x4*)(row + 32 + 8 * rg + 4 * hh) = b;
    }
}
__device__ __forceinline__ void oacc_final(const float* row, h16* orow, const f32x16& o0, const f32x16& o1, float sc, int lane) {
    const int hh = lane >> 5;
#pragma unroll
    for (int rg = 0; rg < 4; ++rg) {
        const f32x4 a = *(const f32x4*)(row + 8 * rg + 4 * hh), b = *(const f32x4*)(row + 32 + 8 * rg + 4 * hh);
        half4 x, y;
#pragma unroll
        for (int j = 0; j < 4; ++j) { x[j] = (h16)(a[j] + o0[4 * rg + j] * sc); y[j] = (h16)(b[j] + o1[4 * rg + j] * sc); }
        *(half4*)(orow + 8 * rg + 4 * hh) = x; *(half4*)(orow + 32 + 8 * rg + 4 * hh) = y;
    }
}

__device__ __forceinline__ void fox_unit(PRef p, int b, int h, int qt, char* smem) {
    const int tid = tidx_(), lane = tid & 63, wid = widx_();
    const int q0 = qt * 128, t0w = q0 + wid * 32, t = t0w + (lane & 31);
    half8 qf[4]; load_q(p.Z + (size_t)(b * SEQ + t) * ZLD + h * 64, qf, lane);
    const float* csg = p.C2 + (size_t)(b * 8 + h) * SEQ;
    const float ct2 = csg[t];
    RowState st; rs_reset(st);
    const int jmax = (q0 + 127) >> 6;
    const u64 mask = (jmax >= 63) ? ~0ull : ((1ull << (jmax + 1)) - 1ull);
    run_flash<M_FOX>(mask, p.Z + (size_t)b * SEQ * ZLD + 512 + h * 64, ZLD, p.VtF + (size_t)(b * 8 + h) * 64 * SEQ, SEQ, csg, smem,
                     qf, st, t, t0w, t0w + 31, 0.f, ct2, 0ull, lane);
    const float lt = st.l + __shfl_xor(st.l, 32);
    const float inv = 1.0f / lt;
#pragma unroll
    for (int r = 0; r < 16; ++r) { st.o0[r] *= inv; st.o1[r] *= inv; }
    store_o(p.O + (size_t)(b * SEQ + t) * DM + h * 64, st.o0, st.o1, lane);
}

__device__ __forceinline__ void nsa_unit(PRef p, int b, int g, int qt32, char* smem) {
    const int tid = tidx_(), lane = tid & 63, wid = widx_(), hh = lane >> 5, r32 = lane & 31;
    const int t0 = qt32 * 32, t = t0 + r32, head = g * 4 + wid, bg = b * 2 + g;
    const float slope2 = exp2f(-(float)(head + 1)) * LOG2E;
    half8 qf[4]; load_q(p.Z + (size_t)(b * SEQ + t) * ZLD + 1024 + head * 64, qf, lane);
    const float* gp = p.FG + (size_t)(b * SEQ + t) * 32 + 8 + head * 3;
    const float gate_c = gp[0], gate_s = gp[1], gate_w = gp[2];
    h16* Kb = (h16*)smem; h16* Vb = Kb + 2 * 64 * KST;
    u64* selS = (u64*)(smem + 37376);
    u64* unS = selS + 32;
    float* oaccrow = p.OACC + (size_t)(b * SEQ + t) * 512 + head * 64;
    unsigned* impS = (unsigned*)(smem + 37888);
    {
        for (int i = tid; i < 32 * 64; i += NTHR) impS[i] = 0u;
        const int nsteps = ((t0 >> 4) >> 6) + 1;
        const h16* Kg = p.KC + (size_t)bg * 256 * 64; const h16* Vg = p.VCt + (size_t)bg * 64 * 256;
        float mrun = NEGBIG, lrun = 0.f;
        for (int i = 0; i < nsteps; ++i) {
            half8 kr[2], vr[2];
            kv_load(Kg + (size_t)i * 64 * 64, 64, Vg + i * 64, 256, kr, vr);
            kv_store(Kb, Vb, kr, vr);
            hsync();
            f32x16 s[2];
            qk_tile(Kb, qf, s, lane);
            float mx = NEGBIG;
            int dbase = t - 31 - 16 * (i * 64 + 4 * hh);
            asm volatile("" : "+v"(dbase));
#pragma unroll
            for (int kt = 0; kt < 2; ++kt)
#pragma unroll
                for (int r = 0; r < 16; ++r) {
                    const int dist = dbase - 16 * (kt * 32 + (r & 3) + 8 * (r >> 2));
                    float v = s[kt][r] - slope2 * (float)dist;
                    v = dist >= 0 ? v : NEGBIG;
                    s[kt][r] = v; mx = fmaxf(mx, v);
                }
            mx = fmaxf(mx, __shfl_xor(mx, 32));
            const float mn = fmaxf(mrun, mx), alpha = __builtin_amdgcn_exp2f(mrun - mn);
            mrun = mn;
            float ps = 0.f;
#pragma unroll
            for (int kt = 0; kt < 2; ++kt)
#pragma unroll
                for (int r = 0; r < 16; ++r) { const float v = s[kt][r]; ps += v > -1.0e29f ? __builtin_amdgcn_exp2f(v - mn) : 0.f; }
            lrun = lrun * alpha + ps;
            hsync();
        }
        const float lt = lrun + __shfl_xor(lrun, 32);
        const float inv = lt > 0.f ? 1.0f / lt : 0.f;
        f32x16 o0 = zero16(), o1 = zero16();
        float carry = 0.f;
        for (int i = 0; i < nsteps; ++i) {
            half8 kr[2], vr[2];
            kv_load(Kg + (size_t)i * 64 * 64, 64, Vg + i * 64, 256, kr, vr);
            kv_store(Kb, Vb, kr, vr);
            hsync();
            f32x16 s[2];
            qk_tile(Kb, qf, s, lane);
            int dbase = t - 31 - 16 * (i * 64 + 4 * hh);
            asm volatile("" : "+v"(dbase));
#pragma unroll
            for (int kt = 0; kt < 2; ++kt)
#pragma unroll
                for (int r = 0; r < 16; ++r) {
                    const int dist = dbase - 16 * (kt * 32 + (r & 3) + 8 * (r >> 2));
                    const float v = s[kt][r] - slope2 * (float)dist;
                    s[kt][r] = dist >= 0 ? __builtin_amdgcn_exp2f(v - mrun) * inv : 0.f;
                }
            float R[2][4];
#pragma unroll
            for (int kt = 0; kt < 2; ++kt)
#pragma unroll
                for (int rg = 0; rg < 4; ++rg) R[kt][rg] = __shfl_xor(s[kt][4 * rg + 3], 32);
#pragma unroll
            for (int kt = 0; kt < 2; ++kt)
#pragma unroll
                for (int rg = 0; rg < 4; ++rg) {
                    const float G = (s[kt][4 * rg] + s[kt][4 * rg + 1]) + (s[kt][4 * rg + 2] + s[kt][4 * rg + 3]);
                    const float prev = (kt == 0 && rg == 0) ? carry : (rg > 0 ? R[kt][rg - 1] : R[kt - 1][3]);
                    const float val = G + (hh ? R[kt][rg] : prev);
                    const int j = 16 * i + 8 * kt + 2 * rg + hh;
                    atomicAdd(&impS[r32 * 64 + j], (unsigned)(val * 67108864.0f + 0.5f));
                }
            carry = R[1][3];
            pv_tile(Vb, s, o0, o1, lane);
            hsync();
        }
        oacc_store(oaccrow, o0, o1, gate_c, lane);
    }
    hsync();
    {
        u64 un = 0ull;
        for (int i = 0; i < 8; ++i) {
            const int tok = wid * 8 + i, tt = t0 + tok, cur = tt >> 6;
            const int j = lane;
            const bool valid = j <= cur;
            const bool forced = (j == 0) || (j == cur) || (j == cur - 1);
            const unsigned key = valid ? impS[tok * 64 + j] + (forced ? 0x40000000u : 0u) : 0u;
            int rank = 0;
            for (int jj = 0; jj < 64; ++jj) {
                const unsigned kv = (unsigned)__builtin_amdgcn_readlane((int)key, jj);
                rank += (kv > key || (kv == key && jj < j)) ? 1 : 0;
            }
            const u64 selm = __ballot(valid && rank < 16);
            if (lane == 0) selS[tok] = selm;
            un |= selm;
        }
        if (lane == 0) unS[wid] = un;
    }
    hsync();
    const u64 mysel = selS[r32];
    const u64 un = unS[0] | unS[1] | unS[2] | unS[3];
    hsync();
    {
        RowState st; rs_reset(st);
        run_flash<M_SLC>(un, p.Z + (size_t)b * SEQ * ZLD + 1792 + g * 64, ZLD, p.VtS + (size_t)bg * 64 * SEQ, SEQ, nullptr, smem,
                         qf, st, t, t0, t0 + 31, slope2, 0.f, mysel, lane);
        const float lt = st.l + __shfl_xor(st.l, 32);
        oacc_add(oaccrow, st.o0, st.o1, gate_s / lt, lane);
    }
    {
        RowState st; rs_reset(st);
        const int lo = t0 - 511, jlo = lo > 0 ? (lo >> 6) : 0, jhi = (t0 + 31) >> 6;
        u64 mask = (jhi >= 63 ? ~0ull : ((1ull << (jhi + 1)) - 1ull)) & ~((1ull << jlo) - 1ull);
        run_flash<M_WIN>(mask, p.Z + (size_t)b * SEQ * ZLD + 1920 + g * 64, ZLD, p.VtW + (size_t)bg * 64 * SEQ, SEQ, nullptr, smem,
                         qf, st, t, t0, t0 + 31, slope2, 0.f, 0ull, lane);
        const float lt = st.l + __shfl_xor(st.l, 32);
        oacc_final(oaccrow, p.O + (size_t)(b * SEQ + t) * DM + 512 + head * 64, st.o0, st.o1, gate_w / lt, lane);
    }
}

__device__ __forceinline__ void phase_attention(PRef p, char* smem) {
    int* nxt = (int*)(smem + 65536 - 16);
    for (;;) {
        if (tidx_() == 0) *nxt = (int)__hip_atomic_fetch_add(p.BAR + XCD_BAR_WORDS_C, 1u, __ATOMIC_RELAXED, __HIP_MEMORY_SCOPE_AGENT);
        hsync();
        const int q = *nxt;
        hsync();
        if (q >= 2048 + 1604) break;
        int u = -1, e = -1;
        if (q < 3072) { if (q & 1) e = q >> 1; else u = q >> 1; }
        else if (q < 3140) e = 1536 + (q - 3072);
        else u = 1536 + (q - 3140);
        if (e >= 0) {
            if (e < 256) wp_unit(p, e * 4 + widx_());
            else if (e < 580) deferred_transpose_item(p, (float*)smem, (e - 256) * 4);
            else {
                const int c = e - 580, tbl = c >> 8, layer = tbl >> 1, rp0 = (c & 255) * 32 + widx_() * 8, lane = tidx_() & 63;
                const float* srcp = ((tbl & 1) ? p.peer_v : p.peer_u) + (size_t)layer * 16384 * 1024;
                unsigned char* dstp = ((tbl & 1) ? p.V8 : p.U8) + (size_t)layer * 16384 * 1024;
                float* sclp = ((tbl & 1) ? p.VS : p.US) + layer * 16384;
                for (int i = 0; i < 8; i += 2) { const int rps[2] = {rp0 + i, rp0 + i + 1}; fp6_rows<2>(srcp, dstp, sclp, rps, lane); }
            }
            continue;
        }
        const int st = 31 - (u >> 6), w = u & 63;
        if (w & 1) { const int idx = w >> 1; nsa_unit(p, (idx & 7) >> 1, idx & 1, st * 4 + (idx >> 3), smem); }
        else { const int idx = w >> 1; fox_unit(p, idx >> 3, idx & 7, st, smem); }
    }
}

__device__ __forceinline__ void phase_rmsnorm(PRef p, const float* g) {
    const int lane = tidx_() & 63, wv = bidx_() * 4 + widx_(), nwv = GRIDV * 4;
    for (int row = wv; row < TOK; row += nwv) {
        float v[16]; load_row16(p.H + (size_t)row * DM, v, lane);
        rms_write_h16(v, g, p.HN + (size_t)row * DM, lane);
    }
}

__device__ __forceinline__ unsigned fkey(float f) { const unsigned b = __float_as_uint(f); return b ^ ((b >> 31) ? 0xFFFFFFFFu : 0x80000000u); }
__device__ __forceinline__ float fkey_inv(unsigned k) { return __uint_as_float(k ^ ((k >> 31) ? 0x80000000u : 0xFFFFFFFFu)); }
__device__ __forceinline__ void ce_desc(unsigned& a, unsigned& b) { const unsigned hi = a > b ? a : b, lo = a > b ? b : a; a = hi; b = lo; }
__device__ __forceinline__ void sort16_desc(unsigned (&k)[16]) {
#pragma unroll
    for (int size = 2; size <= 16; size <<= 1)
#pragma unroll
        for (int stride = size >> 1; stride > 0; stride >>= 1)
#pragma unroll
            for (int i = 0; i < 16; ++i) {
                const int j = i ^ stride;
                if (j > i) { if ((i & size) == 0) ce_desc(k[i], k[j]); else ce_desc(k[j], k[i]); }
            }
}
__device__ __forceinline__ void merge16_desc(unsigned (&run)[16], const unsigned (&b)[16]) {
#pragma unroll
    for (int i = 0; i < 16; ++i) run[i] = run[i] > b[15 - i] ? run[i] : b[15 - i];
#pragma unroll
    for (int stride = 8; stride > 0; stride >>= 1)
#pragma unroll
        for (int i = 0; i < 16; ++i) { const int j = i ^ stride; if (j > i) ce_desc(run[i], run[j]); }
}
__device__ __forceinline__ void list_top16(const h16* __restrict__ base, unsigned (&run)[16]) {
    half8 cur0 = *(const half8*)base, cur1 = *(const half8*)(base + 512), nxt0 = cur0, nxt1 = cur1;
#pragma unroll 1
    for (int bt = 0; bt < 8; ++bt) {
        if (bt < 7) { nxt0 = *(const half8*)(base + (size_t)(2 * bt + 2) * 512); nxt1 = *(const half8*)(base + (size_t)(2 * bt + 3) * 512); }
        unsigned kb[16];
#pragma unroll
        for (int i = 0; i < 8; ++i) {
            kb[i] = (fkey((float)cur0[i]) & ~127u) | (unsigned)(127 - (bt * 16 + i));
            kb[8 + i] = (fkey((float)cur1[i]) & ~127u) | (unsigned)(127 - (bt * 16 + 8 + i));
        }
        sort16_desc(kb);
        if (bt == 0) {
#pragma unroll
            for (int i = 0; i < 16; ++i) run[i] = kb[i];
        } else merge16_desc(run, kb);
        cur0 = nxt0; cur1 = nxt1;
    }
}
__device__ __forceinline__ void phase_peer_topk(PRef p, char* smem) {
    const int tid = tidx_(), lane = tid & 63, wv = bidx_() * 4 + widx_(), nwv = GRIDV * 4;
    int* idS = (int*)smem; float* evS = (float*)smem + 16 * NTHR;
    for (int u = wv; u < 8 * (TOK / 64); u += nwv) {
        const int h = u >> 8, tk = (u & 255) * 64 + lane;
        const h16* b0 = p.SC + ((size_t)((tk >> 6) * 256 + h * 32) * 64 + lane) * 8;
        unsigned k0[16], k1[16];
        list_top16(b0, k0);
        list_top16(b0 + 16 * 512, k1);
        float v0[16], v1[16]; int i0[16], i1[16];
#pragma unroll
        for (int j = 0; j < 16; ++j) {
            v0[j] = fkey_inv(k0[j] & ~127u); i0[j] = 127 - (int)(k0[j] & 127u);
            v1[j] = fkey_inv(k1[j] & ~127u); i1[j] = 127 - (int)(k1[j] & 127u);
        }
        unsigned run[16];
        {
            unsigned kb[16]; int n = 0, nb = 0;
#pragma unroll
            for (int a = 0; a < 16; ++a)
#pragma unroll
                for (int b = 0; b < 16; ++b)
                    if ((a + 1) * (b + 1) <= 16) {
                        kb[n] = fkey(v0[a] + v1[b]); ++n;
                        if (n == 16) {
                            sort16_desc(kb);
                            if (nb == 0) {
#pragma unroll
                                for (int i = 0; i < 16; ++i) run[i] = kb[i];
                            } else merge16_desc(run, kb);
                            n = 0; ++nb;
                        }
                    }
#pragma unroll
            for (int i = 2; i < 16; ++i) kb[i] = 0u;
            sort16_desc(kb); merge16_desc(run, kb);
        }
        const unsigned tkey = run[15]; const float smax = fkey_inv(run[0]);
        int cnt = 0; float esum = 0.f;
#pragma unroll
        for (int j = 0; j < 16; ++j) { idS[j * NTHR + tid] = 0; evS[j * NTHR + tid] = 0.f; }
#pragma unroll
        for (int pass = 0; pass < 2; ++pass)
#pragma unroll
            for (int a = 0; a < 16; ++a)
#pragma unroll
                for (int b = 0; b < 16; ++b)
                    if ((a + 1) * (b + 1) <= 16) {
                        const float s = v0[a] + v1[b]; const unsigned ks = fkey(s);
                        const bool take = pass == 0 ? (ks > tkey) : (ks == tkey && cnt < 16);
                        if (take) {
                            const float e = __expf(s - smax);
                            idS[cnt * NTHR + tid] = i0[a] * 128 + i1[b]; evS[cnt * NTHR + tid] = e;
                            esum += e; ++cnt;
                        }
                    }
        const float rinv = 1.0f / esum;
        int* ip = p.IDS + (size_t)tk * 128 + h * 16; float* gp = p.GW + (size_t)tk * 128 + h * 16;
#pragma unroll
        for (int q = 0; q < 4; ++q) {
            *(i32x4*)(ip + 4 * q) = (i32x4){idS[(4 * q) * NTHR + tid], idS[(4 * q + 1) * NTHR + tid], idS[(4 * q + 2) * NTHR + tid], idS[(4 * q + 3) * NTHR + tid]};
            *(f32x4*)(gp + 4 * q) = (f32x4){evS[(4 * q) * NTHR + tid] * rinv, evS[(4 * q + 1) * NTHR + tid] * rinv, evS[(4 * q + 2) * NTHR + tid] * rinv, evS[(4 * q + 3) * NTHR + tid] * rinv};
        }
    }
}

struct Q6 { i32x4 a; i32x2 b; };
__device__ __forceinline__ Q6 ld6(const unsigned char* row, int g) { Q6 r; r.a = *(const i32x4*)(row + g * 16); r.b = *(const i32x2*)(row + 512 + g * 8); return r; }
__device__ __forceinline__ u32x6 mk6(const Q6 q) { u32x6 r; r[0] = q.a[0]; r[1] = q.a[1]; r[2] = q.a[2]; r[3] = q.a[3]; r[4] = q.b[0]; r[5] = q.b[1]; return r; }
__device__ __forceinline__ float dot32_fp6h(const h16x32 xv, const Q6 q) {
    const h16x32 uf = __builtin_amdgcn_cvt_scalef32_pk32_f16_fp6(mk6(q), 1.0f);
    float d0 = 0.f, d1 = 0.f;
#pragma unroll
    for (int m = 0; m < 16; m += 2) {
        d0 = __builtin_amdgcn_fdot2((half2v){uf[2 * m], uf[2 * m + 1]}, (half2v){xv[2 * m], xv[2 * m + 1]}, d0, false);
        d1 = __builtin_amdgcn_fdot2((half2v){uf[2 * m + 2], uf[2 * m + 3]}, (half2v){xv[2 * m + 2], xv[2 * m + 3]}, d1, false);
    }
    return d0 + d1;
}
__device__ __forceinline__ void axpy32_fp6(f32x2 (&acc)[16], float w, const Q6 q) {
    const f32x32 vf = __builtin_amdgcn_cvt_scalef32_pk32_f32_fp6(mk6(q), 1.0f);
    const f32x2 ww = {w, w};
#pragma unroll
    for (int m = 0; m < 16; ++m) acc[m] = __builtin_elementwise_fma(ww, (f32x2){vf[2 * m], vf[2 * m + 1]}, acc[m]);
}
constexpr int ET_SHIFT = 9, ET_N = 16384 >> ET_SHIFT;
__device__ __forceinline__ void phase_peer_experts(PRef p, int layer, const float* gnext, int mode, char* smem) {
    const int lane = tidx_() & 63, wid = widx_(), wv = bidx_() * 4 + wid, nwv = GRIDV * 4;
    const int hh = lane >> 5, g = lane & 31, dpl = (lane >> 2) & 7;
    const unsigned char* U = p.U8 + (size_t)layer * 16384 * 1024; const unsigned char* V = p.V8 + (size_t)layer * 16384 * 1024;
    const float* US = p.US + layer * 16384; const float* VS = p.VS + layer * 16384;
    const bool b4 = (lane & 16) != 0, b3 = (lane & 8) != 0, b2 = (lane & 4) != 0;
    int* sid = (int*)smem + wid * 512 + hh * 128;
    float* sgw = (float*)(sid + 256);
    for (int tb = wv * 2; tb < TOK; tb += nwv * 2) {
        const int tk = tb + hh;
        h16x32 xv;
        {
            half4 hx[8]; float ssx = 0.f;
#pragma unroll
            for (int c = 0; c < 8; ++c) {
                hx[c] = *(const half4*)(p.H + (size_t)tk * DM + c * 128 + g * 4);
                const float a0 = (float)hx[c][0], a1 = (float)hx[c][1], a2 = (float)hx[c][2], a3 = (float)hx[c][3];
                ssx += (a0 * a0 + a1 * a1) + (a2 * a2 + a3 * a3);
            }
#pragma unroll
            for (int o = 16; o > 0; o >>= 1) ssx += __shfl_xor(ssx, o);
            const float rstdx = rsqrtf(ssx * (1.0f / 1024.0f) + 1e-6f);
            const float* gx = p.ffn_norm_g + layer * DM + g * 4;
#pragma unroll
            for (int c = 0; c < 8; ++c) {
                const f32x4 ga = *(const f32x4*)(gx + c * 128);
#pragma unroll
                for (int j = 0; j < 4; ++j) xv[4 * c + j] = (h16)((float)hx[c][j] * rstdx * ga[j]);
            }
        }
        {
            int idv[4]; float gv[4];
#pragma unroll
            for (int s = 0; s < 4; ++s) { idv[s] = p.IDS[(size_t)tk * 128 + s * 32 + g]; gv[s] = p.GW[(size_t)tk * 128 + s * 32 + g]; }
            int cnt = 0;
            const unsigned below = (1u << g) - 1u;
            for (int e = 0; e < ET_N; ++e) {
#pragma unroll
                for (int s = 0; s < 4; ++s) {
                    const bool in = (idv[s] >> ET_SHIFT) == e;
                    const u64 m = __ballot(in);
                    const unsigned mh = hh ? (unsigned)(m >> 32) : (unsigned)m;
                    if (in) { const int pos = cnt + __popc(mh & below); sid[pos] = idv[s]; sgw[pos] = gv[s]; }
                    cnt += __popc(mh);
                }
            }
        }
        f32x2 acc[16];
#pragma unroll
        for (int i = 0; i < 16; ++i) acc[i] = (f32x2){0.f, 0.f};
        for (int bt = 0; bt < 16; ++bt) {
            const int mine = sid[bt * 8 + dpl]; const float gwm = sgw[bt * 8 + dpl];
            const float usm = US[mine], vsm = VS[mine];
            const i32x4 ida = *(const i32x4*)(sid + bt * 8), idb = *(const i32x4*)(sid + bt * 8 + 4);
            Q6 uq[8], vq[8];
#pragma unroll
            for (int k = 0; k < 8; ++k) {
                const unsigned off = (unsigned)(k < 4 ? ida[k & 3] : idb[k & 3]) * ROW6;
                uq[k] = ld6(U + off, g); vq[k] = ld6(V + off, g);
            }
            float d[8];
#pragma unroll
            for (int k = 0; k < 8; ++k) d[k] = dot32_fp6h(xv, uq[k]);
            float r4[4], r2[2], z;
#pragma unroll
            for (int i = 0; i < 4; ++i) { const float keep = b4 ? d[i + 4] : d[i], send = b4 ? d[i] : d[i + 4]; r4[i] = keep + __shfl_xor(send, 16); }
#pragma unroll
            for (int i = 0; i < 2; ++i) { const float keep = b3 ? r4[i + 2] : r4[i], send = b3 ? r4[i] : r4[i + 2]; r2[i] = keep + __shfl_xor(send, 8); }
            { const float keep = b2 ? r2[1] : r2[0], send = b2 ? r2[0] : r2[1]; z = keep + __shfl_xor(send, 4); }
            z += __shfl_xor(z, 2); z += __shfl_xor(z, 1);
            const float wm = gwm * gelu_exact(z * usm) * vsm;
#pragma unroll
            for (int k = 0; k < 8; ++k) {
                const float w0 = __builtin_bit_cast(float, __builtin_amdgcn_readlane(__builtin_bit_cast(int, wm), 4 * k));
                const float w1 = __builtin_bit_cast(float, __builtin_amdgcn_readlane(__builtin_bit_cast(int, wm), 32 + 4 * k));
                axpy32_fp6(acc, hh ? w1 : w0, vq[k]);
            }
        }
        float hv[32];
        {
            const h16* hr = p.H + (size_t)tk * DM + g * 4;
#pragma unroll
            for (int c = 0; c < 8; ++c) { const half4 t = *(const half4*)(hr + c * 128); hv[4 * c] = (float)t[0] + acc[2 * c][0]; hv[4 * c + 1] = (float)t[1] + acc[2 * c][1]; hv[4 * c + 2] = (float)t[2] + acc[2 * c + 1][0]; hv[4 * c + 3] = (float)t[3] + acc[2 * c + 1][1]; }
        }
        float ss = 0.f;
#pragma unroll
        for (int i = 0; i < 32; ++i) ss += hv[i] * hv[i];
#pragma unroll
        for (int o = 16; o > 0; o >>= 1) ss += __shfl_xor(ss, o);
        const float rstd = rsqrtf(ss * (1.0f / 1024.0f) + 1e-6f);
        const float* gr = gnext + g * 4;
        if (mode == 0) {
            h16* hw = p.H + (size_t)tk * DM + g * 4;
#pragma unroll
            for (int c = 0; c < 8; ++c) {
                { half4 t; t[0] = (h16)hv[4 * c]; t[1] = (h16)hv[4 * c + 1]; t[2] = (h16)hv[4 * c + 2]; t[3] = (h16)hv[4 * c + 3]; *(half4*)(hw + c * 128) = t; }
                const f32x4 ga = *(const f32x4*)(gr + c * 128);
                half4 o;
#pragma unroll
                for (int j = 0; j < 4; ++j) o[j] = (h16)(hv[4 * c + j] * rstd * ga[j]);
                *(half4*)(p.HN + (size_t)tk * DM + c * 128 + g * 4) = o;
            }
        } else {
            float* ow = p.out + (size_t)tk * DM + g * 4;
#pragma unroll
            for (int c = 0; c < 8; ++c) { const f32x4 ga = *(const f32x4*)(gr + c * 128); *(f32x4*)(ow + c * 128) = (f32x4){hv[4 * c] * rstd * ga[0], hv[4 * c + 1] * rstd * ga[1], hv[4 * c + 2] * rstd * ga[2], hv[4 * c + 3] * rstd * ga[3]}; }
        }
    }
}

constexpr int XST = 136;
__device__ __forceinline__ float fast_sigmoid(float v) { return __builtin_amdgcn_rcpf(1.0f + __expf(-v)); }
__device__ __forceinline__ float gelu_as(float v) {
    const float av = fabsf(v), t = __builtin_amdgcn_rcpf(av * 0.2316419f + 1.0f);
    float q = t * 0.5307027145f - 0.7265760135f; q = q * t + 0.7107068705f; q = q * t - 0.142248368f; q = q * t + 0.127414796f; q = q * t;
    const float e = __builtin_amdgcn_exp2f(v * v * -0.72134752044f);
    const float m = v * (q * e);
    return v < 0.f ? m : v - m;
}
__device__ __forceinline__ void phase_rnn_gates(PRef p, char* smem) {
    h16* xcS = (h16*)smem;
    float* aggS = (float*)(smem + 64 * XST * 2);
    h16* laS = (h16*)(smem + 64 * XST * 2 + 4096);
    h16* ruS = laS + 64 * XST;
    const int tid = tidx_(), lane = tid & 63, wid = widx_();
    for (int u = bidx_(); u < 4 * 64 * 10; u += GRIDV) {
        const int nb = u % 10, ck = (u / 10) & 63, b = u / 640;
        const int s0 = ck * 64, ch0 = nb * 128;
        {
            const int c8 = (tid & 15) * 8, tq = (tid >> 4) * 4, ch = ch0 + c8;
            float w[4][8], bias[8];
#pragma unroll
            for (int j = 0; j < 4; ++j) {
                const f32x4 w0 = *(const f32x4*)(p.odd_conv_w + j * DRNN + ch), w1 = *(const f32x4*)(p.odd_conv_w + j * DRNN + ch + 4);
#pragma unroll
                for (int i = 0; i < 4; ++i) { w[j][i] = w0[i]; w[j][4 + i] = w1[i]; }
            }
            { const f32x4 b0 = *(const f32x4*)(p.odd_conv_b + ch), b1 = *(const f32x4*)(p.odd_conv_b + ch + 4);
#pragma unroll
              for (int i = 0; i < 4; ++i) { bias[i] = b0[i]; bias[4 + i] = b1[i]; } }
            half8 xin[7];
#pragma unroll
            for (int r = 0; r < 7; ++r) {
                const int sp = s0 + tq - 3 + r;
                if (sp >= 0) xin[r] = *(const half8*)(p.Z2 + (size_t)(b * SEQ + sp) * Z2LD + DRNN + ch);
                else {
#pragma unroll
                    for (int i = 0; i < 8; ++i) xin[r][i] = (h16)0.f;
                }
            }
#pragma unroll
            for (int tt = 0; tt < 4; ++tt) {
                half8 o;
#pragma unroll
                for (int i = 0; i < 8; ++i) {
                    float a = bias[i];
#pragma unroll
                    for (int j = 0; j < 4; ++j) a = fmaf(w[j][i], (float)xin[tt + j][i], a);
                    o[i] = (h16)a;
                }
                *(half8*)(xcS + (tq + tt) * XST + c8) = o;
            }
        }
        hsync();
        float bra2[2], bri2[2], sp2[2];
#pragma unroll
        for (int e = 0; e < 2; ++e) {
            const int chq = ch0 + (wid * 2 + e) * 16 + (lane & 15);
            bra2[e] = p.odd_b_ra[chq]; bri2[e] = p.odd_b_ri[chq]; sp2[e] = p.odd_lam[chq];
        }
#pragma unroll
        for (int e = 0; e < 2; ++e) sp2[e] = fmaxf(-sp2[e], 0.f) + __logf(1.0f + __expf(-fabsf(sp2[e])));
        f32x4 ar[4][2], ai[4][2];
#pragma unroll
        for (int m = 0; m < 4; ++m)
#pragma unroll
            for (int e = 0; e < 2; ++e) { ar[m][e] = (f32x4){0.f, 0.f, 0.f, 0.f}; ai[m][e] = (f32x4){0.f, 0.f, 0.f, 0.f}; }
        const h16* wr = p.Wr + (size_t)nb * 16384 + (wid * 32 + (lane & 15)) * 128 + (lane >> 4) * 8;
        const h16* wi = p.Wr + (size_t)(10 + nb) * 16384 + (wid * 32 + (lane & 15)) * 128 + (lane >> 4) * 8;
#pragma unroll
        for (int ks = 0; ks < 4; ++ks) {
            half8 a[4];
#pragma unroll
            for (int m = 0; m < 4; ++m) a[m] = *(const half8*)(xcS + (m * 16 + (lane & 15)) * XST + ks * 32 + (lane >> 4) * 8);
#pragma unroll
            for (int e = 0; e < 2; ++e) {
                const half8 w1 = *(const half8*)(wr + e * 16 * 128 + ks * 32), w2 = *(const half8*)(wi + e * 16 * 128 + ks * 32);
#pragma unroll
                for (int m = 0; m < 4; ++m) {
                    ar[m][e] = __builtin_amdgcn_mfma_f32_16x16x32_f16(a[m], w1, ar[m][e], 0, 0, 0);
                    ai[m][e] = __builtin_amdgcn_mfma_f32_16x16x32_f16(a[m], w2, ai[m][e], 0, 0, 0);
                }
            }
        }
        const int g4 = lane >> 4;
#pragma unroll
        for (int e = 0; e < 2; ++e) {
            const int cl = (wid * 2 + e) * 16 + (lane & 15);
            const float bra = bra2[e], bri = bri2[e], sp = sp2[e];
            float Ac = 1.f, Hc = 0.f;
#pragma unroll
            for (int m = 0; m < 4; ++m) {
                float A = 1.f, H = 0.f;
#pragma unroll
                for (int j = 0; j < 4; ++j) {
                    const int tt = m * 16 + g4 * 4 + j;
                    const float r = fast_sigmoid(ar[m][e][j] + bra), ig = fast_sigmoid(ai[m][e][j] + bri);
                    const h16 la16 = (h16)(-8.0f * r * sp);
                    const float a = __expf((float)la16);
                    const float xc = (float)xcS[tt * XST + cl];
                    const h16 u16 = (h16)(__builtin_amdgcn_sqrtf(fmaxf(1.0f - a * a, 0.f)) * (ig * xc));
                    laS[tt * XST + cl] = la16; ruS[tt * XST + cl] = u16;
                    H = a * H + (float)u16; A *= a;
                }
                { const float Al = __shfl_xor(A, 16), Hl = __shfl_xor(H, 16); if (g4 & 1) { H = Hl * A + H; A = Al * A; } }
                { const float Al = __shfl_xor(A, 32), Hl = __shfl_xor(H, 32); if (g4 == 3) { H = Hl * A + H; A = Al * A; } }
                Hc = Hc * A + H; Ac *= A;
            }
            if (g4 == 3) { p.AggP[(size_t)(b * 64 + ck) * DRNN + ch0 + cl] = Ac; p.AggH[(size_t)(b * 64 + ck) * DRNN + ch0 + cl] = Hc; }
        }
        hsync();
#pragma unroll
        for (int i = 0; i < 4; ++i) {
            const int q = tid + 256 * i, row = q >> 4, c8 = (q & 15) * 8;
            const size_t o = (size_t)(b * SEQ + s0 + row) * DRNN + ch0 + c8;
            *(half8*)(p.LA + o) = *(const half8*)(laS + row * XST + c8);
            *(half8*)(p.RU + o) = *(const half8*)(ruS + row * XST + c8);
        }
    }
}
__device__ __forceinline__ void phase_rnn_scan_b(PRef p) {
    for (int u = bidx_(); u < 4 * 64 * 5; u += GRIDV) {
        const int cb = u % 5, ck = (u / 5) & 63, b = u / 320;
        const int ch = cb * 256 + tidx_();
        float h = 0.f;
        {
            const float* ap = p.AggP + (size_t)(b * 64) * DRNN + ch; const float* hp = p.AggH + (size_t)(b * 64) * DRNN + ch;
            for (int c = 0; c < ck; c += 16) {
                float pa[16], ph[16];
#pragma unroll
                for (int i = 0; i < 16; ++i) { const int ci = min(c + i, ck - 1); pa[i] = ap[(size_t)ci * DRNN]; ph[i] = hp[(size_t)ci * DRNN]; }
#pragma unroll
                for (int i = 0; i < 16; ++i) { const bool ok = c + i < ck; h = (ok ? pa[i] : 1.0f) * h + (ok ? ph[i] : 0.f); }
            }
        }
        const size_t base = (size_t)(b * SEQ + ck * 64) * DRNN + ch;
        h16* zrow = p.Z2 + (size_t)(b * SEQ + ck * 64) * Z2LD;
#pragma unroll 1
        for (int i0 = 0; i0 < 64; i0 += 32) {
            h16 la[32], uu[32], gt[32];
#pragma unroll
            for (int i = 0; i < 32; ++i) { la[i] = p.LA[base + (size_t)(i0 + i) * DRNN]; uu[i] = p.RU[base + (size_t)(i0 + i) * DRNN]; gt[i] = zrow[(size_t)(i0 + i) * Z2LD + ch]; }
#pragma unroll
            for (int i = 0; i < 32; ++i) {
                h = __expf((float)la[i]) * h + (float)uu[i];
                zrow[(size_t)(i0 + i) * Z2LD + DRNN + ch] = (h16)(gelu_as((float)gt[i]) * h);
            }
        }
    }
}

#define XB_TMO      128
#define XB_XCNT(j)  (256  + 64 * (j))
#define XB_XSUB(j)  (1280 + 64 * (j))
#define XB_XGEN(j)  (2304 + 64 * (j))
#define XB_TOP      3328
#define XB_TOPGEN   3392
#define XCD_BAR_WORDS 3456
#define XB_SPIN_CAP (1u << 22)
__device__ __forceinline__ unsigned xb_ld(unsigned* p)              { return __hip_atomic_load(p, __ATOMIC_RELAXED, __HIP_MEMORY_SCOPE_AGENT); }
__device__ __forceinline__ unsigned xb_add(unsigned* p, unsigned v) { return __hip_atomic_fetch_add(p, v, __ATOMIC_RELAXED, __HIP_MEMORY_SCOPE_AGENT); }
__device__ __forceinline__ unsigned xb_xcc_id() { return (unsigned)__builtin_amdgcn_s_getreg((3 << 11) | 20) & 0xFu; }
#define XB_SPIN(cond, bar) do { unsigned _sp = 0; while (cond) { __builtin_amdgcn_s_sleep(1); \
    if ((++_sp & 255u) == 0u) { if (xb_ld(&(bar)[XB_TMO])) break; if (_sp > XB_SPIN_CAP) { atomicAdd(&(bar)[XB_TMO], 1u); break; } } } } while (0)
struct XcdBarrier { unsigned* bar; unsigned x; volatile LAS unsigned* st; };
__device__ __forceinline__ XcdBarrier xcd_barrier_post(unsigned* bar, volatile LAS unsigned* st) {
    XcdBarrier b; b.bar = bar; b.x = xb_xcc_id(); b.st = st;
    if (threadIdx.x == 0) (void)xb_add(&bar[XB_XCNT(b.x)], 1u);
    return b;
}
__device__ __forceinline__ void xcd_barrier_complete(unsigned* bar, unsigned x, unsigned& nloc, unsigned& nx) {
    const unsigned G = gridDim.x * gridDim.y * gridDim.z;
    unsigned sum, cnt, mine, sp = 0u;
    for (;;) {
        sum = 0u; cnt = 0u; mine = 0u;
#pragma unroll
        for (unsigned j = 0; j < 16; ++j) { const unsigned c = xb_ld(&bar[XB_XCNT(j)]); sum += c; cnt += (c > 0u) ? 1u : 0u; mine = (j == x) ? c : mine; }
        if (sum == G) break;
        __builtin_amdgcn_s_sleep(1);
        if ((++sp & 255u) == 0u) { if (xb_ld(&bar[XB_TMO])) break; if (sp > XB_SPIN_CAP) { atomicAdd(&bar[XB_TMO], 1u); break; } }
    }
    nloc = mine > 0u ? mine : 1u; nx = cnt > 0u ? cnt : 1u;
}
__device__ __forceinline__ void xcd_barrier(const XcdBarrier& b) {
    asm volatile("s_waitcnt vmcnt(0)" ::: "memory");
    __syncthreads();
    if (threadIdx.x == 0) {
        unsigned* bar = b.bar;
        __builtin_amdgcn_s_waitcnt(0);
        unsigned nloc = b.st[0], nx = b.st[1];
        if (nloc == 0u) { xcd_barrier_complete(bar, b.x, nloc, nx); b.st[0] = nloc; b.st[1] = nx; }
        const unsigned old = xb_add(&bar[XB_XSUB(b.x)], 1u);
        const unsigned gen = old / nloc;
        if (old + 1u == (gen + 1u) * nloc) {
            __builtin_amdgcn_fence(__ATOMIC_RELEASE, "agent");
            asm volatile("s_waitcnt vmcnt(0)" ::: "memory");
            const unsigned og = xb_add(&bar[XB_TOP], 1u);
            const unsigned tg = og / nx;
            if (og + 1u == (tg + 1u) * nx) xb_add(&bar[XB_TOPGEN], 1u);
            else XB_SPIN(xb_ld(&bar[XB_TOPGEN]) == tg, bar);
            __builtin_amdgcn_fence(__ATOMIC_ACQUIRE, "agent");
            xb_add(&bar[XB_XGEN(b.x)], 1u);
            asm volatile("s_waitcnt vmcnt(0)" ::: "memory");
        } else {
            XB_SPIN(xb_ld(&bar[XB_XGEN(b.x)]) == gen, bar);
            __builtin_amdgcn_fence(__ATOMIC_ACQUIRE, "agent");
            asm volatile("s_waitcnt vmcnt(0)" ::: "memory");
        }
    }
    __syncthreads();
}

namespace pg8 {
#define PG8_LAS __attribute__((address_space(3)))
typedef unsigned short bf16_t;
typedef short bf16x8 __attribute__((ext_vector_type(8)));
typedef unsigned u32x4 __attribute__((ext_vector_type(4)));
constexpr int BM = 256, BK = 64, HALF = 128, HTB = HALF * BK * 2  , STAGE_BYTES = 8 * HTB, NXCD = 8, WGM = 8;

__host__ __device__ __forceinline__ int lds_byte(int r, int c) { const int st = (r >> 4) * 2 + (c >> 5), rr = r & 15, cc = c & 31, ob = rr * 64 + cc * 2; return st * 1024 + (ob ^ (((ob >> 9) & 1) << 5)); }
__host__ __device__ __forceinline__ void stage_rc(int b, int& R, int& C) { const int st = b / 1024, sb = b % 1024, swz = sb ^ (((sb >> 9) & 1) << 5); R = (st >> 1) * 16 + swz / 64; C = (st & 1) * 32 + (swz % 64) / 2; }
__host__ __device__ __forceinline__ int perm32(int rho) { const int n = rho >> 4, i = rho & 15; return 8 * (i >> 2) + 4 * n + (i & 3); }

struct Unit { int pm, pn; };
struct Gemm { const bf16_t* A; const bf16_t* Bt; int M, N, K, lda; };

struct StaticOrder {
    int nM, nN, nwg, G, c;
    __host__ __device__ void init(int M, int N, int G_, int c_) { nM = M / BM; nN = N / BM; nwg = nM * nN; G = G_; c = c_; }
    __host__ __device__ bool next(int i, Unit& u) const {
        const long L = (long)i * G + c; if (L >= nwg) return false;
        int wgid = (int)L; { const int q = nwg / NXCD, r = nwg % NXCD, xcd = wgid % NXCD, off = wgid / NXCD; wgid = (xcd < r ? xcd * (q + 1) : r * (q + 1) + (xcd - r) * q) + off; }
        const int nig = WGM * nN, gid = wgid / nig, fm = gid * WGM, gsz = (nM - fm) < WGM ? (nM - fm) : WGM;
        u.pm = fm + ((wgid % nig) % gsz); u.pn = (wgid % nig) / gsz; return true;
    }
    __device__ __forceinline__ void a_ready(const Unit&) const {}
    __device__ __forceinline__ void done(const Unit&) const {}
};
__device__ __forceinline__ unsigned pk_h16(float lo, float hi) { half2v t; t[0] = (h16)lo; t[1] = (h16)hi; return __builtin_bit_cast(unsigned, t); }
template <bool R16>
struct EpiResid {
    static constexpr bool PERM = true, AFTER_DRAIN = false;
    const void* resid; h16* out; float* ssq; int ldc;
    __device__ __forceinline__ void operator()(const f32x4 (&acc)[2][2][4][2], const Unit& u, int wr, int wc, int fr, int fq) const {
#pragma unroll
        for (int ai = 0; ai < 2; ++ai)
#pragma unroll
            for (int m = 0; m < 4; ++m) { const int row = u.pm * BM + ai * HALF + wr * 64 + m * 16 + fr; const size_t ro = (size_t)row * ldc + u.pn * BM + wc * 32 + 8 * fq;
                float ss = 0.f;
#pragma unroll
                for (int bj = 0; bj < 2; ++bj) { const size_t o = ro + bj * HALF;
                    f32x4 v0 = acc[ai][bj][m][0], v1 = acc[ai][bj][m][1];
                    if (R16) { const half8 r = *(const half8*)((const h16*)resid + o);
#pragma unroll
                        for (int i = 0; i < 4; ++i) { v0[i] += (float)r[i]; v1[i] += (float)r[4 + i]; } }
                    else { v0 += *(const f32x4*)((const float*)resid + o); v1 += *(const f32x4*)((const float*)resid + o + 4); }
                    ss += ((v0[0] * v0[0] + v0[1] * v0[1]) + (v0[2] * v0[2] + v0[3] * v0[3])) + ((v1[0] * v1[0] + v1[1] * v1[1]) + (v1[2] * v1[2] + v1[3] * v1[3]));
                    u32x4 w; w.x = pk_h16(v0[0], v0[1]); w.y = pk_h16(v0[2], v0[3]); w.z = pk_h16(v1[0], v1[1]); w.w = pk_h16(v1[2], v1[3]);
                    *(u32x4*)(out + o) = w; }
                ss += __shfl_xor(ss, 16); ss += __shfl_xor(ss, 32);
                if (fq == 0) ssq[(size_t)row * 16 + u.pn * 4 + wc] = ss; }
    }
};
struct EpiF32 {
    static constexpr bool PERM = false, AFTER_DRAIN = false;
    float* out; size_t ldc;
    __device__ __forceinline__ void operator()(const f32x4 (&acc)[2][2][4][2], const Unit& u, int wr, int wc, int fr, int fq) const {
#pragma unroll
        for (int ai = 0; ai < 2; ++ai)
#pragma unroll
            for (int m = 0; m < 4; ++m) { const size_t ro = (size_t)(u.pm * BM + ai * HALF + wr * 64 + m * 16 + fr) * ldc + u.pn * BM + wc * 32 + 4 * fq;
#pragma unroll
                for (int bj = 0; bj < 2; ++bj)
#pragma unroll
                    for (int n = 0; n < 2; ++n) *(f32x4*)(out + ro + bj * HALF + n * 16) = acc[ai][bj][m][n]; }
    }
};
struct EpiH16 {
    static constexpr bool PERM = true, AFTER_DRAIN = false;
    h16* out; int ldc;
    __device__ __forceinline__ void operator()(const f32x4 (&acc)[2][2][4][2], const Unit& u, int wr, int wc, int fr, int fq) const {
#pragma unroll
        for (int ai = 0; ai < 2; ++ai)
#pragma unroll
            for (int m = 0; m < 4; ++m) { h16* rowp = out + (size_t)(u.pm * BM + ai * HALF + wr * 64 + m * 16 + fr) * ldc + u.pn * BM + wc * 32 + 8 * fq;
#pragma unroll
                for (int bj = 0; bj < 2; ++bj) { const f32x4 v0 = acc[ai][bj][m][0], v1 = acc[ai][bj][m][1];
                    u32x4 w; w.x = pk_h16(v0[0], v0[1]); w.y = pk_h16(v0[2], v0[3]); w.z = pk_h16(v1[0], v1[1]); w.w = pk_h16(v1[2], v1[3]);
                    *(u32x4*)(rowp + bj * HALF) = w; } }
    }
};
struct EpiSC {
    static constexpr bool PERM = true, AFTER_DRAIN = false;
    h16* out; const float* ssq;
    __device__ __forceinline__ void operator()(const f32x4 (&acc)[2][2][4][2], const Unit& u, int wr, int wc, int fr, int fq) const {
#pragma unroll
        for (int ai = 0; ai < 2; ++ai)
#pragma unroll
            for (int m = 0; m < 4; ++m) { const int row = u.pm * BM + ai * HALF + wr * 64 + m * 16 + fr;
                const f32x4 s0 = *(const f32x4*)(ssq + (size_t)row * 16), s1 = *(const f32x4*)(ssq + (size_t)row * 16 + 4), s2 = *(const f32x4*)(ssq + (size_t)row * 16 + 8), s3 = *(const f32x4*)(ssq + (size_t)row * 16 + 12);
                const float ssr = (((s0[0] + s0[1]) + (s0[2] + s0[3])) + ((s1[0] + s1[1]) + (s1[2] + s1[3]))) + (((s2[0] + s2[1]) + (s2[2] + s2[3])) + ((s3[0] + s3[1]) + (s3[2] + s3[3])));
                const float rstd = rsqrtf(ssr * (1.0f / 1024.0f) + 1e-6f);
#pragma unroll
                for (int bj = 0; bj < 2; ++bj) { const int col = u.pn * BM + bj * HALF + wc * 32 + 8 * fq;
                    const f32x4 v0 = acc[ai][bj][m][0] * rstd, v1 = acc[ai][bj][m][1] * rstd;
                    u32x4 w; w.x = pk_h16(v0[0], v0[1]); w.y = pk_h16(v0[2], v0[3]); w.z = pk_h16(v1[0], v1[1]); w.w = pk_h16(v1[2], v1[3]);
                    *(u32x4*)(out + ((size_t)((row >> 6) * 256 + (col >> 3)) * 64 + (row & 63)) * 8) = w; } }
    }
};
struct EpiEvenMain {
    static constexpr bool PERM = true, AFTER_DRAIN = false;
    h16* Z; float* FG; const float* b_f;
    __device__ __forceinline__ void operator()(const f32x4 (&acc)[2][2][4][2], const Unit& u, int wr, int wc, int fr, int fq) const {
#pragma unroll
        for (int bj = 0; bj < 2; ++bj) {
            const int col0 = u.pn * BM + bj * HALF + wc * 32 + 8 * fq;
            if (col0 < 2048) {
                const float sc = (col0 < 512 || (col0 >= 1024 && col0 < 1536)) ? QSCALE : 1.0f;
#pragma unroll
                for (int ai = 0; ai < 2; ++ai)
#pragma unroll
                    for (int m = 0; m < 4; ++m) { const f32x4 v0 = acc[ai][bj][m][0] * sc, v1 = acc[ai][bj][m][1] * sc;
                        u32x4 w; w.x = pk_h16(v0[0], v0[1]); w.y = pk_h16(v0[2], v0[3]); w.z = pk_h16(v1[0], v1[1]); w.w = pk_h16(v1[2], v1[3]);
                        *(u32x4*)(Z + (size_t)(u.pm * BM + ai * HALF + wr * 64 + m * 16 + fr) * ZLD + col0) = w; }
            } else if (col0 < 2080) {
                const int c = col0 - 2048;
#pragma unroll
                for (int ai = 0; ai < 2; ++ai)
#pragma unroll
                    for (int m = 0; m < 4; ++m) { const f32x4 v0 = acc[ai][bj][m][0], v1 = acc[ai][bj][m][1]; f32x4 o0, o1;
                        if (c == 0) {
#pragma unroll
                            for (int q = 0; q < 4; ++q) { o0[q] = log_sigmoid(v0[q] + b_f[q]) * LOG2E; o1[q] = log_sigmoid(v1[q] + b_f[4 + q]) * LOG2E; }
                        } else {
#pragma unroll
                            for (int q = 0; q < 4; ++q) { o0[q] = sigmoidf_(v0[q]); o1[q] = sigmoidf_(v1[q]); }
                        }
                        float* fr_ = FG + (size_t)(u.pm * BM + ai * HALF + wr * 64 + m * 16 + fr) * 32 + c;
                        *(f32x4*)fr_ = o0; *(f32x4*)(fr_ + 4) = o1; }
            }
        }
    }
};
struct EpiVt {
    static constexpr bool PERM = true, AFTER_DRAIN = false;
    h16 *VtF, *VtS, *VtW;
    __device__ __forceinline__ void operator()(const f32x4 (&acc)[2][2][4][2], const Unit& u, int wr, int wc, int fr, int fq) const {
#pragma unroll
        for (int ai = 0; ai < 2; ++ai)
#pragma unroll
            for (int m = 0; m < 4; ++m) {
                const int n = u.pm * BM + ai * HALF + wr * 64 + m * 16 + fr;
#pragma unroll
                for (int bj = 0; bj < 2; ++bj) {
                    const int t0 = u.pn * BM + bj * HALF + wc * 32 + 8 * fq, b = t0 >> 12, s = t0 & 4095;
                    h16* dst = n < 512 ? VtF + ((size_t)(b * 512 + n)) * SEQ + s : (n < 640 ? VtS + ((size_t)(b * 128 + n - 512)) * SEQ + s : VtW + ((size_t)(b * 128 + n - 640)) * SEQ + s);
                    const f32x4 v0 = acc[ai][bj][m][0], v1 = acc[ai][bj][m][1];
                    u32x4 w; w.x = pk_h16(v0[0], v0[1]); w.y = pk_h16(v0[2], v0[3]); w.z = pk_h16(v1[0], v1[1]); w.w = pk_h16(v1[2], v1[3]);
                    *(u32x4*)dst = w;
                }
            }
    }
};

template <class Epi, class Sched, bool ALIGN_EPI = false, bool SP2 = false>
__device__ __forceinline__ void gemm_phase(PG8_LAS unsigned char* lds, const Gemm g, const Sched& S, const Epi& E) {
    int tid_ = threadIdx.x; asm volatile("" : "+v"(tid_));
    const int tid = tid_, wid = __builtin_amdgcn_readfirstlane(tid >> 6), lane = tid & 63, wr = wid >> 2, wc = wid & 3, fr = lane & 15, fq = lane >> 4;
    const int K = g.K, nt = K / BK;
    unsigned voffA[2], voffB[2];
#pragma unroll
    for (int i = 0; i < 2; ++i) { int R, C; stage_rc(tid * 16 + i * 8192, R, C); const int Rb = Epi::PERM ? ((R & ~31) + perm32(R & 31)) : R;
        voffA[i] = (unsigned)(R * g.lda + C) * 2u; voffB[i] = (unsigned)(Rb * K + C) * 2u; }
    const size_t kstep = (size_t)(BK * 2);
    const size_t hstepA = (size_t)HALF * g.lda * 2, hstepB = (size_t)HALF * K * 2;
    const size_t tstepA = 2 * hstepA, tstepB = 2 * hstepB;
    const unsigned ldsw = (unsigned)wid * 1024u;
    const int aoff = lds_byte(wr * 64 + fr, fq * 8), boff = lds_byte(wc * 32 + fr, fq * 8);
#define PG8_SA(b, h) (((b) * 2 + (h)) * HTB)
#define PG8_SB(b, h) ((4 + (b) * 2 + (h)) * HTB)
#define PG8_STAGE(bufoff, gbase, voff) do { _Pragma("unroll") for (int _i = 0; _i < 2; ++_i) \
        __builtin_amdgcn_global_load_lds((const unsigned*)((const char*)(gbase) + (voff)[_i]), (PG8_LAS unsigned*)(lds + (bufoff) + ldsw + _i * 8192), 16, 0, 0); } while (0)
#define PG8_LDA(dst, b, h) do { _Pragma("unroll") for (int m = 0; m < 4; ++m) _Pragma("unroll") for (int k = 0; k < 2; ++k) dst[m][k] = *(const PG8_LAS bf16x8*)(lds + PG8_SA(b, h) + aoff + m * 2048 + k * 1024); } while (0)
#define PG8_LDB(dst, b, h) do { _Pragma("unroll") for (int n = 0; n < 2; ++n) _Pragma("unroll") for (int k = 0; k < 2; ++k) dst[n][k] = *(const PG8_LAS bf16x8*)(lds + PG8_SB(b, h) + boff + n * 2048 + k * 1024); } while (0)
#define PG8_MMA(ai, bj, At, Bt) do { __builtin_amdgcn_s_setprio(1); _Pragma("unroll") for (int m = 0; m < 4; ++m) _Pragma("unroll") for (int n = 0; n < 2; ++n) _Pragma("unroll") for (int k = 0; k < 2; ++k) \
        acc[ai][bj][m][n] = __builtin_amdgcn_mfma_f32_16x16x32_f16(__builtin_bit_cast(half8, Bt[n][k]), __builtin_bit_cast(half8, At[m][k]), acc[ai][bj][m][n], 0, 0, 0); __builtin_amdgcn_s_setprio(0); } while (0)
#define PG8_WAIT_V(n) asm volatile("s_waitcnt vmcnt(" #n ")" ::: "memory")
#define PG8_WAIT_L(n) asm volatile("s_waitcnt lgkmcnt(" #n ")" ::: "memory")
#define PG8_BAR __builtin_amdgcn_s_barrier()
#define PG8_SCHED __builtin_amdgcn_sched_barrier(0)
    Unit cur, nxt; int ui = 0;
    if (!S.next(0, cur)) return;
    f32x4 acc[2][2][4][2];
#pragma unroll
    for (int a = 0; a < 2; ++a)
#pragma unroll
        for (int b = 0; b < 2; ++b)
#pragma unroll
            for (int m = 0; m < 4; ++m)
#pragma unroll
                for (int n = 0; n < 2; ++n) acc[a][b][m][n] = (f32x4){0.f, 0.f, 0.f, 0.f};
    bf16x8 At[4][2], B0[2][2], B1[2][2];
    const char* cA = (const char*)g.A + (size_t)cur.pm * tstepA; const char* cB = (const char*)g.Bt + (size_t)cur.pn * tstepB;
    S.a_ready(cur);
    if constexpr (SP2) {
        PG8_STAGE(PG8_SB(0, 0), cB, voffB); PG8_STAGE(PG8_SB(0, 1), cB + hstepB, voffB); PG8_STAGE(PG8_SA(0, 0), cA, voffA); PG8_STAGE(PG8_SA(0, 1), cA + hstepA, voffA);
        if (wr == 1) PG8_BAR;
        PG8_WAIT_V(2); PG8_BAR;
        PG8_STAGE(PG8_SB(1, 0), cB + kstep, voffB); PG8_STAGE(PG8_SA(1, 0), cA + kstep, voffA); PG8_STAGE(PG8_SB(1, 1), cB + hstepB + kstep, voffB);
        PG8_WAIT_V(6); PG8_BAR;
    } else {
        PG8_STAGE(PG8_SB(0, 0), cB, voffB); PG8_STAGE(PG8_SA(0, 0), cA, voffA); PG8_STAGE(PG8_SB(0, 1), cB + hstepB, voffB); PG8_STAGE(PG8_SA(0, 1), cA + hstepA, voffA);
        if (wr == 1) PG8_BAR;
        PG8_WAIT_V(4); PG8_BAR;
        PG8_STAGE(PG8_SB(1, 0), cB + kstep, voffB); PG8_STAGE(PG8_SA(1, 0), cA + kstep, voffA); PG8_STAGE(PG8_SB(1, 1), cB + hstepB + kstep, voffB);
        PG8_WAIT_V(6); PG8_BAR;
    }
    for (;;) {
        const bool has_next = S.next(ui + 1, nxt);
        const char* nA = has_next ? (const char*)g.A + (size_t)nxt.pm * tstepA : cA; const char* nB = has_next ? (const char*)g.Bt + (size_t)nxt.pn * tstepB : cB;
        for (int t = 0; t < nt; t += 2) {
            const bool last = (t == nt - 2);
            const char* a1 = cA + (size_t)(t + 1) * kstep;
            const char* a2 = last ? nA : cA + (size_t)(t + 2) * kstep; const char* b2 = last ? nB : cB + (size_t)(t + 2) * kstep;
            const char* a3 = a2 + kstep; const char* b3 = b2 + kstep;
            if (last && has_next) S.a_ready(nxt);
            if constexpr (SP2) {
            PG8_LDB(B0, 0, 0); PG8_LDB(B1, 0, 1); PG8_SCHED; PG8_LDA(At, 0, 0); PG8_STAGE(PG8_SA(1, 1), a1 + hstepA, voffA);
            PG8_WAIT_V(8); PG8_WAIT_L(0); PG8_BAR; PG8_MMA(0, 0, At, B0); PG8_MMA(0, 1, At, B1); PG8_BAR; PG8_SCHED;
            PG8_LDA(At, 0, 1); PG8_STAGE(PG8_SB(0, 0), b2, voffB); PG8_STAGE(PG8_SB(0, 1), b2 + hstepB, voffB); PG8_STAGE(PG8_SA(0, 0), a2, voffA);
            PG8_WAIT_V(8); PG8_WAIT_L(0); PG8_BAR; PG8_MMA(1, 0, At, B0); PG8_MMA(1, 1, At, B1); PG8_BAR; PG8_SCHED;
            PG8_LDB(B0, 1, 0); PG8_LDB(B1, 1, 1); PG8_SCHED; PG8_LDA(At, 1, 0); PG8_STAGE(PG8_SA(0, 1), a2 + hstepA, voffA);
            PG8_WAIT_V(8); PG8_WAIT_L(0); PG8_BAR; PG8_MMA(0, 0, At, B0); PG8_MMA(0, 1, At, B1); PG8_BAR; PG8_SCHED;
            PG8_LDA(At, 1, 1); PG8_STAGE(PG8_SB(1, 0), b3, voffB); PG8_STAGE(PG8_SB(1, 1), b3 + hstepB, voffB); PG8_STAGE(PG8_SA(1, 0), a3, voffA);
            PG8_WAIT_V(8); PG8_WAIT_L(0); PG8_BAR; PG8_MMA(1, 0, At, B0); PG8_MMA(1, 1, At, B1); PG8_BAR; PG8_SCHED;
            } else {
            PG8_LDB(B0, 0, 0); PG8_SCHED; PG8_LDA(At, 0, 0); PG8_STAGE(PG8_SA(1, 1), a1 + hstepA, voffA);
            PG8_WAIT_L(8); PG8_BAR; PG8_WAIT_L(0); PG8_MMA(0, 0, At, B0); PG8_BAR; PG8_SCHED;
            PG8_LDB(B1, 0, 1); PG8_STAGE(PG8_SB(0, 0), b2, voffB);
            PG8_BAR; PG8_WAIT_L(0); PG8_MMA(0, 1, At, B1); PG8_BAR;
            PG8_LDA(At, 0, 1); PG8_STAGE(PG8_SA(0, 0), a2, voffA);
            PG8_BAR; PG8_WAIT_L(0); PG8_MMA(1, 0, At, B0); PG8_BAR; PG8_SCHED;
            PG8_STAGE(PG8_SB(0, 1), b2 + hstepB, voffB);
            PG8_WAIT_V(6); PG8_BAR; PG8_MMA(1, 1, At, B1); PG8_BAR;
            PG8_LDB(B0, 1, 0); PG8_SCHED; PG8_LDA(At, 1, 0); PG8_STAGE(PG8_SA(0, 1), a2 + hstepA, voffA);
            PG8_WAIT_L(8); PG8_BAR; PG8_WAIT_L(0); PG8_MMA(0, 0, At, B0); PG8_BAR; PG8_SCHED;
            PG8_LDB(B1, 1, 1); PG8_STAGE(PG8_SB(1, 0), b3, voffB);
            PG8_BAR; PG8_WAIT_L(0); PG8_MMA(0, 1, At, B1); PG8_BAR;
            PG8_LDA(At, 1, 1); PG8_STAGE(PG8_SA(1, 0), a3, voffA);
            PG8_BAR; PG8_WAIT_L(0); PG8_MMA(1, 0, At, B0); PG8_BAR; PG8_SCHED;
            PG8_STAGE(PG8_SB(1, 1), b3 + hstepB, voffB);
            PG8_WAIT_V(6); PG8_BAR; PG8_MMA(1, 1, At, B1); PG8_BAR;
            }
        }
        if constexpr (ALIGN_EPI) { if (wr == 0) PG8_BAR; }
        if constexpr (!Epi::AFTER_DRAIN) { E(acc, cur, wr, wc, fr, fq); S.done(cur); }
        if (!has_next) break;
#pragma unroll
        for (int a = 0; a < 2; ++a)
#pragma unroll
            for (int b = 0; b < 2; ++b)
#pragma unroll
                for (int m = 0; m < 4; ++m)
#pragma unroll
                    for (int n = 0; n < 2; ++n) acc[a][b][m][n] = (f32x4){0.f, 0.f, 0.f, 0.f};
        cur = nxt; cA = nA; cB = nB; ++ui;
        if constexpr (ALIGN_EPI) { if (wr == 1) PG8_BAR; }
    }
    PG8_WAIT_V(0);
    if constexpr (!ALIGN_EPI) { if (wr == 0) PG8_BAR; }
    PG8_BAR;
    if constexpr (Epi::AFTER_DRAIN) { E.fused(acc, cur, wr, wc, fr, fq, lds, wid, lane); S.done(cur); }
#undef PG8_SA
#undef PG8_SB
#undef PG8_STAGE
#undef PG8_LDA
#undef PG8_LDB
#undef PG8_MMA
#undef PG8_WAIT_V
#undef PG8_WAIT_L
#undef PG8_BAR
#undef PG8_SCHED
}
}

__device__ __forceinline__ GemmArgs mk_gemm(const h16* A, int lda, const h16* Bt, int ldb, int M, int N, int K, int ans, int mode, h16* c16, int ldc16, float* c32, int ldc32, const float* resid) {
    GemmArgs g; g.A = A; g.lda = lda; g.Bt = Bt; g.ldb = ldb; g.M = M; g.N = N; g.K = K; g.a_ntile_stride = ans; g.mode = mode; g.c16 = c16; g.ldc16 = ldc16; g.c32 = c32; g.ldc32 = ldc32; g.resid = resid; g.aux = nullptr; return g;
}

__device__ __forceinline__ void run_phase(PRef p, int ph, char* smem) {
    if (ph == 1 || ph == 4 || ph == 6 || ph == 10 || ph == 14 || ph == 16) {
        PG8_LAS unsigned char* lds = (PG8_LAS unsigned char*)dyn_lds;
        const int G = (int)gridDim.x, c = (int)blockIdx.x;
        pg8::StaticOrder S;
        typedef const pg8::bf16_t* bp;
        if (ph == 1) {
            { pg8::EpiEvenMain E{p.Z, p.FG, p.even_b_f}; S.init(TOK, ZLD, G, c);
              pg8::gemm_phase<pg8::EpiEvenMain, pg8::StaticOrder, true, true>(lds, pg8::Gemm{(bp)p.HN, (bp)p.WtE, TOK, ZLD, DM, DM}, S, E); }
            { pg8::EpiVt E{p.VtF, p.VtS, p.VtW}; S.init(768, TOK, G, (c + 3 * G / 4) % G);
              pg8::gemm_phase<pg8::EpiVt, pg8::StaticOrder, true, true>(lds, pg8::Gemm{(bp)p.WtV, (bp)p.HN, 768, TOK, DM, DM}, S, E); }
        } else if (ph == 4) {
            pg8::EpiResid<false> E{p.x, p.H, p.SSQ, DM}; S.init(TOK, DM, G, c);
            pg8::gemm_phase<pg8::EpiResid<false>, pg8::StaticOrder, true, true>(lds, pg8::Gemm{(bp)p.O, (bp)p.WtEo, TOK, DM, DM, DM}, S, E);
        } else if (ph == 14) {
            pg8::EpiResid<true> E{p.H, p.H, p.SSQ, DM}; S.init(TOK, DM, G, c);
            pg8::gemm_phase<pg8::EpiResid<true>, pg8::StaticOrder, true, true>(lds, pg8::Gemm{(bp)(p.Z2 + DRNN), (bp)p.WtOo, TOK, DM, DRNN, Z2LD}, S, E);
        } else if (ph == 10) {
            pg8::EpiH16 E{p.Z2, Z2LD}; S.init(TOK, Z2LD, G, c);
            pg8::gemm_phase<pg8::EpiH16, pg8::StaticOrder, true, true>(lds, pg8::Gemm{(bp)p.HN, (bp)p.WtO, TOK, Z2LD, DM, DM}, S, E);
        } else {
            pg8::EpiSC E{p.SC, p.SSQ}; S.init(TOK, 2048, G, c);
            pg8::gemm_phase<pg8::EpiSC, pg8::StaticOrder, true, true>(lds, pg8::Gemm{(bp)p.H, (bp)(p.WtQ + (ph == 16 ? (size_t)2048 * 1024 : 0)), TOK, 2048, DM, DM}, S, E);
        }
        return;
    }
    if (ph == 0) phase_prep(p, smem);
    else if (ph == 2) phase_cumsum_compress(p, smem);
    else if (ph == 3) phase_attention(p, smem);
    else if (ph == 8 || ph == 18) phase_peer_topk(p, smem);
    else if (ph == 9 || ph == 19) phase_peer_experts(p, ph == 19 ? 1 : 0, ph == 19 ? p.final_g : p.odd_norm_g, ph == 19 ? 1 : 0, smem);
    else if (ph == 11) phase_rnn_gates(p, smem);
    else if (ph == 13) phase_rnn_scan_b(p);
}

__global__ void __launch_bounds__(512, 2) mega(Params p_by_value) {
    char* smem = dyn_lds + hidx_() * 65536;
    volatile LAS unsigned* hs_all = (volatile LAS unsigned*)(dyn_lds + 131072);
    const __attribute__((address_space(4))) Params* kp = (const __attribute__((address_space(4))) Params*)__builtin_amdgcn_kernarg_segment_ptr();
    const int ph0 = (int)kp->ph0, ph1 = (int)kp->ph1;
    if (threadIdx.x < 12) hs_all[threadIdx.x] = 0u;
    __syncthreads();
    XcdBarrier xb = xcd_barrier_post(kp->BAR, hs_all + 8);
    for (int ph = ph0; ph < ph1; ++ph) {
        if (ph == 12 || ph == 7 || ph == 17 || ph == 5 || ph == 15) continue;
        const __attribute__((address_space(4))) Params* q = kp;
        asm volatile("" : "+s"(q));
        PRef p = *q;
#if PROBE_PH >= 0
        if (blockIdx.x == 0 && threadIdx.x == 0) p.TS[ph] = __builtin_amdgcn_s_memrealtime();
#endif
        const int reps = ((DUP_MASK >> ph) & 1) ? 2 : 1;
        for (int r = 0; r < reps; ++r) { run_phase(p, ph, smem); if (r + 1 < reps) xcd_barrier(xb); }
        if (ph + 1 < ph1) xcd_barrier(xb);
    }
    PRef p = *kp;
#if PROBE_PH >= 0
    cg::this_grid().sync();
    if (blockIdx.x == 0 && threadIdx.x == 0) { p.TS[NPHASE] = __builtin_amdgcn_s_memrealtime(); __threadfence(); }
    cg::this_grid().sync();
    {
        const unsigned long long t0 = __hip_atomic_load(&p.TS[0], __ATOMIC_RELAXED, __HIP_MEMORY_SCOPE_AGENT), t1 = __hip_atomic_load(&p.TS[NPHASE], __ATOMIC_RELAXED, __HIP_MEMORY_SCOPE_AGENT);
        const unsigned long long a = __hip_atomic_load(&p.TS[PROBE_PH], __ATOMIC_RELAXED, __HIP_MEMORY_SCOPE_AGENT), b = __hip_atomic_load(&p.TS[PROBE_PH + PROBE_N], __ATOMIC_RELAXED, __HIP_MEMORY_SCOPE_AGENT);
        const float frac = (float)(b - a) / (float)(t1 - t0);
        const float scale = 1.1f + frac;
        for (size_t i = (size_t)blockIdx.x * 512 + threadIdx.x; i < (size_t)TOK * DM; i += (size_t)gridDim.x * 512) p.out[i] *= scale;
    }
#endif
}

constexpr int DYN_LDS_BYTES = 131072 + 64;
extern "C" void kernel_launch(void* const* d_in, const int* in_sizes, int n_in, void* d_out, int out_size, void* d_ws, size_t ws_size, hipStream_t stream) {
    Params p; memset(&p, 0, sizeof(p));
    const float* const* in = (const float* const*)d_in;
    p.x = in[0]; p.even_norm_g = in[1]; p.even_w_in = in[2]; p.even_b_f = in[3]; p.even_cmp_pos = in[4]; p.even_w_cmp_k = in[5]; p.even_w_cmp_v = in[6]; p.even_w_out = in[7];
    p.odd_norm_g = in[8]; p.odd_w_in = in[9]; p.odd_conv_w = in[10]; p.odd_conv_b = in[11]; p.odd_w_ra = in[12]; p.odd_b_ra = in[13]; p.odd_w_ri = in[14]; p.odd_b_ri = in[15];
    p.odd_lam = in[16]; p.odd_w_out = in[17]; p.ffn_norm_g = in[18]; p.peer_w_q = in[19]; p.peer_sub_keys = in[20]; p.peer_u = in[21]; p.peer_v = in[22]; p.final_g = in[23];
    p.out = (float*)d_out;
    char* ws = (char*)d_ws; size_t off = 0;
    auto take = [&](size_t bytes) { char* r = ws + off; off += (bytes + 255) & ~(size_t)255; return r; };
    p.WtE = (h16*)take((size_t)ZLD * 1024 * 2); p.WtV = (h16*)take((size_t)768 * 1024 * 2); p.WtEo = (h16*)take((size_t)1024 * 1024 * 2); p.WtO = (h16*)take((size_t)2560 * 1024 * 2); p.WtOo = (h16*)take((size_t)1024 * 1280 * 2);
    p.WtQ = (h16*)take((size_t)2 * 2048 * 1024 * 2); p.Wc = (h16*)take((size_t)2 * 64 * 2048 * 2); p.Wr = (h16*)take((size_t)20 * 16384 * 2); p.Keys = (h16*)take((size_t)2 * 8 * 2 * 128 * 128 * 2);
    p.Pos16 = (h16*)take(4096); p.U8 = (unsigned char*)take((size_t)2 * 16384 * 1024); p.V8 = (unsigned char*)take((size_t)2 * 16384 * 1024);
    p.US = (float*)take((size_t)2 * 16384 * 4); p.VS = (float*)take((size_t)2 * 16384 * 4);
    p.H = (h16*)take((size_t)TOK * DM * 2); p.HN = (h16*)take((size_t)TOK * DM * 2); p.SSQ = (float*)take((size_t)TOK * 16 * 4);
    const size_t scratch0 = off;
    p.Z = (h16*)take((size_t)TOK * ZLD * 2); p.VtF = (h16*)take((size_t)4 * 8 * 64 * SEQ * 2); p.VtS = (h16*)take((size_t)4 * 2 * 64 * SEQ * 2); p.VtW = (h16*)take((size_t)4 * 2 * 64 * SEQ * 2);
    p.KC = (h16*)take((size_t)8 * 256 * 64 * 2); p.VCt = (h16*)take((size_t)8 * 64 * 256 * 2); p.O = (h16*)take((size_t)TOK * DM * 2); p.FG = (float*)take((size_t)TOK * 32 * 4); p.C2 = (float*)take((size_t)32 * SEQ * 4); p.OACC = (float*)take((size_t)TOK * 512 * 4);
    size_t mx = off;
    off = scratch0;
    p.QP = (h16*)take((size_t)TOK * 2048 * 2); p.SC = (h16*)take((size_t)TOK * 2048 * 2); p.IDS = (int*)take((size_t)TOK * 128 * 4); p.GW = (float*)take((size_t)TOK * 128 * 4);
    if (off > mx) mx = off;
    off = scratch0;
    p.Z2 = (h16*)take((size_t)TOK * Z2LD * 2); p.LA = (h16*)take((size_t)TOK * DRNN * 2); p.RU = (h16*)take((size_t)TOK * DRNN * 2);
    p.AggP = (float*)take((size_t)4 * 64 * DRNN * 4); p.AggH = (float*)take((size_t)4 * 64 * DRNN * 4);
    if (off > mx) mx = off;
    off = mx; p.TS = (unsigned long long*)take(256); p.BAR = (unsigned*)take(XCD_BAR_WORDS * 4 + 256); mx = off;
    if (mx > ws_size) { fprintf(stderr, "workspace too small: need %zu have %zu\n", mx, ws_size); return; }

    static int grid_blocks = 0;
    if (!grid_blocks) {
        int dev = 0, cus = 0, per_cu = 0;
        hipGetDevice(&dev);
        hipDeviceGetAttribute(&cus, hipDeviceAttributeMultiprocessorCount, dev);
        hipFuncSetAttribute((const void*)mega, hipFuncAttributeMaxDynamicSharedMemorySize, DYN_LDS_BYTES);
        hipOccupancyMaxActiveBlocksPerMultiprocessor(&per_cu, mega, 512, DYN_LDS_BYTES);
        if (per_cu > 1) per_cu = 1;
        if (per_cu < 1) per_cu = 1;
        grid_blocks = cus * per_cu;
    }
    hipMemsetAsync(p.BAR, 0, XCD_BAR_WORDS * 4 + 256, stream);
#if SINGLE_LAUNCH
    p.ph0 = 0; p.ph1 = NPHASE;
    void* args[] = {&p};
    hipError_t e = hipLaunchCooperativeKernel((void*)mega, dim3(grid_blocks), dim3(512), args, DYN_LDS_BYTES, stream);
    if (e != hipSuccess) fprintf(stderr, "cooperative launch failed: %s (grid %d)\n", hipGetErrorString(e), grid_blocks);
#else
    for (int ph = 0; ph < NPHASE; ++ph) {
        p.ph0 = ph; p.ph1 = ph + 1;
        hipLaunchKernelGGL(mega, dim3(grid_blocks), dim3(512), DYN_LDS_BYTES, stream, p);
    }
#endif
}
```

```cpp
#include <hip/hip_runtime.h>
#include <hip/hip_cooperative_groups.h>
#include <cstdio>
#include <cstdint>
#include <cstring>
namespace cg = cooperative_groups;

#ifndef SINGLE_LAUNCH
#define SINGLE_LAUNCH 1
#endif
#ifndef PROBE_PH
#define PROBE_PH -1
#endif
#ifndef PROBE_N
#define PROBE_N 1
#endif
#ifndef DUP_MASK
#define DUP_MASK 0
#endif

typedef _Float16 h16;
typedef _Float16 half8 __attribute__((ext_vector_type(8)));
typedef _Float16 half4 __attribute__((ext_vector_type(4)));
typedef _Float16 half2v __attribute__((ext_vector_type(2)));
typedef float f32x4 __attribute__((ext_vector_type(4)));
typedef float f32x16 __attribute__((ext_vector_type(16)));
typedef unsigned long long u64;
typedef int i32x4 __attribute__((ext_vector_type(4)));
typedef float f32x2 __attribute__((ext_vector_type(2)));
typedef float f32x32 __attribute__((ext_vector_type(32)));
typedef _Float16 h16x32 __attribute__((ext_vector_type(32)));
typedef unsigned u32x6 __attribute__((ext_vector_type(6)));
typedef int i32x2 __attribute__((ext_vector_type(2)));
typedef i32x4 __attribute__((aligned(8))) i32x4_a8;

#define NTHR 256
constexpr int BATCH = 4, SEQ = 4096, DM = 1024, TOK = BATCH * SEQ;
constexpr int ZLD = 2304, Z2LD = 2560, DRNN = 1280;
constexpr int EVEN_IN = 2848;
constexpr float LOG2E = 1.4426950408889634f;
constexpr float QSCALE = 0.125f * LOG2E;
constexpr float NEGBIG = -1.0e30f;
constexpr int KST = 72;
constexpr int NPHASE = 20;
constexpr int XCD_BAR_WORDS_C = 3456;

struct Params {
    const float *x, *even_norm_g, *even_w_in, *even_b_f, *even_cmp_pos, *even_w_cmp_k, *even_w_cmp_v, *even_w_out;
    const float *odd_norm_g, *odd_w_in, *odd_conv_w, *odd_conv_b, *odd_w_ra, *odd_b_ra, *odd_w_ri, *odd_b_ri, *odd_lam, *odd_w_out;
    const float *ffn_norm_g, *peer_w_q, *peer_sub_keys, *peer_u, *peer_v, *final_g;
    float* out;
    h16 *WtE, *WtV, *WtEo, *WtO, *WtOo, *WtQ, *Wc, *Wr, *Keys, *Pos16;
    unsigned char *U8, *V8; float *US, *VS;
    h16* H; h16* HN;
    h16 *Z, *VtF, *VtS, *VtW, *KC, *VCt, *O; float *FG, *C2, *OACC;
    float* SSQ;
    h16* QP; h16* SC; int* IDS; float* GW;
    h16* Z2; h16 *LA, *RU; float *AggP, *AggH;
    unsigned long long* TS; unsigned* BAR;
    long long ph0, ph1;
};

typedef const __attribute__((address_space(4))) Params& PRef;
extern __shared__ __attribute__((aligned(16))) char dyn_lds[];
#define GRIDV ((int)gridDim.x * 2)
#define LAS __attribute__((address_space(3)))
__device__ __forceinline__ int hidx_() { return __builtin_amdgcn_readfirstlane((int)threadIdx.x >> 8); }
__device__ __forceinline__ int tidx_() { int t = threadIdx.x & 255; asm volatile("" : "+v"(t)); return t; }
__device__ __forceinline__ int bidx_() { int b = blockIdx.x * 2 + hidx_(); asm volatile("" : "+s"(b)); return b; }
__device__ __forceinline__ int widx_() { return __builtin_amdgcn_readfirstlane(((int)threadIdx.x >> 6) & 3); }
__device__ __forceinline__ void hsync() {
    volatile LAS unsigned* w = (volatile LAS unsigned*)(dyn_lds + 131072 + hidx_() * 16);
    asm volatile("s_waitcnt lgkmcnt(0)" ::: "memory");
    if ((threadIdx.x & 63) == 0) {
        const unsigned old = __hip_atomic_fetch_add((LAS unsigned*)w, 1u, __ATOMIC_RELAXED, __HIP_MEMORY_SCOPE_WORKGROUP);
        const unsigned target = (old | 3u) + 1u;
        while ((int)(w[0] - target) < 0) { }
    }
    asm volatile("s_waitcnt lgkmcnt(0)" ::: "memory");
}

__device__ __forceinline__ float wave_sum(float v) {
#pragma unroll
    for (int o = 32; o > 0; o >>= 1) v += __shfl_xor(v, o);
    return v;
}
__device__ __forceinline__ int mbcnt64(u64 m) { return __builtin_amdgcn_mbcnt_hi((unsigned)(m >> 32), __builtin_amdgcn_mbcnt_lo((unsigned)m, 0)); }
__device__ __forceinline__ float gelu_exact(float v) { return 0.5f * v * (1.0f + erff(v * 0.70710678118654752f)); }
__device__ __forceinline__ float sigmoidf_(float v) { return 1.0f / (1.0f + __expf(-v)); }
__device__ __forceinline__ float log_sigmoid(float v) { return v >= 0.f ? -log1pf(expf(-v)) : v - log1pf(expf(v)); }
__device__ __forceinline__ float log_sigmoid_fast(float v) { return fminf(v, 0.f) - __logf(1.0f + __expf(-fabsf(v))); }
__device__ __forceinline__ int crow(int r, int hi) { return (r & 3) + 8 * (r >> 2) + 4 * hi; }
__device__ __forceinline__ f32x16 zero16() { f32x16 z;
#pragma unroll
    for (int i = 0; i < 16; ++i) z[i] = 0.f; return z; }

__device__ __forceinline__ void rms_write_h16(const float (&v)[16], const float* __restrict__ g, h16* __restrict__ dst, int lane) {
    float ss = 0.f;
#pragma unroll
    for (int i = 0; i < 16; ++i) ss += v[i] * v[i];
    ss = wave_sum(ss);
    const float rstd = rsqrtf(ss * (1.0f / 1024.0f) + 1e-6f);
#pragma unroll
    for (int hseg = 0; hseg < 2; ++hseg) {
        const int c0 = hseg * 512 + lane * 8;
        const f32x4 g0 = *(const f32x4*)(g + c0), g1 = *(const f32x4*)(g + c0 + 4);
        half8 o;
#pragma unroll
        for (int i = 0; i < 4; ++i) { o[i] = (h16)(v[hseg * 8 + i] * rstd * g0[i]); o[4 + i] = (h16)(v[hseg * 8 + 4 + i] * rstd * g1[i]); }
        *(half8*)(dst + c0) = o;
    }
}
__device__ __forceinline__ void load_row16(const float* __restrict__ src, float (&v)[16], int lane) {
#pragma unroll
    for (int hseg = 0; hseg < 2; ++hseg) {
        const int c0 = hseg * 512 + lane * 8;
        const f32x4 a = *(const f32x4*)(src + c0), b = *(const f32x4*)(src + c0 + 4);
#pragma unroll
        for (int i = 0; i < 4; ++i) { v[hseg * 8 + i] = a[i]; v[hseg * 8 + 4 + i] = b[i]; }
    }
}

__device__ __forceinline__ void load_row16(const h16* __restrict__ src, float (&v)[16], int lane) {
#pragma unroll
    for (int hseg = 0; hseg < 2; ++hseg) {
        const half8 a = *(const half8*)(src + hseg * 512 + lane * 8);
#pragma unroll
        for (int i = 0; i < 8; ++i) v[hseg * 8 + i] = (float)a[i];
    }
}

__device__ __forceinline__ int even_col_map(int n, int kind) {
    if (kind == 2) {
        if (n < 512) return 1024 + n;
        if (n < 640) return 2056 + 3 * 128 + (n - 512);
        return 2056 + 5 * 128 + (n - 640);
    }
    if (n < 1024) return n;
    if (n < 1536) return 1544 + (n - 1024);
    if (n < 1664) return 2056 + (n - 1536);
    if (n < 1792) return 2056 + 128 + (n - 1664);
    if (n < 1920) return 2056 + 256 + (n - 1792);
    if (n < 2048) return 2056 + 512 + (n - 1920);
    if (n < 2056) return 1536 + (n - 2048);
    if (n < 2080) return 2824 + (n - 2056);
    return -1;
}
__device__ __forceinline__ void transpose_tile(const float* __restrict__ src, int K, int N, h16* __restrict__ dst, int mapped, float* tileS, int tile) {
    const int tid = tidx_(), nkt = K / 64;
    const int k0 = (tile % nkt) * 64, n0 = (tile / nkt) * 64;
#pragma unroll
    for (int i = 0; i < 16; ++i) {
        const int e = tid + 256 * i, kk = e >> 6, nn = e & 63;
        const int sc = mapped ? even_col_map(n0 + nn, mapped) : (n0 + nn);
        tileS[kk * 65 + nn] = (sc >= 0) ? src[(size_t)(k0 + kk) * N + sc] : 0.f;
    }
    hsync();
    const int n = tid >> 2, ks = (tid & 3) * 16;
    half8 o0, o1;
#pragma unroll
    for (int i = 0; i < 8; ++i) { o0[i] = (h16)tileS[(ks + i) * 65 + n]; o1[i] = (h16)tileS[(ks + 8 + i) * 65 + n]; }
    h16* d = dst + (size_t)(n0 + n) * K + k0 + ks;
    *(half8*)d = o0; *(half8*)(d + 8) = o1;
    hsync();
}
__device__ __forceinline__ void transpose_job(const float* __restrict__ src, int K, int N, h16* __restrict__ dst, int Ndst, int mapped, float* tileS, int& base, int b0) {
    const int tid = tidx_(), nb = (int)GRIDV - b0, bid = bidx_() - b0;
    const int nkt = K / 64, nnt = Ndst / 64, ntiles = nkt * nnt;
    int first = (bid - (base % nb) + nb) % nb;
    for (int tile = first; tile < ntiles; tile += nb) transpose_tile(src, K, N, dst, mapped, tileS, tile);
    base += ntiles;
}
__device__ __forceinline__ void convert_job(const float* __restrict__ src, h16* __restrict__ dst, size_t n) {
    const size_t n4 = n / 4, stride = (size_t)GRIDV * NTHR;
    for (size_t i = (size_t)bidx_() * NTHR + tidx_(); i < n4; i += stride) {
        const f32x4 v = *(const f32x4*)(src + 4 * i);
        half4 o; o[0] = (h16)v[0]; o[1] = (h16)v[1]; o[2] = (h16)v[2]; o[3] = (h16)v[3];
        *(half4*)(dst + 4 * i) = o;
    }
}
constexpr int ROW6 = 768;
template <int NP>
__device__ __forceinline__ void fp6_rows(const float* __restrict__ src, unsigned char* __restrict__ dst, float* __restrict__ scl, const int (&rps)[NP], int lane) {
    const int hh = lane >> 5, g = lane & 31;
    f32x4 v[NP][8];
#pragma unroll
    for (int q = 0; q < NP; ++q)
#pragma unroll
        for (int c = 0; c < 8; ++c) v[q][c] = *(const f32x4*)(src + (size_t)(rps[q] * 2 + hh) * 1024 + c * 128 + g * 4);
#pragma unroll
    for (int q = 0; q < NP; ++q) {
        float am = 0.f;
#pragma unroll
        for (int c = 0; c < 8; ++c) am = fmaxf(am, fmaxf(fmaxf(fabsf(v[q][c][0]), fabsf(v[q][c][1])), fmaxf(fabsf(v[q][c][2]), fabsf(v[q][c][3]))));
#pragma unroll
        for (int o = 16; o > 0; o >>= 1) am = fmaxf(am, __shfl_xor(am, o));
        const float sc = am > 0.f ? am * (1.0f / 7.5f) : 1.0f, inv = 1.0f / sc;
        h16x32 hv;
#pragma unroll
        for (int c = 0; c < 8; ++c)
#pragma unroll
            for (int j = 0; j < 4; ++j) hv[4 * c + j] = (h16)(v[q][c][j] * inv);
        const u32x6 pk = __builtin_amdgcn_cvt_scalef32_pk32_fp6_f16(hv, 1.0f);
        unsigned char* o = dst + (size_t)(rps[q] * 2 + hh) * ROW6;
        *(i32x4*)(o + g * 16) = (i32x4){(int)pk[0], (int)pk[1], (int)pk[2], (int)pk[3]};
        *(i32x2*)(o + 512 + g * 8) = (i32x2){(int)pk[4], (int)pk[5]};
        if (g == 0) scl[rps[q] * 2 + hh] = sc;
    }
}
__device__ __forceinline__ void fp6_rows_job(const float* __restrict__ src, unsigned char* __restrict__ dst, float* __restrict__ scl, int npairs, int wv0) {
    const int lane = tidx_() & 63, wv = bidx_() * 4 + widx_() - wv0, nwv = GRIDV * 4 - wv0;
    if (wv < 0) return;
    int r = wv;
    for (; r + nwv < npairs; r += 2 * nwv) { const int rps[2] = {r, r + nwv}; fp6_rows<2>(src, dst, scl, rps, lane); }
    for (; r < npairs; r += nwv) { const int rps[1] = {r}; fp6_rows<1>(src, dst, scl, rps, lane); }
}
__device__ __forceinline__ void weight_jobs(PRef p, char* smem, bool first_only, int b0) {
    float* tileS = (float*)smem;
    int base = 0;
    const int jlo = 0, jhi = 28;
    for (int job = jlo; job < jhi; ++job) {
        if (first_only != (job == 0 || job == 4 || job == 6 || job == 7)) continue;
        const float* src; int K, N, Nd; h16* dst; int mapped = 0;
        if (job == 0) { src = p.even_w_in; K = 1024; N = EVEN_IN; dst = p.WtE; Nd = ZLD; mapped = 1; }
        else if (job == 1) { src = p.even_w_out; K = 1024; N = 1024; dst = p.WtEo; Nd = 1024; }
        else if (job == 2) { src = p.odd_w_in; K = 1024; N = 2560; dst = p.WtO; Nd = 2560; }
        else if (job == 3) { src = p.odd_w_out; K = 1280; N = 1024; dst = p.WtOo; Nd = 1024; }
        else if (job == 4) { src = p.even_w_in; K = 1024; N = EVEN_IN; dst = p.WtV; Nd = 768; mapped = 2; }
        else if (job == 5) continue;
        else if (job == 6) { src = p.even_w_cmp_k; K = 2048; N = 64; dst = p.Wc; Nd = 64; }
        else if (job == 7) { src = p.even_w_cmp_v; K = 2048; N = 64; dst = p.Wc + 64 * 2048; Nd = 64; }
        else if (job < 18) { const int n = job - 8; src = p.odd_w_ra + n * 16384; K = 128; N = 128; dst = p.Wr + n * 16384; Nd = 128; }
        else { const int n = job - 18; src = p.odd_w_ri + n * 16384; K = 128; N = 128; dst = p.Wr + (10 + n) * 16384; Nd = 128; }
        transpose_job(src, K, N, dst, Nd, mapped, tileS, base, b0);
    }
}
__device__ __forceinline__ void deferred_transpose_tile(PRef p, float* tileS, int t) {
    const float* src; int K, N; h16* dst;
    if (t < 256) { src = p.even_w_out; K = 1024; N = 1024; dst = p.WtEo; }
    else if (t < 896) { t -= 256; src = p.odd_w_in; K = 1024; N = 2560; dst = p.WtO; }
    else if (t < 1216) { t -= 896; src = p.odd_w_out; K = 1280; N = 1024; dst = p.WtOo; }
    else { t -= 1216; const int n = t >> 2; t &= 3; src = (n < 10 ? p.odd_w_ra + n * 16384 : p.odd_w_ri + (n - 10) * 16384); K = 128; N = 128; dst = p.Wr + n * 16384; }
    transpose_tile(src, K, N, dst, 0, tileS, t);
}
__device__ __forceinline__ void deferred_transpose_item(PRef p, float* tileS, int t0) {
    const int tid = tidx_();
    float v[4][16]; const float* srcs[4]; h16* dsts[4]; int Ks[4], k0s[4], n0s[4];
#pragma unroll
    for (int q = 0; q < 4; ++q) {
        int t = t0 + q; const float* src; int K, N; h16* dst;
        if (t < 256) { src = p.even_w_out; K = 1024; N = 1024; dst = p.WtEo; }
        else if (t < 896) { t -= 256; src = p.odd_w_in; K = 1024; N = 2560; dst = p.WtO; }
        else if (t < 1216) { t -= 896; src = p.odd_w_out; K = 1280; N = 1024; dst = p.WtOo; }
        else { t -= 1216; const int n = t >> 2; t &= 3; src = (n < 10 ? p.odd_w_ra + n * 16384 : p.odd_w_ri + (n - 10) * 16384); K = 128; N = 128; dst = p.Wr + n * 16384; }
        const int nkt = K / 64, k0 = (t % nkt) * 64, n0 = (t / nkt) * 64;
        dsts[q] = dst; Ks[q] = K; k0s[q] = k0; n0s[q] = n0;
#pragma unroll
        for (int i = 0; i < 16; ++i) { const int e = tid + 256 * i, kk = e >> 6, nn = e & 63; v[q][i] = src[(size_t)(k0 + kk) * N + n0 + nn]; }
    }
#pragma unroll
    for (int q = 0; q < 4; ++q) {
#pragma unroll
        for (int i = 0; i < 16; ++i) { const int e = tid + 256 * i, kk = e >> 6, nn = e & 63; tileS[kk * 65 + nn] = v[q][i]; }
        hsync();
        const int n = tid >> 2, ks = (tid & 3) * 16;
        half8 o0, o1;
#pragma unroll
        for (int i = 0; i < 8; ++i) { o0[i] = (h16)tileS[(ks + i) * 65 + n]; o1[i] = (h16)tileS[(ks + 8 + i) * 65 + n]; }
        h16* d = dsts[q] + (size_t)(n0s[q] + n) * Ks[q] + k0s[q] + ks;
        *(half8*)d = o0; *(half8*)(d + 8) = o1;
        hsync();
    }
}
__device__ __forceinline__ void phase_prep(PRef p, char* smem) {
    weight_jobs(p, smem, true, 0);
    convert_job(p.peer_sub_keys, p.Keys, (size_t)2 * 8 * 2 * 128 * 128);
    convert_job(p.even_cmp_pos, p.Pos16, 2048);
    const int lane = tidx_() & 63, wv = bidx_() * 4 + widx_(), nwv = GRIDV * 4;
    for (int row = wv; row < TOK; row += nwv) {
        float v[16]; load_row16(p.x + (size_t)row * DM, v, lane);
        rms_write_h16(v, p.even_norm_g, p.HN + (size_t)row * DM, lane);
    }
}

enum { EPI_EVEN_IN = 0, EPI_F32_RESID = 1, EPI_H16 = 2, EPI_F32T = 3, EPI_QSCORE = 4 };
struct GemmArgs {
    const h16* A; int lda; const h16* Bt; int ldb; int M, N, K; int a_ntile_stride;
    int mode; h16* c16; int ldc16; float* c32; int ldc32; const float* resid; const h16* aux;
};
template <int MODE, int LDC>
__device__ __forceinline__ void gemm_epilogue(PRef p, const GemmArgs& g, int mt, int nt, bool sw, const f32x4 (&acc)[4][4]) {
    const int lane = tidx_() & 63, wid = widx_(), wm = wid >> 1, wn = wid & 1;
    const int l4 = (lane >> 4) * 4, l15 = lane & 15;
    if (MODE == EPI_EVEN_IN) {
        int kind;
        if (nt < 4 || (nt >= 12 && nt < 16)) kind = 0; else if (nt >= 8 && nt < 12) kind = 2; else if (nt == 19) kind = 3; else if (nt == 21) kind = 4; else if (nt == 22) kind = 5; else kind = 1;
#pragma unroll
        for (int i = 0; i < 4; ++i)
#pragma unroll
            for (int j = 0; j < 4; ++j) {
                const f32x4 v = acc[i][j];
                if (kind <= 1) {
                    const int row = mt * 128 + wm * 64 + j * 16 + l15, col = nt * 128 + wn * 64 + i * 16 + l4;
                    const float sc = kind == 0 ? QSCALE : 1.0f;
                    half4 o; o[0] = (h16)(v[0] * sc); o[1] = (h16)(v[1] * sc); o[2] = (h16)(v[2] * sc); o[3] = (h16)(v[3] * sc);
                    *(half4*)(p.Z + (size_t)row * ZLD + col) = o;
                } else if (kind <= 4) {
                    const int row = mt * 128 + wm * 64 + i * 16 + l4, col = nt * 128 + wn * 64 + j * 16 + l15;
                    const int b = row >> 12, s = row & 4095;
                    half4 o; o[0] = (h16)v[0]; o[1] = (h16)v[1]; o[2] = (h16)v[2]; o[3] = (h16)v[3];
                    h16* dst;
                    if (kind == 2) { const int c = col - 1024; dst = p.VtF + ((size_t)(b * 8 + (c >> 6)) * 64 + (c & 63)) * SEQ + s; }
                    else if (kind == 3) { const int c = col - 2432; dst = p.VtS + ((size_t)(b * 2 + (c >> 6)) * 64 + (c & 63)) * SEQ + s; }
                    else { const int c = col - 2688; dst = p.VtW + ((size_t)(b * 2 + (c >> 6)) * 64 + (c & 63)) * SEQ + s; }
                    *(half4*)dst = o;
                } else {
                    const int row = mt * 128 + wm * 64 + j * 16 + l15, c = nt * 128 + wn * 64 + i * 16 + l4 - 2816;
                    if (c < 32) {
                        f32x4 o;
                        if (c < 8) {
#pragma unroll
                            for (int q = 0; q < 4; ++q) o[q] = log_sigmoid(v[q] + p.even_b_f[c + q]) * LOG2E;
                        } else {
#pragma unroll
                            for (int q = 0; q < 4; ++q) o[q] = sigmoidf_(v[q]);
                        }
                        *(f32x4*)(p.FG + (size_t)row * 32 + c) = o;
                    }
                }
            }
    } else {
#pragma unroll
        for (int i = 0; i < 4; ++i)
#pragma unroll
            for (int j = 0; j < 4; ++j) {
                const f32x4 v = acc[i][j];
                if (MODE == EPI_F32T) {
                    const int row = mt * 128 + wm * 64 + i * 16 + l4, col = nt * 128 + wn * 64 + j * 16 + l15;
                    *(f32x4*)(g.c32 + (size_t)col * TOK + row) = v;
                } else {
                    const int row = mt * 128 + wm * 64 + j * 16 + l15, col = nt * 128 + wn * 64 + i * 16 + l4;
                    if (MODE == EPI_F32_RESID) {
                        const f32x4 r = *(const f32x4*)(g.resid + (size_t)row * LDC + col);
                        *(f32x4*)(g.c32 + (size_t)row * LDC + col) = r + v;
                    } else {
                        half4 o; o[0] = (h16)v[0]; o[1] = (h16)v[1]; o[2] = (h16)v[2]; o[3] = (h16)v[3];
                        *(half4*)(g.c16 + (size_t)row * LDC + col) = o;
                    }
                }
            }
    }
}

template <int MODE, int LDA, int LDB, int GN, int GK, int LDC, int ANS>
__device__ __forceinline__ void phase_gemm(PRef p, const GemmArgs& g, char* smem) {
    h16* As = (h16*)smem;
    h16* Bs = As + 2 * 128 * 64;
    const int tid = tidx_(), lane = tid & 63, wid = widx_(), wm = wid >> 1, wn = wid & 1;
    constexpr int nM = TOK / 128, nN = GN / 128, ntiles = nM * nN, nk = GK / 64;
    const int lr = tid >> 3, lc = tid & 7;
    const int st_off = lr * 64 + ((lc ^ ((tid >> 4) & 7)) * 8);
    const int fsw = (lane & 15) >> 1;
    const int fo0 = (lane & 15) * 64 + ((((lane >> 4)) ^ fsw) * 8), fo1 = (lane & 15) * 64 + (((4 + (lane >> 4)) ^ fsw) * 8);
    for (int tile = bidx_(); tile < ntiles; tile += GRIDV) {
        const int mt = tile / nN, nt = tile % nN;
        bool sw = (MODE != EPI_F32T);
        if (MODE == EPI_EVEN_IN) sw = !((nt >= 8 && nt < 12) || nt == 19 || nt == 21);
        const h16* Ag = g.A + (size_t)(mt * 128 + lr) * LDA + (size_t)nt * ANS + lc * 8;
        const h16* Bg = g.Bt + (size_t)(nt * 128 + lr) * LDB + lc * 8;
        constexpr size_t a32 = (size_t)32 * LDA, b32 = (size_t)32 * LDB;
        f32x4 acc[4][4];
#pragma unroll
        for (int m = 0; m < 4; ++m)
#pragma unroll
            for (int n = 0; n < 4; ++n) acc[m][n] = (f32x4){0.f, 0.f, 0.f, 0.f};
        half8 ra[4], rb[4];
#pragma unroll
        for (int i = 0; i < 4; ++i) { ra[i] = *(const half8*)(Ag + i * a32); rb[i] = *(const half8*)(Bg + i * b32); }
#pragma unroll
        for (int i = 0; i < 4; ++i) { *(half8*)(As + st_off + i * 32 * 64) = ra[i]; *(half8*)(Bs + st_off + i * 32 * 64) = rb[i]; }
        hsync();
        const int pofs = (sw ? wn : wm) * 64 * 64, qofs = (sw ? wm : wn) * 64 * 64;
        for (int kt = 0; kt < nk; ++kt) {
            const int cur = kt & 1;
            if (kt + 1 < nk) {
                const int ko = (kt + 1) * 64;
#pragma unroll
                for (int i = 0; i < 4; ++i) { ra[i] = *(const half8*)(Ag + i * a32 + ko); rb[i] = *(const half8*)(Bg + i * b32 + ko); }
            }
            const h16* Pc = (sw ? Bs : As) + cur * 128 * 64 + pofs;
            const h16* Qc = (sw ? As : Bs) + cur * 128 * 64 + qofs;
#pragma unroll
            for (int ks = 0; ks < 2; ++ks) {
                const int fo = ks ? fo1 : fo0;
                half8 pf[4], qf[4];
#pragma unroll
                for (int i = 0; i < 4; ++i) { pf[i] = *(const half8*)(Pc + i * 16 * 64 + fo); qf[i] = *(const half8*)(Qc + i * 16 * 64 + fo); }
                __builtin_amdgcn_s_setprio(1);
#pragma unroll
                for (int i = 0; i < 4; ++i)
#pragma unroll
                    for (int j = 0; j < 4; ++j) acc[i][j] = __builtin_amdgcn_mfma_f32_16x16x32_f16(pf[i], qf[j], acc[i][j], 0, 0, 0);
                __builtin_amdgcn_s_setprio(0);
            }
            if (kt + 1 < nk) {
                const int nx = (cur ^ 1) * 128 * 64;
#pragma unroll
                for (int i = 0; i < 4; ++i) { *(half8*)(As + nx + st_off + i * 32 * 64) = ra[i]; *(half8*)(Bs + nx + st_off + i * 32 * 64) = rb[i]; }
            }
            hsync();
        }
        if (MODE == EPI_QSCORE) {
            constexpr int QST = 136;
            h16* Qs = (h16*)smem;
            const int l4 = (lane >> 4) * 4, l15 = lane & 15;
#pragma unroll
            for (int i = 0; i < 4; ++i)
#pragma unroll
                for (int j = 0; j < 4; ++j) {
                    const f32x4 v = acc[i][j];
                    half4 o; o[0] = (h16)v[0]; o[1] = (h16)v[1]; o[2] = (h16)v[2]; o[3] = (h16)v[3];
                    *(half4*)(Qs + (wm * 64 + j * 16 + l15) * QST + wn * 64 + i * 16 + l4) = o;
                }
            hsync();
            f32x4 sc[4][4];
#pragma unroll
            for (int i = 0; i < 4; ++i)
#pragma unroll
                for (int j = 0; j < 4; ++j) sc[i][j] = (f32x4){0.f, 0.f, 0.f, 0.f};
            const h16* kb = g.aux + (size_t)(nt * 128 + wn * 64 + l15) * 128 + (lane >> 4) * 8;
#pragma unroll
            for (int ks = 0; ks < 4; ++ks) {
                half8 pf[4], qf[4];
#pragma unroll
                for (int i = 0; i < 4; ++i) { pf[i] = *(const half8*)(Qs + (wm * 64 + i * 16 + l15) * QST + ks * 32 + (lane >> 4) * 8); qf[i] = *(const half8*)(kb + (size_t)i * 16 * 128 + ks * 32); }
#pragma unroll
                for (int i = 0; i < 4; ++i)
#pragma unroll
                    for (int j = 0; j < 4; ++j) sc[i][j] = __builtin_amdgcn_mfma_f32_16x16x32_f16(pf[i], qf[j], sc[i][j], 0, 0, 0);
            }
#pragma unroll
            for (int i = 0; i < 4; ++i)
#pragma unroll
                for (int j = 0; j < 4; ++j) {
                    const int row = mt * 128 + wm * 64 + i * 16 + l4, col = nt * 128 + wn * 64 + j * 16 + l15;
                    *(f32x4*)(g.c32 + (size_t)col * TOK + row) = sc[i][j];
                }
            hsync();
        } else
        gemm_epilogue<MODE, LDC>(p, g, mt, nt, sw, acc);
    }
}

__device__ __forceinline__ void wp_unit(PRef p, int u) {
    const int lane = tidx_() & 63;
    {
        const int l = u >> 9, hc = (u >> 5) & 15, kh = (u >> 4) & 1, jt = u & 15;
        const float* wq = p.peer_w_q + (size_t)l * 1024 * 2048 + (size_t)(jt * 64 + (lane & 15)) * 2048 + hc * 128 + (lane >> 4) * 8;
        const h16* ky = p.Keys + ((size_t)(l * 16 + hc) * 128 + kh * 64 + (lane & 15)) * 128 + (lane >> 4) * 8;
        f32x4 acc[4][4];
#pragma unroll
        for (int a = 0; a < 4; ++a)
#pragma unroll
            for (int b = 0; b < 4; ++b) acc[a][b] = (f32x4){0.f, 0.f, 0.f, 0.f};
        f32x4 wv[4][4][2];
#pragma unroll
        for (int ks = 0; ks < 4; ++ks)
#pragma unroll
            for (int a = 0; a < 4; ++a) { wv[ks][a][0] = *(const f32x4*)(wq + (size_t)a * 16 * 2048 + ks * 32); wv[ks][a][1] = *(const f32x4*)(wq + (size_t)a * 16 * 2048 + ks * 32 + 4); }
#pragma unroll
        for (int ks = 0; ks < 4; ++ks) {
            half8 af[4], bf[4];
#pragma unroll
            for (int a = 0; a < 4; ++a) {
#pragma unroll
                for (int q = 0; q < 4; ++q) { af[a][q] = (h16)wv[ks][a][0][q]; af[a][4 + q] = (h16)wv[ks][a][1][q]; }
                bf[a] = *(const half8*)(ky + (size_t)a * 16 * 128 + ks * 32);
            }
#pragma unroll
            for (int a = 0; a < 4; ++a)
#pragma unroll
                for (int b = 0; b < 4; ++b) acc[a][b] = __builtin_amdgcn_mfma_f32_16x16x32_f16(af[a], bf[b], acc[a][b], 0, 0, 0);
        }
        h16* wp = p.WtQ + (size_t)l * 2048 * 1024;
#pragma unroll
        for (int a = 0; a < 4; ++a)
#pragma unroll
            for (int b = 0; b < 4; ++b) {
                const int n = hc * 128 + kh * 64 + b * 16 + (lane & 15), j0 = jt * 64 + a * 16 + (lane >> 4) * 4;
                const f32x4 gq = *(const f32x4*)(p.ffn_norm_g + l * DM + j0);
                half4 o; o[0] = (h16)(acc[a][b][0] * gq[0]); o[1] = (h16)(acc[a][b][1] * gq[1]); o[2] = (h16)(acc[a][b][2] * gq[2]); o[3] = (h16)(acc[a][b][3] * gq[3]);
                *(half4*)(wp + (size_t)n * 1024 + j0) = o;
            }
    }
}
__device__ __forceinline__ void phase_cumsum_compress(PRef p, char* smem) {
    const int lane = tidx_() & 63, wid = widx_(), vb = bidx_();
    if (vb >= 256 && vb < 264) {
        const int u = (vb - 256) * 4 + wid, b = u >> 3, h = u & 7;
        const float* src = p.FG + (size_t)(b * SEQ + lane * 64) * 32 + h;
        float loc[64]; float run = 0.f;
#pragma unroll
        for (int i = 0; i < 64; ++i) { run += src[(size_t)i * 32]; loc[i] = run; }
        float incl = run;
#pragma unroll
        for (int o = 1; o < 64; o <<= 1) { const float t = __shfl_up(incl, o); if (lane >= o) incl += t; }
        const float excl = incl - run;
        float* dst = p.C2 + (size_t)(b * 8 + h) * SEQ + lane * 64;
#pragma unroll
        for (int i = 0; i < 64; ++i) dst[i] = excl + loc[i];
    }
    if (vb < 256) {
        const int cu = vb, kv = cu >> 7, bg = (cu >> 4) & 7, nt = cu & 15;
        const int b = bg >> 1, g = bg & 1;
        int n = nt * 16 + (lane & 15); const int nc = n < 255 ? n : 254;
        const h16* Ab = p.Z + (size_t)(b * SEQ + 16 * nc) * ZLD + 1536 + kv * 128 + g * 64 + (lane >> 4) * 8;
        const h16* Wb = p.Wc + (size_t)kv * 64 * 2048 + (size_t)(lane & 15) * 2048 + (lane >> 4) * 8;
        const h16* Pb = p.Pos16 + (lane >> 4) * 8;
        f32x4 acc[4];
#pragma unroll
        for (int e = 0; e < 4; ++e) acc[e] = (f32x4){0.f, 0.f, 0.f, 0.f};
#pragma unroll
        for (int k2 = 0; k2 < 16; ++k2) {
            const int ks = wid * 16 + k2, l = ks >> 1, d0 = (ks & 1) * 32;
            half8 a = *(const half8*)(Ab + (size_t)l * ZLD + d0);
            const half8 ps = *(const half8*)(Pb + ks * 32);
            a = a + ps;
#pragma unroll
            for (int e = 0; e < 4; ++e) {
                const half8 w = *(const half8*)(Wb + (size_t)e * 16 * 2048 + ks * 32);
                acc[e] = __builtin_amdgcn_mfma_f32_16x16x32_f16(a, w, acc[e], 0, 0, 0);
            }
        }
        f32x4* part = (f32x4*)smem;
#pragma unroll
        for (int e = 0; e < 4; ++e) part[(wid * 4 + e) * 64 + lane] = acc[e];
        hsync();
        {
            const int e = wid;
            const f32x4 s = (part[(0 * 4 + e) * 64 + lane] + part[(1 * 4 + e) * 64 + lane]) + (part[(2 * 4 + e) * 64 + lane] + part[(3 * 4 + e) * 64 + lane]);
            const int n0 = nt * 16 + (lane >> 4) * 4, ec = e * 16 + (lane & 15);
            if (kv == 0) {
#pragma unroll
                for (int j = 0; j < 4; ++j) p.KC[((size_t)bg * 256 + n0 + j) * 64 + ec] = (n0 + j < 255) ? (h16)s[j] : (h16)0.f;
            } else {
                half4 o;
#pragma unroll
                for (int j = 0; j < 4; ++j) o[j] = (n0 + j < 255) ? (h16)s[j] : (h16)0.f;
                *(half4*)(p.VCt + ((size_t)bg * 64 + ec) * 256 + n0) = o;
            }
        }
        hsync();
    }
}

struct RowState { float m, l; f32x16 o0, o1; };
__device__ __forceinline__ void rs_reset(RowState& s) { s.m = NEGBIG; s.l = 0.f; s.o0 = zero16(); s.o1 = zero16(); }

__device__ __forceinline__ void kv_load(const h16* kb, int kst, const h16* vb, int vst, half8 (&kr)[2], half8 (&vr)[2]) {
    const int tid = tidx_();
#pragma unroll
    for (int i = 0; i < 2; ++i) {
        const int c = tid + 256 * i, row = c >> 3, cc = (c & 7) * 8;
        kr[i] = *(const half8*)(kb + (size_t)row * kst + cc);
        vr[i] = *(const half8*)(vb + (size_t)row * vst + cc);
    }
}
__device__ __forceinline__ void kv_store(h16* Ks, h16* Vs, const half8 (&kr)[2], const half8 (&vr)[2]) {
    const int tid = tidx_();
#pragma unroll
    for (int i = 0; i < 2; ++i) {
        const int c = tid + 256 * i, row = c >> 3, cc = (c & 7) * 8;
        *(half8*)(Ks + row * KST + cc) = kr[i];
        *(half8*)(Vs + row * KST + cc) = vr[i];
    }
}
__device__ __forceinline__ void qk_tile(const h16* Ks, const half8 (&qf)[4], f32x16 (&s)[2], int lane) {
    const int r32 = lane & 31, hh = lane >> 5;
#pragma unroll
    for (int kt = 0; kt < 2; ++kt) {
        s[kt] = zero16();
#pragma unroll
        for (int ks = 0; ks < 4; ++ks) {
            const half8 kf = *(const half8*)(Ks + (kt * 32 + r32) * KST + ks * 16 + hh * 8);
            s[kt] = __builtin_amdgcn_mfma_f32_32x32x16_f16(kf, qf[ks], s[kt], 0, 0, 0);
        }
    }
}
__device__ __forceinline__ void pv_tile(const h16* Vs, const f32x16 (&pr)[2], f32x16& o0, f32x16& o1, int lane) {
    const int r32 = lane & 31, hh = lane >> 5;
#pragma unroll
    for (int kt = 0; kt < 2; ++kt)
#pragma unroll
        for (int s2 = 0; s2 < 2; ++s2) {
            half8 pf;
#pragma unroll
            for (int j = 0; j < 8; ++j) pf[j] = (h16)pr[kt][8 * s2 + j];
            const int kof = kt * 32 + 16 * s2 + 4 * hh;
            {
                const half4 a = *(const half4*)(Vs + r32 * KST + kof), b = *(const half4*)(Vs + r32 * KST + kof + 8);
                half8 vf; vf[0] = a[0]; vf[1] = a[1]; vf[2] = a[2]; vf[3] = a[3]; vf[4] = b[0]; vf[5] = b[1]; vf[6] = b[2]; vf[7] = b[3];
                o0 = __builtin_amdgcn_mfma_f32_32x32x16_f16(vf, pf, o0, 0, 0, 0);
            }
            {
                const half4 a = *(const half4*)(Vs + (32 + r32) * KST + kof), b = *(const half4*)(Vs + (32 + r32) * KST + kof + 8);
                half8 vf; vf[0] = a[0]; vf[1] = a[1]; vf[2] = a[2]; vf[3] = a[3]; vf[4] = b[0]; vf[5] = b[1]; vf[6] = b[2]; vf[7] = b[3];
                o1 = __builtin_amdgcn_mfma_f32_32x32x16_f16(vf, pf, o1, 0, 0, 0);
            }
        }
}

enum { M_FOX = 0, M_SLC = 1, M_WIN = 2 };
template <int MODE, bool MASKED>
__device__ __forceinline__ void flash_step(const h16* Ks, const h16* Vs, const float* csS, const half8 (&qf)[4], RowState& st,
                                           int t, int kpos0, float slope2, float ct2, bool selbit, int lane) {
    const int hh = lane >> 5;
    f32x16 s[2];
    qk_tile(Ks, qf, s, lane);
    int dbase = t - kpos0 - 4 * hh;
    asm volatile("" : "+v"(dbase));
    const float off = (MODE == M_FOX) ? ct2 : -slope2 * (float)dbase;
    float mx = NEGBIG;
#pragma unroll
    for (int kt = 0; kt < 2; ++kt)
#pragma unroll
        for (int r = 0; r < 16; ++r) {
            const int c = kt * 32 + (r & 3) + 8 * (r >> 2);
            float v;
            if (MODE == M_FOX) v = s[kt][r] - csS[c + 4 * hh];
            else v = fmaf(slope2, (float)c, s[kt][r]);
            if (MASKED) {
                const int dist = dbase - c;
                bool valid;
                if (MODE == M_FOX) valid = dist >= 0; else if (MODE == M_SLC) valid = selbit && dist >= 0; else valid = dist >= 0 && dist < 512;
                v = valid ? v : NEGBIG;
            }
            s[kt][r] = v;
            mx = fmaxf(mx, v);
        }
    mx += off;
    mx = fmaxf(mx, __shfl_xor(mx, 32));
    const bool rowoff = (MODE == M_SLC) && !MASKED && !selbit;
    if (rowoff) mx = NEGBIG;
    const float mn = fmaxf(st.m, mx);
    const float alpha = __builtin_amdgcn_exp2f(st.m - mn);
    st.m = mn;
    const float moff = rowoff ? 1.0e30f : mn - off;
    float ps = 0.f;
#pragma unroll
    for (int kt = 0; kt < 2; ++kt)
#pragma unroll
        for (int r = 0; r < 16; ++r) {
            const float v = s[kt][r];
            float pe = __builtin_amdgcn_exp2f(v - moff);
            if (MASKED) pe = v > -1.0e29f ? pe : 0.f;
            s[kt][r] = pe; ps += pe;
        }
    st.l = st.l * alpha + ps;
#pragma unroll
    for (int r = 0; r < 16; ++r) { st.o0[r] *= alpha; st.o1[r] *= alpha; }
    pv_tile(Vs, s, st.o0, st.o1, lane);
}

template <int MODE>
__device__ __forceinline__ void run_flash(u64 mask, const h16* Kg, int kst, const h16* Vg, int vst, const float* csg, char* smem,
                                          const half8 (&qf)[4], RowState& st, int t, int twlo, int twhi, float slope2, float ct2, u64 sel, int lane) {
    h16* Kb = (h16*)smem; h16* Vb = Kb + 2 * 64 * KST; float* csb = (float*)(Vb + 2 * 64 * KST);
    if (mask == 0ull) return;
    half8 kr[2], vr[2]; float csr = 0.f;
    int jc = __builtin_ctzll(mask); mask &= mask - 1;
    kv_load(Kg + (size_t)jc * 64 * kst, kst, Vg + jc * 64, vst, kr, vr);
    if (MODE == M_FOX && tidx_() < 64) csr = csg[jc * 64 + tidx_()];
    kv_store(Kb, Vb, kr, vr);
    if (MODE == M_FOX && tidx_() < 64) csb[tidx_()] = csr;
    hsync();
    int buf = 0;
    for (;;) {
        int jn = -1;
        if (mask) { jn = __builtin_ctzll(mask); mask &= mask - 1; }
        if (jn >= 0) {
            kv_load(Kg + (size_t)jn * 64 * kst, kst, Vg + jn * 64, vst, kr, vr);
            if (MODE == M_FOX && tidx_() < 64) csr = csg[jn * 64 + tidx_()];
        }
        bool need = jc * 64 <= twhi;
        if (MODE == M_WIN) need = need && (jc * 64 + 63 >= twlo - 511);
        if (need) {
            const bool selbit = (sel >> jc) & 1ull;
            bool full = jc * 64 + 63 <= twlo;
            if (MODE == M_WIN) full = full && (jc * 64 > twhi - 512);
            if (full) flash_step<MODE, false>(Kb + buf * 64 * KST, Vb + buf * 64 * KST, csb + buf * 64, qf, st, t, jc * 64, slope2, ct2, selbit, lane);
            else flash_step<MODE, true>(Kb + buf * 64 * KST, Vb + buf * 64 * KST, csb + buf * 64, qf, st, t, jc * 64, slope2, ct2, selbit, lane);
        }
        if (jn >= 0) {
            kv_store(Kb + (buf ^ 1) * 64 * KST, Vb + (buf ^ 1) * 64 * KST, kr, vr);
            if (MODE == M_FOX && tidx_() < 64) csb[(buf ^ 1) * 64 + tidx_()] = csr;
        }
        hsync();
        if (jn < 0) break;
        jc = jn; buf ^= 1;
    }
}

__device__ __forceinline__ void load_q(const h16* qrow, half8 (&qf)[4], int lane) {
#pragma unroll
    for (int ks = 0; ks < 4; ++ks) qf[ks] = *(const half8*)(qrow + ks * 16 + (lane >> 5) * 8);
}
__device__ __forceinline__ void store_o(h16* orow, const f32x16& o0, const f32x16& o1, int lane) {
    const int hh = lane >> 5;
#pragma unroll
    for (int rg = 0; rg < 4; ++rg) {
        half4 a, b;
#pragma unroll
        for (int j = 0; j < 4; ++j) { a[j] = (h16)o0[4 * rg + j]; b[j] = (h16)o1[4 * rg + j]; }
        *(half4*)(orow + 8 * rg + 4 * hh) = a;
        *(half4*)(orow + 32 + 8 * rg + 4 * hh) = b;
    }
}

__device__ __forceinline__ void oacc_store(float* row, const f32x16& o0, const f32x16& o1, float sc, int lane) {
    const int hh = lane >> 5;
#pragma unroll
    for (int rg = 0; rg < 4; ++rg) {
        *(f32x4*)(row + 8 * rg + 4 * hh) = (f32x4){o0[4 * rg] * sc, o0[4 * rg + 1] * sc, o0[4 * rg + 2] * sc, o0[4 * rg + 3] * sc};
        *(f32x4*)(row + 32 + 8 * rg + 4 * hh) = (f32x4){o1[4 * rg] * sc, o1[4 * rg + 1] * sc, o1[4 * rg + 2] * sc, o1[4 * rg + 3] * sc};
    }
}
__device__ __forceinline__ void oacc_add(float* row, const f32x16& o0, const f32x16& o1, float sc, int lane) {
    const int hh = lane >> 5;
#pragma unroll
    for (int rg = 0; rg < 4; ++rg) {
        f32x4 a = *(const f32x4*)(row + 8 * rg + 4 * hh), b = *(const f32x4*)(row + 32 + 8 * rg + 4 * hh);
#pragma unroll
        for (int j = 0; j < 4; ++j) { a[j] += o0[4 * rg + j] * sc; b[j] += o1[4 * rg + j] * sc; }
        *(f32x4*)(row + 8 * rg + 4 * hh) = a; *(f32x4*)(row + 32 + 8 * rg + 4 * hh) = b;
    }
}
__device__ __forceinline__ void oacc_final(const float* row, h16* orow, const f32x16& o0, const f32x16& o1, float sc, int lane) {
    const int hh = lane >> 5;
#pragma unroll
    for (int rg = 0; rg < 4; ++rg) {
        const f32x4 a = *(const f32x4*)(row + 8 * rg + 4 * hh), b = *(const f32x4*)(row + 32 + 8 * rg + 4 * hh);
        half4 x, y;
#pragma unroll
        for (int j = 0; j < 4; ++j) { x[j] = (h16)(a[j] + o0[4 * rg + j] * sc); y[j] = (h16)(b[j] + o1[4 * rg + j] * sc); }
        *(half4*)(orow + 8 * rg + 4 * hh) = x; *(half4*)(orow + 32 + 8 * rg + 4 * hh) = y;
    }
}

__device__ __forceinline__ void fox_unit(PRef p, int b, int h, int qt, char* smem) {
    const int tid = tidx_(), lane = tid & 63, wid = widx_();
    const int q0 = qt * 128, t0w = q0 + wid * 32, t = t0w + (lane & 31);
    half8 qf[4]; load_q(p.Z + (size_t)(b * SEQ + t) * ZLD + h * 64, qf, lane);
    const float* csg = p.C2 + (size_t)(b * 8 + h) * SEQ;
    const float ct2 = csg[t];
    RowState st; rs_reset(st);
    const int jmax = (q0 + 127) >> 6;
    const u64 mask = (jmax >= 63) ? ~0ull : ((1ull << (jmax + 1)) - 1ull);
    run_flash<M_FOX>(mask, p.Z + (size_t)b * SEQ * ZLD + 512 + h * 64, ZLD, p.VtF + (size_t)(b * 8 + h) * 64 * SEQ, SEQ, csg, smem,
                     qf, st, t, t0w, t0w + 31, 0.f, ct2, 0ull, lane);
    const float lt = st.l + __shfl_xor(st.l, 32);
    const float inv = 1.0f / lt;
#pragma unroll
    for (int r = 0; r < 16; ++r) { st.o0[r] *= inv; st.o1[r] *= inv; }
    store_o(p.O + (size_t)(b * SEQ + t) * DM + h * 64, st.o0, st.o1, lane);
}

__device__ __forceinline__ void nsa_unit(PRef p, int b, int g, int qt32, char* smem) {
    const int tid = tidx_(), lane = tid & 63, wid = widx_(), hh = lane >> 5, r32 = lane & 31;
    const int t0 = qt32 * 32, t = t0 + r32, head = g * 4 + wid, bg = b * 2 + g;
    const float slope2 = exp2f(-(float)(head + 1)) * LOG2E;
    half8 qf[4]; load_q(p.Z + (size_t)(b * SEQ + t) * ZLD + 1024 + head * 64, qf, lane);
    const float* gp = p.FG + (size_t)(b * SEQ + t) * 32 + 8 + head * 3;
    const float gate_c = gp[0], gate_s = gp[1], gate_w = gp[2];
    h16* Kb = (h16*)smem; h16* Vb = Kb + 2 * 64 * KST;
    u64* selS = (u64*)(smem + 37376);
    u64* unS = selS + 32;
    float* oaccrow = p.OACC + (size_t)(b * SEQ + t) * 512 + head * 64;
    unsigned* impS = (unsigned*)(smem + 37888);
    {
        for (int i = tid; i < 32 * 64; i += NTHR) impS[i] = 0u;
        const int nsteps = ((t0 >> 4) >> 6) + 1;
        const h16* Kg = p.KC + (size_t)bg * 256 * 64; const h16* Vg = p.VCt + (size_t)bg * 64 * 256;
        float mrun = NEGBIG, lrun = 0.f;
        for (int i = 0; i < nsteps; ++i) {
            half8 kr[2], vr[2];
            kv_load(Kg + (size_t)i * 64 * 64, 64, Vg + i * 64, 256, kr, vr);
            kv_store(Kb, Vb, kr, vr);
            hsync();
            f32x16 s[2];
            qk_tile(Kb, qf, s, lane);
            float mx = NEGBIG;
            int dbase = t - 31 - 16 * (i * 64 + 4 * hh);
            asm volatile("" : "+v"(dbase));
#pragma unroll
            for (int kt = 0; kt < 2; ++kt)
#pragma unroll
                for (int r = 0; r < 16; ++r) {
                    const int dist = dbase - 16 * (kt * 32 + (r & 3) + 8 * (r >> 2));
                    float v = s[kt][r] - slope2 * (float)dist;
                    v = dist >= 0 ? v : NEGBIG;
                    s[kt][r] = v; mx = fmaxf(mx, v);
                }
            mx = fmaxf(mx, __shfl_xor(mx, 32));
            const float mn = fmaxf(mrun, mx), alpha = __builtin_amdgcn_exp2f(mrun - mn);
            mrun = mn;
            float ps = 0.f;
#pragma unroll
            for (int kt = 0; kt < 2; ++kt)
#pragma unroll
                for (int r = 0; r < 16; ++r) { const float v = s[kt][r]; ps += v > -1.0e29f ? __builtin_amdgcn_exp2f(v - mn) : 0.f; }
            lrun = lrun * alpha + ps;
            hsync();
        }
        const float lt = lrun + __shfl_xor(lrun, 32);
        const float inv = lt > 0.f ? 1.0f / lt : 0.f;
        f32x16 o0 = zero16(), o1 = zero16();
        float carry = 0.f;
        for (int i = 0; i < nsteps; ++i) {
            half8 kr[2], vr[2];
            kv_load(Kg + (size_t)i * 64 * 64, 64, Vg + i * 64, 256, kr, vr);
            kv_store(Kb, Vb, kr, vr);
            hsync();
            f32x16 s[2];
            qk_tile(Kb, qf, s, lane);
            int dbase = t - 31 - 16 * (i * 64 + 4 * hh);
            asm volatile("" : "+v"(dbase));
#pragma unroll
            for (int kt = 0; kt < 2; ++kt)
#pragma unroll
                for (int r = 0; r < 16; ++r) {
                    const int dist = dbase - 16 * (kt * 32 + (r & 3) + 8 * (r >> 2));
                    const float v = s[kt][r] - slope2 * (float)dist;
                    s[kt][r] = dist >= 0 ? __builtin_amdgcn_exp2f(v - mrun) * inv : 0.f;
                }
            float R[2][4];
#pragma unroll
            for (int kt = 0; kt < 2; ++kt)
#pragma unroll
                for (int rg = 0; rg < 4; ++rg) R[kt][rg] = __shfl_xor(s[kt][4 * rg + 3], 32);
#pragma unroll
            for (int kt = 0; kt < 2; ++kt)
#pragma unroll
                for (int rg = 0; rg < 4; ++rg) {
                    const float G = (s[kt][4 * rg] + s[kt][4 * rg + 1]) + (s[kt][4 * rg + 2] + s[kt][4 * rg + 3]);
                    const float prev = (kt == 0 && rg == 0) ? carry : (rg > 0 ? R[kt][rg - 1] : R[kt - 1][3]);
                    const float val = G + (hh ? R[kt][rg] : prev);
                    const int j = 16 * i + 8 * kt + 2 * rg + hh;
                    atomicAdd(&impS[r32 * 64 + j], (unsigned)(val * 67108864.0f + 0.5f));
                }
            carry = R[1][3];
            pv_tile(Vb, s, o0, o1, lane);
            hsync();
        }
        oacc_store(oaccrow, o0, o1, gate_c, lane);
    }
    hsync();
    {
        u64 un = 0ull;
        for (int i = 0; i < 8; ++i) {
            const int tok = wid * 8 + i, tt = t0 + tok, cur = tt >> 6;
            const int j = lane;
            const bool valid = j <= cur;
            const bool forced = (j == 0) || (j == cur) || (j == cur - 1);
            const unsigned key = valid ? impS[tok * 64 + j] + (forced ? 0x40000000u : 0u) : 0u;
            int rank = 0;
            for (int jj = 0; jj < 64; ++jj) {
                const unsigned kv = (unsigned)__builtin_amdgcn_readlane((int)key, jj);
                rank += (kv > key || (kv == key && jj < j)) ? 1 : 0;
            }
            const u64 selm = __ballot(valid && rank < 16);
            if (lane == 0) selS[tok] = selm;
            un |= selm;
        }
        if (lane == 0) unS[wid] = un;
    }
    hsync();
    const u64 mysel = selS[r32];
    const u64 un = unS[0] | unS[1] | unS[2] | unS[3];
    hsync();
    {
        RowState st; rs_reset(st);
        run_flash<M_SLC>(un, p.Z + (size_t)b * SEQ * ZLD + 1792 + g * 64, ZLD, p.VtS + (size_t)bg * 64 * SEQ, SEQ, nullptr, smem,
                         qf, st, t, t0, t0 + 31, slope2, 0.f, mysel, lane);
        const float lt = st.l + __shfl_xor(st.l, 32);
        oacc_add(oaccrow, st.o0, st.o1, gate_s / lt, lane);
    }
    {
        RowState st; rs_reset(st);
        const int lo = t0 - 511, jlo = lo > 0 ? (lo >> 6) : 0, jhi = (t0 + 31) >> 6;
        u64 mask = (jhi >= 63 ? ~0ull : ((1ull << (jhi + 1)) - 1ull)) & ~((1ull << jlo) - 1ull);
        run_flash<M_WIN>(mask, p.Z + (size_t)b * SEQ * ZLD + 1920 + g * 64, ZLD, p.VtW + (size_t)bg * 64 * SEQ, SEQ, nullptr, smem,
                         qf, st, t, t0, t0 + 31, slope2, 0.f, 0ull, lane);
        const float lt = st.l + __shfl_xor(st.l, 32);
        oacc_final(oaccrow, p.O + (size_t)(b * SEQ + t) * DM + 512 + head * 64, st.o0, st.o1, gate_w / lt, lane);
    }
}

__device__ __forceinline__ void phase_attention(PRef p, char* smem) {
    int* nxt = (int*)(smem + 65536 - 16);
    for (;;) {
        if (tidx_() == 0) *nxt = (int)__hip_atomic_fetch_add(p.BAR + XCD_BAR_WORDS_C, 1u, __ATOMIC_RELAXED, __HIP_MEMORY_SCOPE_AGENT);
        hsync();
        const int q = *nxt;
        hsync();
        if (q >= 2048 + 1604) break;
        int u = -1, e = -1;
        if (q < 3072) { if (q & 1) e = q >> 1; else u = q >> 1; }
        else if (q < 3140) e = 1536 + (q - 3072);
        else u = 1536 + (q - 3140);
        if (e >= 0) {
            if (e < 256) wp_unit(p, e * 4 + widx_());
            else if (e < 580) deferred_transpose_item(p, (float*)smem, (e - 256) * 4);
            else {
                const int c = e - 580, tbl = c >> 8, layer = tbl >> 1, rp0 = (c & 255) * 32 + widx_() * 8, lane = tidx_() & 63;
                const float* srcp = ((tbl & 1) ? p.peer_v : p.peer_u) + (size_t)layer * 16384 * 1024;
                unsigned char* dstp = ((tbl & 1) ? p.V8 : p.U8) + (size_t)layer * 16384 * 1024;
                float* sclp = ((tbl & 1) ? p.VS : p.US) + layer * 16384;
                for (int i = 0; i < 8; i += 2) { const int rps[2] = {rp0 + i, rp0 + i + 1}; fp6_rows<2>(srcp, dstp, sclp, rps, lane); }
            }
            continue;
        }
        const int st = 31 - (u >> 6), w = u & 63;
        if (w & 1) { const int idx = w >> 1; nsa_unit(p, (idx & 7) >> 1, idx & 1, st * 4 + (idx >> 3), smem); }
        else { const int idx = w >> 1; fox_unit(p, idx >> 3, idx & 7, st, smem); }
    }
}

__device__ __forceinline__ void phase_rmsnorm(PRef p, const float* g) {
    const int lane = tidx_() & 63, wv = bidx_() * 4 + widx_(), nwv = GRIDV * 4;
    for (int row = wv; row < TOK; row += nwv) {
        float v[16]; load_row16(p.H + (size_t)row * DM, v, lane);
        rms_write_h16(v, g, p.HN + (size_t)row * DM, lane);
    }
}

__device__ __forceinline__ unsigned fkey(float f) { const unsigned b = __float_as_uint(f); return b ^ ((b >> 31) ? 0xFFFFFFFFu : 0x80000000u); }
__device__ __forceinline__ float fkey_inv(unsigned k) { return __uint_as_float(k ^ ((k >> 31) ? 0x80000000u : 0xFFFFFFFFu)); }
__device__ __forceinline__ void ce_desc(unsigned& a, unsigned& b) { const unsigned hi = a > b ? a : b, lo = a > b ? b : a; a = hi; b = lo; }
__device__ __forceinline__ void sort16_desc(unsigned (&k)[16]) {
#pragma unroll
    for (int size = 2; size <= 16; size <<= 1)
#pragma unroll
        for (int stride = size >> 1; stride > 0; stride >>= 1)
#pragma unroll
            for (int i = 0; i < 16; ++i) {
                const int j = i ^ stride;
                if (j > i) { if ((i & size) == 0) ce_desc(k[i], k[j]); else ce_desc(k[j], k[i]); }
            }
}
__device__ __forceinline__ void merge16_desc(unsigned (&run)[16], const unsigned (&b)[16]) {
#pragma unroll
    for (int i = 0; i < 16; ++i) run[i] = run[i] > b[15 - i] ? run[i] : b[15 - i];
#pragma unroll
    for (int stride = 8; stride > 0; stride >>= 1)
#pragma unroll
        for (int i = 0; i < 16; ++i) { const int j = i ^ stride; if (j > i) ce_desc(run[i], run[j]); }
}
__device__ __forceinline__ void list_top16(const h16* __restrict__ base, unsigned (&run)[16]) {
    half8 cur0 = *(const half8*)base, cur1 = *(const half8*)(base + 512), nxt0 = cur0, nxt1 = cur1;
#pragma unroll 1
    for (int bt = 0; bt < 8; ++bt) {
        if (bt < 7) { nxt0 = *(const half8*)(base + (size_t)(2 * bt + 2) * 512); nxt1 = *(const half8*)(base + (size_t)(2 * bt + 3) * 512); }
        unsigned kb[16];
#pragma unroll
        for (int i = 0; i < 8; ++i) {
            kb[i] = (fkey((float)cur0[i]) & ~127u) | (unsigned)(127 - (bt * 16 + i));
            kb[8 + i] = (fkey((float)cur1[i]) & ~127u) | (unsigned)(127 - (bt * 16 + 8 + i));
        }
        sort16_desc(kb);
        if (bt == 0) {
#pragma unroll
            for (int i = 0; i < 16; ++i) run[i] = kb[i];
        } else merge16_desc(run, kb);
        cur0 = nxt0; cur1 = nxt1;
    }
}
__device__ __forceinline__ void phase_peer_topk(PRef p, char* smem) {
    const int tid = tidx_(), lane = tid & 63, wv = bidx_() * 4 + widx_(), nwv = GRIDV * 4;
    int* idS = (int*)smem; float* evS = (float*)smem + 16 * NTHR;
    for (int u = wv; u < 8 * (TOK / 64); u += nwv) {
        const int h = u >> 8, tk = (u & 255) * 64 + lane;
        const h16* b0 = p.SC + ((size_t)((tk >> 6) * 256 + h * 32) * 64 + lane) * 8;
        unsigned k0[16], k1[16];
        list_top16(b0, k0);
        list_top16(b0 + 16 * 512, k1);
        float v0[16], v1[16]; int i0[16], i1[16];
#pragma unroll
        for (int j = 0; j < 16; ++j) {
            v0[j] = fkey_inv(k0[j] & ~127u); i0[j] = 127 - (int)(k0[j] & 127u);
            v1[j] = fkey_inv(k1[j] & ~127u); i1[j] = 127 - (int)(k1[j] & 127u);
        }
        unsigned run[16];
        {
            unsigned kb[16]; int n = 0, nb = 0;
#pragma unroll
            for (int a = 0; a < 16; ++a)
#pragma unroll
                for (int b = 0; b < 16; ++b)
                    if ((a + 1) * (b + 1) <= 16) {
                        kb[n] = fkey(v0[a] + v1[b]); ++n;
                        if (n == 16) {
                            sort16_desc(kb);
                            if (nb == 0) {
#pragma unroll
                                for (int i = 0; i < 16; ++i) run[i] = kb[i];
                            } else merge16_desc(run, kb);
                            n = 0; ++nb;
                        }
                    }
#pragma unroll
            for (int i = 2; i < 16; ++i) kb[i] = 0u;
            sort16_desc(kb); merge16_desc(run, kb);
        }
        const unsigned tkey = run[15]; const float smax = fkey_inv(run[0]);
        int cnt = 0; float esum = 0.f;
#pragma unroll
        for (int j = 0; j < 16; ++j) { idS[j * NTHR + tid] = 0; evS[j * NTHR + tid] = 0.f; }
#pragma unroll
        for (int pass = 0; pass < 2; ++pass)
#pragma unroll
            for (int a = 0; a < 16; ++a)
#pragma unroll
                for (int b = 0; b < 16; ++b)
                    if ((a + 1) * (b + 1) <= 16) {
                        const float s = v0[a] + v1[b]; const unsigned ks = fkey(s);
                        const bool take = pass == 0 ? (ks > tkey) : (ks == tkey && cnt < 16);
                        if (take) {
                            const float e = __expf(s - smax);
                            idS[cnt * NTHR + tid] = i0[a] * 128 + i1[b]; evS[cnt * NTHR + tid] = e;
                            esum += e; ++cnt;
                        }
                    }
        const float rinv = 1.0f / esum;
        int* ip = p.IDS + (size_t)tk * 128 + h * 16; float* gp = p.GW + (size_t)tk * 128 + h * 16;
#pragma unroll
        for (int q = 0; q < 4; ++q) {
            *(i32x4*)(ip + 4 * q) = (i32x4){idS[(4 * q) * NTHR + tid], idS[(4 * q + 1) * NTHR + tid], idS[(4 * q + 2) * NTHR + tid], idS[(4 * q + 3) * NTHR + tid]};
            *(f32x4*)(gp + 4 * q) = (f32x4){evS[(4 * q) * NTHR + tid] * rinv, evS[(4 * q + 1) * NTHR + tid] * rinv, evS[(4 * q + 2) * NTHR + tid] * rinv, evS[(4 * q + 3) * NTHR + tid] * rinv};
        }
    }
}

struct Q6 { i32x4 a; i32x2 b; };
__device__ __forceinline__ Q6 ld6(const unsigned char* row, int g) { Q6 r; r.a = *(const i32x4*)(row + g * 16); r.b = *(const i32x2*)(row + 512 + g * 8); return r; }
__device__ __forceinline__ u32x6 mk6(const Q6 q) { u32x6 r; r[0] = q.a[0]; r[1] = q.a[1]; r[2] = q.a[2]; r[3] = q.a[3]; r[4] = q.b[0]; r[5] = q.b[1]; return r; }
__device__ __forceinline__ float dot32_fp6h(const h16x32 xv, const Q6 q) {
    const h16x32 uf = __builtin_amdgcn_cvt_scalef32_pk32_f16_fp6(mk6(q), 1.0f);
    float d0 = 0.f, d1 = 0.f;
#pragma unroll
    for (int m = 0; m < 16; m += 2) {
        d0 = __builtin_amdgcn_fdot2((half2v){uf[2 * m], uf[2 * m + 1]}, (half2v){xv[2 * m], xv[2 * m + 1]}, d0, false);
        d1 = __builtin_amdgcn_fdot2((half2v){uf[2 * m + 2], uf[2 * m + 3]}, (half2v){xv[2 * m + 2], xv[2 * m + 3]}, d1, false);
    }
    return d0 + d1;
}
__device__ __forceinline__ void axpy32_fp6(f32x2 (&acc)[16], float w, const Q6 q) {
    const f32x32 vf = __builtin_amdgcn_cvt_scalef32_pk32_f32_fp6(mk6(q), 1.0f);
    const f32x2 ww = {w, w};
#pragma unroll
    for (int m = 0; m < 16; ++m) acc[m] = __builtin_elementwise_fma(ww, (f32x2){vf[2 * m], vf[2 * m + 1]}, acc[m]);
}
constexpr int ET_SHIFT = 9, ET_N = 16384 >> ET_SHIFT;
__device__ __forceinline__ void phase_peer_experts(PRef p, int layer, const float* gnext, int mode, char* smem) {
    const int lane = tidx_() & 63, wid = widx_(), wv = bidx_() * 4 + wid, nwv = GRIDV * 4;
    const int hh = lane >> 5, g = lane & 31, dpl = (lane >> 2) & 7;
    const unsigned char* U = p.U8 + (size_t)layer * 16384 * 1024; const unsigned char* V = p.V8 + (size_t)layer * 16384 * 1024;
    const float* US = p.US + layer * 16384; const float* VS = p.VS + layer * 16384;
    const bool b4 = (lane & 16) != 0, b3 = (lane & 8) != 0, b2 = (lane & 4) != 0;
    int* sid = (int*)smem + wid * 512 + hh * 128;
    float* sgw = (float*)(sid + 256);
    for (int tb = wv * 2; tb < TOK; tb += nwv * 2) {
        const int tk = tb + hh;
        h16x32 xv;
        {
            half4 hx[8]; float ssx = 0.f;
#pragma unroll
            for (int c = 0; c < 8; ++c) {
                hx[c] = *(const half4*)(p.H + (size_t)tk * DM + c * 128 + g * 4);
                const float a0 = (float)hx[c][0], a1 = (float)hx[c][1], a2 = (float)hx[c][2], a3 = (float)hx[c][3];
                ssx += (a0 * a0 + a1 * a1) + (a2 * a2 + a3 * a3);
            }
#pragma unroll
            for (int o = 16; o > 0; o >>= 1) ssx += __shfl_xor(ssx, o);
            const float rstdx = rsqrtf(ssx * (1.0f / 1024.0f) + 1e-6f);
            const float* gx = p.ffn_norm_g + layer * DM + g * 4;
#pragma unroll
            for (int c = 0; c < 8; ++c) {
                const f32x4 ga = *(const f32x4*)(gx + c * 128);
#pragma unroll
                for (int j = 0; j < 4; ++j) xv[4 * c + j] = (h16)((float)hx[c][j] * rstdx * ga[j]);
            }
        }
        {
            int idv[4]; float gv[4];
#pragma unroll
            for (int s = 0; s < 4; ++s) { idv[s] = p.IDS[(size_t)tk * 128 + s * 32 + g]; gv[s] = p.GW[(size_t)tk * 128 + s * 32 + g]; }
            int cnt = 0;
            const unsigned below = (1u << g) - 1u;
            for (int e = 0; e < ET_N; ++e) {
#pragma unroll
                for (int s = 0; s < 4; ++s) {
                    const bool in = (idv[s] >> ET_SHIFT) == e;
                    const u64 m = __ballot(in);
                    const unsigned mh = hh ? (unsigned)(m >> 32) : (unsigned)m;
                    if (in) { const int pos = cnt + __popc(mh & below); sid[pos] = idv[s]; sgw[pos] = gv[s]; }
                    cnt += __popc(mh);
                }
            }
        }
        f32x2 acc[16];
#pragma unroll
        for (int i = 0; i < 16; ++i) acc[i] = (f32x2){0.f, 0.f};
        for (int bt = 0; bt < 16; ++bt) {
            const int mine = sid[bt * 8 + dpl]; const float gwm = sgw[bt * 8 + dpl];
            const float usm = US[mine], vsm = VS[mine];
            const i32x4 ida = *(const i32x4*)(sid + bt * 8), idb = *(const i32x4*)(sid + bt * 8 + 4);
            Q6 uq[8], vq[8];
#pragma unroll
            for (int k = 0; k < 8; ++k) {
                const unsigned off = (unsigned)(k < 4 ? ida[k & 3] : idb[k & 3]) * ROW6;
                uq[k] = ld6(U + off, g); vq[k] = ld6(V + off, g);
            }
            float d[8];
#pragma unroll
            for (int k = 0; k < 8; ++k) d[k] = dot32_fp6h(xv, uq[k]);
            float r4[4], r2[2], z;
#pragma unroll
            for (int i = 0; i < 4; ++i) { const float keep = b4 ? d[i + 4] : d[i], send = b4 ? d[i] : d[i + 4]; r4[i] = keep + __shfl_xor(send, 16); }
#pragma unroll
            for (int i = 0; i < 2; ++i) { const float keep = b3 ? r4[i + 2] : r4[i], send = b3 ? r4[i] : r4[i + 2]; r2[i] = keep + __shfl_xor(send, 8); }
            { const float keep = b2 ? r2[1] : r2[0], send = b2 ? r2[0] : r2[1]; z = keep + __shfl_xor(send, 4); }
            z += __shfl_xor(z, 2); z += __shfl_xor(z, 1);
            const float wm = gwm * gelu_exact(z * usm) * vsm;
#pragma unroll
            for (int k = 0; k < 8; ++k) {
                const float w0 = __builtin_bit_cast(float, __builtin_amdgcn_readlane(__builtin_bit_cast(int, wm), 4 * k));
                const float w1 = __builtin_bit_cast(float, __builtin_amdgcn_readlane(__builtin_bit_cast(int, wm), 32 + 4 * k));
                axpy32_fp6(acc, hh ? w1 : w0, vq[k]);
            }
        }
        float hv[32];
        {
            const h16* hr = p.H + (size_t)tk * DM + g * 4;
#pragma unroll
            for (int c = 0; c < 8; ++c) { const half4 t = *(const half4*)(hr + c * 128); hv[4 * c] = (float)t[0] + acc[2 * c][0]; hv[4 * c + 1] = (float)t[1] + acc[2 * c][1]; hv[4 * c + 2] = (float)t[2] + acc[2 * c + 1][0]; hv[4 * c + 3] = (float)t[3] + acc[2 * c + 1][1]; }
        }
        float ss = 0.f;
#pragma unroll
        for (int i = 0; i < 32; ++i) ss += hv[i] * hv[i];
#pragma unroll
        for (int o = 16; o > 0; o >>= 1) ss += __shfl_xor(ss, o);
        const float rstd = rsqrtf(ss * (1.0f / 1024.0f) + 1e-6f);
        const float* gr = gnext + g * 4;
        if (mode == 0) {
            h16* hw = p.H + (size_t)tk * DM + g * 4;
#pragma unroll
            for (int c = 0; c < 8; ++c) {
                { half4 t; t[0] = (h16)hv[4 * c]; t[1] = (h16)hv[4 * c + 1]; t[2] = (h16)hv[4 * c + 2]; t[3] = (h16)hv[4 * c + 3]; *(half4*)(hw + c * 128) = t; }
                const f32x4 ga = *(const f32x4*)(gr + c * 128);
                half4 o;
#pragma unroll
                for (int j = 0; j < 4; ++j) o[j] = (h16)(hv[4 * c + j] * rstd * ga[j]);
                *(half4*)(p.HN + (size_t)tk * DM + c * 128 + g * 4) = o;
            }
        } else {
            float* ow = p.out + (size_t)tk * DM + g * 4;
#pragma unroll
            for (int c = 0; c < 8; ++c) { const f32x4 ga = *(const f32x4*)(gr + c * 128); *(f32x4*)(ow + c * 128) = (f32x4){hv[4 * c] * rstd * ga[0], hv[4 * c + 1] * rstd * ga[1], hv[4 * c + 2] * rstd * ga[2], hv[4 * c + 3] * rstd * ga[3]}; }
        }
    }
}

constexpr int XST = 136;
__device__ __forceinline__ float fast_sigmoid(float v) { return __builtin_amdgcn_rcpf(1.0f + __expf(-v)); }
__device__ __forceinline__ float gelu_as(float v) {
    const float av = fabsf(v), t = __builtin_amdgcn_rcpf(av * 0.2316419f + 1.0f);
    float q = t * 0.5307027145f - 0.7265760135f; q = q * t + 0.7107068705f; q = q * t - 0.142248368f; q = q * t + 0.127414796f; q = q * t;
    const float e = __builtin_amdgcn_exp2f(v * v * -0.72134752044f);
    const float m = v * (q * e);
    return v < 0.f ? m : v - m;
}
__device__ __forceinline__ void phase_rnn_gates(PRef p, char* smem) {
    h16* xcS = (h16*)smem;
    float* aggS = (float*)(smem + 64 * XST * 2);
    h16* laS = (h16*)(smem + 64 * XST * 2 + 4096);
    h16* ruS = laS + 64 * XST;
    const int tid = tidx_(), lane = tid & 63, wid = widx_();
    for (int u = bidx_(); u < 4 * 64 * 10; u += GRIDV) {
        const int nb = u % 10, ck = (u / 10) & 63, b = u / 640;
        const int s0 = ck * 64, ch0 = nb * 128;
        {
            const int c8 = (tid & 15) * 8, tq = (tid >> 4) * 4, ch = ch0 + c8;
            float w[4][8], bias[8];
#pragma unroll
            for (int j = 0; j < 4; ++j) {
                const f32x4 w0 = *(const f32x4*)(p.odd_conv_w + j * DRNN + ch), w1 = *(const f32x4*)(p.odd_conv_w + j * DRNN + ch + 4);
#pragma unroll
                for (int i = 0; i < 4; ++i) { w[j][i] = w0[i]; w[j][4 + i] = w1[i]; }
            }
            { const f32x4 b0 = *(const f32x4*)(p.odd_conv_b + ch), b1 = *(const f32x4*)(p.odd_conv_b + ch + 4);
#pragma unroll
              for (int i = 0; i < 4; ++i) { bias[i] = b0[i]; bias[4 + i] = b1[i]; } }
            half8 xin[7];
#pragma unroll
            for (int r = 0; r < 7; ++r) {
                const int sp = s0 + tq - 3 + r;
                if (sp >= 0) xin[r] = *(const half8*)(p.Z2 + (size_t)(b * SEQ + sp) * Z2LD + DRNN + ch);
                else {
#pragma unroll
                    for (int i = 0; i < 8; ++i) xin[r][i] = (h16)0.f;
                }
            }
#pragma unroll
            for (int tt = 0; tt < 4; ++tt) {
                half8 o;
#pragma unroll
                for (int i = 0; i < 8; ++i) {
                    float a = bias[i];
#pragma unroll
                    for (int j = 0; j < 4; ++j) a = fmaf(w[j][i], (float)xin[tt + j][i], a);
                    o[i] = (h16)a;
                }
                *(half8*)(xcS + (tq + tt) * XST + c8) = o;
            }
        }
        hsync();
        float bra2[2], bri2[2], sp2[2];
#pragma unroll
        for (int e = 0; e < 2; ++e) {
            const int chq = ch0 + (wid * 2 + e) * 16 + (lane & 15);
            bra2[e] = p.odd_b_ra[chq]; bri2[e] = p.odd_b_ri[chq]; sp2[e] = p.odd_lam[chq];
        }
#pragma unroll
        for (int e = 0; e < 2; ++e) sp2[e] = fmaxf(-sp2[e], 0.f) + __logf(1.0f + __expf(-fabsf(sp2[e])));
        f32x4 ar[4][2], ai[4][2];
#pragma unroll
        for (int m = 0; m < 4; ++m)
#pragma unroll
            for (int e = 0; e < 2; ++e) { ar[m][e] = (f32x4){0.f, 0.f, 0.f, 0.f}; ai[m][e] = (f32x4){0.f, 0.f, 0.f, 0.f}; }
        const h16* wr = p.Wr + (size_t)nb * 16384 + (wid * 32 + (lane & 15)) * 128 + (lane >> 4) * 8;
        const h16* wi = p.Wr + (size_t)(10 + nb) * 16384 + (wid * 32 + (lane & 15)) * 128 + (lane >> 4) * 8;
#pragma unroll
        for (int ks = 0; ks < 4; ++ks) {
            half8 a[4];
#pragma unroll
            for (int m = 0; m < 4; ++m) a[m] = *(const half8*)(xcS + (m * 16 + (lane & 15)) * XST + ks * 32 + (lane >> 4) * 8);
#pragma unroll
            for (int e = 0; e < 2; ++e) {
                const half8 w1 = *(const half8*)(wr + e * 16 * 128 + ks * 32), w2 = *(const half8*)(wi + e * 16 * 128 + ks * 32);
#pragma unroll
                for (int m = 0; m < 4; ++m) {
                    ar[m][e] = __builtin_amdgcn_mfma_f32_16x16x32_f16(a[m], w1, ar[m][e], 0, 0, 0);
                    ai[m][e] = __builtin_amdgcn_mfma_f32_16x16x32_f16(a[m], w2, ai[m][e], 0, 0, 0);
                }
            }
        }
        const int g4 = lane >> 4;
#pragma unroll
        for (int e = 0; e < 2; ++e) {
            const int cl = (wid * 2 + e) * 16 + (lane & 15);
            const float bra = bra2[e], bri = bri2[e], sp = sp2[e];
            float Ac = 1.f, Hc = 0.f;
#pragma unroll
            for (int m = 0; m < 4; ++m) {
                float A = 1.f, H = 0.f;
#pragma unroll
                for (int j = 0; j < 4; ++j) {
                    const int tt = m * 16 + g4 * 4 + j;
                    const float r = fast_sigmoid(ar[m][e][j] + bra), ig = fast_sigmoid(ai[m][e][j] + bri);
                    const h16 la16 = (h16)(-8.0f * r * sp);
                    const float a = __expf((float)la16);
                    const float xc = (float)xcS[tt * XST + cl];
                    const h16 u16 = (h16)(__builtin_amdgcn_sqrtf(fmaxf(1.0f - a * a, 0.f)) * (ig * xc));
                    laS[tt * XST + cl] = la16; ruS[tt * XST + cl] = u16;
                    H = a * H + (float)u16; A *= a;
                }
                { const float Al = __shfl_xor(A, 16), Hl = __shfl_xor(H, 16); if (g4 & 1) { H = Hl * A + H; A = Al * A; } }
                { const float Al = __shfl_xor(A, 32), Hl = __shfl_xor(H, 32); if (g4 == 3) { H = Hl * A + H; A = Al * A; } }
                Hc = Hc * A + H; Ac *= A;
            }
            if (g4 == 3) { p.AggP[(size_t)(b * 64 + ck) * DRNN + ch0 + cl] = Ac; p.AggH[(size_t)(b * 64 + ck) * DRNN + ch0 + cl] = Hc; }
        }
        hsync();
#pragma unroll
        for (int i = 0; i < 4; ++i) {
            const int q = tid + 256 * i, row = q >> 4, c8 = (q & 15) * 8;
            const size_t o = (size_t)(b * SEQ + s0 + row) * DRNN + ch0 + c8;
            *(half8*)(p.LA + o) = *(const half8*)(laS + row * XST + c8);
            *(half8*)(p.RU + o) = *(const half8*)(ruS + row * XST + c8);
        }
    }
}
__device__ __forceinline__ void phase_rnn_scan_b(PRef p) {
    for (int u = bidx_(); u < 4 * 64 * 5; u += GRIDV) {
        const int cb = u % 5, ck = (u / 5) & 63, b = u / 320;
        const int ch = cb * 256 + tidx_();
        float h = 0.f;
        {
            const float* ap = p.AggP + (size_t)(b * 64) * DRNN + ch; const float* hp = p.AggH + (size_t)(b * 64) * DRNN + ch;
            for (int c = 0; c < ck; c += 16) {
                float pa[16], ph[16];
#pragma unroll
                for (int i = 0; i < 16; ++i) { const int ci = min(c + i, ck - 1); pa[i] = ap[(size_t)ci * DRNN]; ph[i] = hp[(size_t)ci * DRNN]; }
#pragma unroll
                for (int i = 0; i < 16; ++i) { const bool ok = c + i < ck; h = (ok ? pa[i] : 1.0f) * h + (ok ? ph[i] : 0.f); }
            }
        }
        const size_t base = (size_t)(b * SEQ + ck * 64) * DRNN + ch;
        h16* zrow = p.Z2 + (size_t)(b * SEQ + ck * 64) * Z2LD;
#pragma unroll 1
        for (int i0 = 0; i0 < 64; i0 += 32) {
            h16 la[32], uu[32], gt[32];
#pragma unroll
            for (int i = 0; i < 32; ++i) { la[i] = p.LA[base + (size_t)(i0 + i) * DRNN]; uu[i] = p.RU[base + (size_t)(i0 + i) * DRNN]; gt[i] = zrow[(size_t)(i0 + i) * Z2LD + ch]; }
#pragma unroll
            for (int i = 0; i < 32; ++i) {
                h = __expf((float)la[i]) * h + (float)uu[i];
                zrow[(size_t)(i0 + i) * Z2LD + DRNN + ch] = (h16)(gelu_as((float)gt[i]) * h);
            }
        }
    }
}

#define XB_TMO      128
#define XB_XCNT(j)  (256  + 64 * (j))
#define XB_XSUB(j)  (1280 + 64 * (j))
#define XB_XGEN(j)  (2304 + 64 * (j))
#define XB_TOP      3328
#define XB_TOPGEN   3392
#define XCD_BAR_WORDS 3456
#define XB_SPIN_CAP (1u << 22)
__device__ __forceinline__ unsigned xb_ld(unsigned* p)              { return __hip_atomic_load(p, __ATOMIC_RELAXED, __HIP_MEMORY_SCOPE_AGENT); }
__device__ __forceinline__ unsigned xb_add(unsigned* p, unsigned v) { return __hip_atomic_fetch_add(p, v, __ATOMIC_RELAXED, __HIP_MEMORY_SCOPE_AGENT); }
__device__ __forceinline__ unsigned xb_xcc_id() { return (unsigned)__builtin_amdgcn_s_getreg((3 << 11) | 20) & 0xFu; }
#define XB_SPIN(cond, bar) do { unsigned _sp = 0; while (cond) { __builtin_amdgcn_s_sleep(1); \
    if ((++_sp & 255u) == 0u) { if (xb_ld(&(bar)[XB_TMO])) break; if (_sp > XB_SPIN_CAP) { atomicAdd(&(bar)[XB_TMO], 1u); break; } } } } while (0)
struct XcdBarrier { unsigned* bar; unsigned x; volatile LAS unsigned* st; };
__device__ __forceinline__ XcdBarrier xcd_barrier_post(unsigned* bar, volatile LAS unsigned* st) {
    XcdBarrier b; b.bar = bar; b.x = xb_xcc_id(); b.st = st;
    if (threadIdx.x == 0) (void)xb_add(&bar[XB_XCNT(b.x)], 1u);
    return b;
}
__device__ __forceinline__ void xcd_barrier_complete(unsigned* bar, unsigned x, unsigned& nloc, unsigned& nx) {
    const unsigned G = gridDim.x * gridDim.y * gridDim.z;
    unsigned sum, cnt, mine, sp = 0u;
    for (;;) {
        sum = 0u; cnt = 0u; mine = 0u;
#pragma unroll
        for (unsigned j = 0; j < 16; ++j) { const unsigned c = xb_ld(&bar[XB_XCNT(j)]); sum += c; cnt += (c > 0u) ? 1u : 0u; mine = (j == x) ? c : mine; }
        if (sum == G) break;
        __builtin_amdgcn_s_sleep(1);
        if ((++sp & 255u) == 0u) { if (xb_ld(&bar[XB_TMO])) break; if (sp > XB_SPIN_CAP) { atomicAdd(&bar[XB_TMO], 1u); break; } }
    }
    nloc = mine > 0u ? mine : 1u; nx = cnt > 0u ? cnt : 1u;
}
__device__ __forceinline__ void xcd_barrier(const XcdBarrier& b) {
    asm volatile("s_waitcnt vmcnt(0)" ::: "memory");
    __syncthreads();
    if (threadIdx.x == 0) {
        unsigned* bar = b.bar;
        __builtin_amdgcn_s_waitcnt(0);
        unsigned nloc = b.st[0], nx = b.st[1];
        if (nloc == 0u) { xcd_barrier_complete(bar, b.x, nloc, nx); b.st[0] = nloc; b.st[1] = nx; }
        const unsigned old = xb_add(&bar[XB_XSUB(b.x)], 1u);
        const unsigned gen = old / nloc;
        if (old + 1u == (gen + 1u) * nloc) {
            __builtin_amdgcn_fence(__ATOMIC_RELEASE, "agent");
            asm volatile("s_waitcnt vmcnt(0)" ::: "memory");
            const unsigned og = xb_add(&bar[XB_TOP], 1u);
            const unsigned tg = og / nx;
            if (og + 1u == (tg + 1u) * nx) xb_add(&bar[XB_TOPGEN], 1u);
            else XB_SPIN(xb_ld(&bar[XB_TOPGEN]) == tg, bar);
            __builtin_amdgcn_fence(__ATOMIC_ACQUIRE, "agent");
            xb_add(&bar[XB_XGEN(b.x)], 1u);
            asm volatile("s_waitcnt vmcnt(0)" ::: "memory");
        } else {
            XB_SPIN(xb_ld(&bar[XB_XGEN(b.x)]) == gen, bar);
            __builtin_amdgcn_fence(__ATOMIC_ACQUIRE, "agent");
            asm volatile("s_waitcnt vmcnt(0)" ::: "memory");
        }
    }
    __syncthreads();
}

namespace pg8 {
#define PG8_LAS __attribute__((address_space(3)))
typedef unsigned short bf16_t;
typedef short bf16x8 __attribute__((ext_vector_type(8)));
typedef unsigned u32x4 __attribute__((ext_vector_type(4)));
constexpr int BM = 256, BK = 64, HALF = 128, HTB = HALF * BK * 2  , STAGE_BYTES = 8 * HTB, NXCD = 8, WGM = 8;

__host__ __device__ __forceinline__ int lds_byte(int r, int c) { const int st = (r >> 4) * 2 + (c >> 5), rr = r & 15, cc = c & 31, ob = rr * 64 + cc * 2; return st * 1024 + (ob ^ (((ob >> 9) & 1) << 5)); }
__host__ __device__ __forceinline__ void stage_rc(int b, int& R, int& C) { const int st = b / 1024, sb = b % 1024, swz = sb ^ (((sb >> 9) & 1) << 5); R = (st >> 1) * 16 + swz / 64; C = (st & 1) * 32 + (swz % 64) / 2; }
__host__ __device__ __forceinline__ int perm32(int rho) { const int n = rho >> 4, i = rho & 15; return 8 * (i >> 2) + 4 * n + (i & 3); }

struct Unit { int pm, pn; };
struct Gemm { const bf16_t* A; const bf16_t* Bt; int M, N, K, lda; };

struct StaticOrder {
    int nM, nN, nwg, G, c;
    __host__ __device__ void init(int M, int N, int G_, int c_) { nM = M / BM; nN = N / BM; nwg = nM * nN; G = G_; c = c_; }
    __host__ __device__ bool next(int i, Unit& u) const {
        const long L = (long)i * G + c; if (L >= nwg) return false;
        int wgid = (int)L; { const int q = nwg / NXCD, r = nwg % NXCD, xcd = wgid % NXCD, off = wgid / NXCD; wgid = (xcd < r ? xcd * (q + 1) : r * (q + 1) + (xcd - r) * q) + off; }
        const int nig = WGM * nN, gid = wgid / nig, fm = gid * WGM, gsz = (nM - fm) < WGM ? (nM - fm) : WGM;
        u.pm = fm + ((wgid % nig) % gsz); u.pn = (wgid % nig) / gsz; return true;
    }
    __device__ __forceinline__ void a_ready(const Unit&) const {}
    __device__ __forceinline__ void done(const Unit&) const {}
};
__device__ __forceinline__ unsigned pk_h16(float lo, float hi) { half2v t; t[0] = (h16)lo; t[1] = (h16)hi; return __builtin_bit_cast(unsigned, t); }
template <bool R16>
struct EpiResid {
    static constexpr bool PERM = true, AFTER_DRAIN = false;
    const void* resid; h16* out; float* ssq; int ldc;
    __device__ __forceinline__ void operator()(const f32x4 (&acc)[2][2][4][2], const Unit& u, int wr, int wc, int fr, int fq) const {
#pragma unroll
        for (int ai = 0; ai < 2; ++ai)
#pragma unroll
            for (int m = 0; m < 4; ++m) { const int row = u.pm * BM + ai * HALF + wr * 64 + m * 16 + fr; const size_t ro = (size_t)row * ldc + u.pn * BM + wc * 32 + 8 * fq;
                float ss = 0.f;
#pragma unroll
                for (int bj = 0; bj < 2; ++bj) { const size_t o = ro + bj * HALF;
                    f32x4 v0 = acc[ai][bj][m][0], v1 = acc[ai][bj][m][1];
                    if (R16) { const half8 r = *(const half8*)((const h16*)resid + o);
#pragma unroll
                        for (int i = 0; i < 4; ++i) { v0[i] += (float)r[i]; v1[i] += (float)r[4 + i]; } }
                    else { v0 += *(const f32x4*)((const float*)resid + o); v1 += *(const f32x4*)((const float*)resid + o + 4); }
                    ss += ((v0[0] * v0[0] + v0[1] * v0[1]) + (v0[2] * v0[2] + v0[3] * v0[3])) + ((v1[0] * v1[0] + v1[1] * v1[1]) + (v1[2] * v1[2] + v1[3] * v1[3]));
                    u32x4 w; w.x = pk_h16(v0[0], v0[1]); w.y = pk_h16(v0[2], v0[3]); w.z = pk_h16(v1[0], v1[1]); w.w = pk_h16(v1[2], v1[3]);
                    *(u32x4*)(out + o) = w; }
                ss += __shfl_xor(ss, 16); ss += __shfl_xor(ss, 32);
                if (fq == 0) ssq[(size_t)row * 16 + u.pn * 4 + wc] = ss; }
    }
};
struct EpiF32 {
    static constexpr bool PERM = false, AFTER_DRAIN = false;
    float* out; size_t ldc;
    __device__ __forceinline__ void operator()(const f32x4 (&acc)[2][2][4][2], const Unit& u, int wr, int wc, int fr, int fq) const {
#pragma unroll
        for (int ai = 0; ai < 2; ++ai)
#pragma unroll
            for (int m = 0; m < 4; ++m) { const size_t ro = (size_t)(u.pm * BM + ai * HALF + wr * 64 + m * 16 + fr) * ldc + u.pn * BM + wc * 32 + 4 * fq;
#pragma unroll
                for (int bj = 0; bj < 2; ++bj)
#pragma unroll
                    for (int n = 0; n < 2; ++n) *(f32x4*)(out + ro + bj * HALF + n * 16) = acc[ai][bj][m][n]; }
    }
};
struct EpiH16 {
    static constexpr bool PERM = true, AFTER_DRAIN = false;
    h16* out; int ldc;
    __device__ __forceinline__ void operator()(const f32x4 (&acc)[2][2][4][2], const Unit& u, int wr, int wc, int fr, int fq) const {
#pragma unroll
        for (int ai = 0; ai < 2; ++ai)
#pragma unroll
            for (int m = 0; m < 4; ++m) { h16* rowp = out + (size_t)(u.pm * BM + ai * HALF + wr * 64 + m * 16 + fr) * ldc + u.pn * BM + wc * 32 + 8 * fq;
#pragma unroll
                for (int bj = 0; bj < 2; ++bj) { const f32x4 v0 = acc[ai][bj][m][0], v1 = acc[ai][bj][m][1];
                    u32x4 w; w.x = pk_h16(v0[0], v0[1]); w.y = pk_h16(v0[2], v0[3]); w.z = pk_h16(v1[0], v1[1]); w.w = pk_h16(v1[2], v1[3]);
                    *(u32x4*)(rowp + bj * HALF) = w; } }
    }
};
struct EpiSC {
    static constexpr bool PERM = true, AFTER_DRAIN = false;
    h16* out; const float* ssq;
    __device__ __forceinline__ void operator()(const f32x4 (&acc)[2][2][4][2], const Unit& u, int wr, int wc, int fr, int fq) const {
#pragma unroll
        for (int ai = 0; ai < 2; ++ai)
#pragma unroll
            for (int m = 0; m < 4; ++m) { const int row = u.pm * BM + ai * HALF + wr * 64 + m * 16 + fr;
                const f32x4 s0 = *(const f32x4*)(ssq + (size_t)row * 16), s1 = *(const f32x4*)(ssq + (size_t)row * 16 + 4), s2 = *(const f32x4*)(ssq + (size_t)row * 16 + 8), s3 = *(const f32x4*)(ssq + (size_t)row * 16 + 12);
                const float ssr = (((s0[0] + s0[1]) + (s0[2] + s0[3])) + ((s1[0] + s1[1]) + (s1[2] + s1[3]))) + (((s2[0] + s2[1]) + (s2[2] + s2[3])) + ((s3[0] + s3[1]) + (s3[2] + s3[3])));
                const float rstd = rsqrtf(ssr * (1.0f / 1024.0f) + 1e-6f);
#pragma unroll
                for (int bj = 0; bj < 2; ++bj) { const int col = u.pn * BM + bj * HALF + wc * 32 + 8 * fq;
                    const f32x4 v0 = acc[ai][bj][m][0] * rstd, v1 = acc[ai][bj][m][1] * rstd;
                    u32x4 w; w.x = pk_h16(v0[0], v0[1]); w.y = pk_h16(v0[2], v0[3]); w.z = pk_h16(v1[0], v1[1]); w.w = pk_h16(v1[2], v1[3]);
                    *(u32x4*)(out + ((size_t)((row >> 6) * 256 + (col >> 3)) * 64 + (row & 63)) * 8) = w; } }
    }
};
struct EpiEvenMain {
    static constexpr bool PERM = true, AFTER_DRAIN = false;
    h16* Z; float* FG; const float* b_f;
    __device__ __forceinline__ void operator()(const f32x4 (&acc)[2][2][4][2], const Unit& u, int wr, int wc, int fr, int fq) const {
#pragma unroll
        for (int bj = 0; bj < 2; ++bj) {
            const int col0 = u.pn * BM + bj * HALF + wc * 32 + 8 * fq;
            if (col0 < 2048) {
                const float sc = (col0 < 512 || (col0 >= 1024 && col0 < 1536)) ? QSCALE : 1.0f;
#pragma unroll
                for (int ai = 0; ai < 2; ++ai)
#pragma unroll
                    for (int m = 0; m < 4; ++m) { const f32x4 v0 = acc[ai][bj][m][0] * sc, v1 = acc[ai][bj][m][1] * sc;
                        u32x4 w; w.x = pk_h16(v0[0], v0[1]); w.y = pk_h16(v0[2], v0[3]); w.z = pk_h16(v1[0], v1[1]); w.w = pk_h16(v1[2], v1[3]);
                        *(u32x4*)(Z + (size_t)(u.pm * BM + ai * HALF + wr * 64 + m * 16 + fr) * ZLD + col0) = w; }
            } else if (col0 < 2080) {
                const int c = col0 - 2048;
#pragma unroll
                for (int ai = 0; ai < 2; ++ai)
#pragma unroll
                    for (int m = 0; m < 4; ++m) { const f32x4 v0 = acc[ai][bj][m][0], v1 = acc[ai][bj][m][1]; f32x4 o0, o1;
                        if (c == 0) {
#pragma unroll
                            for (int q = 0; q < 4; ++q) { o0[q] = log_sigmoid_fast(v0[q] + b_f[q]) * LOG2E; o1[q] = log_sigmoid_fast(v1[q] + b_f[4 + q]) * LOG2E; }
                        } else {
#pragma unroll
                            for (int q = 0; q < 4; ++q) { o0[q] = __builtin_amdgcn_rcpf(1.0f + __expf(-v0[q])); o1[q] = __builtin_amdgcn_rcpf(1.0f + __expf(-v1[q])); }
                        }
                        float* fr_ = FG + (size_t)(u.pm * BM + ai * HALF + wr * 64 + m * 16 + fr) * 32 + c;
                        *(f32x4*)fr_ = o0; *(f32x4*)(fr_ + 4) = o1; }
            }
        }
    }
};
struct EpiVt {
    static constexpr bool PERM = true, AFTER_DRAIN = false;
    h16 *VtF, *VtS, *VtW;
    __device__ __forceinline__ void operator()(const f32x4 (&acc)[2][2][4][2], const Unit& u, int wr, int wc, int fr, int fq) const {
#pragma unroll
        for (int ai = 0; ai < 2; ++ai)
#pragma unroll
            for (int m = 0; m < 4; ++m) {
                const int n = u.pm * BM + ai * HALF + wr * 64 + m * 16 + fr;
#pragma unroll
                for (int bj = 0; bj < 2; ++bj) {
                    const int t0 = u.pn * BM + bj * HALF + wc * 32 + 8 * fq, b = t0 >> 12, s = t0 & 4095;
                    h16* dst = n < 512 ? VtF + ((size_t)(b * 512 + n)) * SEQ + s : (n < 640 ? VtS + ((size_t)(b * 128 + n - 512)) * SEQ + s : VtW + ((size_t)(b * 128 + n - 640)) * SEQ + s);
                    const f32x4 v0 = acc[ai][bj][m][0], v1 = acc[ai][bj][m][1];
                    u32x4 w; w.x = pk_h16(v0[0], v0[1]); w.y = pk_h16(v0[2], v0[3]); w.z = pk_h16(v1[0], v1[1]); w.w = pk_h16(v1[2], v1[3]);
                    *(u32x4*)dst = w;
                }
            }
    }
};

template <class Epi, class Sched, bool ALIGN_EPI = false, bool SP2 = false>
__device__ __forceinline__ void gemm_phase(PG8_LAS unsigned char* lds, const Gemm g, const Sched& S, const Epi& E) {
    int tid_ = threadIdx.x; asm volatile("" : "+v"(tid_));
    const int tid = tid_, wid = __builtin_amdgcn_readfirstlane(tid >> 6), lane = tid & 63, wr = wid >> 2, wc = wid & 3, fr = lane & 15, fq = lane >> 4;
    const int K = g.K, nt = K / BK;
    unsigned voffA[2], voffB[2];
#pragma unroll
    for (int i = 0; i < 2; ++i) { int R, C; stage_rc(tid * 16 + i * 8192, R, C); const int Rb = Epi::PERM ? ((R & ~31) + perm32(R & 31)) : R;
        voffA[i] = (unsigned)(R * g.lda + C) * 2u; voffB[i] = (unsigned)(Rb * K + C) * 2u; }
    const size_t kstep = (size_t)(BK * 2);
    const size_t hstepA = (size_t)HALF * g.lda * 2, hstepB = (size_t)HALF * K * 2;
    const size_t tstepA = 2 * hstepA, tstepB = 2 * hstepB;
    const unsigned ldsw = (unsigned)wid * 1024u;
    const int aoff = lds_byte(wr * 64 + fr, fq * 8), boff = lds_byte(wc * 32 + fr, fq * 8);
#define PG8_SA(b, h) (((b) * 2 + (h)) * HTB)
#define PG8_SB(b, h) ((4 + (b) * 2 + (h)) * HTB)
#define PG8_STAGE(bufoff, gbase, voff) do { _Pragma("unroll") for (int _i = 0; _i < 2; ++_i) \
        __builtin_amdgcn_global_load_lds((const unsigned*)((const char*)(gbase) + (voff)[_i]), (PG8_LAS unsigned*)(lds + (bufoff) + ldsw + _i * 8192), 16, 0, 0); } while (0)
#define PG8_LDA(dst, b, h) do { _Pragma("unroll") for (int m = 0; m < 4; ++m) _Pragma("unroll") for (int k = 0; k < 2; ++k) dst[m][k] = *(const PG8_LAS bf16x8*)(lds + PG8_SA(b, h) + aoff + m * 2048 + k * 1024); } while (0)
#define PG8_LDB(dst, b, h) do { _Pragma("unroll") for (int n = 0; n < 2; ++n) _Pragma("unroll") for (int k = 0; k < 2; ++k) dst[n][k] = *(const PG8_LAS bf16x8*)(lds + PG8_SB(b, h) + boff + n * 2048 + k * 1024); } while (0)
#define PG8_MMA(ai, bj, At, Bt) do { __builtin_amdgcn_s_setprio(1); _Pragma("unroll") for (int m = 0; m < 4; ++m) _Pragma("unroll") for (int n = 0; n < 2; ++n) _Pragma("unroll") for (int k = 0; k < 2; ++k) \
        acc[ai][bj][m][n] = __builtin_amdgcn_mfma_f32_16x16x32_f16(__builtin_bit_cast(half8, Bt[n][k]), __builtin_bit_cast(half8, At[m][k]), acc[ai][bj][m][n], 0, 0, 0); __builtin_amdgcn_s_setprio(0); } while (0)
#define PG8_WAIT_V(n) asm volatile("s_waitcnt vmcnt(" #n ")" ::: "memory")
#define PG8_WAIT_L(n) asm volatile("s_waitcnt lgkmcnt(" #n ")" ::: "memory")
#define PG8_BAR __builtin_amdgcn_s_barrier()
#define PG8_SCHED __builtin_amdgcn_sched_barrier(0)
    Unit cur, nxt; int ui = 0;
    if (!S.next(0, cur)) return;
    f32x4 acc[2][2][4][2];
#pragma unroll
    for (int a = 0; a < 2; ++a)
#pragma unroll
        for (int b = 0; b < 2; ++b)
#pragma unroll
            for (int m = 0; m < 4; ++m)
#pragma unroll
                for (int n = 0; n < 2; ++n) acc[a][b][m][n] = (f32x4){0.f, 0.f, 0.f, 0.f};
    bf16x8 At[4][2], B0[2][2], B1[2][2];
    const char* cA = (const char*)g.A + (size_t)cur.pm * tstepA; const char* cB = (const char*)g.Bt + (size_t)cur.pn * tstepB;
    S.a_ready(cur);
    if constexpr (SP2) {
        PG8_STAGE(PG8_SB(0, 0), cB, voffB); PG8_STAGE(PG8_SB(0, 1), cB + hstepB, voffB); PG8_STAGE(PG8_SA(0, 0), cA, voffA); PG8_STAGE(PG8_SA(0, 1), cA + hstepA, voffA);
        if (wr == 1) PG8_BAR;
        PG8_WAIT_V(2); PG8_BAR;
        PG8_STAGE(PG8_SB(1, 0), cB + kstep, voffB); PG8_STAGE(PG8_SA(1, 0), cA + kstep, voffA); PG8_STAGE(PG8_SB(1, 1), cB + hstepB + kstep, voffB);
        PG8_WAIT_V(6); PG8_BAR;
    } else {
        PG8_STAGE(PG8_SB(0, 0), cB, voffB); PG8_STAGE(PG8_SA(0, 0), cA, voffA); PG8_STAGE(PG8_SB(0, 1), cB + hstepB, voffB); PG8_STAGE(PG8_SA(0, 1), cA + hstepA, voffA);
        if (wr == 1) PG8_BAR;
        PG8_WAIT_V(4); PG8_BAR;
        PG8_STAGE(PG8_SB(1, 0), cB + kstep, voffB); PG8_STAGE(PG8_SA(1, 0), cA + kstep, voffA); PG8_STAGE(PG8_SB(1, 1), cB + hstepB + kstep, voffB);
        PG8_WAIT_V(6); PG8_BAR;
    }
    for (;;) {
        const bool has_next = S.next(ui + 1, nxt);
        const char* nA = has_next ? (const char*)g.A + (size_t)nxt.pm * tstepA : cA; const char* nB = has_next ? (const char*)g.Bt + (size_t)nxt.pn * tstepB : cB;
        for (int t = 0; t < nt; t += 2) {
            const bool last = (t == nt - 2);
            const char* a1 = cA + (size_t)(t + 1) * kstep;
            const char* a2 = last ? nA : cA + (size_t)(t + 2) * kstep; const char* b2 = last ? nB : cB + (size_t)(t + 2) * kstep;
            const char* a3 = a2 + kstep; const char* b3 = b2 + kstep;
            if (last && has_next) S.a_ready(nxt);
            if constexpr (SP2) {
            PG8_LDB(B0, 0, 0); PG8_LDB(B1, 0, 1); PG8_SCHED; PG8_LDA(At, 0, 0); PG8_STAGE(PG8_SA(1, 1), a1 + hstepA, voffA);
            PG8_WAIT_V(8); PG8_WAIT_L(0); PG8_BAR; PG8_MMA(0, 0, At, B0); PG8_MMA(0, 1, At, B1); PG8_BAR; PG8_SCHED;
            PG8_LDA(At, 0, 1); PG8_STAGE(PG8_SB(0, 0), b2, voffB); PG8_STAGE(PG8_SB(0, 1), b2 + hstepB, voffB); PG8_STAGE(PG8_SA(0, 0), a2, voffA);
            PG8_WAIT_V(8); PG8_WAIT_L(0); PG8_BAR; PG8_MMA(1, 0, At, B0); PG8_MMA(1, 1, At, B1); PG8_BAR; PG8_SCHED;
            PG8_LDB(B0, 1, 0); PG8_LDB(B1, 1, 1); PG8_SCHED; PG8_LDA(At, 1, 0); PG8_STAGE(PG8_SA(0, 1), a2 + hstepA, voffA);
            PG8_WAIT_V(8); PG8_WAIT_L(0); PG8_BAR; PG8_MMA(0, 0, At, B0); PG8_MMA(0, 1, At, B1); PG8_BAR; PG8_SCHED;
            PG8_LDA(At, 1, 1); PG8_STAGE(PG8_SB(1, 0), b3, voffB); PG8_STAGE(PG8_SB(1, 1), b3 + hstepB, voffB); PG8_STAGE(PG8_SA(1, 0), a3, voffA);
            PG8_WAIT_V(8); PG8_WAIT_L(0); PG8_BAR; PG8_MMA(1, 0, At, B0); PG8_MMA(1, 1, At, B1); PG8_BAR; PG8_SCHED;
            } else {
            PG8_LDB(B0, 0, 0); PG8_SCHED; PG8_LDA(At, 0, 0); PG8_STAGE(PG8_SA(1, 1), a1 + hstepA, voffA);
            PG8_WAIT_L(8); PG8_BAR; PG8_WAIT_L(0); PG8_MMA(0, 0, At, B0); PG8_BAR; PG8_SCHED;
            PG8_LDB(B1, 0, 1); PG8_STAGE(PG8_SB(0, 0), b2, voffB);
            PG8_BAR; PG8_WAIT_L(0); PG8_MMA(0, 1, At, B1); PG8_BAR;
            PG8_LDA(At, 0, 1); PG8_STAGE(PG8_SA(0, 0), a2, voffA);
            PG8_BAR; PG8_WAIT_L(0); PG8_MMA(1, 0, At, B0); PG8_BAR; PG8_SCHED;
            PG8_STAGE(PG8_SB(0, 1), b2 + hstepB, voffB);
            PG8_WAIT_V(6); PG8_BAR; PG8_MMA(1, 1, At, B1); PG8_BAR;
            PG8_LDB(B0, 1, 0); PG8_SCHED; PG8_LDA(At, 1, 0); PG8_STAGE(PG8_SA(0, 1), a2 + hstepA, voffA);
            PG8_WAIT_L(8); PG8_BAR; PG8_WAIT_L(0); PG8_MMA(0, 0, At, B0); PG8_BAR; PG8_SCHED;
            PG8_LDB(B1, 1, 1); PG8_STAGE(PG8_SB(1, 0), b3, voffB);
            PG8_BAR; PG8_WAIT_L(0); PG8_MMA(0, 1, At, B1); PG8_BAR;
            PG8_LDA(At, 1, 1); PG8_STAGE(PG8_SA(1, 0), a3, voffA);
            PG8_BAR; PG8_WAIT_L(0); PG8_MMA(1, 0, At, B0); PG8_BAR; PG8_SCHED;
            PG8_STAGE(PG8_SB(1, 1), b3 + hstepB, voffB);
            PG8_WAIT_V(6); PG8_BAR; PG8_MMA(1, 1, At, B1); PG8_BAR;
            }
        }
        if constexpr (ALIGN_EPI) { if (wr == 0) PG8_BAR; }
        if constexpr (!Epi::AFTER_DRAIN) { E(acc, cur, wr, wc, fr, fq); S.done(cur); }
        if (!has_next) break;
#pragma unroll
        for (int a = 0; a < 2; ++a)
#pragma unroll
            for (int b = 0; b < 2; ++b)
#pragma unroll
                for (int m = 0; m < 4; ++m)
#pragma unroll
                    for (int n = 0; n < 2; ++n) acc[a][b][m][n] = (f32x4){0.f, 0.f, 0.f, 0.f};
        cur = nxt; cA = nA; cB = nB; ++ui;
        if constexpr (ALIGN_EPI) { if (wr == 1) PG8_BAR; }
    }
    PG8_WAIT_V(0);
    if constexpr (!ALIGN_EPI) { if (wr == 0) PG8_BAR; }
    PG8_BAR;
    if constexpr (Epi::AFTER_DRAIN) { E.fused(acc, cur, wr, wc, fr, fq, lds, wid, lane); S.done(cur); }
#undef PG8_SA
#undef PG8_SB
#undef PG8_STAGE
#undef PG8_LDA
#undef PG8_LDB
#undef PG8_MMA
#undef PG8_WAIT_V
#undef PG8_WAIT_L
#undef PG8_BAR
#undef PG8_SCHED
}
}

__device__ __forceinline__ GemmArgs mk_gemm(const h16* A, int lda, const h16* Bt, int ldb, int M, int N, int K, int ans, int mode, h16* c16, int ldc16, float* c32, int ldc32, const float* resid) {
    GemmArgs g; g.A = A; g.lda = lda; g.Bt = Bt; g.ldb = ldb; g.M = M; g.N = N; g.K = K; g.a_ntile_stride = ans; g.mode = mode; g.c16 = c16; g.ldc16 = ldc16; g.c32 = c32; g.ldc32 = ldc32; g.resid = resid; g.aux = nullptr; return g;
}

__device__ __forceinline__ void run_phase(PRef p, int ph, char* smem) {
    if (ph == 1 || ph == 4 || ph == 6 || ph == 10 || ph == 14 || ph == 16) {
        PG8_LAS unsigned char* lds = (PG8_LAS unsigned char*)dyn_lds;
        const int G = (int)gridDim.x, c = (int)blockIdx.x;
        pg8::StaticOrder S;
        typedef const pg8::bf16_t* bp;
        if (ph == 1) {
            { pg8::EpiEvenMain E{p.Z, p.FG, p.even_b_f}; S.init(TOK, ZLD, G, c);
              pg8::gemm_phase<pg8::EpiEvenMain, pg8::StaticOrder, true, true>(lds, pg8::Gemm{(bp)p.HN, (bp)p.WtE, TOK, ZLD, DM, DM}, S, E); }
            { pg8::EpiVt E{p.VtF, p.VtS, p.VtW}; S.init(768, TOK, G, (c + 3 * G / 4) % G);
              pg8::gemm_phase<pg8::EpiVt, pg8::StaticOrder, true, true>(lds, pg8::Gemm{(bp)p.WtV, (bp)p.HN, 768, TOK, DM, DM}, S, E); }
        } else if (ph == 4) {
            pg8::EpiResid<false> E{p.x, p.H, p.SSQ, DM}; S.init(TOK, DM, G, c);
            pg8::gemm_phase<pg8::EpiResid<false>, pg8::StaticOrder, true, true>(lds, pg8::Gemm{(bp)p.O, (bp)p.WtEo, TOK, DM, DM, DM}, S, E);
        } else if (ph == 14) {
            pg8::EpiResid<true> E{p.H, p.H, p.SSQ, DM}; S.init(TOK, DM, G, c);
            pg8::gemm_phase<pg8::EpiResid<true>, pg8::StaticOrder, true, true>(lds, pg8::Gemm{(bp)(p.Z2 + DRNN), (bp)p.WtOo, TOK, DM, DRNN, Z2LD}, S, E);
        } else if (ph == 10) {
            pg8::EpiH16 E{p.Z2, Z2LD}; S.init(TOK, Z2LD, G, c);
            pg8::gemm_phase<pg8::EpiH16, pg8::StaticOrder, true, true>(lds, pg8::Gemm{(bp)p.HN, (bp)p.WtO, TOK, Z2LD, DM, DM}, S, E);
        } else {
            pg8::EpiSC E{p.SC, p.SSQ}; S.init(TOK, 2048, G, c);
            pg8::gemm_phase<pg8::EpiSC, pg8::StaticOrder, true, true>(lds, pg8::Gemm{(bp)p.H, (bp)(p.WtQ + (ph == 16 ? (size_t)2048 * 1024 : 0)), TOK, 2048, DM, DM}, S, E);
        }
        return;
    }
    if (ph == 0) phase_prep(p, smem);
    else if (ph == 2) phase_cumsum_compress(p, smem);
    else if (ph == 3) phase_attention(p, smem);
    else if (ph == 8 || ph == 18) phase_peer_topk(p, smem);
    else if (ph == 9 || ph == 19) phase_peer_experts(p, ph == 19 ? 1 : 0, ph == 19 ? p.final_g : p.odd_norm_g, ph == 19 ? 1 : 0, smem);
    else if (ph == 11) phase_rnn_gates(p, smem);
    else if (ph == 13) phase_rnn_scan_b(p);
}

__global__ void __launch_bounds__(512, 2) mega(Params p_by_value) {
    char* smem = dyn_lds + hidx_() * 65536;
    volatile LAS unsigned* hs_all = (volatile LAS unsigned*)(dyn_lds + 131072);
    const __attribute__((address_space(4))) Params* kp = (const __attribute__((address_space(4))) Params*)__builtin_amdgcn_kernarg_segment_ptr();
    const int ph0 = (int)kp->ph0, ph1 = (int)kp->ph1;
    if (threadIdx.x < 12) hs_all[threadIdx.x] = 0u;
    __syncthreads();
    XcdBarrier xb = xcd_barrier_post(kp->BAR, hs_all + 8);
    for (int ph = ph0; ph < ph1; ++ph) {
        if (ph == 12 || ph == 7 || ph == 17 || ph == 5 || ph == 15) continue;
        const __attribute__((address_space(4))) Params* q = kp;
        asm volatile("" : "+s"(q));
        PRef p = *q;
#if PROBE_PH >= 0
        if (blockIdx.x == 0 && threadIdx.x == 0) p.TS[ph] = __builtin_amdgcn_s_memrealtime();
#endif
        const int reps = ((DUP_MASK >> ph) & 1) ? 2 : 1;
        for (int r = 0; r < reps; ++r) { run_phase(p, ph, smem); if (r + 1 < reps) xcd_barrier(xb); }
        if (ph + 1 < ph1) xcd_barrier(xb);
    }
    PRef p = *kp;
#if PROBE_PH >= 0
    cg::this_grid().sync();
    if (blockIdx.x == 0 && threadIdx.x == 0) { p.TS[NPHASE] = __builtin_amdgcn_s_memrealtime(); __threadfence(); }
    cg::this_grid().sync();
    {
        const unsigned long long t0 = __hip_atomic_load(&p.TS[0], __ATOMIC_RELAXED, __HIP_MEMORY_SCOPE_AGENT), t1 = __hip_atomic_load(&p.TS[NPHASE], __ATOMIC_RELAXED, __HIP_MEMORY_SCOPE_AGENT);
        const unsigned long long a = __hip_atomic_load(&p.TS[PROBE_PH], __ATOMIC_RELAXED, __HIP_MEMORY_SCOPE_AGENT), b = __hip_atomic_load(&p.TS[PROBE_PH + PROBE_N], __ATOMIC_RELAXED, __HIP_MEMORY_SCOPE_AGENT);
        const float frac = (float)(b - a) / (float)(t1 - t0);
        const float scale = 1.1f + frac;
        for (size_t i = (size_t)blockIdx.x * 512 + threadIdx.x; i < (size_t)TOK * DM; i += (size_t)gridDim.x * 512) p.out[i] *= scale;
    }
#endif
}

constexpr int DYN_LDS_BYTES = 131072 + 64;
extern "C" void kernel_launch(void* const* d_in, const int* in_sizes, int n_in, void* d_out, int out_size, void* d_ws, size_t ws_size, hipStream_t stream) {
    Params p; memset(&p, 0, sizeof(p));
    const float* const* in = (const float* const*)d_in;
    p.x = in[0]; p.even_norm_g = in[1]; p.even_w_in = in[2]; p.even_b_f = in[3]; p.even_cmp_pos = in[4]; p.even_w_cmp_k = in[5]; p.even_w_cmp_v = in[6]; p.even_w_out = in[7];
    p.odd_norm_g = in[8]; p.odd_w_in = in[9]; p.odd_conv_w = in[10]; p.odd_conv_b = in[11]; p.odd_w_ra = in[12]; p.odd_b_ra = in[13]; p.odd_w_ri = in[14]; p.odd_b_ri = in[15];
    p.odd_lam = in[16]; p.odd_w_out = in[17]; p.ffn_norm_g = in[18]; p.peer_w_q = in[19]; p.peer_sub_keys = in[20]; p.peer_u = in[21]; p.peer_v = in[22]; p.final_g = in[23];
    p.out = (float*)d_out;
    char* ws = (char*)d_ws; size_t off = 0;
    auto take = [&](size_t bytes) { char* r = ws + off; off += (bytes + 255) & ~(size_t)255; return r; };
    p.WtE = (h16*)take((size_t)ZLD * 1024 * 2); p.WtV = (h16*)take((size_t)768 * 1024 * 2); p.WtEo = (h16*)take((size_t)1024 * 1024 * 2); p.WtO = (h16*)take((size_t)2560 * 1024 * 2); p.WtOo = (h16*)take((size_t)1024 * 1280 * 2);
    p.WtQ = (h16*)take((size_t)2 * 2048 * 1024 * 2); p.Wc = (h16*)take((size_t)2 * 64 * 2048 * 2); p.Wr = (h16*)take((size_t)20 * 16384 * 2); p.Keys = (h16*)take((size_t)2 * 8 * 2 * 128 * 128 * 2);
    p.Pos16 = (h16*)take(4096); p.U8 = (unsigned char*)take((size_t)2 * 16384 * 1024); p.V8 = (unsigned char*)take((size_t)2 * 16384 * 1024);
    p.US = (float*)take((size_t)2 * 16384 * 4); p.VS = (float*)take((size_t)2 * 16384 * 4);
    p.H = (h16*)take((size_t)TOK * DM * 2); p.HN = (h16*)take((size_t)TOK * DM * 2); p.SSQ = (float*)take((size_t)TOK * 16 * 4);
    const size_t scratch0 = off;
    p.Z = (h16*)take((size_t)TOK * ZLD * 2); p.VtF = (h16*)take((size_t)4 * 8 * 64 * SEQ * 2); p.VtS = (h16*)take((size_t)4 * 2 * 64 * SEQ * 2); p.VtW = (h16*)take((size_t)4 * 2 * 64 * SEQ * 2);
    p.KC = (h16*)take((size_t)8 * 256 * 64 * 2); p.VCt = (h16*)take((size_t)8 * 64 * 256 * 2); p.O = (h16*)take((size_t)TOK * DM * 2); p.FG = (float*)take((size_t)TOK * 32 * 4); p.C2 = (float*)take((size_t)32 * SEQ * 4); p.OACC = (float*)take((size_t)TOK * 512 * 4);
    size_t mx = off;
    off = scratch0;
    p.QP = (h16*)take((size_t)TOK * 2048 * 2); p.SC = (h16*)take((size_t)TOK * 2048 * 2); p.IDS = (int*)take((size_t)TOK * 128 * 4); p.GW = (float*)take((size_t)TOK * 128 * 4);
    if (off > mx) mx = off;
    off = scratch0;
    p.Z2 = (h16*)take((size_t)TOK * Z2LD * 2); p.LA = (h16*)take((size_t)TOK * DRNN * 2); p.RU = (h16*)take((size_t)TOK * DRNN * 2);
    p.AggP = (float*)take((size_t)4 * 64 * DRNN * 4); p.AggH = (float*)take((size_t)4 * 64 * DRNN * 4);
    if (off > mx) mx = off;
    off = mx; p.TS = (unsigned long long*)take(256); p.BAR = (unsigned*)take(XCD_BAR_WORDS * 4 + 256); mx = off;
    if (mx > ws_size) { fprintf(stderr, "workspace too small: need %zu have %zu\n", mx, ws_size); return; }

    static int grid_blocks = 0;
    if (!grid_blocks) {
        int dev = 0, cus = 0, per_cu = 0;
        hipGetDevice(&dev);
        hipDeviceGetAttribute(&cus, hipDeviceAttributeMultiprocessorCount, dev);
        hipFuncSetAttribute((const void*)mega, hipFuncAttributeMaxDynamicSharedMemorySize, DYN_LDS_BYTES);
        hipOccupancyMaxActiveBlocksPerMultiprocessor(&per_cu, mega, 512, DYN_LDS_BYTES);
        if (per_cu > 1) per_cu = 1;
        if (per_cu < 1) per_cu = 1;
        grid_blocks = cus * per_cu;
    }
    hipMemsetAsync(p.BAR, 0, XCD_BAR_WORDS * 4 + 256, stream);
#if SINGLE_LAUNCH
    p.ph0 = 0; p.ph1 = NPHASE;
    void* args[] = {&p};
    hipError_t e = hipLaunchCooperativeKernel((void*)mega, dim3(grid_blocks), dim3(512), args, DYN_LDS_BYTES, stream);
    if (e != hipSuccess) fprintf(stderr, "cooperative launch failed: %s (grid %d)\n", hipGetErrorString(e), grid_blocks);
#else
    for (int ph = 0; ph < NPHASE; ++ph) {
        p.ph0 = ph; p.ph1 = ph + 1;
        hipLaunchKernelGGL(mega, dim3(grid_blocks), dim3(512), DYN_LDS_BYTES, stream, p);
    }
#endif
}
```

```cpp
#include <hip/hip_runtime.h>
#include <hip/hip_cooperative_groups.h>
#include <cstdio>
#include <cstdint>
#include <cstring>
namespace cg = cooperative_groups;

#ifndef SINGLE_LAUNCH
#define SINGLE_LAUNCH 1
#endif
#ifndef PROBE_PH
#define PROBE_PH -1
#endif
#ifndef PROBE_N
#define PROBE_N 1
#endif
#ifndef DUP_MASK
#define DUP_MASK 0
#endif

typedef _Float16 h16;
typedef _Float16 half8 __attribute__((ext_vector_type(8)));
typedef _Float16 half4 __attribute__((ext_vector_type(4)));
typedef _Float16 half2v __attribute__((ext_vector_type(2)));
typedef float f32x4 __attribute__((ext_vector_type(4)));
typedef float f32x16 __attribute__((ext_vector_type(16)));
typedef unsigned long long u64;
typedef int i32x4 __attribute__((ext_vector_type(4)));
typedef float f32x2 __attribute__((ext_vector_type(2)));
typedef float f32x32 __attribute__((ext_vector_type(32)));
typedef _Float16 h16x32 __attribute__((ext_vector_type(32)));
typedef unsigned u32x6 __attribute__((ext_vector_type(6)));
typedef int i32x2 __attribute__((ext_vector_type(2)));
typedef i32x4 __attribute__((aligned(8))) i32x4_a8;

#define NTHR 256
constexpr int BATCH = 4, SEQ = 4096, DM = 1024, TOK = BATCH * SEQ;
constexpr int ZLD = 2304, Z2LD = 2560, DRNN = 1280;
constexpr int EVEN_IN = 2848;
constexpr float LOG2E = 1.4426950408889634f;
constexpr float QSCALE = 0.125f * LOG2E;
constexpr float NEGBIG = -1.0e30f;
constexpr int KST = 72;
constexpr int NPHASE = 20;
constexpr int XCD_BAR_WORDS_C = 3456;

struct Params {
    const float *x, *even_norm_g, *even_w_in, *even_b_f, *even_cmp_pos, *even_w_cmp_k, *even_w_cmp_v, *even_w_out;
    const float *odd_norm_g, *odd_w_in, *odd_conv_w, *odd_conv_b, *odd_w_ra, *odd_b_ra, *odd_w_ri, *odd_b_ri, *odd_lam, *odd_w_out;
    const float *ffn_norm_g, *peer_w_q, *peer_sub_keys, *peer_u, *peer_v, *final_g;
    float* out;
    h16 *WtE, *WtV, *WtEo, *WtO, *WtOo, *WtQ, *Wc, *Wr, *Keys, *Pos16;
    unsigned char *U8, *V8; float *US, *VS;
    h16* H; h16* HN;
    h16 *Z, *VtF, *VtS, *VtW, *KC, *VCt, *O, *OACC; float *FG, *C2;
    float* SSQ;
    h16* QP; h16* SC; int* IDS; float* GW;
    h16* Z2; h16 *LA, *RU; float *AggP, *AggH;
    unsigned long long* TS; unsigned* BAR;
    long long ph0, ph1;
};

typedef const __attribute__((address_space(4))) Params& PRef;
extern __shared__ __attribute__((aligned(16))) char dyn_lds[];
#define GRIDV ((int)gridDim.x * 2)
#define LAS __attribute__((address_space(3)))
__device__ __forceinline__ int hidx_() { return __builtin_amdgcn_readfirstlane((int)threadIdx.x >> 8); }
__device__ __forceinline__ int tidx_() { int t = threadIdx.x & 255; asm volatile("" : "+v"(t)); return t; }
__device__ __forceinline__ int bidx_() { int b = blockIdx.x * 2 + hidx_(); asm volatile("" : "+s"(b)); return b; }
__device__ __forceinline__ int widx_() { return __builtin_amdgcn_readfirstlane(((int)threadIdx.x >> 6) & 3); }
__device__ __forceinline__ void hsync() {
    volatile LAS unsigned* w = (volatile LAS unsigned*)(dyn_lds + 131072 + hidx_() * 16);
    asm volatile("s_waitcnt lgkmcnt(0)" ::: "memory");
    if ((threadIdx.x & 63) == 0) {
        const unsigned old = __hip_atomic_fetch_add((LAS unsigned*)w, 1u, __ATOMIC_RELAXED, __HIP_MEMORY_SCOPE_WORKGROUP);
        const unsigned target = (old | 3u) + 1u;
        while ((int)(w[0] - target) < 0) { }
    }
    asm volatile("s_waitcnt lgkmcnt(0)" ::: "memory");
}

__device__ __forceinline__ float wave_sum(float v) {
#pragma unroll
    for (int o = 32; o > 0; o >>= 1) v += __shfl_xor(v, o);
    return v;
}
__device__ __forceinline__ int mbcnt64(u64 m) { return __builtin_amdgcn_mbcnt_hi((unsigned)(m >> 32), __builtin_amdgcn_mbcnt_lo((unsigned)m, 0)); }
__device__ __forceinline__ float gelu_as(float v) {
    const float av = fabsf(v), t = __builtin_amdgcn_rcpf(av * 0.2316419f + 1.0f);
    float q = t * 0.5307027145f - 0.7265760135f; q = q * t + 0.7107068705f; q = q * t - 0.142248368f; q = q * t + 0.127414796f; q = q * t;
    const float e = __builtin_amdgcn_exp2f(v * v * -0.72134752044f);
    const float m = v * (q * e);
    return v < 0.f ? m : v - m;
}
__device__ __forceinline__ float gelu_exact(float v) { return 0.5f * v * (1.0f + erff(v * 0.70710678118654752f)); }
__device__ __forceinline__ float sigmoidf_(float v) { return 1.0f / (1.0f + __expf(-v)); }
__device__ __forceinline__ float log_sigmoid(float v) { return v >= 0.f ? -log1pf(expf(-v)) : v - log1pf(expf(v)); }
__device__ __forceinline__ float log_sigmoid_fast(float v) { return fminf(v, 0.f) - __logf(1.0f + __expf(-fabsf(v))); }
__device__ __forceinline__ int crow(int r, int hi) { return (r & 3) + 8 * (r >> 2) + 4 * hi; }
__device__ __forceinline__ f32x16 zero16() { f32x16 z;
#pragma unroll
    for (int i = 0; i < 16; ++i) z[i] = 0.f; return z; }

__device__ __forceinline__ void rms_write_h16(const float (&v)[16], const float* __restrict__ g, h16* __restrict__ dst, int lane) {
    float ss = 0.f;
#pragma unroll
    for (int i = 0; i < 16; ++i) ss += v[i] * v[i];
    ss = wave_sum(ss);
    const float rstd = rsqrtf(ss * (1.0f / 1024.0f) + 1e-6f);
#pragma unroll
    for (int hseg = 0; hseg < 2; ++hseg) {
        const int c0 = hseg * 512 + lane * 8;
        const f32x4 g0 = *(const f32x4*)(g + c0), g1 = *(const f32x4*)(g + c0 + 4);
        half8 o;
#pragma unroll
        for (int i = 0; i < 4; ++i) { o[i] = (h16)(v[hseg * 8 + i] * rstd * g0[i]); o[4 + i] = (h16)(v[hseg * 8 + 4 + i] * rstd * g1[i]); }
        *(half8*)(dst + c0) = o;
    }
}
__device__ __forceinline__ void load_row16(const float* __restrict__ src, float (&v)[16], int lane) {
#pragma unroll
    for (int hseg = 0; hseg < 2; ++hseg) {
        const int c0 = hseg * 512 + lane * 8;
        const f32x4 a = *(const f32x4*)(src + c0), b = *(const f32x4*)(src + c0 + 4);
#pragma unroll
        for (int i = 0; i < 4; ++i) { v[hseg * 8 + i] = a[i]; v[hseg * 8 + 4 + i] = b[i]; }
    }
}

__device__ __forceinline__ void load_row16(const h16* __restrict__ src, float (&v)[16], int lane) {
#pragma unroll
    for (int hseg = 0; hseg < 2; ++hseg) {
        const half8 a = *(const half8*)(src + hseg * 512 + lane * 8);
#pragma unroll
        for (int i = 0; i < 8; ++i) v[hseg * 8 + i] = (float)a[i];
    }
}

__device__ __forceinline__ int even_col_map(int n, int kind) {
    if (kind == 2) {
        if (n < 512) return 1024 + n;
        if (n < 640) return 2056 + 3 * 128 + (n - 512);
        return 2056 + 5 * 128 + (n - 640);
    }
    if (n < 1024) return n;
    if (n < 1536) return 1544 + (n - 1024);
    if (n < 1664) return 2056 + (n - 1536);
    if (n < 1792) return 2056 + 128 + (n - 1664);
    if (n < 1920) return 2056 + 256 + (n - 1792);
    if (n < 2048) return 2056 + 512 + (n - 1920);
    if (n < 2056) return 1536 + (n - 2048);
    if (n < 2080) return 2824 + (n - 2056);
    return -1;
}
__device__ __forceinline__ void transpose_tile(const float* __restrict__ src, int K, int N, h16* __restrict__ dst, int mapped, float* tileS, int tile) {
    const int tid = tidx_(), nkt = K / 64;
    const int k0 = (tile % nkt) * 64, n0 = (tile / nkt) * 64;
#pragma unroll
    for (int i = 0; i < 16; ++i) {
        const int e = tid + 256 * i, kk = e >> 6, nn = e & 63;
        const int sc = mapped ? even_col_map(n0 + nn, mapped) : (n0 + nn);
        tileS[kk * 65 + nn] = (sc >= 0) ? src[(size_t)(k0 + kk) * N + sc] : 0.f;
    }
    hsync();
    const int n = tid >> 2, ks = (tid & 3) * 16;
    half8 o0, o1;
#pragma unroll
    for (int i = 0; i < 8; ++i) { o0[i] = (h16)tileS[(ks + i) * 65 + n]; o1[i] = (h16)tileS[(ks + 8 + i) * 65 + n]; }
    h16* d = dst + (size_t)(n0 + n) * K + k0 + ks;
    *(half8*)d = o0; *(half8*)(d + 8) = o1;
    hsync();
}
__device__ __forceinline__ void transpose_job(const float* __restrict__ src, int K, int N, h16* __restrict__ dst, int Ndst, int mapped, float* tileS, int& base, int b0) {
    const int tid = tidx_(), nb = (int)GRIDV - b0, bid = bidx_() - b0;
    const int nkt = K / 64, nnt = Ndst / 64, ntiles = nkt * nnt;
    int first = (bid - (base % nb) + nb) % nb;
    for (int tile = first; tile < ntiles; tile += nb) transpose_tile(src, K, N, dst, mapped, tileS, tile);
    base += ntiles;
}
__device__ __forceinline__ void convert_job(const float* __restrict__ src, h16* __restrict__ dst, size_t n) {
    const size_t n4 = n / 4, stride = (size_t)GRIDV * NTHR;
    for (size_t i = (size_t)bidx_() * NTHR + tidx_(); i < n4; i += stride) {
        const f32x4 v = *(const f32x4*)(src + 4 * i);
        half4 o; o[0] = (h16)v[0]; o[1] = (h16)v[1]; o[2] = (h16)v[2]; o[3] = (h16)v[3];
        *(half4*)(dst + 4 * i) = o;
    }
}
constexpr int ROW6 = 768;
template <int NP>
__device__ __forceinline__ void fp6_rows(const float* __restrict__ src, unsigned char* __restrict__ dst, float* __restrict__ scl, const int (&rps)[NP], int lane) {
    const int hh = lane >> 5, g = lane & 31;
    f32x4 v[NP][8];
#pragma unroll
    for (int q = 0; q < NP; ++q)
#pragma unroll
        for (int c = 0; c < 8; ++c) v[q][c] = *(const f32x4*)(src + (size_t)(rps[q] * 2 + hh) * 1024 + c * 128 + g * 4);
#pragma unroll
    for (int q = 0; q < NP; ++q) {
        float am = 0.f;
#pragma unroll
        for (int c = 0; c < 8; ++c) am = fmaxf(am, fmaxf(fmaxf(fabsf(v[q][c][0]), fabsf(v[q][c][1])), fmaxf(fabsf(v[q][c][2]), fabsf(v[q][c][3]))));
#pragma unroll
        for (int o = 16; o > 0; o >>= 1) am = fmaxf(am, __shfl_xor(am, o));
        const float sc = am > 0.f ? am * (1.0f / 7.5f) : 1.0f, inv = 1.0f / sc;
        h16x32 hv;
#pragma unroll
        for (int c = 0; c < 8; ++c)
#pragma unroll
            for (int j = 0; j < 4; ++j) hv[4 * c + j] = (h16)(v[q][c][j] * inv);
        const u32x6 pk = __builtin_amdgcn_cvt_scalef32_pk32_fp6_f16(hv, 1.0f);
        unsigned char* o = dst + (size_t)(rps[q] * 2 + hh) * ROW6;
        *(i32x4*)(o + g * 16) = (i32x4){(int)pk[0], (int)pk[1], (int)pk[2], (int)pk[3]};
        *(i32x2*)(o + 512 + g * 8) = (i32x2){(int)pk[4], (int)pk[5]};
        if (g == 0) scl[rps[q] * 2 + hh] = sc;
    }
}
__device__ __forceinline__ void fp6_rows_job(const float* __restrict__ src, unsigned char* __restrict__ dst, float* __restrict__ scl, int npairs, int wv0) {
    const int lane = tidx_() & 63, wv = bidx_() * 4 + widx_() - wv0, nwv = GRIDV * 4 - wv0;
    if (wv < 0) return;
    int r = wv;
    for (; r + nwv < npairs; r += 2 * nwv) { const int rps[2] = {r, r + nwv}; fp6_rows<2>(src, dst, scl, rps, lane); }
    for (; r < npairs; r += nwv) { const int rps[1] = {r}; fp6_rows<1>(src, dst, scl, rps, lane); }
}
__device__ __forceinline__ void weight_jobs(PRef p, char* smem, bool first_only, int b0) {
    float* tileS = (float*)smem;
    int base = 0;
    const int jlo = 0, jhi = 28;
    for (int job = jlo; job < jhi; ++job) {
        if (first_only != (job == 0 || job == 4 || job == 6 || job == 7)) continue;
        const float* src; int K, N, Nd; h16* dst; int mapped = 0;
        if (job == 0) { src = p.even_w_in; K = 1024; N = EVEN_IN; dst = p.WtE; Nd = ZLD; mapped = 1; }
        else if (job == 1) { src = p.even_w_out; K = 1024; N = 1024; dst = p.WtEo; Nd = 1024; }
        else if (job == 2) { src = p.odd_w_in; K = 1024; N = 2560; dst = p.WtO; Nd = 2560; }
        else if (job == 3) { src = p.odd_w_out; K = 1280; N = 1024; dst = p.WtOo; Nd = 1024; }
        else if (job == 4) { src = p.even_w_in; K = 1024; N = EVEN_IN; dst = p.WtV; Nd = 768; mapped = 2; }
        else if (job == 5) continue;
        else if (job == 6) { src = p.even_w_cmp_k; K = 2048; N = 64; dst = p.Wc; Nd = 64; }
        else if (job == 7) { src = p.even_w_cmp_v; K = 2048; N = 64; dst = p.Wc + 64 * 2048; Nd = 64; }
        else if (job < 18) { const int n = job - 8; src = p.odd_w_ra + n * 16384; K = 128; N = 128; dst = p.Wr + n * 16384; Nd = 128; }
        else { const int n = job - 18; src = p.odd_w_ri + n * 16384; K = 128; N = 128; dst = p.Wr + (10 + n) * 16384; Nd = 128; }
        transpose_job(src, K, N, dst, Nd, mapped, tileS, base, b0);
    }
}
__device__ __forceinline__ void deferred_transpose_tile(PRef p, float* tileS, int t) {
    const float* src; int K, N; h16* dst;
    if (t < 256) { src = p.even_w_out; K = 1024; N = 1024; dst = p.WtEo; }
    else if (t < 896) { t -= 256; src = p.odd_w_in; K = 1024; N = 2560; dst = p.WtO; }
    else if (t < 1216) { t -= 896; src = p.odd_w_out; K = 1280; N = 1024; dst = p.WtOo; }
    else { t -= 1216; const int n = t >> 2; t &= 3; src = (n < 10 ? p.odd_w_ra + n * 16384 : p.odd_w_ri + (n - 10) * 16384); K = 128; N = 128; dst = p.Wr + n * 16384; }
    transpose_tile(src, K, N, dst, 0, tileS, t);
}
__device__ __forceinline__ void deferred_transpose_item(PRef p, float* tileS, int t0) {
    const int tid = tidx_();
    float v[4][16]; const float* srcs[4]; h16* dsts[4]; int Ks[4], k0s[4], n0s[4];
#pragma unroll
    for (int q = 0; q < 4; ++q) {
        int t = t0 + q; const float* src; int K, N; h16* dst;
        if (t < 256) { src = p.even_w_out; K = 1024; N = 1024; dst = p.WtEo; }
        else if (t < 896) { t -= 256; src = p.odd_w_in; K = 1024; N = 2560; dst = p.WtO; }
        else if (t < 1216) { t -= 896; src = p.odd_w_out; K = 1280; N = 1024; dst = p.WtOo; }
        else { t -= 1216; const int n = t >> 2; t &= 3; src = (n < 10 ? p.odd_w_ra + n * 16384 : p.odd_w_ri + (n - 10) * 16384); K = 128; N = 128; dst = p.Wr + n * 16384; }
        const int nkt = K / 64, k0 = (t % nkt) * 64, n0 = (t / nkt) * 64;
        dsts[q] = dst; Ks[q] = K; k0s[q] = k0; n0s[q] = n0;
#pragma unroll
        for (int i = 0; i < 16; ++i) { const int e = tid + 256 * i, kk = e >> 6, nn = e & 63; v[q][i] = src[(size_t)(k0 + kk) * N + n0 + nn]; }
    }
#pragma unroll
    for (int q = 0; q < 4; ++q) {
#pragma unroll
        for (int i = 0; i < 16; ++i) { const int e = tid + 256 * i, kk = e >> 6, nn = e & 63; tileS[kk * 65 + nn] = v[q][i]; }
        hsync();
        const int n = tid >> 2, ks = (tid & 3) * 16;
        half8 o0, o1;
#pragma unroll
        for (int i = 0; i < 8; ++i) { o0[i] = (h16)tileS[(ks + i) * 65 + n]; o1[i] = (h16)tileS[(ks + 8 + i) * 65 + n]; }
        h16* d = dsts[q] + (size_t)(n0s[q] + n) * Ks[q] + k0s[q] + ks;
        *(half8*)d = o0; *(half8*)(d + 8) = o1;
        hsync();
    }
}
__device__ __forceinline__ void phase_prep(PRef p, char* smem) {
    weight_jobs(p, smem, true, 0);
    convert_job(p.peer_sub_keys, p.Keys, (size_t)2 * 8 * 2 * 128 * 128);
    convert_job(p.even_cmp_pos, p.Pos16, 2048);
    const int lane = tidx_() & 63, wv = bidx_() * 4 + widx_(), nwv = GRIDV * 4;
    for (int row = wv; row < TOK; row += nwv) {
        float v[16]; load_row16(p.x + (size_t)row * DM, v, lane);
        rms_write_h16(v, p.even_norm_g, p.HN + (size_t)row * DM, lane);
    }
}

enum { EPI_EVEN_IN = 0, EPI_F32_RESID = 1, EPI_H16 = 2, EPI_F32T = 3, EPI_QSCORE = 4 };
struct GemmArgs {
    const h16* A; int lda; const h16* Bt; int ldb; int M, N, K; int a_ntile_stride;
    int mode; h16* c16; int ldc16; float* c32; int ldc32; const float* resid; const h16* aux;
};
template <int MODE, int LDC>
__device__ __forceinline__ void gemm_epilogue(PRef p, const GemmArgs& g, int mt, int nt, bool sw, const f32x4 (&acc)[4][4]) {
    const int lane = tidx_() & 63, wid = widx_(), wm = wid >> 1, wn = wid & 1;
    const int l4 = (lane >> 4) * 4, l15 = lane & 15;
    if (MODE == EPI_EVEN_IN) {
        int kind;
        if (nt < 4 || (nt >= 12 && nt < 16)) kind = 0; else if (nt >= 8 && nt < 12) kind = 2; else if (nt == 19) kind = 3; else if (nt == 21) kind = 4; else if (nt == 22) kind = 5; else kind = 1;
#pragma unroll
        for (int i = 0; i < 4; ++i)
#pragma unroll
            for (int j = 0; j < 4; ++j) {
                const f32x4 v = acc[i][j];
                if (kind <= 1) {
                    const int row = mt * 128 + wm * 64 + j * 16 + l15, col = nt * 128 + wn * 64 + i * 16 + l4;
                    const float sc = kind == 0 ? QSCALE : 1.0f;
                    half4 o; o[0] = (h16)(v[0] * sc); o[1] = (h16)(v[1] * sc); o[2] = (h16)(v[2] * sc); o[3] = (h16)(v[3] * sc);
                    *(half4*)(p.Z + (size_t)row * ZLD + col) = o;
                } else if (kind <= 4) {
                    const int row = mt * 128 + wm * 64 + i * 16 + l4, col = nt * 128 + wn * 64 + j * 16 + l15;
                    const int b = row >> 12, s = row & 4095;
                    half4 o; o[0] = (h16)v[0]; o[1] = (h16)v[1]; o[2] = (h16)v[2]; o[3] = (h16)v[3];
                    h16* dst;
                    if (kind == 2) { const int c = col - 1024; dst = p.VtF + ((size_t)(b * 8 + (c >> 6)) * 64 + (c & 63)) * SEQ + s; }
                    else if (kind == 3) { const int c = col - 2432; dst = p.VtS + ((size_t)(b * 2 + (c >> 6)) * 64 + (c & 63)) * SEQ + s; }
                    else { const int c = col - 2688; dst = p.VtW + ((size_t)(b * 2 + (c >> 6)) * 64 + (c & 63)) * SEQ + s; }
                    *(half4*)dst = o;
                } else {
                    const int row = mt * 128 + wm * 64 + j * 16 + l15, c = nt * 128 + wn * 64 + i * 16 + l4 - 2816;
                    if (c < 32) {
                        f32x4 o;
                        if (c < 8) {
#pragma unroll
                            for (int q = 0; q < 4; ++q) o[q] = log_sigmoid(v[q] + p.even_b_f[c + q]) * LOG2E;
                        } else {
#pragma unroll
                            for (int q = 0; q < 4; ++q) o[q] = sigmoidf_(v[q]);
                        }
                        *(f32x4*)(p.FG + (size_t)row * 32 + c) = o;
                    }
                }
            }
    } else {
#pragma unroll
        for (int i = 0; i < 4; ++i)
#pragma unroll
            for (int j = 0; j < 4; ++j) {
                const f32x4 v = acc[i][j];
                if (MODE == EPI_F32T) {
                    const int row = mt * 128 + wm * 64 + i * 16 + l4, col = nt * 128 + wn * 64 + j * 16 + l15;
                    *(f32x4*)(g.c32 + (size_t)col * TOK + row) = v;
                } else {
                    const int row = mt * 128 + wm * 64 + j * 16 + l15, col = nt * 128 + wn * 64 + i * 16 + l4;
                    if (MODE == EPI_F32_RESID) {
                        const f32x4 r = *(const f32x4*)(g.resid + (size_t)row * LDC + col);
                        *(f32x4*)(g.c32 + (size_t)row * LDC + col) = r + v;
                    } else {
                        half4 o; o[0] = (h16)v[0]; o[1] = (h16)v[1]; o[2] = (h16)v[2]; o[3] = (h16)v[3];
                        *(half4*)(g.c16 + (size_t)row * LDC + col) = o;
                    }
                }
            }
    }
}

template <int MODE, int LDA, int LDB, int GN, int GK, int LDC, int ANS>
__device__ __forceinline__ void phase_gemm(PRef p, const GemmArgs& g, char* smem) {
    h16* As = (h16*)smem;
    h16* Bs = As + 2 * 128 * 64;
    const int tid = tidx_(), lane = tid & 63, wid = widx_(), wm = wid >> 1, wn = wid & 1;
    constexpr int nM = TOK / 128, nN = GN / 128, ntiles = nM * nN, nk = GK / 64;
    const int lr = tid >> 3, lc = tid & 7;
    const int st_off = lr * 64 + ((lc ^ ((tid >> 4) & 7)) * 8);
    const int fsw = (lane & 15) >> 1;
    const int fo0 = (lane & 15) * 64 + ((((lane >> 4)) ^ fsw) * 8), fo1 = (lane & 15) * 64 + (((4 + (lane >> 4)) ^ fsw) * 8);
    for (int tile = bidx_(); tile < ntiles; tile += GRIDV) {
        const int mt = tile / nN, nt = tile % nN;
        bool sw = (MODE != EPI_F32T);
        if (MODE == EPI_EVEN_IN) sw = !((nt >= 8 && nt < 12) || nt == 19 || nt == 21);
        const h16* Ag = g.A + (size_t)(mt * 128 + lr) * LDA + (size_t)nt * ANS + lc * 8;
        const h16* Bg = g.Bt + (size_t)(nt * 128 + lr) * LDB + lc * 8;
        constexpr size_t a32 = (size_t)32 * LDA, b32 = (size_t)32 * LDB;
        f32x4 acc[4][4];
#pragma unroll
        for (int m = 0; m < 4; ++m)
#pragma unroll
            for (int n = 0; n < 4; ++n) acc[m][n] = (f32x4){0.f, 0.f, 0.f, 0.f};
        half8 ra[4], rb[4];
#pragma unroll
        for (int i = 0; i < 4; ++i) { ra[i] = *(const half8*)(Ag + i * a32); rb[i] = *(const half8*)(Bg + i * b32); }
#pragma unroll
        for (int i = 0; i < 4; ++i) { *(half8*)(As + st_off + i * 32 * 64) = ra[i]; *(half8*)(Bs + st_off + i * 32 * 64) = rb[i]; }
        hsync();
        const int pofs = (sw ? wn : wm) * 64 * 64, qofs = (sw ? wm : wn) * 64 * 64;
        for (int kt = 0; kt < nk; ++kt) {
            const int cur = kt & 1;
            if (kt + 1 < nk) {
                const int ko = (kt + 1) * 64;
#pragma unroll
                for (int i = 0; i < 4; ++i) { ra[i] = *(const half8*)(Ag + i * a32 + ko); rb[i] = *(const half8*)(Bg + i * b32 + ko); }
            }
            const h16* Pc = (sw ? Bs : As) + cur * 128 * 64 + pofs;
            const h16* Qc = (sw ? As : Bs) + cur * 128 * 64 + qofs;
#pragma unroll
            for (int ks = 0; ks < 2; ++ks) {
                const int fo = ks ? fo1 : fo0;
                half8 pf[4], qf[4];
#pragma unroll
                for (int i = 0; i < 4; ++i) { pf[i] = *(const half8*)(Pc + i * 16 * 64 + fo); qf[i] = *(const half8*)(Qc + i * 16 * 64 + fo); }
                __builtin_amdgcn_s_setprio(1);
#pragma unroll
                for (int i = 0; i < 4; ++i)
#pragma unroll
                    for (int j = 0; j < 4; ++j) acc[i][j] = __builtin_amdgcn_mfma_f32_16x16x32_f16(pf[i], qf[j], acc[i][j], 0, 0, 0);
                __builtin_amdgcn_s_setprio(0);
            }
            if (kt + 1 < nk) {
                const int nx = (cur ^ 1) * 128 * 64;
#pragma unroll
                for (int i = 0; i < 4; ++i) { *(half8*)(As + nx + st_off + i * 32 * 64) = ra[i]; *(half8*)(Bs + nx + st_off + i * 32 * 64) = rb[i]; }
            }
            hsync();
        }
        if (MODE == EPI_QSCORE) {
            constexpr int QST = 136;
            h16* Qs = (h16*)smem;
            const int l4 = (lane >> 4) * 4, l15 = lane & 15;
#pragma unroll
            for (int i = 0; i < 4; ++i)
#pragma unroll
                for (int j = 0; j < 4; ++j) {
                    const f32x4 v = acc[i][j];
                    half4 o; o[0] = (h16)v[0]; o[1] = (h16)v[1]; o[2] = (h16)v[2]; o[3] = (h16)v[3];
                    *(half4*)(Qs + (wm * 64 + j * 16 + l15) * QST + wn * 64 + i * 16 + l4) = o;
                }
            hsync();
            f32x4 sc[4][4];
#pragma unroll
            for (int i = 0; i < 4; ++i)
#pragma unroll
                for (int j = 0; j < 4; ++j) sc[i][j] = (f32x4){0.f, 0.f, 0.f, 0.f};
            const h16* kb = g.aux + (size_t)(nt * 128 + wn * 64 + l15) * 128 + (lane >> 4) * 8;
#pragma unroll
            for (int ks = 0; ks < 4; ++ks) {
                half8 pf[4], qf[4];
#pragma unroll
                for (int i = 0; i < 4; ++i) { pf[i] = *(const half8*)(Qs + (wm * 64 + i * 16 + l15) * QST + ks * 32 + (lane >> 4) * 8); qf[i] = *(const half8*)(kb + (size_t)i * 16 * 128 + ks * 32); }
#pragma unroll
                for (int i = 0; i < 4; ++i)
#pragma unroll
                    for (int j = 0; j < 4; ++j) sc[i][j] = __builtin_amdgcn_mfma_f32_16x16x32_f16(pf[i], qf[j], sc[i][j], 0, 0, 0);
            }
#pragma unroll
            for (int i = 0; i < 4; ++i)
#pragma unroll
                for (int j = 0; j < 4; ++j) {
                    const int row = mt * 128 + wm * 64 + i * 16 + l4, col = nt * 128 + wn * 64 + j * 16 + l15;
                    *(f32x4*)(g.c32 + (size_t)col * TOK + row) = sc[i][j];
                }
            hsync();
        } else
        gemm_epilogue<MODE, LDC>(p, g, mt, nt, sw, acc);
    }
}

__device__ __forceinline__ void wp_unit(PRef p, int u) {
    const int lane = tidx_() & 63;
    {
        const int l = u >> 9, hc = (u >> 5) & 15, kh = (u >> 4) & 1, jt = u & 15;
        const float* wq = p.peer_w_q + (size_t)l * 1024 * 2048 + (size_t)(jt * 64 + (lane & 15)) * 2048 + hc * 128 + (lane >> 4) * 8;
        const h16* ky = p.Keys + ((size_t)(l * 16 + hc) * 128 + kh * 64 + (lane & 15)) * 128 + (lane >> 4) * 8;
        f32x4 acc[4][4];
#pragma unroll
        for (int a = 0; a < 4; ++a)
#pragma unroll
            for (int b = 0; b < 4; ++b) acc[a][b] = (f32x4){0.f, 0.f, 0.f, 0.f};
        f32x4 wv[4][4][2];
#pragma unroll
        for (int ks = 0; ks < 4; ++ks)
#pragma unroll
            for (int a = 0; a < 4; ++a) { wv[ks][a][0] = *(const f32x4*)(wq + (size_t)a * 16 * 2048 + ks * 32); wv[ks][a][1] = *(const f32x4*)(wq + (size_t)a * 16 * 2048 + ks * 32 + 4); }
#pragma unroll
        for (int ks = 0; ks < 4; ++ks) {
            half8 af[4], bf[4];
#pragma unroll
            for (int a = 0; a < 4; ++a) {
#pragma unroll
                for (int q = 0; q < 4; ++q) { af[a][q] = (h16)wv[ks][a][0][q]; af[a][4 + q] = (h16)wv[ks][a][1][q]; }
                bf[a] = *(const half8*)(ky + (size_t)a * 16 * 128 + ks * 32);
            }
#pragma unroll
            for (int a = 0; a < 4; ++a)
#pragma unroll
                for (int b = 0; b < 4; ++b) acc[a][b] = __builtin_amdgcn_mfma_f32_16x16x32_f16(af[a], bf[b], acc[a][b], 0, 0, 0);
        }
        h16* wp = p.WtQ + (size_t)l * 2048 * 1024;
#pragma unroll
        for (int a = 0; a < 4; ++a)
#pragma unroll
            for (int b = 0; b < 4; ++b) {
                const int n = hc * 128 + kh * 64 + b * 16 + (lane & 15), j0 = jt * 64 + a * 16 + (lane >> 4) * 4;
                const f32x4 gq = *(const f32x4*)(p.ffn_norm_g + l * DM + j0);
                half4 o; o[0] = (h16)(acc[a][b][0] * gq[0]); o[1] = (h16)(acc[a][b][1] * gq[1]); o[2] = (h16)(acc[a][b][2] * gq[2]); o[3] = (h16)(acc[a][b][3] * gq[3]);
                *(half4*)(wp + (size_t)n * 1024 + j0) = o;
            }
    }
}
__device__ __forceinline__ void phase_cumsum_compress(PRef p, char* smem) {
    const int lane = tidx_() & 63, wid = widx_(), vb = bidx_();
    if (vb >= 256 && vb < 264) {
        const int u = (vb - 256) * 4 + wid, b = u >> 3, h = u & 7;
        const float* src = p.FG + (size_t)(b * SEQ + lane * 64) * 32 + h;
        float loc[64]; float run = 0.f;
#pragma unroll
        for (int i = 0; i < 64; ++i) { run += src[(size_t)i * 32]; loc[i] = run; }
        float incl = run;
#pragma unroll
        for (int o = 1; o < 64; o <<= 1) { const float t = __shfl_up(incl, o); if (lane >= o) incl += t; }
        const float excl = incl - run;
        float* dst = p.C2 + (size_t)(b * 8 + h) * SEQ + lane * 64;
#pragma unroll
        for (int i = 0; i < 64; ++i) dst[i] = excl + loc[i];
    }
    if (vb < 256) {
        const int cu = vb, kv = cu >> 7, bg = (cu >> 4) & 7, nt = cu & 15;
        const int b = bg >> 1, g = bg & 1;
        int n = nt * 16 + (lane & 15); const int nc = n < 255 ? n : 254;
        const h16* Ab = p.Z + (size_t)(b * SEQ + 16 * nc) * ZLD + 1536 + kv * 128 + g * 64 + (lane >> 4) * 8;
        const h16* Wb = p.Wc + (size_t)kv * 64 * 2048 + (size_t)(lane & 15) * 2048 + (lane >> 4) * 8;
        const h16* Pb = p.Pos16 + (lane >> 4) * 8;
        f32x4 acc[4];
#pragma unroll
        for (int e = 0; e < 4; ++e) acc[e] = (f32x4){0.f, 0.f, 0.f, 0.f};
#pragma unroll
        for (int k2 = 0; k2 < 16; ++k2) {
            const int ks = wid * 16 + k2, l = ks >> 1, d0 = (ks & 1) * 32;
            half8 a = *(const half8*)(Ab + (size_t)l * ZLD + d0);
            const half8 ps = *(const half8*)(Pb + ks * 32);
            a = a + ps;
#pragma unroll
            for (int e = 0; e < 4; ++e) {
                const half8 w = *(const half8*)(Wb + (size_t)e * 16 * 2048 + ks * 32);
                acc[e] = __builtin_amdgcn_mfma_f32_16x16x32_f16(a, w, acc[e], 0, 0, 0);
            }
        }
        f32x4* part = (f32x4*)smem;
#pragma unroll
        for (int e = 0; e < 4; ++e) part[(wid * 4 + e) * 64 + lane] = acc[e];
        hsync();
        {
            const int e = wid;
            const f32x4 s = (part[(0 * 4 + e) * 64 + lane] + part[(1 * 4 + e) * 64 + lane]) + (part[(2 * 4 + e) * 64 + lane] + part[(3 * 4 + e) * 64 + lane]);
            const int n0 = nt * 16 + (lane >> 4) * 4, ec = e * 16 + (lane & 15);
            if (kv == 0) {
#pragma unroll
                for (int j = 0; j < 4; ++j) p.KC[((size_t)bg * 256 + n0 + j) * 64 + ec] = (n0 + j < 255) ? (h16)s[j] : (h16)0.f;
            } else {
                half4 o;
#pragma unroll
                for (int j = 0; j < 4; ++j) o[j] = (n0 + j < 255) ? (h16)s[j] : (h16)0.f;
                *(half4*)(p.VCt + ((size_t)bg * 64 + ec) * 256 + n0) = o;
            }
        }
        hsync();
    }
}

struct RowState { float m, l; f32x16 o0, o1; };
__device__ __forceinline__ void rs_reset(RowState& s) { s.m = NEGBIG; s.l = 0.f; s.o0 = zero16(); s.o1 = zero16(); }

__device__ __forceinline__ void kv_load(const h16* kb, int kst, const h16* vb, int vst, half8 (&kr)[2], half8 (&vr)[2]) {
    const int tid = tidx_();
#pragma unroll
    for (int i = 0; i < 2; ++i) {
        const int c = tid + 256 * i, row = c >> 3, cc = (c & 7) * 8;
        kr[i] = *(const half8*)(kb + (size_t)row * kst + cc);
        vr[i] = *(const half8*)(vb + (size_t)row * vst + cc);
    }
}
__device__ __forceinline__ void kv_store(h16* Ks, h16* Vs, const half8 (&kr)[2], const half8 (&vr)[2]) {
    const int tid = tidx_();
#pragma unroll
    for (int i = 0; i < 2; ++i) {
        const int c = tid + 256 * i, row = c >> 3, cc = (c & 7) * 8;
        *(half8*)(Ks + row * KST + cc) = kr[i];
        *(half8*)(Vs + row * KST + cc) = vr[i];
    }
}
__device__ __forceinline__ void qk_tile(const h16* Ks, const half8 (&qf)[4], f32x16 (&s)[2], int lane) {
    const int r32 = lane & 31, hh = lane >> 5;
#pragma unroll
    for (int kt = 0; kt < 2; ++kt) {
        s[kt] = zero16();
#pragma unroll
        for (int ks = 0; ks < 4; ++ks) {
            const half8 kf = *(const half8*)(Ks + (kt * 32 + r32) * KST + ks * 16 + hh * 8);
            s[kt] = __builtin_amdgcn_mfma_f32_32x32x16_f16(kf, qf[ks], s[kt], 0, 0, 0);
        }
    }
}
__device__ __forceinline__ void pv_tile(const h16* Vs, const f32x16 (&pr)[2], f32x16& o0, f32x16& o1, int lane) {
    const int r32 = lane & 31, hh = lane >> 5;
#pragma unroll
    for (int kt = 0; kt < 2; ++kt)
#pragma unroll
        for (int s2 = 0; s2 < 2; ++s2) {
            half8 pf;
#pragma unroll
            for (int j = 0; j < 8; ++j) pf[j] = (h16)pr[kt][8 * s2 + j];
            const int kof = kt * 32 + 16 * s2 + 4 * hh;
            {
                const half4 a = *(const half4*)(Vs + r32 * KST + kof), b = *(const half4*)(Vs + r32 * KST + kof + 8);
                half8 vf; vf[0] = a[0]; vf[1] = a[1]; vf[2] = a[2]; vf[3] = a[3]; vf[4] = b[0]; vf[5] = b[1]; vf[6] = b[2]; vf[7] = b[3];
                o0 = __builtin_amdgcn_mfma_f32_32x32x16_f16(vf, pf, o0, 0, 0, 0);
            }
            {
                const half4 a = *(const half4*)(Vs + (32 + r32) * KST + kof), b = *(const half4*)(Vs + (32 + r32) * KST + kof + 8);
                half8 vf; vf[0] = a[0]; vf[1] = a[1]; vf[2] = a[2]; vf[3] = a[3]; vf[4] = b[0]; vf[5] = b[1]; vf[6] = b[2]; vf[7] = b[3];
                o1 = __builtin_amdgcn_mfma_f32_32x32x16_f16(vf, pf, o1, 0, 0, 0);
            }
        }
}

__device__ __forceinline__ float xhalf_max(float x) {
    float a = x, b = x;
    asm volatile("s_nop 1\n\tv_permlane32_swap_b32 %0, %1\n\ts_nop 1" : "+v"(a), "+v"(b));
    return fmaxf(a, b);
}
__device__ __forceinline__ float xhalf_lo(float x) {
    float a = x, b = x;
    asm volatile("s_nop 1\n\tv_permlane32_swap_b32 %0, %1\n\ts_nop 1" : "+v"(a), "+v"(b));
    return a;
}
enum { M_FOX = 0, M_SLC = 1, M_WIN = 2 };
template <int MODE, bool MASKED>
__device__ __forceinline__ void flash_step(const h16* Ks, const h16* Vs, const float* csS, const half8 (&qf)[4], RowState& st,
                                           int t, int kpos0, float slope2, float ct2, bool selbit, int lane) {
    const int hh = lane >> 5;
    f32x16 s[2];
    qk_tile(Ks, qf, s, lane);
    int dbase = t - kpos0 - 4 * hh;
    asm volatile("" : "+v"(dbase));
    const float off = (MODE == M_FOX) ? ct2 : -slope2 * (float)dbase;
    float mx = NEGBIG;
#pragma unroll
    for (int kt = 0; kt < 2; ++kt)
#pragma unroll
        for (int r = 0; r < 16; ++r) {
            const int c = kt * 32 + (r & 3) + 8 * (r >> 2);
            float v;
            if (MODE == M_FOX) v = s[kt][r] - csS[c + 4 * hh];
            else v = fmaf(slope2, (float)c, s[kt][r]);
            if (MASKED) {
                const int dist = dbase - c;
                bool valid;
                if (MODE == M_FOX) valid = dist >= 0; else if (MODE == M_SLC) valid = selbit && dist >= 0; else valid = dist >= 0 && dist < 512;
                v = valid ? v : NEGBIG;
            }
            s[kt][r] = v;
            mx = fmaxf(mx, v);
        }
    mx += off;
    mx = xhalf_max(mx);
    const bool rowoff = (MODE == M_SLC) && !MASKED && !selbit;
    if (rowoff) mx = NEGBIG;
    const float mn = fmaxf(st.m, mx);
    const float alpha = __builtin_amdgcn_exp2f(st.m - mn);
    st.m = mn;
    const float moff = rowoff ? 1.0e30f : mn - off;
    float ps = 0.f;
#pragma unroll
    for (int kt = 0; kt < 2; ++kt)
#pragma unroll
        for (int r = 0; r < 16; ++r) {
            const float v = s[kt][r];
            float pe = __builtin_amdgcn_exp2f(v - moff);
            if (MASKED) pe = v > -1.0e29f ? pe : 0.f;
            s[kt][r] = pe; ps += pe;
        }
    st.l = st.l * alpha + ps;
#pragma unroll
    for (int r = 0; r < 16; ++r) { st.o0[r] *= alpha; st.o1[r] *= alpha; }
    pv_tile(Vs, s, st.o0, st.o1, lane);
}

template <int MODE>
__device__ __forceinline__ void run_flash(u64 mask, const h16* Kg, int kst, const h16* Vg, int vst, const float* csg, char* smem,
                                          const half8 (&qf)[4], RowState& st, int t, int twlo, int twhi, float slope2, float ct2, u64 sel, int lane) {
    h16* Kb = (h16*)smem; h16* Vb = Kb + 2 * 64 * KST; float* csb = (float*)(Vb + 2 * 64 * KST);
    if (mask == 0ull) return;
    half8 kr[2], vr[2]; float csr = 0.f;
    int jc = __builtin_ctzll(mask); mask &= mask - 1;
    kv_load(Kg + (size_t)jc * 64 * kst, kst, Vg + jc * 64, vst, kr, vr);
    if (MODE == M_FOX && tidx_() < 64) csr = csg[jc * 64 + tidx_()];
    kv_store(Kb, Vb, kr, vr);
    if (MODE == M_FOX && tidx_() < 64) csb[tidx_()] = csr;
    hsync();
    int buf = 0;
    for (;;) {
        int jn = -1;
        if (mask) { jn = __builtin_ctzll(mask); mask &= mask - 1; }
        if (jn >= 0) {
            kv_load(Kg + (size_t)jn * 64 * kst, kst, Vg + jn * 64, vst, kr, vr);
            if (MODE == M_FOX && tidx_() < 64) csr = csg[jn * 64 + tidx_()];
        }
        bool need = jc * 64 <= twhi;
        if (MODE == M_WIN) need = need && (jc * 64 + 63 >= twlo - 511);
        if (need) {
            const bool selbit = (sel >> jc) & 1ull;
            bool full = jc * 64 + 63 <= twlo;
            if (MODE == M_WIN) full = full && (jc * 64 > twhi - 512);
            if (full) flash_step<MODE, false>(Kb + buf * 64 * KST, Vb + buf * 64 * KST, csb + buf * 64, qf, st, t, jc * 64, slope2, ct2, selbit, lane);
            else flash_step<MODE, true>(Kb + buf * 64 * KST, Vb + buf * 64 * KST, csb + buf * 64, qf, st, t, jc * 64, slope2, ct2, selbit, lane);
        }
        if (jn >= 0) {
            kv_store(Kb + (buf ^ 1) * 64 * KST, Vb + (buf ^ 1) * 64 * KST, kr, vr);
            if (MODE == M_FOX && tidx_() < 64) csb[(buf ^ 1) * 64 + tidx_()] = csr;
        }
        hsync();
        if (jn < 0) break;
        jc = jn; buf ^= 1;
    }
}

__device__ __forceinline__ void load_q(const h16* qrow, half8 (&qf)[4], int lane) {
#pragma unroll
    for (int ks = 0; ks < 4; ++ks) qf[ks] = *(const half8*)(qrow + ks * 16 + (lane >> 5) * 8);
}
__device__ __forceinline__ void store_o(h16* orow, const f32x16& o0, const f32x16& o1, int lane) {
    const int hh = lane >> 5;
#pragma unroll
    for (int rg = 0; rg < 4; ++rg) {
        half4 a, b;
#pragma unroll
        for (int j = 0; j < 4; ++j) { a[j] = (h16)o0[4 * rg + j]; b[j] = (h16)o1[4 * rg + j]; }
        *(half4*)(orow + 8 * rg + 4 * hh) = a;
        *(half4*)(orow + 32 + 8 * rg + 4 * hh) = b;
    }
}

__device__ __forceinline__ void oacc_store(h16* row, const f32x16& o0, const f32x16& o1, float sc, int lane) {
    const int hh = lane >> 5;
#pragma unroll
    for (int rg = 0; rg < 4; ++rg) {
        half4 a, b;
#pragma unroll
        for (int j = 0; j < 4; ++j) { a[j] = (h16)(o0[4 * rg + j] * sc); b[j] = (h16)(o1[4 * rg + j] * sc); }
        *(half4*)(row + 8 * rg + 4 * hh) = a; *(half4*)(row + 32 + 8 * rg + 4 * hh) = b;
    }
}
__device__ __forceinline__ void oacc_add(h16* row, const f32x16& o0, const f32x16& o1, float sc, int lane) {
    const int hh = lane >> 5;
#pragma unroll
    for (int rg = 0; rg < 4; ++rg) {
        half4 a = *(const half4*)(row + 8 * rg + 4 * hh), b = *(const half4*)(row + 32 + 8 * rg + 4 * hh);
#pragma unroll
        for (int j = 0; j < 4; ++j) { a[j] = (h16)((float)a[j] + o0[4 * rg + j] * sc); b[j] = (h16)((float)b[j] + o1[4 * rg + j] * sc); }
        *(half4*)(row + 8 * rg + 4 * hh) = a; *(half4*)(row + 32 + 8 * rg + 4 * hh) = b;
    }
}
__device__ __forceinline__ void oacc_final(const h16* row, h16* orow, const f32x16& o0, const f32x16& o1, float sc, int lane) {
    const int hh = lane >> 5;
#pragma unroll
    for (int rg = 0; rg < 4; ++rg) {
        const half4 a = *(const half4*)(row + 8 * rg + 4 * hh), b = *(const half4*)(row + 32 + 8 * rg + 4 * hh);
        half4 x, y;
#pragma unroll
        for (int j = 0; j < 4; ++j) { x[j] = (h16)((float)a[j] + o0[4 * rg + j] * sc); y[j] = (h16)((float)b[j] + o1[4 * rg + j] * sc); }
        *(half4*)(orow + 8 * rg + 4 * hh) = x; *(half4*)(orow + 32 + 8 * rg + 4 * hh) = y;
    }
}

__device__ __forceinline__ void fox_unit(PRef p, int b, int h, int qt, char* smem) {
    const int tid = tidx_(), lane = tid & 63, wid = widx_();
    const int q0 = qt * 128, t0w = q0 + wid * 32, t = t0w + (lane & 31);
    half8 qf[4]; load_q(p.Z + (size_t)(b * SEQ + t) * ZLD + h * 64, qf, lane);
    const float* csg = p.C2 + (size_t)(b * 8 + h) * SEQ;
    const float ct2 = csg[t];
    RowState st; rs_reset(st);
    const int jmax = (q0 + 127) >> 6;
    const u64 mask = (jmax >= 63) ? ~0ull : ((1ull << (jmax + 1)) - 1ull);
    run_flash<M_FOX>(mask, p.Z + (size_t)b * SEQ * ZLD + 512 + h * 64, ZLD, p.VtF + (size_t)(b * 8 + h) * 64 * SEQ, SEQ, csg, smem,
                     qf, st, t, t0w, t0w + 31, 0.f, ct2, 0ull, lane);
    const float lt = st.l + __shfl_xor(st.l, 32);
    const float inv = 1.0f / lt;
#pragma unroll
    for (int r = 0; r < 16; ++r) { st.o0[r] *= inv; st.o1[r] *= inv; }
    store_o(p.O + (size_t)(b * SEQ + t) * DM + h * 64, st.o0, st.o1, lane);
}

__device__ __forceinline__ void nsa_unit(PRef p, int b, int g, int qt32, char* smem) {
    const int tid = tidx_(), lane = tid & 63, wid = widx_(), hh = lane >> 5, r32 = lane & 31;
    const int t0 = qt32 * 32, t = t0 + r32, head = g * 4 + wid, bg = b * 2 + g;
    const float slope2 = exp2f(-(float)(head + 1)) * LOG2E;
    half8 qf[4]; load_q(p.Z + (size_t)(b * SEQ + t) * ZLD + 1024 + head * 64, qf, lane);
    const float* gp = p.FG + (size_t)(b * SEQ + t) * 32 + 8 + head * 3;
    const float gate_c = gp[0], gate_s = gp[1], gate_w = gp[2];
    h16* Kb = (h16*)smem; h16* Vb = Kb + 2 * 64 * KST;
    u64* selS = (u64*)(smem + 37376);
    u64* unS = selS + 32;
    h16* oaccrow = p.OACC + (size_t)(b * SEQ + t) * 512 + head * 64;
    unsigned* impS = (unsigned*)(smem + 37888);
    {
        for (int i = tid; i < 32 * 64; i += NTHR) impS[i] = 0u;
        const int nsteps = ((t0 >> 4) >> 6) + 1;
        const h16* Kg = p.KC + (size_t)bg * 256 * 64; const h16* Vg = p.VCt + (size_t)bg * 64 * 256;
        float mrun = NEGBIG, lrun = 0.f;
        for (int i = 0; i < nsteps; ++i) {
            half8 kr[2], vr[2];
            kv_load(Kg + (size_t)i * 64 * 64, 64, Vg + i * 64, 256, kr, vr);
            kv_store(Kb, Vb, kr, vr);
            hsync();
            f32x16 s[2];
            qk_tile(Kb, qf, s, lane);
            float mx = NEGBIG;
            int dbase = t - 31 - 16 * (i * 64 + 4 * hh);
            asm volatile("" : "+v"(dbase));
#pragma unroll
            for (int kt = 0; kt < 2; ++kt)
#pragma unroll
                for (int r = 0; r < 16; ++r) {
                    const int dist = dbase - 16 * (kt * 32 + (r & 3) + 8 * (r >> 2));
                    float v = s[kt][r] - slope2 * (float)dist;
                    v = dist >= 0 ? v : NEGBIG;
                    s[kt][r] = v; mx = fmaxf(mx, v);
                }
            mx = fmaxf(mx, __shfl_xor(mx, 32));
            const float mn = fmaxf(mrun, mx), alpha = __builtin_amdgcn_exp2f(mrun - mn);
            mrun = mn;
            float ps = 0.f;
#pragma unroll
            for (int kt = 0; kt < 2; ++kt)
#pragma unroll
                for (int r = 0; r < 16; ++r) { const float v = s[kt][r]; ps += v > -1.0e29f ? __builtin_amdgcn_exp2f(v - mn) : 0.f; }
            lrun = lrun * alpha + ps;
            hsync();
        }
        const float lt = lrun + __shfl_xor(lrun, 32);
        const float inv = lt > 0.f ? 1.0f / lt : 0.f;
        f32x16 o0 = zero16(), o1 = zero16();
        float carry = 0.f;
        for (int i = 0; i < nsteps; ++i) {
            half8 kr[2], vr[2];
            kv_load(Kg + (size_t)i * 64 * 64, 64, Vg + i * 64, 256, kr, vr);
            kv_store(Kb, Vb, kr, vr);
            hsync();
            f32x16 s[2];
            qk_tile(Kb, qf, s, lane);
            int dbase = t - 31 - 16 * (i * 64 + 4 * hh);
            asm volatile("" : "+v"(dbase));
#pragma unroll
            for (int kt = 0; kt < 2; ++kt)
#pragma unroll
                for (int r = 0; r < 16; ++r) {
                    const int dist = dbase - 16 * (kt * 32 + (r & 3) + 8 * (r >> 2));
                    const float v = s[kt][r] - slope2 * (float)dist;
                    s[kt][r] = dist >= 0 ? __builtin_amdgcn_exp2f(v - mrun) * inv : 0.f;
                }
            float R[2][4];
#pragma unroll
            for (int kt = 0; kt < 2; ++kt)
#pragma unroll
                for (int rg = 0; rg < 4; ++rg) R[kt][rg] = __shfl_xor(s[kt][4 * rg + 3], 32);
#pragma unroll
            for (int kt = 0; kt < 2; ++kt)
#pragma unroll
                for (int rg = 0; rg < 4; ++rg) {
                    const float G = (s[kt][4 * rg] + s[kt][4 * rg + 1]) + (s[kt][4 * rg + 2] + s[kt][4 * rg + 3]);
                    const float prev = (kt == 0 && rg == 0) ? carry : (rg > 0 ? R[kt][rg - 1] : R[kt - 1][3]);
                    const float val = G + (hh ? R[kt][rg] : prev);
                    const int j = 16 * i + 8 * kt + 2 * rg + hh;
                    atomicAdd(&impS[r32 * 64 + j], (unsigned)(val * 67108864.0f + 0.5f));
                }
            carry = R[1][3];
            pv_tile(Vb, s, o0, o1, lane);
            hsync();
        }
        oacc_store(oaccrow, o0, o1, gate_c, lane);
    }
    hsync();
    {
        u64 un = 0ull;
        for (int i = 0; i < 8; ++i) {
            const int tok = wid * 8 + i, tt = t0 + tok, cur = tt >> 6;
            const int j = lane;
            const bool valid = j <= cur;
            const bool forced = (j == 0) || (j == cur) || (j == cur - 1);
            const unsigned key = valid ? impS[tok * 64 + j] + (forced ? 0x40000000u : 0u) : 0u;
            int rank = 0;
            for (int jj = 0; jj < 64; ++jj) {
                const unsigned kv = (unsigned)__builtin_amdgcn_readlane((int)key, jj);
                rank += (kv > key || (kv == key && jj < j)) ? 1 : 0;
            }
            const u64 selm = __ballot(valid && rank < 16);
            if (lane == 0) selS[tok] = selm;
            un |= selm;
        }
        if (lane == 0) unS[wid] = un;
    }
    hsync();
    const u64 mysel = selS[r32];
    const u64 un = unS[0] | unS[1] | unS[2] | unS[3];
    hsync();
    {
        RowState st; rs_reset(st);
        run_flash<M_SLC>(un, p.Z + (size_t)b * SEQ * ZLD + 1792 + g * 64, ZLD, p.VtS + (size_t)bg * 64 * SEQ, SEQ, nullptr, smem,
                         qf, st, t, t0, t0 + 31, slope2, 0.f, mysel, lane);
        const float lt = st.l + __shfl_xor(st.l, 32);
        oacc_add(oaccrow, st.o0, st.o1, gate_s / lt, lane);
    }
    {
        RowState st; rs_reset(st);
        const int lo = t0 - 511, jlo = lo > 0 ? (lo >> 6) : 0, jhi = (t0 + 31) >> 6;
        u64 mask = (jhi >= 63 ? ~0ull : ((1ull << (jhi + 1)) - 1ull)) & ~((1ull << jlo) - 1ull);
        run_flash<M_WIN>(mask, p.Z + (size_t)b * SEQ * ZLD + 1920 + g * 64, ZLD, p.VtW + (size_t)bg * 64 * SEQ, SEQ, nullptr, smem,
                         qf, st, t, t0, t0 + 31, slope2, 0.f, 0ull, lane);
        const float lt = st.l + __shfl_xor(st.l, 32);
        oacc_final(oaccrow, p.O + (size_t)(b * SEQ + t) * DM + 512 + head * 64, st.o0, st.o1, gate_w / lt, lane);
    }
}

__device__ __forceinline__ void phase_attention(PRef p, char* smem) {
    int* nxt = (int*)(smem + 65536 - 16);
    for (;;) {
        if (tidx_() == 0) *nxt = (int)__hip_atomic_fetch_add(p.BAR + XCD_BAR_WORDS_C, 1u, __ATOMIC_RELAXED, __HIP_MEMORY_SCOPE_AGENT);
        hsync();
        const int q = *nxt;
        hsync();
        if (q >= 2048 + 1604) break;
        int u = -1, e = -1;
        if (q < 3072) { if (q & 1) e = q >> 1; else u = q >> 1; }
        else if (q < 3140) e = 1536 + (q - 3072);
        else u = 1536 + (q - 3140);
        if (e >= 0) {
            if (e < 256) wp_unit(p, e * 4 + widx_());
            else if (e < 580) deferred_transpose_item(p, (float*)smem, (e - 256) * 4);
            else {
                const int c = e - 580, tbl = c >> 8, layer = tbl >> 1, rp0 = (c & 255) * 32 + widx_() * 8, lane = tidx_() & 63;
                const float* srcp = ((tbl & 1) ? p.peer_v : p.peer_u) + (size_t)layer * 16384 * 1024;
                unsigned char* dstp = ((tbl & 1) ? p.V8 : p.U8) + (size_t)layer * 16384 * 1024;
                float* sclp = ((tbl & 1) ? p.VS : p.US) + layer * 16384;
                for (int i = 0; i < 8; i += 2) { const int rps[2] = {rp0 + i, rp0 + i + 1}; fp6_rows<2>(srcp, dstp, sclp, rps, lane); }
            }
            continue;
        }
        const int st = 31 - (u >> 6), w = u & 63;
        if (w & 1) { const int idx = w >> 1; nsa_unit(p, (idx & 7) >> 1, idx & 1, st * 4 + (idx >> 3), smem); }
        else { const int idx = w >> 1; fox_unit(p, idx >> 3, idx & 7, st, smem); }
    }
}

__device__ __forceinline__ void phase_rmsnorm(PRef p, const float* g) {
    const int lane = tidx_() & 63, wv = bidx_() * 4 + widx_(), nwv = GRIDV * 4;
    for (int row = wv; row < TOK; row += nwv) {
        float v[16]; load_row16(p.H + (size_t)row * DM, v, lane);
        rms_write_h16(v, g, p.HN + (size_t)row * DM, lane);
    }
}

__device__ __forceinline__ unsigned fkey(float f) { const unsigned b = __float_as_uint(f); return b ^ ((b >> 31) ? 0xFFFFFFFFu : 0x80000000u); }
__device__ __forceinline__ float fkey_inv(unsigned k) { return __uint_as_float(k ^ ((k >> 31) ? 0x80000000u : 0xFFFFFFFFu)); }
__device__ __forceinline__ void ce_desc(unsigned& a, unsigned& b) { const unsigned hi = a > b ? a : b, lo = a > b ? b : a; a = hi; b = lo; }
__device__ __forceinline__ void sort16_desc(unsigned (&k)[16]) {
#pragma unroll
    for (int size = 2; size <= 16; size <<= 1)
#pragma unroll
        for (int stride = size >> 1; stride > 0; stride >>= 1)
#pragma unroll
            for (int i = 0; i < 16; ++i) {
                const int j = i ^ stride;
                if (j > i) { if ((i & size) == 0) ce_desc(k[i], k[j]); else ce_desc(k[j], k[i]); }
            }
}
__device__ __forceinline__ void merge16_desc(unsigned (&run)[16], const unsigned (&b)[16]) {
#pragma unroll
    for (int i = 0; i < 16; ++i) run[i] = run[i] > b[15 - i] ? run[i] : b[15 - i];
#pragma unroll
    for (int stride = 8; stride > 0; stride >>= 1)
#pragma unroll
        for (int i = 0; i < 16; ++i) { const int j = i ^ stride; if (j > i) ce_desc(run[i], run[j]); }
}
__device__ __forceinline__ void list_top16(const h16* __restrict__ base, unsigned (&run)[16]) {
    half8 cur0 = *(const half8*)base, cur1 = *(const half8*)(base + 512), nxt0 = cur0, nxt1 = cur1;
#pragma unroll 1
    for (int bt = 0; bt < 8; ++bt) {
        if (bt < 7) { nxt0 = *(const half8*)(base + (size_t)(2 * bt + 2) * 512); nxt1 = *(const half8*)(base + (size_t)(2 * bt + 3) * 512); }
        unsigned kb[16];
#pragma unroll
        for (int i = 0; i < 8; ++i) {
            kb[i] = (fkey((float)cur0[i]) & ~127u) | (unsigned)(127 - (bt * 16 + i));
            kb[8 + i] = (fkey((float)cur1[i]) & ~127u) | (unsigned)(127 - (bt * 16 + 8 + i));
        }
        sort16_desc(kb);
        if (bt == 0) {
#pragma unroll
            for (int i = 0; i < 16; ++i) run[i] = kb[i];
        } else merge16_desc(run, kb);
        cur0 = nxt0; cur1 = nxt1;
    }
}
__device__ __forceinline__ void peer_topk_block(PRef p, char* smem, int blk) {
    const int tid = tidx_();
    int* idS = (int*)smem; float* evS = (float*)smem + 16 * NTHR;
    {
        const int h = tid >> 5, tk = blk * 32 + (tid & 31);
        const h16* b0 = p.SC + ((size_t)((tk >> 6) * 256 + h * 32) * 64 + (tk & 63)) * 8;
        unsigned k0[16], k1[16];
        list_top16(b0, k0);
        list_top16(b0 + 16 * 512, k1);
        float v0[16], v1[16]; int i0[16], i1[16];
#pragma unroll
        for (int j = 0; j < 16; ++j) {
            v0[j] = fkey_inv(k0[j] & ~127u); i0[j] = 127 - (int)(k0[j] & 127u);
            v1[j] = fkey_inv(k1[j] & ~127u); i1[j] = 127 - (int)(k1[j] & 127u);
        }
        unsigned run[16];
        {
            unsigned kb[16]; int n = 0, nb = 0;
#pragma unroll
            for (int a = 0; a < 16; ++a)
#pragma unroll
                for (int b = 0; b < 16; ++b)
                    if ((a + 1) * (b + 1) <= 16) {
                        kb[n] = fkey(v0[a] + v1[b]); ++n;
                        if (n == 16) {
                            sort16_desc(kb);
                            if (nb == 0) {
#pragma unroll
                                for (int i = 0; i < 16; ++i) run[i] = kb[i];
                            } else merge16_desc(run, kb);
                            n = 0; ++nb;
                        }
                    }
#pragma unroll
            for (int i = 2; i < 16; ++i) kb[i] = 0u;
            sort16_desc(kb); merge16_desc(run, kb);
        }
        const unsigned tkey = run[15]; const float smax = fkey_inv(run[0]);
        int cnt = 0; float esum = 0.f;
#pragma unroll
        for (int j = 0; j < 16; ++j) { idS[j * NTHR + tid] = 0; evS[j * NTHR + tid] = 0.f; }
#pragma unroll
        for (int pass = 0; pass < 2; ++pass)
#pragma unroll
            for (int a = 0; a < 16; ++a)
#pragma unroll
                for (int b = 0; b < 16; ++b)
                    if ((a + 1) * (b + 1) <= 16) {
                        const float s = v0[a] + v1[b]; const unsigned ks = fkey(s);
                        const bool take = pass == 0 ? (ks > tkey) : (ks == tkey && cnt < 16);
                        if (take) {
                            const float e = __expf(s - smax);
                            idS[cnt * NTHR + tid] = i0[a] * 128 + i1[b]; evS[cnt * NTHR + tid] = e;
                            esum += e; ++cnt;
                        }
                    }
        const float rinv = 1.0f / esum;
#pragma unroll
        for (int j = 0; j < 16; ++j) evS[j * NTHR + tid] *= rinv;
    }
}

struct Q6 { i32x4 a; i32x2 b; };
__device__ __forceinline__ Q6 ld6(const unsigned char* row, int g) { Q6 r; r.a = *(const i32x4*)(row + g * 16); r.b = *(const i32x2*)(row + 512 + g * 8); return r; }
__device__ __forceinline__ u32x6 mk6(const Q6 q) { u32x6 r; r[0] = q.a[0]; r[1] = q.a[1]; r[2] = q.a[2]; r[3] = q.a[3]; r[4] = q.b[0]; r[5] = q.b[1]; return r; }
__device__ __forceinline__ float dot32_fp6h(const h16x32 xv, const Q6 q) {
    const h16x32 uf = __builtin_amdgcn_cvt_scalef32_pk32_f16_fp6(mk6(q), 1.0f);
    float d0 = 0.f, d1 = 0.f;
#pragma unroll
    for (int m = 0; m < 16; m += 2) {
        d0 = __builtin_amdgcn_fdot2((half2v){uf[2 * m], uf[2 * m + 1]}, (half2v){xv[2 * m], xv[2 * m + 1]}, d0, false);
        d1 = __builtin_amdgcn_fdot2((half2v){uf[2 * m + 2], uf[2 * m + 3]}, (half2v){xv[2 * m + 2], xv[2 * m + 3]}, d1, false);
    }
    return d0 + d1;
}
__device__ __forceinline__ void axpy32_fp6(f32x2 (&acc)[16], float w, const Q6 q) {
    const f32x32 vf = __builtin_amdgcn_cvt_scalef32_pk32_f32_fp6(mk6(q), 1.0f);
    const f32x2 ww = {w, w};
#pragma unroll
    for (int m = 0; m < 16; ++m) acc[m] = __builtin_elementwise_fma(ww, (f32x2){vf[2 * m], vf[2 * m + 1]}, acc[m]);
}
constexpr int ET_SHIFT = 9, ET_N = 16384 >> ET_SHIFT;
__device__ __forceinline__ void peer_experts_block(PRef p, int layer, const float* gnext, int mode, char* smem, int blk) {
    const int lane = tidx_() & 63, wid = widx_();
    const int hh = lane >> 5, g = lane & 31, dpl = (lane >> 2) & 7;
    const unsigned char* U = p.U8 + (size_t)layer * 16384 * 1024; const unsigned char* V = p.V8 + (size_t)layer * 16384 * 1024;
    const float* US = p.US + layer * 16384; const float* VS = p.VS + layer * 16384;
    const bool b4 = (lane & 16) != 0, b3 = (lane & 8) != 0, b2 = (lane & 4) != 0;
    int* sid = (int*)(smem + 32768) + wid * 512 + hh * 128;
    float* sgw = (float*)(sid + 256);
    const int* idS = (const int*)smem; const float* evS = (const float*)smem + 16 * NTHR;
    for (int r4 = 0; r4 < 4; ++r4) {
        const int tb = blk * 32 + r4 * 8 + wid * 2;
        const int tk = tb + hh;
        h16x32 xv;
        {
            half4 hx[8]; float ssx = 0.f;
#pragma unroll
            for (int c = 0; c < 8; ++c) {
                hx[c] = *(const half4*)(p.H + (size_t)tk * DM + c * 128 + g * 4);
                const float a0 = (float)hx[c][0], a1 = (float)hx[c][1], a2 = (float)hx[c][2], a3 = (float)hx[c][3];
                ssx += (a0 * a0 + a1 * a1) + (a2 * a2 + a3 * a3);
            }
#pragma unroll
            for (int o = 16; o > 0; o >>= 1) ssx += __shfl_xor(ssx, o);
            const float rstdx = rsqrtf(ssx * (1.0f / 1024.0f) + 1e-6f);
            const float* gx = p.ffn_norm_g + layer * DM + g * 4;
#pragma unroll
            for (int c = 0; c < 8; ++c) {
                const f32x4 ga = *(const f32x4*)(gx + c * 128);
#pragma unroll
                for (int j = 0; j < 4; ++j) xv[4 * c + j] = (h16)((float)hx[c][j] * rstdx * ga[j]);
            }
        }
        {
            int idv[4]; float gv[4];
#pragma unroll
            for (int s = 0; s < 4; ++s) { const int n = s * 32 + g, o = (n & 15) * NTHR + (n >> 4) * 32 + (tk & 31); idv[s] = idS[o]; gv[s] = evS[o]; }
            int cnt = 0, pos4[4] = {0, 0, 0, 0};
            const unsigned below = (1u << g) - 1u;
            for (int e = 0; e < ET_N; ++e) {
#pragma unroll
                for (int s = 0; s < 4; ++s) {
                    const bool in = (idv[s] >> ET_SHIFT) == e;
                    const u64 m = __ballot(in);
                    const unsigned mh = hh ? (unsigned)(m >> 32) : (unsigned)m;
                    pos4[s] = in ? cnt + __popc(mh & below) : pos4[s];
                    cnt += __popc(mh);
                }
            }
#pragma unroll
            for (int s = 0; s < 4; ++s) { sid[pos4[s]] = idv[s]; sgw[pos4[s]] = gv[s]; }
        }
        f32x2 acc[16];
#pragma unroll
        for (int i = 0; i < 16; ++i) acc[i] = (f32x2){0.f, 0.f};
        Q6 uq[8], vq[8]; float gwm, usm, vsm;
        auto ld_u = [&](int bt) {
            const int mine = sid[bt * 8 + dpl]; gwm = sgw[bt * 8 + dpl];
            usm = US[mine]; vsm = VS[mine];
            const i32x4 ida = *(const i32x4*)(sid + bt * 8), idb = *(const i32x4*)(sid + bt * 8 + 4);
#pragma unroll
            for (int k = 0; k < 8; ++k) uq[k] = ld6(U + (unsigned)(k < 4 ? ida[k & 3] : idb[k & 3]) * ROW6, g);
        };
        auto ld_v = [&](int bt) {
            const i32x4 ida = *(const i32x4*)(sid + bt * 8), idb = *(const i32x4*)(sid + bt * 8 + 4);
#pragma unroll
            for (int k = 0; k < 8; ++k) vq[k] = ld6(V + (unsigned)(k < 4 ? ida[k & 3] : idb[k & 3]) * ROW6, g);
        };
        ld_u(0); ld_v(0);
        for (int bt = 0; bt < 16; ++bt) {
            float d[8];
#pragma unroll
            for (int k = 0; k < 8; ++k) d[k] = dot32_fp6h(xv, uq[k]);
            const float gw_c = gwm, us_c = usm, vs_c = vsm;
            if (bt + 1 < 16) ld_u(bt + 1);
            float r4[4], r2[2], z;
#pragma unroll
            for (int i = 0; i < 4; ++i) { const float keep = b4 ? d[i + 4] : d[i], send = b4 ? d[i] : d[i + 4]; r4[i] = keep + __shfl_xor(send, 16); }
#pragma unroll
            for (int i = 0; i < 2; ++i) { const float keep = b3 ? r4[i + 2] : r4[i], send = b3 ? r4[i] : r4[i + 2]; r2[i] = keep + __shfl_xor(send, 8); }
            { const float keep = b2 ? r2[1] : r2[0], send = b2 ? r2[0] : r2[1]; z = keep + __shfl_xor(send, 4); }
            z += __shfl_xor(z, 2); z += __shfl_xor(z, 1);
            const float wm = gw_c * gelu_as(z * us_c) * vs_c;
#pragma unroll
            for (int k = 0; k < 8; ++k) {
                const float w0 = __builtin_bit_cast(float, __builtin_amdgcn_readlane(__builtin_bit_cast(int, wm), 4 * k));
                const float w1 = __builtin_bit_cast(float, __builtin_amdgcn_readlane(__builtin_bit_cast(int, wm), 32 + 4 * k));
                axpy32_fp6(acc, hh ? w1 : w0, vq[k]);
            }
            if (bt + 1 < 16) ld_v(bt + 1);
        }
        float hv[32];
        {
            const h16* hr = p.H + (size_t)tk * DM + g * 4;
#pragma unroll
            for (int c = 0; c < 8; ++c) { const half4 t = *(const half4*)(hr + c * 128); hv[4 * c] = (float)t[0] + acc[2 * c][0]; hv[4 * c + 1] = (float)t[1] + acc[2 * c][1]; hv[4 * c + 2] = (float)t[2] + acc[2 * c + 1][0]; hv[4 * c + 3] = (float)t[3] + acc[2 * c + 1][1]; }
        }
        float ss = 0.f;
#pragma unroll
        for (int i = 0; i < 32; ++i) ss += hv[i] * hv[i];
#pragma unroll
        for (int o = 16; o > 0; o >>= 1) ss += __shfl_xor(ss, o);
        const float rstd = rsqrtf(ss * (1.0f / 1024.0f) + 1e-6f);
        const float* gr = gnext + g * 4;
        if (mode == 0) {
            h16* hw = p.H + (size_t)tk * DM + g * 4;
#pragma unroll
            for (int c = 0; c < 8; ++c) {
                { half4 t; t[0] = (h16)hv[4 * c]; t[1] = (h16)hv[4 * c + 1]; t[2] = (h16)hv[4 * c + 2]; t[3] = (h16)hv[4 * c + 3]; *(half4*)(hw + c * 128) = t; }
                const f32x4 ga = *(const f32x4*)(gr + c * 128);
                half4 o;
#pragma unroll
                for (int j = 0; j < 4; ++j) o[j] = (h16)(hv[4 * c + j] * rstd * ga[j]);
                *(half4*)(p.HN + (size_t)tk * DM + c * 128 + g * 4) = o;
            }
        } else {
            float* ow = p.out + (size_t)tk * DM + g * 4;
#pragma unroll
            for (int c = 0; c < 8; ++c) { const f32x4 ga = *(const f32x4*)(gr + c * 128); *(f32x4*)(ow + c * 128) = (f32x4){hv[4 * c] * rstd * ga[0], hv[4 * c + 1] * rstd * ga[1], hv[4 * c + 2] * rstd * ga[2], hv[4 * c + 3] * rstd * ga[3]}; }
        }
    }
}

__device__ __forceinline__ void phase_peer(PRef p, int layer, const float* gnext, int mode, char* smem) {
    for (int blk = bidx_(); blk < TOK / 32; blk += GRIDV) {
        peer_topk_block(p, smem, blk);
        hsync();
        peer_experts_block(p, layer, gnext, mode, smem, blk);
        hsync();
    }
}

constexpr int XST = 136;
__device__ __forceinline__ float fast_sigmoid(float v) { return __builtin_amdgcn_rcpf(1.0f + __expf(-v)); }
__device__ __forceinline__ void phase_rnn_gates(PRef p, char* smem) {
    h16* xcS = (h16*)smem;
    float* aggS = (float*)(smem + 64 * XST * 2);
    h16* laS = (h16*)(smem + 64 * XST * 2 + 4096);
    h16* ruS = laS + 64 * XST;
    const int tid = tidx_(), lane = tid & 63, wid = widx_();
    f32x4 cw[4][2], cb[2]; half8 xin[7];
    auto ld_conv = [&](int u) {
        const int nb = u % 10, ck = (u / 10) & 63, b = u / 640;
        const int ch = nb * 128 + (tid & 15) * 8, tq = (tid >> 4) * 4;
#pragma unroll
        for (int j = 0; j < 4; ++j) { cw[j][0] = *(const f32x4*)(p.odd_conv_w + j * DRNN + ch); cw[j][1] = *(const f32x4*)(p.odd_conv_w + j * DRNN + ch + 4); }
        cb[0] = *(const f32x4*)(p.odd_conv_b + ch); cb[1] = *(const f32x4*)(p.odd_conv_b + ch + 4);
#pragma unroll
        for (int r = 0; r < 7; ++r) {
            const int sp = ck * 64 + tq - 3 + r;
            if (sp >= 0) xin[r] = *(const half8*)(p.Z2 + (size_t)(b * SEQ + sp) * Z2LD + DRNN + ch);
            else {
#pragma unroll
                for (int i = 0; i < 8; ++i) xin[r][i] = (h16)0.f;
            }
        }
    };
    if (bidx_() < 4 * 64 * 10) ld_conv(bidx_());
    for (int u = bidx_(); u < 4 * 64 * 10; u += GRIDV) {
        const int nb = u % 10, ck = (u / 10) & 63, b = u / 640;
        const int s0 = ck * 64, ch0 = nb * 128;
        half8 wfr[4][2], wfi[4][2];
        {
            const h16* wr = p.Wr + (size_t)nb * 16384 + (wid * 32 + (lane & 15)) * 128 + (lane >> 4) * 8;
            const h16* wi = p.Wr + (size_t)(10 + nb) * 16384 + (wid * 32 + (lane & 15)) * 128 + (lane >> 4) * 8;
#pragma unroll
            for (int ks = 0; ks < 4; ++ks)
#pragma unroll
                for (int e = 0; e < 2; ++e) { wfr[ks][e] = *(const half8*)(wr + e * 16 * 128 + ks * 32); wfi[ks][e] = *(const half8*)(wi + e * 16 * 128 + ks * 32); }
        }
        {
            const int c8 = (tid & 15) * 8, tq = (tid >> 4) * 4;
            float w[4][8], bias[8];
#pragma unroll
            for (int j = 0; j < 4; ++j)
#pragma unroll
                for (int i = 0; i < 4; ++i) { w[j][i] = cw[j][0][i]; w[j][4 + i] = cw[j][1][i]; }
#pragma unroll
            for (int i = 0; i < 4; ++i) { bias[i] = cb[0][i]; bias[4 + i] = cb[1][i]; }
#pragma unroll
            for (int tt = 0; tt < 4; ++tt) {
                half8 o;
#pragma unroll
                for (int i = 0; i < 8; ++i) {
                    float a = bias[i];
#pragma unroll
                    for (int j = 0; j < 4; ++j) a = fmaf(w[j][i], (float)xin[tt + j][i], a);
                    o[i] = (h16)a;
                }
                *(half8*)(xcS + (tq + tt) * XST + c8) = o;
            }
        }
        hsync();
        float bra2[2], bri2[2], sp2[2];
#pragma unroll
        for (int e = 0; e < 2; ++e) {
            const int chq = ch0 + (wid * 2 + e) * 16 + (lane & 15);
            bra2[e] = p.odd_b_ra[chq]; bri2[e] = p.odd_b_ri[chq]; sp2[e] = p.odd_lam[chq];
        }
#pragma unroll
        for (int e = 0; e < 2; ++e) sp2[e] = fmaxf(-sp2[e], 0.f) + __logf(1.0f + __expf(-fabsf(sp2[e])));
        f32x4 ar[4][2], ai[4][2];
#pragma unroll
        for (int m = 0; m < 4; ++m)
#pragma unroll
            for (int e = 0; e < 2; ++e) { ar[m][e] = (f32x4){0.f, 0.f, 0.f, 0.f}; ai[m][e] = (f32x4){0.f, 0.f, 0.f, 0.f}; }
#pragma unroll
        for (int ks = 0; ks < 4; ++ks) {
            half8 a[4];
#pragma unroll
            for (int m = 0; m < 4; ++m) a[m] = *(const half8*)(xcS + (m * 16 + (lane & 15)) * XST + ks * 32 + (lane >> 4) * 8);
#pragma unroll
            for (int e = 0; e < 2; ++e) {
                const half8 w1 = wfr[ks][e], w2 = wfi[ks][e];
#pragma unroll
                for (int m = 0; m < 4; ++m) {
                    ar[m][e] = __builtin_amdgcn_mfma_f32_16x16x32_f16(a[m], w1, ar[m][e], 0, 0, 0);
                    ai[m][e] = __builtin_amdgcn_mfma_f32_16x16x32_f16(a[m], w2, ai[m][e], 0, 0, 0);
                }
            }
        }
        if (u + GRIDV < 4 * 64 * 10) ld_conv(u + GRIDV);
        const int g4 = lane >> 4;
#pragma unroll
        for (int e = 0; e < 2; ++e) {
            const int cl = (wid * 2 + e) * 16 + (lane & 15);
            const float bra = bra2[e], bri = bri2[e], sp = sp2[e];
            float Ac = 1.f, Hc = 0.f;
#pragma unroll
            for (int m = 0; m < 4; ++m) {
                float A = 1.f, H = 0.f;
#pragma unroll
                for (int j = 0; j < 4; ++j) {
                    const int tt = m * 16 + g4 * 4 + j;
                    const float r = fast_sigmoid(ar[m][e][j] + bra), ig = fast_sigmoid(ai[m][e][j] + bri);
                    const h16 la16 = (h16)(-8.0f * r * sp);
                    const float a = __expf((float)la16);
                    const float xc = (float)xcS[tt * XST + cl];
                    const h16 u16 = (h16)(__builtin_amdgcn_sqrtf(fmaxf(1.0f - a * a, 0.f)) * (ig * xc));
                    laS[tt * XST + cl] = la16; ruS[tt * XST + cl] = u16;
                    H = a * H + (float)u16; A *= a;
                }
                { const float Al = __shfl_xor(A, 16), Hl = __shfl_xor(H, 16); if (g4 & 1) { H = Hl * A + H; A = Al * A; } }
                { const float Al = xhalf_lo(A), Hl = xhalf_lo(H); if (g4 == 3) { H = Hl * A + H; A = Al * A; } }
                Hc = Hc * A + H; Ac *= A;
            }
            if (g4 == 3) { p.AggP[(size_t)(b * 64 + ck) * DRNN + ch0 + cl] = Ac; p.AggH[(size_t)(b * 64 + ck) * DRNN + ch0 + cl] = Hc; }
        }
        hsync();
#pragma unroll
        for (int i = 0; i < 4; ++i) {
            const int q = tid + 256 * i, row = q >> 4, c8 = (q & 15) * 8;
            const size_t o = (size_t)(b * SEQ + s0 + row) * DRNN + ch0 + c8;
            *(half8*)(p.LA + o) = *(const half8*)(laS + row * XST + c8);
            *(half8*)(p.RU + o) = *(const half8*)(ruS + row * XST + c8);
        }
    }
}
__device__ __forceinline__ void phase_rnn_scan_b(PRef p) {
    for (int u = bidx_(); u < 4 * 64 * 5; u += GRIDV) {
        const int cb = u % 5, ck = (u / 5) & 63, b = u / 320;
        const int ch = cb * 256 + tidx_();
        float h = 0.f;
        {
            const float* ap = p.AggP + (size_t)(b * 64) * DRNN + ch; const float* hp = p.AggH + (size_t)(b * 64) * DRNN + ch;
            for (int c = 0; c < ck; c += 16) {
                float pa[16], ph[16];
#pragma unroll
                for (int i = 0; i < 16; ++i) { const int ci = min(c + i, ck - 1); pa[i] = ap[(size_t)ci * DRNN]; ph[i] = hp[(size_t)ci * DRNN]; }
#pragma unroll
                for (int i = 0; i < 16; ++i) { const bool ok = c + i < ck; h = (ok ? pa[i] : 1.0f) * h + (ok ? ph[i] : 0.f); }
            }
        }
        const size_t base = (size_t)(b * SEQ + ck * 64) * DRNN + ch;
        h16* zrow = p.Z2 + (size_t)(b * SEQ + ck * 64) * Z2LD;
#pragma unroll 1
        for (int i0 = 0; i0 < 64; i0 += 32) {
            h16 la[32], uu[32], gt[32];
#pragma unroll
            for (int i = 0; i < 32; ++i) { la[i] = p.LA[base + (size_t)(i0 + i) * DRNN]; uu[i] = p.RU[base + (size_t)(i0 + i) * DRNN]; gt[i] = zrow[(size_t)(i0 + i) * Z2LD + ch]; }
#pragma unroll
            for (int i = 0; i < 32; ++i) {
                h = __expf((float)la[i]) * h + (float)uu[i];
                zrow[(size_t)(i0 + i) * Z2LD + DRNN + ch] = (h16)(gelu_as((float)gt[i]) * h);
            }
        }
    }
}

#define XB_TMO      128
#define XB_XCNT(j)  (256  + 64 * (j))
#define XB_XSUB(j)  (1280 + 64 * (j))
#define XB_XGEN(j)  (2304 + 64 * (j))
#define XB_TOP      3328
#define XB_TOPGEN   3392
#define XCD_BAR_WORDS 3456
#define XB_SPIN_CAP (1u << 22)
__device__ __forceinline__ unsigned xb_ld(unsigned* p)              { return __hip_atomic_load(p, __ATOMIC_RELAXED, __HIP_MEMORY_SCOPE_AGENT); }
__device__ __forceinline__ unsigned xb_add(unsigned* p, unsigned v) { return __hip_atomic_fetch_add(p, v, __ATOMIC_RELAXED, __HIP_MEMORY_SCOPE_AGENT); }
__device__ __forceinline__ unsigned xb_xcc_id() { return (unsigned)__builtin_amdgcn_s_getreg((3 << 11) | 20) & 0xFu; }
#define XB_SPIN(cond, bar) do { unsigned _sp = 0; while (cond) { __builtin_amdgcn_s_sleep(1); \
    if ((++_sp & 255u) == 0u) { if (xb_ld(&(bar)[XB_TMO])) break; if (_sp > XB_SPIN_CAP) { atomicAdd(&(bar)[XB_TMO], 1u); break; } } } } while (0)
struct XcdBarrier { unsigned* bar; unsigned x; volatile LAS unsigned* st; };
__device__ __forceinline__ XcdBarrier xcd_barrier_post(unsigned* bar, volatile LAS unsigned* st) {
    XcdBarrier b; b.bar = bar; b.x = xb_xcc_id(); b.st = st;
    if (threadIdx.x == 0) (void)xb_add(&bar[XB_XCNT(b.x)], 1u);
    return b;
}
__device__ __forceinline__ void xcd_barrier_complete(unsigned* bar, unsigned x, unsigned& nloc, unsigned& nx) {
    const unsigned G = gridDim.x * gridDim.y * gridDim.z;
    unsigned sum, cnt, mine, sp = 0u;
    for (;;) {
        sum = 0u; cnt = 0u; mine = 0u;
#pragma unroll
        for (unsigned j = 0; j < 16; ++j) { const unsigned c = xb_ld(&bar[XB_XCNT(j)]); sum += c; cnt += (c > 0u) ? 1u : 0u; mine = (j == x) ? c : mine; }
        if (sum == G) break;
        __builtin_amdgcn_s_sleep(1);
        if ((++sp & 255u) == 0u) { if (xb_ld(&bar[XB_TMO])) break; if (sp > XB_SPIN_CAP) { atomicAdd(&bar[XB_TMO], 1u); break; } }
    }
    nloc = mine > 0u ? mine : 1u; nx = cnt > 0u ? cnt : 1u;
}
__device__ __forceinline__ void xcd_barrier(const XcdBarrier& b) {
    asm volatile("s_waitcnt vmcnt(0)" ::: "memory");
    __syncthreads();
    if (threadIdx.x == 0) {
        unsigned* bar = b.bar;
        __builtin_amdgcn_s_waitcnt(0);
        unsigned nloc = b.st[0], nx = b.st[1];
        if (nloc == 0u) { xcd_barrier_complete(bar, b.x, nloc, nx); b.st[0] = nloc; b.st[1] = nx; }
        const unsigned old = xb_add(&bar[XB_XSUB(b.x)], 1u);
        const unsigned gen = old / nloc;
        if (old + 1u == (gen + 1u) * nloc) {
            __builtin_amdgcn_fence(__ATOMIC_RELEASE, "agent");
            asm volatile("s_waitcnt vmcnt(0)" ::: "memory");
            const unsigned og = xb_add(&bar[XB_TOP], 1u);
            const unsigned tg = og / nx;
            if (og + 1u == (tg + 1u) * nx) xb_add(&bar[XB_TOPGEN], 1u);
            else XB_SPIN(xb_ld(&bar[XB_TOPGEN]) == tg, bar);
            __builtin_amdgcn_fence(__ATOMIC_ACQUIRE, "agent");
            xb_add(&bar[XB_XGEN(b.x)], 1u);
            asm volatile("s_waitcnt vmcnt(0)" ::: "memory");
        } else {
            XB_SPIN(xb_ld(&bar[XB_XGEN(b.x)]) == gen, bar);
            __builtin_amdgcn_fence(__ATOMIC_ACQUIRE, "agent");
            asm volatile("s_waitcnt vmcnt(0)" ::: "memory");
        }
    }
    __syncthreads();
}

namespace pg8 {
#define PG8_LAS __attribute__((address_space(3)))
typedef unsigned short bf16_t;
typedef short bf16x8 __attribute__((ext_vector_type(8)));
typedef unsigned u32x4 __attribute__((ext_vector_type(4)));
constexpr int BM = 256, BK = 64, HALF = 128, HTB = HALF * BK * 2  , STAGE_BYTES = 8 * HTB, NXCD = 8, WGM = 8;

__host__ __device__ __forceinline__ int lds_byte(int r, int c) { const int st = (r >> 4) * 2 + (c >> 5), rr = r & 15, cc = c & 31, ob = rr * 64 + cc * 2; return st * 1024 + (ob ^ (((ob >> 9) & 1) << 5)); }
__host__ __device__ __forceinline__ void stage_rc(int b, int& R, int& C) { const int st = b / 1024, sb = b % 1024, swz = sb ^ (((sb >> 9) & 1) << 5); R = (st >> 1) * 16 + swz / 64; C = (st & 1) * 32 + (swz % 64) / 2; }
__host__ __device__ __forceinline__ int perm32(int rho) { const int n = rho >> 4, i = rho & 15; return 8 * (i >> 2) + 4 * n + (i & 3); }

struct Unit { int pm, pn; };
struct Gemm { const bf16_t* A; const bf16_t* Bt; int M, N, K, lda; };

struct StaticOrder {
    int nM, nN, nwg, G, c;
    __host__ __device__ void init(int M, int N, int G_, int c_) { nM = M / BM; nN = N / BM; nwg = nM * nN; G = G_; c = c_; }
    __host__ __device__ bool next(int i, Unit& u) const {
        const long L = (long)i * G + c; if (L >= nwg) return false;
        int wgid = (int)L; { const int q = nwg / NXCD, r = nwg % NXCD, xcd = wgid % NXCD, off = wgid / NXCD; wgid = (xcd < r ? xcd * (q + 1) : r * (q + 1) + (xcd - r) * q) + off; }
        const int nig = WGM * nN, gid = wgid / nig, fm = gid * WGM, gsz = (nM - fm) < WGM ? (nM - fm) : WGM;
        u.pm = fm + ((wgid % nig) % gsz); u.pn = (wgid % nig) / gsz; return true;
    }
    __device__ __forceinline__ void a_ready(const Unit&) const {}
    __device__ __forceinline__ void done(const Unit&) const {}
};
__device__ __forceinline__ unsigned pk_h16(float lo, float hi) { half2v t; t[0] = (h16)lo; t[1] = (h16)hi; return __builtin_bit_cast(unsigned, t); }
template <bool R16>
struct EpiResid {
    static constexpr bool PERM = true, AFTER_DRAIN = false;
    const void* resid; h16* out; float* ssq; int ldc;
    __device__ __forceinline__ void operator()(const f32x4 (&acc)[2][2][4][2], const Unit& u, int wr, int wc, int fr, int fq) const {
#pragma unroll
        for (int ai = 0; ai < 2; ++ai)
#pragma unroll
            for (int m = 0; m < 4; ++m) { const int row = u.pm * BM + ai * HALF + wr * 64 + m * 16 + fr; const size_t ro = (size_t)row * ldc + u.pn * BM + wc * 32 + 8 * fq;
                float ss = 0.f;
#pragma unroll
                for (int bj = 0; bj < 2; ++bj) { const size_t o = ro + bj * HALF;
                    f32x4 v0 = acc[ai][bj][m][0], v1 = acc[ai][bj][m][1];
                    if (R16) { const half8 r = *(const half8*)((const h16*)resid + o);
#pragma unroll
                        for (int i = 0; i < 4; ++i) { v0[i] += (float)r[i]; v1[i] += (float)r[4 + i]; } }
                    else { v0 += *(const f32x4*)((const float*)resid + o); v1 += *(const f32x4*)((const float*)resid + o + 4); }
                    ss += ((v0[0] * v0[0] + v0[1] * v0[1]) + (v0[2] * v0[2] + v0[3] * v0[3])) + ((v1[0] * v1[0] + v1[1] * v1[1]) + (v1[2] * v1[2] + v1[3] * v1[3]));
                    u32x4 w; w.x = pk_h16(v0[0], v0[1]); w.y = pk_h16(v0[2], v0[3]); w.z = pk_h16(v1[0], v1[1]); w.w = pk_h16(v1[2], v1[3]);
                    *(u32x4*)(out + o) = w; }
                ss += __shfl_xor(ss, 16); ss += __shfl_xor(ss, 32);
                if (fq == 0) ssq[(size_t)row * 16 + u.pn * 4 + wc] = ss; }
    }
};
struct EpiF32 {
    static constexpr bool PERM = false, AFTER_DRAIN = false;
    float* out; size_t ldc;
    __device__ __forceinline__ void operator()(const f32x4 (&acc)[2][2][4][2], const Unit& u, int wr, int wc, int fr, int fq) const {
#pragma unroll
        for (int ai = 0; ai < 2; ++ai)
#pragma unroll
            for (int m = 0; m < 4; ++m) { const size_t ro = (size_t)(u.pm * BM + ai * HALF + wr * 64 + m * 16 + fr) * ldc + u.pn * BM + wc * 32 + 4 * fq;
#pragma unroll
                for (int bj = 0; bj < 2; ++bj)
#pragma unroll
                    for (int n = 0; n < 2; ++n) *(f32x4*)(out + ro + bj * HALF + n * 16) = acc[ai][bj][m][n]; }
    }
};
struct EpiH16 {
    static constexpr bool PERM = true, AFTER_DRAIN = false;
    h16* out; int ldc;
    __device__ __forceinline__ void operator()(const f32x4 (&acc)[2][2][4][2], const Unit& u, int wr, int wc, int fr, int fq) const {
#pragma unroll
        for (int ai = 0; ai < 2; ++ai)
#pragma unroll
            for (int m = 0; m < 4; ++m) { h16* rowp = out + (size_t)(u.pm * BM + ai * HALF + wr * 64 + m * 16 + fr) * ldc + u.pn * BM + wc * 32 + 8 * fq;
#pragma unroll
                for (int bj = 0; bj < 2; ++bj) { const f32x4 v0 = acc[ai][bj][m][0], v1 = acc[ai][bj][m][1];
                    u32x4 w; w.x = pk_h16(v0[0], v0[1]); w.y = pk_h16(v0[2], v0[3]); w.z = pk_h16(v1[0], v1[1]); w.w = pk_h16(v1[2], v1[3]);
                    *(u32x4*)(rowp + bj * HALF) = w; } }
    }
};
struct EpiSC {
    static constexpr bool PERM = true, AFTER_DRAIN = false;
    h16* out; const float* ssq;
    __device__ __forceinline__ void operator()(const f32x4 (&acc)[2][2][4][2], const Unit& u, int wr, int wc, int fr, int fq) const {
#pragma unroll
        for (int ai = 0; ai < 2; ++ai)
#pragma unroll
            for (int m = 0; m < 4; ++m) { const int row = u.pm * BM + ai * HALF + wr * 64 + m * 16 + fr;
                const f32x4 s0 = *(const f32x4*)(ssq + (size_t)row * 16), s1 = *(const f32x4*)(ssq + (size_t)row * 16 + 4), s2 = *(const f32x4*)(ssq + (size_t)row * 16 + 8), s3 = *(const f32x4*)(ssq + (size_t)row * 16 + 12);
                const float ssr = (((s0[0] + s0[1]) + (s0[2] + s0[3])) + ((s1[0] + s1[1]) + (s1[2] + s1[3]))) + (((s2[0] + s2[1]) + (s2[2] + s2[3])) + ((s3[0] + s3[1]) + (s3[2] + s3[3])));
                const float rstd = rsqrtf(ssr * (1.0f / 1024.0f) + 1e-6f);
#pragma unroll
                for (int bj = 0; bj < 2; ++bj) { const int col = u.pn * BM + bj * HALF + wc * 32 + 8 * fq;
                    const f32x4 v0 = acc[ai][bj][m][0] * rstd, v1 = acc[ai][bj][m][1] * rstd;
                    u32x4 w; w.x = pk_h16(v0[0], v0[1]); w.y = pk_h16(v0[2], v0[3]); w.z = pk_h16(v1[0], v1[1]); w.w = pk_h16(v1[2], v1[3]);
                    *(u32x4*)(out + ((size_t)((row >> 6) * 256 + (col >> 3)) * 64 + (row & 63)) * 8) = w; } }
    }
};
struct EpiEvenMain {
    static constexpr bool PERM = true, AFTER_DRAIN = false;
    h16* Z; float* FG; const float* b_f;
    __device__ __forceinline__ void operator()(const f32x4 (&acc)[2][2][4][2], const Unit& u, int wr, int wc, int fr, int fq) const {
#pragma unroll
        for (int bj = 0; bj < 2; ++bj) {
            const int col0 = u.pn * BM + bj * HALF + wc * 32 + 8 * fq;
            if (col0 < 2048) {
                const float sc = (col0 < 512 || (col0 >= 1024 && col0 < 1536)) ? QSCALE : 1.0f;
#pragma unroll
                for (int ai = 0; ai < 2; ++ai)
#pragma unroll
                    for (int m = 0; m < 4; ++m) { const f32x4 v0 = acc[ai][bj][m][0] * sc, v1 = acc[ai][bj][m][1] * sc;
                        u32x4 w; w.x = pk_h16(v0[0], v0[1]); w.y = pk_h16(v0[2], v0[3]); w.z = pk_h16(v1[0], v1[1]); w.w = pk_h16(v1[2], v1[3]);
                        *(u32x4*)(Z + (size_t)(u.pm * BM + ai * HALF + wr * 64 + m * 16 + fr) * ZLD + col0) = w; }
            } else if (col0 < 2080) {
                const int c = col0 - 2048;
#pragma unroll
                for (int ai = 0; ai < 2; ++ai)
#pragma unroll
                    for (int m = 0; m < 4; ++m) { const f32x4 v0 = acc[ai][bj][m][0], v1 = acc[ai][bj][m][1]; f32x4 o0, o1;
                        if (c == 0) {
#pragma unroll
                            for (int q = 0; q < 4; ++q) { o0[q] = log_sigmoid_fast(v0[q] + b_f[q]) * LOG2E; o1[q] = log_sigmoid_fast(v1[q] + b_f[4 + q]) * LOG2E; }
                        } else {
#pragma unroll
                            for (int q = 0; q < 4; ++q) { o0[q] = __builtin_amdgcn_rcpf(1.0f + __expf(-v0[q])); o1[q] = __builtin_amdgcn_rcpf(1.0f + __expf(-v1[q])); }
                        }
                        float* fr_ = FG + (size_t)(u.pm * BM + ai * HALF + wr * 64 + m * 16 + fr) * 32 + c;
                        *(f32x4*)fr_ = o0; *(f32x4*)(fr_ + 4) = o1; }
            }
        }
    }
};
struct EpiVt {
    static constexpr bool PERM = true, AFTER_DRAIN = false;
    h16 *VtF, *VtS, *VtW;
    __device__ __forceinline__ void operator()(const f32x4 (&acc)[2][2][4][2], const Unit& u, int wr, int wc, int fr, int fq) const {
#pragma unroll
        for (int ai = 0; ai < 2; ++ai)
#pragma unroll
            for (int m = 0; m < 4; ++m) {
                const int n = u.pm * BM + ai * HALF + wr * 64 + m * 16 + fr;
#pragma unroll
                for (int bj = 0; bj < 2; ++bj) {
                    const int t0 = u.pn * BM + bj * HALF + wc * 32 + 8 * fq, b = t0 >> 12, s = t0 & 4095;
                    h16* dst = n < 512 ? VtF + ((size_t)(b * 512 + n)) * SEQ + s : (n < 640 ? VtS + ((size_t)(b * 128 + n - 512)) * SEQ + s : VtW + ((size_t)(b * 128 + n - 640)) * SEQ + s);
                    const f32x4 v0 = acc[ai][bj][m][0], v1 = acc[ai][bj][m][1];
                    u32x4 w; w.x = pk_h16(v0[0], v0[1]); w.y = pk_h16(v0[2], v0[3]); w.z = pk_h16(v1[0], v1[1]); w.w = pk_h16(v1[2], v1[3]);
                    *(u32x4*)dst = w;
                }
            }
    }
};

template <class Epi, class Sched, bool ALIGN_EPI = false, bool SP2 = false>
__device__ __forceinline__ void gemm_phase(PG8_LAS unsigned char* lds, const Gemm g, const Sched& S, const Epi& E) {
    int tid_ = threadIdx.x; asm volatile("" : "+v"(tid_));
    const int tid = tid_, wid = __builtin_amdgcn_readfirstlane(tid >> 6), lane = tid & 63, wr = wid >> 2, wc = wid & 3, fr = lane & 15, fq = lane >> 4;
    const int K = g.K, nt = K / BK;
    unsigned voffA[2], voffB[2];
#pragma unroll
    for (int i = 0; i < 2; ++i) { int R, C; stage_rc(tid * 16 + i * 8192, R, C); const int Rb = Epi::PERM ? ((R & ~31) + perm32(R & 31)) : R;
        voffA[i] = (unsigned)(R * g.lda + C) * 2u; voffB[i] = (unsigned)(Rb * K + C) * 2u; }
    const size_t kstep = (size_t)(BK * 2);
    const size_t hstepA = (size_t)HALF * g.lda * 2, hstepB = (size_t)HALF * K * 2;
    const size_t tstepA = 2 * hstepA, tstepB = 2 * hstepB;
    const unsigned ldsw = (unsigned)wid * 1024u;
    const int aoff = lds_byte(wr * 64 + fr, fq * 8), boff = lds_byte(wc * 32 + fr, fq * 8);
#define PG8_SA(b, h) (((b) * 2 + (h)) * HTB)
#define PG8_SB(b, h) ((4 + (b) * 2 + (h)) * HTB)
#define PG8_STAGE(bufoff, gbase, voff) do { _Pragma("unroll") for (int _i = 0; _i < 2; ++_i) \
        __builtin_amdgcn_global_load_lds((const unsigned*)((const char*)(gbase) + (voff)[_i]), (PG8_LAS unsigned*)(lds + (bufoff) + ldsw + _i * 8192), 16, 0, 0); } while (0)
#define PG8_LDA(dst, b, h) do { _Pragma("unroll") for (int m = 0; m < 4; ++m) _Pragma("unroll") for (int k = 0; k < 2; ++k) dst[m][k] = *(const PG8_LAS bf16x8*)(lds + PG8_SA(b, h) + aoff + m * 2048 + k * 1024); } while (0)
#define PG8_LDB(dst, b, h) do { _Pragma("unroll") for (int n = 0; n < 2; ++n) _Pragma("unroll") for (int k = 0; k < 2; ++k) dst[n][k] = *(const PG8_LAS bf16x8*)(lds + PG8_SB(b, h) + boff + n * 2048 + k * 1024); } while (0)
#define PG8_MMA(ai, bj, At, Bt) do { __builtin_amdgcn_s_setprio(1); _Pragma("unroll") for (int m = 0; m < 4; ++m) _Pragma("unroll") for (int n = 0; n < 2; ++n) _Pragma("unroll") for (int k = 0; k < 2; ++k) \
        acc[ai][bj][m][n] = __builtin_amdgcn_mfma_f32_16x16x32_f16(__builtin_bit_cast(half8, Bt[n][k]), __builtin_bit_cast(half8, At[m][k]), acc[ai][bj][m][n], 0, 0, 0); __builtin_amdgcn_s_setprio(0); } while (0)
#define PG8_WAIT_V(n) asm volatile("s_waitcnt vmcnt(" #n ")" ::: "memory")
#define PG8_WAIT_L(n) asm volatile("s_waitcnt lgkmcnt(" #n ")" ::: "memory")
#define PG8_BAR __builtin_amdgcn_s_barrier()
#define PG8_SCHED __builtin_amdgcn_sched_barrier(0)
    Unit cur, nxt; int ui = 0;
    if (!S.next(0, cur)) return;
    f32x4 acc[2][2][4][2];
#pragma unroll
    for (int a = 0; a < 2; ++a)
#pragma unroll
        for (int b = 0; b < 2; ++b)
#pragma unroll
            for (int m = 0; m < 4; ++m)
#pragma unroll
                for (int n = 0; n < 2; ++n) acc[a][b][m][n] = (f32x4){0.f, 0.f, 0.f, 0.f};
    bf16x8 At[4][2], B0[2][2], B1[2][2];
    const char* cA = (const char*)g.A + (size_t)cur.pm * tstepA; const char* cB = (const char*)g.Bt + (size_t)cur.pn * tstepB;
    S.a_ready(cur);
    if constexpr (SP2) {
        PG8_STAGE(PG8_SB(0, 0), cB, voffB); PG8_STAGE(PG8_SB(0, 1), cB + hstepB, voffB); PG8_STAGE(PG8_SA(0, 0), cA, voffA); PG8_STAGE(PG8_SA(0, 1), cA + hstepA, voffA);
        if (wr == 1) PG8_BAR;
        PG8_WAIT_V(2); PG8_BAR;
        PG8_STAGE(PG8_SB(1, 0), cB + kstep, voffB); PG8_STAGE(PG8_SA(1, 0), cA + kstep, voffA); PG8_STAGE(PG8_SB(1, 1), cB + hstepB + kstep, voffB);
        PG8_WAIT_V(6); PG8_BAR;
    } else {
        PG8_STAGE(PG8_SB(0, 0), cB, voffB); PG8_STAGE(PG8_SA(0, 0), cA, voffA); PG8_STAGE(PG8_SB(0, 1), cB + hstepB, voffB); PG8_STAGE(PG8_SA(0, 1), cA + hstepA, voffA);
        if (wr == 1) PG8_BAR;
        PG8_WAIT_V(4); PG8_BAR;
        PG8_STAGE(PG8_SB(1, 0), cB + kstep, voffB); PG8_STAGE(PG8_SA(1, 0), cA + kstep, voffA); PG8_STAGE(PG8_SB(1, 1), cB + hstepB + kstep, voffB);
        PG8_WAIT_V(6); PG8_BAR;
    }
    for (;;) {
        const bool has_next = S.next(ui + 1, nxt);
        const char* nA = has_next ? (const char*)g.A + (size_t)nxt.pm * tstepA : cA; const char* nB = has_next ? (const char*)g.Bt + (size_t)nxt.pn * tstepB : cB;
        for (int t = 0; t < nt; t += 2) {
            const bool last = (t == nt - 2);
            const char* a1 = cA + (size_t)(t + 1) * kstep;
            const char* a2 = last ? nA : cA + (size_t)(t + 2) * kstep; const char* b2 = last ? nB : cB + (size_t)(t + 2) * kstep;
            const char* a3 = a2 + kstep; const char* b3 = b2 + kstep;
            if (last && has_next) S.a_ready(nxt);
            if constexpr (SP2) {
            PG8_LDB(B0, 0, 0); PG8_LDB(B1, 0, 1); PG8_SCHED; PG8_LDA(At, 0, 0); PG8_STAGE(PG8_SA(1, 1), a1 + hstepA, voffA);
            PG8_WAIT_V(8); PG8_WAIT_L(0); PG8_BAR; PG8_MMA(0, 0, At, B0); PG8_MMA(0, 1, At, B1); PG8_BAR; PG8_SCHED;
            PG8_LDA(At, 0, 1); PG8_STAGE(PG8_SB(0, 0), b2, voffB); PG8_STAGE(PG8_SB(0, 1), b2 + hstepB, voffB); PG8_STAGE(PG8_SA(0, 0), a2, voffA);
            PG8_WAIT_V(8); PG8_WAIT_L(0); PG8_BAR; PG8_MMA(1, 0, At, B0); PG8_MMA(1, 1, At, B1); PG8_BAR; PG8_SCHED;
            PG8_LDB(B0, 1, 0); PG8_LDB(B1, 1, 1); PG8_SCHED; PG8_LDA(At, 1, 0); PG8_STAGE(PG8_SA(0, 1), a2 + hstepA, voffA);
            PG8_WAIT_V(8); PG8_WAIT_L(0); PG8_BAR; PG8_MMA(0, 0, At, B0); PG8_MMA(0, 1, At, B1); PG8_BAR; PG8_SCHED;
            PG8_LDA(At, 1, 1); PG8_STAGE(PG8_SB(1, 0), b3, voffB); PG8_STAGE(PG8_SB(1, 1), b3 + hstepB, voffB); PG8_STAGE(PG8_SA(1, 0), a3, voffA);
            PG8_WAIT_V(8); PG8_WAIT_L(0); PG8_BAR; PG8_MMA(1, 0, At, B0); PG8_MMA(1, 1, At, B1); PG8_BAR; PG8_SCHED;
            } else {
            PG8_LDB(B0, 0, 0); PG8_SCHED; PG8_LDA(At, 0, 0); PG8_STAGE(PG8_SA(1, 1), a1 + hstepA, voffA);
            PG8_WAIT_L(8); PG8_BAR; PG8_WAIT_L(0); PG8_MMA(0, 0, At, B0); PG8_BAR; PG8_SCHED;
            PG8_LDB(B1, 0, 1); PG8_STAGE(PG8_SB(0, 0), b2, voffB);
            PG8_BAR; PG8_WAIT_L(0); PG8_MMA(0, 1, At, B1); PG8_BAR;
            PG8_LDA(At, 0, 1); PG8_STAGE(PG8_SA(0, 0), a2, voffA);
            PG8_BAR; PG8_WAIT_L(0); PG8_MMA(1, 0, At, B0); PG8_BAR; PG8_SCHED;
            PG8_STAGE(PG8_SB(0, 1), b2 + hstepB, voffB);
            PG8_WAIT_V(6); PG8_BAR; PG8_MMA(1, 1, At, B1); PG8_BAR;
            PG8_LDB(B0, 1, 0); PG8_SCHED; PG8_LDA(At, 1, 0); PG8_STAGE(PG8_SA(0, 1), a2 + hstepA, voffA);
            PG8_WAIT_L(8); PG8_BAR; PG8_WAIT_L(0); PG8_MMA(0, 0, At, B0); PG8_BAR; PG8_SCHED;
            PG8_LDB(B1, 1, 1); PG8_STAGE(PG8_SB(1, 0), b3, voffB);
            PG8_BAR; PG8_WAIT_L(0); PG8_MMA(0, 1, At, B1); PG8_BAR;
            PG8_LDA(At, 1, 1); PG8_STAGE(PG8_SA(1, 0), a3, voffA);
            PG8_BAR; PG8_WAIT_L(0); PG8_MMA(1, 0, At, B0); PG8_BAR; PG8_SCHED;
            PG8_STAGE(PG8_SB(1, 1), b3 + hstepB, voffB);
            PG8_WAIT_V(6); PG8_BAR; PG8_MMA(1, 1, At, B1); PG8_BAR;
            }
        }
        if constexpr (ALIGN_EPI) { if (wr == 0) PG8_BAR; }
        if constexpr (!Epi::AFTER_DRAIN) { E(acc, cur, wr, wc, fr, fq); S.done(cur); }
        if (!has_next) break;
#pragma unroll
        for (int a = 0; a < 2; ++a)
#pragma unroll
            for (int b = 0; b < 2; ++b)
#pragma unroll
                for (int m = 0; m < 4; ++m)
#pragma unroll
                    for (int n = 0; n < 2; ++n) acc[a][b][m][n] = (f32x4){0.f, 0.f, 0.f, 0.f};
        cur = nxt; cA = nA; cB = nB; ++ui;
        if constexpr (ALIGN_EPI) { if (wr == 1) PG8_BAR; }
    }
    PG8_WAIT_V(0);
    if constexpr (!ALIGN_EPI) { if (wr == 0) PG8_BAR; }
    PG8_BAR;
    if constexpr (Epi::AFTER_DRAIN) { E.fused(acc, cur, wr, wc, fr, fq, lds, wid, lane); S.done(cur); }
#undef PG8_SA
#undef PG8_SB
#undef PG8_STAGE
#undef PG8_LDA
#undef PG8_LDB
#undef PG8_MMA
#undef PG8_WAIT_V
#undef PG8_WAIT_L
#undef PG8_BAR
#undef PG8_SCHED
}
}

__device__ __forceinline__ GemmArgs mk_gemm(const h16* A, int lda, const h16* Bt, int ldb, int M, int N, int K, int ans, int mode, h16* c16, int ldc16, float* c32, int ldc32, const float* resid) {
    GemmArgs g; g.A = A; g.lda = lda; g.Bt = Bt; g.ldb = ldb; g.M = M; g.N = N; g.K = K; g.a_ntile_stride = ans; g.mode = mode; g.c16 = c16; g.ldc16 = ldc16; g.c32 = c32; g.ldc32 = ldc32; g.resid = resid; g.aux = nullptr; return g;
}

__device__ __forceinline__ void run_phase(PRef p, int ph, char* smem) {
    if (ph == 1 || ph == 4 || ph == 6 || ph == 10 || ph == 14 || ph == 16) {
        PG8_LAS unsigned char* lds = (PG8_LAS unsigned char*)dyn_lds;
        const int G = (int)gridDim.x, c = (int)blockIdx.x;
        pg8::StaticOrder S;
        typedef const pg8::bf16_t* bp;
        if (ph == 1) {
            { pg8::EpiEvenMain E{p.Z, p.FG, p.even_b_f}; S.init(TOK, ZLD, G, c);
              pg8::gemm_phase<pg8::EpiEvenMain, pg8::StaticOrder, true, true>(lds, pg8::Gemm{(bp)p.HN, (bp)p.WtE, TOK, ZLD, DM, DM}, S, E); }
            { pg8::EpiVt E{p.VtF, p.VtS, p.VtW}; S.init(768, TOK, G, (c + 3 * G / 4) % G);
              pg8::gemm_phase<pg8::EpiVt, pg8::StaticOrder, true, true>(lds, pg8::Gemm{(bp)p.WtV, (bp)p.HN, 768, TOK, DM, DM}, S, E); }
        } else if (ph == 4) {
            pg8::EpiResid<false> E{p.x, p.H, p.SSQ, DM}; S.init(TOK, DM, G, c);
            pg8::gemm_phase<pg8::EpiResid<false>, pg8::StaticOrder, true, true>(lds, pg8::Gemm{(bp)p.O, (bp)p.WtEo, TOK, DM, DM, DM}, S, E);
        } else if (ph == 14) {
            pg8::EpiResid<true> E{p.H, p.H, p.SSQ, DM}; S.init(TOK, DM, G, c);
            pg8::gemm_phase<pg8::EpiResid<true>, pg8::StaticOrder, true, true>(lds, pg8::Gemm{(bp)(p.Z2 + DRNN), (bp)p.WtOo, TOK, DM, DRNN, Z2LD}, S, E);
        } else if (ph == 10) {
            pg8::EpiH16 E{p.Z2, Z2LD}; S.init(TOK, Z2LD, G, c);
            pg8::gemm_phase<pg8::EpiH16, pg8::StaticOrder, true, true>(lds, pg8::Gemm{(bp)p.HN, (bp)p.WtO, TOK, Z2LD, DM, DM}, S, E);
        } else {
            pg8::EpiSC E{p.SC, p.SSQ}; S.init(TOK, 2048, G, c);
            pg8::gemm_phase<pg8::EpiSC, pg8::StaticOrder, true, true>(lds, pg8::Gemm{(bp)p.H, (bp)(p.WtQ + (ph == 16 ? (size_t)2048 * 1024 : 0)), TOK, 2048, DM, DM}, S, E);
        }
        return;
    }
    if (ph == 0) phase_prep(p, smem);
    else if (ph == 2) phase_cumsum_compress(p, smem);
    else if (ph == 3) phase_attention(p, smem);
    else if (ph == 9 || ph == 19) phase_peer(p, ph == 19 ? 1 : 0, ph == 19 ? p.final_g : p.odd_norm_g, ph == 19 ? 1 : 0, smem);
    else if (ph == 11) phase_rnn_gates(p, smem);
    else if (ph == 13) phase_rnn_scan_b(p);
}

__global__ void __launch_bounds__(512, 2) mega(Params p_by_value) {
    char* smem = dyn_lds + hidx_() * 65536;
    volatile LAS unsigned* hs_all = (volatile LAS unsigned*)(dyn_lds + 131072);
    const __attribute__((address_space(4))) Params* kp = (const __attribute__((address_space(4))) Params*)__builtin_amdgcn_kernarg_segment_ptr();
    const int ph0 = (int)kp->ph0, ph1 = (int)kp->ph1;
    if (threadIdx.x < 12) hs_all[threadIdx.x] = 0u;
    __syncthreads();
    XcdBarrier xb = xcd_barrier_post(kp->BAR, hs_all + 8);
    for (int ph = ph0; ph < ph1; ++ph) {
        if (ph == 12 || ph == 7 || ph == 17 || ph == 5 || ph == 15 || ph == 8 || ph == 18) continue;
        const __attribute__((address_space(4))) Params* q = kp;
        asm volatile("" : "+s"(q));
        PRef p = *q;
#if PROBE_PH >= 0
        if (blockIdx.x == 0 && threadIdx.x == 0) p.TS[ph] = __builtin_amdgcn_s_memrealtime();
#endif
        const int reps = ((DUP_MASK >> ph) & 1) ? 2 : 1;
        for (int r = 0; r < reps; ++r) { run_phase(p, ph, smem); if (r + 1 < reps) xcd_barrier(xb); }
        if (ph + 1 < ph1) xcd_barrier(xb);
    }
    PRef p = *kp;
#if PROBE_PH >= 0
    cg::this_grid().sync();
    if (blockIdx.x == 0 && threadIdx.x == 0) { p.TS[NPHASE] = __builtin_amdgcn_s_memrealtime(); __threadfence(); }
    cg::this_grid().sync();
    {
        const unsigned long long t0 = __hip_atomic_load(&p.TS[0], __ATOMIC_RELAXED, __HIP_MEMORY_SCOPE_AGENT), t1 = __hip_atomic_load(&p.TS[NPHASE], __ATOMIC_RELAXED, __HIP_MEMORY_SCOPE_AGENT);
        const unsigned long long a = __hip_atomic_load(&p.TS[PROBE_PH], __ATOMIC_RELAXED, __HIP_MEMORY_SCOPE_AGENT), b = __hip_atomic_load(&p.TS[PROBE_PH + PROBE_N], __ATOMIC_RELAXED, __HIP_MEMORY_SCOPE_AGENT);
        const float frac = (float)(b - a) / (float)(t1 - t0);
        const float scale = 1.1f + frac;
        for (size_t i = (size_t)blockIdx.x * 512 + threadIdx.x; i < (size_t)TOK * DM; i += (size_t)gridDim.x * 512) p.out[i] *= scale;
    }
#endif
}

constexpr int DYN_LDS_BYTES = 131072 + 64;
extern "C" void kernel_launch(void* const* d_in, const int* in_sizes, int n_in, void* d_out, int out_size, void* d_ws, size_t ws_size, hipStream_t stream) {
    Params p; memset(&p, 0, sizeof(p));
    const float* const* in = (const float* const*)d_in;
    p.x = in[0]; p.even_norm_g = in[1]; p.even_w_in = in[2]; p.even_b_f = in[3]; p.even_cmp_pos = in[4]; p.even_w_cmp_k = in[5]; p.even_w_cmp_v = in[6]; p.even_w_out = in[7];
    p.odd_norm_g = in[8]; p.odd_w_in = in[9]; p.odd_conv_w = in[10]; p.odd_conv_b = in[11]; p.odd_w_ra = in[12]; p.odd_b_ra = in[13]; p.odd_w_ri = in[14]; p.odd_b_ri = in[15];
    p.odd_lam = in[16]; p.odd_w_out = in[17]; p.ffn_norm_g = in[18]; p.peer_w_q = in[19]; p.peer_sub_keys = in[20]; p.peer_u = in[21]; p.peer_v = in[22]; p.final_g = in[23];
    p.out = (float*)d_out;
    char* ws = (char*)d_ws; size_t off = 0;
    auto take = [&](size_t bytes) { char* r = ws + off; off += (bytes + 255) & ~(size_t)255; return r; };
    p.WtE = (h16*)take((size_t)ZLD * 1024 * 2); p.WtV = (h16*)take((size_t)768 * 1024 * 2); p.WtEo = (h16*)take((size_t)1024 * 1024 * 2); p.WtO = (h16*)take((size_t)2560 * 1024 * 2); p.WtOo = (h16*)take((size_t)1024 * 1280 * 2);
    p.WtQ = (h16*)take((size_t)2 * 2048 * 1024 * 2); p.Wc = (h16*)take((size_t)2 * 64 * 2048 * 2); p.Wr = (h16*)take((size_t)20 * 16384 * 2); p.Keys = (h16*)take((size_t)2 * 8 * 2 * 128 * 128 * 2);
    p.Pos16 = (h16*)take(4096); p.U8 = (unsigned char*)take((size_t)2 * 16384 * 1024); p.V8 = (unsigned char*)take((size_t)2 * 16384 * 1024);
    p.US = (float*)take((size_t)2 * 16384 * 4); p.VS = (float*)take((size_t)2 * 16384 * 4);
    p.H = (h16*)take((size_t)TOK * DM * 2); p.HN = (h16*)take((size_t)TOK * DM * 2); p.SSQ = (float*)take((size_t)TOK * 16 * 4);
    const size_t scratch0 = off;
    p.Z = (h16*)take((size_t)TOK * ZLD * 2); p.VtF = (h16*)take((size_t)4 * 8 * 64 * SEQ * 2); p.VtS = (h16*)take((size_t)4 * 2 * 64 * SEQ * 2); p.VtW = (h16*)take((size_t)4 * 2 * 64 * SEQ * 2);
    p.KC = (h16*)take((size_t)8 * 256 * 64 * 2); p.VCt = (h16*)take((size_t)8 * 64 * 256 * 2); p.O = (h16*)take((size_t)TOK * DM * 2); p.FG = (float*)take((size_t)TOK * 32 * 4); p.C2 = (float*)take((size_t)32 * SEQ * 4); p.OACC = (h16*)take((size_t)TOK * 512 * 2);
    size_t mx = off;
    off = scratch0;
    p.QP = (h16*)take((size_t)TOK * 2048 * 2); p.SC = (h16*)take((size_t)TOK * 2048 * 2); p.IDS = (int*)take((size_t)TOK * 128 * 4); p.GW = (float*)take((size_t)TOK * 128 * 4);
    if (off > mx) mx = off;
    off = scratch0;
    p.Z2 = (h16*)take((size_t)TOK * Z2LD * 2); p.LA = (h16*)take((size_t)TOK * DRNN * 2); p.RU = (h16*)take((size_t)TOK * DRNN * 2);
    p.AggP = (float*)take((size_t)4 * 64 * DRNN * 4); p.AggH = (float*)take((size_t)4 * 64 * DRNN * 4);
    if (off > mx) mx = off;
    off = mx; p.TS = (unsigned long long*)take(256); p.BAR = (unsigned*)take(XCD_BAR_WORDS * 4 + 256); mx = off;
    if (mx > ws_size) { fprintf(stderr, "workspace too small: need %zu have %zu\n", mx, ws_size); return; }

    static int grid_blocks = 0;
    if (!grid_blocks) {
        int dev = 0, cus = 0, per_cu = 0;
        hipGetDevice(&dev);
        hipDeviceGetAttribute(&cus, hipDeviceAttributeMultiprocessorCount, dev);
        hipFuncSetAttribute((const void*)mega, hipFuncAttributeMaxDynamicSharedMemorySize, DYN_LDS_BYTES);
        hipOccupancyMaxActiveBlocksPerMultiprocessor(&per_cu, mega, 512, DYN_LDS_BYTES);
        if (per_cu > 1) per_cu = 1;
        if (per_cu < 1) per_cu = 1;
        grid_blocks = cus * per_cu;
    }
    hipMemsetAsync(p.BAR, 0, XCD_BAR_WORDS * 4 + 256, stream);
#if SINGLE_LAUNCH
    p.ph0 = 0; p.ph1 = NPHASE;
    void* args[] = {&p};
    hipError_t e = hipLaunchCooperativeKernel((void*)mega, dim3(grid_blocks), dim3(512), args, DYN_LDS_BYTES, stream);
    if (e != hipSuccess) fprintf(stderr, "cooperative launch failed: %s (grid %d)\n", hipGetErrorString(e), grid_blocks);
#else
    for (int ph = 0; ph < NPHASE; ++ph) {
        p.ph0 = ph; p.ph1 = ph + 1;
        hipLaunchKernelGGL(mega, dim3(grid_blocks), dim3(512), DYN_LDS_BYTES, stream, p);
    }
#endif
}
```
